# Optimizing an MI355X kernel written in HIP

```python
import jax, jax.numpy as jnp
from jax import lax
import numpy as np

D_MODEL = 1024
BATCH = 8
SEQ = 4096
DEPTH = 1

EPS = 1e-6
GRID_W = 64
D_MIX = D_MODEL

GLA_HEADS = 4
GLA_DK = 64
GLA_DV = 128
GLA_KEY_WIDTH = GLA_HEADS * GLA_DK
GLA_WIDTH = GLA_HEADS * GLA_DV
GLA_GATE_RANK = 16
GLA_GATE_NORM = 16.0
GLA_CHUNK = 64

ATT_HEADS = 8
ATT_KV_HEADS = 2
ATT_HEAD_DIM = 64
ATT_WIDTH = ATT_HEADS * ATT_HEAD_DIM
ATT_KV_WIDTH = ATT_KV_HEADS * ATT_HEAD_DIM
Q_BLOCK = 128
ROPE_THETA = 10000.0

N_GROUPS = 8
EXPERTS_PER_GROUP = 8
N_EXPERTS = N_GROUPS * EXPERTS_PER_GROUP
TOP_K = 2
D_EXPERT = 512
MOE_BLOCK = 128

IN_SIZES = (GLA_KEY_WIDTH, GLA_KEY_WIDTH, GLA_WIDTH, GLA_WIDTH,
            GLA_GATE_RANK, GLA_GATE_RANK,
            ATT_WIDTH, ATT_KV_WIDTH, ATT_KV_WIDTH)
D_IN = 2336

kernel_name = "hymba_gla_axialgqa_hmoe_encoder"


def rms_norm(x, gain):
    x32 = x.astype(jnp.float32)
    y = x32 * lax.rsqrt(jnp.mean(x32 * x32, axis=-1, keepdims=True) + EPS)
    return y.astype(x.dtype) * gain


def gla_chunked(q, k, v, log_a):
    B, H, T, dk = q.shape
    dv = v.shape[-1]
    C = GLA_CHUNK
    N = T // C
    f32 = jnp.float32
    qf = q.astype(f32).reshape(B, H, N, C, dk)
    kf = k.astype(f32).reshape(B, H, N, C, dk)
    vf = v.astype(f32).reshape(B, H, N, C, dv)
    b = jnp.cumsum(log_a.astype(f32).reshape(B, H, N, C, dk), axis=3)
    b_ref = b[:, :, :, C // 2 - 1:C // 2, :]
    b_last = b[:, :, :, -1:, :]
    scores = jnp.einsum('bhncd,bhnsd->bhncs', qf * jnp.exp(b - b_ref), kf * jnp.exp(b_ref - b))
    mask = jnp.tril(jnp.ones((C, C), dtype=bool))
    scores = jnp.where(mask, scores, 0.0)
    o_intra = jnp.einsum('bhncs,bhnse->bhnce', scores, vf)
    chunk_kv = jnp.einsum('bhncd,bhnce->bhnde', kf * jnp.exp(b_last - b), vf)
    chunk_decay = jnp.exp(b_last[:, :, :, 0, :])

    def step(state, inp):
        decay, kv = inp
        return decay[..., None] * state + kv, state

    init = jnp.zeros((B, H, dk, dv), f32)
    _, states = lax.scan(step, init, (jnp.moveaxis(chunk_decay, 2, 0), jnp.moveaxis(chunk_kv, 2, 0)))
    states = jnp.moveaxis(states, 0, 2)
    o_inter = jnp.einsum('bhncd,bhnde->bhnce', qf * jnp.exp(b), states)
    return (o_intra + o_inter).reshape(B, H, T, dv).astype(v.dtype)


def gla_group(q, k, v, g, z_fwd, z_bwd, up_f, up_f_bias, up_b, up_b_bias, out_gain):
    B, T, _ = q.shape

    def heads(t, d):
        return t.reshape(B, T, GLA_HEADS, d).transpose(0, 2, 1, 3)

    qh = heads(q, GLA_DK) * (GLA_DK ** -0.5)
    kh = heads(k, GLA_DK)
    vh = heads(v, GLA_DV)
    la_f = heads(jax.nn.log_sigmoid((z_fwd @ up_f + up_f_bias).astype(jnp.float32)) / GLA_GATE_NORM, GLA_DK)
    la_b = heads(jax.nn.log_sigmoid((z_bwd @ up_b + up_b_bias).astype(jnp.float32)) / GLA_GATE_NORM, GLA_DK)
    o_f = gla_chunked(qh, kh, vh, la_f)
    flip = lambda t: jnp.flip(t, axis=2)
    o_b = flip(gla_chunked(flip(qh), flip(kh), flip(vh), flip(la_b)))
    o = rms_norm(o_f + o_b, out_gain)
    o = o.transpose(0, 2, 1, 3).reshape(B, T, GLA_WIDTH)
    return o * jax.nn.silu(g)


def axial_rope_tables(T):
    rows = T // GRID_W
    row = jnp.repeat(jnp.arange(rows), GRID_W).astype(jnp.float32)
    col = jnp.tile(jnp.arange(GRID_W), rows).astype(jnp.float32)
    axis_dim = ATT_HEAD_DIM // 2
    inv_freq = ROPE_THETA ** (-jnp.arange(0, axis_dim, 2, dtype=jnp.float32) / axis_dim)
    ang = jnp.concatenate([row[:, None] * inv_freq, col[:, None] * inv_freq], axis=-1)
    return jnp.cos(ang), jnp.sin(ang)


def apply_axial_rope(x, cos, sin):
    xr = x.astype(jnp.float32).reshape(*x.shape[:-1], -1, 2)
    x0, x1 = xr[..., 0], xr[..., 1]
    out = jnp.stack([x0 * cos - x1 * sin, x0 * sin + x1 * cos], axis=-1)
    return out.reshape(x.shape).astype(x.dtype)


def gqa_group(q, k, v, q_gain, k_gain, out_gain):
    B, T, _ = q.shape
    dh = ATT_HEAD_DIM
    G = ATT_HEADS // ATT_KV_HEADS
    qh = rms_norm(q.reshape(B, T, ATT_HEADS, dh).transpose(0, 2, 1, 3), q_gain)
    kh = rms_norm(k.reshape(B, T, ATT_KV_HEADS, dh).transpose(0, 2, 1, 3), k_gain)
    vh = v.reshape(B, T, ATT_KV_HEADS, dh).transpose(0, 2, 1, 3)
    cos, sin = axial_rope_tables(T)
    qh = apply_axial_rope(qh, cos, sin) * (dh ** -0.5)
    kh = apply_axial_rope(kh, cos, sin)
    nb = T // Q_BLOCK
    q_blocks = qh.reshape(B, ATT_KV_HEADS, G, nb, Q_BLOCK, dh).transpose(3, 0, 1, 2, 4, 5)

    def attend(qb):
        s = jnp.einsum('bkgqd,bksd->bkgqs', qb, kh).astype(jnp.float32)
        p = jax.nn.softmax(s, axis=-1).astype(vh.dtype)
        return jnp.einsum('bkgqs,bksd->bkgqd', p, vh)

    o = lax.map(attend, q_blocks)
    o = o.transpose(1, 0, 4, 2, 3, 5).reshape(B, T, ATT_WIDTH)
    return rms_norm(o, out_gain)


def hier_moe(x, w_group, b_group, w_expert, b_expert, w_gate, w_up, w_down):
    B, T, D = x.shape
    xt = x.reshape(-1, D)
    N = xt.shape[0]
    g_logits = (xt @ w_group + b_group).astype(jnp.float32)
    g_prob = jax.nn.softmax(g_logits, axis=-1)
    g_idx = jnp.argmax(g_logits, axis=-1)
    g_w = jnp.take_along_axis(g_prob, g_idx[:, None], axis=-1)
    e_logits = (xt @ w_expert + b_expert).astype(jnp.float32).reshape(N, N_GROUPS, EXPERTS_PER_GROUP)
    e_logits = jnp.take_along_axis(e_logits, g_idx[:, None, None], axis=1)[:, 0]
    top_val, top_idx = lax.top_k(e_logits, TOP_K)
    gate = g_w * jax.nn.softmax(top_val, axis=-1)
    expert_id = g_idx[:, None] * EXPERTS_PER_GROUP + top_idx

    M = N * TOP_K
    flat_e = expert_id.reshape(M).astype(jnp.int32)
    flat_tok = jnp.repeat(jnp.arange(N, dtype=jnp.int32), TOP_K)
    flat_gate = gate.reshape(M).astype(x.dtype)
    order = jnp.argsort(flat_e)
    se = flat_e[order]
    counts = jnp.bincount(flat_e, length=N_EXPERTS)
    starts = jnp.cumsum(counts) - counts
    padded = (counts + MOE_BLOCK - 1) // MOE_BLOCK * MOE_BLOCK
    pad_ends = jnp.cumsum(padded)
    pad_starts = pad_ends - padded
    dest = pad_starts[se] + (jnp.arange(M, dtype=jnp.int32) - starts[se])
    P = M + N_EXPERTS * MOE_BLOCK
    slot_tok = jnp.zeros((P,), jnp.int32).at[dest].set(flat_tok[order])
    slot_gate = jnp.zeros((P,), x.dtype).at[dest].set(flat_gate[order])
    nblk = P // MOE_BLOCK
    blk_start = jnp.arange(nblk, dtype=jnp.int32) * MOE_BLOCK
    blk_expert = jnp.minimum(jnp.searchsorted(pad_ends, blk_start, side='right'), N_EXPERTS - 1)
    xs = xt[slot_tok].reshape(nblk, MOE_BLOCK, D)

    def run_block(args):
        xb, e = args
        h = jax.nn.silu(xb @ w_gate[e]) * (xb @ w_up[e])
        return h @ w_down[e]

    ys = lax.map(run_block, (xs, blk_expert)).reshape(P, D)
    y = jnp.zeros((N, D), x.dtype).at[slot_tok].add(ys * slot_gate[:, None])
    return y.reshape(B, T, D)


def setup_inputs(seed: int = 0) -> dict:
    key = jax.random.key(seed)
    ks = jax.random.split(key, 24)
    f32 = jnp.float32
    L = DEPTH

    def nrm(k, shape, scale):
        return jax.random.normal(k, shape, f32) * scale

    def gain(k, shape):
        return 1.0 + 0.02 * jax.random.normal(k, shape, f32)

    return {
        "x": nrm(ks[0], (BATCH, SEQ, D_MODEL), 1.0),
        "norm1_gain": gain(ks[1], (L, D_MODEL)),
        "w_in": nrm(ks[2], (L, D_MODEL, D_IN), D_MODEL ** -0.5),
        "gla_up_fwd": nrm(ks[3], (L, GLA_GATE_RANK, GLA_KEY_WIDTH), GLA_GATE_RANK ** -0.5),
        "gla_up_fwd_bias": nrm(ks[4], (L, GLA_KEY_WIDTH), 0.1),
        "gla_up_bwd": nrm(ks[5], (L, GLA_GATE_RANK, GLA_KEY_WIDTH), GLA_GATE_RANK ** -0.5),
        "gla_up_bwd_bias": nrm(ks[6], (L, GLA_KEY_WIDTH), 0.1),
        "gla_out_gain": gain(ks[7], (L, GLA_DV)),
        "q_norm_gain": gain(ks[8], (L, ATT_HEAD_DIM)),
        "k_norm_gain": gain(ks[9], (L, ATT_HEAD_DIM)),
        "att_out_gain": gain(ks[10], (L, ATT_WIDTH)),
        "w_out": nrm(ks[11], (L, D_MIX, D_MODEL), D_MIX ** -0.5),
        "norm2_gain": gain(ks[12], (L, D_MODEL)),
        "w_group": nrm(ks[13], (L, D_MODEL, N_GROUPS), D_MODEL ** -0.5),
        "b_group": nrm(ks[14], (L, N_GROUPS), 0.01),
        "w_expert": nrm(ks[15], (L, D_MODEL, N_EXPERTS), D_MODEL ** -0.5),
        "b_expert": nrm(ks[16], (L, N_EXPERTS), 0.01),
        "w_gate": nrm(ks[17], (L, N_EXPERTS, D_MODEL, D_EXPERT), D_MODEL ** -0.5),
        "w_up": nrm(ks[18], (L, N_EXPERTS, D_MODEL, D_EXPERT), D_MODEL ** -0.5),
        "w_down": nrm(ks[19], (L, N_EXPERTS, D_EXPERT, D_MODEL), D_EXPERT ** -0.5),
        "final_gain": gain(ks[20], (D_MODEL,)),
    }


def reference(x, norm1_gain, w_in, gla_up_fwd, gla_up_fwd_bias, gla_up_bwd, gla_up_bwd_bias,
              gla_out_gain, q_norm_gain, k_norm_gain, att_out_gain, w_out, norm2_gain,
              w_group, b_group, w_expert, b_expert, w_gate, w_up, w_down, final_gain):
    split_points = np.cumsum(IN_SIZES)[:-1].tolist()
    h = x
    for l in range(DEPTH):
        u = rms_norm(h, norm1_gain[l])
        proj = u @ w_in[l]
        gq, gk, gv, gg, zf, zb, aq, ak, av = jnp.split(proj, split_points, axis=-1)
        o_gla = gla_group(gq, gk, gv, gg, zf, zb, gla_up_fwd[l], gla_up_fwd_bias[l],
                          gla_up_bwd[l], gla_up_bwd_bias[l], gla_out_gain[l])
        o_att = gqa_group(aq, ak, av, q_norm_gain[l], k_norm_gain[l], att_out_gain[l])
        mixed = jnp.concatenate([o_gla, o_att], axis=-1)
        h = h + mixed @ w_out[l]
        h = h + hier_moe(rms_norm(h, norm2_gain[l]), w_group[l], b_group[l], w_expert[l],
                         b_expert[l], w_gate[l], w_up[l], w_down[l])
    return rms_norm(h, final_gain)
```

```cpp
#include <hip/hip_runtime.h>
#include <stdint.h>
#include <math.h>

constexpr int NB = 8, T = 4096, D = 1024, NTOK = NB * T;
constexpr int DIN = 2336;
constexpr int PW = 2560;
constexpr int C_GQ = 0, C_GK = 256, C_GV = 512, C_GG = 1024, C_AQ = 1536, C_AK = 2048, C_AV = 2176, C_ZF = 2304, C_ZB = 2320;
constexpr int NEXP = 64, DEXP = 512, NSLOT = 2 * NTOK;
constexpr float EPS = 1e-6f;

typedef unsigned short bf16_t;

constexpr size_t MiB = 1u << 20;
constexpr size_t WS_CTL = 0;
constexpr size_t WS_TOKINFO = 1 * MiB;
constexpr size_t WS_TOKSLOT = 1 * MiB + 512 * 1024;
constexpr size_t WS_SLOTTOK = 2 * MiB;
constexpr size_t WS_SLOTGATE = 2 * MiB + 256 * 1024;
constexpr size_t WS_ROPE = 3 * MiB;
constexpr size_t WS_LAF = 16 * MiB;
constexpr size_t WS_LAB = 48 * MiB;
constexpr size_t WS_OF = 80 * MiB;
constexpr size_t WS_OB = 144 * MiB;
constexpr size_t WS_U = 208 * MiB;
constexpr size_t WS_PROJ = 272 * MiB;
constexpr size_t WS_G = 432 * MiB;
constexpr int CW_COUNTS = 0, CW_CURSOR = 64, CW_OFFS = 128, CW_NTILES = 256, CW_TILE_E = 1024, CW_TILE_R0 = 4096, CW_TILE_NR = 8192;

__device__ __forceinline__ float bf2f(bf16_t v) { return __uint_as_float(((unsigned)v) << 16); }
__device__ __forceinline__ bf16_t f2bf(float f) { unsigned u = __float_as_uint(f); return (bf16_t)((u + 0x7fffu + ((u >> 16) & 1u)) >> 16); }
__device__ __forceinline__ float wave_sum(float v) {
#pragma unroll
    for (int o = 1; o < 64; o <<= 1) v += __shfl_xor(v, o);
    return v;
}
__device__ __forceinline__ float silu_f(float x) { return x / (1.f + expf(-x)); }

__global__ void __launch_bounds__(256) k_prep_x(const float* __restrict__ x, const float* __restrict__ g, bf16_t* __restrict__ U) {
    const int lane = threadIdx.x & 63, row = blockIdx.x * 4 + (threadIdx.x >> 6);
    const float4* xr = (const float4*)(x + (size_t)row * D);
    float4 v[4]; float ss = 0.f;
#pragma unroll
    for (int j = 0; j < 4; ++j) { v[j] = xr[j * 64 + lane]; ss += v[j].x * v[j].x + v[j].y * v[j].y + v[j].z * v[j].z + v[j].w * v[j].w; }
    ss = wave_sum(ss);
    const float rstd = rsqrtf(ss * (1.f / D) + EPS);
#pragma unroll
    for (int j = 0; j < 4; ++j) {
        const float4 gg = ((const float4*)g)[j * 64 + lane];
        ushort4 o; o.x = f2bf(v[j].x * rstd * gg.x); o.y = f2bf(v[j].y * rstd * gg.y); o.z = f2bf(v[j].z * rstd * gg.z); o.w = f2bf(v[j].w * rstd * gg.w);
        ((ushort4*)(U + (size_t)row * D))[j * 64 + lane] = o;
    }
}

__global__ void k_rope_table(float* __restrict__ tab) {
    const int i = threadIdx.x + blockIdx.x * blockDim.x;
    if (i >= 1024) return;
    const int pos = i >> 4, j = i & 15;
    const float inv = powf(10000.0f, -(float)(2 * j) / 32.0f);
    const float ang = (float)pos * inv;
    tab[i] = cosf(ang); tab[1024 + i] = sinf(ang);
}

template <bool DUAL, class FA, class FB, class FB2, class FE>
__device__ __forceinline__ void naive_tile(int K, FA fa, FB fb, FB2 fb2, FE fe) {
    __shared__ float As[16][68];
    __shared__ float Bs[16][68];
    __shared__ float Bs2[DUAL ? 16 : 1][68];
    const int tid = threadIdx.x, tx = tid & 15, ty = tid >> 4;
    float acc[4][4], acc2[4][4];
#pragma unroll
    for (int i = 0; i < 4; ++i)
#pragma unroll
        for (int j = 0; j < 4; ++j) { acc[i][j] = 0.f; acc2[i][j] = 0.f; }
    for (int k0 = 0; k0 < K; k0 += 16) {
        { const int r = tid >> 2, kk = (tid & 3) * 4; const float4 a = fa(r, k0 + kk); As[kk][r] = a.x; As[kk + 1][r] = a.y; As[kk + 2][r] = a.z; As[kk + 3][r] = a.w; }
        { const int kk = tid >> 4, c = (tid & 15) * 4; *(float4*)&Bs[kk][c] = fb(k0 + kk, c); if (DUAL) *(float4*)&Bs2[kk][c] = fb2(k0 + kk, c); }
        __syncthreads();
#pragma unroll
        for (int kk = 0; kk < 16; ++kk) {
            const float4 a = *(const float4*)&As[kk][ty * 4]; const float4 b = *(const float4*)&Bs[kk][tx * 4];
            const float av[4] = {a.x, a.y, a.z, a.w}; const float bv[4] = {b.x, b.y, b.z, b.w};
#pragma unroll
            for (int i = 0; i < 4; ++i)
#pragma unroll
                for (int j = 0; j < 4; ++j) acc[i][j] += av[i] * bv[j];
            if (DUAL) {
                const float4 b2 = *(const float4*)&Bs2[kk][tx * 4]; const float bw[4] = {b2.x, b2.y, b2.z, b2.w};
#pragma unroll
                for (int i = 0; i < 4; ++i)
#pragma unroll
                    for (int j = 0; j < 4; ++j) acc2[i][j] += av[i] * bw[j];
            }
        }
        __syncthreads();
    }
#pragma unroll
    for (int i = 0; i < 4; ++i) fe(ty * 4 + i, tx * 4, make_float4(acc[i][0], acc[i][1], acc[i][2], acc[i][3]), make_float4(acc2[i][0], acc2[i][1], acc2[i][2], acc2[i][3]));
}
__device__ __forceinline__ float4 ld_bf4(const bf16_t* p) { const ushort4 u = *(const ushort4*)p; return make_float4(bf2f(u.x), bf2f(u.y), bf2f(u.z), bf2f(u.w)); }
__device__ __forceinline__ void st_bf4(bf16_t* p, float4 v) { ushort4 o; o.x = f2bf(v.x); o.y = f2bf(v.y); o.z = f2bf(v.z); o.w = f2bf(v.w); *(ushort4*)p = o; }

__device__ __forceinline__ int proj_src_col(int cd) {
    if (cd < 1536) return cd;
    if (cd < 2048) return 1568 + (cd - 1536);
    if (cd < 2176) return 2080 + (cd - 2048);
    if (cd < 2304) return 2208 + (cd - 2176);
    if (cd < 2336) return 1536 + (cd - 2304);
    return -1;
}
__global__ void __launch_bounds__(256) k_gemm_inproj(const bf16_t* __restrict__ U, const float* __restrict__ w_in, bf16_t* __restrict__ PROJ) {
    const int r0 = blockIdx.y * 64, c0 = blockIdx.x * 64;
    auto fa = [&](int r, int k) { return ld_bf4(U + (size_t)(r0 + r) * D + k); };
    auto fb = [&](int k, int c) { const int cs = proj_src_col(c0 + c); return cs < 0 ? make_float4(0.f, 0.f, 0.f, 0.f) : *(const float4*)(w_in + (size_t)k * DIN + cs); };
    auto fe = [&](int r, int c, float4 a, float4) { st_bf4(PROJ + (size_t)(r0 + r) * PW + c0 + c, a); };
    naive_tile<false>(D, fa, fb, fb, fe);
}
__global__ void __launch_bounds__(256) k_gemm_outproj(const bf16_t* __restrict__ MIXED, const float* __restrict__ w_out, const float* __restrict__ x, float* __restrict__ H) {
    const int r0 = blockIdx.y * 64, c0 = blockIdx.x * 64;
    auto fa = [&](int r, int k) { return ld_bf4(MIXED + (size_t)(r0 + r) * D + k); };
    auto fb = [&](int k, int c) { return *(const float4*)(w_out + (size_t)k * D + c0 + c); };
    auto fe = [&](int r, int c, float4 a, float4) { const size_t o = (size_t)(r0 + r) * D + c0 + c; const float4 xv = *(const float4*)(x + o); *(float4*)(H + o) = make_float4(xv.x + a.x, xv.y + a.y, xv.z + a.z, xv.w + a.w); };
    naive_tile<false>(D, fa, fb, fb, fe);
}

__global__ void __launch_bounds__(256) k_la(const bf16_t* __restrict__ PROJ, const float* __restrict__ upf, const float* __restrict__ bf, const float* __restrict__ upb, const float* __restrict__ bb,
                                            float* __restrict__ LAF, float* __restrict__ LAB) {
    const int c = threadIdx.x, t = blockIdx.x, dir = blockIdx.y;
    const bf16_t* z = PROJ + (size_t)t * PW + (dir ? C_ZB : C_ZF);
    const float* up = dir ? upb : upf; const float* bias = dir ? bb : bf;
    float pre = bias[c];
#pragma unroll
    for (int r = 0; r < 16; ++r) pre += bf2f(z[r]) * up[r * 256 + c];
    const float ls = fminf(pre, 0.f) - log1pf(expf(-fabsf(pre)));
    (dir ? LAB : LAF)[(size_t)t * 256 + c] = ls * (1.f / 16.f);
}
__global__ void __launch_bounds__(512) k_gla_scan(const bf16_t* __restrict__ PROJ, const float* __restrict__ LAF, const float* __restrict__ LAB, float* __restrict__ OF, float* __restrict__ OB) {
    const int bid = blockIdx.x, es = bid & 3, dir = (bid >> 2) & 1, h = (bid >> 3) & 3, b = bid >> 5;
    const int tid = threadIdx.x, dg = tid & 15, el = tid >> 4, e = es * 32 + el;
    const float* LA = dir ? LAB : LAF; float* O = dir ? OB : OF;
    float S0 = 0.f, S1 = 0.f, S2 = 0.f, S3 = 0.f;
#pragma unroll 4
    for (int step = 0; step < T; ++step) {
        const int t = dir ? (T - 1 - step) : step;
        const size_t row = (size_t)b * T + t;
        const bf16_t* pr = PROJ + row * PW;
        const float4 la = *(const float4*)(LA + row * 256 + h * 64 + dg * 4);
        const float4 q = ld_bf4(pr + C_GQ + h * 64 + dg * 4);
        const float4 k = ld_bf4(pr + C_GK + h * 64 + dg * 4);
        const float v = bf2f(pr[C_GV + h * 128 + e]);
        S0 = expf(la.x) * S0 + k.x * v; S1 = expf(la.y) * S1 + k.y * v; S2 = expf(la.z) * S2 + k.z * v; S3 = expf(la.w) * S3 + k.w * v;
        float part = (q.x * S0 + q.y * S1 + q.z * S2 + q.w * S3) * 0.125f;
        part += __shfl_xor(part, 1); part += __shfl_xor(part, 2); part += __shfl_xor(part, 4); part += __shfl_xor(part, 8);
        if (dg == 0) O[row * 512 + h * 128 + e] = part;
    }
}
__global__ void __launch_bounds__(256) k_gla_combine(const float* __restrict__ OF, const float* __restrict__ OB, const bf16_t* __restrict__ PROJ, const float* __restrict__ gain, bf16_t* __restrict__ MIXED) {
    const int lane = threadIdx.x & 63, w = blockIdx.x * 4 + (threadIdx.x >> 6), t = w >> 2, h = w & 3;
    const size_t o = (size_t)t * 512 + h * 128 + lane * 2;
    const float2 a = *(const float2*)(OF + o), bq = *(const float2*)(OB + o);
    const float v0 = a.x + bq.x, v1 = a.y + bq.y;
    const float ss = wave_sum(v0 * v0 + v1 * v1);
    const float rstd = rsqrtf(ss * (1.f / 128.f) + EPS);
    const bf16_t* g = PROJ + (size_t)t * PW + C_GG + h * 128 + lane * 2;
    const float g0 = bf2f(g[0]), g1 = bf2f(g[1]);
    bf16_t* m = MIXED + (size_t)t * D + h * 128 + lane * 2;
    m[0] = f2bf(v0 * rstd * gain[lane * 2] * silu_f(g0)); m[1] = f2bf(v1 * rstd * gain[lane * 2 + 1] * silu_f(g1));
}

__global__ void __launch_bounds__(256) k_qk_prep(bf16_t* __restrict__ PROJ, const float* __restrict__ qg, const float* __restrict__ kg, const float* __restrict__ rope) {
    const int lane = threadIdx.x & 63, w = blockIdx.x * 4 + (threadIdx.x >> 6);
    const int t = w / 10, hs = w % 10;
    const bool isq = hs < 8;
    bf16_t* p = PROJ + (size_t)t * PW + (isq ? C_AQ + hs * 64 : C_AK + (hs - 8) * 64) + lane;
    const float v = bf2f(*p);
    const float ss = wave_sum(v * v);
    const float y = v * rsqrtf(ss * (1.f / 64.f) + EPS) * (isq ? qg[lane] : kg[lane]);
    const float partner = __shfl_xor(y, 1);
    const int pi = lane >> 1, tt = t & (T - 1);
    const int pos = pi < 16 ? (tt >> 6) : (tt & 63), j = pi & 15;
    const float c = rope[pos * 16 + j], s = rope[1024 + pos * 16 + j];
    float o = (lane & 1) ? (partner * s + y * c) : (y * c - partner * s);
    if (isq) o *= 0.125f;
    *p = f2bf(o);
}
__global__ void __launch_bounds__(256) k_attn(const bf16_t* __restrict__ PROJ, float* __restrict__ ATT) {
    __shared__ float Qt[64][68];
    __shared__ float KV[64][68];
    __shared__ float St[64][68];
    __shared__ float al[64];
    const int tid = threadIdx.x, tx = tid & 15, ty = tid >> 4;
    const int q0 = blockIdx.x * 64, hq = blockIdx.y, b = blockIdx.z, kvh = hq >> 2;
    const size_t rowb = (size_t)b * T;
    { const int r = tid >> 2, d0 = (tid & 3) * 16; const bf16_t* p = PROJ + (rowb + q0 + r) * PW + C_AQ + hq * 64 + d0;
#pragma unroll
      for (int i = 0; i < 16; ++i) Qt[d0 + i][r] = bf2f(p[i]); }
    float O[4][4];
#pragma unroll
    for (int i = 0; i < 4; ++i)
#pragma unroll
        for (int j = 0; j < 4; ++j) O[i][j] = 0.f;
    float m_run = -INFINITY, l_run = 0.f;
    for (int k0 = 0; k0 < T; k0 += 64) {
        { const int c = tid >> 2, d0 = (tid & 3) * 16; const bf16_t* p = PROJ + (rowb + k0 + c) * PW + C_AK + kvh * 64 + d0;
#pragma unroll
          for (int i = 0; i < 16; ++i) KV[d0 + i][c] = bf2f(p[i]); }
        __syncthreads();
        float s[4][4];
#pragma unroll
        for (int i = 0; i < 4; ++i)
#pragma unroll
            for (int j = 0; j < 4; ++j) s[i][j] = 0.f;
#pragma unroll 8
        for (int d = 0; d < 64; ++d) {
            const float4 a = *(const float4*)&Qt[d][ty * 4]; const float4 bq = *(const float4*)&KV[d][tx * 4];
            const float av[4] = {a.x, a.y, a.z, a.w}; const float bv[4] = {bq.x, bq.y, bq.z, bq.w};
#pragma unroll
            for (int i = 0; i < 4; ++i)
#pragma unroll
                for (int j = 0; j < 4; ++j) s[i][j] += av[i] * bv[j];
        }
#pragma unroll
        for (int i = 0; i < 4; ++i)
#pragma unroll
            for (int j = 0; j < 4; ++j) St[tx * 4 + j][ty * 4 + i] = s[i][j];
        __syncthreads();
        { const int c = tid >> 2, e0 = (tid & 3) * 16; const bf16_t* p = PROJ + (rowb + k0 + c) * PW + C_AV + kvh * 64 + e0;
#pragma unroll
          for (int i = 0; i < 16; ++i) KV[c][e0 + i] = bf2f(p[i]); }
        if (tid < 64) {
            float mx = -INFINITY;
            for (int c = 0; c < 64; ++c) mx = fmaxf(mx, St[c][tid]);
            const float mn = fmaxf(m_run, mx);
            const float alpha = expf(m_run - mn);
            float sum = 0.f;
            for (int c = 0; c < 64; ++c) { const float p = expf(St[c][tid] - mn); St[c][tid] = p; sum += p; }
            l_run = l_run * alpha + sum; m_run = mn; al[tid] = alpha;
        }
        __syncthreads();
#pragma unroll
        for (int i = 0; i < 4; ++i) { const float a = al[ty * 4 + i];
#pragma unroll
            for (int j = 0; j < 4; ++j) O[i][j] *= a; }
#pragma unroll 8
        for (int c = 0; c < 64; ++c) {
            const float4 a = *(const float4*)&St[c][ty * 4]; const float4 bq = *(const float4*)&KV[c][tx * 4];
            const float av[4] = {a.x, a.y, a.z, a.w}; const float bv[4] = {bq.x, bq.y, bq.z, bq.w};
#pragma unroll
            for (int i = 0; i < 4; ++i)
#pragma unroll
                for (int j = 0; j < 4; ++j) O[i][j] += av[i] * bv[j];
        }
        __syncthreads();
    }
    if (tid < 64) al[tid] = 1.f / l_run;
    __syncthreads();
#pragma unroll
    for (int i = 0; i < 4; ++i) { const float a = al[ty * 4 + i];
        *(float4*)(ATT + (rowb + q0 + ty * 4 + i) * 512 + hq * 64 + tx * 4) = make_float4(O[i][0] * a, O[i][1] * a, O[i][2] * a, O[i][3] * a); }
}
__global__ void __launch_bounds__(256) k_att_norm(const float* __restrict__ ATT, const float* __restrict__ gain, bf16_t* __restrict__ MIXED) {
    const int lane = threadIdx.x & 63, t = blockIdx.x * 4 + (threadIdx.x >> 6);
    const float4* a = (const float4*)(ATT + (size_t)t * 512);
    const float4 v0 = a[lane], v1 = a[64 + lane];
    const float ss = wave_sum(v0.x * v0.x + v0.y * v0.y + v0.z * v0.z + v0.w * v0.w + v1.x * v1.x + v1.y * v1.y + v1.z * v1.z + v1.w * v1.w);
    const float rstd = rsqrtf(ss * (1.f / 512.f) + EPS);
    const float4 g0 = ((const float4*)gain)[lane], g1 = ((const float4*)gain)[64 + lane];
    bf16_t* m = MIXED + (size_t)t * D + 512;
    st_bf4(m + lane * 4, make_float4(v0.x * rstd * g0.x, v0.y * rstd * g0.y, v0.z * rstd * g0.z, v0.w * rstd * g0.w));
    st_bf4(m + 256 + lane * 4, make_float4(v1.x * rstd * g1.x, v1.y * rstd * g1.y, v1.z * rstd * g1.z, v1.w * rstd * g1.w));
}

__global__ void __launch_bounds__(256) k_router(const float* __restrict__ H, const float* __restrict__ g2, const float* __restrict__ wg, const float* __restrict__ bg, const float* __restrict__ we, const float* __restrict__ be,
                                                bf16_t* __restrict__ XN2, unsigned* __restrict__ tokinfo, unsigned* __restrict__ ctl) {
    const int lane = threadIdx.x & 63, t = blockIdx.x * 4 + (threadIdx.x >> 6);
    const float4* hr = (const float4*)(H + (size_t)t * D);
    float xn[16]; float ss = 0.f;
#pragma unroll
    for (int j = 0; j < 4; ++j) { const float4 v = hr[j * 64 + lane]; xn[j * 4] = v.x; xn[j * 4 + 1] = v.y; xn[j * 4 + 2] = v.z; xn[j * 4 + 3] = v.w; ss += v.x * v.x + v.y * v.y + v.z * v.z + v.w * v.w; }
    ss = wave_sum(ss);
    const float rstd = rsqrtf(ss * (1.f / D) + EPS);
#pragma unroll
    for (int j = 0; j < 4; ++j) { const float4 gg = ((const float4*)g2)[j * 64 + lane];
        xn[j * 4] *= rstd * gg.x; xn[j * 4 + 1] *= rstd * gg.y; xn[j * 4 + 2] *= rstd * gg.z; xn[j * 4 + 3] *= rstd * gg.w;
        st_bf4(XN2 + (size_t)t * D + (j * 64 + lane) * 4, make_float4(xn[j * 4], xn[j * 4 + 1], xn[j * 4 + 2], xn[j * 4 + 3])); }
    float gl[8], el[64];
#pragma unroll
    for (int i = 0; i < 8; ++i) gl[i] = 0.f;
#pragma unroll
    for (int i = 0; i < 64; ++i) el[i] = 0.f;
#pragma unroll
    for (int j = 0; j < 4; ++j)
#pragma unroll
        for (int i = 0; i < 4; ++i) {
            const int k = (j * 64 + lane) * 4 + i; const float xv = xn[j * 4 + i];
            const float4* pg = (const float4*)(wg + (size_t)k * 8);
#pragma unroll
            for (int q = 0; q < 2; ++q) { const float4 w = pg[q]; gl[q * 4] += xv * w.x; gl[q * 4 + 1] += xv * w.y; gl[q * 4 + 2] += xv * w.z; gl[q * 4 + 3] += xv * w.w; }
            const float4* pe = (const float4*)(we + (size_t)k * 64);
#pragma unroll
            for (int q = 0; q < 16; ++q) { const float4 w = pe[q]; el[q * 4] += xv * w.x; el[q * 4 + 1] += xv * w.y; el[q * 4 + 2] += xv * w.z; el[q * 4 + 3] += xv * w.w; }
        }
#pragma unroll
    for (int i = 0; i < 8; ++i) gl[i] = wave_sum(gl[i]) + bg[i];
#pragma unroll
    for (int i = 0; i < 64; ++i) el[i] = wave_sum(el[i]) + be[i];
    float best = gl[0]; int g = 0;
#pragma unroll
    for (int i = 1; i < 8; ++i) if (gl[i] > best) { best = gl[i]; g = i; }
    float den = 0.f;
#pragma unroll
    for (int i = 0; i < 8; ++i) den += expf(gl[i] - best);
    const float gw = 1.f / den;
    float ev[8];
#pragma unroll
    for (int j = 0; j < 8; ++j) { float v = el[j];
#pragma unroll
        for (int q = 1; q < 8; ++q) v = (g == q) ? el[q * 8 + j] : v;
        ev[j] = v; }
    float v1 = ev[0]; int i1 = 0;
#pragma unroll
    for (int j = 1; j < 8; ++j) if (ev[j] > v1) { v1 = ev[j]; i1 = j; }
    float v2 = -INFINITY; int i2 = 0;
#pragma unroll
    for (int j = 0; j < 8; ++j) if (j != i1 && ev[j] > v2) { v2 = ev[j]; i2 = j; }
    const float ex = expf(v2 - v1), p1 = 1.f / (1.f + ex), p2 = ex * p1;
    if (lane == 0) {
        const int e1 = g * 8 + i1, e2 = g * 8 + i2;
        uint4 o; o.x = (unsigned)e1; o.y = (unsigned)e2; o.z = __float_as_uint(gw * p1); o.w = __float_as_uint(gw * p2);
        ((uint4*)tokinfo)[t] = o;
        atomicAdd(&ctl[CW_COUNTS + e1], 1u); atomicAdd(&ctl[CW_COUNTS + e2], 1u);
    }
}
__global__ void k_offsets(unsigned* __restrict__ ctl) {
    if (threadIdx.x == 0) {
        unsigned off = 0, nt = 0;
        for (int e = 0; e < NEXP; ++e) {
            const unsigned c = ctl[CW_COUNTS + e]; ctl[CW_OFFS + e] = off;
            for (unsigned r = 0; r < c; r += 64) { ctl[CW_TILE_E + nt] = (unsigned)e; ctl[CW_TILE_R0 + nt] = off + r; ctl[CW_TILE_NR + nt] = (c - r) < 64u ? (c - r) : 64u; ++nt; }
            off += c;
        }
        ctl[CW_OFFS + NEXP] = off; ctl[CW_NTILES] = nt;
    }
}
__global__ void __launch_bounds__(256) k_scatter(const unsigned* __restrict__ tokinfo, unsigned* __restrict__ ctl, int* __restrict__ tokslot, int* __restrict__ slottok, float* __restrict__ slotgate) {
    const int t = blockIdx.x * 256 + threadIdx.x;
    const uint4 ti = ((const uint4*)tokinfo)[t];
    const unsigned p0 = ctl[CW_OFFS + ti.x] + atomicAdd(&ctl[CW_CURSOR + ti.x], 1u);
    const unsigned p1 = ctl[CW_OFFS + ti.y] + atomicAdd(&ctl[CW_CURSOR + ti.y], 1u);
    slottok[p0] = t; slottok[p1] = t; slotgate[p0] = __uint_as_float(ti.z); slotgate[p1] = __uint_as_float(ti.w);
    tokslot[2 * t] = (int)p0; tokslot[2 * t + 1] = (int)p1;
}
__global__ void __launch_bounds__(256) k_moe1(const bf16_t* __restrict__ XN2, const float* __restrict__ w_gate, const float* __restrict__ w_up, const unsigned* __restrict__ ctl, const int* __restrict__ slottok, bf16_t* __restrict__ HMID) {
    const unsigned tile = blockIdx.x; if (tile >= ctl[CW_NTILES]) return;
    const int e = (int)ctl[CW_TILE_E + tile], row0 = (int)ctl[CW_TILE_R0 + tile], nr = (int)ctl[CW_TILE_NR + tile], c0 = blockIdx.y * 64;
    const float* wgp = w_gate + (size_t)e * D * DEXP; const float* wup = w_up + (size_t)e * D * DEXP;
    auto fa = [&](int r, int k) { if (r >= nr) return make_float4(0.f, 0.f, 0.f, 0.f); const int tok = slottok[row0 + r]; return ld_bf4(XN2 + (size_t)tok * D + k); };
    auto fb = [&](int k, int c) { return *(const float4*)(wgp + (size_t)k * DEXP + c0 + c); };
    auto fb2 = [&](int k, int c) { return *(const float4*)(wup + (size_t)k * DEXP + c0 + c); };
    auto fe = [&](int r, int c, float4 a, float4 u) { if (r >= nr) return; st_bf4(HMID + (size_t)(row0 + r) * DEXP + c0 + c, make_float4(silu_f(a.x) * u.x, silu_f(a.y) * u.y, silu_f(a.z) * u.z, silu_f(a.w) * u.w)); };
    naive_tile<true>(D, fa, fb, fb2, fe);
}
__global__ void __launch_bounds__(256) k_moe2(const bf16_t* __restrict__ HMID, const float* __restrict__ w_down, const unsigned* __restrict__ ctl, const float* __restrict__ slotgate, bf16_t* __restrict__ YS) {
    const unsigned tile = blockIdx.x; if (tile >= ctl[CW_NTILES]) return;
    const int e = (int)ctl[CW_TILE_E + tile], row0 = (int)ctl[CW_TILE_R0 + tile], nr = (int)ctl[CW_TILE_NR + tile], c0 = blockIdx.y * 64;
    const float* wd = w_down + (size_t)e * DEXP * D;
    auto fa = [&](int r, int k) { if (r >= nr) return make_float4(0.f, 0.f, 0.f, 0.f); return ld_bf4(HMID + (size_t)(row0 + r) * DEXP + k); };
    auto fb = [&](int k, int c) { return *(const float4*)(wd + (size_t)k * D + c0 + c); };
    auto fe = [&](int r, int c, float4 a, float4) { if (r >= nr) return; const float g = slotgate[row0 + r]; st_bf4(YS + (size_t)(row0 + r) * D + c0 + c, make_float4(a.x * g, a.y * g, a.z * g, a.w * g)); };
    naive_tile<false>(DEXP, fa, fb, fb, fe);
}
__global__ void __launch_bounds__(256) k_final(float* __restrict__ H, const bf16_t* __restrict__ YS, const int* __restrict__ tokslot, const float* __restrict__ fg) {
    const int lane = threadIdx.x & 63, t = blockIdx.x * 4 + (threadIdx.x >> 6);
    const int s0 = tokslot[2 * t], s1 = tokslot[2 * t + 1];
    float4* hr = (float4*)(H + (size_t)t * D);
    float4 v[4]; float ss = 0.f;
#pragma unroll
    for (int j = 0; j < 4; ++j) {
        const float4 hv = hr[j * 64 + lane]; const float4 a = ld_bf4(YS + (size_t)s0 * D + (j * 64 + lane) * 4), bq = ld_bf4(YS + (size_t)s1 * D + (j * 64 + lane) * 4);
        v[j] = make_float4(hv.x + a.x + bq.x, hv.y + a.y + bq.y, hv.z + a.z + bq.z, hv.w + a.w + bq.w);
        ss += v[j].x * v[j].x + v[j].y * v[j].y + v[j].z * v[j].z + v[j].w * v[j].w;
    }
    ss = wave_sum(ss);
    const float rstd = rsqrtf(ss * (1.f / D) + EPS);
#pragma unroll
    for (int j = 0; j < 4; ++j) { const float4 g = ((const float4*)fg)[j * 64 + lane]; hr[j * 64 + lane] = make_float4(v[j].x * rstd * g.x, v[j].y * rstd * g.y, v[j].z * rstd * g.z, v[j].w * rstd * g.w); }
}

extern "C" void kernel_launch(void* const* d_in, const int* in_sizes, int n_in, void* d_out, int out_size, void* d_ws, size_t ws_size, hipStream_t stream) {
    const float* x = (const float*)d_in[0]; const float* norm1_gain = (const float*)d_in[1]; const float* w_in = (const float*)d_in[2];
    const float* up_f = (const float*)d_in[3]; const float* up_f_b = (const float*)d_in[4]; const float* up_b = (const float*)d_in[5]; const float* up_b_b = (const float*)d_in[6];
    const float* gla_out_gain = (const float*)d_in[7]; const float* q_gain = (const float*)d_in[8]; const float* k_gain = (const float*)d_in[9]; const float* att_out_gain = (const float*)d_in[10];
    const float* w_out = (const float*)d_in[11]; const float* norm2_gain = (const float*)d_in[12]; const float* w_group = (const float*)d_in[13]; const float* b_group = (const float*)d_in[14];
    const float* w_expert = (const float*)d_in[15]; const float* b_expert = (const float*)d_in[16]; const float* w_gate = (const float*)d_in[17]; const float* w_up = (const float*)d_in[18];
    const float* w_down = (const float*)d_in[19]; const float* final_gain = (const float*)d_in[20];
    char* ws = (char*)d_ws; float* out = (float*)d_out;
    unsigned* ctl = (unsigned*)(ws + WS_CTL); unsigned* tokinfo = (unsigned*)(ws + WS_TOKINFO); int* tokslot = (int*)(ws + WS_TOKSLOT); int* slottok = (int*)(ws + WS_SLOTTOK);
    float* slotgate = (float*)(ws + WS_SLOTGATE); float* rope = (float*)(ws + WS_ROPE);
    float* LAF = (float*)(ws + WS_LAF); float* LAB = (float*)(ws + WS_LAB); float* OF = (float*)(ws + WS_OF); float* OB = (float*)(ws + WS_OB);
    bf16_t* U = (bf16_t*)(ws + WS_U); bf16_t* PROJ = (bf16_t*)(ws + WS_PROJ); float* ATT = (float*)(ws + WS_G); bf16_t* HMID = (bf16_t*)(ws + WS_G); bf16_t* YS = (bf16_t*)(ws + WS_PROJ);

    hipMemsetAsync(ws + WS_CTL, 0, 1 * MiB, stream);
    k_prep_x<<<NTOK / 4, 256, 0, stream>>>(x, norm1_gain, U);
    k_rope_table<<<4, 256, 0, stream>>>(rope);
    k_gemm_inproj<<<dim3(PW / 64, NTOK / 64), 256, 0, stream>>>(U, w_in, PROJ);
    k_la<<<dim3(NTOK, 2), 256, 0, stream>>>(PROJ, up_f, up_f_b, up_b, up_b_b, LAF, LAB);
    k_gla_scan<<<256, 512, 0, stream>>>(PROJ, LAF, LAB, OF, OB);
    k_gla_combine<<<NTOK, 256, 0, stream>>>(OF, OB, PROJ, gla_out_gain, U);
    k_qk_prep<<<NTOK * 10 / 4, 256, 0, stream>>>(PROJ, q_gain, k_gain, rope);
    k_attn<<<dim3(T / 64, 8, NB), 256, 0, stream>>>(PROJ, ATT);
    k_att_norm<<<NTOK / 4, 256, 0, stream>>>(ATT, att_out_gain, U);
    k_gemm_outproj<<<dim3(D / 64, NTOK / 64), 256, 0, stream>>>(U, w_out, x, out);
    k_router<<<NTOK / 4, 256, 0, stream>>>(out, norm2_gain, w_group, b_group, w_expert, b_expert, U, tokinfo, ctl);
    k_offsets<<<1, 64, 0, stream>>>(ctl);
    k_scatter<<<NTOK / 256, 256, 0, stream>>>(tokinfo, ctl, tokslot, slottok, slotgate);
    k_moe1<<<dim3(NSLOT / 64 + NEXP, DEXP / 64), 256, 0, stream>>>(U, w_gate, w_up, ctl, slottok, HMID);
    k_moe2<<<dim3(NSLOT / 64 + NEXP, D / 64), 256, 0, stream>>>(HMID, w_down, ctl, slotgate, YS);
    k_final<<<NTOK / 4, 256, 0, stream>>>(out, YS, tokslot, final_gain);
}
```

```cpp
#include <hip/hip_runtime.h>
#include <stdint.h>
#include <math.h>

constexpr int NB = 8, T = 4096, D = 1024, NTOK = NB * T;
constexpr int DIN = 2336;
constexpr int PW = 2560;
constexpr int C_GQ = 0, C_GK = 256, C_GV = 512, C_GG = 1024, C_AQ = 1536, C_AK = 2048, C_AV = 2176, C_ZF = 2304, C_ZB = 2320;
constexpr int NEXP = 64, DEXP = 512, NSLOT = 2 * NTOK;
constexpr float EPS = 1e-6f;

typedef unsigned short bf16_t;

constexpr size_t MiB = 1u << 20;
constexpr size_t WS_CTL = 0;
constexpr size_t WS_TOKINFO = 1 * MiB;
constexpr size_t WS_TOKSLOT = 1 * MiB + 512 * 1024;
constexpr size_t WS_SLOTTOK = 2 * MiB;
constexpr size_t WS_SLOTGATE = 2 * MiB + 256 * 1024;
constexpr size_t WS_ROPE = 3 * MiB;
constexpr size_t WS_LAF = 16 * MiB;
constexpr size_t WS_LAB = 48 * MiB;
constexpr size_t WS_OF = 80 * MiB;
constexpr size_t WS_OB = 144 * MiB;
constexpr size_t WS_U = 208 * MiB;
constexpr size_t WS_PROJ = 272 * MiB;
constexpr size_t WS_G = 432 * MiB;
constexpr int CW_COUNTS = 0, CW_CURSOR = 64, CW_OFFS = 128, CW_NTILES = 256, CW_TILE_E = 1024, CW_TILE_R0 = 4096, CW_TILE_NR = 8192;

__device__ __forceinline__ float bf2f(bf16_t v) { return __uint_as_float(((unsigned)v) << 16); }
__device__ __forceinline__ bf16_t f2bf(float f) { unsigned u = __float_as_uint(f); return (bf16_t)((u + 0x7fffu + ((u >> 16) & 1u)) >> 16); }
__device__ __forceinline__ float wave_sum(float v) {
#pragma unroll
    for (int o = 1; o < 64; o <<= 1) v += __shfl_xor(v, o);
    return v;
}
__device__ __forceinline__ float silu_f(float x) { return x / (1.f + expf(-x)); }


__device__ __forceinline__ float4 ld_bf4(const bf16_t* p) { const ushort4 u = *(const ushort4*)p; return make_float4(bf2f(u.x), bf2f(u.y), bf2f(u.z), bf2f(u.w)); }
__device__ __forceinline__ void st_bf4(bf16_t* p, float4 v) { ushort4 o; o.x = f2bf(v.x); o.y = f2bf(v.y); o.z = f2bf(v.z); o.w = f2bf(v.w); *(ushort4*)p = o; }
__host__ __device__ __forceinline__ int proj_src_col(int cd) {
    if (cd < 1536) return cd;
    if (cd < 2048) return 1568 + (cd - 1536);
    if (cd < 2176) return 2080 + (cd - 2048);
    if (cd < 2304) return 2208 + (cd - 2176);
    if (cd < 2336) return 1536 + (cd - 2304);
    return -1;
}
#include <cstdio>
namespace pg8 {
#define PG8_LAS __attribute__((address_space(3)))
typedef unsigned short bf16_t;
typedef short bf16x8 __attribute__((ext_vector_type(8)));
typedef float f32x4 __attribute__((ext_vector_type(4)));
typedef unsigned u32x4 __attribute__((ext_vector_type(4)));
constexpr int BM = 256, BK = 64, HALF = 128, HTB = HALF * BK * 2  , STAGE_BYTES = 8 * HTB, NXCD = 8, WGM = 4;

__host__ __device__ __forceinline__ int lds_byte(int r, int c) { const int st = (r >> 4) * 2 + (c >> 5), rr = r & 15, cc = c & 31, ob = rr * 64 + cc * 2; return st * 1024 + (ob ^ (((ob >> 9) & 1) << 5)); }
__host__ __device__ __forceinline__ void stage_rc(int b, int& R, int& C) { const int st = b / 1024, sb = b % 1024, swz = sb ^ (((sb >> 9) & 1) << 5); R = (st >> 1) * 16 + swz / 64; C = (st & 1) * 32 + (swz % 64) / 2; }
__host__ __device__ __forceinline__ int perm32(int rho) { const int n = rho >> 4, i = rho & 15; return 8 * (i >> 2) + 4 * n + (i & 3); }

typedef int i32x4 __attribute__((ext_vector_type(4)));
struct Unit { int pm, pn, row0, nr, e; unsigned rdy; };
struct Gemm { const bf16_t* A; const bf16_t* Bt; int M, N, K; };

struct StaticOrder {
    int nM, nN, nwg, G, c;
    __host__ __device__ void init(int M, int N, int G_, int c_) { nM = M / BM; nN = N / BM; nwg = nM * nN; G = G_; c = c_; }
    __host__ __device__ bool next(int i, Unit& u) const {
        const long L = (long)i * G + c; if (L >= nwg) return false;
        int wgid = (int)L; { const int q = nwg / NXCD, r = nwg % NXCD, xcd = wgid % NXCD, off = wgid / NXCD; wgid = (xcd < r ? xcd * (q + 1) : r * (q + 1) + (xcd - r) * q) + off; }
        const int nig = WGM * nN, gid = wgid / nig, fm = gid * WGM, gsz = (nM - fm) < WGM ? (nM - fm) : WGM;
        u.pm = fm + ((wgid % nig) % gsz); u.pn = (wgid % nig) / gsz; return true;
    }
    __device__ __forceinline__ size_t a_off(const Unit& u, size_t tstep) const { return (size_t)u.pm * tstep; }
    __device__ __forceinline__ size_t b_off(const Unit& u, size_t tstep) const { return (size_t)u.pn * tstep; }
    __device__ __forceinline__ void a_ready(const Unit&) const {}
    __device__ __forceinline__ void done(const Unit&) const {}
};

__device__ __forceinline__ unsigned cvt_pk_bf16(float lo, float hi) { unsigned r; asm volatile("v_cvt_pk_bf16_f32 %0, %1, %2" : "=v"(r) : "v"(lo), "v"(hi)); return r; }
typedef float f32x2 __attribute__((ext_vector_type(2)));
__device__ __forceinline__ f32x2 gelu_pk(f32x2 v) {
    const f32x2 av = __builtin_elementwise_abs(v), d = av * 0.2316418882f + 1.0f;
    f32x2 t; t.x = __builtin_amdgcn_rcpf(d.x); t.y = __builtin_amdgcn_rcpf(d.y);
    f32x2 q = t * 0.5307027145f + (-0.7265760135f); q = q * t + 0.7107068705f; q = q * t + (-0.142248368f); q = q * t + 0.127414796f; q = q * t;
    const f32x2 s = (v * v) * (-0.72134752044f);
    f32x2 e; e.x = __builtin_amdgcn_exp2f(s.x); e.y = __builtin_amdgcn_exp2f(s.y);
    const f32x2 m = v * (q * e), r = v - m;
    f32x2 o; o.x = v.x < 0.f ? m.x : r.x; o.y = v.y < 0.f ? m.y : r.y; return o;
}

template <int ACT  > struct EpiBf16 {
    static constexpr bool PERM = true, AFTER_DRAIN = false; static_assert(ACT == 0 || ACT == 1, "EpiBf16: ACT is 0 (none) or 1 (gelu_pk)");
    bf16_t* O; int ldc; const float* bias; int split_cols; size_t split_stride; float scale0;
    __device__ __forceinline__ void operator()(const f32x4 (&acc)[2][2][4][2], const Unit& u, int wr, int wc, int fr, int fq) const {
        const int row0 = u.pm * BM + wr * 64 + fr; int colt = u.pn * BM; bf16_t* base = O;
        float sc = 1.f; if (split_cols) { const int t = colt / split_cols; base += (size_t)t * split_stride; colt -= t * split_cols; if (t == 0) sc = scale0; }
        const int col0 = colt + wc * 32 + 8 * fq, bcol0 = u.pn * BM + wc * 32 + 8 * fq;
        f32x4 bv[2][2];
#pragma unroll
        for (int bj = 0; bj < 2; ++bj)
#pragma unroll
            for (int n = 0; n < 2; ++n) bv[bj][n] = bias ? *(const f32x4*)(bias + bcol0 + bj * HALF + 4 * n) : (f32x4){0.f, 0.f, 0.f, 0.f};
#pragma unroll
        for (int ai = 0; ai < 2; ++ai)
#pragma unroll
            for (int m = 0; m < 4; ++m) { bf16_t* rowp = base + (size_t)(row0 + ai * HALF + m * 16) * ldc + col0;
#pragma unroll
                for (int bj = 0; bj < 2; ++bj) { f32x4 v0 = acc[ai][bj][m][0] + bv[bj][0], v1 = acc[ai][bj][m][1] + bv[bj][1];
                    if (ACT == 1) { f32x2 a = gelu_pk((f32x2){v0[0], v0[1]}), b = gelu_pk((f32x2){v0[2], v0[3]}), c = gelu_pk((f32x2){v1[0], v1[1]}), d = gelu_pk((f32x2){v1[2], v1[3]});
                        v0 = (f32x4){a.x, a.y, b.x, b.y}; v1 = (f32x4){c.x, c.y, d.x, d.y}; }
                    v0 = v0 * sc; v1 = v1 * sc; u32x4 w; w.x = cvt_pk_bf16(v0[0], v0[1]); w.y = cvt_pk_bf16(v0[2], v0[3]); w.z = cvt_pk_bf16(v1[0], v1[1]); w.w = cvt_pk_bf16(v1[2], v1[3]);
                    *(u32x4*)(rowp + bj * HALF) = w; } }
    }
};
struct EpiBf16Res {
    static constexpr bool PERM = true, AFTER_DRAIN = false;
    bf16_t* O; const float* R; int ldc; const float* rs;
    __device__ __forceinline__ void operator()(const f32x4 (&acc)[2][2][4][2], const Unit& u, int wr, int wc, int fr, int fq) const {
        const int row0 = u.pm * BM + wr * 64 + fr, col0 = u.pn * BM + wc * 32 + 8 * fq;
#pragma unroll
        for (int ai = 0; ai < 2; ++ai)
#pragma unroll
            for (int m = 0; m < 4; ++m) { const int row = row0 + ai * HALF + m * 16; const size_t ro = (size_t)row * ldc + col0; const float r = rs[row];
#pragma unroll
                for (int bj = 0; bj < 2; ++bj) { const f32x4 v0 = acc[ai][bj][m][0] * r + *(const f32x4*)(R + ro + bj * HALF), v1 = acc[ai][bj][m][1] * r + *(const f32x4*)(R + ro + bj * HALF + 4);
                    u32x4 w; w.x = cvt_pk_bf16(v0[0], v0[1]); w.y = cvt_pk_bf16(v0[2], v0[3]); w.z = cvt_pk_bf16(v1[0], v1[1]); w.w = cvt_pk_bf16(v1[2], v1[3]);
                    *(u32x4*)(O + ro + bj * HALF) = w; } }
    }
};
struct GroupedOrder {
    const PG8_LAS int* te; const PG8_LAS int* tr0; const PG8_LAS int* tnr; int nunits, G, c; size_t a_pitch, b_exp;
    __device__ __forceinline__ bool next(int i, Unit& u) const {
        const int L = i * G + c; if (L >= nunits) return false;
        const int t = L >> 2; u.pm = t; u.pn = L & 3; u.e = __builtin_amdgcn_readfirstlane(te[t]); u.row0 = __builtin_amdgcn_readfirstlane(tr0[t]); u.nr = __builtin_amdgcn_readfirstlane(tnr[t]); return true;
    }
    __device__ __forceinline__ size_t a_off(const Unit& u, size_t) const { return (size_t)u.row0 * a_pitch; }
    __device__ __forceinline__ size_t b_off(const Unit& u, size_t tstep) const { return (size_t)u.e * b_exp + (size_t)u.pn * tstep; }
    __device__ __forceinline__ void a_ready(const Unit&) const {}
    __device__ __forceinline__ void done(const Unit&) const {}
};
struct GroupedOrderPub {
    const PG8_LAS int* te; const PG8_LAS int* tr0; const PG8_LAS int* tnr; int nunits, G, c; size_t a_pitch, b_exp; unsigned* cnt;
    __device__ __forceinline__ bool next(int i, Unit& u) const {
        const int L = i * G + c; if (L >= nunits) return false;
        const int t = L >> 2; u.pm = t; u.pn = L & 3; u.e = __builtin_amdgcn_readfirstlane(te[t]); u.row0 = __builtin_amdgcn_readfirstlane(tr0[t]); u.nr = __builtin_amdgcn_readfirstlane(tnr[t]); return true;
    }
    __device__ __forceinline__ size_t a_off(const Unit& u, size_t) const { return (size_t)u.row0 * a_pitch; }
    __device__ __forceinline__ size_t b_off(const Unit& u, size_t tstep) const { return (size_t)u.e * b_exp + (size_t)u.pn * tstep; }
    __device__ __forceinline__ void a_ready(const Unit&) const {}
    __device__ __forceinline__ void done(const Unit& u) const {
        asm volatile("s_waitcnt vmcnt(0)" ::: "memory");
        if ((threadIdx.x & 63) == 0) __hip_atomic_fetch_add(cnt + 16 * u.pm, 1u, __ATOMIC_RELAXED, __HIP_MEMORY_SCOPE_AGENT);
    }
};
struct GroupedOrderDep {
    const PG8_LAS int* te; const PG8_LAS int* tr0; const PG8_LAS int* tnr; int nunits, G, c; size_t b_exp; unsigned* cnt;
    __device__ __forceinline__ bool next(int i, Unit& u) const {
        const int L = i * G + (G - 1 - c); if (L >= nunits) return false;
        const int t = L >> 2; u.pm = t; u.pn = L & 3; u.e = __builtin_amdgcn_readfirstlane(te[t]); u.row0 = __builtin_amdgcn_readfirstlane(tr0[t]); u.nr = __builtin_amdgcn_readfirstlane(tnr[t]);
        u.rdy = __hip_atomic_load(cnt + 16 * t, __ATOMIC_RELAXED, __HIP_MEMORY_SCOPE_AGENT); return true;
    }
    __device__ __forceinline__ int tok(int i, int r) const { const int t = (i * G + (G - 1 - c)) >> 2; const int r0 = tr0[t], n = tnr[t]; return r0 + (r < n ? r : n - 1); }
    __device__ __forceinline__ size_t a_off(const Unit&, size_t) const { return 0; }
    __device__ __forceinline__ size_t b_off(const Unit& u, size_t tstep) const { return (size_t)u.e * b_exp + (size_t)u.pn * tstep; }
    __device__ __forceinline__ void a_ready(const Unit& u) const {
        if ((unsigned)__builtin_amdgcn_readfirstlane(u.rdy) < 32u) { unsigned spins = 0;
            while ((unsigned)__builtin_amdgcn_readfirstlane(__hip_atomic_load(cnt + 16 * u.pm, __ATOMIC_RELAXED, __HIP_MEMORY_SCOPE_AGENT)) < 32u && ++spins < (1u << 22)) __builtin_amdgcn_s_sleep(2); }
        asm volatile("" ::: "memory");
    }
    __device__ __forceinline__ void done(const Unit&) const {}
};
struct GroupedGatherOrder {
    const PG8_LAS int* te; const PG8_LAS int* tr0; const PG8_LAS int* tnr; const PG8_LAS int* rt; int nunits, G, c; size_t b_exp;
    __device__ __forceinline__ bool next(int i, Unit& u) const {
        const int L = i * G + c; if (L >= nunits) return false;
        const int t = L >> 2; u.pm = t; u.pn = L & 3; u.e = __builtin_amdgcn_readfirstlane(te[t]); u.row0 = __builtin_amdgcn_readfirstlane(tr0[t]); u.nr = __builtin_amdgcn_readfirstlane(tnr[t]); return true;
    }
    __device__ __forceinline__ int tok(int i, int r) const { return rt[i * 256 + r]; }
    __device__ __forceinline__ size_t a_off(const Unit&, size_t) const { return 0; }
    __device__ __forceinline__ size_t b_off(const Unit& u, size_t tstep) const { return (size_t)u.e * b_exp + (size_t)u.pn * tstep; }
    __device__ __forceinline__ void a_ready(const Unit&) const {}
    __device__ __forceinline__ void done(const Unit&) const {}
};
__device__ __forceinline__ float silu_fast(float x) { return x * __builtin_amdgcn_rcpf(1.f + __builtin_amdgcn_exp2f(-1.4426950408889634f * x)); }
struct EpiSwiGLU {
    static constexpr bool PERM = true, AFTER_DRAIN = false;
    bf16_t* H;
    __device__ __forceinline__ void operator()(const f32x4 (&acc)[2][2][4][2], const Unit& u, int wr, int wc, int fr, int fq) const {
        const int colh = u.pn * 128 + wc * 32 + 8 * fq;
#pragma unroll
        for (int ai = 0; ai < 2; ++ai)
#pragma unroll
            for (int m = 0; m < 4; ++m) { const int r = ai * HALF + wr * 64 + m * 16 + fr;
                if (r < u.nr) {
                    const f32x4 g0 = acc[ai][0][m][0], g1 = acc[ai][0][m][1], u0 = acc[ai][1][m][0], u1 = acc[ai][1][m][1];
                    u32x4 w; w.x = cvt_pk_bf16(silu_fast(g0[0]) * u0[0], silu_fast(g0[1]) * u0[1]); w.y = cvt_pk_bf16(silu_fast(g0[2]) * u0[2], silu_fast(g0[3]) * u0[3]);
                    w.z = cvt_pk_bf16(silu_fast(g1[0]) * u1[0], silu_fast(g1[1]) * u1[1]); w.w = cvt_pk_bf16(silu_fast(g1[2]) * u1[2], silu_fast(g1[3]) * u1[3]);
                    *(u32x4*)(H + (size_t)(u.row0 + r) * 512 + colh) = w; } }
    }
};
struct EpiBf16_I8 {
    static constexpr bool PERM = true, AFTER_DRAIN = false;
    bf16_t* O; int ldc; const float* sa; const float* sw; int nvalid;
    __device__ __forceinline__ void operator()(const f32x4 (&acc)[2][2][4][2], const Unit& u, int wr, int wc, int fr, int fq) const {
        const int row0 = u.pm * BM + wr * 64 + fr, col0 = u.pn * BM + wc * 32 + 8 * fq;
        f32x4 sv[2][2];
#pragma unroll
        for (int bj = 0; bj < 2; ++bj)
#pragma unroll
            for (int n = 0; n < 2; ++n) sv[bj][n] = *(const f32x4*)(sw + col0 + bj * HALF + 4 * n);
#pragma unroll
        for (int ai = 0; ai < 2; ++ai)
#pragma unroll
            for (int m = 0; m < 4; ++m) { const int r = row0 + ai * HALF + m * 16; const float a = sa[r]; bf16_t* rowp = O + (size_t)r * ldc + col0;
#pragma unroll
                for (int bj = 0; bj < 2; ++bj) { f32x4 v0, v1;
#pragma unroll
                    for (int j = 0; j < 4; ++j) { v0[j] = (float)__float_as_int(acc[ai][bj][m][0][j]) * (a * sv[bj][0][j]); v1[j] = (float)__float_as_int(acc[ai][bj][m][1][j]) * (a * sv[bj][1][j]); }
                    u32x4 w; w.x = cvt_pk_bf16(v0[0], v0[1]); w.y = cvt_pk_bf16(v0[2], v0[3]); w.z = cvt_pk_bf16(v1[0], v1[1]); w.w = cvt_pk_bf16(v1[2], v1[3]);
                    if (col0 + bj * HALF < nvalid) *(u32x4*)(rowp + bj * HALF) = w; } }
    }
};
template <bool WT = false> struct EpiSwiGLU_I8 {
    static constexpr bool PERM = true, AFTER_DRAIN = false;
    bf16_t* H; const float* sa; const float* sw;
    __device__ __forceinline__ void operator()(const f32x4 (&acc)[2][2][4][2], const Unit& u, int wr, int wc, int fr, int fq) const {
        const int colh = u.pn * 128 + wc * 32 + 8 * fq;
        const float* swp = sw + (size_t)u.e * 1024 + u.pn * 256 + wc * 32 + 8 * fq;
        const f32x4 sg0 = *(const f32x4*)swp, sg1 = *(const f32x4*)(swp + 4), su0 = *(const f32x4*)(swp + 128), su1 = *(const f32x4*)(swp + 132);
#pragma unroll
        for (int ai = 0; ai < 2; ++ai)
#pragma unroll
            for (int m = 0; m < 4; ++m) { const int r = ai * HALF + wr * 64 + m * 16 + fr;
                if (r < u.nr) { const float a = sa[u.row0 + r];
                    f32x4 g0, g1, u0, u1;
#pragma unroll
                    for (int j = 0; j < 4; ++j) { g0[j] = (float)__float_as_int(acc[ai][0][m][0][j]) * (a * sg0[j]); g1[j] = (float)__float_as_int(acc[ai][0][m][1][j]) * (a * sg1[j]);
                                                  u0[j] = (float)__float_as_int(acc[ai][1][m][0][j]) * (a * su0[j]); u1[j] = (float)__float_as_int(acc[ai][1][m][1][j]) * (a * su1[j]); }
                    u32x4 w; w.x = cvt_pk_bf16(silu_fast(g0[0]) * u0[0], silu_fast(g0[1]) * u0[1]); w.y = cvt_pk_bf16(silu_fast(g0[2]) * u0[2], silu_fast(g0[3]) * u0[3]);
                    w.z = cvt_pk_bf16(silu_fast(g1[0]) * u1[0], silu_fast(g1[1]) * u1[1]); w.w = cvt_pk_bf16(silu_fast(g1[2]) * u1[2], silu_fast(g1[3]) * u1[3]);
                    if (WT) asm volatile("global_store_dwordx4 %0, %1, off sc1" :: "v"(H + (size_t)(u.row0 + r) * 512 + colh), "v"(w) : "memory");
                    else *(u32x4*)(H + (size_t)(u.row0 + r) * 512 + colh) = w; } }
    }
};
struct EpiYs {
    static constexpr bool PERM = true, AFTER_DRAIN = false;
    bf16_t* Y; const float* gate;
    __device__ __forceinline__ void operator()(const f32x4 (&acc)[2][2][4][2], const Unit& u, int wr, int wc, int fr, int fq) const {
        const int col0 = u.pn * BM + wc * 32 + 8 * fq;
#pragma unroll
        for (int ai = 0; ai < 2; ++ai)
#pragma unroll
            for (int m = 0; m < 4; ++m) { const int r = ai * HALF + wr * 64 + m * 16 + fr;
                if (r < u.nr) { const float g = gate[u.row0 + r];
#pragma unroll
                    for (int bj = 0; bj < 2; ++bj) { const f32x4 v0 = acc[ai][bj][m][0] * g, v1 = acc[ai][bj][m][1] * g;
                        u32x4 w; w.x = cvt_pk_bf16(v0[0], v0[1]); w.y = cvt_pk_bf16(v0[2], v0[3]); w.z = cvt_pk_bf16(v1[0], v1[1]); w.w = cvt_pk_bf16(v1[2], v1[3]);
                        *(u32x4*)(Y + (size_t)(u.row0 + r) * 1024 + col0 + bj * HALF) = w; } } }
    }
};
struct EpiYs8 {
    static constexpr bool PERM = true, AFTER_DRAIN = false;
    unsigned char* Y; float* SC; const float* gate;
    __device__ __forceinline__ void operator()(const f32x4 (&acc)[2][2][4][2], const Unit& u, int wr, int wc, int fr, int fq) const {
        const int col0 = u.pn * BM + wc * 32 + 8 * fq;
#pragma unroll
        for (int ai = 0; ai < 2; ++ai)
#pragma unroll
            for (int m = 0; m < 4; ++m) { const int r = ai * HALF + wr * 64 + m * 16 + fr; const bool ok = r < u.nr;
                const float g = ok ? gate[u.row0 + r] : 0.f;
                f32x4 v[2][2]; float mx = 0.f;
#pragma unroll
                for (int bj = 0; bj < 2; ++bj)
#pragma unroll
                    for (int n = 0; n < 2; ++n) { v[bj][n] = acc[ai][bj][m][n] * g;
#pragma unroll
                        for (int j = 0; j < 4; ++j) mx = fmaxf(mx, fabsf(v[bj][n][j])); }
                mx = fmaxf(mx, __shfl_xor(mx, 16)); mx = fmaxf(mx, __shfl_xor(mx, 32));
                const float inv = mx > 0.f ? 127.f * __builtin_amdgcn_rcpf(mx) : 0.f;
                unsigned w[2][2];
#pragma unroll
                for (int bj = 0; bj < 2; ++bj)
#pragma unroll
                    for (int n = 0; n < 2; ++n) { const f32x4 f = v[bj][n] * inv + 128.5f;
                        w[bj][n] = (unsigned)f[0] | ((unsigned)f[1] << 8) | ((unsigned)f[2] << 16) | ((unsigned)f[3] << 24); }
                const bool odd = fq & 1;
                const unsigned s0 = odd ? w[0][0] : w[1][0], s1 = odd ? w[0][1] : w[1][1];
                const unsigned g0 = (unsigned)__shfl_xor((int)s0, 16), g1 = (unsigned)__shfl_xor((int)s1, 16);
                if (ok) {
                    const u32x4 o = odd ? (u32x4){g0, g1, w[1][0], w[1][1]} : (u32x4){w[0][0], w[0][1], g0, g1};
                    *(u32x4*)(Y + (size_t)(u.row0 + r) * 1024 + (col0 & ~15) + (odd ? HALF : 0)) = o;
                    if (fq == 0) SC[(size_t)(u.row0 + r) * 16 + wc * 4 + u.pn] = mx * (1.f / 127.f); } }
    }
};
template <class Epi, class Sched, bool ALIGN_EPI = false, bool SP2 = false, bool GATHER = false, bool I8 = false>
__device__ __forceinline__ void gemm_phase(PG8_LAS unsigned char* lds, const Gemm g, const Sched& S, const Epi& E) {
    const int tid = threadIdx.x, wid = __builtin_amdgcn_readfirstlane(tid >> 6), lane = tid & 63, wr = wid >> 2, wc = wid & 3, fr = lane & 15, fq = lane >> 4;
    const int K = g.K, KB = I8 ? K : 2 * K  , nt = KB / (BK * 2);
    unsigned voffA[2], voffB[2];
#pragma unroll
    for (int i = 0; i < 2; ++i) { int R, C; stage_rc(tid * 16 + i * 8192, R, C); const int Rb = Epi::PERM ? ((R & ~31) + perm32(R & 31)) : R;
        voffA[i] = (unsigned)(R * KB + C * 2); voffB[i] = (unsigned)(Rb * KB + C * 2); }
    unsigned cv0[2] = {0u, 0u}, cv1[2] = {0u, 0u}, nv0[2] = {0u, 0u}, nv1[2] = {0u, 0u};
    int gR[2], gC[2];
#pragma unroll
    for (int i = 0; i < 2; ++i) stage_rc(tid * 16 + i * 8192, gR[i], gC[i]);
#define PG8_GOFF(dst0, dst1, ui_) do { _Pragma("unroll") for (int _i = 0; _i < 2; ++_i) { \
        dst0[_i] = (unsigned)S.tok((ui_), gR[_i]) * (unsigned)KB + (unsigned)gC[_i] * 2u; dst1[_i] = (unsigned)S.tok((ui_), HALF + gR[_i]) * (unsigned)KB + (unsigned)gC[_i] * 2u; } } while (0)
    const size_t kstep = (size_t)(BK * 2);
    const size_t hstep = (size_t)HALF * KB;
    const size_t tstep = 2 * hstep;
    const unsigned ldsw = (unsigned)wid * 1024u;
    const int aoff = lds_byte(wr * 64 + fr, fq * 8), boff = lds_byte(wc * 32 + fr, fq * 8);
#define PG8_SA(b, h) (((b) * 2 + (h)) * HTB)
#define PG8_SB(b, h) ((4 + (b) * 2 + (h)) * HTB)
#define PG8_STAGE(bufoff, gbase, voff) do { _Pragma("unroll") for (int _i = 0; _i < 2; ++_i) \
        __builtin_amdgcn_global_load_lds((const unsigned*)((const char*)(gbase) + (voff)[_i]), (PG8_LAS unsigned*)(lds + (bufoff) + ldsw + _i * 8192), 16, 0, 0); } while (0)
#define PG8_GLDS1(gp, ldsoff) __builtin_amdgcn_global_load_lds((const unsigned*)(gp), (PG8_LAS unsigned*)(lds + (ldsoff)), 16, 0, 0)
#define PG8_STAGEA(bufoff, kptr, half, nx) do { if constexpr (GATHER) { \
        const unsigned _v0 = (half) ? ((nx) ? nv1[0] : cv1[0]) : ((nx) ? nv0[0] : cv0[0]), _v1 = (half) ? ((nx) ? nv1[1] : cv1[1]) : ((nx) ? nv0[1] : cv0[1]); \
        PG8_GLDS1((const char*)(kptr) + _v0, (bufoff) + ldsw); PG8_GLDS1((const char*)(kptr) + _v1, (bufoff) + ldsw + 8192); \
    } else { PG8_STAGE(bufoff, (kptr) + ((half) ? hstep : (size_t)0), voffA); } } while (0)
#define PG8_LDA(dst, b, h) do { _Pragma("unroll") for (int m = 0; m < 4; ++m) _Pragma("unroll") for (int k = 0; k < 2; ++k) dst[m][k] = *(const PG8_LAS bf16x8*)(lds + PG8_SA(b, h) + aoff + m * 2048 + k * 1024); } while (0)
#define PG8_LDB(dst, b, h) do { _Pragma("unroll") for (int n = 0; n < 2; ++n) _Pragma("unroll") for (int k = 0; k < 2; ++k) dst[n][k] = *(const PG8_LAS bf16x8*)(lds + PG8_SB(b, h) + boff + n * 2048 + k * 1024); } while (0)
#define PG8_MMA(ai, bj, At, Bt) do { __builtin_amdgcn_s_setprio(1); _Pragma("unroll") for (int m = 0; m < 4; ++m) _Pragma("unroll") for (int n = 0; n < 2; ++n) _Pragma("unroll") for (int k = 0; k < 2; ++k) { \
        if constexpr (I8) acc[ai][bj][m][n] = __builtin_bit_cast(f32x4, __builtin_amdgcn_mfma_i32_16x16x64_i8(__builtin_bit_cast(i32x4, Bt[n][k]), __builtin_bit_cast(i32x4, At[m][k]), __builtin_bit_cast(i32x4, acc[ai][bj][m][n]), 0, 0, 0)); \
        else acc[ai][bj][m][n] = __builtin_amdgcn_mfma_f32_16x16x32_bf16(Bt[n][k], At[m][k], acc[ai][bj][m][n], 0, 0, 0); } __builtin_amdgcn_s_setprio(0); } while (0)
#define PG8_WAIT_V(n) asm volatile("s_waitcnt vmcnt(" #n ")" ::: "memory")
#define PG8_WAIT_L(n) asm volatile("s_waitcnt lgkmcnt(" #n ")" ::: "memory")
#define PG8_BAR __builtin_amdgcn_s_barrier()
#define PG8_SCHED __builtin_amdgcn_sched_barrier(0)
    Unit cur, nxt; int ui = 0;
    if (!S.next(0, cur)) return;
    if constexpr (GATHER) { PG8_GOFF(cv0, cv1, 0); }
    f32x4 acc[2][2][4][2];
#pragma unroll
    for (int a = 0; a < 2; ++a)
#pragma unroll
        for (int b = 0; b < 2; ++b)
#pragma unroll
            for (int m = 0; m < 4; ++m)
#pragma unroll
                for (int n = 0; n < 2; ++n) acc[a][b][m][n] = (f32x4){0.f, 0.f, 0.f, 0.f};
    bf16x8 At[4][2], B0[2][2], B1[2][2];
    const char* cA = (const char*)g.A + S.a_off(cur, tstep); const char* cB = (const char*)g.Bt + S.b_off(cur, tstep);
    S.a_ready(cur);
    if constexpr (SP2) {
        PG8_STAGE(PG8_SB(0, 0), cB, voffB); PG8_STAGE(PG8_SB(0, 1), cB + hstep, voffB); PG8_STAGEA(PG8_SA(0, 0), cA, 0, false); PG8_STAGEA(PG8_SA(0, 1), cA, 1, false);
        if (wr == 1) PG8_BAR;
        PG8_WAIT_V(2); PG8_BAR;
        PG8_STAGE(PG8_SB(1, 0), cB + kstep, voffB); PG8_STAGEA(PG8_SA(1, 0), cA + kstep, 0, false); PG8_STAGE(PG8_SB(1, 1), cB + hstep + kstep, voffB);
        PG8_WAIT_V(6); PG8_BAR;
    } else {
        PG8_STAGE(PG8_SB(0, 0), cB, voffB); PG8_STAGEA(PG8_SA(0, 0), cA, 0, false); PG8_STAGE(PG8_SB(0, 1), cB + hstep, voffB); PG8_STAGEA(PG8_SA(0, 1), cA, 1, false);
        if (wr == 1) PG8_BAR;
        PG8_WAIT_V(4); PG8_BAR;
        PG8_STAGE(PG8_SB(1, 0), cB + kstep, voffB); PG8_STAGEA(PG8_SA(1, 0), cA + kstep, 0, false); PG8_STAGE(PG8_SB(1, 1), cB + hstep + kstep, voffB);
        PG8_WAIT_V(6); PG8_BAR;
    }
    for (;;) {
        const bool has_next = S.next(ui + 1, nxt);
        if constexpr (GATHER) { if (has_next) { PG8_GOFF(nv0, nv1, ui + 1); } else { nv0[0] = cv0[0]; nv0[1] = cv0[1]; nv1[0] = cv1[0]; nv1[1] = cv1[1]; } }
        const char* nA = has_next ? (const char*)g.A + S.a_off(nxt, tstep) : cA; const char* nB = has_next ? (const char*)g.Bt + S.b_off(nxt, tstep) : cB;
        for (int t = 0; t < nt; t += 2) {
            const bool last = (t == nt - 2);
            const char* a1 = cA + (size_t)(t + 1) * kstep;
            const char* a2 = last ? nA : cA + (size_t)(t + 2) * kstep; const char* b2 = last ? nB : cB + (size_t)(t + 2) * kstep;
            const char* a3 = a2 + kstep; const char* b3 = b2 + kstep;
            if (last && has_next) S.a_ready(nxt);
            if constexpr (SP2) {
            PG8_LDB(B0, 0, 0); PG8_LDB(B1, 0, 1); PG8_SCHED; PG8_LDA(At, 0, 0); PG8_STAGEA(PG8_SA(1, 1), a1, 1, false);
            PG8_WAIT_V(8); PG8_WAIT_L(0); PG8_BAR; PG8_MMA(0, 0, At, B0); PG8_MMA(0, 1, At, B1); PG8_BAR; PG8_SCHED;
            PG8_LDA(At, 0, 1); PG8_STAGE(PG8_SB(0, 0), b2, voffB); PG8_STAGE(PG8_SB(0, 1), b2 + hstep, voffB); PG8_STAGEA(PG8_SA(0, 0), a2, 0, last);
            PG8_WAIT_V(8); PG8_WAIT_L(0); PG8_BAR; PG8_MMA(1, 0, At, B0); PG8_MMA(1, 1, At, B1); PG8_BAR; PG8_SCHED;
            PG8_LDB(B0, 1, 0); PG8_LDB(B1, 1, 1); PG8_SCHED; PG8_LDA(At, 1, 0); PG8_STAGEA(PG8_SA(0, 1), a2, 1, last);
            PG8_WAIT_V(8); PG8_WAIT_L(0); PG8_BAR; PG8_MMA(0, 0, At, B0); PG8_MMA(0, 1, At, B1); PG8_BAR; PG8_SCHED;
            PG8_LDA(At, 1, 1); PG8_STAGE(PG8_SB(1, 0), b3, voffB); PG8_STAGE(PG8_SB(1, 1), b3 + hstep, voffB); PG8_STAGEA(PG8_SA(1, 0), a3, 0, last);
            PG8_WAIT_V(8); PG8_WAIT_L(0); PG8_BAR; PG8_MMA(1, 0, At, B0); PG8_MMA(1, 1, At, B1); PG8_BAR; PG8_SCHED;
            } else {
            PG8_LDB(B0, 0, 0); PG8_SCHED; PG8_LDA(At, 0, 0); PG8_STAGEA(PG8_SA(1, 1), a1, 1, false);
            PG8_WAIT_L(8); PG8_BAR; PG8_WAIT_L(0); PG8_MMA(0, 0, At, B0); PG8_BAR; PG8_SCHED;
            PG8_LDB(B1, 0, 1); PG8_STAGE(PG8_SB(0, 0), b2, voffB);
            PG8_BAR; PG8_WAIT_L(0); PG8_MMA(0, 1, At, B1); PG8_BAR;
            PG8_LDA(At, 0, 1); PG8_STAGEA(PG8_SA(0, 0), a2, 0, last);
            PG8_BAR; PG8_WAIT_L(0); PG8_MMA(1, 0, At, B0); PG8_BAR; PG8_SCHED;
            PG8_STAGE(PG8_SB(0, 1), b2 + hstep, voffB);
            PG8_WAIT_V(6); PG8_BAR; PG8_MMA(1, 1, At, B1); PG8_BAR;
            PG8_LDB(B0, 1, 0); PG8_SCHED; PG8_LDA(At, 1, 0); PG8_STAGEA(PG8_SA(0, 1), a2, 1, last);
            PG8_WAIT_L(8); PG8_BAR; PG8_WAIT_L(0); PG8_MMA(0, 0, At, B0); PG8_BAR; PG8_SCHED;
            PG8_LDB(B1, 1, 1); PG8_STAGE(PG8_SB(1, 0), b3, voffB);
            PG8_BAR; PG8_WAIT_L(0); PG8_MMA(0, 1, At, B1); PG8_BAR;
            PG8_LDA(At, 1, 1); PG8_STAGEA(PG8_SA(1, 0), a3, 0, last);
            PG8_BAR; PG8_WAIT_L(0); PG8_MMA(1, 0, At, B0); PG8_BAR; PG8_SCHED;
            PG8_STAGE(PG8_SB(1, 1), b3 + hstep, voffB);
            PG8_WAIT_V(6); PG8_BAR; PG8_MMA(1, 1, At, B1); PG8_BAR;
            }
        }
        if constexpr (ALIGN_EPI) { if (wr == 0) PG8_BAR; }
        if constexpr (!Epi::AFTER_DRAIN) { E(acc, cur, wr, wc, fr, fq); S.done(cur); }
        if (!has_next) break;
#pragma unroll
        for (int a = 0; a < 2; ++a)
#pragma unroll
            for (int b = 0; b < 2; ++b)
#pragma unroll
                for (int m = 0; m < 4; ++m)
#pragma unroll
                    for (int n = 0; n < 2; ++n) acc[a][b][m][n] = (f32x4){0.f, 0.f, 0.f, 0.f};
        cur = nxt; cA = nA; cB = nB; ++ui;
        if constexpr (GATHER) { cv0[0] = nv0[0]; cv0[1] = nv0[1]; cv1[0] = nv1[0]; cv1[1] = nv1[1]; }
        if constexpr (ALIGN_EPI) { if (wr == 1) PG8_BAR; }
    }
    PG8_WAIT_V(0);
    if constexpr (!ALIGN_EPI) { if (wr == 0) PG8_BAR; }
    PG8_BAR;
    if constexpr (Epi::AFTER_DRAIN) { E.fused(acc, cur, wr, wc, fr, fq, lds, wid, lane); S.done(cur); }
#undef PG8_SA
#undef PG8_SB
#undef PG8_STAGE
#undef PG8_STAGEA
#undef PG8_GLDS1
#undef PG8_GOFF
#undef PG8_LDA
#undef PG8_LDB
#undef PG8_MMA
#undef PG8_WAIT_V
#undef PG8_WAIT_L
#undef PG8_BAR
#undef PG8_SCHED
}
}
#define GAS __attribute__((address_space(1)))
#define LAS __attribute__((address_space(3)))
typedef unsigned short bf16;
typedef unsigned v4u __attribute__((ext_vector_type(4)));
typedef float f32x4 __attribute__((ext_vector_type(4)));
typedef short bf16x8 __attribute__((ext_vector_type(8)));
typedef GAS unsigned gu32;
typedef GAS unsigned long long gu64;
#define RLX_AGENT __ATOMIC_RELAXED, __HIP_MEMORY_SCOPE_AGENT
#define LDS_WAIT() asm volatile("s_waitcnt lgkmcnt(0)" ::: "memory")
#define VM_WAIT() asm volatile("s_waitcnt vmcnt(0)" ::: "memory")
__device__ __forceinline__ unsigned long long rt() { return __builtin_amdgcn_s_memrealtime(); }
__device__ __forceinline__ unsigned f2bfu(float f) { unsigned u = __builtin_bit_cast(unsigned, f); return (u + 0x7fffu + ((u >> 16) & 1u)) >> 16; }
__device__ __forceinline__ unsigned pk2(float lo, float hi) { return f2bfu(lo) | (f2bfu(hi) << 16); }

#define XB_TMO      128
#define XB_XCNT(j)  (256  + 64 * (j))
#define XB_XSUB(j)  (1280 + 64 * (j))
#define XB_XGEN(j)  (2304 + 64 * (j))
#define XB_TOP      3328
#define XB_TOPGEN   3392
#define XCD_BAR_WORDS 3456
#define XB_SPIN_CAP (1u << 18)

__device__ __forceinline__ unsigned xb_ld(unsigned* p)              { return __hip_atomic_load(p, __ATOMIC_RELAXED, __HIP_MEMORY_SCOPE_AGENT); }
__device__ __forceinline__ unsigned xb_add(unsigned* p, unsigned v) { return __hip_atomic_fetch_add(p, v, __ATOMIC_RELAXED, __HIP_MEMORY_SCOPE_AGENT); }
__device__ __forceinline__ unsigned xb_xcc_id() { return (unsigned)__builtin_amdgcn_s_getreg((3 << 11) | 20) & 0xFu; }
#define XB_SPIN(cond, bar) do { unsigned _sp = 0; while (cond) { __builtin_amdgcn_s_sleep(1); \
    if ((++_sp & 255u) == 0u) { if (xb_ld(&(bar)[XB_TMO])) break; if (_sp > XB_SPIN_CAP) { atomicAdd(&(bar)[XB_TMO], 1u); break; } } } } while (0)

struct XcdBarrier {
    unsigned* bar; unsigned x;
    volatile LAS unsigned* st;
};

__device__ __forceinline__ XcdBarrier xcd_barrier_post(unsigned* bar, volatile LAS unsigned* st) {
    XcdBarrier b; b.bar = bar; b.x = xb_xcc_id(); b.st = st;
    if (threadIdx.x == 0) (void)xb_add(&bar[XB_XCNT(b.x)], 1u);
    return b;
}
__device__ __forceinline__ void xcd_barrier_complete(unsigned* bar, unsigned x, unsigned& nloc, unsigned& nx) {
    const unsigned G = gridDim.x * gridDim.y * gridDim.z;
    unsigned sum, cnt, mine, sp = 0u;
    for (;;) {
        sum = 0u; cnt = 0u; mine = 0u;
#pragma unroll
        for (unsigned j = 0; j < 16; ++j) { const unsigned c = xb_ld(&bar[XB_XCNT(j)]); sum += c; cnt += (c > 0u) ? 1u : 0u; mine = (j == x) ? c : mine; }
        if (sum == G) break;
        __builtin_amdgcn_s_sleep(1);
        if ((++sp & 255u) == 0u) { if (xb_ld(&bar[XB_TMO])) break; if (sp > XB_SPIN_CAP) { atomicAdd(&bar[XB_TMO], 1u); break; } }
    }
    nloc = mine > 0u ? mine : 1u; nx = cnt > 0u ? cnt : 1u;
}

__device__ __forceinline__ void xcd_barrier(const XcdBarrier& b) {
    asm volatile("s_waitcnt vmcnt(0)" ::: "memory");
    __syncthreads();
    if (threadIdx.x == 0) {
        unsigned* bar = b.bar;
        __builtin_amdgcn_s_waitcnt(0);
        unsigned nloc = b.st[0], nx = b.st[1];
        if (nloc == 0u) { xcd_barrier_complete(bar, b.x, nloc, nx); b.st[0] = nloc; b.st[1] = nx; }
        const unsigned old = xb_add(&bar[XB_XSUB(b.x)], 1u);
        const unsigned gen = old / nloc;
        if (old + 1u == (gen + 1u) * nloc) {
            __builtin_amdgcn_fence(__ATOMIC_RELEASE, "agent");
            asm volatile("s_waitcnt vmcnt(0)" ::: "memory");
            const unsigned og = xb_add(&bar[XB_TOP], 1u);
            const unsigned tg = og / nx;
            if (og + 1u == (tg + 1u) * nx) xb_add(&bar[XB_TOPGEN], 1u);
            else XB_SPIN(xb_ld(&bar[XB_TOPGEN]) == tg, bar);
            __builtin_amdgcn_fence(__ATOMIC_ACQUIRE, "agent");
            xb_add(&bar[XB_XGEN(b.x)], 1u);
            asm volatile("s_waitcnt vmcnt(0)" ::: "memory");
        } else {
            XB_SPIN(xb_ld(&bar[XB_XGEN(b.x)]) == gen, bar);
            __builtin_amdgcn_fence(__ATOMIC_ACQUIRE, "agent");
            asm volatile("s_waitcnt vmcnt(0)" ::: "memory");
        }
    }
    __syncthreads();
}

template <bool DUAL, class FA, class FB, class FB2, class FE>
__device__ __forceinline__ void naive_tile_h(float* sm, int t256, int K, FA fa, FB fb, FB2 fb2, FE fe) {
    float* As = sm; float* Bs = sm + 1088; float* Bs2 = sm + 2176;
    const int tx = t256 & 15, ty = t256 >> 4;
    float acc[4][4], acc2[4][4];
#pragma unroll
    for (int i = 0; i < 4; ++i)
#pragma unroll
        for (int j = 0; j < 4; ++j) { acc[i][j] = 0.f; acc2[i][j] = 0.f; }
    for (int k0 = 0; k0 < K; k0 += 16) {
        { const int r = t256 >> 2, kk = (t256 & 3) * 4; const float4 a = fa(r, k0 + kk); As[kk * 68 + r] = a.x; As[(kk + 1) * 68 + r] = a.y; As[(kk + 2) * 68 + r] = a.z; As[(kk + 3) * 68 + r] = a.w; }
        { const int kk = t256 >> 4, c = (t256 & 15) * 4; *(float4*)&Bs[kk * 68 + c] = fb(k0 + kk, c); if (DUAL) *(float4*)&Bs2[kk * 68 + c] = fb2(k0 + kk, c); }
        __syncthreads();
#pragma unroll
        for (int kk = 0; kk < 16; ++kk) {
            const float4 a = *(const float4*)&As[kk * 68 + ty * 4]; const float4 b = *(const float4*)&Bs[kk * 68 + tx * 4];
            const float av[4] = {a.x, a.y, a.z, a.w}; const float bv[4] = {b.x, b.y, b.z, b.w};
#pragma unroll
            for (int i = 0; i < 4; ++i)
#pragma unroll
                for (int j = 0; j < 4; ++j) acc[i][j] += av[i] * bv[j];
            if (DUAL) {
                const float4 b2 = *(const float4*)&Bs2[kk * 68 + tx * 4]; const float bw[4] = {b2.x, b2.y, b2.z, b2.w};
#pragma unroll
                for (int i = 0; i < 4; ++i)
#pragma unroll
                    for (int j = 0; j < 4; ++j) acc2[i][j] += av[i] * bw[j];
            }
        }
        __syncthreads();
    }
#pragma unroll
    for (int i = 0; i < 4; ++i) fe(ty * 4 + i, tx * 4, make_float4(acc[i][0], acc[i][1], acc[i][2], acc[i][3]), make_float4(acc2[i][0], acc2[i][1], acc2[i][2], acc2[i][3]));
}

__device__ __forceinline__ void ph_la(int gtid, int nthr, const bf16_t* PROJ, const float* upf, const float* bf, const float* upb, const float* bb, float* LAF, float* LAB) {
    for (int i = gtid; i < NTOK * 256 * 2; i += nthr) {
        const int c = i & 255, t = (i >> 8) & (NTOK - 1), dir = i >> 23;
        const bf16_t* z = PROJ + (size_t)t * PW + (dir ? C_ZB : C_ZF);
        const float* up = dir ? upb : upf; const float* bias = dir ? bb : bf;
        float pre = bias[c];
#pragma unroll
        for (int r = 0; r < 16; ++r) pre += bf2f(z[r]) * up[r * 256 + c];
        const float ls = fminf(pre, 0.f) - log1pf(expf(-fabsf(pre)));
        (dir ? LAB : LAF)[(size_t)t * 256 + c] = ls * (1.f / 16.f);
    }
}
__device__ __forceinline__ void ph_gla_scan(int bid, int tid, const bf16_t* PROJ, const float* LAF, const float* LAB, float* OF, float* OB) {
    const int es = bid & 3, dir = (bid >> 2) & 1, h = (bid >> 3) & 3, b = bid >> 5;
    const int dg = tid & 15, el = tid >> 4, e = es * 32 + el;
    const float* LA = dir ? LAB : LAF; float* O = dir ? OB : OF;
    float S0 = 0.f, S1 = 0.f, S2 = 0.f, S3 = 0.f;
#pragma unroll 4
    for (int step = 0; step < T; ++step) {
        const int t = dir ? (T - 1 - step) : step;
        const size_t row = (size_t)b * T + t;
        const bf16_t* pr = PROJ + row * PW;
        const float4 la = *(const float4*)(LA + row * 256 + h * 64 + dg * 4);
        const float4 q = ld_bf4(pr + C_GQ + h * 64 + dg * 4);
        const float4 k = ld_bf4(pr + C_GK + h * 64 + dg * 4);
        const float v = bf2f(pr[C_GV + h * 128 + e]);
        S0 = expf(la.x) * S0 + k.x * v; S1 = expf(la.y) * S1 + k.y * v; S2 = expf(la.z) * S2 + k.z * v; S3 = expf(la.w) * S3 + k.w * v;
        float part = (q.x * S0 + q.y * S1 + q.z * S2 + q.w * S3) * 0.125f;
        part += __shfl_xor(part, 1); part += __shfl_xor(part, 2); part += __shfl_xor(part, 4); part += __shfl_xor(part, 8);
        if (dg == 0) O[row * 512 + h * 128 + e] = part;
    }
}
__device__ __forceinline__ void ph_gla_combine(int gw, int NGW, int lane, const float* OF, const float* OB, const bf16_t* PROJ, const float* gain, bf16_t* MIXED) {
    for (int w = gw; w < NTOK * 4; w += NGW) {
        const int t = w >> 2, h = w & 3;
        const size_t o = (size_t)t * 512 + h * 128 + lane * 2;
        const float2 a = *(const float2*)(OF + o), bq = *(const float2*)(OB + o);
        const float v0 = a.x + bq.x, v1 = a.y + bq.y;
        const float ss = wave_sum(v0 * v0 + v1 * v1);
        const float rstd = rsqrtf(ss * (1.f / 128.f) + EPS);
        const bf16_t* g = PROJ + (size_t)t * PW + C_GG + h * 128 + lane * 2;
        const float g0 = bf2f(g[0]), g1 = bf2f(g[1]);
        bf16_t* m = MIXED + (size_t)t * D + h * 128 + lane * 2;
        m[0] = f2bf(v0 * rstd * gain[lane * 2] * silu_f(g0)); m[1] = f2bf(v1 * rstd * gain[lane * 2 + 1] * silu_f(g1));
    }
}
__device__ __forceinline__ void ph_qk_prep(int gw, int NGW, int lane, bf16_t* PROJ, const float* qg, const float* kg, const float* rope, bf16_t* OUT, int opitch) {
    const float gq = qg[lane], gk = kg[lane];
    const int pi = lane >> 1, j = pi & 15;
    for (int t = gw; t < NTOK; t += NGW) {
        bf16_t* p = PROJ + (size_t)t * PW + C_AQ + lane;
        float v[10];
#pragma unroll
        for (int hs = 8; hs < 10; ++hs) v[hs] = bf2f(p[hs * 64]);
        const int tt = t & (T - 1), pos = pi < 16 ? (tt >> 6) : (tt & 63);
        const float c = rope[pos * 16 + j], s = rope[1024 + pos * 16 + j];
#pragma unroll
        for (int hs = 8; hs < 10; ++hs) {
            const float ss = wave_sum(v[hs] * v[hs]);
            const float y = v[hs] * rsqrtf(ss * (1.f / 64.f) + EPS) * (hs < 8 ? gq : gk);
            const float partner = __shfl_xor(y, 1);
            float o = (lane & 1) ? (partner * s + y * c) : (y * c - partner * s);
            if (hs < 8) o *= 0.125f * 1.4426950408889634f;
            OUT[(size_t)t * opitch + lane + hs * 64] = f2bf(o);
        }
    }
}
__device__ __forceinline__ void ph_attn_vb(float* sm, int t256, int vb, const bf16_t* PROJ, float* ATT) {
    float* Qt = sm; float* KV = sm + 4352; float* St = sm + 8704; float* al = sm + 13056;
    const int tx = t256 & 15, ty = t256 >> 4;
    const int q0 = (vb & 63) * 64, hq = (vb >> 6) & 7, b = vb >> 9, kvh = hq >> 2;
    const size_t rowb = (size_t)b * T;
    { const int r = t256 >> 2, d0 = (t256 & 3) * 16; const bf16_t* p = PROJ + (rowb + q0 + r) * PW + C_AQ + hq * 64 + d0;
#pragma unroll
      for (int i = 0; i < 16; ++i) Qt[(d0 + i) * 68 + r] = bf2f(p[i]); }
    float O[4][4];
#pragma unroll
    for (int i = 0; i < 4; ++i)
#pragma unroll
        for (int j = 0; j < 4; ++j) O[i][j] = 0.f;
    float m_run = -INFINITY, l_run = 0.f;
    for (int k0 = 0; k0 < T; k0 += 64) {
        { const int c = t256 >> 2, d0 = (t256 & 3) * 16; const bf16_t* p = PROJ + (rowb + k0 + c) * PW + C_AK + kvh * 64 + d0;
#pragma unroll
          for (int i = 0; i < 16; ++i) KV[(d0 + i) * 68 + c] = bf2f(p[i]); }
        __syncthreads();
        float s[4][4];
#pragma unroll
        for (int i = 0; i < 4; ++i)
#pragma unroll
            for (int j = 0; j < 4; ++j) s[i][j] = 0.f;
#pragma unroll 8
        for (int d = 0; d < 64; ++d) {
            const float4 a = *(const float4*)&Qt[d * 68 + ty * 4]; const float4 bq = *(const float4*)&KV[d * 68 + tx * 4];
            const float av[4] = {a.x, a.y, a.z, a.w}; const float bv[4] = {bq.x, bq.y, bq.z, bq.w};
#pragma unroll
            for (int i = 0; i < 4; ++i)
#pragma unroll
                for (int j = 0; j < 4; ++j) s[i][j] += av[i] * bv[j];
        }
#pragma unroll
        for (int i = 0; i < 4; ++i)
#pragma unroll
            for (int j = 0; j < 4; ++j) St[(tx * 4 + j) * 68 + ty * 4 + i] = s[i][j];
        __syncthreads();
        { const int c = t256 >> 2, e0 = (t256 & 3) * 16; const bf16_t* p = PROJ + (rowb + k0 + c) * PW + C_AV + kvh * 64 + e0;
#pragma unroll
          for (int i = 0; i < 16; ++i) KV[c * 68 + e0 + i] = bf2f(p[i]); }
        if (t256 < 64) {
            float mx = -INFINITY;
            for (int c = 0; c < 64; ++c) mx = fmaxf(mx, St[c * 68 + t256]);
            const float mn = fmaxf(m_run, mx);
            const float alpha = expf(m_run - mn);
            float sum = 0.f;
            for (int c = 0; c < 64; ++c) { const float p = expf(St[c * 68 + t256] - mn); St[c * 68 + t256] = p; sum += p; }
            l_run = l_run * alpha + sum; m_run = mn; al[t256] = alpha;
        }
        __syncthreads();
#pragma unroll
        for (int i = 0; i < 4; ++i) { const float a = al[ty * 4 + i];
#pragma unroll
            for (int j = 0; j < 4; ++j) O[i][j] *= a; }
#pragma unroll 8
        for (int c = 0; c < 64; ++c) {
            const float4 a = *(const float4*)&St[c * 68 + ty * 4]; const float4 bq = *(const float4*)&KV[c * 68 + tx * 4];
            const float av[4] = {a.x, a.y, a.z, a.w}; const float bv[4] = {bq.x, bq.y, bq.z, bq.w};
#pragma unroll
            for (int i = 0; i < 4; ++i)
#pragma unroll
                for (int j = 0; j < 4; ++j) O[i][j] += av[i] * bv[j];
        }
        __syncthreads();
    }
    if (t256 < 64) al[t256] = 1.f / l_run;
    __syncthreads();
#pragma unroll
    for (int i = 0; i < 4; ++i) { const float a = al[ty * 4 + i];
        *(float4*)(ATT + (rowb + q0 + ty * 4 + i) * 512 + hq * 64 + tx * 4) = make_float4(O[i][0] * a, O[i][1] * a, O[i][2] * a, O[i][3] * a); }
    __syncthreads();
}
__device__ __forceinline__ void ph_att_norm(int gw, int NGW, int lane, const float* ATT, const float* gain, bf16_t* MIXED) {
    for (int t = gw; t < NTOK; t += NGW) {
        const float4* a = (const float4*)(ATT + (size_t)t * 512);
        const float4 v0 = a[lane], v1 = a[64 + lane];
        const float ss = wave_sum(v0.x * v0.x + v0.y * v0.y + v0.z * v0.z + v0.w * v0.w + v1.x * v1.x + v1.y * v1.y + v1.z * v1.z + v1.w * v1.w);
        const float rstd = rsqrtf(ss * (1.f / 512.f) + EPS);
        const float4 g0 = ((const float4*)gain)[lane], g1 = ((const float4*)gain)[64 + lane];
        bf16_t* m = MIXED + (size_t)t * D + 512;
        st_bf4(m + lane * 4, make_float4(v0.x * rstd * g0.x, v0.y * rstd * g0.y, v0.z * rstd * g0.z, v0.w * rstd * g0.w));
        st_bf4(m + 256 + lane * 4, make_float4(v1.x * rstd * g1.x, v1.y * rstd * g1.y, v1.z * rstd * g1.z, v1.w * rstd * g1.w));
    }
}
__device__ __forceinline__ void ph_router(int gw, int NGW, int lane, const float* H, const float* g2, const float* wg, const float* bg, const float* we, const float* be, float* RSTD, unsigned* tokinfo, unsigned* ctl) {
    for (int t = gw; t < NTOK; t += NGW) {
        const float4* hr = (const float4*)(H + (size_t)t * D);
        float ss = 0.f;
#pragma unroll
        for (int j = 0; j < 4; ++j) { const float4 v = hr[j * 64 + lane]; ss += v.x * v.x + v.y * v.y + v.z * v.z + v.w * v.w; }
        ss = wave_sum(ss);
        const float rstd = rsqrtf(ss * (1.f / D) + EPS);
        float gl[8], el[64];
#pragma unroll
        for (int i = 0; i < 8; ++i) gl[i] = 0.f;
#pragma unroll
        for (int i = 0; i < 64; ++i) el[i] = 0.f;
#pragma unroll 1
        for (int ji = 0; ji < 16; ++ji) {
            const int k = ((ji >> 2) * 64 + lane) * 4 + (ji & 3);
            const float xv = H[(size_t)t * D + k] * rstd * g2[k];
            const float4* pg = (const float4*)(wg + (size_t)k * 8);
#pragma unroll
            for (int q = 0; q < 2; ++q) { const float4 w = pg[q]; gl[q * 4] += xv * w.x; gl[q * 4 + 1] += xv * w.y; gl[q * 4 + 2] += xv * w.z; gl[q * 4 + 3] += xv * w.w; }
            const float4* pe = (const float4*)(we + (size_t)k * 64);
#pragma unroll
            for (int q = 0; q < 16; ++q) { const float4 w = pe[q]; el[q * 4] += xv * w.x; el[q * 4 + 1] += xv * w.y; el[q * 4 + 2] += xv * w.z; el[q * 4 + 3] += xv * w.w; }
        }
#pragma unroll
        for (int i = 0; i < 8; ++i) gl[i] = wave_sum(gl[i]) + bg[i];
#pragma unroll
        for (int i = 0; i < 64; ++i) el[i] = wave_sum(el[i]) + be[i];
        float best = gl[0]; int g = 0;
#pragma unroll
        for (int i = 1; i < 8; ++i) if (gl[i] > best) { best = gl[i]; g = i; }
        float den = 0.f;
#pragma unroll
        for (int i = 0; i < 8; ++i) den += expf(gl[i] - best);
        const float gw_ = 1.f / den;
        float ev[8];
#pragma unroll
        for (int j = 0; j < 8; ++j) { float v = el[j];
#pragma unroll
            for (int q = 1; q < 8; ++q) v = (g == q) ? el[q * 8 + j] : v;
            ev[j] = v; }
        float v1 = ev[0]; int i1 = 0;
#pragma unroll
        for (int j = 1; j < 8; ++j) if (ev[j] > v1) { v1 = ev[j]; i1 = j; }
        float v2 = -INFINITY; int i2 = 0;
#pragma unroll
        for (int j = 0; j < 8; ++j) if (j != i1 && ev[j] > v2) { v2 = ev[j]; i2 = j; }
        const float ex = expf(v2 - v1), p1 = 1.f / (1.f + ex), p2 = ex * p1;
        if (lane == 0) {
            const int e1 = g * 8 + i1, e2 = g * 8 + i2;
            uint4 o; o.x = (unsigned)e1; o.y = (unsigned)e2; o.z = __float_as_uint(gw_ * p1); o.w = __float_as_uint(gw_ * p2);
            ((uint4*)tokinfo)[t] = o;
            RSTD[t] = rstd;
            atomicAdd(&ctl[CW_COUNTS + e1], 1u); atomicAdd(&ctl[CW_COUNTS + e2], 1u);
        }
    }
}
__device__ __forceinline__ void ph_offsets(unsigned* ctl) {
    unsigned off = 0, nt = 0;
    for (int e = 0; e < NEXP; ++e) {
        const unsigned c = ctl[CW_COUNTS + e]; ctl[CW_OFFS + e] = off;
        for (unsigned r = 0; r < c; r += 64) { ctl[CW_TILE_E + nt] = (unsigned)e; ctl[CW_TILE_R0 + nt] = off + r; ctl[CW_TILE_NR + nt] = (c - r) < 64u ? (c - r) : 64u; ++nt; }
        off += c;
    }
    ctl[CW_OFFS + NEXP] = off; ctl[CW_NTILES] = nt;
}
__device__ __forceinline__ void ph_scatter(int gtid, int nthr, const unsigned* tokinfo, unsigned* ctl, int* tokslot, int* slottok, float* slotgate) {
    for (int t = gtid; t < NTOK; t += nthr) {
        const uint4 ti = ((const uint4*)tokinfo)[t];
        const unsigned p0 = ctl[CW_OFFS + ti.x] + atomicAdd(&ctl[CW_CURSOR + ti.x], 1u);
        const unsigned p1 = ctl[CW_OFFS + ti.y] + atomicAdd(&ctl[CW_CURSOR + ti.y], 1u);
        slottok[p0] = t; slottok[p1] = t; slotgate[p0] = __uint_as_float(ti.z); slotgate[p1] = __uint_as_float(ti.w);
        tokslot[2 * t] = (int)p0; tokslot[2 * t + 1] = (int)p1;
    }
}
__device__ __forceinline__ void ph_moe1_vb(float* sm, int t256, bool valid, int vb, const bf16_t* XN2, const float* w_gate, const float* w_up, const unsigned* ctl, const int* slottok, bf16_t* HMID) {
    const int tile = valid ? (vb >> 3) : 0, c0 = (vb & 7) * 64;
    const int e = (int)ctl[CW_TILE_E + tile], row0 = (int)ctl[CW_TILE_R0 + tile], nr = valid ? (int)ctl[CW_TILE_NR + tile] : 0;
    const float* wgp = w_gate + (size_t)e * D * DEXP; const float* wup = w_up + (size_t)e * D * DEXP;
    auto fa = [&](int r, int k) { if (r >= nr) return make_float4(0.f, 0.f, 0.f, 0.f); const int tok = slottok[row0 + r]; return ld_bf4(XN2 + (size_t)tok * D + k); };
    auto fb = [&](int k, int c) { return *(const float4*)(wgp + (size_t)k * DEXP + c0 + c); };
    auto fb2 = [&](int k, int c) { return *(const float4*)(wup + (size_t)k * DEXP + c0 + c); };
    auto fe = [&](int r, int c, float4 a, float4 u) { if (r >= nr) return; st_bf4(HMID + (size_t)(row0 + r) * DEXP + c0 + c, make_float4(silu_f(a.x) * u.x, silu_f(a.y) * u.y, silu_f(a.z) * u.z, silu_f(a.w) * u.w)); };
    naive_tile_h<true>(sm, t256, D, fa, fb, fb2, fe);
}
__device__ __forceinline__ void ph_moe2_vb(float* sm, int t256, bool valid, int vb, const bf16_t* HMID, const float* w_down, const unsigned* ctl, const float* slotgate, bf16_t* YS) {
    const int tile = valid ? (vb >> 4) : 0, c0 = (vb & 15) * 64;
    const int e = (int)ctl[CW_TILE_E + tile], row0 = (int)ctl[CW_TILE_R0 + tile], nr = valid ? (int)ctl[CW_TILE_NR + tile] : 0;
    const float* wd = w_down + (size_t)e * DEXP * D;
    auto fa = [&](int r, int k) { if (r >= nr) return make_float4(0.f, 0.f, 0.f, 0.f); return ld_bf4(HMID + (size_t)(row0 + r) * DEXP + k); };
    auto fb = [&](int k, int c) { return *(const float4*)(wd + (size_t)k * D + c0 + c); };
    auto fe = [&](int r, int c, float4 a, float4) { if (r >= nr) return; const float g = slotgate[row0 + r]; st_bf4(YS + (size_t)(row0 + r) * D + c0 + c, make_float4(a.x * g, a.y * g, a.z * g, a.w * g)); };
    naive_tile_h<false>(sm, t256, DEXP, fa, fb, fb, fe);
}
__device__ __forceinline__ void ph_final(int gw, int NGW, int lane, const bf16_t* H, const unsigned char* YS8, const float* YSC, const int* tokslot, const float* fg, float* OUTA, float* OUTB) {
    const int sub = (lane & 31) >> 3;
    float4 g[4];
#pragma unroll
    for (int j = 0; j < 4; ++j) g[j] = ((const float4*)fg)[j * 64 + lane];
    for (int t = 2 * gw; t < NTOK; t += 2 * NGW) {
        const int4 sl = *(const int4*)(tokslot + 2 * t);
        float4 v[2][4]; float ss[2] = {0.f, 0.f};
#pragma unroll
        for (int q = 0; q < 2; ++q) {
            const int s0 = q ? sl.z : sl.x, s1 = q ? sl.w : sl.y;
            const bf16_t* hr = H + (size_t)(t + q) * D;
            const unsigned* y0 = (const unsigned*)(YS8 + (size_t)s0 * D); const unsigned* y1 = (const unsigned*)(YS8 + (size_t)s1 * D);
            const float4 a0 = *(const float4*)(YSC + (size_t)s0 * 16 + sub * 4), a1 = *(const float4*)(YSC + (size_t)s1 * 16 + sub * 4);
            const float a0j[4] = {a0.x, a0.y, a0.z, a0.w}, a1j[4] = {a1.x, a1.y, a1.z, a1.w};
#pragma unroll
            for (int j = 0; j < 4; ++j) {
                const float4 hv = ld_bf4(hr + (j * 64 + lane) * 4); const unsigned w0 = y0[j * 64 + lane], w1 = y1[j * 64 + lane];
                const float p = a0j[j], r = a1j[j], off = -128.f * (p + r);
                v[q][j] = make_float4((hv.x + off) + p * (float)(w0 & 0xffu) + r * (float)(w1 & 0xffu), (hv.y + off) + p * (float)((w0 >> 8) & 0xffu) + r * (float)((w1 >> 8) & 0xffu),
                                      (hv.z + off) + p * (float)((w0 >> 16) & 0xffu) + r * (float)((w1 >> 16) & 0xffu), (hv.w + off) + p * (float)(w0 >> 24) + r * (float)(w1 >> 24));
                ss[q] += v[q][j].x * v[q][j].x + v[q][j].y * v[q][j].y + v[q][j].z * v[q][j].z + v[q][j].w * v[q][j].w;
            }
        }
#pragma unroll
        for (int q = 0; q < 2; ++q) {
            const float rstd = rsqrtf(wave_sum(ss[q]) * (1.f / D) + EPS);
            const int tt = t + q;
            float4* orow = (float4*)((tt < NTOK / 2 ? OUTA + (size_t)tt * D : OUTB + (size_t)(tt - NTOK / 2) * D));
#pragma unroll
            for (int j = 0; j < 4; ++j) orow[j * 64 + lane] = make_float4(v[q][j].x * rstd * g[j].x, v[q][j].y * rstd * g[j].y, v[q][j].z * rstd * g[j].z, v[q][j].w * rstd * g[j].w);
        }
    }
}
__device__ __forceinline__ void ph_copy_xs(int bx, int wave, int lane, const LAS int* pos, const float* H, const float* RSTD, const float* g2, bf16_t* XS) {
    float4 g[4];
#pragma unroll
    for (int j = 0; j < 4; ++j) g[j] = ((const float4*)g2)[j * 64 + lane];
#pragma unroll 1
    for (int i = 0; i < 16; i += 2) {
        const int l0 = wave * 16 + i, l1 = l0 + 1, t0 = bx * 128 + l0, t1 = t0 + 1;
        const float r0 = RSTD[t0], r1 = RSTD[t1];
        const float4* h0 = (const float4*)(H + (size_t)t0 * D); const float4* h1 = (const float4*)(H + (size_t)t1 * D);
        float4 a[4], b[4];
#pragma unroll
        for (int j = 0; j < 4; ++j) { a[j] = h0[j * 64 + lane]; b[j] = h1[j * 64 + lane]; }
        uint2* o00 = (uint2*)(XS + (size_t)pos[2 * l0] * D); uint2* o01 = (uint2*)(XS + (size_t)pos[2 * l0 + 1] * D);
        uint2* o10 = (uint2*)(XS + (size_t)pos[2 * l1] * D); uint2* o11 = (uint2*)(XS + (size_t)pos[2 * l1 + 1] * D);
#pragma unroll
        for (int j = 0; j < 4; ++j) {
            uint2 w; w.x = (unsigned)f2bf(a[j].x * r0 * g[j].x) | ((unsigned)f2bf(a[j].y * r0 * g[j].y) << 16); w.y = (unsigned)f2bf(a[j].z * r0 * g[j].z) | ((unsigned)f2bf(a[j].w * r0 * g[j].w) << 16);
            o00[j * 64 + lane] = w; o01[j * 64 + lane] = w;
            uint2 v; v.x = (unsigned)f2bf(b[j].x * r1 * g[j].x) | ((unsigned)f2bf(b[j].y * r1 * g[j].y) << 16); v.y = (unsigned)f2bf(b[j].z * r1 * g[j].z) | ((unsigned)f2bf(b[j].w * r1 * g[j].w) << 16);
            o10[j * 64 + lane] = v; o11[j * 64 + lane] = v;
        }
    }
}

__device__ __forceinline__ void ph_copy_xs_i8(int bx, int wave, int lane, const LAS int* pos, const bf16_t* H, const float* RSTD, const float* g2, unsigned char* XS8, float* SA) {
    float4 g[4];
#pragma unroll
    for (int j = 0; j < 4; ++j) g[j] = ((const float4*)g2)[lane * 4 + j];
#pragma unroll 1
    for (int i = 0; i < 16; i += 2) {
        const int l0 = wave * 16 + i, t0 = bx * 128 + l0;
        float4 a[2][4]; float mx[2];
#pragma unroll
        for (int q = 0; q < 2; ++q) { const uint4* hp = (const uint4*)(H + (size_t)(t0 + q) * D + lane * 16); const uint4 h0 = hp[0], h1 = hp[1];
            const unsigned hw[8] = {h0.x, h0.y, h0.z, h0.w, h1.x, h1.y, h1.z, h1.w};
#pragma unroll
            for (int j = 0; j < 4; ++j) a[q][j] = make_float4(__uint_as_float(hw[2 * j] << 16), __uint_as_float(hw[2 * j] & 0xffff0000u), __uint_as_float(hw[2 * j + 1] << 16), __uint_as_float(hw[2 * j + 1] & 0xffff0000u)); }
#pragma unroll
        for (int q = 0; q < 2; ++q) { const float r = RSTD[t0 + q]; float m = 0.f;
#pragma unroll
            for (int j = 0; j < 4; ++j) { a[q][j].x *= r * g[j].x; a[q][j].y *= r * g[j].y; a[q][j].z *= r * g[j].z; a[q][j].w *= r * g[j].w;
                m = fmaxf(m, fmaxf(fmaxf(fabsf(a[q][j].x), fabsf(a[q][j].y)), fmaxf(fabsf(a[q][j].z), fabsf(a[q][j].w)))); }
#pragma unroll
            for (int o = 1; o < 64; o <<= 1) m = fmaxf(m, __shfl_xor(m, o));
            mx[q] = m; }
#pragma unroll
        for (int q = 0; q < 2; ++q) { const float inv = mx[q] > 0.f ? 127.f / mx[q] : 0.f;
            v4u w;
#pragma unroll
            for (int j = 0; j < 4; ++j) { const int ia = __float2int_rn(a[q][j].x * inv), ib = __float2int_rn(a[q][j].y * inv), ic = __float2int_rn(a[q][j].z * inv), id = __float2int_rn(a[q][j].w * inv);
                w[j] = ((unsigned)ia & 0xffu) | (((unsigned)ib & 0xffu) << 8) | (((unsigned)ic & 0xffu) << 16) | ((unsigned)id << 24); }
            const int p0 = pos[2 * (l0 + q)], p1 = pos[2 * (l0 + q) + 1];
            *(GAS v4u*)(XS8 + (size_t)p0 * D + lane * 16) = w; *(GAS v4u*)(XS8 + (size_t)p1 * D + lane * 16) = w;
            if (lane == 0) { SA[p0] = mx[q] * (1.f / 127.f); SA[p1] = mx[q] * (1.f / 127.f); } }
    }
}
constexpr size_t WS_DEC = 11 * MiB;
constexpr int LDT = 72;
constexpr int GL_QE = 0, GL_KE = 9216, GL_P = 18432, GL_VT = 27648, GL_ST = 46080, GL_TOT = 64512, GL_PART = 68608, GL_RSTD = 70656;
typedef float gf32x4 __attribute__((ext_vector_type(4)));
typedef short gbf16x8 __attribute__((ext_vector_type(8)));

__device__ __forceinline__ float exp_fast(float x) { return __builtin_amdgcn_exp2f(x * 1.4426950408889634f); }
__device__ __forceinline__ float log_sigmoid_f(float x) { return fminf(x, 0.f) - 0.6931471805599453f * __builtin_amdgcn_logf(1.f + exp_fast(-fabsf(x))); }
__device__ __forceinline__ gf32x4 mfma_tile64(const LAS bf16_t* A, const LAS bf16_t* Bt, gf32x4 acc, int lane) {
    const int r = lane & 15, kq = (lane >> 4) * 8;
    const gbf16x8 a0 = *(const LAS gbf16x8*)(A + r * LDT + kq), a1 = *(const LAS gbf16x8*)(A + r * LDT + kq + 32);
    const gbf16x8 b0 = *(const LAS gbf16x8*)(Bt + r * LDT + kq), b1 = *(const LAS gbf16x8*)(Bt + r * LDT + kq + 32);
    acc = __builtin_amdgcn_mfma_f32_16x16x32_bf16(a0, b0, acc, 0, 0, 0);
    acc = __builtin_amdgcn_mfma_f32_16x16x32_bf16(a1, b1, acc, 0, 0, 0);
    return acc;
}
template <bool BWD>
__device__ __forceinline__ void gla_cumsum(const bf16_t* zbase  , const float* up  , const float* bias, int hd  , int tg, int d, LAS float* tot, float (&bv)[8], float& bl) {
    float upc[16];
#pragma unroll
    for (int r = 0; r < 16; ++r) upc[r] = up[r * 256 + hd];
    const float bs = bias[hd];
    float c[8];
#pragma unroll
    for (int i = 0; i < 8; ++i) {
        const uint4* zp = (const uint4*)(zbase + (size_t)(8 * tg + i) * PW);
        const uint4 z0 = zp[0], z1 = zp[1];
        const unsigned zw[8] = {z0.x, z0.y, z0.z, z0.w, z1.x, z1.y, z1.z, z1.w};
        float pre = bs;
#pragma unroll
        for (int r = 0; r < 8; ++r) { pre += __uint_as_float(zw[r] << 16) * upc[2 * r]; pre += __uint_as_float(zw[r] & 0xffff0000u) * upc[2 * r + 1]; }
        c[i] = log_sigmoid_f(pre) * (1.f / 16.f);
    }
    if (!BWD) {
#pragma unroll
        for (int i = 1; i < 8; ++i) c[i] += c[i - 1];
        tot[tg * 64 + d] = c[7];
    } else {
#pragma unroll
        for (int i = 6; i >= 0; --i) c[i] += c[i + 1];
        tot[tg * 64 + d] = c[0];
    }
    __syncthreads();
    float off = 0.f, all = 0.f;
#pragma unroll
    for (int t2 = 0; t2 < 8; ++t2) { const float v = tot[t2 * 64 + d]; all += v; if (BWD ? (t2 > tg) : (t2 < tg)) off += v; }
#pragma unroll
    for (int i = 0; i < 8; ++i) bv[i] = c[i] + off;
    bl = all;
}
__device__ __forceinline__ void gla_stage_vt(const bf16_t* vbase, LAS bf16_t* VT, int tid) {
    const int s = tid & 63, e0 = (tid >> 6) * 16;
    const uint4* vp = (const uint4*)(vbase + (size_t)s * PW + e0);
    const uint4 v0 = vp[0], v1 = vp[1];
    const unsigned w[8] = {v0.x, v0.y, v0.z, v0.w, v1.x, v1.y, v1.z, v1.w};
#pragma unroll
    for (int i = 0; i < 8; ++i) { VT[(e0 + 2 * i) * LDT + s] = (bf16_t)(w[i] & 0xffffu); VT[(e0 + 2 * i + 1) * LDT + s] = (bf16_t)(w[i] >> 16); }
}
__device__ __forceinline__ void gla_g1_unit(LAS unsigned char* lds, int tid, int unit, const bf16_t* PROJ, const float* upf, const float* bf_, const float* upb, const float* bb_, bf16_t* KVS, float* DEC) {
    const int n = unit & 63, h = (unit >> 6) & 3, b = unit >> 8;
    const int d = tid & 63, tg = tid >> 6, lane = tid & 63, w = tid >> 6;
    const size_t tok0 = (size_t)b * T + n * 64;
    LAS bf16_t* KET = (LAS bf16_t*)(lds + GL_QE); LAS bf16_t* VT = (LAS bf16_t*)(lds + GL_VT); LAS float* tot = (LAS float*)(lds + GL_TOT);
    gla_stage_vt(PROJ + tok0 * PW + C_GV + h * 128, VT, tid);
#pragma unroll
    for (int dir = 0; dir < 2; ++dir) {
        float bv[8], bl;
        if (dir == 0) gla_cumsum<false>(PROJ + tok0 * PW + C_ZF, upf, bf_, h * 64 + d, tg, d, tot, bv, bl);
        else          gla_cumsum<true>(PROJ + tok0 * PW + C_ZB, upb, bb_, h * 64 + d, tg, d, tot + 512, bv, bl);
        unsigned pk[4];
#pragma unroll
        for (int i = 0; i < 8; i += 2) {
            const float k0 = bf2f(PROJ[(tok0 + 8 * tg + i) * PW + C_GK + h * 64 + d]) * exp_fast(bl - bv[i]);
            const float k1 = bf2f(PROJ[(tok0 + 8 * tg + i + 1) * PW + C_GK + h * 64 + d]) * exp_fast(bl - bv[i + 1]);
            pk[i >> 1] = (unsigned)f2bf(k0) | ((unsigned)f2bf(k1) << 16);
        }
        *(LAS v4u*)(KET + d * LDT + 8 * tg) = (v4u){pk[0], pk[1], pk[2], pk[3]};
        const size_t sq = (((size_t)b * 4 + h) * 2 + dir) * 64 + n;
        if (tg == 0) DEC[sq * 64 + d] = exp_fast(bl);
        __syncthreads();
        bf16_t* kvo = KVS + sq * 8192;
#pragma unroll
        for (int dt = 0; dt < 4; ++dt) {
            gf32x4 acc = {0.f, 0.f, 0.f, 0.f};
            acc = mfma_tile64(VT + (16 * w) * LDT, KET + (16 * dt) * LDT, acc, lane);
#pragma unroll
            for (int r = 0; r < 4; ++r) kvo[(size_t)(16 * w + 4 * (lane >> 4) + r) * 64 + 16 * dt + (lane & 15)] = f2bf(acc[r]);
        }
        __syncthreads();
    }
}
template <bool BWD>
__device__ __forceinline__ void gla_g2_item(unsigned* base, const float* dc) {
    float s0 = 0.f, s1 = 0.f;
#pragma unroll 1
    for (int hf = 0; hf < 2; ++hf) {
        unsigned kv[32]; float2 dd[32];
#pragma unroll
        for (int st = 0; st < 32; ++st) { const int n = BWD ? (63 - 32 * hf - st) : (32 * hf + st); kv[st] = base[(size_t)n * 4096]; dd[st] = *(const float2*)(dc + n * 64); }
#pragma unroll
        for (int st = 0; st < 32; ++st) { const int n = BWD ? (63 - 32 * hf - st) : (32 * hf + st);
            base[(size_t)n * 4096] = (unsigned)f2bf(s0) | ((unsigned)f2bf(s1) << 16);
            s0 = dd[st].x * s0 + __uint_as_float(kv[st] << 16); s1 = dd[st].y * s1 + __uint_as_float(kv[st] & 0xffff0000u); }
    }
}
__device__ __forceinline__ void gla_g2_scan(int gtid, int nthr, bf16_t* KVS, const float* DEC) {
    for (int item = gtid; item < 64 * 4096; item += nthr) {
        const int seq = item >> 12, ed = item & 4095, d2 = (ed & 31) * 2;
        unsigned* base = (unsigned*)(KVS + (size_t)seq * 64 * 8192) + ed;
        const float* dc = DEC + (size_t)seq * 64 * 64 + d2;
        if (seq & 1) gla_g2_item<true>(base, dc); else gla_g2_item<false>(base, dc);
    }
}
__device__ __forceinline__ void gla_g3_unit(LAS unsigned char* lds, int tid, int unit, const bf16_t* PROJ, const float* upf, const float* bf_, const float* upb, const float* bb_, const bf16_t* KVS, const float* gain, bf16_t* MIXED) {
    const int n = unit & 63, h = (unit >> 6) & 3, b = unit >> 8;
    const int d = tid & 63, tg = tid >> 6, lane = tid & 63, w = tid >> 6;
    const size_t tok0 = (size_t)b * T + n * 64;
    LAS bf16_t* QE = (LAS bf16_t*)(lds + GL_QE); LAS bf16_t* KE = (LAS bf16_t*)(lds + GL_KE); LAS bf16_t* PP = (LAS bf16_t*)(lds + GL_P);
    LAS bf16_t* VT = (LAS bf16_t*)(lds + GL_VT); LAS bf16_t* ST = (LAS bf16_t*)(lds + GL_ST);
    LAS float* tot = (LAS float*)(lds + GL_TOT); LAS float* part = (LAS float*)(lds + GL_PART); LAS float* rs = (LAS float*)(lds + GL_RSTD);
    gla_stage_vt(PROJ + tok0 * PW + C_GV + h * 128, VT, tid);
    gf32x4 o[4];
#pragma unroll
    for (int rt = 0; rt < 4; ++rt) o[rt] = (gf32x4){0.f, 0.f, 0.f, 0.f};
#pragma unroll
    for (int dir = 0; dir < 2; ++dir) {
        float bv[8], bl;
        if (dir == 0) gla_cumsum<false>(PROJ + tok0 * PW + C_ZF, upf, bf_, h * 64 + d, tg, d, tot, bv, bl);
        else          gla_cumsum<true>(PROJ + tok0 * PW + C_ZB, upb, bb_, h * 64 + d, tg, d, tot + 512, bv, bl);
#pragma unroll
        for (int i = 0; i < 8; ++i) {
            const size_t ro = (tok0 + 8 * tg + i) * PW + h * 64 + d;
            const float e = exp_fast(bv[i]);
            QE[(8 * tg + i) * LDT + d] = f2bf(bf2f(PROJ[ro + C_GQ]) * e * 0.125f);
            KE[(8 * tg + i) * LDT + d] = f2bf(bf2f(PROJ[ro + C_GK]) * __builtin_amdgcn_rcpf(e));
        }
        {
            const size_t sq = (((size_t)b * 4 + h) * 2 + dir) * 64 + n;
            const int e = tid >> 2, part4 = tid & 3;
            const uint4* sp = (const uint4*)(KVS + sq * 8192 + e * 64 + part4 * 16);
            const uint4 s0 = sp[0], s1 = sp[1];
            *(LAS v4u*)(ST + e * LDT + part4 * 16) = (v4u){s0.x, s0.y, s0.z, s0.w}; *(LAS v4u*)(ST + e * LDT + part4 * 16 + 8) = (v4u){s1.x, s1.y, s1.z, s1.w};
        }
        __syncthreads();
        { const int ct = w >> 1;
#pragma unroll
          for (int j = 0; j < 2; ++j) { const int st = 2 * (w & 1) + j;
            gf32x4 acc = {0.f, 0.f, 0.f, 0.f};
            acc = mfma_tile64(QE + (16 * ct) * LDT, KE + (16 * st) * LDT, acc, lane);
            const int s = 16 * st + (lane & 15);
#pragma unroll
            for (int r = 0; r < 4; ++r) { const int c = 16 * ct + 4 * (lane >> 4) + r; const bool keep = dir ? (s >= c) : (s <= c);
                PP[c * LDT + s] = f2bf(keep ? acc[r] : 0.f); } } }
        __syncthreads();
#pragma unroll
        for (int rt = 0; rt < 4; ++rt) {
            o[rt] = mfma_tile64(PP + (16 * rt) * LDT, VT + (16 * w) * LDT, o[rt], lane);
            o[rt] = mfma_tile64(QE + (16 * rt) * LDT, ST + (16 * w) * LDT, o[rt], lane);
        }
        __syncthreads();
    }
#pragma unroll
    for (int rt = 0; rt < 4; ++rt)
#pragma unroll
        for (int r = 0; r < 4; ++r) {
            float ss = o[rt][r] * o[rt][r];
            ss += __shfl_xor(ss, 1); ss += __shfl_xor(ss, 2); ss += __shfl_xor(ss, 4); ss += __shfl_xor(ss, 8);
            if ((lane & 15) == 0) part[w * 64 + 16 * rt + 4 * (lane >> 4) + r] = ss;
        }
    __syncthreads();
    if (tid < 64) { float ss = 0.f;
#pragma unroll
        for (int t2 = 0; t2 < 8; ++t2) ss += part[t2 * 64 + tid];
        rs[tid] = rsqrtf(ss * (1.f / 128.f) + EPS); }
    __syncthreads();
    { const int e = 16 * w + (lane & 15); const float ge = gain[e];
#pragma unroll
      for (int rt = 0; rt < 4; ++rt)
#pragma unroll
        for (int r = 0; r < 4; ++r) { const int c = 16 * rt + 4 * (lane >> 4) + r;
            const float g = bf2f(PROJ[(tok0 + c) * PW + C_GG + h * 128 + e]);
            MIXED[(tok0 + c) * D + h * 128 + e] = f2bf(o[rt][r] * rs[c] * ge * g * __builtin_amdgcn_rcpf(1.f + exp_fast(-g))); } }
    __syncthreads();
}

constexpr size_t WS_BFRAG = 12 * MiB;
__device__ __forceinline__ void router_build_bfrag(int gtid, int nthr, const float* wg, const float* we, const float* g2, bf16_t* BF) {
    for (int i = gtid; i < 32 * 5 * 64; i += nthr) {
        const int ks = i / 320, rem = i - ks * 320, ct = rem >> 6, lane = rem & 63, col = 16 * ct + (lane & 15);
        unsigned hi[4], lo[4];
#pragma unroll
        for (int j = 0; j < 8; ++j) {
            const int k = 32 * ks + 8 * (lane >> 4) + j;
            float w = col < 8 ? wg[k * 8 + col] : (col < 72 ? we[k * 64 + col - 8] : 0.f);
            w *= g2[k];
            const bf16_t h = f2bf(w); const bf16_t l = f2bf(w - bf2f(h));
            if (j & 1) { hi[j >> 1] |= (unsigned)h << 16; lo[j >> 1] |= (unsigned)l << 16; } else { hi[j >> 1] = h; lo[j >> 1] = l; }
        }
        uint4* o = (uint4*)(BF + ((size_t)(ks * 5 + ct) * 2) * 512 + lane * 8);
        o[0] = make_uint4(hi[0], hi[1], hi[2], hi[3]); o[64] = make_uint4(lo[0], lo[1], lo[2], lo[3]);
    }
}
__device__ __forceinline__ void ph_router_mfma(int gw, int NGW, int lane, LAS float* lsm  , const bf16_t* H, const bf16_t* BF, const float* bg, const float* be, float* RSTD, unsigned* tokinfo, LAS int* hist, bool dry) {
    for (int task = gw; task < NTOK / 16; task += NGW) {
        const int t0 = task * 16, row = lane & 15, kg = lane >> 4;
        const bf16_t* hp = H + (size_t)(t0 + row) * D + kg * 8;
        gf32x4 acc[5];
#pragma unroll
        for (int ct = 0; ct < 5; ++ct) acc[ct] = (gf32x4){0.f, 0.f, 0.f, 0.f};
        float ss = 0.f;
#pragma unroll 2
        for (int ks = 0; ks < 32; ++ks) {
            const gbf16x8 ah = *(const gbf16x8*)(hp + ks * 32);
#pragma unroll
            for (int j = 0; j < 8; ++j) { const float xv = bf2f((bf16_t)ah[j]); ss += xv * xv; }
            const gbf16x8* bp = (const gbf16x8*)(BF + (size_t)ks * 5 * 2 * 512) + lane;
#pragma unroll
            for (int ct = 0; ct < 5; ++ct) {
                const gbf16x8 bh = bp[(ct * 2) * 64], bl = bp[(ct * 2 + 1) * 64];
                acc[ct] = __builtin_amdgcn_mfma_f32_16x16x32_bf16(ah, bh, acc[ct], 0, 0, 0);
                acc[ct] = __builtin_amdgcn_mfma_f32_16x16x32_bf16(ah, bl, acc[ct], 0, 0, 0);
            }
        }
        ss += __shfl_xor(ss, 16); ss += __shfl_xor(ss, 32);
        const float rstd = rsqrtf(ss * (1.f / D) + EPS);
#pragma unroll
        for (int ct = 0; ct < 5; ++ct) { const int col = 16 * ct + row; const float bias = col < 8 ? bg[col] : (col < 72 ? be[col - 8] : 0.f);
#pragma unroll
            for (int r = 0; r < 4; ++r) { const int rr = 4 * kg + r; const float rs = __shfl(rstd, rr); lsm[rr * 80 + col] = acc[ct][r] * rs + bias; } }
        asm volatile("s_waitcnt lgkmcnt(0)" ::: "memory");
        if (lane < 16) {
            const LAS float* L = lsm + lane * 80;
            float best = L[0]; int g = 0;
#pragma unroll
            for (int i = 1; i < 8; ++i) { const float v = L[i]; if (v > best) { best = v; g = i; } }
            float den = 0.f;
#pragma unroll
            for (int i = 0; i < 8; ++i) den += expf(L[i] - best);
            const float gw_ = 1.f / den;
            const LAS float* E = L + 8 + g * 8;
            float v1 = E[0]; int i1 = 0;
#pragma unroll
            for (int j = 1; j < 8; ++j) { const float v = E[j]; if (v > v1) { v1 = v; i1 = j; } }
            float v2 = -INFINITY; int i2 = 0;
#pragma unroll
            for (int j = 0; j < 8; ++j) { const float v = E[j]; if (j != i1 && v > v2) { v2 = v; i2 = j; } }
            const float ex = expf(v2 - v1), p1 = 1.f / (1.f + ex), p2 = ex * p1;
            const int e1 = g * 8 + i1, e2 = g * 8 + i2, t = t0 + lane;
            uint4 o; o.x = (unsigned)e1; o.y = (unsigned)e2; o.z = __float_as_uint(gw_ * p1); o.w = __float_as_uint(gw_ * p2);
            ((uint4*)tokinfo)[t] = o;
            RSTD[t] = rstd;
            if (!dry) { __hip_atomic_fetch_add(hist + e1, 1, __ATOMIC_RELAXED, __HIP_MEMORY_SCOPE_WORKGROUP); __hip_atomic_fetch_add(hist + e2, 1, __ATOMIC_RELAXED, __HIP_MEMORY_SCOPE_WORKGROUP); }
        }
        asm volatile("s_waitcnt lgkmcnt(0)" ::: "memory");
    }
}

__device__ __forceinline__ void ph_router_lds(int vcu, int G, int wave, int lane, LAS unsigned char* lds, const bf16_t* H, const bf16_t* BF, const float* bg, const float* be, float* RSTD, unsigned* tokinfo, LAS int* hist, bool dry) {
    for (int tg = vcu; tg < NTOK / 128; tg += G) {
        const int t0 = (tg * 8 + wave) * 16, row = lane & 15, kg = lane >> 4;
        const bf16_t* hp = H + (size_t)(t0 + row) * D + kg * 8;
        gf32x4 acc[5];
#pragma unroll
        for (int ct = 0; ct < 5; ++ct) acc[ct] = (gf32x4){0.f, 0.f, 0.f, 0.f};
        float ss = 0.f;
        gbf16x8 ha[2][4];
#define RT_DMA(j) do { _Pragma("unroll") for (int i = 0; i < 5; ++i) __builtin_amdgcn_global_load_lds((const unsigned*)(BF + (size_t)(j) * 20480 + (wave + 8 * i) * 512 + lane * 8), \
            (LAS unsigned*)(lds + ((j) & 1) * 65536 + (wave + 8 * i) * 1024), 16, 0, 0); } while (0)
#define RT_LDH(j) do { _Pragma("unroll") for (int k = 0; k < 4; ++k) ha[(j) & 1][k] = *(const GAS gbf16x8*)(hp + ((j) * 4 + k) * 32); } while (0)
        RT_DMA(0); RT_LDH(0);
#pragma unroll
        for (int j = 0; j < 8; ++j) {
            if (j + 1 < 8) { RT_DMA(j + 1); RT_LDH(j + 1); asm volatile("s_waitcnt vmcnt(9)" ::: "memory"); } else asm volatile("s_waitcnt vmcnt(0)" ::: "memory");
            __syncthreads();
            const LAS unsigned char* buf = lds + (j & 1) * 65536;
#pragma unroll
            for (int k = 0; k < 4; ++k) {
                const gbf16x8 ah = ha[j & 1][k];
#pragma unroll
                for (int e = 0; e < 8; ++e) { const float xv = bf2f((bf16_t)ah[e]); ss += xv * xv; }
#pragma unroll
                for (int ct = 0; ct < 5; ++ct) {
                    const gbf16x8 bh = *(const LAS gbf16x8*)(buf + ((k * 10 + ct * 2) * 64 + lane) * 16), bl = *(const LAS gbf16x8*)(buf + ((k * 10 + ct * 2 + 1) * 64 + lane) * 16);
                    acc[ct] = __builtin_amdgcn_mfma_f32_16x16x32_bf16(ah, bh, acc[ct], 0, 0, 0);
                    acc[ct] = __builtin_amdgcn_mfma_f32_16x16x32_bf16(ah, bl, acc[ct], 0, 0, 0);
                }
            }
            __syncthreads();
        }
#undef RT_DMA
#undef RT_LDH
        LAS float* lsm = (LAS float*)(lds + wave * 5120);
        ss += __shfl_xor(ss, 16); ss += __shfl_xor(ss, 32);
        const float rstd = rsqrtf(ss * (1.f / D) + EPS);
#pragma unroll
        for (int ct = 0; ct < 5; ++ct) { const int col = 16 * ct + row; const float bias = col < 8 ? bg[col] : (col < 72 ? be[col - 8] : 0.f);
#pragma unroll
            for (int r = 0; r < 4; ++r) { const int rr = 4 * kg + r; const float rs = __shfl(rstd, rr); lsm[rr * 80 + col] = acc[ct][r] * rs + bias; } }
        asm volatile("s_waitcnt lgkmcnt(0)" ::: "memory");
        if (lane < 16) {
            const LAS float* L = lsm + lane * 80;
            float best = L[0]; int g = 0;
#pragma unroll
            for (int i = 1; i < 8; ++i) { const float v = L[i]; if (v > best) { best = v; g = i; } }
            float den = 0.f;
#pragma unroll
            for (int i = 0; i < 8; ++i) den += expf(L[i] - best);
            const float gw_ = 1.f / den;
            const LAS float* E = L + 8 + g * 8;
            float v1 = E[0]; int i1 = 0;
#pragma unroll
            for (int j = 1; j < 8; ++j) { const float v = E[j]; if (v > v1) { v1 = v; i1 = j; } }
            float v2 = -INFINITY; int i2 = 0;
#pragma unroll
            for (int j = 0; j < 8; ++j) { const float v = E[j]; if (j != i1 && v > v2) { v2 = v; i2 = j; } }
            const float ex = expf(v2 - v1), p1 = 1.f / (1.f + ex), p2 = ex * p1;
            const int e1 = g * 8 + i1, e2 = g * 8 + i2, t = t0 + lane;
            uint4 o; o.x = (unsigned)e1; o.y = (unsigned)e2; o.z = __float_as_uint(gw_ * p1); o.w = __float_as_uint(gw_ * p2);
            ((uint4*)tokinfo)[t] = o;
            RSTD[t] = rstd;
            if (!dry) { __hip_atomic_fetch_add(hist + e1, 1, __ATOMIC_RELAXED, __HIP_MEMORY_SCOPE_WORKGROUP); __hip_atomic_fetch_add(hist + e2, 1, __ATOMIC_RELAXED, __HIP_MEMORY_SCOPE_WORKGROUP); }
        }
        asm volatile("s_waitcnt lgkmcnt(0)" ::: "memory");
        __syncthreads();
    }
}

constexpr int G_Z = 0, G_VT = 8192, G_G = 26624, G_ST0 = 43008, G_ST1 = 61440, G_BM = 79872, G_QE = 97280, G_KE = 106496, G_P = 115712, G_TOT = 124928, G_PART = 129024;
constexpr int BMS = 68;
typedef unsigned v2u __attribute__((ext_vector_type(2)));
struct GlaRaw3 { v4u q, k, z, v0, v1, g0, g1, sa0, sa1, sb0, sb1, oa0, oa1; float sq; };
struct GlaRaw1 { v4u k, z, v0, v1; };
__device__ __forceinline__ v4u ld16(const bf16_t* p) { return *(const GAS v4u*)p; }
__device__ __forceinline__ void gla_load3(GlaRaw3& R, int tid, int b, int h, int n, const bf16_t* PROJ, const bf16_t* KVS, const bf16_t* MIXED, const float* SSQ) {
    const size_t tok0 = (size_t)b * T + n * 64;
    const int s8 = tid >> 3, c8 = tid & 7, lane = tid & 63, w = tid >> 6;
    R.q = ld16(PROJ + (tok0 + s8) * PW + C_GQ + h * 64 + c8 * 8);
    R.k = ld16(PROJ + (tok0 + s8) * PW + C_GK + h * 64 + c8 * 8);
    R.z = ld16(PROJ + (tok0 + ((tid >> 2) & 63)) * PW + C_ZF + (tid & 3) * 8);
    R.v0 = ld16(PROJ + (tok0 + lane) * PW + C_GV + h * 128 + (2 * w) * 8); R.v1 = ld16(PROJ + (tok0 + lane) * PW + C_GV + h * 128 + (2 * w + 1) * 8);
    const int s16 = tid >> 4, c16 = tid & 15;
    R.g0 = ld16(PROJ + (tok0 + s16) * PW + C_GG + h * 128 + c16 * 8); R.g1 = ld16(PROJ + (tok0 + s16 + 32) * PW + C_GG + h * 128 + c16 * 8);
    const size_t sq = (((size_t)b * 4 + h) * 2) * 64 + n;
    const bf16_t* sp = KVS + sq * 8192 + (tid >> 2) * 64 + (tid & 3) * 16;
    R.sa0 = ld16(sp); R.sa1 = ld16(sp + 8); R.sb0 = ld16(sp + (size_t)64 * 8192); R.sb1 = ld16(sp + (size_t)64 * 8192 + 8);
    R.sq = SSQ[(size_t)(tid >> 6) * NTOK + tok0 + (tid & 63)];
}
__device__ __forceinline__ void gla_store_z(LAS unsigned char* lds, int tid, v4u z) {
    if (tid < 256) { LAS f32x4* zp = (LAS f32x4*)(lds + G_Z) + (tid >> 2) * 8 + (tid & 3) * 2;
        zp[0] = (f32x4){__uint_as_float(z.x << 16), __uint_as_float(z.x & 0xffff0000u), __uint_as_float(z.y << 16), __uint_as_float(z.y & 0xffff0000u)};
        zp[1] = (f32x4){__uint_as_float(z.z << 16), __uint_as_float(z.z & 0xffff0000u), __uint_as_float(z.w << 16), __uint_as_float(z.w & 0xffff0000u)}; }
}
__device__ __forceinline__ void gla_store_vt(LAS unsigned char* lds, int tid, v4u v0, v4u v1) {
    LAS bf16_t* VT = (LAS bf16_t*)(lds + G_VT); const int lane = tid & 63, e0 = (tid >> 6) * 16;
    const unsigned wv[8] = {v0.x, v0.y, v0.z, v0.w, v1.x, v1.y, v1.z, v1.w};
#pragma unroll
    for (int i = 0; i < 8; ++i) { VT[(e0 + 2 * i) * LDT + lane] = (bf16_t)(wv[i] & 0xffffu); VT[(e0 + 2 * i + 1) * LDT + lane] = (bf16_t)(wv[i] >> 16); }
}
constexpr int ZBS = 40, GL_UPT = 132096;
template <int DIR>
__device__ __forceinline__ void gla_cumsum3(LAS unsigned char* lds, float bias, int w, int lane, float (&bv)[2][4], float& bl) {
    const LAS bf16_t* ZB = (const LAS bf16_t*)(lds + G_Z); const LAS bf16_t* UPT = (const LAS bf16_t*)(lds + GL_UPT) + DIR * 64 * ZBS; LAS float* tot = (LAS float*)(lds + G_TOT);
    const int r16 = lane & 15, kg = lane >> 4, dcol = 16 * (w & 3) + r16, run0 = 8 * (w >> 2) + kg;
    const gbf16x8 bfr = *(const LAS gbf16x8*)(UPT + (16 * (w & 3) + r16) * ZBS + 8 * kg);
    float c[2][4];
#pragma unroll
    for (int j = 0; j < 2; ++j) {
        const gbf16x8 afr = *(const LAS gbf16x8*)(ZB + (32 * (w >> 2) + 16 * j + r16) * ZBS + 8 * kg);
        const gf32x4 acc = __builtin_amdgcn_mfma_f32_16x16x32_bf16(afr, bfr, (gf32x4){0.f, 0.f, 0.f, 0.f}, 0, 0, 0);
#pragma unroll
        for (int r = 0; r < 4; ++r) c[j][r] = log_sigmoid_f(acc[r] + bias) * (1.f / 16.f);
        if (DIR == 0) { c[j][1] += c[j][0]; c[j][2] += c[j][1]; c[j][3] += c[j][2]; tot[(run0 + 4 * j) * 64 + dcol] = c[j][3]; }
        else          { c[j][2] += c[j][3]; c[j][1] += c[j][2]; c[j][0] += c[j][1]; tot[(run0 + 4 * j) * 64 + dcol] = c[j][0]; }
    }
    __syncthreads();
    float off0 = 0.f, off1 = 0.f, all = 0.f;
#pragma unroll
    for (int q = 0; q < 16; ++q) { const float v = tot[q * 64 + dcol]; all += v;
        if (DIR ? (q > run0) : (q < run0)) off0 += v;
        if (DIR ? (q > run0 + 4) : (q < run0 + 4)) off1 += v; }
#pragma unroll
    for (int r = 0; r < 4; ++r) { bv[0][r] = c[0][r] + off0; bv[1][r] = c[1][r] + off1; }
    bl = all;
}
__device__ __forceinline__ void gla_store_zb(LAS unsigned char* lds, int tid, v4u z) { if (tid < 256) *(LAS v4u*)((LAS bf16_t*)(lds + G_Z) + (tid >> 2) * ZBS + (tid & 3) * 8) = z; }
__device__ __forceinline__ void gla_build_upt(LAS unsigned char* lds, int tid, int h, const float* upf, const float* upb) {
    LAS bf16_t* U0 = (LAS bf16_t*)(lds + GL_UPT); LAS bf16_t* U1 = U0 + 64 * ZBS;
    const int d = tid & 63, k0 = (tid >> 6) * 4;
    unsigned a0 = 0u, a1 = 0u, b0 = 0u, b1 = 0u;
    if (k0 < 16) { const float* p = upf + k0 * 256 + h * 64 + d; a0 = (unsigned)f2bf(p[0]) | ((unsigned)f2bf(p[256]) << 16); a1 = (unsigned)f2bf(p[512]) | ((unsigned)f2bf(p[768]) << 16); }
    else { const float* p = upb + (k0 - 16) * 256 + h * 64 + d; b0 = (unsigned)f2bf(p[0]) | ((unsigned)f2bf(p[256]) << 16); b1 = (unsigned)f2bf(p[512]) | ((unsigned)f2bf(p[768]) << 16); }
    *(LAS v2u*)(U0 + d * ZBS + k0) = (v2u){a0, a1}; *(LAS v2u*)(U1 + d * ZBS + k0) = (v2u){b0, b1};
}
__device__ __forceinline__ unsigned pk_bf2(float a, float b) { return (unsigned)f2bf(a) | ((unsigned)f2bf(b) << 16); }

__device__ __forceinline__ void gla_g3_phase(LAS unsigned char* lds, int tid, int bx, const bf16_t* PROJ, const float* upf, const float* bf_, const float* upb, const float* bb_, const bf16_t* KVS, const float* gain, bf16_t* MIXED, const float* SSQ, float* ratt) {
    const int n = bx & 63, h = (bx >> 6) & 3;
    const int d = tid & 63, tg = tid >> 6, lane = tid & 63, w = tid >> 6, s8 = tid >> 3, c8 = tid & 7;
    const int dcol = 16 * (w & 3) + (lane & 15), tk0 = 32 * (w >> 2) + 4 * (lane >> 4);
    const float bsF = bf_[h * 64 + dcol], bsB = bb_[h * 64 + dcol];
    gla_build_upt(lds, tid, h, upf, upb);
    float ge4[4];
#pragma unroll
    for (int r = 0; r < 4; ++r) ge4[r] = gain[16 * w + 4 * (lane >> 4) + r];
    LAS bf16_t* QE = (LAS bf16_t*)(lds + G_QE); LAS bf16_t* KE = (LAS bf16_t*)(lds + G_KE); LAS bf16_t* PP = (LAS bf16_t*)(lds + G_P);
    LAS bf16_t* VT = (LAS bf16_t*)(lds + G_VT); LAS bf16_t* GG = (LAS bf16_t*)(lds + G_G); LAS float* BM = (LAS float*)(lds + G_BM);
    LAS float* part = (LAS float*)(lds + G_PART); LAS float* rs = (LAS float*)(lds + G_TOT);
    GlaRaw3 R; gla_load3(R, tid, 0, h, n, PROJ, KVS, MIXED, SSQ);
    for (int b = 0; b < NB; ++b) {
        const size_t tok0 = (size_t)b * T + n * 64;
        const v4u cq = R.q, ck = R.k;
        gla_store_zb(lds, tid, R.z); gla_store_vt(lds, tid, R.v0, R.v1);
        { const int s16 = tid >> 4, c16 = tid & 15; *(LAS v4u*)(GG + s16 * 128 + c16 * 8) = R.g0; *(LAS v4u*)(GG + (s16 + 32) * 128 + c16 * 8) = R.g1; }
        { const int e = tid >> 2, p4 = tid & 3; LAS bf16_t* s0 = (LAS bf16_t*)(lds + G_ST0) + e * LDT + p4 * 16; LAS bf16_t* s1 = (LAS bf16_t*)(lds + G_ST1) + e * LDT + p4 * 16;
          *(LAS v4u*)s0 = R.sa0; *(LAS v4u*)(s0 + 8) = R.sa1; *(LAS v4u*)s1 = R.sb0; *(LAS v4u*)(s1 + 8) = R.sb1; }
        part[tid] = R.sq;
        if (b + 1 < NB) gla_load3(R, tid, b + 1, h, n, PROJ, KVS, MIXED, SSQ);
        __syncthreads();
        if (tid < 64) { float q = 0.f;
#pragma unroll
            for (int hh = 0; hh < 8; ++hh) q += part[hh * 64 + tid];
            const float ms = q * (1.f / 512.f) + EPS; ((LAS float*)(lds + 143360))[tid] = sqrtf(ms); if (h == 0) ratt[tok0 + tid] = rsqrtf(ms); }
        gf32x4 o[4];
#pragma unroll
        for (int rt = 0; rt < 4; ++rt) o[rt] = (gf32x4){0.f, 0.f, 0.f, 0.f};
#pragma unroll
        for (int dir = 0; dir < 2; ++dir) {
            float bv[2][4], bl;
            if (dir == 0) gla_cumsum3<0>(lds, bsF, w, lane, bv, bl); else gla_cumsum3<1>(lds, bsB, w, lane, bv, bl);
#pragma unroll
            for (int j = 0; j < 2; ++j)
#pragma unroll
                for (int r = 0; r < 4; ++r) BM[(tk0 + 16 * j + r) * BMS + dcol] = bv[j][r];
            __syncthreads();
            {
                const f32x4 b0 = *(const LAS f32x4*)(BM + s8 * BMS + c8 * 8), b1 = *(const LAS f32x4*)(BM + s8 * BMS + c8 * 8 + 4);
                const float bb[8] = {b0.x, b0.y, b0.z, b0.w, b1.x, b1.y, b1.z, b1.w};
                const unsigned qw[4] = {cq.x, cq.y, cq.z, cq.w}, kw[4] = {ck.x, ck.y, ck.z, ck.w};
                unsigned qo[4], ko[4];
#pragma unroll
                for (int j = 0; j < 4; ++j) {
                    const float e0 = exp_fast(bb[2 * j]), e1 = exp_fast(bb[2 * j + 1]);
                    qo[j] = pk_bf2(__uint_as_float(qw[j] << 16) * e0 * 0.125f, __uint_as_float(qw[j] & 0xffff0000u) * e1 * 0.125f);
                    ko[j] = pk_bf2(__uint_as_float(kw[j] << 16) * __builtin_amdgcn_rcpf(e0), __uint_as_float(kw[j] & 0xffff0000u) * __builtin_amdgcn_rcpf(e1));
                }
                *(LAS v4u*)(QE + s8 * LDT + c8 * 8) = (v4u){qo[0], qo[1], qo[2], qo[3]}; *(LAS v4u*)(KE + s8 * LDT + c8 * 8) = (v4u){ko[0], ko[1], ko[2], ko[3]};
            }
            __syncthreads();
            { const int ct = w >> 1;
#pragma unroll
              for (int j = 0; j < 2; ++j) { const int st = 2 * (w & 1) + j;
                gf32x4 acc = {0.f, 0.f, 0.f, 0.f};
                acc = mfma_tile64(KE + (16 * st) * LDT, QE + (16 * ct) * LDT, acc, lane);
                const int c = 16 * ct + (lane & 15), s0 = 16 * st + 4 * (lane >> 4);
                float pv[4];
#pragma unroll
                for (int r = 0; r < 4; ++r) { const int s = s0 + r; const bool keep = dir ? (s >= c) : (s <= c); pv[r] = keep ? acc[r] : 0.f; }
                *(LAS v2u*)(PP + c * LDT + s0) = (v2u){pk_bf2(pv[0], pv[1]), pk_bf2(pv[2], pv[3])}; } }
            __syncthreads();
            const LAS bf16_t* ST = (const LAS bf16_t*)(lds + (dir ? G_ST1 : G_ST0));
#pragma unroll
            for (int rt = 0; rt < 4; ++rt) {
                o[rt] = mfma_tile64(VT + (16 * w) * LDT, PP + (16 * rt) * LDT, o[rt], lane);
                o[rt] = mfma_tile64(ST + (16 * w) * LDT, QE + (16 * rt) * LDT, o[rt], lane);
            }
        }
#pragma unroll
        for (int rt = 0; rt < 4; ++rt) {
            float ss = o[rt][0] * o[rt][0] + o[rt][1] * o[rt][1] + o[rt][2] * o[rt][2] + o[rt][3] * o[rt][3];
            ss += __shfl_xor(ss, 16); ss += __shfl_xor(ss, 32);
            if (lane < 16) part[w * 64 + 16 * rt + lane] = ss;
        }
        __syncthreads();
        if (tid < 64) { float ss = 0.f;
#pragma unroll
            for (int t2 = 0; t2 < 8; ++t2) ss += part[t2 * 64 + tid];
            rs[tid] = rsqrtf(ss * (1.f / 128.f) + EPS) * ((LAS float*)(lds + 143360))[tid]; }
        __syncthreads();
#pragma unroll
        for (int rt = 0; rt < 4; ++rt) { const int c = 16 * rt + (lane & 15), e0 = 16 * w + 4 * (lane >> 4);
            const v2u gw2 = *(const LAS v2u*)(GG + c * 128 + e0);
            const float gv[4] = {__uint_as_float(gw2.x << 16), __uint_as_float(gw2.x & 0xffff0000u), __uint_as_float(gw2.y << 16), __uint_as_float(gw2.y & 0xffff0000u)};
            const float rc = rs[c]; float ov[4];
#pragma unroll
            for (int r = 0; r < 4; ++r) ov[r] = o[rt][r] * rc * ge4[r] * gv[r] * __builtin_amdgcn_rcpf(1.f + exp_fast(-gv[r]));
            *(GAS v2u*)(MIXED + (tok0 + c) * D + 512 + h * 128 + e0) = (v2u){pk_bf2(ov[0], ov[1]), pk_bf2(ov[2], ov[3])}; }
        __syncthreads();
    }
}
__device__ __forceinline__ void gla_load1(GlaRaw1& R, int tid, int b, int h, int n, const bf16_t* PROJ) {
    const size_t tok0 = (size_t)b * T + n * 64;
    const int s8 = tid >> 3, c8 = tid & 7, lane = tid & 63, w = tid >> 6;
    R.k = ld16(PROJ + (tok0 + s8) * PW + C_GK + h * 64 + c8 * 8);
    R.z = ld16(PROJ + (tok0 + ((tid >> 2) & 63)) * PW + C_ZF + (tid & 3) * 8);
    R.v0 = ld16(PROJ + (tok0 + lane) * PW + C_GV + h * 128 + (2 * w) * 8); R.v1 = ld16(PROJ + (tok0 + lane) * PW + C_GV + h * 128 + (2 * w + 1) * 8);
}
__device__ __forceinline__ void gla_g1_phase(LAS unsigned char* lds, int tid, int bx, const bf16_t* PROJ, const float* upf, const float* bf_, const float* upb, const float* bb_, bf16_t* KVS, float* DEC) {
    const int n = bx & 63, h = (bx >> 6) & 3;
    const int d = tid & 63, tg = tid >> 6, lane = tid & 63, w = tid >> 6, s8 = tid >> 3, c8 = tid & 7;
    const int dcol = 16 * (w & 3) + (lane & 15), tk0 = 32 * (w >> 2) + 4 * (lane >> 4);
    const float bsF = bf_[h * 64 + dcol], bsB = bb_[h * 64 + dcol];
    gla_build_upt(lds, tid, h, upf, upb);
    LAS bf16_t* KR = (LAS bf16_t*)(lds + G_G); LAS bf16_t* KET = (LAS bf16_t*)(lds + G_QE); LAS bf16_t* VT = (LAS bf16_t*)(lds + G_VT);
    GlaRaw1 R; gla_load1(R, tid, 0, h, n, PROJ);
    for (int b = 0; b < NB; ++b) {
        gla_store_zb(lds, tid, R.z); gla_store_vt(lds, tid, R.v0, R.v1);
        *(LAS v4u*)(KR + s8 * LDT + c8 * 8) = R.k;
        if (b + 1 < NB) gla_load1(R, tid, b + 1, h, n, PROJ);
        __syncthreads();
#pragma unroll
        for (int dir = 0; dir < 2; ++dir) {
            float bv[2][4], bl;
            if (dir == 0) gla_cumsum3<0>(lds, bsF, w, lane, bv, bl); else gla_cumsum3<1>(lds, bsB, w, lane, bv, bl);
#pragma unroll
            for (int j = 0; j < 2; ++j) {
                const int t0 = tk0 + 16 * j;
                const unsigned p0 = pk_bf2(bf2f(KR[(t0 + 0) * LDT + dcol]) * exp_fast(bl - bv[j][0]), bf2f(KR[(t0 + 1) * LDT + dcol]) * exp_fast(bl - bv[j][1]));
                const unsigned p1 = pk_bf2(bf2f(KR[(t0 + 2) * LDT + dcol]) * exp_fast(bl - bv[j][2]), bf2f(KR[(t0 + 3) * LDT + dcol]) * exp_fast(bl - bv[j][3]));
                *(LAS v2u*)(KET + dcol * LDT + t0) = (v2u){p0, p1};
            }
            const size_t sq = (((size_t)b * 4 + h) * 2 + dir) * 64 + n;
            if (w < 4 && lane < 16) DEC[sq * 64 + dcol] = exp_fast(bl);
            __syncthreads();
            bf16_t* kvo = KVS + sq * 8192;
#pragma unroll
            for (int dt = 0; dt < 4; ++dt) {
                gf32x4 acc = {0.f, 0.f, 0.f, 0.f};
                acc = mfma_tile64(KET + (16 * dt) * LDT, VT + (16 * w) * LDT, acc, lane);
                *(GAS v2u*)(kvo + (size_t)(16 * w + (lane & 15)) * 64 + 16 * dt + 4 * (lane >> 4)) = (v2u){pk_bf2(acc[0], acc[1]), pk_bf2(acc[2], acc[3])};
            }
        }
        __syncthreads();
    }
}
#include <hip/hip_bf16.h>
#include <cmath>
namespace attn_body {
using bf16=__hip_bfloat16;
using bf16x8=__attribute__((ext_vector_type(8)))short;
using s16x4=__attribute__((ext_vector_type(4)))short;
using f32x16=__attribute__((ext_vector_type(16)))float;
using u32x4=__attribute__((ext_vector_type(4)))unsigned;
constexpr int BATCH=8,NHEAD=8,SEQ=4096,D=64,DM=2560,OP=1024;
constexpr int NW=8,QBLK=32,QB=QBLK*NW,KVBLK=64,NQB=SEQ/QB;
constexpr int ATTN_PITCH=DM, ATTN_UNIT_ROWS=QB;
__device__ __forceinline__ int crow(int r,int hi){return (r&3)+8*(r>>2)+4*hi;}
#define SBAR() __builtin_amdgcn_sched_barrier(0)
__device__ __forceinline__ void cmask(f32x16&p0,f32x16&p1,int jb,int qrel,int hi){
  const float NEG=-INFINITY; int kb=64*jb+4*hi;
  #pragma unroll
  for(int r=0;r<16;++r){int kv=kb+(r&3)+8*(r>>2); if(kv>qrel)p0[r]=NEG; if(kv+32>qrel)p1[r]=NEG;}
}

constexpr int NSLOT=3, SLOTB=8192;
constexpr int LDS_K=0, LDS_V=NSLOT*SLOTB, LDS_WS=2*NSLOT*SLOTB, LDS_OST=LDS_WS+NW*64*4, LDS_BYTES=LDS_OST+NW*4096;
constexpr bool FIXREF=true;
constexpr float C2=0.125f*1.4426950408889634f;
__device__ __forceinline__ void glds16(const void*gsrc,unsigned lds_dst){unsigned keep;
  asm volatile("s_mov_b32 %0, m0\n\ts_mov_b32 m0, %2\n\ts_nop 0\n\tglobal_load_lds_dwordx4 %1, off\n\ts_mov_b32 m0, %0":"=&s"(keep):"v"(gsrc),"s"(lds_dst):"memory");}
__device__ __forceinline__ float max3f(float a,float b,float c){float r;asm("v_max3_f32 %0, %1, %2, %3":"=v"(r):"v"(a),"v"(b),"v"(c));return r;}
__device__ __forceinline__ float max2f(float a,float b){float r;asm("v_max_f32_e32 %0, %1, %2":"=v"(r):"v"(a),"v"(b));return r;}
__device__ __forceinline__ float fadd_s(float a,float b){float r;asm("v_add_f32_e32 %0, %1, %2":"=v"(r):"v"(a),"v"(b));return r;}
__device__ __forceinline__ float fsub_s(float a,float b){float r;asm("v_sub_f32_e32 %0, %1, %2":"=v"(r):"v"(a),"v"(b));return r;}
typedef float f32x2_t __attribute__((ext_vector_type(2))); typedef __bf16 bf16x2_t __attribute__((ext_vector_type(2)));
__device__ __forceinline__ unsigned cvtpk_s(float lo,float hi){f32x2_t v={lo,hi};bf16x2_t b=__builtin_convertvector(v,bf16x2_t);return __builtin_bit_cast(unsigned,b);}
#define WAIT_BAR(N) asm volatile("s_waitcnt vmcnt(" #N ") lgkmcnt(0)\n\ts_barrier":::"memory")

__device__ __forceinline__ void qkt(f32x16&p0,f32x16&p1,const char*Kslot,const bf16x8*qr,const f32x16&negm,int r32,int hi){
  const char*kb=Kslot+r32*128; const int xs=(r32>>1)&7;
  #pragma unroll
  for(int d0=0;d0<4;++d0){
    const bf16x8 b0=*reinterpret_cast<const bf16x8*>(kb+(((2*d0+hi)^xs)<<4));
    const bf16x8 b1=*reinterpret_cast<const bf16x8*>(kb+(((2*d0+hi)^xs)<<4)+4096);
    if(d0==0){p0=__builtin_amdgcn_mfma_f32_32x32x16_bf16(b0,qr[0],negm,0,0,0);p1=__builtin_amdgcn_mfma_f32_32x32x16_bf16(b1,qr[0],negm,0,0,0);}
    else{p0=__builtin_amdgcn_mfma_f32_32x32x16_bf16(b0,qr[d0],p0,0,0,0);p1=__builtin_amdgcn_mfma_f32_32x32x16_bf16(b1,qr[d0],p1,0,0,0);}}
}
typedef __attribute__((address_space(3))) const char* lds_cptr;
typedef short v4i16_t __attribute__((ext_vector_type(4)));
struct KBases { int o[4]; };
__device__ __forceinline__ void kload8(bf16x8*kf,lds_cptr kring,const KBases&kb,int sl){
  #pragma unroll
  for(int d0=0;d0<4;++d0){ kf[2*d0]=*(const __attribute__((address_space(3))) bf16x8*)(kring+kb.o[d0]+sl); kf[2*d0+1]=*(const __attribute__((address_space(3))) bf16x8*)(kring+kb.o[d0]+sl+4096); }
}
__device__ __forceinline__ void kload2(bf16x8*kf,lds_cptr kring,const KBases&kb,int sl,int j){ kf[2*j]=*(const __attribute__((address_space(3))) bf16x8*)(kring+kb.o[j]+sl); kf[2*j+1]=*(const __attribute__((address_space(3))) bf16x8*)(kring+kb.o[j]+sl+4096); }
__device__ __forceinline__ s16x4 vtr(lds_cptr p){ return __builtin_bit_cast(s16x4,__builtin_amdgcn_ds_read_tr16_b64_v4i16((__attribute__((address_space(3))) v4i16_t*)p)); }
__device__ __forceinline__ float rowmax(const f32x16&p0,const f32x16&p1){
  float a=max3f(p0[0],p0[1],p1[0]),b=max3f(p0[2],p0[3],p1[1]);a=max3f(a,p1[2],p1[3]);
  #pragma unroll
  for(int r=4;r<16;r+=4){a=max3f(a,p0[r],p0[r+1]);b=max3f(b,p0[r+2],p0[r+3]);a=max3f(a,p1[r],p1[r+1]);b=max3f(b,p1[r+2],p1[r+3]);}
  const float m=max2f(a,b);
  auto rr=__builtin_amdgcn_permlane32_swap(__float_as_uint(m),__float_as_uint(m),false,false);
  return max2f(__uint_as_float(rr[0]),__uint_as_float(rr[1]));
}
__device__ __forceinline__ void pv(f32x16*o,int vb,bf16x8 pa0,bf16x8 pa1,bf16x8 pa2,bf16x8 pa3){
  #pragma unroll
  for(int d0=0;d0<2;++d0){s16x4 lo[4],hi[4];
    #pragma unroll
    for(int ks=0;ks<4;++ks){
      asm volatile("ds_read_b64_tr_b16 %0,%1 offset:%c2":"=&v"(lo[ks]):"v"(vb),"i"(d0*4096+ks*1024):"memory");
      asm volatile("ds_read_b64_tr_b16 %0,%1 offset:%c2":"=&v"(hi[ks]):"v"(vb),"i"(d0*4096+ks*1024+512):"memory");}
    asm volatile("s_waitcnt lgkmcnt(0)":::"memory");SBAR();
    #define PK(k) (bf16x8){lo[k][0],lo[k][1],lo[k][2],lo[k][3],hi[k][0],hi[k][1],hi[k][2],hi[k][3]}
    o[d0]=__builtin_amdgcn_mfma_f32_32x32x16_bf16(pa0,PK(0),o[d0],0,0,0);
    o[d0]=__builtin_amdgcn_mfma_f32_32x32x16_bf16(pa1,PK(1),o[d0],0,0,0);
    o[d0]=__builtin_amdgcn_mfma_f32_32x32x16_bf16(pa2,PK(2),o[d0],0,0,0);
    o[d0]=__builtin_amdgcn_mfma_f32_32x32x16_bf16(pa3,PK(3),o[d0],0,0,0);
    #undef PK
  }
}

#ifndef ATTN_STORE16
#define ATTN_STORE16(p,v) (*(u32x4*)(p)=(v))
#endif
template<int THRL> __device__ __forceinline__ void attn_unit(int b,int h,int qb,const bf16*Q,const bf16*__restrict__ K,const bf16*__restrict__ V,bf16*O,char*shm,const float*qg,const float*rope,float*ssq,float sbound){
  const int tid=threadIdx.x,lane=tid&63,r32=lane&31,hi=lane>>5; const int wid=__builtin_amdgcn_readfirstlane(tid>>6);
  const long rowbase=(long)b*SEQ; const int q0=qb*QB;
  const bf16*Qw=Q+(rowbase+q0+wid*QBLK)*DM+h*D;
  const bf16*Kh=K+rowbase*DM+(h>>2)*D,*Vh=V+rowbase*DM+(h>>2)*D;
  const unsigned lds0=(unsigned)(uintptr_t)shm;
  float*wsf=(float*)(shm+LDS_WS)+wid*64;
  const unsigned koff=(unsigned)((8*wid+(lane>>3))*DM+(((lane&7)^((4*wid+(lane>>4))&7))*8)),
  voff_dummy_=0u, voff=(unsigned)((16*(wid&3)+(lane>>2))*DM+(wid>>2)*32+(lane&3)*8);
  const unsigned kdst=lds0+LDS_K+wid*1024, vdst=lds0+LDS_V+wid*1024;
  #define DMA_K(t,slot) glds16(Kh+(long)(t)*KVBLK*DM+koff,(unsigned)__builtin_amdgcn_readfirstlane(kdst+(slot)))
  #define DMA_V(t,slot) glds16(Vh+(long)(t)*KVBLK*DM+voff,(unsigned)__builtin_amdgcn_readfirstlane(vdst+(slot)))
  const int vb0=(int)(lds0+LDS_V)+((lane>>4)&1)*32+(lane&3)*8+(4*hi+((lane&15)>>2))*64;
  const char*Kbase=shm+LDS_K; bf16x8 kf[8];
  const lds_cptr shm3=(lds_cptr)shm; const lds_cptr kring=shm3+LDS_K; KBases kbs; _Pragma("unroll") for(int d0=0;d0<4;++d0)kbs.o[d0]=r32*128+(((2*d0+hi)^((r32>>1)&7))<<4); const lds_cptr vp0=shm3+LDS_V+((lane>>4)&1)*32+(lane&3)*8+(4*hi+((lane&15)>>2))*64;
  const int NT=SEQ/KVBLK;
  DMA_K(0,0);DMA_V(0,0);DMA_K(1,SLOTB);
  bf16x8 qr[4];
  #pragma unroll
  for(int d0=0;d0<4;++d0)qr[d0]=*reinterpret_cast<const bf16x8*>(&Qw[(long)r32*DM+d0*16+hi*8]);
  {
    float x[4][8]; float ss=0.f;
    #pragma unroll
    for(int d0=0;d0<4;++d0){
      #pragma unroll
      for(int j=0;j<8;++j){ x[d0][j]=__uint_as_float(((unsigned)(unsigned short)qr[d0][j])<<16); ss+=x[d0][j]*x[d0][j]; } }
    ss+=__shfl_xor(ss,32);
    const float rstd=rsqrtf(ss*(1.f/64.f)+1e-6f);
    const int tt=q0+wid*QBLK+r32, prow=tt>>6, pcol=tt&63;
    #pragma unroll
    for(int d0=0;d0<4;++d0){
      const float4 g0=*reinterpret_cast<const float4*>(qg+d0*16+hi*8), g1=*reinterpret_cast<const float4*>(qg+d0*16+hi*8+4);
      const int pos=(d0<2)?prow:pcol, i0=8*(d0&1)+4*hi;
      const float4 c4=*reinterpret_cast<const float4*>(rope+pos*16+i0), s4=*reinterpret_cast<const float4*>(rope+1024+pos*16+i0);
      const float gg[8]={g0.x,g0.y,g0.z,g0.w,g1.x,g1.y,g1.z,g1.w}, cc[4]={c4.x,c4.y,c4.z,c4.w}, sn[4]={s4.x,s4.y,s4.z,s4.w};
      u32x4 pw;
      #pragma unroll
      for(int jj=0;jj<4;++jj){ const float y0=x[d0][2*jj]*rstd*gg[2*jj], y1=x[d0][2*jj+1]*rstd*gg[2*jj+1];
        pw[jj]=cvtpk_s((y0*cc[jj]-y1*sn[jj])*C2,(y0*sn[jj]+y1*cc[jj])*C2); }
      qr[d0]=__builtin_bit_cast(bf16x8,pw); } }
  float mhat=0.f,l_reg=0.f;f32x16 o[2];o[0]=f32x16{};o[1]=f32x16{};f32x16 negm; _Pragma("unroll") for(int r=0;r<16;++r)negm[r]=FIXREF?-sbound:0.f; asm volatile("":"+v"(negm));

  #define CMASK(P0,P1,t) do{}while(0)
  bool resc=false;
  #define START(P0,P1) do{ resc=false; if(!FIXREF) \
    { const float rm=rowmax(P0,P1); const float dl=rm; mhat=fadd_s(mhat,dl); \
      _Pragma("unroll") for(int r=0;r<16;++r){P0[r]=fsub_s(P0[r],dl);P1[r]=fsub_s(P1[r],dl);} \
      _Pragma("unroll") for(int r=0;r<16;++r)negm[r]=-mhat; asm volatile("":"+v"(negm)); } \
    _Pragma("unroll") for(int r=0;r<16;++r)P0[r]=__builtin_amdgcn_exp2f(P0[r]); }while(0)
  #define RESC() do{ if(resc){ asm volatile("s_waitcnt lgkmcnt(0)":::"memory"); \
      _Pragma("unroll") for(int d_=0;d_<2;++d_) _Pragma("unroll") for(int r=0;r<16;++r)o[d_][r]*=wsf[crow(r,hi)]; } }while(0)
  f32x16 pA0,pA1,pB0,pB1;
  int sl_prev=0,sl_cur=0,sl_next=SLOTB;
  #define ROT() do{sl_prev=sl_cur;sl_cur=sl_next;sl_next=(sl_next==(NSLOT-1)*SLOTB)?0:sl_next+SLOTB;}while(0)
  DMA_K(2,2*SLOTB);
  WAIT_BAR(3);
  qkt(pA0,pA1,Kbase,qr,negm,r32,hi);asm volatile("s_nop 15\n\ts_nop 7":"+v"(pA0),"+v"(pA1));CMASK(pA0,pA1,0);
  START(pA0,pA1);
  _Pragma("unroll") for(int r=0;r<16;++r)pA1[r]=__builtin_amdgcn_exp2f(pA1[r]);
  WAIT_BAR(0);
  DMA_K(3,0);DMA_V(1,SLOTB);
  ROT();
  kload8(kf,kring,kbs,sl_cur);
  WAIT_BAR(2);
  s16x4 vlo[8],vhi[8]; u32x4 pw0,pw1,pw2,pw3;
  #define PKW(P,B) cvtpk_s(P[B],P[B+1])
  #define PAF(k) __builtin_bit_cast(bf16x8,pw##k)
  #define VFR(i) (bf16x8){vlo[i][0],vlo[i][1],vlo[i][2],vlo[i][3],vhi[i][0],vhi[i][1],vhi[i][2],vhi[i][3]}
  #define PIN(x) asm volatile("":"+v"(x))
  #define MX3(a,b,c) __builtin_fmaxf(__builtin_fmaxf((a),(b)),(c))
  #define GAPA(MF,A0,A1,A2,A3,W0,W1,PW) do{ MF; sacc+=A0; sacc+=A1; sacc+=A2; sacc+=A3; PIN(sacc); W0; W1; PIN(PW); SBAR(); }while(0)
  #define EX(v) __builtin_amdgcn_exp2f(v)
  #define GAPB(MF,X,B) do{ MF; X[B]=EX(X[B]); X[B+1]=EX(X[B+1]); X[B+2]=EX(X[B+2]); X[B+3]=EX(X[B+3]); PIN(X); SBAR(); }while(0)
  #define VRD(i) do{ vlo[i]=vtr(vp_+(((i)>>2)*4096+((i)&3)*1024)); vhi[i]=vtr(vp_+(((i)>>2)*4096+((i)&3)*1024+512)); }while(0)
  #define KRD(G,j) do{ if(G){ kload2(kf,kring,kbs,sl_next,j); SBAR(); } }while(0)
  #define STEP(C0,C1,P0,P1,t,GK,GV,GL) do{ SBAR(); \
    const lds_cptr vp_=vp0+sl_prev; \
    VRD(0); SBAR(); float sacc=(P0[0]+P0[1]); \
    GAPA(C0=__builtin_amdgcn_mfma_f32_32x32x16_bf16(kf[0],qr[0],negm,0,0,0), P0[2],P0[3],P0[4],P0[5],     pw0[0]=PKW(P0,0), pw0[1]=PKW(P0,2), pw0); \
    VRD(4); SBAR(); GAPA(C1=__builtin_amdgcn_mfma_f32_32x32x16_bf16(kf[1],qr[0],negm,0,0,0), P0[6],P0[7],P0[8],P0[9],     pw0[2]=PKW(P0,4), pw0[3]=PKW(P0,6), pw0); \
    VRD(1); SBAR(); GAPA(C0=__builtin_amdgcn_mfma_f32_32x32x16_bf16(kf[2],qr[1],C0,0,0,0),   P0[10],P0[11],P0[12],P0[13], pw1[0]=PKW(P0,8), pw1[1]=PKW(P0,10), pw1); \
    VRD(5); SBAR(); GAPA(C1=__builtin_amdgcn_mfma_f32_32x32x16_bf16(kf[3],qr[1],C1,0,0,0),   P0[14],P0[15],P1[0],P1[1],   pw1[2]=PKW(P0,12),pw1[3]=PKW(P0,14), pw1); \
    VRD(2); SBAR(); GAPA(C0=__builtin_amdgcn_mfma_f32_32x32x16_bf16(kf[4],qr[2],C0,0,0,0),   P1[2],P1[3],P1[4],P1[5],     pw2[0]=PKW(P1,0), pw2[1]=PKW(P1,2), pw2); \
    VRD(6); SBAR(); GAPA(C1=__builtin_amdgcn_mfma_f32_32x32x16_bf16(kf[5],qr[2],C1,0,0,0),   P1[6],P1[7],P1[8],P1[9],     pw2[2]=PKW(P1,4), pw2[3]=PKW(P1,6), pw2); \
    VRD(3); SBAR(); GAPA(C0=__builtin_amdgcn_mfma_f32_32x32x16_bf16(kf[6],qr[3],C0,0,0,0),   P1[10],P1[11],P1[12],P1[13], pw3[0]=PKW(P1,8), pw3[1]=PKW(P1,10), pw3); \
    VRD(7); SBAR(); GAPA(C1=__builtin_amdgcn_mfma_f32_32x32x16_bf16(kf[7],qr[3],C1,0,0,0),   P1[14],P1[15],0.f,0.f,       pw3[2]=PKW(P1,12),pw3[3]=PKW(P1,14), pw3); \
    l_reg+=sacc; \
    if(GK){DMA_K((t)+3,sl_cur);} if(GV){DMA_V((t)+1,sl_next);} \
    CMASK(C0,C1,t); \
    if(!FIXREF){ float a=MX3(C0[0],C0[1],C1[0]),b=MX3(C0[2],C0[3],C1[1]); a=MX3(a,C1[2],C1[3]); \
      _Pragma("unroll") for(int r=4;r<16;r+=4){a=MX3(a,C0[r],C0[r+1]);b=MX3(b,C0[r+2],C0[r+3]);a=MX3(a,C1[r],C1[r+1]);b=MX3(b,C1[r+2],C1[r+3]);} \
      float rm=__builtin_fmaxf(a,b); { auto rr=__builtin_amdgcn_permlane32_swap(__float_as_uint(rm),__float_as_uint(rm),false,false); rm=__builtin_fmaxf(__uint_as_float(rr[0]),__uint_as_float(rr[1])); } \
      resc=false; \
      if(__builtin_expect(__any(rm>(float)THRL),0)){ const float dl=__builtin_fmaxf(rm,0.f); mhat+=dl; \
        _Pragma("unroll") for(int r=0;r<16;++r){C0[r]-=dl;C1[r]-=dl;} \
        _Pragma("unroll") for(int r=0;r<16;++r)negm[r]=-mhat; asm volatile("":"+v"(negm)); \
        const float f=__builtin_amdgcn_exp2f(-dl); l_reg*=f; if(hi==0)wsf[r32]=f; resc=true; } } \
    SBAR(); \
    GAPB(o[0]=__builtin_amdgcn_mfma_f32_32x32x16_bf16(PAF(0),VFR(0),o[0],0,0,0), C0,0); \
    GAPB(o[1]=__builtin_amdgcn_mfma_f32_32x32x16_bf16(PAF(0),VFR(4),o[1],0,0,0), C0,4); \
    KRD(GL,0); GAPB(o[0]=__builtin_amdgcn_mfma_f32_32x32x16_bf16(PAF(1),VFR(1),o[0],0,0,0), C0,8); \
    KRD(GL,1); GAPB(o[1]=__builtin_amdgcn_mfma_f32_32x32x16_bf16(PAF(1),VFR(5),o[1],0,0,0), C0,12); \
    KRD(GL,2); GAPB(o[0]=__builtin_amdgcn_mfma_f32_32x32x16_bf16(PAF(2),VFR(2),o[0],0,0,0), C1,0); \
    KRD(GL,3); GAPB(o[1]=__builtin_amdgcn_mfma_f32_32x32x16_bf16(PAF(2),VFR(6),o[1],0,0,0), C1,4); \
    GAPB(o[0]=__builtin_amdgcn_mfma_f32_32x32x16_bf16(PAF(3),VFR(3),o[0],0,0,0), C1,8); \
    GAPB(o[1]=__builtin_amdgcn_mfma_f32_32x32x16_bf16(PAF(3),VFR(7),o[1],0,0,0), C1,12); \
    }while(0)
  int t=1;
  #undef CMASK
  #define CMASK(P0,P1,t) do{}while(0)
  for(;t+5<NT;t+=2){
    STEP(pB0,pB1,pA0,pA1,t,true,true,true);     WAIT_BAR(2); RESC(); ROT();
    STEP(pA0,pA1,pB0,pB1,t+1,true,true,true);   WAIT_BAR(2); RESC(); ROT();
  }
  #undef CMASK
  #define CMASK(P0,P1,t) do{}while(0)
  #define ENDW(tt) do{ if((tt)+3<NT){WAIT_BAR(2);} else if((tt)+2<NT){WAIT_BAR(1);} else {WAIT_BAR(0);} }while(0)
  for(;t+1<NT;t+=2){
    STEP(pB0,pB1,pA0,pA1,t,(t+3<NT),(t+1<NT),(t+1<NT));       ENDW(t);   RESC(); ROT();
    STEP(pA0,pA1,pB0,pB1,t+1,(t+4<NT),(t+2<NT),(t+2<NT));     ENDW(t+1); RESC(); ROT();
  }
  STEP(pB0,pB1,pA0,pA1,NT-1,false,false,false); RESC();
  { float sacc=pB0[0]+pB0[1]; _Pragma("unroll") for(int r=2;r<16;++r)sacc+=pB0[r]; _Pragma("unroll") for(int r=0;r<16;++r)sacc+=pB1[r]; l_reg+=sacc;
    pw0=(u32x4){PKW(pB0,0),PKW(pB0,2),PKW(pB0,4),PKW(pB0,6)};pw1=(u32x4){PKW(pB0,8),PKW(pB0,10),PKW(pB0,12),PKW(pB0,14)};pw2=(u32x4){PKW(pB1,0),PKW(pB1,2),PKW(pB1,4),PKW(pB1,6)};pw3=(u32x4){PKW(pB1,8),PKW(pB1,10),PKW(pB1,12),PKW(pB1,14)};
    SBAR(); pv(o,vb0+sl_cur,PAF(0),PAF(1),PAF(2),PAF(3)); }
  #undef PKW
  #undef PAF
  #undef VFR
  #undef PIN
  #undef MX3
  #undef GAPA
  #undef GAPB
  #undef EX
  #undef VRD
  #undef KRD
  #undef STEP
  #undef ENDW
  {auto rr=__builtin_amdgcn_permlane32_swap(__float_as_uint(l_reg),__float_as_uint(l_reg),false,false);l_reg=__uint_as_float(rr[0])+__uint_as_float(rr[1]);}
  if(hi==0)wsf[32+r32]=l_reg;asm volatile("s_waitcnt lgkmcnt(0)":::"memory");
  float rli[16];
  #pragma unroll
  for(int r=0;r<16;++r)rli[r]=__builtin_amdgcn_rcpf(wsf[32+crow(r,hi)]);
  bf16*Ow=O+(rowbase+q0+wid*QBLK)*OP+h*D;
  { bf16*stg=(bf16*)(shm+LDS_OST)+wid*2048;
    #pragma unroll
    for(int r=0;r<16;++r){const int orow=crow(r,hi);
      #pragma unroll
      for(int d0=0;d0<2;++d0)stg[orow*64+d0*32+r32]=__float2bfloat16(o[d0][r]*rli[r]);}
    asm volatile("s_waitcnt lgkmcnt(0)":::"memory");
    #pragma unroll
    for(int i=0;i<4;++i){const int row=i*8+(lane>>3),ch=lane&7; const u32x4 v=*(const u32x4*)(stg+row*64+ch*8); ATTN_STORE16(Ow+(long)row*OP+ch*8,v);
      float sq=0.f;
      #pragma unroll
      for(int k=0;k<4;++k){ const float lo=__uint_as_float(v[k]<<16), hi_=__uint_as_float(v[k]&0xffff0000u); sq+=lo*lo+hi_*hi_; }
      sq+=__shfl_xor(sq,1); sq+=__shfl_xor(sq,2); sq+=__shfl_xor(sq,4);
      if(ch==0) ssq[(long)h*(BATCH*SEQ)+rowbase+q0+wid*QBLK+row]=sq; } }
  asm volatile("s_waitcnt lgkmcnt(0)\n\ts_barrier":::"memory");
  #undef DMA_K
  #undef DMA_V
  #undef CMASK
  #undef START
  #undef RESC
  #undef ROT
}
constexpr int ATTN_LDS_BYTES=LDS_BYTES;
struct AttnTensors { const bf16* Q; const bf16* K; const bf16* V; bf16* O; const float* qg; const float* rope; float* ssq; float sbound; };
struct AttnUnit { int bh; int qb; };
struct StaticOrder {
  int vcu;
  __device__ __forceinline__ explicit StaticOrder(int grid,int block):vcu((block%8)*(grid/8)+block/8){}
  __device__ __forceinline__ bool next(int i,AttnUnit&u)const{ if(i>=4)return false; const int pair=vcu>>4, c16=vcu&15; u.bh=(pair>>1)*NHEAD+(pair&1)*4+(c16>>2); u.qb=(c16&3)*4+i; return true; }
  __device__ __forceinline__ void a_ready(const AttnUnit&)const{}
  __device__ __forceinline__ void done(const AttnUnit&)const{}
};
template<class Sched,int THRL=8> __device__ __forceinline__ void attn_phase(char*lds,const AttnTensors&T,const Sched&S){
  AttnUnit u;
  for(int i=0;S.next(i,u);++i){ S.a_ready(u); attn_unit<THRL>(u.bh/NHEAD,u.bh%NHEAD,u.qb,T.Q,T.K,T.V,T.O,lds,T.qg,T.rope,T.ssq,T.sbound); S.done(u); }
}
#undef SBAR
#undef WAIT_BAR
}

constexpr int NWAVES = 8;
constexpr int RING_OFF = 0, RING_BYTES = 131072;
constexpr int LDSCTL_OFF = RING_BYTES, MISC_OFF = LDSCTL_OFF + 320;
constexpr int LDS_BYTES = 147456;
constexpr int CW_BAR = 32768;
constexpr int MAX_LAUNCH = 8;
static_assert((CW_BAR + MAX_LAUNCH * XCD_BAR_WORDS) * 4 <= (int)(1 * MiB), "barrier words inside the memset region");
constexpr size_t WS_WINT = 4 * MiB;
constexpr size_t WS_WOUTT = 9 * MiB;
constexpr size_t WS_SSQ = 13 * MiB;
constexpr size_t WS_RSTD = 3 * MiB + 65536;
constexpr size_t WS_WGU = 16 * MiB;
constexpr size_t WS_WD = 144 * MiB;
constexpr int TAB_OFF = LDSCTL_OFF + 1024;
constexpr int XS_ROWS = NSLOT + 256;

constexpr int PROF_A = -1, PROF_B = -1;
constexpr int CW_PROF = 20000;
constexpr int FP8TEST = 0;
constexpr int NCONV = 136;
constexpr int CW_COUNTS2 = 70000, CW_CURSOR2 = 75000, CW_TILECNT = 90000;
constexpr int HIST_OFF = 49152, POS_OFF = 50176;
constexpr int REP0 = 1, REPG1 = 1, REPG3 = 1, REPATT = 1, REPM1 = 1, REPM2 = 1, REPP1 = 1, REPALL = 1, REPU = 1, REPP5 = 1, DRYQK = 0, DRYAN = 0, DRYSC = 0, DRYFIN = 0, DRYRT = 0;
struct Args { const float* in[21]; float* out; unsigned char* ws; int ph_lo, ph_hi, li, pad; };

struct Frame {
    LAS unsigned char* lds;
    volatile LAS unsigned* MISC;
    int tid, lane, wave, vcu, G;
};

template <bool NT = false>
__device__ __forceinline__ void p0_transpose_item(const float* W, int ldw, int k0, int ns0, bf16* WT, int K, int nd0, LAS float* scr, int lane) {
    if (ns0 >= 0) {
        f32x4 v[8];
#pragma unroll
        for (int i = 0; i < 8; ++i) { const GAS f32x4* p = (const GAS f32x4*)(W + (size_t)(k0 + 8 * i + (lane >> 3)) * ldw + ns0 + (lane & 7) * 4); v[i] = NT ? __builtin_nontemporal_load(p) : *p; }
#pragma unroll
        for (int i = 0; i < 8; ++i) { LAS float* p = scr + (8 * i + (lane >> 3)) * 33 + (lane & 7) * 4; p[0] = v[i].x; p[1] = v[i].y; p[2] = v[i].z; p[3] = v[i].w; }
    } else {
#pragma unroll 8
        for (int i = 0; i < 32; ++i) { const int kk = 2 * i + (lane >> 5); scr[kk * 33 + (lane & 31)] = 0.f; }
    }
    LDS_WAIT(); asm volatile("" ::: "memory");
    const int c = lane & 7;
#pragma unroll
    for (int j = 0; j < 4; ++j) { const int n = (lane >> 3) + 8 * j; const LAS float* s = scr + (8 * c) * 33 + n;
        v4u o; o.x = pk2(s[0 * 33], s[1 * 33]); o.y = pk2(s[2 * 33], s[3 * 33]); o.z = pk2(s[4 * 33], s[5 * 33]); o.w = pk2(s[6 * 33], s[7 * 33]);
        GAS v4u* q = (GAS v4u*)(WT + (size_t)(nd0 + n) * K + k0 + 8 * c); if (NT) __builtin_nontemporal_store(o, q); else *q = o; }
    LDS_WAIT(); asm volatile("" ::: "memory");
}

__device__ __forceinline__ void p0_transpose_item_wout(const float* W, int k0, int ns0, bf16* WT, const float* again, LAS float* scr, int lane) {
    f32x4 v[8];
#pragma unroll
    for (int i = 0; i < 8; ++i) { const int k = k0 + 8 * i + (lane >> 3); v[i] = *(const GAS f32x4*)(W + (size_t)k * D + ns0 + (lane & 7) * 4); if (k0 >= 512) v[i] = v[i] * again[k - 512]; }
#pragma unroll
    for (int i = 0; i < 8; ++i) { LAS float* p = scr + (8 * i + (lane >> 3)) * 33 + (lane & 7) * 4; p[0] = v[i].x; p[1] = v[i].y; p[2] = v[i].z; p[3] = v[i].w; }
    LDS_WAIT(); asm volatile("" ::: "memory");
    const int c = lane & 7, kd0 = (k0 + 512) & 1023;
#pragma unroll
    for (int j = 0; j < 4; ++j) { const int n = (lane >> 3) + 8 * j; const LAS float* sp = scr + (8 * c) * 33 + n;
        v4u o; o.x = pk2(sp[0 * 33], sp[1 * 33]); o.y = pk2(sp[2 * 33], sp[3 * 33]); o.z = pk2(sp[4 * 33], sp[5 * 33]); o.w = pk2(sp[6 * 33], sp[7 * 33]);
        *(GAS v4u*)(WT + (size_t)(ns0 + n) * D + kd0 + 8 * c) = o; }
    LDS_WAIT(); asm volatile("" ::: "memory");
}
struct ConvItem { const float* W; int ldw, k0, ns0; bf16* WT; int K, nd0; };
__device__ __forceinline__ void conv_load(const ConvItem& it, f32x4 (&v)[8], int lane) {
#pragma unroll
    for (int i = 0; i < 8; ++i) v[i] = __builtin_nontemporal_load((const GAS f32x4*)(it.W + (size_t)(it.k0 + 8 * i + (lane >> 3)) * it.ldw + it.ns0 + (lane & 7) * 4));
}
__device__ __forceinline__ void conv_finish(const ConvItem& it, const f32x4 (&v)[8], LAS float* scr, int lane) {
#pragma unroll
    for (int i = 0; i < 8; ++i) { LAS float* p = scr + (8 * i + (lane >> 3)) * 33 + (lane & 7) * 4; p[0] = v[i].x; p[1] = v[i].y; p[2] = v[i].z; p[3] = v[i].w; }
    LDS_WAIT(); asm volatile("" ::: "memory");
    const int c = lane & 7;
#pragma unroll
    for (int j = 0; j < 4; ++j) { const int n = (lane >> 3) + 8 * j; const LAS float* s = scr + (8 * c) * 33 + n;
        v4u o; o.x = pk2(s[0 * 33], s[1 * 33]); o.y = pk2(s[2 * 33], s[3 * 33]); o.z = pk2(s[4 * 33], s[5 * 33]); o.w = pk2(s[6 * 33], s[7 * 33]);
        __builtin_nontemporal_store(o, (GAS v4u*)(it.WT + (size_t)(it.nd0 + n) * it.K + it.k0 + 8 * c)); }
    LDS_WAIT(); asm volatile("" ::: "memory");
}
__device__ __forceinline__ ConvItem conv_item(int it, const float* wgate, const float* wup, const float* wdown, bf16* WguT, bf16* WdT) {
    constexpr int I_GU = NEXP * (D / 64) * (1024 / 32);
    ConvItem c;
    if (it < I_GU) { const int e = it >> 9, q = it & 511, kb = q >> 5, nb = q & 31, pn = nb >> 3, bj = (nb >> 2) & 1, c0 = (nb & 3) * 32;
        c.W = (bj ? wup : wgate) + (size_t)e * D * DEXP; c.ldw = DEXP; c.k0 = kb * 64; c.ns0 = pn * 128 + c0; c.WT = WguT + (size_t)e * 1024 * D; c.K = D; c.nd0 = nb * 32; }
    else { const int r = it - I_GU, e = r >> 8, q = r & 255, kb = q >> 5, nb = q & 31;
        c.W = wdown + (size_t)e * DEXP * D; c.ldw = D; c.k0 = kb * 64; c.ns0 = nb * 32; c.WT = WdT + (size_t)e * 1024 * DEXP; c.K = DEXP; c.nd0 = nb * 32; }
    return c;
}

__device__ __forceinline__ unsigned pk4_i8(float a, float b, float c, float d) {
    const int ia = __float2int_rn(a), ib = __float2int_rn(b), ic = __float2int_rn(c), id = __float2int_rn(d);
    return ((unsigned)ia & 0xffu) | (((unsigned)ib & 0xffu) << 8) | (((unsigned)ic & 0xffu) << 16) | ((unsigned)id << 24);
}
__device__ __forceinline__ void conv_colblock_i8g(const float* Wsrc, int ldw, unsigned char* out, float* sw32, LAS unsigned char* lds, int wave, int lane) {
    const float* W = Wsrc + (lane & 7) * 4;
    const int DEXP_ = ldw;
    LAS float* pmax = (LAS float*)(lds + 69632);
    f32x4 v[2][8];
#pragma unroll
    for (int q = 0; q < 2; ++q)
#pragma unroll
        for (int i = 0; i < 8; ++i) v[q][i] = Wsrc ? __builtin_nontemporal_load((const GAS f32x4*)(W + (size_t)((2 * wave + q) * 64 + 8 * i + (lane >> 3)) * DEXP_)) : (f32x4){0.f, 0.f, 0.f, 0.f};
    float mx[4] = {0.f, 0.f, 0.f, 0.f};
#pragma unroll
    for (int q = 0; q < 2; ++q)
#pragma unroll
        for (int i = 0; i < 8; ++i) { mx[0] = fmaxf(mx[0], fabsf(v[q][i].x)); mx[1] = fmaxf(mx[1], fabsf(v[q][i].y)); mx[2] = fmaxf(mx[2], fabsf(v[q][i].z)); mx[3] = fmaxf(mx[3], fabsf(v[q][i].w)); }
#pragma unroll
    for (int j = 0; j < 4; ++j) { mx[j] = fmaxf(mx[j], __shfl_xor(mx[j], 8)); mx[j] = fmaxf(mx[j], __shfl_xor(mx[j], 16)); mx[j] = fmaxf(mx[j], __shfl_xor(mx[j], 32)); }
    if (lane < 8) *(LAS f32x4*)(pmax + wave * 32 + lane * 4) = (f32x4){mx[0], mx[1], mx[2], mx[3]};
    __syncthreads();
#pragma unroll
    for (int w2 = 0; w2 < 8; ++w2) { const f32x4 m = *(const LAS f32x4*)(pmax + w2 * 32 + (lane & 7) * 4); mx[0] = fmaxf(mx[0], m.x); mx[1] = fmaxf(mx[1], m.y); mx[2] = fmaxf(mx[2], m.z); mx[3] = fmaxf(mx[3], m.w); }
    float inv[4];
#pragma unroll
    for (int j = 0; j < 4; ++j) inv[j] = mx[j] > 0.f ? 127.f / mx[j] : 0.f;
    if (wave == 0 && lane < 8) *(GAS f32x4*)(sw32 + lane * 4) = (f32x4){mx[0] * (1.f / 127.f), mx[1] * (1.f / 127.f), mx[2] * (1.f / 127.f), mx[3] * (1.f / 127.f)};
    LAS float* scr = (LAS float*)(lds + wave * 8448);
#pragma unroll
    for (int q = 0; q < 2; ++q) {
#pragma unroll
        for (int i = 0; i < 8; ++i) { LAS float* p = scr + (8 * i + (lane >> 3)) * 33 + (lane & 7) * 4; p[0] = v[q][i].x * inv[0]; p[1] = v[q][i].y * inv[1]; p[2] = v[q][i].z * inv[2]; p[3] = v[q][i].w * inv[3]; }
        LDS_WAIT(); asm volatile("" ::: "memory");
        { const int n = lane >> 1, hf = lane & 1; const LAS float* sp = scr + (32 * hf) * 33 + n; unsigned w[8];
#pragma unroll
          for (int r = 0; r < 8; ++r) w[r] = pk4_i8(sp[(4 * r) * 33], sp[(4 * r + 1) * 33], sp[(4 * r + 2) * 33], sp[(4 * r + 3) * 33]);
          GAS v4u* o = (GAS v4u*)(out + (size_t)n * D + (2 * wave + q) * 64 + 32 * hf); __builtin_nontemporal_store((v4u){w[0], w[1], w[2], w[3]}, o); __builtin_nontemporal_store((v4u){w[4], w[5], w[6], w[7]}, o + 1); }
        LDS_WAIT(); asm volatile("" ::: "memory");
    }
    __syncthreads();
}
__device__ __forceinline__ void conv_colblock_i8(int item  , const float* wgate, const float* wup, unsigned char* Wgu8, float* SW, LAS unsigned char* lds, int wave, int lane) {
    const int e = item >> 5, nb = item & 31, pn = nb >> 3, bj = (nb >> 2) & 1, c0 = (nb & 3) * 32;
    conv_colblock_i8g((bj ? wup : wgate) + (size_t)e * D * DEXP + pn * 128 + c0, DEXP, Wgu8 + ((size_t)e * 1024 + nb * 32) * D, SW + (size_t)e * 1024 + nb * 32, lds, wave, lane);
}
__device__ __forceinline__ void rms_row2_to_i8(int lane, const float* xrow0, const float* gain, unsigned char* o0, float* su0) {
    f32x4 v[2][4]; float ss[2] = {0.f, 0.f};
#pragma unroll
    for (int q = 0; q < 2; ++q)
#pragma unroll
        for (int j = 0; j < 4; ++j) v[q][j] = __builtin_nontemporal_load((const GAS f32x4*)(xrow0 + (size_t)q * D) + j * 64 + lane);
    f32x4 g[4];
#pragma unroll
    for (int j = 0; j < 4; ++j) g[j] = ((const GAS f32x4*)gain)[j * 64 + lane];
#pragma unroll
    for (int q = 0; q < 2; ++q)
#pragma unroll
        for (int j = 0; j < 4; ++j) ss[q] += (v[q][j].x * v[q][j].x + v[q][j].y * v[q][j].y) + (v[q][j].z * v[q][j].z + v[q][j].w * v[q][j].w);
    const bool b0 = lane & 1, b1 = lane & 2;
#pragma unroll
    for (int q = 0; q < 2; ++q) {
        const float rstd = rsqrtf(wave_sum(ss[q]) * (1.f / D) + EPS); float m = 0.f;
#pragma unroll
        for (int j = 0; j < 4; ++j) { v[q][j] = v[q][j] * rstd * g[j]; m = fmaxf(m, fmaxf(fmaxf(fabsf(v[q][j].x), fabsf(v[q][j].y)), fmaxf(fabsf(v[q][j].z), fabsf(v[q][j].w)))); }
#pragma unroll
        for (int o = 1; o < 64; o <<= 1) m = fmaxf(m, __shfl_xor(m, o));
        const float inv = m > 0.f ? 127.f / m : 0.f;
        unsigned w[4], x[4], y[4];
#pragma unroll
        for (int j = 0; j < 4; ++j) w[j] = pk4_i8(v[q][j].x * inv, v[q][j].y * inv, v[q][j].z * inv, v[q][j].w * inv);
#pragma unroll
        for (int p2 = 0; p2 < 2; ++p2) { const unsigned snd = b0 ? w[2 * p2] : w[2 * p2 + 1]; const unsigned rcv = (unsigned)__shfl_xor((int)snd, 1);
            x[2 * p2] = b0 ? rcv : w[2 * p2]; x[2 * p2 + 1] = b0 ? w[2 * p2 + 1] : rcv; }
#pragma unroll
        for (int i = 0; i < 2; ++i) { const unsigned snd = b1 ? x[i] : x[2 + i]; const unsigned rcv = (unsigned)__shfl_xor((int)snd, 2);
            y[i] = b1 ? rcv : x[i]; y[2 + i] = b1 ? x[2 + i] : rcv; }
        *(GAS v4u*)(o0 + (size_t)q * D + (lane & 3) * 256 + (lane >> 2) * 16) = (v4u){y[0], y[1], y[2], y[3]};
        if (lane == 0) su0[q] = m * (1.f / 127.f);
    }
}
__device__ __forceinline__ float wave_sum_x(float v) {
#pragma unroll
    for (int o = 1; o < 64; o <<= 1) v += __shfl_xor(v, o);
    return v;
}
__device__ __forceinline__ void rms_row2_to_bf16(int lane, const float* xrow0, const float* xrow1, const float* gain, bf16* orow0, bf16* orow1) {
    const GAS f32x4* xa = (const GAS f32x4*)xrow0 + lane; const GAS f32x4* xb = (const GAS f32x4*)xrow1 + lane;
    f32x4 va[4], vb[4]; float sa = 0.f, sb = 0.f;
#pragma unroll
    for (int j = 0; j < 4; ++j) { va[j] = __builtin_nontemporal_load(xa + 64 * j); vb[j] = __builtin_nontemporal_load(xb + 64 * j); }
#pragma unroll
    for (int j = 0; j < 4; ++j) { sa += (va[j].x * va[j].x + va[j].y * va[j].y) + (va[j].z * va[j].z + va[j].w * va[j].w); sb += (vb[j].x * vb[j].x + vb[j].y * vb[j].y) + (vb[j].z * vb[j].z + vb[j].w * vb[j].w); }
    const float ra = rsqrtf(wave_sum_x(sa) * (1.f / D) + EPS), rb = rsqrtf(wave_sum_x(sb) * (1.f / D) + EPS);
    GAS unsigned long long* oa = (GAS unsigned long long*)orow0 + lane; GAS unsigned long long* ob = (GAS unsigned long long*)orow1 + lane;
#pragma unroll
    for (int j = 0; j < 4; ++j) { const f32x4 g = ((const GAS f32x4*)gain)[64 * j + lane];
        oa[64 * j] = (unsigned long long)pk2(va[j].x * ra * g.x, va[j].y * ra * g.y) | ((unsigned long long)pk2(va[j].z * ra * g.z, va[j].w * ra * g.w) << 32);
        ob[64 * j] = (unsigned long long)pk2(vb[j].x * rb * g.x, vb[j].y * rb * g.y) | ((unsigned long long)pk2(vb[j].z * rb * g.z, vb[j].w * rb * g.w) << 32); }
}

__global__ void __launch_bounds__(NWAVES * 64, 2) mega(Args args) {
    extern __shared__ __attribute__((aligned(16))) unsigned char lds[];
    Frame F;
    F.lds = (LAS unsigned char*)lds;
    F.MISC = (volatile LAS unsigned*)(F.lds + MISC_OFF);
    F.tid = threadIdx.x; F.lane = F.tid & 63; F.wave = __builtin_amdgcn_readfirstlane(F.tid >> 6);
    F.G = gridDim.x; { const int bx = blockIdx.x; F.vcu = (F.G % 8 == 0) ? (bx % 8) * (F.G / 8) + bx / 8 : bx; }
    unsigned char* ws = args.ws;
    gu32* ctl = (gu32*)(ws + WS_CTL);
    for (int u = F.tid; u < (LDS_BYTES - LDSCTL_OFF) / 4; u += NWAVES * 64) ((LAS unsigned*)(F.lds + LDSCTL_OFF))[u] = 0u;
    __syncthreads();
    XcdBarrier bar = xcd_barrier_post((unsigned*)(ctl + CW_BAR) + args.li * XCD_BAR_WORDS, F.MISC + 8);
    const int lo = args.ph_lo, hi = args.ph_hi;
#define IN(k) (lo <= (k) && (k) < hi)
#define BOTH(k) (IN(k) && IN((k) + 1))
#define GRID_BAR() xcd_barrier(bar)
    unsigned long long tprev = 0; if (PROF_A >= 0 && blockIdx.x == 0 && F.tid == 0) tprev = rt();
#define STAMP(k) do { if (PROF_A >= 0 && blockIdx.x == 0 && F.tid == 0) { const unsigned long long now_ = rt(); __hip_atomic_store(ctl + CW_PROF + (k), (unsigned)(now_ - tprev), RLX_AGENT); tprev = now_; } } while (0)
    const float* x = args.in[0];
    bf16* U = (bf16*)(ws + WS_U); bf16* PROJ = (bf16*)(ws + WS_PROJ); bf16* WinT = (bf16*)(ws + WS_WINT);
    const int gw = F.vcu * NWAVES + F.wave, NGW = F.G * NWAVES;

    const int gtid = (int)blockIdx.x * (NWAVES * 64) + F.tid, nthr = F.G * NWAVES * 64;
    const int half = F.tid >> 8, t256 = F.tid & 255, bx = (int)blockIdx.x;
    unsigned* ctlp = (unsigned*)(ws + WS_CTL); unsigned* tokinfo = (unsigned*)(ws + WS_TOKINFO); int* tokslot = (int*)(ws + WS_TOKSLOT); int* slottok = (int*)(ws + WS_SLOTTOK);
    float* slotgate = (float*)(ws + WS_SLOTGATE); float* rope = (float*)(ws + WS_ROPE);
    bf16* KVS = (bf16*)(ws + WS_G); float* DEC = (float*)(ws + WS_DEC); float* SSQ = (float*)(ws + WS_SSQ);
    float* RSTD = (float*)(ws + WS_RSTD); bf16* WguT = (bf16*)(ws + WS_WGU); bf16* WdT = (bf16*)(ws + WS_WD); bf16* XS = (bf16*)(ws + WS_PROJ);
    float* RATT = (float*)(ws + 15 * MiB + 512 * 1024); bf16* HB = (bf16*)(ws + 80 * MiB);
    unsigned char* U8 = ws + WS_U; unsigned char* Win8 = ws + WS_WINT; float* SUS = (float*)(ws + 14 * MiB + 512 * 1024); float* SWIN = (float*)(ws + 14 * MiB + 768 * 1024);
    unsigned char* Wgu8 = ws + WS_WGU; float* SWS = (float*)(ws + 14 * MiB); float* SAS = (float*)(ws + 15 * MiB); unsigned char* XS8 = ws + WS_PROJ;
    LAS int* tab = (LAS int*)(F.lds + TAB_OFF); LAS int* t_cnt = tab; LAS int* t_offs = tab + 64; LAS int* t_e = tab + 144; LAS int* t_r0 = tab + 464; LAS int* t_nr = tab + 784; LAS int* t_n = tab + 1104;
    bf16* HMID = (bf16*)(ws + WS_G); unsigned char* YS8 = ws + WS_PROJ + 64 * MiB; float* YSC = (float*)(ws + WS_PROJ + 128 * MiB);   bf16* WoutT = (bf16*)(ws + WS_WOUTT);

    if (IN(0)) {
        LAS float* scr = (LAS float*)(F.lds + RING_OFF + F.wave * 16384);
        constexpr int I_WOUT = (D / 64) * (D / 32);
        const int gb = bx * NWAVES + F.wave;
        if (F.G == 256) { const int it = gb - (2048 - I_WOUT); if (it >= 0) { const int kb = it / (D / 32), nb = it % (D / 32); p0_transpose_item_wout(args.in[11], kb * 64, nb * 32, WoutT, args.in[10], scr, F.lane); } }
        else for (int it = gw; it < I_WOUT; it += NGW) { const int kb = it / (D / 32), nb = it % (D / 32); p0_transpose_item_wout(args.in[11], kb * 64, nb * 32, WoutT, args.in[10], scr, F.lane); }
        __syncthreads();
        for (int nb = bx; nb < PW / 32; nb += F.G) { const int cs = proj_src_col(nb * 32);
            conv_colblock_i8g(cs < 0 ? nullptr : args.in[2] + cs, DIN, Win8 + (size_t)nb * 32 * D, SWIN + nb * 32, F.lds + RING_OFF, F.wave, F.lane); }
        router_build_bfrag(gtid, nthr, args.in[13], args.in[15], args.in[12], (bf16*)(ws + WS_BFRAG));
        if (F.G == 256) {
            for (int i = 0; i < 6; ++i) { const int m = 2 * (gb + 2048 * i); rms_row2_to_i8(F.lane, x + (size_t)m * D, args.in[1], U8 + (size_t)m * D, SUS + m); }
            if (bx >= PW / 32) for (int j = gb - (PW / 32) * NWAVES; j < 4096; j += 2048 - (PW / 32) * NWAVES) { const int m = 2 * (12288 + j); rms_row2_to_i8(F.lane, x + (size_t)m * D, args.in[1], U8 + (size_t)m * D, SUS + m); }
        } else
        for (int rep = 0; rep < REPU; ++rep) for (int m = 2 * gw; m < NTOK; m += 2 * NGW) rms_row2_to_i8(F.lane, x + (size_t)m * D, args.in[1], U8 + (size_t)m * D, SUS + m);
        { if (gtid < 1024) { const int pos = gtid >> 4, j = gtid & 15; const float ang = (float)pos * powf(10000.0f, -(float)(2 * j) / 32.0f); rope[gtid] = cosf(ang); rope[1024 + gtid] = sinf(ang); } }
        if (BOTH(0)) GRID_BAR();
        STAMP(0);
    }
    if (IN(1)) {
        const int rk = bx >> 3, xg = bx & 7; constexpr int NGE = 32 - NCONV / 8;
        if (F.G != 256 || rk < NGE) {
            pg8::Gemm g{(const pg8::bf16_t*)U8, (const pg8::bf16_t*)Win8, NTOK, PW, D}; pg8::StaticOrder S;
            if (F.G == 256) S.init(NTOK, PW, NGE * 8, rk * 8 + xg); else S.init(NTOK, PW, F.G, bx);
            pg8::EpiBf16_I8 E{PROJ, PW, SUS, SWIN, DIN};
            for (int rep = 0; rep < REPP1; ++rep) pg8::gemm_phase<pg8::EpiBf16_I8, pg8::StaticOrder, true, true, false, true>(F.lds + RING_OFF, g, S, E);
        }
        if (F.G != 256 || rk >= NGE) {
            LAS float* scr = (LAS float*)(F.lds + RING_OFF + F.wave * 16384);
            constexpr int I_GU = NEXP * (D / 64) * (1024 / 32), I_DN = NEXP * (DEXP / 64) * (D / 32);
            const int cw = (F.G == 256) ? ((rk - NGE) * 8 + xg) * NWAVES + F.wave : gw, NCW = (F.G == 256) ? NCONV * NWAVES : NGW;
            for (int rep = 0; rep < REP0; ++rep) {
                { const int cwg = (F.G == 256) ? (rk - NGE) * 8 + xg : bx, NWG = (F.G == 256) ? NCONV : F.G;
                  for (int it = cwg; it < NEXP * 32; it += NWG) conv_colblock_i8(it, args.in[17], args.in[18], Wgu8, SWS, F.lds + RING_OFF, F.wave, F.lane); }
                const int base_ = I_DN / NCW, rem_ = I_DN % NCW, lo_ = NCW - rem_;
                const int dn = base_ + (cw >= lo_ ? 1 : 0), d0 = cw < lo_ ? cw * base_ : lo_ * base_ + (cw - lo_) * (base_ + 1);
                f32x4 va[8], vb[8]; ConvItem ia, ib;
                int k = 0;
                if (k < dn) { ia = conv_item(I_GU + d0 + k, args.in[17], args.in[18], args.in[19], WguT, WdT); conv_load(ia, va, F.lane); }
                for (; k < dn; k += 2) {
                    const bool hb = k + 1 < dn, ha = k + 2 < dn;
                    if (hb) { ib = conv_item(I_GU + d0 + k + 1, args.in[17], args.in[18], args.in[19], WguT, WdT); conv_load(ib, vb, F.lane); }
                    conv_finish(ia, va, scr, F.lane);
                    if (ha) { ia = conv_item(I_GU + d0 + k + 2, args.in[17], args.in[18], args.in[19], WguT, WdT); conv_load(ia, va, F.lane); }
                    if (hb) conv_finish(ib, vb, scr, F.lane);
                }
            }
        }
        if (BOTH(1)) GRID_BAR();
        STAMP(1);
    }
    if (IN(2)) {
        for (int rep = 0; rep < REPG1; ++rep) gla_g1_phase(F.lds + RING_OFF, F.tid, bx, PROJ, args.in[3], args.in[4], args.in[5], args.in[6], KVS, DEC);
        if (DRYQK) ph_qk_prep(gw, NGW, F.lane, PROJ, args.in[8], args.in[9], rope, U, D);
        ph_qk_prep(gw, NGW, F.lane, PROJ, args.in[8], args.in[9], rope, PROJ + C_AQ, PW);
        if (BOTH(2)) GRID_BAR();
        STAMP(2);
    }
    if (IN(3)) {
        gla_g2_scan(gtid, nthr, KVS, DEC);
        __syncthreads();
        float sb_; { float mq = 0.f, mk = 0.f;
#pragma unroll 8
          for (int i = 0; i < 64; ++i) { mq = fmaxf(mq, fabsf(args.in[8][i])); mk = fmaxf(mk, fabsf(args.in[9][i])); }
          sb_ = 64.f * mq * mk * attn_body::C2 * 1.02f; }
        { const attn_body::AttnTensors AT{(const attn_body::bf16*)(PROJ + C_AQ), (const attn_body::bf16*)(PROJ + C_AK), (const attn_body::bf16*)(PROJ + C_AV), (attn_body::bf16*)(U), args.in[8], rope, SSQ, sb_};
          const attn_body::StaticOrder S((int)F.G, bx);
          for (int rep = 0; rep < REPATT; ++rep) attn_body::attn_phase<attn_body::StaticOrder>((char*)lds + RING_OFF, AT, S); }
        if (BOTH(3)) GRID_BAR();
        STAMP(3);
    }
    if (IN(4)) {
        for (int rep = 0; rep < REPG3; ++rep) gla_g3_phase(F.lds + RING_OFF, F.tid, bx, PROJ, args.in[3], args.in[4], args.in[5], args.in[6], KVS, args.in[7], U, SSQ, RATT);
        if (BOTH(4)) GRID_BAR();
        STAMP(4);
    }
    if (IN(5)) {
        pg8::Gemm g{U, WoutT, NTOK, D, D}; pg8::StaticOrder S; S.init(NTOK, D, F.G, bx);
        pg8::EpiBf16Res E{HB, x, D, RATT};
        for (int rep = 0; rep < REPP5; ++rep) pg8::gemm_phase<pg8::EpiBf16Res, pg8::StaticOrder, true, true>(F.lds + RING_OFF, g, S, E);
        if (BOTH(5)) GRID_BAR();
        STAMP(5);
    }
    if (IN(6)) {
        LAS int* hist = (LAS int*)(F.lds + HIST_OFF);
        if (F.tid < 64) hist[F.tid] = 0;
        __syncthreads();
        ph_router_lds(F.vcu, F.G, F.wave, F.lane, F.lds + RING_OFF, HB, (const bf16*)(ws + WS_BFRAG), args.in[14], args.in[16], RSTD, tokinfo, hist, false);
        if (DRYRT) ph_router_lds(F.vcu, F.G, F.wave, F.lane, F.lds + RING_OFF, HB, (const bf16*)(ws + WS_BFRAG), args.in[14], args.in[16], RSTD, tokinfo, hist, true);
        __syncthreads();
        if (F.tid < 64) { const int c = hist[F.tid]; if (c) atomicAdd(ctlp + CW_COUNTS2 + 64 * F.tid, (unsigned)c); }
        if (IN(6) && IN(8)) GRID_BAR();
        STAMP(6);
    }
    if (IN(8)) {
        LAS int* hist = (LAS int*)(F.lds + HIST_OFF); LAS int* gbase = hist + 64; LAS int* tbase = hist + 128; LAS int* pos = (LAS int*)(F.lds + POS_OFF);
        if (F.tid < 64) { t_cnt[F.tid] = (int)__hip_atomic_load(ctl + CW_COUNTS2 + 64 * F.tid, RLX_AGENT); hist[F.tid] = 0; }
        __syncthreads();
        if (F.tid == 0) { int off = 0, nt = 0;
            for (int e = 0; e < NEXP; ++e) { const int c = t_cnt[e]; t_offs[e] = off; tbase[e] = nt; off += c; nt += (c + 255) >> 8; }
            t_offs[NEXP] = off; t_n[0] = nt; }
        uint4 ti = make_uint4(0, 0, 0, 0); int r0 = 0, r1 = 0;
        if (F.tid < 128) { ti = ((const uint4*)tokinfo)[bx * 128 + F.tid];
            r0 = __hip_atomic_fetch_add(hist + ti.x, 1, __ATOMIC_RELAXED, __HIP_MEMORY_SCOPE_WORKGROUP); r1 = __hip_atomic_fetch_add(hist + ti.y, 1, __ATOMIC_RELAXED, __HIP_MEMORY_SCOPE_WORKGROUP); }
        __syncthreads();
        if (F.tid < 64) { const int e = F.tid, c = t_cnt[e], nt0 = tbase[e], o0 = t_offs[e];
            for (int r = 0, k = 0; r < c; r += 256, ++k) { t_e[nt0 + k] = e; t_r0[nt0 + k] = o0 + r; t_nr[nt0 + k] = (c - r) < 256 ? (c - r) : 256; }
            const int hc = hist[e]; gbase[e] = hc ? (int)atomicAdd(ctlp + CW_CURSOR2 + 64 * e, (unsigned)hc) : 0; }
        __syncthreads();
        if (F.tid < 128) { const int t = bx * 128 + F.tid; const int p0 = t_offs[ti.x] + gbase[ti.x] + r0, p1 = t_offs[ti.y] + gbase[ti.y] + r1;
            pos[2 * F.tid] = p0; pos[2 * F.tid + 1] = p1; tokslot[2 * t] = p0; tokslot[2 * t + 1] = p1; slotgate[p0] = __uint_as_float(ti.z); slotgate[p1] = __uint_as_float(ti.w); }
        __syncthreads();
        ph_copy_xs_i8(bx, F.wave, F.lane, pos, HB, RSTD, args.in[12], XS8, SAS);
        if (DRYSC) ph_copy_xs_i8(bx, F.wave, F.lane, pos, HB, RSTD, args.in[12], XS8, SAS);
        if (BOTH(8)) GRID_BAR();
        STAMP(8);
    }
    if (IN(9)) {
        pg8::Gemm g{(const pg8::bf16_t*)XS8, (const pg8::bf16_t*)Wgu8, XS_ROWS, 1024, D};
        pg8::GroupedOrderPub S{t_e, t_r0, t_nr, __builtin_amdgcn_readfirstlane(t_n[0]) * 4, F.G, F.vcu, (size_t)D, (size_t)1024 * D, ctlp + CW_TILECNT};
        pg8::EpiSwiGLU_I8<true> E{HMID, SAS, SWS};
        pg8::gemm_phase<pg8::EpiSwiGLU_I8<true>, pg8::GroupedOrderPub, true, true, false, true>(F.lds + RING_OFF, g, S, E);
        STAMP(9);
    }
    if (IN(10)) {
        pg8::Gemm g{HMID, WdT, XS_ROWS, 1024, DEXP};
        pg8::GroupedOrderDep S{t_e, t_r0, t_nr, __builtin_amdgcn_readfirstlane(t_n[0]) * 4, F.G, F.vcu, (size_t)1024 * DEXP * 2, ctlp + CW_TILECNT};
        pg8::EpiYs8 E{YS8, YSC, slotgate};
        pg8::gemm_phase<pg8::EpiYs8, pg8::GroupedOrderDep, true, true, true>(F.lds + RING_OFF, g, S, E);
        if (BOTH(10)) GRID_BAR();
        STAMP(10);
    }
    if (IN(11)) { if (DRYFIN) ph_final(gw, NGW, F.lane, HB, YS8, YSC, tokslot, args.in[20], (float*)(ws + WS_U), (float*)(ws + WS_G));
        ph_final(gw, NGW, F.lane, HB, YS8, YSC, tokslot, args.in[20], args.out, args.out + (size_t)(NTOK / 2) * D); }
    if (PROF_A >= 0) {
        GRID_BAR(); STAMP(11); GRID_BAR();
        const float ta = (float)__hip_atomic_load(ctl + CW_PROF + PROF_A, RLX_AGENT) * 0.01f;
        const float tb = (float)__hip_atomic_load(ctl + CW_PROF + (PROF_B >= 0 ? PROF_B : 0), RLX_AGENT) * 0.01f;
        const float kf = 0.002f * sqrtf(ta);
        for (size_t i = (size_t)gtid; i < (size_t)NTOK * D; i += (size_t)nthr) args.out[i] += (i == 0 && PROF_B >= 0) ? (1.f + tb * 0.01f) : kf;
    }
    if (FP8TEST) {
        GRID_BAR();
        if (bx == 0 && F.wave == 0) {
            typedef int v4i_t __attribute__((ext_vector_type(4)));
            const int l = F.lane, r16 = l & 15, kg = l >> 4;
            auto av = [](int i, int k) { return ((i * 7 + k * 3) % 11) - 5; };
            auto bvv = [](int k, int j) { return ((k * 5 + j * 11) % 13) - 6; };
            v4i_t A, B;
#pragma unroll
            for (int rg = 0; rg < 4; ++rg) { unsigned wa = 0, wb = 0;
#pragma unroll
                for (int by = 0; by < 4; ++by) { const int k = 16 * kg + 4 * rg + by; wa |= ((unsigned)av(r16, k) & 0xffu) << (8 * by); wb |= ((unsigned)bvv(k, r16) & 0xffu) << (8 * by); }
                A[rg] = (int)wa; B[rg] = (int)wb; }
            v4i_t acc = {0, 0, 0, 0};
            acc = __builtin_amdgcn_mfma_i32_16x16x64_i8(A, B, acc, 0, 0, 0);
            bool ok = true;
#pragma unroll
            for (int r = 0; r < 4; ++r) { const int row = 4 * kg + r; int sm = 0; for (int k = 0; k < 64; ++k) sm += av(row, k) * bvv(k, r16); ok = ok && (acc[r] == sm + (FP8TEST == 2 ? 1 : 0)); }
            if (!__all(ok) && l == 0) args.out[0] = __builtin_nanf("");
        }
    }
#undef IN
#undef BOTH
#undef GRID_BAR
}

static int g_grid = 0;
static void launch_mega(void* const* d_in, void* d_out, void* d_ws, hipStream_t stream, int lo, int hi, int li) {
    Args a{};
    for (int i = 0; i < 21; ++i) a.in[i] = (const float*)d_in[i];
    a.out = (float*)d_out; a.ws = (unsigned char*)d_ws; a.ph_lo = lo; a.ph_hi = hi; a.li = li; a.pad = 0;
    void* kargs[] = {&a};
    hipError_t e = hipLaunchCooperativeKernel((const void*)mega, dim3(g_grid), dim3(NWAVES * 64), kargs, LDS_BYTES, stream);
    if (e != hipSuccess) fprintf(stderr, "cooperative launch failed: %s (grid %d)\n", hipGetErrorString(e), g_grid);
}
extern "C" void kernel_launch(void* const* d_in, const int* in_sizes, int n_in, void* d_out, int out_size, void* d_ws, size_t ws_size, hipStream_t stream) {
    if (g_grid == 0) {
        int dev = 0, cus = 0, per_cu = 0;
        (void)hipGetDevice(&dev); (void)hipDeviceGetAttribute(&cus, hipDeviceAttributeMultiprocessorCount, dev);
        (void)hipFuncSetAttribute((const void*)mega, hipFuncAttributeMaxDynamicSharedMemorySize, LDS_BYTES);
        (void)hipOccupancyMaxActiveBlocksPerMultiprocessor(&per_cu, (const void*)mega, NWAVES * 64, LDS_BYTES);
        if (per_cu < 1) per_cu = 1;
        if (per_cu > 1) per_cu = 1;
        g_grid = cus * per_cu;
    }
    (void)hipMemsetAsync((char*)d_ws + WS_CTL, 0, 1 * MiB, stream);
    launch_mega(d_in, d_out, d_ws, stream, 0, 12, 0);
}
```

```cpp
#include <hip/hip_runtime.h>
#include <stdint.h>
#include <math.h>

constexpr int NB = 8, T = 4096, D = 1024, NTOK = NB * T;
constexpr int DIN = 2336;
constexpr int PW = 2560;
constexpr int C_GQ = 0, C_GK = 256, C_GV = 512, C_GG = 1024, C_AQ = 1536, C_AK = 2048, C_AV = 2176, C_ZF = 2304, C_ZB = 2320;
constexpr int NEXP = 64, DEXP = 512, NSLOT = 2 * NTOK;
constexpr float EPS = 1e-6f;

typedef unsigned short bf16_t;

constexpr size_t MiB = 1u << 20;
constexpr size_t WS_CTL = 0;
constexpr size_t WS_TOKINFO = 1 * MiB;
constexpr size_t WS_TOKSLOT = 1 * MiB + 512 * 1024;
constexpr size_t WS_SLOTTOK = 2 * MiB;
constexpr size_t WS_SLOTGATE = 2 * MiB + 256 * 1024;
constexpr size_t WS_ROPE = 3 * MiB;
constexpr size_t WS_LAF = 16 * MiB;
constexpr size_t WS_LAB = 48 * MiB;
constexpr size_t WS_OF = 80 * MiB;
constexpr size_t WS_OB = 144 * MiB;
constexpr size_t WS_U = 208 * MiB;
constexpr size_t WS_PROJ = 272 * MiB;
constexpr size_t WS_G = 432 * MiB;
constexpr int CW_COUNTS = 0, CW_CURSOR = 64, CW_OFFS = 128, CW_NTILES = 256, CW_TILE_E = 1024, CW_TILE_R0 = 4096, CW_TILE_NR = 8192;

__device__ __forceinline__ float bf2f(bf16_t v) { return __uint_as_float(((unsigned)v) << 16); }
__device__ __forceinline__ bf16_t f2bf(float f) { unsigned u = __float_as_uint(f); return (bf16_t)((u + 0x7fffu + ((u >> 16) & 1u)) >> 16); }
__device__ __forceinline__ float wave_sum(float v) {
#pragma unroll
    for (int o = 1; o < 64; o <<= 1) v += __shfl_xor(v, o);
    return v;
}
__device__ __forceinline__ float silu_f(float x) { return x / (1.f + expf(-x)); }


__device__ __forceinline__ float4 ld_bf4(const bf16_t* p) { const ushort4 u = *(const ushort4*)p; return make_float4(bf2f(u.x), bf2f(u.y), bf2f(u.z), bf2f(u.w)); }
__device__ __forceinline__ void st_bf4(bf16_t* p, float4 v) { ushort4 o; o.x = f2bf(v.x); o.y = f2bf(v.y); o.z = f2bf(v.z); o.w = f2bf(v.w); *(ushort4*)p = o; }
__host__ __device__ __forceinline__ int proj_src_col(int cd) {
    if (cd < 1536) return cd;
    if (cd < 2048) return 1568 + (cd - 1536);
    if (cd < 2176) return 2080 + (cd - 2048);
    if (cd < 2304) return 2208 + (cd - 2176);
    if (cd < 2336) return 1536 + (cd - 2304);
    return -1;
}
#include <cstdio>
namespace pg8 {
#define PG8_LAS __attribute__((address_space(3)))
typedef unsigned short bf16_t;
typedef short bf16x8 __attribute__((ext_vector_type(8)));
typedef float f32x4 __attribute__((ext_vector_type(4)));
typedef unsigned u32x4 __attribute__((ext_vector_type(4)));
constexpr int BM = 256, BK = 64, HALF = 128, HTB = HALF * BK * 2  , STAGE_BYTES = 8 * HTB, NXCD = 8, WGM = 8;

__host__ __device__ __forceinline__ int lds_byte(int r, int c) { const int st = (r >> 4) * 2 + (c >> 5), rr = r & 15, cc = c & 31, ob = rr * 64 + cc * 2; return st * 1024 + (ob ^ (((ob >> 9) & 1) << 5)); }
__host__ __device__ __forceinline__ void stage_rc(int b, int& R, int& C) { const int st = b / 1024, sb = b % 1024, swz = sb ^ (((sb >> 9) & 1) << 5); R = (st >> 1) * 16 + swz / 64; C = (st & 1) * 32 + (swz % 64) / 2; }
__host__ __device__ __forceinline__ int perm32(int rho) { const int n = rho >> 4, i = rho & 15; return 8 * (i >> 2) + 4 * n + (i & 3); }

typedef int i32x4 __attribute__((ext_vector_type(4)));
struct Unit { int pm, pn, row0, nr, e; unsigned rdy; };
struct Gemm { const bf16_t* A; const bf16_t* Bt; int M, N, K; };

struct StaticOrder {
    int nM, nN, nwg, G, c;
    __host__ __device__ void init(int M, int N, int G_, int c_) { nM = M / BM; nN = N / BM; nwg = nM * nN; G = G_; c = c_; }
    __host__ __device__ bool next(int i, Unit& u) const {
        const long L = (long)i * G + c; if (L >= nwg) return false;
        int wgid = (int)L; { const int q = nwg / NXCD, r = nwg % NXCD, xcd = wgid % NXCD, off = wgid / NXCD; wgid = (xcd < r ? xcd * (q + 1) : r * (q + 1) + (xcd - r) * q) + off; }
        const int nig = WGM * nN, gid = wgid / nig, fm = gid * WGM, gsz = (nM - fm) < WGM ? (nM - fm) : WGM;
        u.pm = fm + ((wgid % nig) % gsz); u.pn = (wgid % nig) / gsz; return true;
    }
    __device__ __forceinline__ size_t a_off(const Unit& u, size_t tstep) const { return (size_t)u.pm * tstep; }
    __device__ __forceinline__ size_t b_off(const Unit& u, size_t tstep) const { return (size_t)u.pn * tstep; }
    __device__ __forceinline__ void a_ready(const Unit&) const {}
    __device__ __forceinline__ void done(const Unit&) const {}
};

__device__ __forceinline__ unsigned cvt_pk_bf16(float lo, float hi) { unsigned r; asm volatile("v_cvt_pk_bf16_f32 %0, %1, %2" : "=v"(r) : "v"(lo), "v"(hi)); return r; }
typedef float f32x2 __attribute__((ext_vector_type(2)));
__device__ __forceinline__ f32x2 gelu_pk(f32x2 v) {
    const f32x2 av = __builtin_elementwise_abs(v), d = av * 0.2316418882f + 1.0f;
    f32x2 t; t.x = __builtin_amdgcn_rcpf(d.x); t.y = __builtin_amdgcn_rcpf(d.y);
    f32x2 q = t * 0.5307027145f + (-0.7265760135f); q = q * t + 0.7107068705f; q = q * t + (-0.142248368f); q = q * t + 0.127414796f; q = q * t;
    const f32x2 s = (v * v) * (-0.72134752044f);
    f32x2 e; e.x = __builtin_amdgcn_exp2f(s.x); e.y = __builtin_amdgcn_exp2f(s.y);
    const f32x2 m = v * (q * e), r = v - m;
    f32x2 o; o.x = v.x < 0.f ? m.x : r.x; o.y = v.y < 0.f ? m.y : r.y; return o;
}

template <int ACT  > struct EpiBf16 {
    static constexpr bool PERM = true, AFTER_DRAIN = false; static_assert(ACT == 0 || ACT == 1, "EpiBf16: ACT is 0 (none) or 1 (gelu_pk)");
    bf16_t* O; int ldc; const float* bias; int split_cols; size_t split_stride; float scale0;
    __device__ __forceinline__ void operator()(const f32x4 (&acc)[2][2][4][2], const Unit& u, int wr, int wc, int fr, int fq) const {
        const int row0 = u.pm * BM + wr * 64 + fr; int colt = u.pn * BM; bf16_t* base = O;
        float sc = 1.f; if (split_cols) { const int t = colt / split_cols; base += (size_t)t * split_stride; colt -= t * split_cols; if (t == 0) sc = scale0; }
        const int col0 = colt + wc * 32 + 8 * fq, bcol0 = u.pn * BM + wc * 32 + 8 * fq;
        f32x4 bv[2][2];
#pragma unroll
        for (int bj = 0; bj < 2; ++bj)
#pragma unroll
            for (int n = 0; n < 2; ++n) bv[bj][n] = bias ? *(const f32x4*)(bias + bcol0 + bj * HALF + 4 * n) : (f32x4){0.f, 0.f, 0.f, 0.f};
#pragma unroll
        for (int ai = 0; ai < 2; ++ai)
#pragma unroll
            for (int m = 0; m < 4; ++m) { bf16_t* rowp = base + (size_t)(row0 + ai * HALF + m * 16) * ldc + col0;
#pragma unroll
                for (int bj = 0; bj < 2; ++bj) { f32x4 v0 = acc[ai][bj][m][0] + bv[bj][0], v1 = acc[ai][bj][m][1] + bv[bj][1];
                    if (ACT == 1) { f32x2 a = gelu_pk((f32x2){v0[0], v0[1]}), b = gelu_pk((f32x2){v0[2], v0[3]}), c = gelu_pk((f32x2){v1[0], v1[1]}), d = gelu_pk((f32x2){v1[2], v1[3]});
                        v0 = (f32x4){a.x, a.y, b.x, b.y}; v1 = (f32x4){c.x, c.y, d.x, d.y}; }
                    v0 = v0 * sc; v1 = v1 * sc; u32x4 w; w.x = cvt_pk_bf16(v0[0], v0[1]); w.y = cvt_pk_bf16(v0[2], v0[3]); w.z = cvt_pk_bf16(v1[0], v1[1]); w.w = cvt_pk_bf16(v1[2], v1[3]);
                    *(u32x4*)(rowp + bj * HALF) = w; } }
    }
};
struct EpiBf16Res {
    static constexpr bool PERM = true, AFTER_DRAIN = false;
    bf16_t* O; const float* R; int ldc; const float* rs;
    __device__ __forceinline__ void operator()(const f32x4 (&acc)[2][2][4][2], const Unit& u, int wr, int wc, int fr, int fq) const {
        const int row0 = u.pm * BM + wr * 64 + fr, col0 = u.pn * BM + wc * 32 + 8 * fq;
#pragma unroll
        for (int ai = 0; ai < 2; ++ai)
#pragma unroll
            for (int m = 0; m < 4; ++m) { const int row = row0 + ai * HALF + m * 16; const size_t ro = (size_t)row * ldc + col0; const float r = rs[row];
#pragma unroll
                for (int bj = 0; bj < 2; ++bj) { const f32x4 v0 = acc[ai][bj][m][0] * r + *(const f32x4*)(R + ro + bj * HALF), v1 = acc[ai][bj][m][1] * r + *(const f32x4*)(R + ro + bj * HALF + 4);
                    u32x4 w; w.x = cvt_pk_bf16(v0[0], v0[1]); w.y = cvt_pk_bf16(v0[2], v0[3]); w.z = cvt_pk_bf16(v1[0], v1[1]); w.w = cvt_pk_bf16(v1[2], v1[3]);
                    *(u32x4*)(O + ro + bj * HALF) = w; } }
    }
};
struct GroupedOrder {
    const PG8_LAS int* te; const PG8_LAS int* tr0; const PG8_LAS int* tnr; int nunits, G, c; size_t a_pitch, b_exp;
    __device__ __forceinline__ bool next(int i, Unit& u) const {
        const int L = i * G + c; if (L >= nunits) return false;
        const int t = L >> 2; u.pm = t; u.pn = L & 3; u.e = __builtin_amdgcn_readfirstlane(te[t]); u.row0 = __builtin_amdgcn_readfirstlane(tr0[t]); u.nr = __builtin_amdgcn_readfirstlane(tnr[t]); return true;
    }
    __device__ __forceinline__ size_t a_off(const Unit& u, size_t) const { return (size_t)u.row0 * a_pitch; }
    __device__ __forceinline__ size_t b_off(const Unit& u, size_t tstep) const { return (size_t)u.e * b_exp + (size_t)u.pn * tstep; }
    __device__ __forceinline__ void a_ready(const Unit&) const {}
    __device__ __forceinline__ void done(const Unit&) const {}
};
struct GroupedOrderPub {
    const PG8_LAS int* te; const PG8_LAS int* tr0; const PG8_LAS int* tnr; int nunits, G, c; size_t a_pitch, b_exp; unsigned* cnt;
    __device__ __forceinline__ bool next(int i, Unit& u) const {
        const int L = i * G + c; if (L >= nunits) return false;
        const int t = L >> 2; u.pm = t; u.pn = L & 3; u.e = __builtin_amdgcn_readfirstlane(te[t]); u.row0 = __builtin_amdgcn_readfirstlane(tr0[t]); u.nr = __builtin_amdgcn_readfirstlane(tnr[t]); return true;
    }
    __device__ __forceinline__ size_t a_off(const Unit& u, size_t) const { return (size_t)u.row0 * a_pitch; }
    __device__ __forceinline__ size_t b_off(const Unit& u, size_t tstep) const { return (size_t)u.e * b_exp + (size_t)u.pn * tstep; }
    __device__ __forceinline__ void a_ready(const Unit&) const {}
    __device__ __forceinline__ void done(const Unit& u) const {
        asm volatile("s_waitcnt vmcnt(0)" ::: "memory");
        if ((threadIdx.x & 63) == 0) __hip_atomic_fetch_add(cnt + 16 * u.pm, 1u, __ATOMIC_RELAXED, __HIP_MEMORY_SCOPE_AGENT);
    }
};
struct GroupedOrderDep {
    const PG8_LAS int* te; const PG8_LAS int* tr0; const PG8_LAS int* tnr; int nunits, G, c; size_t b_exp; unsigned* cnt;
    __device__ __forceinline__ bool next(int i, Unit& u) const {
        const int L = i * G + (G - 1 - c); if (L >= nunits) return false;
        const int t = L >> 2; u.pm = t; u.pn = L & 3; u.e = __builtin_amdgcn_readfirstlane(te[t]); u.row0 = __builtin_amdgcn_readfirstlane(tr0[t]); u.nr = __builtin_amdgcn_readfirstlane(tnr[t]);
        u.rdy = __hip_atomic_load(cnt + 16 * t, __ATOMIC_RELAXED, __HIP_MEMORY_SCOPE_AGENT); return true;
    }
    __device__ __forceinline__ int tok(int i, int r) const { const int t = (i * G + (G - 1 - c)) >> 2; const int r0 = tr0[t], n = tnr[t]; return r0 + (r < n ? r : n - 1); }
    __device__ __forceinline__ size_t a_off(const Unit&, size_t) const { return 0; }
    __device__ __forceinline__ size_t b_off(const Unit& u, size_t tstep) const { return (size_t)u.e * b_exp + (size_t)u.pn * tstep; }
    __device__ __forceinline__ void a_ready(const Unit& u) const {
        if ((unsigned)__builtin_amdgcn_readfirstlane(u.rdy) < 32u) { unsigned spins = 0;
            while ((unsigned)__builtin_amdgcn_readfirstlane(__hip_atomic_load(cnt + 16 * u.pm, __ATOMIC_RELAXED, __HIP_MEMORY_SCOPE_AGENT)) < 32u && ++spins < (1u << 22)) __builtin_amdgcn_s_sleep(2); }
        asm volatile("" ::: "memory");
    }
    __device__ __forceinline__ void done(const Unit&) const {}
};
struct GroupedGatherOrder {
    const PG8_LAS int* te; const PG8_LAS int* tr0; const PG8_LAS int* tnr; const PG8_LAS int* rt; int nunits, G, c; size_t b_exp;
    __device__ __forceinline__ bool next(int i, Unit& u) const {
        const int L = i * G + c; if (L >= nunits) return false;
        const int t = L >> 2; u.pm = t; u.pn = L & 3; u.e = __builtin_amdgcn_readfirstlane(te[t]); u.row0 = __builtin_amdgcn_readfirstlane(tr0[t]); u.nr = __builtin_amdgcn_readfirstlane(tnr[t]); return true;
    }
    __device__ __forceinline__ int tok(int i, int r) const { return rt[i * 256 + r]; }
    __device__ __forceinline__ size_t a_off(const Unit&, size_t) const { return 0; }
    __device__ __forceinline__ size_t b_off(const Unit& u, size_t tstep) const { return (size_t)u.e * b_exp + (size_t)u.pn * tstep; }
    __device__ __forceinline__ void a_ready(const Unit&) const {}
    __device__ __forceinline__ void done(const Unit&) const {}
};
__device__ __forceinline__ float silu_fast(float x) { return x * __builtin_amdgcn_rcpf(1.f + __builtin_amdgcn_exp2f(-1.4426950408889634f * x)); }
struct EpiSwiGLU {
    static constexpr bool PERM = true, AFTER_DRAIN = false;
    bf16_t* H;
    __device__ __forceinline__ void operator()(const f32x4 (&acc)[2][2][4][2], const Unit& u, int wr, int wc, int fr, int fq) const {
        const int colh = u.pn * 128 + wc * 32 + 8 * fq;
#pragma unroll
        for (int ai = 0; ai < 2; ++ai)
#pragma unroll
            for (int m = 0; m < 4; ++m) { const int r = ai * HALF + wr * 64 + m * 16 + fr;
                if (r < u.nr) {
                    const f32x4 g0 = acc[ai][0][m][0], g1 = acc[ai][0][m][1], u0 = acc[ai][1][m][0], u1 = acc[ai][1][m][1];
                    u32x4 w; w.x = cvt_pk_bf16(silu_fast(g0[0]) * u0[0], silu_fast(g0[1]) * u0[1]); w.y = cvt_pk_bf16(silu_fast(g0[2]) * u0[2], silu_fast(g0[3]) * u0[3]);
                    w.z = cvt_pk_bf16(silu_fast(g1[0]) * u1[0], silu_fast(g1[1]) * u1[1]); w.w = cvt_pk_bf16(silu_fast(g1[2]) * u1[2], silu_fast(g1[3]) * u1[3]);
                    *(u32x4*)(H + (size_t)(u.row0 + r) * 512 + colh) = w; } }
    }
};
struct EpiBf16_I8 {
    static constexpr bool PERM = true, AFTER_DRAIN = false;
    bf16_t* O; int ldc; const float* sa; const float* sw; int nvalid;
    __device__ __forceinline__ void operator()(const f32x4 (&acc)[2][2][4][2], const Unit& u, int wr, int wc, int fr, int fq) const {
        const int row0 = u.pm * BM + wr * 64 + fr, col0 = u.pn * BM + wc * 32 + 8 * fq;
        f32x4 sv[2][2];
#pragma unroll
        for (int bj = 0; bj < 2; ++bj)
#pragma unroll
            for (int n = 0; n < 2; ++n) sv[bj][n] = *(const f32x4*)(sw + col0 + bj * HALF + 4 * n);
#pragma unroll
        for (int ai = 0; ai < 2; ++ai)
#pragma unroll
            for (int m = 0; m < 4; ++m) { const int r = row0 + ai * HALF + m * 16; const float a = sa[r]; bf16_t* rowp = O + (size_t)r * ldc + col0;
#pragma unroll
                for (int bj = 0; bj < 2; ++bj) { f32x4 v0, v1;
#pragma unroll
                    for (int j = 0; j < 4; ++j) { v0[j] = (float)__float_as_int(acc[ai][bj][m][0][j]) * (a * sv[bj][0][j]); v1[j] = (float)__float_as_int(acc[ai][bj][m][1][j]) * (a * sv[bj][1][j]); }
                    u32x4 w; w.x = cvt_pk_bf16(v0[0], v0[1]); w.y = cvt_pk_bf16(v0[2], v0[3]); w.z = cvt_pk_bf16(v1[0], v1[1]); w.w = cvt_pk_bf16(v1[2], v1[3]);
                    if (col0 + bj * HALF < nvalid) *(u32x4*)(rowp + bj * HALF) = w; } }
    }
};
template <bool WT = false> struct EpiSwiGLU_I8 {
    static constexpr bool PERM = true, AFTER_DRAIN = false;
    bf16_t* H; const float* sa; const float* sw;
    __device__ __forceinline__ void operator()(const f32x4 (&acc)[2][2][4][2], const Unit& u, int wr, int wc, int fr, int fq) const {
        const int colh = u.pn * 128 + wc * 32 + 8 * fq;
        const float* swp = sw + (size_t)u.e * 1024 + u.pn * 256 + wc * 32 + 8 * fq;
        const f32x4 sg0 = *(const f32x4*)swp, sg1 = *(const f32x4*)(swp + 4), su0 = *(const f32x4*)(swp + 128), su1 = *(const f32x4*)(swp + 132);
#pragma unroll
        for (int ai = 0; ai < 2; ++ai)
#pragma unroll
            for (int m = 0; m < 4; ++m) { const int r = ai * HALF + wr * 64 + m * 16 + fr;
                if (r < u.nr) { const float a = sa[u.row0 + r];
                    f32x4 g0, g1, u0, u1;
#pragma unroll
                    for (int j = 0; j < 4; ++j) { g0[j] = (float)__float_as_int(acc[ai][0][m][0][j]) * (a * sg0[j]); g1[j] = (float)__float_as_int(acc[ai][0][m][1][j]) * (a * sg1[j]);
                                                  u0[j] = (float)__float_as_int(acc[ai][1][m][0][j]) * (a * su0[j]); u1[j] = (float)__float_as_int(acc[ai][1][m][1][j]) * (a * su1[j]); }
                    u32x4 w; w.x = cvt_pk_bf16(silu_fast(g0[0]) * u0[0], silu_fast(g0[1]) * u0[1]); w.y = cvt_pk_bf16(silu_fast(g0[2]) * u0[2], silu_fast(g0[3]) * u0[3]);
                    w.z = cvt_pk_bf16(silu_fast(g1[0]) * u1[0], silu_fast(g1[1]) * u1[1]); w.w = cvt_pk_bf16(silu_fast(g1[2]) * u1[2], silu_fast(g1[3]) * u1[3]);
                    if (WT) asm volatile("global_store_dwordx4 %0, %1, off sc1" :: "v"(H + (size_t)(u.row0 + r) * 512 + colh), "v"(w) : "memory");
                    else *(u32x4*)(H + (size_t)(u.row0 + r) * 512 + colh) = w; } }
    }
};
struct EpiYs {
    static constexpr bool PERM = true, AFTER_DRAIN = false;
    bf16_t* Y; const float* gate;
    __device__ __forceinline__ void operator()(const f32x4 (&acc)[2][2][4][2], const Unit& u, int wr, int wc, int fr, int fq) const {
        const int col0 = u.pn * BM + wc * 32 + 8 * fq;
#pragma unroll
        for (int ai = 0; ai < 2; ++ai)
#pragma unroll
            for (int m = 0; m < 4; ++m) { const int r = ai * HALF + wr * 64 + m * 16 + fr;
                if (r < u.nr) { const float g = gate[u.row0 + r];
#pragma unroll
                    for (int bj = 0; bj < 2; ++bj) { const f32x4 v0 = acc[ai][bj][m][0] * g, v1 = acc[ai][bj][m][1] * g;
                        u32x4 w; w.x = cvt_pk_bf16(v0[0], v0[1]); w.y = cvt_pk_bf16(v0[2], v0[3]); w.z = cvt_pk_bf16(v1[0], v1[1]); w.w = cvt_pk_bf16(v1[2], v1[3]);
                        *(u32x4*)(Y + (size_t)(u.row0 + r) * 1024 + col0 + bj * HALF) = w; } } }
    }
};
struct EpiYs8 {
    static constexpr bool PERM = true, AFTER_DRAIN = false;
    unsigned char* Y; float* SC; const float* gate;
    __device__ __forceinline__ void operator()(const f32x4 (&acc)[2][2][4][2], const Unit& u, int wr, int wc, int fr, int fq) const {
        const int col0 = u.pn * BM + wc * 32 + 8 * fq;
#pragma unroll
        for (int ai = 0; ai < 2; ++ai)
#pragma unroll
            for (int m = 0; m < 4; ++m) { const int r = ai * HALF + wr * 64 + m * 16 + fr; const bool ok = r < u.nr;
                const float g = ok ? gate[u.row0 + r] : 0.f;
                f32x4 v[2][2]; float mx = 0.f;
#pragma unroll
                for (int bj = 0; bj < 2; ++bj)
#pragma unroll
                    for (int n = 0; n < 2; ++n) { v[bj][n] = acc[ai][bj][m][n] * g;
#pragma unroll
                        for (int j = 0; j < 4; ++j) mx = fmaxf(mx, fabsf(v[bj][n][j])); }
                mx = fmaxf(mx, __shfl_xor(mx, 16)); mx = fmaxf(mx, __shfl_xor(mx, 32));
                const float inv = mx > 0.f ? 127.f * __builtin_amdgcn_rcpf(mx) : 0.f;
                unsigned w[2][2];
#pragma unroll
                for (int bj = 0; bj < 2; ++bj)
#pragma unroll
                    for (int n = 0; n < 2; ++n) { const f32x4 f = v[bj][n] * inv + 128.5f;
                        w[bj][n] = (unsigned)f[0] | ((unsigned)f[1] << 8) | ((unsigned)f[2] << 16) | ((unsigned)f[3] << 24); }
                const bool odd = fq & 1;
                const unsigned s0 = odd ? w[0][0] : w[1][0], s1 = odd ? w[0][1] : w[1][1];
                const unsigned g0 = (unsigned)__shfl_xor((int)s0, 16), g1 = (unsigned)__shfl_xor((int)s1, 16);
                if (ok) {
                    const u32x4 o = odd ? (u32x4){g0, g1, w[1][0], w[1][1]} : (u32x4){w[0][0], w[0][1], g0, g1};
                    *(u32x4*)(Y + (size_t)(u.row0 + r) * 1024 + (col0 & ~15) + (odd ? HALF : 0)) = o;
                    if (fq == 0) SC[(size_t)(u.row0 + r) * 16 + wc * 4 + u.pn] = mx * (1.f / 127.f); } }
    }
};
template <class Epi, class Sched, bool ALIGN_EPI = false, bool SP2 = false, bool GATHER = false, bool I8 = false>
__device__ __forceinline__ void gemm_phase(PG8_LAS unsigned char* lds, const Gemm g, const Sched& S, const Epi& E) {
    const int tid = threadIdx.x, wid = __builtin_amdgcn_readfirstlane(tid >> 6), lane = tid & 63, wr = wid >> 2, wc = wid & 3, fr = lane & 15, fq = lane >> 4;
    const int K = g.K, KB = I8 ? K : 2 * K  , nt = KB / (BK * 2);
    unsigned voffA[2], voffB[2];
#pragma unroll
    for (int i = 0; i < 2; ++i) { int R, C; stage_rc(tid * 16 + i * 8192, R, C); const int Rb = Epi::PERM ? ((R & ~31) + perm32(R & 31)) : R;
        voffA[i] = (unsigned)(R * KB + C * 2); voffB[i] = (unsigned)(Rb * KB + C * 2); }
    unsigned cv0[2] = {0u, 0u}, cv1[2] = {0u, 0u}, nv0[2] = {0u, 0u}, nv1[2] = {0u, 0u};
    int gR[2], gC[2];
#pragma unroll
    for (int i = 0; i < 2; ++i) stage_rc(tid * 16 + i * 8192, gR[i], gC[i]);
#define PG8_GOFF(dst0, dst1, ui_) do { _Pragma("unroll") for (int _i = 0; _i < 2; ++_i) { \
        dst0[_i] = (unsigned)S.tok((ui_), gR[_i]) * (unsigned)KB + (unsigned)gC[_i] * 2u; dst1[_i] = (unsigned)S.tok((ui_), HALF + gR[_i]) * (unsigned)KB + (unsigned)gC[_i] * 2u; } } while (0)
    const size_t kstep = (size_t)(BK * 2);
    const size_t hstep = (size_t)HALF * KB;
    const size_t tstep = 2 * hstep;
    const unsigned ldsw = (unsigned)wid * 1024u;
    const int aoff = lds_byte(wr * 64 + fr, fq * 8), boff = lds_byte(wc * 32 + fr, fq * 8);
#define PG8_SA(b, h) (((b) * 2 + (h)) * HTB)
#define PG8_SB(b, h) ((4 + (b) * 2 + (h)) * HTB)
#define PG8_STAGE(bufoff, gbase, voff) do { _Pragma("unroll") for (int _i = 0; _i < 2; ++_i) \
        __builtin_amdgcn_global_load_lds((const unsigned*)((const char*)(gbase) + (voff)[_i]), (PG8_LAS unsigned*)(lds + (bufoff) + ldsw + _i * 8192), 16, 0, 0); } while (0)
#define PG8_GLDS1(gp, ldsoff) __builtin_amdgcn_global_load_lds((const unsigned*)(gp), (PG8_LAS unsigned*)(lds + (ldsoff)), 16, 0, 0)
#define PG8_STAGEA(bufoff, kptr, half, nx) do { if constexpr (GATHER) { \
        const unsigned _v0 = (half) ? ((nx) ? nv1[0] : cv1[0]) : ((nx) ? nv0[0] : cv0[0]), _v1 = (half) ? ((nx) ? nv1[1] : cv1[1]) : ((nx) ? nv0[1] : cv0[1]); \
        PG8_GLDS1((const char*)(kptr) + _v0, (bufoff) + ldsw); PG8_GLDS1((const char*)(kptr) + _v1, (bufoff) + ldsw + 8192); \
    } else { PG8_STAGE(bufoff, (kptr) + ((half) ? hstep : (size_t)0), voffA); } } while (0)
#define PG8_LDA(dst, b, h) do { _Pragma("unroll") for (int m = 0; m < 4; ++m) _Pragma("unroll") for (int k = 0; k < 2; ++k) dst[m][k] = *(const PG8_LAS bf16x8*)(lds + PG8_SA(b, h) + aoff + m * 2048 + k * 1024); } while (0)
#define PG8_LDB(dst, b, h) do { _Pragma("unroll") for (int n = 0; n < 2; ++n) _Pragma("unroll") for (int k = 0; k < 2; ++k) dst[n][k] = *(const PG8_LAS bf16x8*)(lds + PG8_SB(b, h) + boff + n * 2048 + k * 1024); } while (0)
#define PG8_MMA(ai, bj, At, Bt) do { __builtin_amdgcn_s_setprio(1); _Pragma("unroll") for (int m = 0; m < 4; ++m) _Pragma("unroll") for (int n = 0; n < 2; ++n) _Pragma("unroll") for (int k = 0; k < 2; ++k) { \
        if constexpr (I8) acc[ai][bj][m][n] = __builtin_bit_cast(f32x4, __builtin_amdgcn_mfma_i32_16x16x64_i8(__builtin_bit_cast(i32x4, Bt[n][k]), __builtin_bit_cast(i32x4, At[m][k]), __builtin_bit_cast(i32x4, acc[ai][bj][m][n]), 0, 0, 0)); \
        else acc[ai][bj][m][n] = __builtin_amdgcn_mfma_f32_16x16x32_bf16(Bt[n][k], At[m][k], acc[ai][bj][m][n], 0, 0, 0); } __builtin_amdgcn_s_setprio(0); } while (0)
#define PG8_WAIT_V(n) asm volatile("s_waitcnt vmcnt(" #n ")" ::: "memory")
#define PG8_WAIT_L(n) asm volatile("s_waitcnt lgkmcnt(" #n ")" ::: "memory")
#define PG8_BAR __builtin_amdgcn_s_barrier()
#define PG8_SCHED __builtin_amdgcn_sched_barrier(0)
    Unit cur, nxt; int ui = 0;
    if (!S.next(0, cur)) return;
    if constexpr (GATHER) { PG8_GOFF(cv0, cv1, 0); }
    f32x4 acc[2][2][4][2];
#pragma unroll
    for (int a = 0; a < 2; ++a)
#pragma unroll
        for (int b = 0; b < 2; ++b)
#pragma unroll
            for (int m = 0; m < 4; ++m)
#pragma unroll
                for (int n = 0; n < 2; ++n) acc[a][b][m][n] = (f32x4){0.f, 0.f, 0.f, 0.f};
    bf16x8 At[4][2], B0[2][2], B1[2][2];
    const char* cA = (const char*)g.A + S.a_off(cur, tstep); const char* cB = (const char*)g.Bt + S.b_off(cur, tstep);
    S.a_ready(cur);
    if constexpr (SP2) {
        PG8_STAGE(PG8_SB(0, 0), cB, voffB); PG8_STAGE(PG8_SB(0, 1), cB + hstep, voffB); PG8_STAGEA(PG8_SA(0, 0), cA, 0, false); PG8_STAGEA(PG8_SA(0, 1), cA, 1, false);
        if (wr == 1) PG8_BAR;
        PG8_WAIT_V(2); PG8_BAR;
        PG8_STAGE(PG8_SB(1, 0), cB + kstep, voffB); PG8_STAGEA(PG8_SA(1, 0), cA + kstep, 0, false); PG8_STAGE(PG8_SB(1, 1), cB + hstep + kstep, voffB);
        PG8_WAIT_V(6); PG8_BAR;
    } else {
        PG8_STAGE(PG8_SB(0, 0), cB, voffB); PG8_STAGEA(PG8_SA(0, 0), cA, 0, false); PG8_STAGE(PG8_SB(0, 1), cB + hstep, voffB); PG8_STAGEA(PG8_SA(0, 1), cA, 1, false);
        if (wr == 1) PG8_BAR;
        PG8_WAIT_V(4); PG8_BAR;
        PG8_STAGE(PG8_SB(1, 0), cB + kstep, voffB); PG8_STAGEA(PG8_SA(1, 0), cA + kstep, 0, false); PG8_STAGE(PG8_SB(1, 1), cB + hstep + kstep, voffB);
        PG8_WAIT_V(6); PG8_BAR;
    }
    for (;;) {
        const bool has_next = S.next(ui + 1, nxt);
        if constexpr (GATHER) { if (has_next) { PG8_GOFF(nv0, nv1, ui + 1); } else { nv0[0] = cv0[0]; nv0[1] = cv0[1]; nv1[0] = cv1[0]; nv1[1] = cv1[1]; } }
        const char* nA = has_next ? (const char*)g.A + S.a_off(nxt, tstep) : cA; const char* nB = has_next ? (const char*)g.Bt + S.b_off(nxt, tstep) : cB;
        for (int t = 0; t < nt; t += 2) {
            const bool last = (t == nt - 2);
            const char* a1 = cA + (size_t)(t + 1) * kstep;
            const char* a2 = last ? nA : cA + (size_t)(t + 2) * kstep; const char* b2 = last ? nB : cB + (size_t)(t + 2) * kstep;
            const char* a3 = a2 + kstep; const char* b3 = b2 + kstep;
            if (last && has_next) S.a_ready(nxt);
            if constexpr (SP2) {
            PG8_LDB(B0, 0, 0); PG8_LDB(B1, 0, 1); PG8_SCHED; PG8_LDA(At, 0, 0); PG8_STAGEA(PG8_SA(1, 1), a1, 1, false);
            PG8_WAIT_V(8); PG8_WAIT_L(0); PG8_BAR; PG8_MMA(0, 0, At, B0); PG8_MMA(0, 1, At, B1); PG8_BAR; PG8_SCHED;
            PG8_LDA(At, 0, 1); PG8_STAGE(PG8_SB(0, 0), b2, voffB); PG8_STAGE(PG8_SB(0, 1), b2 + hstep, voffB); PG8_STAGEA(PG8_SA(0, 0), a2, 0, last);
            PG8_WAIT_V(8); PG8_WAIT_L(0); PG8_BAR; PG8_MMA(1, 0, At, B0); PG8_MMA(1, 1, At, B1); PG8_BAR; PG8_SCHED;
            PG8_LDB(B0, 1, 0); PG8_LDB(B1, 1, 1); PG8_SCHED; PG8_LDA(At, 1, 0); PG8_STAGEA(PG8_SA(0, 1), a2, 1, last);
            PG8_WAIT_V(8); PG8_WAIT_L(0); PG8_BAR; PG8_MMA(0, 0, At, B0); PG8_MMA(0, 1, At, B1); PG8_BAR; PG8_SCHED;
            PG8_LDA(At, 1, 1); PG8_STAGE(PG8_SB(1, 0), b3, voffB); PG8_STAGE(PG8_SB(1, 1), b3 + hstep, voffB); PG8_STAGEA(PG8_SA(1, 0), a3, 0, last);
            PG8_WAIT_V(8); PG8_WAIT_L(0); PG8_BAR; PG8_MMA(1, 0, At, B0); PG8_MMA(1, 1, At, B1); PG8_BAR; PG8_SCHED;
            } else {
            PG8_LDB(B0, 0, 0); PG8_SCHED; PG8_LDA(At, 0, 0); PG8_STAGEA(PG8_SA(1, 1), a1, 1, false);
            PG8_WAIT_L(8); PG8_BAR; PG8_WAIT_L(0); PG8_MMA(0, 0, At, B0); PG8_BAR; PG8_SCHED;
            PG8_LDB(B1, 0, 1); PG8_STAGE(PG8_SB(0, 0), b2, voffB);
            PG8_BAR; PG8_WAIT_L(0); PG8_MMA(0, 1, At, B1); PG8_BAR;
            PG8_LDA(At, 0, 1); PG8_STAGEA(PG8_SA(0, 0), a2, 0, last);
            PG8_BAR; PG8_WAIT_L(0); PG8_MMA(1, 0, At, B0); PG8_BAR; PG8_SCHED;
            PG8_STAGE(PG8_SB(0, 1), b2 + hstep, voffB);
            PG8_WAIT_V(6); PG8_BAR; PG8_MMA(1, 1, At, B1); PG8_BAR;
            PG8_LDB(B0, 1, 0); PG8_SCHED; PG8_LDA(At, 1, 0); PG8_STAGEA(PG8_SA(0, 1), a2, 1, last);
            PG8_WAIT_L(8); PG8_BAR; PG8_WAIT_L(0); PG8_MMA(0, 0, At, B0); PG8_BAR; PG8_SCHED;
            PG8_LDB(B1, 1, 1); PG8_STAGE(PG8_SB(1, 0), b3, voffB);
            PG8_BAR; PG8_WAIT_L(0); PG8_MMA(0, 1, At, B1); PG8_BAR;
            PG8_LDA(At, 1, 1); PG8_STAGEA(PG8_SA(1, 0), a3, 0, last);
            PG8_BAR; PG8_WAIT_L(0); PG8_MMA(1, 0, At, B0); PG8_BAR; PG8_SCHED;
            PG8_STAGE(PG8_SB(1, 1), b3 + hstep, voffB);
            PG8_WAIT_V(6); PG8_BAR; PG8_MMA(1, 1, At, B1); PG8_BAR;
            }
        }
        if constexpr (ALIGN_EPI) { if (wr == 0) PG8_BAR; }
        if constexpr (!Epi::AFTER_DRAIN) { E(acc, cur, wr, wc, fr, fq); S.done(cur); }
        if (!has_next) break;
#pragma unroll
        for (int a = 0; a < 2; ++a)
#pragma unroll
            for (int b = 0; b < 2; ++b)
#pragma unroll
                for (int m = 0; m < 4; ++m)
#pragma unroll
                    for (int n = 0; n < 2; ++n) acc[a][b][m][n] = (f32x4){0.f, 0.f, 0.f, 0.f};
        cur = nxt; cA = nA; cB = nB; ++ui;
        if constexpr (GATHER) { cv0[0] = nv0[0]; cv0[1] = nv0[1]; cv1[0] = nv1[0]; cv1[1] = nv1[1]; }
        if constexpr (ALIGN_EPI) { if (wr == 1) PG8_BAR; }
    }
    PG8_WAIT_V(0);
    if constexpr (!ALIGN_EPI) { if (wr == 0) PG8_BAR; }
    PG8_BAR;
    if constexpr (Epi::AFTER_DRAIN) { E.fused(acc, cur, wr, wc, fr, fq, lds, wid, lane); S.done(cur); }
#undef PG8_SA
#undef PG8_SB
#undef PG8_STAGE
#undef PG8_STAGEA
#undef PG8_GLDS1
#undef PG8_GOFF
#undef PG8_LDA
#undef PG8_LDB
#undef PG8_MMA
#undef PG8_WAIT_V
#undef PG8_WAIT_L
#undef PG8_BAR
#undef PG8_SCHED
}
}
#define GAS __attribute__((address_space(1)))
#define LAS __attribute__((address_space(3)))
typedef unsigned short bf16;
typedef unsigned v4u __attribute__((ext_vector_type(4)));
typedef float f32x4 __attribute__((ext_vector_type(4)));
typedef short bf16x8 __attribute__((ext_vector_type(8)));
typedef GAS unsigned gu32;
typedef GAS unsigned long long gu64;
#define RLX_AGENT __ATOMIC_RELAXED, __HIP_MEMORY_SCOPE_AGENT
#define LDS_WAIT() asm volatile("s_waitcnt lgkmcnt(0)" ::: "memory")
#define VM_WAIT() asm volatile("s_waitcnt vmcnt(0)" ::: "memory")
__device__ __forceinline__ unsigned long long rt() { return __builtin_amdgcn_s_memrealtime(); }
__device__ __forceinline__ unsigned f2bfu(float f) { unsigned u = __builtin_bit_cast(unsigned, f); return (u + 0x7fffu + ((u >> 16) & 1u)) >> 16; }
__device__ __forceinline__ unsigned pk2(float lo, float hi) { return f2bfu(lo) | (f2bfu(hi) << 16); }

#define XB_TMO      128
#define XB_XCNT(j)  (256  + 64 * (j))
#define XB_XSUB(j)  (1280 + 64 * (j))
#define XB_XGEN(j)  (2304 + 64 * (j))
#define XB_TOP      3328
#define XB_TOPGEN   3392
#define XCD_BAR_WORDS 3456
#define XB_SPIN_CAP (1u << 18)

__device__ __forceinline__ unsigned xb_ld(unsigned* p)              { return __hip_atomic_load(p, __ATOMIC_RELAXED, __HIP_MEMORY_SCOPE_AGENT); }
__device__ __forceinline__ unsigned xb_add(unsigned* p, unsigned v) { return __hip_atomic_fetch_add(p, v, __ATOMIC_RELAXED, __HIP_MEMORY_SCOPE_AGENT); }
__device__ __forceinline__ unsigned xb_xcc_id() { return (unsigned)__builtin_amdgcn_s_getreg((3 << 11) | 20) & 0xFu; }
#define XB_SPIN(cond, bar) do { unsigned _sp = 0; while (cond) { __builtin_amdgcn_s_sleep(1); \
    if ((++_sp & 255u) == 0u) { if (xb_ld(&(bar)[XB_TMO])) break; if (_sp > XB_SPIN_CAP) { atomicAdd(&(bar)[XB_TMO], 1u); break; } } } } while (0)

struct XcdBarrier {
    unsigned* bar; unsigned x;
    volatile LAS unsigned* st;
};

__device__ __forceinline__ XcdBarrier xcd_barrier_post(unsigned* bar, volatile LAS unsigned* st) {
    XcdBarrier b; b.bar = bar; b.x = xb_xcc_id(); b.st = st;
    if (threadIdx.x == 0) (void)xb_add(&bar[XB_XCNT(b.x)], 1u);
    return b;
}
__device__ __forceinline__ void xcd_barrier_complete(unsigned* bar, unsigned x, unsigned& nloc, unsigned& nx) {
    const unsigned G = gridDim.x * gridDim.y * gridDim.z;
    unsigned sum, cnt, mine, sp = 0u;
    for (;;) {
        sum = 0u; cnt = 0u; mine = 0u;
#pragma unroll
        for (unsigned j = 0; j < 16; ++j) { const unsigned c = xb_ld(&bar[XB_XCNT(j)]); sum += c; cnt += (c > 0u) ? 1u : 0u; mine = (j == x) ? c : mine; }
        if (sum == G) break;
        __builtin_amdgcn_s_sleep(1);
        if ((++sp & 255u) == 0u) { if (xb_ld(&bar[XB_TMO])) break; if (sp > XB_SPIN_CAP) { atomicAdd(&bar[XB_TMO], 1u); break; } }
    }
    nloc = mine > 0u ? mine : 1u; nx = cnt > 0u ? cnt : 1u;
}

__device__ __forceinline__ void xcd_barrier(const XcdBarrier& b) {
    asm volatile("s_waitcnt vmcnt(0)" ::: "memory");
    __syncthreads();
    if (threadIdx.x == 0) {
        unsigned* bar = b.bar;
        __builtin_amdgcn_s_waitcnt(0);
        unsigned nloc = b.st[0], nx = b.st[1];
        if (nloc == 0u) { xcd_barrier_complete(bar, b.x, nloc, nx); b.st[0] = nloc; b.st[1] = nx; }
        const unsigned old = xb_add(&bar[XB_XSUB(b.x)], 1u);
        const unsigned gen = old / nloc;
        if (old + 1u == (gen + 1u) * nloc) {
            __builtin_amdgcn_fence(__ATOMIC_RELEASE, "agent");
            asm volatile("s_waitcnt vmcnt(0)" ::: "memory");
            const unsigned og = xb_add(&bar[XB_TOP], 1u);
            const unsigned tg = og / nx;
            if (og + 1u == (tg + 1u) * nx) xb_add(&bar[XB_TOPGEN], 1u);
            else XB_SPIN(xb_ld(&bar[XB_TOPGEN]) == tg, bar);
            __builtin_amdgcn_fence(__ATOMIC_ACQUIRE, "agent");
            xb_add(&bar[XB_XGEN(b.x)], 1u);
            asm volatile("s_waitcnt vmcnt(0)" ::: "memory");
        } else {
            XB_SPIN(xb_ld(&bar[XB_XGEN(b.x)]) == gen, bar);
            __builtin_amdgcn_fence(__ATOMIC_ACQUIRE, "agent");
            asm volatile("s_waitcnt vmcnt(0)" ::: "memory");
        }
    }
    __syncthreads();
}

template <bool DUAL, class FA, class FB, class FB2, class FE>
__device__ __forceinline__ void naive_tile_h(float* sm, int t256, int K, FA fa, FB fb, FB2 fb2, FE fe) {
    float* As = sm; float* Bs = sm + 1088; float* Bs2 = sm + 2176;
    const int tx = t256 & 15, ty = t256 >> 4;
    float acc[4][4], acc2[4][4];
#pragma unroll
    for (int i = 0; i < 4; ++i)
#pragma unroll
        for (int j = 0; j < 4; ++j) { acc[i][j] = 0.f; acc2[i][j] = 0.f; }
    for (int k0 = 0; k0 < K; k0 += 16) {
        { const int r = t256 >> 2, kk = (t256 & 3) * 4; const float4 a = fa(r, k0 + kk); As[kk * 68 + r] = a.x; As[(kk + 1) * 68 + r] = a.y; As[(kk + 2) * 68 + r] = a.z; As[(kk + 3) * 68 + r] = a.w; }
        { const int kk = t256 >> 4, c = (t256 & 15) * 4; *(float4*)&Bs[kk * 68 + c] = fb(k0 + kk, c); if (DUAL) *(float4*)&Bs2[kk * 68 + c] = fb2(k0 + kk, c); }
        __syncthreads();
#pragma unroll
        for (int kk = 0; kk < 16; ++kk) {
            const float4 a = *(const float4*)&As[kk * 68 + ty * 4]; const float4 b = *(const float4*)&Bs[kk * 68 + tx * 4];
            const float av[4] = {a.x, a.y, a.z, a.w}; const float bv[4] = {b.x, b.y, b.z, b.w};
#pragma unroll
            for (int i = 0; i < 4; ++i)
#pragma unroll
                for (int j = 0; j < 4; ++j) acc[i][j] += av[i] * bv[j];
            if (DUAL) {
                const float4 b2 = *(const float4*)&Bs2[kk * 68 + tx * 4]; const float bw[4] = {b2.x, b2.y, b2.z, b2.w};
#pragma unroll
                for (int i = 0; i < 4; ++i)
#pragma unroll
                    for (int j = 0; j < 4; ++j) acc2[i][j] += av[i] * bw[j];
            }
        }
        __syncthreads();
    }
#pragma unroll
    for (int i = 0; i < 4; ++i) fe(ty * 4 + i, tx * 4, make_float4(acc[i][0], acc[i][1], acc[i][2], acc[i][3]), make_float4(acc2[i][0], acc2[i][1], acc2[i][2], acc2[i][3]));
}

__device__ __forceinline__ void ph_la(int gtid, int nthr, const bf16_t* PROJ, const float* upf, const float* bf, const float* upb, const float* bb, float* LAF, float* LAB) {
    for (int i = gtid; i < NTOK * 256 * 2; i += nthr) {
        const int c = i & 255, t = (i >> 8) & (NTOK - 1), dir = i >> 23;
        const bf16_t* z = PROJ + (size_t)t * PW + (dir ? C_ZB : C_ZF);
        const float* up = dir ? upb : upf; const float* bias = dir ? bb : bf;
        float pre = bias[c];
#pragma unroll
        for (int r = 0; r < 16; ++r) pre += bf2f(z[r]) * up[r * 256 + c];
        const float ls = fminf(pre, 0.f) - log1pf(expf(-fabsf(pre)));
        (dir ? LAB : LAF)[(size_t)t * 256 + c] = ls * (1.f / 16.f);
    }
}
__device__ __forceinline__ void ph_gla_scan(int bid, int tid, const bf16_t* PROJ, const float* LAF, const float* LAB, float* OF, float* OB) {
    const int es = bid & 3, dir = (bid >> 2) & 1, h = (bid >> 3) & 3, b = bid >> 5;
    const int dg = tid & 15, el = tid >> 4, e = es * 32 + el;
    const float* LA = dir ? LAB : LAF; float* O = dir ? OB : OF;
    float S0 = 0.f, S1 = 0.f, S2 = 0.f, S3 = 0.f;
#pragma unroll 4
    for (int step = 0; step < T; ++step) {
        const int t = dir ? (T - 1 - step) : step;
        const size_t row = (size_t)b * T + t;
        const bf16_t* pr = PROJ + row * PW;
        const float4 la = *(const float4*)(LA + row * 256 + h * 64 + dg * 4);
        const float4 q = ld_bf4(pr + C_GQ + h * 64 + dg * 4);
        const float4 k = ld_bf4(pr + C_GK + h * 64 + dg * 4);
        const float v = bf2f(pr[C_GV + h * 128 + e]);
        S0 = expf(la.x) * S0 + k.x * v; S1 = expf(la.y) * S1 + k.y * v; S2 = expf(la.z) * S2 + k.z * v; S3 = expf(la.w) * S3 + k.w * v;
        float part = (q.x * S0 + q.y * S1 + q.z * S2 + q.w * S3) * 0.125f;
        part += __shfl_xor(part, 1); part += __shfl_xor(part, 2); part += __shfl_xor(part, 4); part += __shfl_xor(part, 8);
        if (dg == 0) O[row * 512 + h * 128 + e] = part;
    }
}
__device__ __forceinline__ void ph_gla_combine(int gw, int NGW, int lane, const float* OF, const float* OB, const bf16_t* PROJ, const float* gain, bf16_t* MIXED) {
    for (int w = gw; w < NTOK * 4; w += NGW) {
        const int t = w >> 2, h = w & 3;
        const size_t o = (size_t)t * 512 + h * 128 + lane * 2;
        const float2 a = *(const float2*)(OF + o), bq = *(const float2*)(OB + o);
        const float v0 = a.x + bq.x, v1 = a.y + bq.y;
        const float ss = wave_sum(v0 * v0 + v1 * v1);
        const float rstd = rsqrtf(ss * (1.f / 128.f) + EPS);
        const bf16_t* g = PROJ + (size_t)t * PW + C_GG + h * 128 + lane * 2;
        const float g0 = bf2f(g[0]), g1 = bf2f(g[1]);
        bf16_t* m = MIXED + (size_t)t * D + h * 128 + lane * 2;
        m[0] = f2bf(v0 * rstd * gain[lane * 2] * silu_f(g0)); m[1] = f2bf(v1 * rstd * gain[lane * 2 + 1] * silu_f(g1));
    }
}
__device__ __forceinline__ void ph_qk_prep(int gw, int NGW, int lane, bf16_t* PROJ, const float* qg, const float* kg, const float* rope, bf16_t* OUT, int opitch) {
    const float gq = qg[lane], gk = kg[lane];
    const int pi = lane >> 1, j = pi & 15;
    for (int t = gw; t < NTOK; t += NGW) {
        bf16_t* p = PROJ + (size_t)t * PW + C_AQ + lane;
        float v[10];
#pragma unroll
        for (int hs = 8; hs < 10; ++hs) v[hs] = bf2f(p[hs * 64]);
        const int tt = t & (T - 1), pos = pi < 16 ? (tt >> 6) : (tt & 63);
        const float c = rope[pos * 16 + j], s = rope[1024 + pos * 16 + j];
#pragma unroll
        for (int hs = 8; hs < 10; ++hs) {
            const float ss = wave_sum(v[hs] * v[hs]);
            const float y = v[hs] * rsqrtf(ss * (1.f / 64.f) + EPS) * (hs < 8 ? gq : gk);
            const float partner = __shfl_xor(y, 1);
            float o = (lane & 1) ? (partner * s + y * c) : (y * c - partner * s);
            if (hs < 8) o *= 0.125f * 1.4426950408889634f;
            OUT[(size_t)t * opitch + lane + hs * 64] = f2bf(o);
        }
    }
}
__device__ __forceinline__ void ph_attn_vb(float* sm, int t256, int vb, const bf16_t* PROJ, float* ATT) {
    float* Qt = sm; float* KV = sm + 4352; float* St = sm + 8704; float* al = sm + 13056;
    const int tx = t256 & 15, ty = t256 >> 4;
    const int q0 = (vb & 63) * 64, hq = (vb >> 6) & 7, b = vb >> 9, kvh = hq >> 2;
    const size_t rowb = (size_t)b * T;
    { const int r = t256 >> 2, d0 = (t256 & 3) * 16; const bf16_t* p = PROJ + (rowb + q0 + r) * PW + C_AQ + hq * 64 + d0;
#pragma unroll
      for (int i = 0; i < 16; ++i) Qt[(d0 + i) * 68 + r] = bf2f(p[i]); }
    float O[4][4];
#pragma unroll
    for (int i = 0; i < 4; ++i)
#pragma unroll
        for (int j = 0; j < 4; ++j) O[i][j] = 0.f;
    float m_run = -INFINITY, l_run = 0.f;
    for (int k0 = 0; k0 < T; k0 += 64) {
        { const int c = t256 >> 2, d0 = (t256 & 3) * 16; const bf16_t* p = PROJ + (rowb + k0 + c) * PW + C_AK + kvh * 64 + d0;
#pragma unroll
          for (int i = 0; i < 16; ++i) KV[(d0 + i) * 68 + c] = bf2f(p[i]); }
        __syncthreads();
        float s[4][4];
#pragma unroll
        for (int i = 0; i < 4; ++i)
#pragma unroll
            for (int j = 0; j < 4; ++j) s[i][j] = 0.f;
#pragma unroll 8
        for (int d = 0; d < 64; ++d) {
            const float4 a = *(const float4*)&Qt[d * 68 + ty * 4]; const float4 bq = *(const float4*)&KV[d * 68 + tx * 4];
            const float av[4] = {a.x, a.y, a.z, a.w}; const float bv[4] = {bq.x, bq.y, bq.z, bq.w};
#pragma unroll
            for (int i = 0; i < 4; ++i)
#pragma unroll
                for (int j = 0; j < 4; ++j) s[i][j] += av[i] * bv[j];
        }
#pragma unroll
        for (int i = 0; i < 4; ++i)
#pragma unroll
            for (int j = 0; j < 4; ++j) St[(tx * 4 + j) * 68 + ty * 4 + i] = s[i][j];
        __syncthreads();
        { const int c = t256 >> 2, e0 = (t256 & 3) * 16; const bf16_t* p = PROJ + (rowb + k0 + c) * PW + C_AV + kvh * 64 + e0;
#pragma unroll
          for (int i = 0; i < 16; ++i) KV[c * 68 + e0 + i] = bf2f(p[i]); }
        if (t256 < 64) {
            float mx = -INFINITY;
            for (int c = 0; c < 64; ++c) mx = fmaxf(mx, St[c * 68 + t256]);
            const float mn = fmaxf(m_run, mx);
            const float alpha = expf(m_run - mn);
            float sum = 0.f;
            for (int c = 0; c < 64; ++c) { const float p = expf(St[c * 68 + t256] - mn); St[c * 68 + t256] = p; sum += p; }
            l_run = l_run * alpha + sum; m_run = mn; al[t256] = alpha;
        }
        __syncthreads();
#pragma unroll
        for (int i = 0; i < 4; ++i) { const float a = al[ty * 4 + i];
#pragma unroll
            for (int j = 0; j < 4; ++j) O[i][j] *= a; }
#pragma unroll 8
        for (int c = 0; c < 64; ++c) {
            const float4 a = *(const float4*)&St[c * 68 + ty * 4]; const float4 bq = *(const float4*)&KV[c * 68 + tx * 4];
            const float av[4] = {a.x, a.y, a.z, a.w}; const float bv[4] = {bq.x, bq.y, bq.z, bq.w};
#pragma unroll
            for (int i = 0; i < 4; ++i)
#pragma unroll
                for (int j = 0; j < 4; ++j) O[i][j] += av[i] * bv[j];
        }
        __syncthreads();
    }
    if (t256 < 64) al[t256] = 1.f / l_run;
    __syncthreads();
#pragma unroll
    for (int i = 0; i < 4; ++i) { const float a = al[ty * 4 + i];
        *(float4*)(ATT + (rowb + q0 + ty * 4 + i) * 512 + hq * 64 + tx * 4) = make_float4(O[i][0] * a, O[i][1] * a, O[i][2] * a, O[i][3] * a); }
    __syncthreads();
}
__device__ __forceinline__ void ph_att_norm(int gw, int NGW, int lane, const float* ATT, const float* gain, bf16_t* MIXED) {
    for (int t = gw; t < NTOK; t += NGW) {
        const float4* a = (const float4*)(ATT + (size_t)t * 512);
        const float4 v0 = a[lane], v1 = a[64 + lane];
        const float ss = wave_sum(v0.x * v0.x + v0.y * v0.y + v0.z * v0.z + v0.w * v0.w + v1.x * v1.x + v1.y * v1.y + v1.z * v1.z + v1.w * v1.w);
        const float rstd = rsqrtf(ss * (1.f / 512.f) + EPS);
        const float4 g0 = ((const float4*)gain)[lane], g1 = ((const float4*)gain)[64 + lane];
        bf16_t* m = MIXED + (size_t)t * D + 512;
        st_bf4(m + lane * 4, make_float4(v0.x * rstd * g0.x, v0.y * rstd * g0.y, v0.z * rstd * g0.z, v0.w * rstd * g0.w));
        st_bf4(m + 256 + lane * 4, make_float4(v1.x * rstd * g1.x, v1.y * rstd * g1.y, v1.z * rstd * g1.z, v1.w * rstd * g1.w));
    }
}
__device__ __forceinline__ void ph_router(int gw, int NGW, int lane, const float* H, const float* g2, const float* wg, const float* bg, const float* we, const float* be, float* RSTD, unsigned* tokinfo, unsigned* ctl) {
    for (int t = gw; t < NTOK; t += NGW) {
        const float4* hr = (const float4*)(H + (size_t)t * D);
        float ss = 0.f;
#pragma unroll
        for (int j = 0; j < 4; ++j) { const float4 v = hr[j * 64 + lane]; ss += v.x * v.x + v.y * v.y + v.z * v.z + v.w * v.w; }
        ss = wave_sum(ss);
        const float rstd = rsqrtf(ss * (1.f / D) + EPS);
        float gl[8], el[64];
#pragma unroll
        for (int i = 0; i < 8; ++i) gl[i] = 0.f;
#pragma unroll
        for (int i = 0; i < 64; ++i) el[i] = 0.f;
#pragma unroll 1
        for (int ji = 0; ji < 16; ++ji) {
            const int k = ((ji >> 2) * 64 + lane) * 4 + (ji & 3);
            const float xv = H[(size_t)t * D + k] * rstd * g2[k];
            const float4* pg = (const float4*)(wg + (size_t)k * 8);
#pragma unroll
            for (int q = 0; q < 2; ++q) { const float4 w = pg[q]; gl[q * 4] += xv * w.x; gl[q * 4 + 1] += xv * w.y; gl[q * 4 + 2] += xv * w.z; gl[q * 4 + 3] += xv * w.w; }
            const float4* pe = (const float4*)(we + (size_t)k * 64);
#pragma unroll
            for (int q = 0; q < 16; ++q) { const float4 w = pe[q]; el[q * 4] += xv * w.x; el[q * 4 + 1] += xv * w.y; el[q * 4 + 2] += xv * w.z; el[q * 4 + 3] += xv * w.w; }
        }
#pragma unroll
        for (int i = 0; i < 8; ++i) gl[i] = wave_sum(gl[i]) + bg[i];
#pragma unroll
        for (int i = 0; i < 64; ++i) el[i] = wave_sum(el[i]) + be[i];
        float best = gl[0]; int g = 0;
#pragma unroll
        for (int i = 1; i < 8; ++i) if (gl[i] > best) { best = gl[i]; g = i; }
        float den = 0.f;
#pragma unroll
        for (int i = 0; i < 8; ++i) den += expf(gl[i] - best);
        const float gw_ = 1.f / den;
        float ev[8];
#pragma unroll
        for (int j = 0; j < 8; ++j) { float v = el[j];
#pragma unroll
            for (int q = 1; q < 8; ++q) v = (g == q) ? el[q * 8 + j] : v;
            ev[j] = v; }
        float v1 = ev[0]; int i1 = 0;
#pragma unroll
        for (int j = 1; j < 8; ++j) if (ev[j] > v1) { v1 = ev[j]; i1 = j; }
        float v2 = -INFINITY; int i2 = 0;
#pragma unroll
        for (int j = 0; j < 8; ++j) if (j != i1 && ev[j] > v2) { v2 = ev[j]; i2 = j; }
        const float ex = expf(v2 - v1), p1 = 1.f / (1.f + ex), p2 = ex * p1;
        if (lane == 0) {
            const int e1 = g * 8 + i1, e2 = g * 8 + i2;
            uint4 o; o.x = (unsigned)e1; o.y = (unsigned)e2; o.z = __float_as_uint(gw_ * p1); o.w = __float_as_uint(gw_ * p2);
            ((uint4*)tokinfo)[t] = o;
            RSTD[t] = rstd;
            atomicAdd(&ctl[CW_COUNTS + e1], 1u); atomicAdd(&ctl[CW_COUNTS + e2], 1u);
        }
    }
}
__device__ __forceinline__ void ph_offsets(unsigned* ctl) {
    unsigned off = 0, nt = 0;
    for (int e = 0; e < NEXP; ++e) {
        const unsigned c = ctl[CW_COUNTS + e]; ctl[CW_OFFS + e] = off;
        for (unsigned r = 0; r < c; r += 64) { ctl[CW_TILE_E + nt] = (unsigned)e; ctl[CW_TILE_R0 + nt] = off + r; ctl[CW_TILE_NR + nt] = (c - r) < 64u ? (c - r) : 64u; ++nt; }
        off += c;
    }
    ctl[CW_OFFS + NEXP] = off; ctl[CW_NTILES] = nt;
}
__device__ __forceinline__ void ph_scatter(int gtid, int nthr, const unsigned* tokinfo, unsigned* ctl, int* tokslot, int* slottok, float* slotgate) {
    for (int t = gtid; t < NTOK; t += nthr) {
        const uint4 ti = ((const uint4*)tokinfo)[t];
        const unsigned p0 = ctl[CW_OFFS + ti.x] + atomicAdd(&ctl[CW_CURSOR + ti.x], 1u);
        const unsigned p1 = ctl[CW_OFFS + ti.y] + atomicAdd(&ctl[CW_CURSOR + ti.y], 1u);
        slottok[p0] = t; slottok[p1] = t; slotgate[p0] = __uint_as_float(ti.z); slotgate[p1] = __uint_as_float(ti.w);
        tokslot[2 * t] = (int)p0; tokslot[2 * t + 1] = (int)p1;
    }
}
__device__ __forceinline__ void ph_moe1_vb(float* sm, int t256, bool valid, int vb, const bf16_t* XN2, const float* w_gate, const float* w_up, const unsigned* ctl, const int* slottok, bf16_t* HMID) {
    const int tile = valid ? (vb >> 3) : 0, c0 = (vb & 7) * 64;
    const int e = (int)ctl[CW_TILE_E + tile], row0 = (int)ctl[CW_TILE_R0 + tile], nr = valid ? (int)ctl[CW_TILE_NR + tile] : 0;
    const float* wgp = w_gate + (size_t)e * D * DEXP; const float* wup = w_up + (size_t)e * D * DEXP;
    auto fa = [&](int r, int k) { if (r >= nr) return make_float4(0.f, 0.f, 0.f, 0.f); const int tok = slottok[row0 + r]; return ld_bf4(XN2 + (size_t)tok * D + k); };
    auto fb = [&](int k, int c) { return *(const float4*)(wgp + (size_t)k * DEXP + c0 + c); };
    auto fb2 = [&](int k, int c) { return *(const float4*)(wup + (size_t)k * DEXP + c0 + c); };
    auto fe = [&](int r, int c, float4 a, float4 u) { if (r >= nr) return; st_bf4(HMID + (size_t)(row0 + r) * DEXP + c0 + c, make_float4(silu_f(a.x) * u.x, silu_f(a.y) * u.y, silu_f(a.z) * u.z, silu_f(a.w) * u.w)); };
    naive_tile_h<true>(sm, t256, D, fa, fb, fb2, fe);
}
__device__ __forceinline__ void ph_moe2_vb(float* sm, int t256, bool valid, int vb, const bf16_t* HMID, const float* w_down, const unsigned* ctl, const float* slotgate, bf16_t* YS) {
    const int tile = valid ? (vb >> 4) : 0, c0 = (vb & 15) * 64;
    const int e = (int)ctl[CW_TILE_E + tile], row0 = (int)ctl[CW_TILE_R0 + tile], nr = valid ? (int)ctl[CW_TILE_NR + tile] : 0;
    const float* wd = w_down + (size_t)e * DEXP * D;
    auto fa = [&](int r, int k) { if (r >= nr) return make_float4(0.f, 0.f, 0.f, 0.f); return ld_bf4(HMID + (size_t)(row0 + r) * DEXP + k); };
    auto fb = [&](int k, int c) { return *(const float4*)(wd + (size_t)k * D + c0 + c); };
    auto fe = [&](int r, int c, float4 a, float4) { if (r >= nr) return; const float g = slotgate[row0 + r]; st_bf4(YS + (size_t)(row0 + r) * D + c0 + c, make_float4(a.x * g, a.y * g, a.z * g, a.w * g)); };
    naive_tile_h<false>(sm, t256, DEXP, fa, fb, fb, fe);
}
__device__ __forceinline__ void ph_final(int gw, int NGW, int lane, const bf16_t* H, const unsigned char* YS8, const float* YSC, const int* tokslot, const float* fg, float* OUTA, float* OUTB) {
    const int sub = (lane & 31) >> 3;
    float4 g[4];
#pragma unroll
    for (int j = 0; j < 4; ++j) g[j] = ((const float4*)fg)[j * 64 + lane];
    for (int t = 2 * gw; t < NTOK; t += 2 * NGW) {
        const int4 sl = *(const int4*)(tokslot + 2 * t);
        float4 v[2][4]; float ss[2] = {0.f, 0.f};
#pragma unroll
        for (int q = 0; q < 2; ++q) {
            const int s0 = q ? sl.z : sl.x, s1 = q ? sl.w : sl.y;
            const bf16_t* hr = H + (size_t)(t + q) * D;
            const unsigned* y0 = (const unsigned*)(YS8 + (size_t)s0 * D); const unsigned* y1 = (const unsigned*)(YS8 + (size_t)s1 * D);
            const float4 a0 = *(const float4*)(YSC + (size_t)s0 * 16 + sub * 4), a1 = *(const float4*)(YSC + (size_t)s1 * 16 + sub * 4);
            const float a0j[4] = {a0.x, a0.y, a0.z, a0.w}, a1j[4] = {a1.x, a1.y, a1.z, a1.w};
#pragma unroll
            for (int j = 0; j < 4; ++j) {
                const float4 hv = ld_bf4(hr + (j * 64 + lane) * 4); const unsigned w0 = y0[j * 64 + lane], w1 = y1[j * 64 + lane];
                const float p = a0j[j], r = a1j[j], off = -128.f * (p + r);
                v[q][j] = make_float4((hv.x + off) + p * (float)(w0 & 0xffu) + r * (float)(w1 & 0xffu), (hv.y + off) + p * (float)((w0 >> 8) & 0xffu) + r * (float)((w1 >> 8) & 0xffu),
                                      (hv.z + off) + p * (float)((w0 >> 16) & 0xffu) + r * (float)((w1 >> 16) & 0xffu), (hv.w + off) + p * (float)(w0 >> 24) + r * (float)(w1 >> 24));
                ss[q] += v[q][j].x * v[q][j].x + v[q][j].y * v[q][j].y + v[q][j].z * v[q][j].z + v[q][j].w * v[q][j].w;
            }
        }
#pragma unroll
        for (int q = 0; q < 2; ++q) {
            const float rstd = rsqrtf(wave_sum(ss[q]) * (1.f / D) + EPS);
            const int tt = t + q;
            float4* orow = (float4*)((tt < NTOK / 2 ? OUTA + (size_t)tt * D : OUTB + (size_t)(tt - NTOK / 2) * D));
#pragma unroll
            for (int j = 0; j < 4; ++j) orow[j * 64 + lane] = make_float4(v[q][j].x * rstd * g[j].x, v[q][j].y * rstd * g[j].y, v[q][j].z * rstd * g[j].z, v[q][j].w * rstd * g[j].w);
        }
    }
}
__device__ __forceinline__ void ph_copy_xs(int bx, int wave, int lane, const LAS int* pos, const float* H, const float* RSTD, const float* g2, bf16_t* XS) {
    float4 g[4];
#pragma unroll
    for (int j = 0; j < 4; ++j) g[j] = ((const float4*)g2)[j * 64 + lane];
#pragma unroll 1
    for (int i = 0; i < 16; i += 2) {
        const int l0 = wave * 16 + i, l1 = l0 + 1, t0 = bx * 128 + l0, t1 = t0 + 1;
        const float r0 = RSTD[t0], r1 = RSTD[t1];
        const float4* h0 = (const float4*)(H + (size_t)t0 * D); const float4* h1 = (const float4*)(H + (size_t)t1 * D);
        float4 a[4], b[4];
#pragma unroll
        for (int j = 0; j < 4; ++j) { a[j] = h0[j * 64 + lane]; b[j] = h1[j * 64 + lane]; }
        uint2* o00 = (uint2*)(XS + (size_t)pos[2 * l0] * D); uint2* o01 = (uint2*)(XS + (size_t)pos[2 * l0 + 1] * D);
        uint2* o10 = (uint2*)(XS + (size_t)pos[2 * l1] * D); uint2* o11 = (uint2*)(XS + (size_t)pos[2 * l1 + 1] * D);
#pragma unroll
        for (int j = 0; j < 4; ++j) {
            uint2 w; w.x = (unsigned)f2bf(a[j].x * r0 * g[j].x) | ((unsigned)f2bf(a[j].y * r0 * g[j].y) << 16); w.y = (unsigned)f2bf(a[j].z * r0 * g[j].z) | ((unsigned)f2bf(a[j].w * r0 * g[j].w) << 16);
            o00[j * 64 + lane] = w; o01[j * 64 + lane] = w;
            uint2 v; v.x = (unsigned)f2bf(b[j].x * r1 * g[j].x) | ((unsigned)f2bf(b[j].y * r1 * g[j].y) << 16); v.y = (unsigned)f2bf(b[j].z * r1 * g[j].z) | ((unsigned)f2bf(b[j].w * r1 * g[j].w) << 16);
            o10[j * 64 + lane] = v; o11[j * 64 + lane] = v;
        }
    }
}

__device__ __forceinline__ void ph_copy_xs_i8(int bx, int wave, int lane, const LAS int* pos, const bf16_t* H, const float* RSTD, const float* g2, unsigned char* XS8, float* SA) {
    float4 g[4];
#pragma unroll
    for (int j = 0; j < 4; ++j) g[j] = ((const float4*)g2)[lane * 4 + j];
#pragma unroll 1
    for (int i = 0; i < 16; i += 2) {
        const int l0 = wave * 16 + i, t0 = bx * 128 + l0;
        float4 a[2][4]; float mx[2];
#pragma unroll
        for (int q = 0; q < 2; ++q) { const uint4* hp = (const uint4*)(H + (size_t)(t0 + q) * D + lane * 16); const uint4 h0 = hp[0], h1 = hp[1];
            const unsigned hw[8] = {h0.x, h0.y, h0.z, h0.w, h1.x, h1.y, h1.z, h1.w};
#pragma unroll
            for (int j = 0; j < 4; ++j) a[q][j] = make_float4(__uint_as_float(hw[2 * j] << 16), __uint_as_float(hw[2 * j] & 0xffff0000u), __uint_as_float(hw[2 * j + 1] << 16), __uint_as_float(hw[2 * j + 1] & 0xffff0000u)); }
#pragma unroll
        for (int q = 0; q < 2; ++q) { const float r = RSTD[t0 + q]; float m = 0.f;
#pragma unroll
            for (int j = 0; j < 4; ++j) { a[q][j].x *= r * g[j].x; a[q][j].y *= r * g[j].y; a[q][j].z *= r * g[j].z; a[q][j].w *= r * g[j].w;
                m = fmaxf(m, fmaxf(fmaxf(fabsf(a[q][j].x), fabsf(a[q][j].y)), fmaxf(fabsf(a[q][j].z), fabsf(a[q][j].w)))); }
#pragma unroll
            for (int o = 1; o < 64; o <<= 1) m = fmaxf(m, __shfl_xor(m, o));
            mx[q] = m; }
#pragma unroll
        for (int q = 0; q < 2; ++q) { const float inv = mx[q] > 0.f ? 127.f / mx[q] : 0.f;
            v4u w;
#pragma unroll
            for (int j = 0; j < 4; ++j) { const int ia = __float2int_rn(a[q][j].x * inv), ib = __float2int_rn(a[q][j].y * inv), ic = __float2int_rn(a[q][j].z * inv), id = __float2int_rn(a[q][j].w * inv);
                w[j] = ((unsigned)ia & 0xffu) | (((unsigned)ib & 0xffu) << 8) | (((unsigned)ic & 0xffu) << 16) | ((unsigned)id << 24); }
            const int p0 = pos[2 * (l0 + q)], p1 = pos[2 * (l0 + q) + 1];
            *(GAS v4u*)(XS8 + (size_t)p0 * D + lane * 16) = w; *(GAS v4u*)(XS8 + (size_t)p1 * D + lane * 16) = w;
            if (lane == 0) { SA[p0] = mx[q] * (1.f / 127.f); SA[p1] = mx[q] * (1.f / 127.f); } }
    }
}
constexpr size_t WS_DEC = 11 * MiB;
constexpr int LDT = 72;
constexpr int GL_QE = 0, GL_KE = 9216, GL_P = 18432, GL_VT = 27648, GL_ST = 46080, GL_TOT = 64512, GL_PART = 68608, GL_RSTD = 70656;
typedef float gf32x4 __attribute__((ext_vector_type(4)));
typedef short gbf16x8 __attribute__((ext_vector_type(8)));

__device__ __forceinline__ float exp_fast(float x) { return __builtin_amdgcn_exp2f(x * 1.4426950408889634f); }
__device__ __forceinline__ float log_sigmoid_f(float x) { return fminf(x, 0.f) - 0.6931471805599453f * __builtin_amdgcn_logf(1.f + exp_fast(-fabsf(x))); }
__device__ __forceinline__ gf32x4 mfma_tile64(const LAS bf16_t* A, const LAS bf16_t* Bt, gf32x4 acc, int lane) {
    const int r = lane & 15, kq = (lane >> 4) * 8;
    const gbf16x8 a0 = *(const LAS gbf16x8*)(A + r * LDT + kq), a1 = *(const LAS gbf16x8*)(A + r * LDT + kq + 32);
    const gbf16x8 b0 = *(const LAS gbf16x8*)(Bt + r * LDT + kq), b1 = *(const LAS gbf16x8*)(Bt + r * LDT + kq + 32);
    acc = __builtin_amdgcn_mfma_f32_16x16x32_bf16(a0, b0, acc, 0, 0, 0);
    acc = __builtin_amdgcn_mfma_f32_16x16x32_bf16(a1, b1, acc, 0, 0, 0);
    return acc;
}
template <bool BWD>
__device__ __forceinline__ void gla_cumsum(const bf16_t* zbase  , const float* up  , const float* bias, int hd  , int tg, int d, LAS float* tot, float (&bv)[8], float& bl) {
    float upc[16];
#pragma unroll
    for (int r = 0; r < 16; ++r) upc[r] = up[r * 256 + hd];
    const float bs = bias[hd];
    float c[8];
#pragma unroll
    for (int i = 0; i < 8; ++i) {
        const uint4* zp = (const uint4*)(zbase + (size_t)(8 * tg + i) * PW);
        const uint4 z0 = zp[0], z1 = zp[1];
        const unsigned zw[8] = {z0.x, z0.y, z0.z, z0.w, z1.x, z1.y, z1.z, z1.w};
        float pre = bs;
#pragma unroll
        for (int r = 0; r < 8; ++r) { pre += __uint_as_float(zw[r] << 16) * upc[2 * r]; pre += __uint_as_float(zw[r] & 0xffff0000u) * upc[2 * r + 1]; }
        c[i] = log_sigmoid_f(pre) * (1.f / 16.f);
    }
    if (!BWD) {
#pragma unroll
        for (int i = 1; i < 8; ++i) c[i] += c[i - 1];
        tot[tg * 64 + d] = c[7];
    } else {
#pragma unroll
        for (int i = 6; i >= 0; --i) c[i] += c[i + 1];
        tot[tg * 64 + d] = c[0];
    }
    __syncthreads();
    float off = 0.f, all = 0.f;
#pragma unroll
    for (int t2 = 0; t2 < 8; ++t2) { const float v = tot[t2 * 64 + d]; all += v; if (BWD ? (t2 > tg) : (t2 < tg)) off += v; }
#pragma unroll
    for (int i = 0; i < 8; ++i) bv[i] = c[i] + off;
    bl = all;
}
__device__ __forceinline__ void gla_stage_vt(const bf16_t* vbase, LAS bf16_t* VT, int tid) {
    const int s = tid & 63, e0 = (tid >> 6) * 16;
    const uint4* vp = (const uint4*)(vbase + (size_t)s * PW + e0);
    const uint4 v0 = vp[0], v1 = vp[1];
    const unsigned w[8] = {v0.x, v0.y, v0.z, v0.w, v1.x, v1.y, v1.z, v1.w};
#pragma unroll
    for (int i = 0; i < 8; ++i) { VT[(e0 + 2 * i) * LDT + s] = (bf16_t)(w[i] & 0xffffu); VT[(e0 + 2 * i + 1) * LDT + s] = (bf16_t)(w[i] >> 16); }
}
__device__ __forceinline__ void gla_g1_unit(LAS unsigned char* lds, int tid, int unit, const bf16_t* PROJ, const float* upf, const float* bf_, const float* upb, const float* bb_, bf16_t* KVS, float* DEC) {
    const int n = unit & 63, h = (unit >> 6) & 3, b = unit >> 8;
    const int d = tid & 63, tg = tid >> 6, lane = tid & 63, w = tid >> 6;
    const size_t tok0 = (size_t)b * T + n * 64;
    LAS bf16_t* KET = (LAS bf16_t*)(lds + GL_QE); LAS bf16_t* VT = (LAS bf16_t*)(lds + GL_VT); LAS float* tot = (LAS float*)(lds + GL_TOT);
    gla_stage_vt(PROJ + tok0 * PW + C_GV + h * 128, VT, tid);
#pragma unroll
    for (int dir = 0; dir < 2; ++dir) {
        float bv[8], bl;
        if (dir == 0) gla_cumsum<false>(PROJ + tok0 * PW + C_ZF, upf, bf_, h * 64 + d, tg, d, tot, bv, bl);
        else          gla_cumsum<true>(PROJ + tok0 * PW + C_ZB, upb, bb_, h * 64 + d, tg, d, tot + 512, bv, bl);
        unsigned pk[4];
#pragma unroll
        for (int i = 0; i < 8; i += 2) {
            const float k0 = bf2f(PROJ[(tok0 + 8 * tg + i) * PW + C_GK + h * 64 + d]) * exp_fast(bl - bv[i]);
            const float k1 = bf2f(PROJ[(tok0 + 8 * tg + i + 1) * PW + C_GK + h * 64 + d]) * exp_fast(bl - bv[i + 1]);
            pk[i >> 1] = (unsigned)f2bf(k0) | ((unsigned)f2bf(k1) << 16);
        }
        *(LAS v4u*)(KET + d * LDT + 8 * tg) = (v4u){pk[0], pk[1], pk[2], pk[3]};
        const size_t sq = (((size_t)b * 4 + h) * 2 + dir) * 64 + n;
        if (tg == 0) DEC[sq * 64 + d] = exp_fast(bl);
        __syncthreads();
        bf16_t* kvo = KVS + sq * 8192;
#pragma unroll
        for (int dt = 0; dt < 4; ++dt) {
            gf32x4 acc = {0.f, 0.f, 0.f, 0.f};
            acc = mfma_tile64(VT + (16 * w) * LDT, KET + (16 * dt) * LDT, acc, lane);
#pragma unroll
            for (int r = 0; r < 4; ++r) kvo[(size_t)(16 * w + 4 * (lane >> 4) + r) * 64 + 16 * dt + (lane & 15)] = f2bf(acc[r]);
        }
        __syncthreads();
    }
}
template <bool BWD>
__device__ __forceinline__ void gla_g2_item(unsigned* base, const float* dc) {
    float s0 = 0.f, s1 = 0.f;
#pragma unroll 1
    for (int hf = 0; hf < 2; ++hf) {
        unsigned kv[32]; float2 dd[32];
#pragma unroll
        for (int st = 0; st < 32; ++st) { const int n = BWD ? (63 - 32 * hf - st) : (32 * hf + st); kv[st] = base[(size_t)n * 4096]; dd[st] = *(const float2*)(dc + n * 64); }
#pragma unroll
        for (int st = 0; st < 32; ++st) { const int n = BWD ? (63 - 32 * hf - st) : (32 * hf + st);
            base[(size_t)n * 4096] = (unsigned)f2bf(s0) | ((unsigned)f2bf(s1) << 16);
            s0 = dd[st].x * s0 + __uint_as_float(kv[st] << 16); s1 = dd[st].y * s1 + __uint_as_float(kv[st] & 0xffff0000u); }
    }
}
__device__ __forceinline__ void gla_g2_scan(int gtid, int nthr, bf16_t* KVS, const float* DEC) {
    for (int item = gtid; item < 64 * 4096; item += nthr) {
        const int seq = item >> 12, ed = item & 4095, d2 = (ed & 31) * 2;
        unsigned* base = (unsigned*)(KVS + (size_t)seq * 64 * 8192) + ed;
        const float* dc = DEC + (size_t)seq * 64 * 64 + d2;
        if (seq & 1) gla_g2_item<true>(base, dc); else gla_g2_item<false>(base, dc);
    }
}
__device__ __forceinline__ void gla_g3_unit(LAS unsigned char* lds, int tid, int unit, const bf16_t* PROJ, const float* upf, const float* bf_, const float* upb, const float* bb_, const bf16_t* KVS, const float* gain, bf16_t* MIXED) {
    const int n = unit & 63, h = (unit >> 6) & 3, b = unit >> 8;
    const int d = tid & 63, tg = tid >> 6, lane = tid & 63, w = tid >> 6;
    const size_t tok0 = (size_t)b * T + n * 64;
    LAS bf16_t* QE = (LAS bf16_t*)(lds + GL_QE); LAS bf16_t* KE = (LAS bf16_t*)(lds + GL_KE); LAS bf16_t* PP = (LAS bf16_t*)(lds + GL_P);
    LAS bf16_t* VT = (LAS bf16_t*)(lds + GL_VT); LAS bf16_t* ST = (LAS bf16_t*)(lds + GL_ST);
    LAS float* tot = (LAS float*)(lds + GL_TOT); LAS float* part = (LAS float*)(lds + GL_PART); LAS float* rs = (LAS float*)(lds + GL_RSTD);
    gla_stage_vt(PROJ + tok0 * PW + C_GV + h * 128, VT, tid);
    gf32x4 o[4];
#pragma unroll
    for (int rt = 0; rt < 4; ++rt) o[rt] = (gf32x4){0.f, 0.f, 0.f, 0.f};
#pragma unroll
    for (int dir = 0; dir < 2; ++dir) {
        float bv[8], bl;
        if (dir == 0) gla_cumsum<false>(PROJ + tok0 * PW + C_ZF, upf, bf_, h * 64 + d, tg, d, tot, bv, bl);
        else          gla_cumsum<true>(PROJ + tok0 * PW + C_ZB, upb, bb_, h * 64 + d, tg, d, tot + 512, bv, bl);
#pragma unroll
        for (int i = 0; i < 8; ++i) {
            const size_t ro = (tok0 + 8 * tg + i) * PW + h * 64 + d;
            const float e = exp_fast(bv[i]);
            QE[(8 * tg + i) * LDT + d] = f2bf(bf2f(PROJ[ro + C_GQ]) * e * 0.125f);
            KE[(8 * tg + i) * LDT + d] = f2bf(bf2f(PROJ[ro + C_GK]) * __builtin_amdgcn_rcpf(e));
        }
        {
            const size_t sq = (((size_t)b * 4 + h) * 2 + dir) * 64 + n;
            const int e = tid >> 2, part4 = tid & 3;
            const uint4* sp = (const uint4*)(KVS + sq * 8192 + e * 64 + part4 * 16);
            const uint4 s0 = sp[0], s1 = sp[1];
            *(LAS v4u*)(ST + e * LDT + part4 * 16) = (v4u){s0.x, s0.y, s0.z, s0.w}; *(LAS v4u*)(ST + e * LDT + part4 * 16 + 8) = (v4u){s1.x, s1.y, s1.z, s1.w};
        }
        __syncthreads();
        { const int ct = w >> 1;
#pragma unroll
          for (int j = 0; j < 2; ++j) { const int st = 2 * (w & 1) + j;
            gf32x4 acc = {0.f, 0.f, 0.f, 0.f};
            acc = mfma_tile64(QE + (16 * ct) * LDT, KE + (16 * st) * LDT, acc, lane);
            const int s = 16 * st + (lane & 15);
#pragma unroll
            for (int r = 0; r < 4; ++r) { const int c = 16 * ct + 4 * (lane >> 4) + r; const bool keep = dir ? (s >= c) : (s <= c);
                PP[c * LDT + s] = f2bf(keep ? acc[r] : 0.f); } } }
        __syncthreads();
#pragma unroll
        for (int rt = 0; rt < 4; ++rt) {
            o[rt] = mfma_tile64(PP + (16 * rt) * LDT, VT + (16 * w) * LDT, o[rt], lane);
            o[rt] = mfma_tile64(QE + (16 * rt) * LDT, ST + (16 * w) * LDT, o[rt], lane);
        }
        __syncthreads();
    }
#pragma unroll
    for (int rt = 0; rt < 4; ++rt)
#pragma unroll
        for (int r = 0; r < 4; ++r) {
            float ss = o[rt][r] * o[rt][r];
            ss += __shfl_xor(ss, 1); ss += __shfl_xor(ss, 2); ss += __shfl_xor(ss, 4); ss += __shfl_xor(ss, 8);
            if ((lane & 15) == 0) part[w * 64 + 16 * rt + 4 * (lane >> 4) + r] = ss;
        }
    __syncthreads();
    if (tid < 64) { float ss = 0.f;
#pragma unroll
        for (int t2 = 0; t2 < 8; ++t2) ss += part[t2 * 64 + tid];
        rs[tid] = rsqrtf(ss * (1.f / 128.f) + EPS); }
    __syncthreads();
    { const int e = 16 * w + (lane & 15); const float ge = gain[e];
#pragma unroll
      for (int rt = 0; rt < 4; ++rt)
#pragma unroll
        for (int r = 0; r < 4; ++r) { const int c = 16 * rt + 4 * (lane >> 4) + r;
            const float g = bf2f(PROJ[(tok0 + c) * PW + C_GG + h * 128 + e]);
            MIXED[(tok0 + c) * D + h * 128 + e] = f2bf(o[rt][r] * rs[c] * ge * g * __builtin_amdgcn_rcpf(1.f + exp_fast(-g))); } }
    __syncthreads();
}

constexpr size_t WS_BFRAG = 12 * MiB;
__device__ __forceinline__ void router_build_bfrag(int gtid, int nthr, const float* wg, const float* we, const float* g2, bf16_t* BF) {
    for (int i = gtid; i < 32 * 5 * 64; i += nthr) {
        const int ks = i / 320, rem = i - ks * 320, ct = rem >> 6, lane = rem & 63, col = 16 * ct + (lane & 15);
        unsigned hi[4], lo[4];
#pragma unroll
        for (int j = 0; j < 8; ++j) {
            const int k = 32 * ks + 8 * (lane >> 4) + j;
            float w = col < 8 ? wg[k * 8 + col] : (col < 72 ? we[k * 64 + col - 8] : 0.f);
            w *= g2[k];
            const bf16_t h = f2bf(w); const bf16_t l = f2bf(w - bf2f(h));
            if (j & 1) { hi[j >> 1] |= (unsigned)h << 16; lo[j >> 1] |= (unsigned)l << 16; } else { hi[j >> 1] = h; lo[j >> 1] = l; }
        }
        uint4* o = (uint4*)(BF + ((size_t)(ks * 5 + ct) * 2) * 512 + lane * 8);
        o[0] = make_uint4(hi[0], hi[1], hi[2], hi[3]); o[64] = make_uint4(lo[0], lo[1], lo[2], lo[3]);
    }
}
__device__ __forceinline__ void ph_router_mfma(int gw, int NGW, int lane, LAS float* lsm  , const bf16_t* H, const bf16_t* BF, const float* bg, const float* be, float* RSTD, unsigned* tokinfo, LAS int* hist, bool dry) {
    for (int task = gw; task < NTOK / 16; task += NGW) {
        const int t0 = task * 16, row = lane & 15, kg = lane >> 4;
        const bf16_t* hp = H + (size_t)(t0 + row) * D + kg * 8;
        gf32x4 acc[5];
#pragma unroll
        for (int ct = 0; ct < 5; ++ct) acc[ct] = (gf32x4){0.f, 0.f, 0.f, 0.f};
        float ss = 0.f;
#pragma unroll 2
        for (int ks = 0; ks < 32; ++ks) {
            const gbf16x8 ah = *(const gbf16x8*)(hp + ks * 32);
#pragma unroll
            for (int j = 0; j < 8; ++j) { const float xv = bf2f((bf16_t)ah[j]); ss += xv * xv; }
            const gbf16x8* bp = (const gbf16x8*)(BF + (size_t)ks * 5 * 2 * 512) + lane;
#pragma unroll
            for (int ct = 0; ct < 5; ++ct) {
                const gbf16x8 bh = bp[(ct * 2) * 64], bl = bp[(ct * 2 + 1) * 64];
                acc[ct] = __builtin_amdgcn_mfma_f32_16x16x32_bf16(ah, bh, acc[ct], 0, 0, 0);
                acc[ct] = __builtin_amdgcn_mfma_f32_16x16x32_bf16(ah, bl, acc[ct], 0, 0, 0);
            }
        }
        ss += __shfl_xor(ss, 16); ss += __shfl_xor(ss, 32);
        const float rstd = rsqrtf(ss * (1.f / D) + EPS);
#pragma unroll
        for (int ct = 0; ct < 5; ++ct) { const int col = 16 * ct + row; const float bias = col < 8 ? bg[col] : (col < 72 ? be[col - 8] : 0.f);
#pragma unroll
            for (int r = 0; r < 4; ++r) { const int rr = 4 * kg + r; const float rs = __shfl(rstd, rr); lsm[rr * 80 + col] = acc[ct][r] * rs + bias; } }
        asm volatile("s_waitcnt lgkmcnt(0)" ::: "memory");
        if (lane < 16) {
            const LAS float* L = lsm + lane * 80;
            float best = L[0]; int g = 0;
#pragma unroll
            for (int i = 1; i < 8; ++i) { const float v = L[i]; if (v > best) { best = v; g = i; } }
            float den = 0.f;
#pragma unroll
            for (int i = 0; i < 8; ++i) den += expf(L[i] - best);
            const float gw_ = 1.f / den;
            const LAS float* E = L + 8 + g * 8;
            float v1 = E[0]; int i1 = 0;
#pragma unroll
            for (int j = 1; j < 8; ++j) { const float v = E[j]; if (v > v1) { v1 = v; i1 = j; } }
            float v2 = -INFINITY; int i2 = 0;
#pragma unroll
            for (int j = 0; j < 8; ++j) { const float v = E[j]; if (j != i1 && v > v2) { v2 = v; i2 = j; } }
            const float ex = expf(v2 - v1), p1 = 1.f / (1.f + ex), p2 = ex * p1;
            const int e1 = g * 8 + i1, e2 = g * 8 + i2, t = t0 + lane;
            uint4 o; o.x = (unsigned)e1; o.y = (unsigned)e2; o.z = __float_as_uint(gw_ * p1); o.w = __float_as_uint(gw_ * p2);
            ((uint4*)tokinfo)[t] = o;
            RSTD[t] = rstd;
            if (!dry) { __hip_atomic_fetch_add(hist + e1, 1, __ATOMIC_RELAXED, __HIP_MEMORY_SCOPE_WORKGROUP); __hip_atomic_fetch_add(hist + e2, 1, __ATOMIC_RELAXED, __HIP_MEMORY_SCOPE_WORKGROUP); }
        }
        asm volatile("s_waitcnt lgkmcnt(0)" ::: "memory");
    }
}

__device__ __forceinline__ void ph_router_lds(int vcu, int G, int wave, int lane, LAS unsigned char* lds, const bf16_t* H, const bf16_t* BF, const float* bg, const float* be, float* RSTD, unsigned* tokinfo, LAS int* hist, bool dry) {
    for (int tg = vcu; tg < NTOK / 128; tg += G) {
        const int t0 = (tg * 8 + wave) * 16, row = lane & 15, kg = lane >> 4;
        const bf16_t* hp = H + (size_t)(t0 + row) * D + kg * 8;
        gf32x4 acc[5];
#pragma unroll
        for (int ct = 0; ct < 5; ++ct) acc[ct] = (gf32x4){0.f, 0.f, 0.f, 0.f};
        float ss = 0.f;
        gbf16x8 ha[2][4];
#define RT_DMA(j) do { _Pragma("unroll") for (int i = 0; i < 5; ++i) __builtin_amdgcn_global_load_lds((const unsigned*)(BF + (size_t)(j) * 20480 + (wave + 8 * i) * 512 + lane * 8), \
            (LAS unsigned*)(lds + ((j) & 1) * 65536 + (wave + 8 * i) * 1024), 16, 0, 0); } while (0)
#define RT_LDH(j) do { _Pragma("unroll") for (int k = 0; k < 4; ++k) ha[(j) & 1][k] = *(const GAS gbf16x8*)(hp + ((j) * 4 + k) * 32); } while (0)
        RT_DMA(0); RT_LDH(0);
#pragma unroll
        for (int j = 0; j < 8; ++j) {
            if (j + 1 < 8) { RT_DMA(j + 1); RT_LDH(j + 1); asm volatile("s_waitcnt vmcnt(9)" ::: "memory"); } else asm volatile("s_waitcnt vmcnt(0)" ::: "memory");
            __syncthreads();
            const LAS unsigned char* buf = lds + (j & 1) * 65536;
#pragma unroll
            for (int k = 0; k < 4; ++k) {
                const gbf16x8 ah = ha[j & 1][k];
#pragma unroll
                for (int e = 0; e < 8; ++e) { const float xv = bf2f((bf16_t)ah[e]); ss += xv * xv; }
#pragma unroll
                for (int ct = 0; ct < 5; ++ct) {
                    const gbf16x8 bh = *(const LAS gbf16x8*)(buf + ((k * 10 + ct * 2) * 64 + lane) * 16), bl = *(const LAS gbf16x8*)(buf + ((k * 10 + ct * 2 + 1) * 64 + lane) * 16);
                    acc[ct] = __builtin_amdgcn_mfma_f32_16x16x32_bf16(ah, bh, acc[ct], 0, 0, 0);
                    acc[ct] = __builtin_amdgcn_mfma_f32_16x16x32_bf16(ah, bl, acc[ct], 0, 0, 0);
                }
            }
            __syncthreads();
        }
#undef RT_DMA
#undef RT_LDH
        LAS float* lsm = (LAS float*)(lds + wave * 5120);
        ss += __shfl_xor(ss, 16); ss += __shfl_xor(ss, 32);
        const float rstd = rsqrtf(ss * (1.f / D) + EPS);
#pragma unroll
        for (int ct = 0; ct < 5; ++ct) { const int col = 16 * ct + row; const float bias = col < 8 ? bg[col] : (col < 72 ? be[col - 8] : 0.f);
#pragma unroll
            for (int r = 0; r < 4; ++r) { const int rr = 4 * kg + r; const float rs = __shfl(rstd, rr); lsm[rr * 80 + col] = acc[ct][r] * rs + bias; } }
        asm volatile("s_waitcnt lgkmcnt(0)" ::: "memory");
        if (lane < 16) {
            const LAS float* L = lsm + lane * 80;
            float best = L[0]; int g = 0;
#pragma unroll
            for (int i = 1; i < 8; ++i) { const float v = L[i]; if (v > best) { best = v; g = i; } }
            float den = 0.f;
#pragma unroll
            for (int i = 0; i < 8; ++i) den += expf(L[i] - best);
            const float gw_ = 1.f / den;
            const LAS float* E = L + 8 + g * 8;
            float v1 = E[0]; int i1 = 0;
#pragma unroll
            for (int j = 1; j < 8; ++j) { const float v = E[j]; if (v > v1) { v1 = v; i1 = j; } }
            float v2 = -INFINITY; int i2 = 0;
#pragma unroll
            for (int j = 0; j < 8; ++j) { const float v = E[j]; if (j != i1 && v > v2) { v2 = v; i2 = j; } }
            const float ex = expf(v2 - v1), p1 = 1.f / (1.f + ex), p2 = ex * p1;
            const int e1 = g * 8 + i1, e2 = g * 8 + i2, t = t0 + lane;
            uint4 o; o.x = (unsigned)e1; o.y = (unsigned)e2; o.z = __float_as_uint(gw_ * p1); o.w = __float_as_uint(gw_ * p2);
            ((uint4*)tokinfo)[t] = o;
            RSTD[t] = rstd;
            if (!dry) { __hip_atomic_fetch_add(hist + e1, 1, __ATOMIC_RELAXED, __HIP_MEMORY_SCOPE_WORKGROUP); __hip_atomic_fetch_add(hist + e2, 1, __ATOMIC_RELAXED, __HIP_MEMORY_SCOPE_WORKGROUP); }
        }
        asm volatile("s_waitcnt lgkmcnt(0)" ::: "memory");
        __syncthreads();
    }
}

constexpr int G_Z = 0, G_VT = 8192, G_G = 26624, G_ST0 = 43008, G_ST1 = 61440, G_BM = 79872, G_QE = 97280, G_KE = 106496, G_P = 115712, G_TOT = 124928, G_PART = 129024;
constexpr int BMS = 68;
typedef unsigned v2u __attribute__((ext_vector_type(2)));
struct GlaRaw3 { v4u q, k, z, v0, v1, g0, g1, sa0, sa1, sb0, sb1, oa0, oa1; float sq; };
struct GlaRaw1 { v4u k, z, v0, v1; };
__device__ __forceinline__ v4u ld16(const bf16_t* p) { return *(const GAS v4u*)p; }
__device__ __forceinline__ void gla_load3(GlaRaw3& R, int tid, int b, int h, int n, const bf16_t* PROJ, const bf16_t* KVS, const bf16_t* MIXED, const float* SSQ) {
    const size_t tok0 = (size_t)b * T + n * 64;
    const int s8 = tid >> 3, c8 = tid & 7, lane = tid & 63, w = tid >> 6;
    R.q = ld16(PROJ + (tok0 + s8) * PW + C_GQ + h * 64 + c8 * 8);
    R.k = ld16(PROJ + (tok0 + s8) * PW + C_GK + h * 64 + c8 * 8);
    R.z = ld16(PROJ + (tok0 + ((tid >> 2) & 63)) * PW + C_ZF + (tid & 3) * 8);
    R.v0 = ld16(PROJ + (tok0 + (tid >> 4)) * PW + C_GV + h * 128 + (tid & 15) * 8); R.v1 = ld16(PROJ + (tok0 + (tid >> 4) + 32) * PW + C_GV + h * 128 + (tid & 15) * 8);
    const int s16 = tid >> 4, c16 = tid & 15;
    R.g0 = ld16(PROJ + (tok0 + s16) * PW + C_GG + h * 128 + c16 * 8); R.g1 = ld16(PROJ + (tok0 + s16 + 32) * PW + C_GG + h * 128 + c16 * 8);
    const size_t sq = (((size_t)b * 4 + h) * 2) * 64 + n;
    const bf16_t* sp = KVS + sq * 8192 + (tid >> 2) * 64 + (tid & 3) * 16;
    R.sa0 = ld16(sp); R.sa1 = ld16(sp + 8); R.sb0 = ld16(sp + (size_t)64 * 8192); R.sb1 = ld16(sp + (size_t)64 * 8192 + 8);
    R.sq = SSQ[(size_t)(tid >> 6) * NTOK + tok0 + (tid & 63)];
}
__device__ __forceinline__ void gla_store_z(LAS unsigned char* lds, int tid, v4u z) {
    if (tid < 256) { LAS f32x4* zp = (LAS f32x4*)(lds + G_Z) + (tid >> 2) * 8 + (tid & 3) * 2;
        zp[0] = (f32x4){__uint_as_float(z.x << 16), __uint_as_float(z.x & 0xffff0000u), __uint_as_float(z.y << 16), __uint_as_float(z.y & 0xffff0000u)};
        zp[1] = (f32x4){__uint_as_float(z.z << 16), __uint_as_float(z.z & 0xffff0000u), __uint_as_float(z.w << 16), __uint_as_float(z.w & 0xffff0000u)}; }
}
__device__ __forceinline__ void gla_store_vt(LAS unsigned char* lds, int tid, v4u v0, v4u v1) {
    LAS bf16_t* VT = (LAS bf16_t*)(lds + G_VT); const int c16 = tid & 15, sA = (tid >> 4) ^ (8 * (c16 & 7)), sB = sA ^ 32;
    const unsigned wa[4] = {v0.x, v0.y, v0.z, v0.w}, wb[4] = {v1.x, v1.y, v1.z, v1.w};
#pragma unroll
    for (int i = 0; i < 4; ++i) { LAS bf16_t* r0 = VT + (c16 * 8 + 2 * i) * LDT; LAS bf16_t* r1 = r0 + LDT;
        r0[sA] = (bf16_t)(wa[i] & 0xffffu); r1[sA] = (bf16_t)(wa[i] >> 16); r0[sB] = (bf16_t)(wb[i] & 0xffffu); r1[sB] = (bf16_t)(wb[i] >> 16); }
}
template <bool VA>
__device__ __forceinline__ gf32x4 mfma_tile64_v(const LAS bf16_t* X, const LAS bf16_t* VTw, int w, gf32x4 acc, int lane) {
    const int r = lane & 15, grp = lane >> 4, g = (2 * w + (r >> 3)) & 7;
    const gbf16x8 x0 = *(const LAS gbf16x8*)(X + r * LDT + grp * 8), x1 = *(const LAS gbf16x8*)(X + r * LDT + grp * 8 + 32);
    const gbf16x8 v0 = *(const LAS gbf16x8*)(VTw + r * LDT + ((grp ^ g) * 8)), v1 = *(const LAS gbf16x8*)(VTw + r * LDT + (((grp + 4) ^ g) * 8));
    if (VA) { acc = __builtin_amdgcn_mfma_f32_16x16x32_bf16(v0, x0, acc, 0, 0, 0); acc = __builtin_amdgcn_mfma_f32_16x16x32_bf16(v1, x1, acc, 0, 0, 0); }
    else    { acc = __builtin_amdgcn_mfma_f32_16x16x32_bf16(x0, v0, acc, 0, 0, 0); acc = __builtin_amdgcn_mfma_f32_16x16x32_bf16(x1, v1, acc, 0, 0, 0); }
    return acc;
}
constexpr int ZBS = 40, GL_UPT = 132096;
template <int DIR>
__device__ __forceinline__ void gla_cumsum3(LAS unsigned char* lds, float bias, int w, int lane, float (&bv)[2][4], float& bl) {
    const LAS bf16_t* ZB = (const LAS bf16_t*)(lds + G_Z); const LAS bf16_t* UPT = (const LAS bf16_t*)(lds + GL_UPT) + DIR * 64 * ZBS; LAS float* tot = (LAS float*)(lds + G_TOT);
    const int r16 = lane & 15, kg = lane >> 4, dcol = 16 * (w & 3) + r16, run0 = 8 * (w >> 2) + kg;
    const gbf16x8 bfr = *(const LAS gbf16x8*)(UPT + (16 * (w & 3) + r16) * ZBS + 8 * kg);
    float c[2][4];
#pragma unroll
    for (int j = 0; j < 2; ++j) {
        const gbf16x8 afr = *(const LAS gbf16x8*)(ZB + (32 * (w >> 2) + 16 * j + r16) * ZBS + 8 * kg);
        const gf32x4 acc = __builtin_amdgcn_mfma_f32_16x16x32_bf16(afr, bfr, (gf32x4){0.f, 0.f, 0.f, 0.f}, 0, 0, 0);
#pragma unroll
        for (int r = 0; r < 4; ++r) c[j][r] = log_sigmoid_f(acc[r] + bias) * (1.f / 16.f);
        if (DIR == 0) { c[j][1] += c[j][0]; c[j][2] += c[j][1]; c[j][3] += c[j][2]; tot[(run0 + 4 * j) * 64 + dcol] = c[j][3]; }
        else          { c[j][2] += c[j][3]; c[j][1] += c[j][2]; c[j][0] += c[j][1]; tot[(run0 + 4 * j) * 64 + dcol] = c[j][0]; }
    }
    __syncthreads();
    float off0 = 0.f, off1 = 0.f, all = 0.f;
#pragma unroll
    for (int q = 0; q < 16; ++q) { const float v = tot[q * 64 + dcol]; all += v;
        if (DIR ? (q > run0) : (q < run0)) off0 += v;
        if (DIR ? (q > run0 + 4) : (q < run0 + 4)) off1 += v; }
#pragma unroll
    for (int r = 0; r < 4; ++r) { bv[0][r] = c[0][r] + off0; bv[1][r] = c[1][r] + off1; }
    bl = all;
}
__device__ __forceinline__ void gla_store_zb(LAS unsigned char* lds, int tid, v4u z) { if (tid < 256) *(LAS v4u*)((LAS bf16_t*)(lds + G_Z) + (tid >> 2) * ZBS + (tid & 3) * 8) = z; }
__device__ __forceinline__ void gla_build_upt(LAS unsigned char* lds, int tid, int h, const float* upf, const float* upb) {
    LAS bf16_t* U0 = (LAS bf16_t*)(lds + GL_UPT); LAS bf16_t* U1 = U0 + 64 * ZBS;
    const int d = tid & 63, k0 = (tid >> 6) * 4;
    unsigned a0 = 0u, a1 = 0u, b0 = 0u, b1 = 0u;
    if (k0 < 16) { const float* p = upf + k0 * 256 + h * 64 + d; a0 = (unsigned)f2bf(p[0]) | ((unsigned)f2bf(p[256]) << 16); a1 = (unsigned)f2bf(p[512]) | ((unsigned)f2bf(p[768]) << 16); }
    else { const float* p = upb + (k0 - 16) * 256 + h * 64 + d; b0 = (unsigned)f2bf(p[0]) | ((unsigned)f2bf(p[256]) << 16); b1 = (unsigned)f2bf(p[512]) | ((unsigned)f2bf(p[768]) << 16); }
    *(LAS v2u*)(U0 + d * ZBS + k0) = (v2u){a0, a1}; *(LAS v2u*)(U1 + d * ZBS + k0) = (v2u){b0, b1};
}
__device__ __forceinline__ unsigned pk_bf2(float a, float b) { return (unsigned)f2bf(a) | ((unsigned)f2bf(b) << 16); }

__device__ __forceinline__ void gla_g3_phase(LAS unsigned char* lds, int tid, int bx, const bf16_t* PROJ, const float* upf, const float* bf_, const float* upb, const float* bb_, const bf16_t* KVS, const float* gain, bf16_t* MIXED, const float* SSQ, float* ratt) {
    const int n = bx & 63, h = (bx >> 6) & 3;
    const int d = tid & 63, tg = tid >> 6, lane = tid & 63, w = tid >> 6, s8 = tid >> 3, c8 = tid & 7;
    const int dcol = 16 * (w & 3) + (lane & 15), tk0 = 32 * (w >> 2) + 4 * (lane >> 4);
    const float bsF = bf_[h * 64 + dcol], bsB = bb_[h * 64 + dcol];
    gla_build_upt(lds, tid, h, upf, upb);
    float ge4[4];
#pragma unroll
    for (int r = 0; r < 4; ++r) ge4[r] = gain[16 * w + 4 * (lane >> 4) + r];
    LAS bf16_t* QE = (LAS bf16_t*)(lds + G_QE); LAS bf16_t* KE = (LAS bf16_t*)(lds + G_KE); LAS bf16_t* PP = (LAS bf16_t*)(lds + G_P);
    LAS bf16_t* VT = (LAS bf16_t*)(lds + G_VT); LAS bf16_t* GG = (LAS bf16_t*)(lds + G_G); LAS float* BM = (LAS float*)(lds + G_BM);
    LAS float* part = (LAS float*)(lds + G_PART); LAS float* rs = (LAS float*)(lds + G_TOT);
    GlaRaw3 R; gla_load3(R, tid, 0, h, n, PROJ, KVS, MIXED, SSQ);
    for (int b = 0; b < NB; ++b) {
        const size_t tok0 = (size_t)b * T + n * 64;
        const v4u cq = R.q, ck = R.k;
        gla_store_zb(lds, tid, R.z); gla_store_vt(lds, tid, R.v0, R.v1);
        { const int s16 = tid >> 4, c16 = tid & 15; *(LAS v4u*)(GG + s16 * 128 + c16 * 8) = R.g0; *(LAS v4u*)(GG + (s16 + 32) * 128 + c16 * 8) = R.g1; }
        { const int e = tid >> 2, p4 = tid & 3; LAS bf16_t* s0 = (LAS bf16_t*)(lds + G_ST0) + e * LDT + p4 * 16; LAS bf16_t* s1 = (LAS bf16_t*)(lds + G_ST1) + e * LDT + p4 * 16;
          *(LAS v4u*)s0 = R.sa0; *(LAS v4u*)(s0 + 8) = R.sa1; *(LAS v4u*)s1 = R.sb0; *(LAS v4u*)(s1 + 8) = R.sb1; }
        part[tid] = R.sq;
        if (b + 1 < NB) gla_load3(R, tid, b + 1, h, n, PROJ, KVS, MIXED, SSQ);
        __syncthreads();
        if (tid < 64) { float q = 0.f;
#pragma unroll
            for (int hh = 0; hh < 8; ++hh) q += part[hh * 64 + tid];
            const float ms = q * (1.f / 512.f) + EPS; ((LAS float*)(lds + 143360))[tid] = sqrtf(ms); if (h == 0) ratt[tok0 + tid] = rsqrtf(ms); }
        gf32x4 o[4];
#pragma unroll
        for (int rt = 0; rt < 4; ++rt) o[rt] = (gf32x4){0.f, 0.f, 0.f, 0.f};
#pragma unroll
        for (int dir = 0; dir < 2; ++dir) {
            float bv[2][4], bl;
            if (dir == 0) gla_cumsum3<0>(lds, bsF, w, lane, bv, bl); else gla_cumsum3<1>(lds, bsB, w, lane, bv, bl);
#pragma unroll
            for (int j = 0; j < 2; ++j)
#pragma unroll
                for (int r = 0; r < 4; ++r) BM[(tk0 + 16 * j + r) * BMS + dcol] = bv[j][r];
            __syncthreads();
            {
                const f32x4 b0 = *(const LAS f32x4*)(BM + s8 * BMS + c8 * 8), b1 = *(const LAS f32x4*)(BM + s8 * BMS + c8 * 8 + 4);
                const float bb[8] = {b0.x, b0.y, b0.z, b0.w, b1.x, b1.y, b1.z, b1.w};
                const unsigned qw[4] = {cq.x, cq.y, cq.z, cq.w}, kw[4] = {ck.x, ck.y, ck.z, ck.w};
                unsigned qo[4], ko[4];
#pragma unroll
                for (int j = 0; j < 4; ++j) {
                    const float e0 = exp_fast(bb[2 * j]), e1 = exp_fast(bb[2 * j + 1]);
                    qo[j] = pk_bf2(__uint_as_float(qw[j] << 16) * e0 * 0.125f, __uint_as_float(qw[j] & 0xffff0000u) * e1 * 0.125f);
                    ko[j] = pk_bf2(__uint_as_float(kw[j] << 16) * __builtin_amdgcn_rcpf(e0), __uint_as_float(kw[j] & 0xffff0000u) * __builtin_amdgcn_rcpf(e1));
                }
                *(LAS v4u*)(QE + s8 * LDT + c8 * 8) = (v4u){qo[0], qo[1], qo[2], qo[3]}; *(LAS v4u*)(KE + s8 * LDT + c8 * 8) = (v4u){ko[0], ko[1], ko[2], ko[3]};
            }
            __syncthreads();
            { const int ct = w >> 1;
#pragma unroll
              for (int j = 0; j < 2; ++j) { const int st = 2 * (w & 1) + j;
                gf32x4 acc = {0.f, 0.f, 0.f, 0.f};
                acc = mfma_tile64(KE + (16 * st) * LDT, QE + (16 * ct) * LDT, acc, lane);
                const int c = 16 * ct + (lane & 15), s0 = 16 * st + 4 * (lane >> 4);
                float pv[4];
#pragma unroll
                for (int r = 0; r < 4; ++r) { const int s = s0 + r; const bool keep = dir ? (s >= c) : (s <= c); pv[r] = keep ? acc[r] : 0.f; }
                *(LAS v2u*)(PP + c * LDT + s0) = (v2u){pk_bf2(pv[0], pv[1]), pk_bf2(pv[2], pv[3])}; } }
            __syncthreads();
            const LAS bf16_t* ST = (const LAS bf16_t*)(lds + (dir ? G_ST1 : G_ST0));
#pragma unroll
            for (int rt = 0; rt < 4; ++rt) {
                o[rt] = mfma_tile64_v<true>(PP + (16 * rt) * LDT, VT + (16 * w) * LDT, w, o[rt], lane);
                o[rt] = mfma_tile64(ST + (16 * w) * LDT, QE + (16 * rt) * LDT, o[rt], lane);
            }
        }
#pragma unroll
        for (int rt = 0; rt < 4; ++rt) {
            float ss = o[rt][0] * o[rt][0] + o[rt][1] * o[rt][1] + o[rt][2] * o[rt][2] + o[rt][3] * o[rt][3];
            ss += __shfl_xor(ss, 16); ss += __shfl_xor(ss, 32);
            if (lane < 16) part[w * 64 + 16 * rt + lane] = ss;
        }
        __syncthreads();
        if (tid < 64) { float ss = 0.f;
#pragma unroll
            for (int t2 = 0; t2 < 8; ++t2) ss += part[t2 * 64 + tid];
            rs[tid] = rsqrtf(ss * (1.f / 128.f) + EPS) * ((LAS float*)(lds + 143360))[tid]; }
        __syncthreads();
#pragma unroll
        for (int rt = 0; rt < 4; ++rt) { const int c = 16 * rt + (lane & 15), e0 = 16 * w + 4 * (lane >> 4);
            const v2u gw2 = *(const LAS v2u*)(GG + c * 128 + e0);
            const float gv[4] = {__uint_as_float(gw2.x << 16), __uint_as_float(gw2.x & 0xffff0000u), __uint_as_float(gw2.y << 16), __uint_as_float(gw2.y & 0xffff0000u)};
            const float rc = rs[c]; float ov[4];
#pragma unroll
            for (int r = 0; r < 4; ++r) ov[r] = o[rt][r] * rc * ge4[r] * gv[r] * __builtin_amdgcn_rcpf(1.f + exp_fast(-gv[r]));
            *(GAS v2u*)(MIXED + (tok0 + c) * D + 512 + h * 128 + e0) = (v2u){pk_bf2(ov[0], ov[1]), pk_bf2(ov[2], ov[3])}; }
        __syncthreads();
    }
}
__device__ __forceinline__ void gla_load1(GlaRaw1& R, int tid, int b, int h, int n, const bf16_t* PROJ) {
    const size_t tok0 = (size_t)b * T + n * 64;
    const int s8 = tid >> 3, c8 = tid & 7, lane = tid & 63, w = tid >> 6;
    R.k = ld16(PROJ + (tok0 + s8) * PW + C_GK + h * 64 + c8 * 8);
    R.z = ld16(PROJ + (tok0 + ((tid >> 2) & 63)) * PW + C_ZF + (tid & 3) * 8);
    R.v0 = ld16(PROJ + (tok0 + (tid >> 4)) * PW + C_GV + h * 128 + (tid & 15) * 8); R.v1 = ld16(PROJ + (tok0 + (tid >> 4) + 32) * PW + C_GV + h * 128 + (tid & 15) * 8);
}
__device__ __forceinline__ void gla_g1_phase(LAS unsigned char* lds, int tid, int bx, const bf16_t* PROJ, const float* upf, const float* bf_, const float* upb, const float* bb_, bf16_t* KVS, float* DEC) {
    const int n = bx & 63, h = (bx >> 6) & 3;
    const int d = tid & 63, tg = tid >> 6, lane = tid & 63, w = tid >> 6, s8 = tid >> 3, c8 = tid & 7;
    const int dcol = 16 * (w & 3) + (lane & 15), tk0 = 32 * (w >> 2) + 4 * (lane >> 4);
    const float bsF = bf_[h * 64 + dcol], bsB = bb_[h * 64 + dcol];
    gla_build_upt(lds, tid, h, upf, upb);
    LAS bf16_t* KR = (LAS bf16_t*)(lds + G_G); LAS bf16_t* KET = (LAS bf16_t*)(lds + G_QE); LAS bf16_t* VT = (LAS bf16_t*)(lds + G_VT);
    GlaRaw1 R; gla_load1(R, tid, 0, h, n, PROJ);
    for (int b = 0; b < NB; ++b) {
        gla_store_zb(lds, tid, R.z); gla_store_vt(lds, tid, R.v0, R.v1);
        *(LAS v4u*)(KR + s8 * LDT + c8 * 8) = R.k;
        if (b + 1 < NB) gla_load1(R, tid, b + 1, h, n, PROJ);
        __syncthreads();
#pragma unroll
        for (int dir = 0; dir < 2; ++dir) {
            float bv[2][4], bl;
            if (dir == 0) gla_cumsum3<0>(lds, bsF, w, lane, bv, bl); else gla_cumsum3<1>(lds, bsB, w, lane, bv, bl);
#pragma unroll
            for (int j = 0; j < 2; ++j) {
                const int t0 = tk0 + 16 * j;
                const unsigned p0 = pk_bf2(bf2f(KR[(t0 + 0) * LDT + dcol]) * exp_fast(bl - bv[j][0]), bf2f(KR[(t0 + 1) * LDT + dcol]) * exp_fast(bl - bv[j][1]));
                const unsigned p1 = pk_bf2(bf2f(KR[(t0 + 2) * LDT + dcol]) * exp_fast(bl - bv[j][2]), bf2f(KR[(t0 + 3) * LDT + dcol]) * exp_fast(bl - bv[j][3]));
                *(LAS v2u*)(KET + dcol * LDT + t0) = (v2u){p0, p1};
            }
            const size_t sq = (((size_t)b * 4 + h) * 2 + dir) * 64 + n;
            if (w < 4 && lane < 16) DEC[sq * 64 + dcol] = exp_fast(bl);
            __syncthreads();
            bf16_t* kvo = KVS + sq * 8192;
#pragma unroll
            for (int dt = 0; dt < 4; ++dt) {
                gf32x4 acc = {0.f, 0.f, 0.f, 0.f};
                acc = mfma_tile64_v<false>(KET + (16 * dt) * LDT, VT + (16 * w) * LDT, w, acc, lane);
                *(GAS v2u*)(kvo + (size_t)(16 * w + (lane & 15)) * 64 + 16 * dt + 4 * (lane >> 4)) = (v2u){pk_bf2(acc[0], acc[1]), pk_bf2(acc[2], acc[3])};
            }
        }
        __syncthreads();
    }
}
#include <hip/hip_bf16.h>
#include <cmath>
namespace attn_body {
using bf16=__hip_bfloat16;
using bf16x8=__attribute__((ext_vector_type(8)))short;
using s16x4=__attribute__((ext_vector_type(4)))short;
using f32x16=__attribute__((ext_vector_type(16)))float;
using u32x4=__attribute__((ext_vector_type(4)))unsigned;
constexpr int BATCH=8,NHEAD=8,SEQ=4096,D=64,DM=2560,OP=1024;
constexpr int NW=8,QBLK=32,QB=QBLK*NW,KVBLK=64,NQB=SEQ/QB;
constexpr int ATTN_PITCH=DM, ATTN_UNIT_ROWS=QB;
__device__ __forceinline__ int crow(int r,int hi){return (r&3)+8*(r>>2)+4*hi;}
#define SBAR() __builtin_amdgcn_sched_barrier(0)
__device__ __forceinline__ void cmask(f32x16&p0,f32x16&p1,int jb,int qrel,int hi){
  const float NEG=-INFINITY; int kb=64*jb+4*hi;
  #pragma unroll
  for(int r=0;r<16;++r){int kv=kb+(r&3)+8*(r>>2); if(kv>qrel)p0[r]=NEG; if(kv+32>qrel)p1[r]=NEG;}
}

constexpr int NSLOT=3, SLOTB=8192;
constexpr int LDS_K=0, LDS_V=NSLOT*SLOTB, LDS_WS=2*NSLOT*SLOTB, LDS_OST=LDS_WS+NW*64*4, LDS_BYTES=LDS_OST+NW*4096;
constexpr bool FIXREF=true;
constexpr float C2=0.125f*1.4426950408889634f;
__device__ __forceinline__ void glds16(const void*gsrc,unsigned lds_dst){unsigned keep;
  asm volatile("s_mov_b32 %0, m0\n\ts_mov_b32 m0, %2\n\ts_nop 0\n\tglobal_load_lds_dwordx4 %1, off\n\ts_mov_b32 m0, %0":"=&s"(keep):"v"(gsrc),"s"(lds_dst):"memory");}
__device__ __forceinline__ float max3f(float a,float b,float c){float r;asm("v_max3_f32 %0, %1, %2, %3":"=v"(r):"v"(a),"v"(b),"v"(c));return r;}
__device__ __forceinline__ float max2f(float a,float b){float r;asm("v_max_f32_e32 %0, %1, %2":"=v"(r):"v"(a),"v"(b));return r;}
__device__ __forceinline__ float fadd_s(float a,float b){float r;asm("v_add_f32_e32 %0, %1, %2":"=v"(r):"v"(a),"v"(b));return r;}
__device__ __forceinline__ float fsub_s(float a,float b){float r;asm("v_sub_f32_e32 %0, %1, %2":"=v"(r):"v"(a),"v"(b));return r;}
typedef float f32x2_t __attribute__((ext_vector_type(2))); typedef __bf16 bf16x2_t __attribute__((ext_vector_type(2)));
__device__ __forceinline__ unsigned cvtpk_s(float lo,float hi){f32x2_t v={lo,hi};bf16x2_t b=__builtin_convertvector(v,bf16x2_t);return __builtin_bit_cast(unsigned,b);}
#define WAIT_BAR(N) asm volatile("s_waitcnt vmcnt(" #N ") lgkmcnt(0)\n\ts_barrier":::"memory")

__device__ __forceinline__ void qkt(f32x16&p0,f32x16&p1,const char*Kslot,const bf16x8*qr,const f32x16&negm,int r32,int hi){
  const char*kb=Kslot+r32*128; const int xs=(r32>>1)&7;
  #pragma unroll
  for(int d0=0;d0<4;++d0){
    const bf16x8 b0=*reinterpret_cast<const bf16x8*>(kb+(((2*d0+hi)^xs)<<4));
    const bf16x8 b1=*reinterpret_cast<const bf16x8*>(kb+(((2*d0+hi)^xs)<<4)+4096);
    if(d0==0){p0=__builtin_amdgcn_mfma_f32_32x32x16_bf16(b0,qr[0],negm,0,0,0);p1=__builtin_amdgcn_mfma_f32_32x32x16_bf16(b1,qr[0],negm,0,0,0);}
    else{p0=__builtin_amdgcn_mfma_f32_32x32x16_bf16(b0,qr[d0],p0,0,0,0);p1=__builtin_amdgcn_mfma_f32_32x32x16_bf16(b1,qr[d0],p1,0,0,0);}}
}
typedef __attribute__((address_space(3))) const char* lds_cptr;
typedef short v4i16_t __attribute__((ext_vector_type(4)));
struct KBases { int o[4]; };
__device__ __forceinline__ void kload8(bf16x8*kf,lds_cptr kring,const KBases&kb,int sl){
  #pragma unroll
  for(int d0=0;d0<4;++d0){ kf[2*d0]=*(const __attribute__((address_space(3))) bf16x8*)(kring+kb.o[d0]+sl); kf[2*d0+1]=*(const __attribute__((address_space(3))) bf16x8*)(kring+kb.o[d0]+sl+4096); }
}
__device__ __forceinline__ void kload2(bf16x8*kf,lds_cptr kring,const KBases&kb,int sl,int j){ kf[2*j]=*(const __attribute__((address_space(3))) bf16x8*)(kring+kb.o[j]+sl); kf[2*j+1]=*(const __attribute__((address_space(3))) bf16x8*)(kring+kb.o[j]+sl+4096); }
__device__ __forceinline__ s16x4 vtr(lds_cptr p){ return __builtin_bit_cast(s16x4,__builtin_amdgcn_ds_read_tr16_b64_v4i16((__attribute__((address_space(3))) v4i16_t*)p)); }
__device__ __forceinline__ float rowmax(const f32x16&p0,const f32x16&p1){
  float a=max3f(p0[0],p0[1],p1[0]),b=max3f(p0[2],p0[3],p1[1]);a=max3f(a,p1[2],p1[3]);
  #pragma unroll
  for(int r=4;r<16;r+=4){a=max3f(a,p0[r],p0[r+1]);b=max3f(b,p0[r+2],p0[r+3]);a=max3f(a,p1[r],p1[r+1]);b=max3f(b,p1[r+2],p1[r+3]);}
  const float m=max2f(a,b);
  auto rr=__builtin_amdgcn_permlane32_swap(__float_as_uint(m),__float_as_uint(m),false,false);
  return max2f(__uint_as_float(rr[0]),__uint_as_float(rr[1]));
}
__device__ __forceinline__ void pv(f32x16*o,int vb,bf16x8 pa0,bf16x8 pa1,bf16x8 pa2,bf16x8 pa3){
  #pragma unroll
  for(int d0=0;d0<2;++d0){s16x4 lo[4],hi[4];
    #pragma unroll
    for(int ks=0;ks<4;++ks){
      asm volatile("ds_read_b64_tr_b16 %0,%1 offset:%c2":"=&v"(lo[ks]):"v"(vb),"i"(d0*4096+ks*1024):"memory");
      asm volatile("ds_read_b64_tr_b16 %0,%1 offset:%c2":"=&v"(hi[ks]):"v"(vb),"i"(d0*4096+ks*1024+512):"memory");}
    asm volatile("s_waitcnt lgkmcnt(0)":::"memory");SBAR();
    #define PK(k) (bf16x8){lo[k][0],lo[k][1],lo[k][2],lo[k][3],hi[k][0],hi[k][1],hi[k][2],hi[k][3]}
    o[d0]=__builtin_amdgcn_mfma_f32_32x32x16_bf16(pa0,PK(0),o[d0],0,0,0);
    o[d0]=__builtin_amdgcn_mfma_f32_32x32x16_bf16(pa1,PK(1),o[d0],0,0,0);
    o[d0]=__builtin_amdgcn_mfma_f32_32x32x16_bf16(pa2,PK(2),o[d0],0,0,0);
    o[d0]=__builtin_amdgcn_mfma_f32_32x32x16_bf16(pa3,PK(3),o[d0],0,0,0);
    #undef PK
  }
}

#ifndef ATTN_STORE16
#define ATTN_STORE16(p,v) (*(u32x4*)(p)=(v))
#endif
template<int THRL> __device__ __forceinline__ void attn_unit(int b,int h,int qb,const bf16*Q,const bf16*__restrict__ K,const bf16*__restrict__ V,bf16*O,char*shm,const float*qg,const float*rope,float*ssq,float sbound){
  const int tid=threadIdx.x,lane=tid&63,r32=lane&31,hi=lane>>5; const int wid=__builtin_amdgcn_readfirstlane(tid>>6);
  const long rowbase=(long)b*SEQ; const int q0=qb*QB;
  const bf16*Qw=Q+(rowbase+q0+wid*QBLK)*DM+h*D;
  const bf16*Kh=K+rowbase*DM+(h>>2)*D,*Vh=V+rowbase*DM+(h>>2)*D;
  const unsigned lds0=(unsigned)(uintptr_t)shm;
  float*wsf=(float*)(shm+LDS_WS)+wid*64;
  const unsigned koff=(unsigned)((8*wid+(lane>>3))*DM+(((lane&7)^((4*wid+(lane>>4))&7))*8)),
  voff_dummy_=0u, voff=(unsigned)((16*(wid&3)+(lane>>2))*DM+(wid>>2)*32+(lane&3)*8);
  const unsigned kdst=lds0+LDS_K+wid*1024, vdst=lds0+LDS_V+wid*1024;
  #define DMA_K(t,slot) glds16(Kh+(long)(t)*KVBLK*DM+koff,(unsigned)__builtin_amdgcn_readfirstlane(kdst+(slot)))
  #define DMA_V(t,slot) glds16(Vh+(long)(t)*KVBLK*DM+voff,(unsigned)__builtin_amdgcn_readfirstlane(vdst+(slot)))
  const int vb0=(int)(lds0+LDS_V)+((lane>>4)&1)*32+(lane&3)*8+(4*hi+((lane&15)>>2))*64;
  const char*Kbase=shm+LDS_K; bf16x8 kf[8];
  const lds_cptr shm3=(lds_cptr)shm; const lds_cptr kring=shm3+LDS_K; KBases kbs; _Pragma("unroll") for(int d0=0;d0<4;++d0)kbs.o[d0]=r32*128+(((2*d0+hi)^((r32>>1)&7))<<4); const lds_cptr vp0=shm3+LDS_V+((lane>>4)&1)*32+(lane&3)*8+(4*hi+((lane&15)>>2))*64;
  const int NT=SEQ/KVBLK;
  DMA_K(0,0);DMA_V(0,0);DMA_K(1,SLOTB);
  bf16x8 qr[4];
  #pragma unroll
  for(int d0=0;d0<4;++d0)qr[d0]=*reinterpret_cast<const bf16x8*>(&Qw[(long)r32*DM+d0*16+hi*8]);
  {
    float x[4][8]; float ss=0.f;
    #pragma unroll
    for(int d0=0;d0<4;++d0){
      #pragma unroll
      for(int j=0;j<8;++j){ x[d0][j]=__uint_as_float(((unsigned)(unsigned short)qr[d0][j])<<16); ss+=x[d0][j]*x[d0][j]; } }
    ss+=__shfl_xor(ss,32);
    const float rstd=rsqrtf(ss*(1.f/64.f)+1e-6f);
    const int tt=q0+wid*QBLK+r32, prow=tt>>6, pcol=tt&63;
    #pragma unroll
    for(int d0=0;d0<4;++d0){
      const float4 g0=*reinterpret_cast<const float4*>(qg+d0*16+hi*8), g1=*reinterpret_cast<const float4*>(qg+d0*16+hi*8+4);
      const int pos=(d0<2)?prow:pcol, i0=8*(d0&1)+4*hi;
      const float4 c4=*reinterpret_cast<const float4*>(rope+pos*16+i0), s4=*reinterpret_cast<const float4*>(rope+1024+pos*16+i0);
      const float gg[8]={g0.x,g0.y,g0.z,g0.w,g1.x,g1.y,g1.z,g1.w}, cc[4]={c4.x,c4.y,c4.z,c4.w}, sn[4]={s4.x,s4.y,s4.z,s4.w};
      u32x4 pw;
      #pragma unroll
      for(int jj=0;jj<4;++jj){ const float y0=x[d0][2*jj]*rstd*gg[2*jj], y1=x[d0][2*jj+1]*rstd*gg[2*jj+1];
        pw[jj]=cvtpk_s((y0*cc[jj]-y1*sn[jj])*C2,(y0*sn[jj]+y1*cc[jj])*C2); }
      qr[d0]=__builtin_bit_cast(bf16x8,pw); } }
  float mhat=0.f,l_reg=0.f;f32x16 o[2];o[0]=f32x16{};o[1]=f32x16{};f32x16 negm; _Pragma("unroll") for(int r=0;r<16;++r)negm[r]=FIXREF?-sbound:0.f; asm volatile("":"+v"(negm));

  #define CMASK(P0,P1,t) do{}while(0)
  bool resc=false;
  #define START(P0,P1) do{ resc=false; if(!FIXREF) \
    { const float rm=rowmax(P0,P1); const float dl=rm; mhat=fadd_s(mhat,dl); \
      _Pragma("unroll") for(int r=0;r<16;++r){P0[r]=fsub_s(P0[r],dl);P1[r]=fsub_s(P1[r],dl);} \
      _Pragma("unroll") for(int r=0;r<16;++r)negm[r]=-mhat; asm volatile("":"+v"(negm)); } \
    _Pragma("unroll") for(int r=0;r<16;++r)P0[r]=__builtin_amdgcn_exp2f(P0[r]); }while(0)
  #define RESC() do{ if(resc){ asm volatile("s_waitcnt lgkmcnt(0)":::"memory"); \
      _Pragma("unroll") for(int d_=0;d_<2;++d_) _Pragma("unroll") for(int r=0;r<16;++r)o[d_][r]*=wsf[crow(r,hi)]; } }while(0)
  f32x16 pA0,pA1,pB0,pB1;
  int sl_prev=0,sl_cur=0,sl_next=SLOTB;
  #define ROT() do{sl_prev=sl_cur;sl_cur=sl_next;sl_next=(sl_next==(NSLOT-1)*SLOTB)?0:sl_next+SLOTB;}while(0)
  DMA_K(2,2*SLOTB);
  WAIT_BAR(3);
  qkt(pA0,pA1,Kbase,qr,negm,r32,hi);asm volatile("s_nop 15\n\ts_nop 7":"+v"(pA0),"+v"(pA1));CMASK(pA0,pA1,0);
  START(pA0,pA1);
  _Pragma("unroll") for(int r=0;r<16;++r)pA1[r]=__builtin_amdgcn_exp2f(pA1[r]);
  WAIT_BAR(0);
  DMA_K(3,0);DMA_V(1,SLOTB);
  ROT();
  kload8(kf,kring,kbs,sl_cur);
  WAIT_BAR(2);
  s16x4 vlo[8],vhi[8]; u32x4 pw0,pw1,pw2,pw3;
  #define PKW(P,B) cvtpk_s(P[B],P[B+1])
  #define PAF(k) __builtin_bit_cast(bf16x8,pw##k)
  #define VFR(i) (bf16x8){vlo[i][0],vlo[i][1],vlo[i][2],vlo[i][3],vhi[i][0],vhi[i][1],vhi[i][2],vhi[i][3]}
  #define PIN(x) asm volatile("":"+v"(x))
  #define MX3(a,b,c) __builtin_fmaxf(__builtin_fmaxf((a),(b)),(c))
  #define GAPA(MF,A0,A1,A2,A3,W0,W1,PW) do{ MF; sacc+=A0; sacc+=A1; sacc+=A2; sacc+=A3; PIN(sacc); W0; W1; PIN(PW); SBAR(); }while(0)
  #define EX(v) __builtin_amdgcn_exp2f(v)
  #define GAPB(MF,X,B) do{ MF; X[B]=EX(X[B]); X[B+1]=EX(X[B+1]); X[B+2]=EX(X[B+2]); X[B+3]=EX(X[B+3]); PIN(X); SBAR(); }while(0)
  #define VRD(i) do{ vlo[i]=vtr(vp_+(((i)>>2)*4096+((i)&3)*1024)); vhi[i]=vtr(vp_+(((i)>>2)*4096+((i)&3)*1024+512)); }while(0)
  #define KRD(G,j) do{ if(G){ kload2(kf,kring,kbs,sl_next,j); SBAR(); } }while(0)
  #define STEP(C0,C1,P0,P1,t,GK,GV,GL) do{ SBAR(); \
    const lds_cptr vp_=vp0+sl_prev; \
    VRD(0); SBAR(); float sacc=(P0[0]+P0[1]); \
    GAPA(C0=__builtin_amdgcn_mfma_f32_32x32x16_bf16(kf[0],qr[0],negm,0,0,0), P0[2],P0[3],P0[4],P0[5],     pw0[0]=PKW(P0,0), pw0[1]=PKW(P0,2), pw0); \
    VRD(4); SBAR(); GAPA(C1=__builtin_amdgcn_mfma_f32_32x32x16_bf16(kf[1],qr[0],negm,0,0,0), P0[6],P0[7],P0[8],P0[9],     pw0[2]=PKW(P0,4), pw0[3]=PKW(P0,6), pw0); \
    VRD(1); SBAR(); GAPA(C0=__builtin_amdgcn_mfma_f32_32x32x16_bf16(kf[2],qr[1],C0,0,0,0),   P0[10],P0[11],P0[12],P0[13], pw1[0]=PKW(P0,8), pw1[1]=PKW(P0,10), pw1); \
    VRD(5); SBAR(); GAPA(C1=__builtin_amdgcn_mfma_f32_32x32x16_bf16(kf[3],qr[1],C1,0,0,0),   P0[14],P0[15],P1[0],P1[1],   pw1[2]=PKW(P0,12),pw1[3]=PKW(P0,14), pw1); \
    VRD(2); SBAR(); GAPA(C0=__builtin_amdgcn_mfma_f32_32x32x16_bf16(kf[4],qr[2],C0,0,0,0),   P1[2],P1[3],P1[4],P1[5],     pw2[0]=PKW(P1,0), pw2[1]=PKW(P1,2), pw2); \
    VRD(6); SBAR(); GAPA(C1=__builtin_amdgcn_mfma_f32_32x32x16_bf16(kf[5],qr[2],C1,0,0,0),   P1[6],P1[7],P1[8],P1[9],     pw2[2]=PKW(P1,4), pw2[3]=PKW(P1,6), pw2); \
    VRD(3); SBAR(); GAPA(C0=__builtin_amdgcn_mfma_f32_32x32x16_bf16(kf[6],qr[3],C0,0,0,0),   P1[10],P1[11],P1[12],P1[13], pw3[0]=PKW(P1,8), pw3[1]=PKW(P1,10), pw3); \
    VRD(7); SBAR(); GAPA(C1=__builtin_amdgcn_mfma_f32_32x32x16_bf16(kf[7],qr[3],C1,0,0,0),   P1[14],P1[15],0.f,0.f,       pw3[2]=PKW(P1,12),pw3[3]=PKW(P1,14), pw3); \
    l_reg+=sacc; \
    if(GK){DMA_K((t)+3,sl_cur);} if(GV){DMA_V((t)+1,sl_next);} \
    CMASK(C0,C1,t); \
    if(!FIXREF){ float a=MX3(C0[0],C0[1],C1[0]),b=MX3(C0[2],C0[3],C1[1]); a=MX3(a,C1[2],C1[3]); \
      _Pragma("unroll") for(int r=4;r<16;r+=4){a=MX3(a,C0[r],C0[r+1]);b=MX3(b,C0[r+2],C0[r+3]);a=MX3(a,C1[r],C1[r+1]);b=MX3(b,C1[r+2],C1[r+3]);} \
      float rm=__builtin_fmaxf(a,b); { auto rr=__builtin_amdgcn_permlane32_swap(__float_as_uint(rm),__float_as_uint(rm),false,false); rm=__builtin_fmaxf(__uint_as_float(rr[0]),__uint_as_float(rr[1])); } \
      resc=false; \
      if(__builtin_expect(__any(rm>(float)THRL),0)){ const float dl=__builtin_fmaxf(rm,0.f); mhat+=dl; \
        _Pragma("unroll") for(int r=0;r<16;++r){C0[r]-=dl;C1[r]-=dl;} \
        _Pragma("unroll") for(int r=0;r<16;++r)negm[r]=-mhat; asm volatile("":"+v"(negm)); \
        const float f=__builtin_amdgcn_exp2f(-dl); l_reg*=f; if(hi==0)wsf[r32]=f; resc=true; } } \
    SBAR(); \
    GAPB(o[0]=__builtin_amdgcn_mfma_f32_32x32x16_bf16(PAF(0),VFR(0),o[0],0,0,0), C0,0); \
    GAPB(o[1]=__builtin_amdgcn_mfma_f32_32x32x16_bf16(PAF(0),VFR(4),o[1],0,0,0), C0,4); \
    KRD(GL,0); GAPB(o[0]=__builtin_amdgcn_mfma_f32_32x32x16_bf16(PAF(1),VFR(1),o[0],0,0,0), C0,8); \
    KRD(GL,1); GAPB(o[1]=__builtin_amdgcn_mfma_f32_32x32x16_bf16(PAF(1),VFR(5),o[1],0,0,0), C0,12); \
    KRD(GL,2); GAPB(o[0]=__builtin_amdgcn_mfma_f32_32x32x16_bf16(PAF(2),VFR(2),o[0],0,0,0), C1,0); \
    KRD(GL,3); GAPB(o[1]=__builtin_amdgcn_mfma_f32_32x32x16_bf16(PAF(2),VFR(6),o[1],0,0,0), C1,4); \
    GAPB(o[0]=__builtin_amdgcn_mfma_f32_32x32x16_bf16(PAF(3),VFR(3),o[0],0,0,0), C1,8); \
    GAPB(o[1]=__builtin_amdgcn_mfma_f32_32x32x16_bf16(PAF(3),VFR(7),o[1],0,0,0), C1,12); \
    }while(0)
  int t=1;
  #undef CMASK
  #define CMASK(P0,P1,t) do{}while(0)
  for(;t+5<NT;t+=2){
    STEP(pB0,pB1,pA0,pA1,t,true,true,true);     WAIT_BAR(2); RESC(); ROT();
    STEP(pA0,pA1,pB0,pB1,t+1,true,true,true);   WAIT_BAR(2); RESC(); ROT();
  }
  #undef CMASK
  #define CMASK(P0,P1,t) do{}while(0)
  #define ENDW(tt) do{ if((tt)+3<NT){WAIT_BAR(2);} else if((tt)+2<NT){WAIT_BAR(1);} else {WAIT_BAR(0);} }while(0)
  for(;t+1<NT;t+=2){
    STEP(pB0,pB1,pA0,pA1,t,(t+3<NT),(t+1<NT),(t+1<NT));       ENDW(t);   RESC(); ROT();
    STEP(pA0,pA1,pB0,pB1,t+1,(t+4<NT),(t+2<NT),(t+2<NT));     ENDW(t+1); RESC(); ROT();
  }
  STEP(pB0,pB1,pA0,pA1,NT-1,false,false,false); RESC();
  { float sacc=pB0[0]+pB0[1]; _Pragma("unroll") for(int r=2;r<16;++r)sacc+=pB0[r]; _Pragma("unroll") for(int r=0;r<16;++r)sacc+=pB1[r]; l_reg+=sacc;
    pw0=(u32x4){PKW(pB0,0),PKW(pB0,2),PKW(pB0,4),PKW(pB0,6)};pw1=(u32x4){PKW(pB0,8),PKW(pB0,10),PKW(pB0,12),PKW(pB0,14)};pw2=(u32x4){PKW(pB1,0),PKW(pB1,2),PKW(pB1,4),PKW(pB1,6)};pw3=(u32x4){PKW(pB1,8),PKW(pB1,10),PKW(pB1,12),PKW(pB1,14)};
    SBAR(); pv(o,vb0+sl_cur,PAF(0),PAF(1),PAF(2),PAF(3)); }
  #undef PKW
  #undef PAF
  #undef VFR
  #undef PIN
  #undef MX3
  #undef GAPA
  #undef GAPB
  #undef EX
  #undef VRD
  #undef KRD
  #undef STEP
  #undef ENDW
  {auto rr=__builtin_amdgcn_permlane32_swap(__float_as_uint(l_reg),__float_as_uint(l_reg),false,false);l_reg=__uint_as_float(rr[0])+__uint_as_float(rr[1]);}
  if(hi==0)wsf[32+r32]=l_reg;asm volatile("s_waitcnt lgkmcnt(0)":::"memory");
  float rli[16];
  #pragma unroll
  for(int r=0;r<16;++r)rli[r]=__builtin_amdgcn_rcpf(wsf[32+crow(r,hi)]);
  bf16*Ow=O+(rowbase+q0+wid*QBLK)*OP+h*D;
  { bf16*stg=(bf16*)(shm+LDS_OST)+wid*2048;
    #pragma unroll
    for(int r=0;r<16;++r){const int orow=crow(r,hi);
      #pragma unroll
      for(int d0=0;d0<2;++d0)stg[orow*64+d0*32+r32]=__float2bfloat16(o[d0][r]*rli[r]);}
    asm volatile("s_waitcnt lgkmcnt(0)":::"memory");
    #pragma unroll
    for(int i=0;i<4;++i){const int row=i*8+(lane>>3),ch=lane&7; const u32x4 v=*(const u32x4*)(stg+row*64+ch*8); ATTN_STORE16(Ow+(long)row*OP+ch*8,v);
      float sq=0.f;
      #pragma unroll
      for(int k=0;k<4;++k){ const float lo=__uint_as_float(v[k]<<16), hi_=__uint_as_float(v[k]&0xffff0000u); sq+=lo*lo+hi_*hi_; }
      sq+=__shfl_xor(sq,1); sq+=__shfl_xor(sq,2); sq+=__shfl_xor(sq,4);
      if(ch==0) ssq[(long)h*(BATCH*SEQ)+rowbase+q0+wid*QBLK+row]=sq; } }
  asm volatile("s_waitcnt lgkmcnt(0)\n\ts_barrier":::"memory");
  #undef DMA_K
  #undef DMA_V
  #undef CMASK
  #undef START
  #undef RESC
  #undef ROT
}
constexpr int ATTN_LDS_BYTES=LDS_BYTES;
struct AttnTensors { const bf16* Q; const bf16* K; const bf16* V; bf16* O; const float* qg; const float* rope; float* ssq; float sbound; };
struct AttnUnit { int bh; int qb; };
struct StaticOrder {
  int vcu;
  __device__ __forceinline__ explicit StaticOrder(int grid,int block):vcu((block%8)*(grid/8)+block/8){}
  __device__ __forceinline__ bool next(int i,AttnUnit&u)const{ if(i>=4)return false; const int pair=vcu>>4, c16=vcu&15; u.bh=(pair>>1)*NHEAD+(pair&1)*4+(c16>>2); u.qb=(c16&3)*4+i; return true; }
  __device__ __forceinline__ void a_ready(const AttnUnit&)const{}
  __device__ __forceinline__ void done(const AttnUnit&)const{}
};
template<class Sched,int THRL=8> __device__ __forceinline__ void attn_phase(char*lds,const AttnTensors&T,const Sched&S){
  AttnUnit u;
  for(int i=0;S.next(i,u);++i){ S.a_ready(u); attn_unit<THRL>(u.bh/NHEAD,u.bh%NHEAD,u.qb,T.Q,T.K,T.V,T.O,lds,T.qg,T.rope,T.ssq,T.sbound); S.done(u); }
}
#undef SBAR
#undef WAIT_BAR
}

constexpr int NWAVES = 8;
constexpr int RING_OFF = 0, RING_BYTES = 131072;
constexpr int LDSCTL_OFF = RING_BYTES, MISC_OFF = LDSCTL_OFF + 320;
constexpr int LDS_BYTES = 147456;
constexpr int CW_BAR = 32768;
constexpr int MAX_LAUNCH = 8;
static_assert((CW_BAR + MAX_LAUNCH * XCD_BAR_WORDS) * 4 <= (int)(1 * MiB), "barrier words inside the memset region");
constexpr size_t WS_WINT = 4 * MiB;
constexpr size_t WS_WOUTT = 9 * MiB;
constexpr size_t WS_SSQ = 13 * MiB;
constexpr size_t WS_RSTD = 3 * MiB + 65536;
constexpr size_t WS_WGU = 16 * MiB;
constexpr size_t WS_WD = 144 * MiB;
constexpr int TAB_OFF = LDSCTL_OFF + 1024;
constexpr int XS_ROWS = NSLOT + 256;

constexpr int PROF_A = -1, PROF_B = -1;
constexpr int CW_PROF = 20000;
constexpr int FP8TEST = 0;
constexpr int NCONV = 136;
constexpr int CW_COUNTS2 = 70000, CW_CURSOR2 = 75000, CW_TILECNT = 90000;
constexpr int HIST_OFF = 49152, POS_OFF = 50176;
constexpr int REP0 = 1, REPG1 = 1, REPG3 = 1, REPATT = 1, REPM1 = 1, REPM2 = 1, REPP1 = 1, REPALL = 1, REPU = 1, REPP5 = 1, DRYQK = 0, DRYAN = 0, DRYSC = 0, DRYFIN = 0, DRYRT = 0;
struct Args { const float* in[21]; float* out; unsigned char* ws; int ph_lo, ph_hi, li, pad; };

struct Frame {
    LAS unsigned char* lds;
    volatile LAS unsigned* MISC;
    int tid, lane, wave, vcu, G;
};

template <bool NT = false>
__device__ __forceinline__ void p0_transpose_item(const float* W, int ldw, int k0, int ns0, bf16* WT, int K, int nd0, LAS float* scr, int lane) {
    if (ns0 >= 0) {
        f32x4 v[8];
#pragma unroll
        for (int i = 0; i < 8; ++i) { const GAS f32x4* p = (const GAS f32x4*)(W + (size_t)(k0 + 8 * i + (lane >> 3)) * ldw + ns0 + (lane & 7) * 4); v[i] = NT ? __builtin_nontemporal_load(p) : *p; }
#pragma unroll
        for (int i = 0; i < 8; ++i) { LAS float* p = scr + (8 * i + (lane >> 3)) * 33 + (lane & 7) * 4; p[0] = v[i].x; p[1] = v[i].y; p[2] = v[i].z; p[3] = v[i].w; }
    } else {
#pragma unroll 8
        for (int i = 0; i < 32; ++i) { const int kk = 2 * i + (lane >> 5); scr[kk * 33 + (lane & 31)] = 0.f; }
    }
    LDS_WAIT(); asm volatile("" ::: "memory");
    const int c = lane & 7;
#pragma unroll
    for (int j = 0; j < 4; ++j) { const int n = (lane >> 3) + 8 * j; const LAS float* s = scr + (8 * c) * 33 + n;
        v4u o; o.x = pk2(s[0 * 33], s[1 * 33]); o.y = pk2(s[2 * 33], s[3 * 33]); o.z = pk2(s[4 * 33], s[5 * 33]); o.w = pk2(s[6 * 33], s[7 * 33]);
        GAS v4u* q = (GAS v4u*)(WT + (size_t)(nd0 + n) * K + k0 + 8 * c); if (NT) __builtin_nontemporal_store(o, q); else *q = o; }
    LDS_WAIT(); asm volatile("" ::: "memory");
}

__device__ __forceinline__ void p0_transpose_item_wout(const float* W, int k0, int ns0, bf16* WT, const float* again, LAS float* scr, int lane) {
    f32x4 v[8];
#pragma unroll
    for (int i = 0; i < 8; ++i) { const int k = k0 + 8 * i + (lane >> 3); v[i] = *(const GAS f32x4*)(W + (size_t)k * D + ns0 + (lane & 7) * 4); if (k0 >= 512) v[i] = v[i] * again[k - 512]; }
#pragma unroll
    for (int i = 0; i < 8; ++i) { LAS float* p = scr + (8 * i + (lane >> 3)) * 33 + (lane & 7) * 4; p[0] = v[i].x; p[1] = v[i].y; p[2] = v[i].z; p[3] = v[i].w; }
    LDS_WAIT(); asm volatile("" ::: "memory");
    const int c = lane & 7, kd0 = (k0 + 512) & 1023;
#pragma unroll
    for (int j = 0; j < 4; ++j) { const int n = (lane >> 3) + 8 * j; const LAS float* sp = scr + (8 * c) * 33 + n;
        v4u o; o.x = pk2(sp[0 * 33], sp[1 * 33]); o.y = pk2(sp[2 * 33], sp[3 * 33]); o.z = pk2(sp[4 * 33], sp[5 * 33]); o.w = pk2(sp[6 * 33], sp[7 * 33]);
        *(GAS v4u*)(WT + (size_t)(ns0 + n) * D + kd0 + 8 * c) = o; }
    LDS_WAIT(); asm volatile("" ::: "memory");
}
struct ConvItem { const float* W; int ldw, k0, ns0; bf16* WT; int K, nd0; };
__device__ __forceinline__ void conv_load(const ConvItem& it, f32x4 (&v)[8], int lane) {
#pragma unroll
    for (int i = 0; i < 8; ++i) v[i] = __builtin_nontemporal_load((const GAS f32x4*)(it.W + (size_t)(it.k0 + 8 * i + (lane >> 3)) * it.ldw + it.ns0 + (lane & 7) * 4));
}
__device__ __forceinline__ void conv_finish(const ConvItem& it, const f32x4 (&v)[8], LAS float* scr, int lane) {
#pragma unroll
    for (int i = 0; i < 8; ++i) { LAS float* p = scr + (8 * i + (lane >> 3)) * 33 + (lane & 7) * 4; p[0] = v[i].x; p[1] = v[i].y; p[2] = v[i].z; p[3] = v[i].w; }
    LDS_WAIT(); asm volatile("" ::: "memory");
    const int c = lane & 7;
#pragma unroll
    for (int j = 0; j < 4; ++j) { const int n = (lane >> 3) + 8 * j; const LAS float* s = scr + (8 * c) * 33 + n;
        v4u o; o.x = pk2(s[0 * 33], s[1 * 33]); o.y = pk2(s[2 * 33], s[3 * 33]); o.z = pk2(s[4 * 33], s[5 * 33]); o.w = pk2(s[6 * 33], s[7 * 33]);
        __builtin_nontemporal_store(o, (GAS v4u*)(it.WT + (size_t)(it.nd0 + n) * it.K + it.k0 + 8 * c)); }
    LDS_WAIT(); asm volatile("" ::: "memory");
}
__device__ __forceinline__ ConvItem conv_item(int it, const float* wgate, const float* wup, const float* wdown, bf16* WguT, bf16* WdT) {
    constexpr int I_GU = NEXP * (D / 64) * (1024 / 32);
    ConvItem c;
    if (it < I_GU) { const int e = it >> 9, q = it & 511, kb = q >> 5, nb = q & 31, pn = nb >> 3, bj = (nb >> 2) & 1, c0 = (nb & 3) * 32;
        c.W = (bj ? wup : wgate) + (size_t)e * D * DEXP; c.ldw = DEXP; c.k0 = kb * 64; c.ns0 = pn * 128 + c0; c.WT = WguT + (size_t)e * 1024 * D; c.K = D; c.nd0 = nb * 32; }
    else { const int r = it - I_GU, e = r >> 8, q = r & 255, kb = q >> 5, nb = q & 31;
        c.W = wdown + (size_t)e * DEXP * D; c.ldw = D; c.k0 = kb * 64; c.ns0 = nb * 32; c.WT = WdT + (size_t)e * 1024 * DEXP; c.K = DEXP; c.nd0 = nb * 32; }
    return c;
}

__device__ __forceinline__ unsigned pk4_i8(float a, float b, float c, float d) {
    const int ia = __float2int_rn(a), ib = __float2int_rn(b), ic = __float2int_rn(c), id = __float2int_rn(d);
    return ((unsigned)ia & 0xffu) | (((unsigned)ib & 0xffu) << 8) | (((unsigned)ic & 0xffu) << 16) | ((unsigned)id << 24);
}
__device__ __forceinline__ void conv_colblock_i8g(const float* Wsrc, int ldw, unsigned char* out, float* sw32, LAS unsigned char* lds, int wave, int lane) {
    const float* W = Wsrc + (lane & 7) * 4;
    const int DEXP_ = ldw;
    LAS float* pmax = (LAS float*)(lds + 69632);
    f32x4 v[2][8];
#pragma unroll
    for (int q = 0; q < 2; ++q)
#pragma unroll
        for (int i = 0; i < 8; ++i) v[q][i] = Wsrc ? __builtin_nontemporal_load((const GAS f32x4*)(W + (size_t)((2 * wave + q) * 64 + 8 * i + (lane >> 3)) * DEXP_)) : (f32x4){0.f, 0.f, 0.f, 0.f};
    float mx[4] = {0.f, 0.f, 0.f, 0.f};
#pragma unroll
    for (int q = 0; q < 2; ++q)
#pragma unroll
        for (int i = 0; i < 8; ++i) { mx[0] = fmaxf(mx[0], fabsf(v[q][i].x)); mx[1] = fmaxf(mx[1], fabsf(v[q][i].y)); mx[2] = fmaxf(mx[2], fabsf(v[q][i].z)); mx[3] = fmaxf(mx[3], fabsf(v[q][i].w)); }
#pragma unroll
    for (int j = 0; j < 4; ++j) { mx[j] = fmaxf(mx[j], __shfl_xor(mx[j], 8)); mx[j] = fmaxf(mx[j], __shfl_xor(mx[j], 16)); mx[j] = fmaxf(mx[j], __shfl_xor(mx[j], 32)); }
    if (lane < 8) *(LAS f32x4*)(pmax + wave * 32 + lane * 4) = (f32x4){mx[0], mx[1], mx[2], mx[3]};
    __syncthreads();
#pragma unroll
    for (int w2 = 0; w2 < 8; ++w2) { const f32x4 m = *(const LAS f32x4*)(pmax + w2 * 32 + (lane & 7) * 4); mx[0] = fmaxf(mx[0], m.x); mx[1] = fmaxf(mx[1], m.y); mx[2] = fmaxf(mx[2], m.z); mx[3] = fmaxf(mx[3], m.w); }
    float inv[4];
#pragma unroll
    for (int j = 0; j < 4; ++j) inv[j] = mx[j] > 0.f ? 127.f / mx[j] : 0.f;
    if (wave == 0 && lane < 8) *(GAS f32x4*)(sw32 + lane * 4) = (f32x4){mx[0] * (1.f / 127.f), mx[1] * (1.f / 127.f), mx[2] * (1.f / 127.f), mx[3] * (1.f / 127.f)};
    LAS float* scr = (LAS float*)(lds + wave * 8448);
#pragma unroll
    for (int q = 0; q < 2; ++q) {
#pragma unroll
        for (int i = 0; i < 8; ++i) { LAS float* p = scr + (8 * i + (lane >> 3)) * 33 + (lane & 7) * 4; p[0] = v[q][i].x * inv[0]; p[1] = v[q][i].y * inv[1]; p[2] = v[q][i].z * inv[2]; p[3] = v[q][i].w * inv[3]; }
        LDS_WAIT(); asm volatile("" ::: "memory");
        { const int n = lane >> 1, hf = lane & 1; const LAS float* sp = scr + (32 * hf) * 33 + n; unsigned w[8];
#pragma unroll
          for (int r = 0; r < 8; ++r) w[r] = pk4_i8(sp[(4 * r) * 33], sp[(4 * r + 1) * 33], sp[(4 * r + 2) * 33], sp[(4 * r + 3) * 33]);
          GAS v4u* o = (GAS v4u*)(out + (size_t)n * D + (2 * wave + q) * 64 + 32 * hf); __builtin_nontemporal_store((v4u){w[0], w[1], w[2], w[3]}, o); __builtin_nontemporal_store((v4u){w[4], w[5], w[6], w[7]}, o + 1); }
        LDS_WAIT(); asm volatile("" ::: "memory");
    }
    __syncthreads();
}
__device__ __forceinline__ void conv_colblock_i8(int item  , const float* wgate, const float* wup, unsigned char* Wgu8, float* SW, LAS unsigned char* lds, int wave, int lane) {
    const int e = item >> 5, nb = item & 31, pn = nb >> 3, bj = (nb >> 2) & 1, c0 = (nb & 3) * 32;
    conv_colblock_i8g((bj ? wup : wgate) + (size_t)e * D * DEXP + pn * 128 + c0, DEXP, Wgu8 + ((size_t)e * 1024 + nb * 32) * D, SW + (size_t)e * 1024 + nb * 32, lds, wave, lane);
}
__device__ __forceinline__ void rms_row2_to_i8(int lane, const float* xrow0, const float* gain, unsigned char* o0, float* su0) {
    f32x4 v[2][4]; float ss[2] = {0.f, 0.f};
#pragma unroll
    for (int q = 0; q < 2; ++q)
#pragma unroll
        for (int j = 0; j < 4; ++j) v[q][j] = __builtin_nontemporal_load((const GAS f32x4*)(xrow0 + (size_t)q * D) + j * 64 + lane);
    f32x4 g[4];
#pragma unroll
    for (int j = 0; j < 4; ++j) g[j] = ((const GAS f32x4*)gain)[j * 64 + lane];
#pragma unroll
    for (int q = 0; q < 2; ++q)
#pragma unroll
        for (int j = 0; j < 4; ++j) ss[q] += (v[q][j].x * v[q][j].x + v[q][j].y * v[q][j].y) + (v[q][j].z * v[q][j].z + v[q][j].w * v[q][j].w);
    const bool b0 = lane & 1, b1 = lane & 2;
#pragma unroll
    for (int q = 0; q < 2; ++q) {
        const float rstd = rsqrtf(wave_sum(ss[q]) * (1.f / D) + EPS); float m = 0.f;
#pragma unroll
        for (int j = 0; j < 4; ++j) { v[q][j] = v[q][j] * rstd * g[j]; m = fmaxf(m, fmaxf(fmaxf(fabsf(v[q][j].x), fabsf(v[q][j].y)), fmaxf(fabsf(v[q][j].z), fabsf(v[q][j].w)))); }
#pragma unroll
        for (int o = 1; o < 64; o <<= 1) m = fmaxf(m, __shfl_xor(m, o));
        const float inv = m > 0.f ? 127.f / m : 0.f;
        unsigned w[4], x[4], y[4];
#pragma unroll
        for (int j = 0; j < 4; ++j) w[j] = pk4_i8(v[q][j].x * inv, v[q][j].y * inv, v[q][j].z * inv, v[q][j].w * inv);
#pragma unroll
        for (int p2 = 0; p2 < 2; ++p2) { const unsigned snd = b0 ? w[2 * p2] : w[2 * p2 + 1]; const unsigned rcv = (unsigned)__shfl_xor((int)snd, 1);
            x[2 * p2] = b0 ? rcv : w[2 * p2]; x[2 * p2 + 1] = b0 ? w[2 * p2 + 1] : rcv; }
#pragma unroll
        for (int i = 0; i < 2; ++i) { const unsigned snd = b1 ? x[i] : x[2 + i]; const unsigned rcv = (unsigned)__shfl_xor((int)snd, 2);
            y[i] = b1 ? rcv : x[i]; y[2 + i] = b1 ? x[2 + i] : rcv; }
        *(GAS v4u*)(o0 + (size_t)q * D + (lane & 3) * 256 + (lane >> 2) * 16) = (v4u){y[0], y[1], y[2], y[3]};
        if (lane == 0) su0[q] = m * (1.f / 127.f);
    }
}
__device__ __forceinline__ float wave_sum_x(float v) {
#pragma unroll
    for (int o = 1; o < 64; o <<= 1) v += __shfl_xor(v, o);
    return v;
}
__device__ __forceinline__ void rms_row2_to_bf16(int lane, const float* xrow0, const float* xrow1, const float* gain, bf16* orow0, bf16* orow1) {
    const GAS f32x4* xa = (const GAS f32x4*)xrow0 + lane; const GAS f32x4* xb = (const GAS f32x4*)xrow1 + lane;
    f32x4 va[4], vb[4]; float sa = 0.f, sb = 0.f;
#pragma unroll
    for (int j = 0; j < 4; ++j) { va[j] = __builtin_nontemporal_load(xa + 64 * j); vb[j] = __builtin_nontemporal_load(xb + 64 * j); }
#pragma unroll
    for (int j = 0; j < 4; ++j) { sa += (va[j].x * va[j].x + va[j].y * va[j].y) + (va[j].z * va[j].z + va[j].w * va[j].w); sb += (vb[j].x * vb[j].x + vb[j].y * vb[j].y) + (vb[j].z * vb[j].z + vb[j].w * vb[j].w); }
    const float ra = rsqrtf(wave_sum_x(sa) * (1.f / D) + EPS), rb = rsqrtf(wave_sum_x(sb) * (1.f / D) + EPS);
    GAS unsigned long long* oa = (GAS unsigned long long*)orow0 + lane; GAS unsigned long long* ob = (GAS unsigned long long*)orow1 + lane;
#pragma unroll
    for (int j = 0; j < 4; ++j) { const f32x4 g = ((const GAS f32x4*)gain)[64 * j + lane];
        oa[64 * j] = (unsigned long long)pk2(va[j].x * ra * g.x, va[j].y * ra * g.y) | ((unsigned long long)pk2(va[j].z * ra * g.z, va[j].w * ra * g.w) << 32);
        ob[64 * j] = (unsigned long long)pk2(vb[j].x * rb * g.x, vb[j].y * rb * g.y) | ((unsigned long long)pk2(vb[j].z * rb * g.z, vb[j].w * rb * g.w) << 32); }
}

__global__ void __launch_bounds__(NWAVES * 64, 2) mega(Args args) {
    extern __shared__ __attribute__((aligned(16))) unsigned char lds[];
    Frame F;
    F.lds = (LAS unsigned char*)lds;
    F.MISC = (volatile LAS unsigned*)(F.lds + MISC_OFF);
    F.tid = threadIdx.x; F.lane = F.tid & 63; F.wave = __builtin_amdgcn_readfirstlane(F.tid >> 6);
    F.G = gridDim.x; { const int bx = blockIdx.x; F.vcu = (F.G % 8 == 0) ? (bx % 8) * (F.G / 8) + bx / 8 : bx; }
    unsigned char* ws = args.ws;
    gu32* ctl = (gu32*)(ws + WS_CTL);
    for (int u = F.tid; u < (LDS_BYTES - LDSCTL_OFF) / 4; u += NWAVES * 64) ((LAS unsigned*)(F.lds + LDSCTL_OFF))[u] = 0u;
    __syncthreads();
    XcdBarrier bar = xcd_barrier_post((unsigned*)(ctl + CW_BAR) + args.li * XCD_BAR_WORDS, F.MISC + 8);
    const int lo = args.ph_lo, hi = args.ph_hi;
#define IN(k) (lo <= (k) && (k) < hi)
#define BOTH(k) (IN(k) && IN((k) + 1))
#define GRID_BAR() xcd_barrier(bar)
    unsigned long long tprev = 0; if (PROF_A >= 0 && blockIdx.x == 0 && F.tid == 0) tprev = rt();
#define STAMP(k) do { if (PROF_A >= 0 && blockIdx.x == 0 && F.tid == 0) { const unsigned long long now_ = rt(); __hip_atomic_store(ctl + CW_PROF + (k), (unsigned)(now_ - tprev), RLX_AGENT); tprev = now_; } } while (0)
    const float* x = args.in[0];
    bf16* U = (bf16*)(ws + WS_U); bf16* PROJ = (bf16*)(ws + WS_PROJ); bf16* WinT = (bf16*)(ws + WS_WINT);
    const int gw = F.vcu * NWAVES + F.wave, NGW = F.G * NWAVES;

    const int gtid = (int)blockIdx.x * (NWAVES * 64) + F.tid, nthr = F.G * NWAVES * 64;
    const int half = F.tid >> 8, t256 = F.tid & 255, bx = (int)blockIdx.x;
    unsigned* ctlp = (unsigned*)(ws + WS_CTL); unsigned* tokinfo = (unsigned*)(ws + WS_TOKINFO); int* tokslot = (int*)(ws + WS_TOKSLOT); int* slottok = (int*)(ws + WS_SLOTTOK);
    float* slotgate = (float*)(ws + WS_SLOTGATE); float* rope = (float*)(ws + WS_ROPE);
    bf16* KVS = (bf16*)(ws + WS_G); float* DEC = (float*)(ws + WS_DEC); float* SSQ = (float*)(ws + WS_SSQ);
    float* RSTD = (float*)(ws + WS_RSTD); bf16* WguT = (bf16*)(ws + WS_WGU); bf16* WdT = (bf16*)(ws + WS_WD); bf16* XS = (bf16*)(ws + WS_PROJ);
    float* RATT = (float*)(ws + 15 * MiB + 512 * 1024); bf16* HB = (bf16*)(ws + 80 * MiB);
    unsigned char* U8 = ws + WS_U; unsigned char* Win8 = ws + WS_WINT; float* SUS = (float*)(ws + 14 * MiB + 512 * 1024); float* SWIN = (float*)(ws + 14 * MiB + 768 * 1024);
    unsigned char* Wgu8 = ws + WS_WGU; float* SWS = (float*)(ws + 14 * MiB); float* SAS = (float*)(ws + 15 * MiB); unsigned char* XS8 = ws + WS_PROJ;
    LAS int* tab = (LAS int*)(F.lds + TAB_OFF); LAS int* t_cnt = tab; LAS int* t_offs = tab + 64; LAS int* t_e = tab + 144; LAS int* t_r0 = tab + 464; LAS int* t_nr = tab + 784; LAS int* t_n = tab + 1104;
    bf16* HMID = (bf16*)(ws + WS_G); unsigned char* YS8 = ws + WS_PROJ + 64 * MiB; float* YSC = (float*)(ws + WS_PROJ + 128 * MiB);   bf16* WoutT = (bf16*)(ws + WS_WOUTT);

    if (IN(0)) {
        LAS float* scr = (LAS float*)(F.lds + RING_OFF + F.wave * 16384);
        constexpr int I_WOUT = (D / 64) * (D / 32);
        const int gb = bx * NWAVES + F.wave;
        if (F.G == 256) { const int it = gb - (2048 - I_WOUT); if (it >= 0) { const int kb = it / (D / 32), nb = it % (D / 32); p0_transpose_item_wout(args.in[11], kb * 64, nb * 32, WoutT, args.in[10], scr, F.lane); } }
        else for (int it = gw; it < I_WOUT; it += NGW) { const int kb = it / (D / 32), nb = it % (D / 32); p0_transpose_item_wout(args.in[11], kb * 64, nb * 32, WoutT, args.in[10], scr, F.lane); }
        __syncthreads();
        for (int nb = bx; nb < PW / 32; nb += F.G) { const int cs = proj_src_col(nb * 32);
            conv_colblock_i8g(cs < 0 ? nullptr : args.in[2] + cs, DIN, Win8 + (size_t)nb * 32 * D, SWIN + nb * 32, F.lds + RING_OFF, F.wave, F.lane); }
        router_build_bfrag(gtid, nthr, args.in[13], args.in[15], args.in[12], (bf16*)(ws + WS_BFRAG));
        if (F.G == 256) {
            for (int i = 0; i < 6; ++i) { const int m = 2 * (gb + 2048 * i); rms_row2_to_i8(F.lane, x + (size_t)m * D, args.in[1], U8 + (size_t)m * D, SUS + m); }
            if (bx >= PW / 32) for (int j = gb - (PW / 32) * NWAVES; j < 4096; j += 2048 - (PW / 32) * NWAVES) { const int m = 2 * (12288 + j); rms_row2_to_i8(F.lane, x + (size_t)m * D, args.in[1], U8 + (size_t)m * D, SUS + m); }
        } else
        for (int rep = 0; rep < REPU; ++rep) for (int m = 2 * gw; m < NTOK; m += 2 * NGW) rms_row2_to_i8(F.lane, x + (size_t)m * D, args.in[1], U8 + (size_t)m * D, SUS + m);
        { if (gtid < 1024) { const int pos = gtid >> 4, j = gtid & 15; const float ang = (float)pos * powf(10000.0f, -(float)(2 * j) / 32.0f); rope[gtid] = cosf(ang); rope[1024 + gtid] = sinf(ang); } }
        if (BOTH(0)) GRID_BAR();
        STAMP(0);
    }
    if (IN(1)) {
        const int rk = bx >> 3, xg = bx & 7; constexpr int NGE = 32 - NCONV / 8;
        if (F.G != 256 || rk < NGE) {
            pg8::Gemm g{(const pg8::bf16_t*)U8, (const pg8::bf16_t*)Win8, NTOK, PW, D}; pg8::StaticOrder S;
            if (F.G == 256) S.init(NTOK, PW, NGE * 8, rk * 8 + xg); else S.init(NTOK, PW, F.G, bx);
            pg8::EpiBf16_I8 E{PROJ, PW, SUS, SWIN, DIN};
            for (int rep = 0; rep < REPP1; ++rep) pg8::gemm_phase<pg8::EpiBf16_I8, pg8::StaticOrder, true, true, false, true>(F.lds + RING_OFF, g, S, E);
        }
        if (F.G != 256 || rk >= NGE) {
            LAS float* scr = (LAS float*)(F.lds + RING_OFF + F.wave * 16384);
            constexpr int I_GU = NEXP * (D / 64) * (1024 / 32), I_DN = NEXP * (DEXP / 64) * (D / 32);
            const int cw = (F.G == 256) ? ((rk - NGE) * 8 + xg) * NWAVES + F.wave : gw, NCW = (F.G == 256) ? NCONV * NWAVES : NGW;
            for (int rep = 0; rep < REP0; ++rep) {
                { const int cwg = (F.G == 256) ? (rk - NGE) * 8 + xg : bx, NWG = (F.G == 256) ? NCONV : F.G;
                  for (int it = cwg; it < NEXP * 32; it += NWG) conv_colblock_i8(it, args.in[17], args.in[18], Wgu8, SWS, F.lds + RING_OFF, F.wave, F.lane); }
                const int base_ = I_DN / NCW, rem_ = I_DN % NCW, lo_ = NCW - rem_;
                const int dn = base_ + (cw >= lo_ ? 1 : 0), d0 = cw < lo_ ? cw * base_ : lo_ * base_ + (cw - lo_) * (base_ + 1);
                f32x4 va[8], vb[8]; ConvItem ia, ib;
                int k = 0;
                if (k < dn) { ia = conv_item(I_GU + d0 + k, args.in[17], args.in[18], args.in[19], WguT, WdT); conv_load(ia, va, F.lane); }
                for (; k < dn; k += 2) {
                    const bool hb = k + 1 < dn, ha = k + 2 < dn;
                    if (hb) { ib = conv_item(I_GU + d0 + k + 1, args.in[17], args.in[18], args.in[19], WguT, WdT); conv_load(ib, vb, F.lane); }
                    conv_finish(ia, va, scr, F.lane);
                    if (ha) { ia = conv_item(I_GU + d0 + k + 2, args.in[17], args.in[18], args.in[19], WguT, WdT); conv_load(ia, va, F.lane); }
                    if (hb) conv_finish(ib, vb, scr, F.lane);
                }
            }
        }
        if (BOTH(1)) GRID_BAR();
        STAMP(1);
    }
    if (IN(2)) {
        for (int rep = 0; rep < REPG1; ++rep) gla_g1_phase(F.lds + RING_OFF, F.tid, bx, PROJ, args.in[3], args.in[4], args.in[5], args.in[6], KVS, DEC);
        if (DRYQK) ph_qk_prep(gw, NGW, F.lane, PROJ, args.in[8], args.in[9], rope, U, D);
        ph_qk_prep(gw, NGW, F.lane, PROJ, args.in[8], args.in[9], rope, PROJ + C_AQ, PW);
        if (BOTH(2)) GRID_BAR();
        STAMP(2);
    }
    if (IN(3)) {
        gla_g2_scan(gtid, nthr, KVS, DEC);
        __syncthreads();
        float sb_; { float mq = 0.f, mk = 0.f;
#pragma unroll 8
          for (int i = 0; i < 64; ++i) { mq = fmaxf(mq, fabsf(args.in[8][i])); mk = fmaxf(mk, fabsf(args.in[9][i])); }
          sb_ = 64.f * mq * mk * attn_body::C2 * 1.02f; }
        { const attn_body::AttnTensors AT{(const attn_body::bf16*)(PROJ + C_AQ), (const attn_body::bf16*)(PROJ + C_AK), (const attn_body::bf16*)(PROJ + C_AV), (attn_body::bf16*)(U), args.in[8], rope, SSQ, sb_};
          const attn_body::StaticOrder S((int)F.G, bx);
          for (int rep = 0; rep < REPATT; ++rep) attn_body::attn_phase<attn_body::StaticOrder>((char*)lds + RING_OFF, AT, S); }
        if (BOTH(3)) GRID_BAR();
        STAMP(3);
    }
    if (IN(4)) {
        for (int rep = 0; rep < REPG3; ++rep) gla_g3_phase(F.lds + RING_OFF, F.tid, bx, PROJ, args.in[3], args.in[4], args.in[5], args.in[6], KVS, args.in[7], U, SSQ, RATT);
        if (BOTH(4)) GRID_BAR();
        STAMP(4);
    }
    if (IN(5)) {
        pg8::Gemm g{U, WoutT, NTOK, D, D}; pg8::StaticOrder S; S.init(NTOK, D, F.G, bx);
        pg8::EpiBf16Res E{HB, x, D, RATT};
        for (int rep = 0; rep < REPP5; ++rep) pg8::gemm_phase<pg8::EpiBf16Res, pg8::StaticOrder, true, true>(F.lds + RING_OFF, g, S, E);
        if (BOTH(5)) GRID_BAR();
        STAMP(5);
    }
    if (IN(6)) {
        LAS int* hist = (LAS int*)(F.lds + HIST_OFF);
        if (F.tid < 64) hist[F.tid] = 0;
        __syncthreads();
        ph_router_lds(F.vcu, F.G, F.wave, F.lane, F.lds + RING_OFF, HB, (const bf16*)(ws + WS_BFRAG), args.in[14], args.in[16], RSTD, tokinfo, hist, false);
        if (DRYRT) ph_router_lds(F.vcu, F.G, F.wave, F.lane, F.lds + RING_OFF, HB, (const bf16*)(ws + WS_BFRAG), args.in[14], args.in[16], RSTD, tokinfo, hist, true);
        __syncthreads();
        if (F.tid < 64) { const int c = hist[F.tid]; if (c) atomicAdd(ctlp + CW_COUNTS2 + 64 * F.tid, (unsigned)c); }
        if (IN(6) && IN(8)) GRID_BAR();
        STAMP(6);
    }
    if (IN(8)) {
        LAS int* hist = (LAS int*)(F.lds + HIST_OFF); LAS int* gbase = hist + 64; LAS int* tbase = hist + 128; LAS int* pos = (LAS int*)(F.lds + POS_OFF);
        if (F.tid < 64) { t_cnt[F.tid] = (int)__hip_atomic_load(ctl + CW_COUNTS2 + 64 * F.tid, RLX_AGENT); hist[F.tid] = 0; }
        __syncthreads();
        if (F.tid == 0) { int off = 0, nt = 0;
            for (int e = 0; e < NEXP; ++e) { const int c = t_cnt[e]; t_offs[e] = off; tbase[e] = nt; off += c; nt += (c + 255) >> 8; }
            t_offs[NEXP] = off; t_n[0] = nt; }
        uint4 ti = make_uint4(0, 0, 0, 0); int r0 = 0, r1 = 0;
        if (F.tid < 128) { ti = ((const uint4*)tokinfo)[bx * 128 + F.tid];
            r0 = __hip_atomic_fetch_add(hist + ti.x, 1, __ATOMIC_RELAXED, __HIP_MEMORY_SCOPE_WORKGROUP); r1 = __hip_atomic_fetch_add(hist + ti.y, 1, __ATOMIC_RELAXED, __HIP_MEMORY_SCOPE_WORKGROUP); }
        __syncthreads();
        if (F.tid < 64) { const int e = F.tid, c = t_cnt[e], nt0 = tbase[e], o0 = t_offs[e];
            for (int r = 0, k = 0; r < c; r += 256, ++k) { t_e[nt0 + k] = e; t_r0[nt0 + k] = o0 + r; t_nr[nt0 + k] = (c - r) < 256 ? (c - r) : 256; }
            const int hc = hist[e]; gbase[e] = hc ? (int)atomicAdd(ctlp + CW_CURSOR2 + 64 * e, (unsigned)hc) : 0; }
        __syncthreads();
        if (F.tid < 128) { const int t = bx * 128 + F.tid; const int p0 = t_offs[ti.x] + gbase[ti.x] + r0, p1 = t_offs[ti.y] + gbase[ti.y] + r1;
            pos[2 * F.tid] = p0; pos[2 * F.tid + 1] = p1; tokslot[2 * t] = p0; tokslot[2 * t + 1] = p1; slotgate[p0] = __uint_as_float(ti.z); slotgate[p1] = __uint_as_float(ti.w); }
        __syncthreads();
        ph_copy_xs_i8(bx, F.wave, F.lane, pos, HB, RSTD, args.in[12], XS8, SAS);
        if (DRYSC) ph_copy_xs_i8(bx, F.wave, F.lane, pos, HB, RSTD, args.in[12], XS8, SAS);
        if (BOTH(8)) GRID_BAR();
        STAMP(8);
    }
    if (IN(9)) {
        pg8::Gemm g{(const pg8::bf16_t*)XS8, (const pg8::bf16_t*)Wgu8, XS_ROWS, 1024, D};
        pg8::GroupedOrderPub S{t_e, t_r0, t_nr, __builtin_amdgcn_readfirstlane(t_n[0]) * 4, F.G, F.vcu, (size_t)D, (size_t)1024 * D, ctlp + CW_TILECNT};
        pg8::EpiSwiGLU_I8<true> E{HMID, SAS, SWS};
        pg8::gemm_phase<pg8::EpiSwiGLU_I8<true>, pg8::GroupedOrderPub, true, true, false, true>(F.lds + RING_OFF, g, S, E);
        STAMP(9);
    }
    if (IN(10)) {
        pg8::Gemm g{HMID, WdT, XS_ROWS, 1024, DEXP};
        pg8::GroupedOrderDep S{t_e, t_r0, t_nr, __builtin_amdgcn_readfirstlane(t_n[0]) * 4, F.G, F.vcu, (size_t)1024 * DEXP * 2, ctlp + CW_TILECNT};
        pg8::EpiYs8 E{YS8, YSC, slotgate};
        pg8::gemm_phase<pg8::EpiYs8, pg8::GroupedOrderDep, true, true, true>(F.lds + RING_OFF, g, S, E);
        if (BOTH(10)) GRID_BAR();
        STAMP(10);
    }
    if (IN(11)) { if (DRYFIN) ph_final(gw, NGW, F.lane, HB, YS8, YSC, tokslot, args.in[20], (float*)(ws + WS_U), (float*)(ws + WS_G));
        ph_final(gw, NGW, F.lane, HB, YS8, YSC, tokslot, args.in[20], args.out, args.out + (size_t)(NTOK / 2) * D); }
    if (PROF_A >= 0) {
        GRID_BAR(); STAMP(11); GRID_BAR();
        const float ta = (float)__hip_atomic_load(ctl + CW_PROF + PROF_A, RLX_AGENT) * 0.01f;
        const float tb = (float)__hip_atomic_load(ctl + CW_PROF + (PROF_B >= 0 ? PROF_B : 0), RLX_AGENT) * 0.01f;
        const float kf = 0.002f * sqrtf(ta);
        for (size_t i = (size_t)gtid; i < (size_t)NTOK * D; i += (size_t)nthr) args.out[i] += (i == 0 && PROF_B >= 0) ? (1.f + tb * 0.01f) : kf;
    }
    if (FP8TEST) {
        GRID_BAR();
        if (bx == 0 && F.wave == 0) {
            typedef int v4i_t __attribute__((ext_vector_type(4)));
            const int l = F.lane, r16 = l & 15, kg = l >> 4;
            auto av = [](int i, int k) { return ((i * 7 + k * 3) % 11) - 5; };
            auto bvv = [](int k, int j) { return ((k * 5 + j * 11) % 13) - 6; };
            v4i_t A, B;
#pragma unroll
            for (int rg = 0; rg < 4; ++rg) { unsigned wa = 0, wb = 0;
#pragma unroll
                for (int by = 0; by < 4; ++by) { const int k = 16 * kg + 4 * rg + by; wa |= ((unsigned)av(r16, k) & 0xffu) << (8 * by); wb |= ((unsigned)bvv(k, r16) & 0xffu) << (8 * by); }
                A[rg] = (int)wa; B[rg] = (int)wb; }
            v4i_t acc = {0, 0, 0, 0};
            acc = __builtin_amdgcn_mfma_i32_16x16x64_i8(A, B, acc, 0, 0, 0);
            bool ok = true;
#pragma unroll
            for (int r = 0; r < 4; ++r) { const int row = 4 * kg + r; int sm = 0; for (int k = 0; k < 64; ++k) sm += av(row, k) * bvv(k, r16); ok = ok && (acc[r] == sm + (FP8TEST == 2 ? 1 : 0)); }
            if (!__all(ok) && l == 0) args.out[0] = __builtin_nanf("");
        }
    }
#undef IN
#undef BOTH
#undef GRID_BAR
}

static int g_grid = 0;
static void launch_mega(void* const* d_in, void* d_out, void* d_ws, hipStream_t stream, int lo, int hi, int li) {
    Args a{};
    for (int i = 0; i < 21; ++i) a.in[i] = (const float*)d_in[i];
    a.out = (float*)d_out; a.ws = (unsigned char*)d_ws; a.ph_lo = lo; a.ph_hi = hi; a.li = li; a.pad = 0;
    void* kargs[] = {&a};
    hipError_t e = hipLaunchCooperativeKernel((const void*)mega, dim3(g_grid), dim3(NWAVES * 64), kargs, LDS_BYTES, stream);
    if (e != hipSuccess) fprintf(stderr, "cooperative launch failed: %s (grid %d)\n", hipGetErrorString(e), g_grid);
}
extern "C" void kernel_launch(void* const* d_in, const int* in_sizes, int n_in, void* d_out, int out_size, void* d_ws, size_t ws_size, hipStream_t stream) {
    if (g_grid == 0) {
        int dev = 0, cus = 0, per_cu = 0;
        (void)hipGetDevice(&dev); (void)hipDeviceGetAttribute(&cus, hipDeviceAttributeMultiprocessorCount, dev);
        (void)hipFuncSetAttribute((const void*)mega, hipFuncAttributeMaxDynamicSharedMemorySize, LDS_BYTES);
        (void)hipOccupancyMaxActiveBlocksPerMultiprocessor(&per_cu, (const void*)mega, NWAVES * 64, LDS_BYTES);
        if (per_cu < 1) per_cu = 1;
        if (per_cu > 1) per_cu = 1;
        g_grid = cus * per_cu;
    }
    (void)hipMemsetAsync((char*)d_ws + WS_CTL, 0, 1 * MiB, stream);
    launch_mega(d_in, d_out, d_ws, stream, 0, 12, 0);
}
```

```cpp
#include <hip/hip_runtime.h>
#include <stdint.h>
#include <math.h>

constexpr int NB = 8, T = 4096, D = 1024, NTOK = NB * T;
constexpr int DIN = 2336;
constexpr int PW = 2560;
constexpr int C_GQ = 0, C_GK = 256, C_GV = 512, C_GG = 1024, C_AQ = 1536, C_AK = 2048, C_AV = 2176, C_ZF = 2304, C_ZB = 2320;
constexpr int NEXP = 64, DEXP = 512, NSLOT = 2 * NTOK;
constexpr float EPS = 1e-6f;

typedef unsigned short bf16_t;

constexpr size_t MiB = 1u << 20;
constexpr size_t WS_CTL = 0;
constexpr size_t WS_TOKINFO = 1 * MiB;
constexpr size_t WS_TOKSLOT = 1 * MiB + 512 * 1024;
constexpr size_t WS_SLOTTOK = 2 * MiB;
constexpr size_t WS_SLOTGATE = 2 * MiB + 256 * 1024;
constexpr size_t WS_ROPE = 3 * MiB;
constexpr size_t WS_LAF = 16 * MiB;
constexpr size_t WS_LAB = 48 * MiB;
constexpr size_t WS_OF = 80 * MiB;
constexpr size_t WS_OB = 144 * MiB;
constexpr size_t WS_U = 208 * MiB;
constexpr size_t WS_PROJ = 272 * MiB;
constexpr size_t WS_G = 432 * MiB;
constexpr int CW_COUNTS = 0, CW_CURSOR = 64, CW_OFFS = 128, CW_NTILES = 256, CW_TILE_E = 1024, CW_TILE_R0 = 4096, CW_TILE_NR = 8192;

__device__ __forceinline__ float bf2f(bf16_t v) { return __uint_as_float(((unsigned)v) << 16); }
__device__ __forceinline__ bf16_t f2bf(float f) { unsigned u = __float_as_uint(f); return (bf16_t)((u + 0x7fffu + ((u >> 16) & 1u)) >> 16); }
__device__ __forceinline__ float wave_sum(float v) {
#pragma unroll
    for (int o = 1; o < 64; o <<= 1) v += __shfl_xor(v, o);
    return v;
}
__device__ __forceinline__ float silu_f(float x) { return x / (1.f + expf(-x)); }


__device__ __forceinline__ float4 ld_bf4(const bf16_t* p) { const ushort4 u = *(const ushort4*)p; return make_float4(bf2f(u.x), bf2f(u.y), bf2f(u.z), bf2f(u.w)); }
__device__ __forceinline__ void st_bf4(bf16_t* p, float4 v) { ushort4 o; o.x = f2bf(v.x); o.y = f2bf(v.y); o.z = f2bf(v.z); o.w = f2bf(v.w); *(ushort4*)p = o; }
__host__ __device__ __forceinline__ int proj_src_col(int cd) {
    if (cd < 1536) return cd;
    if (cd < 2048) return 1568 + (cd - 1536);
    if (cd < 2176) return 2080 + (cd - 2048);
    if (cd < 2304) return 2208 + (cd - 2176);
    if (cd < 2336) return 1536 + (cd - 2304);
    return -1;
}
#include <cstdio>
namespace pg8 {
#define PG8_LAS __attribute__((address_space(3)))
typedef unsigned short bf16_t;
typedef short bf16x8 __attribute__((ext_vector_type(8)));
typedef float f32x4 __attribute__((ext_vector_type(4)));
typedef unsigned u32x4 __attribute__((ext_vector_type(4)));
constexpr int BM = 256, BK = 64, HALF = 128, HTB = HALF * BK * 2  , STAGE_BYTES = 8 * HTB, NXCD = 8, WGM = 8;

__host__ __device__ __forceinline__ int lds_byte(int r, int c) { return r * 128 + ((((c >> 3)) ^ ((r >> 1) & 7)) << 4) + (c & 7) * 2; }
__host__ __device__ __forceinline__ void stage_rc(int b, int& R, int& C) { R = b >> 7; C = ((((b >> 4) & 7) ^ ((R >> 1) & 7)) << 3); }
__host__ __device__ __forceinline__ int perm32(int rho) { const int n = rho >> 4, i = rho & 15; return 8 * (i >> 2) + 4 * n + (i & 3); }

typedef int i32x4 __attribute__((ext_vector_type(4)));
struct Unit { int pm, pn, row0, nr, e; unsigned rdy; };
struct Gemm { const bf16_t* A; const bf16_t* Bt; int M, N, K; };

struct StaticOrder {
    int nM, nN, nwg, G, c;
    __host__ __device__ void init(int M, int N, int G_, int c_) { nM = M / BM; nN = N / BM; nwg = nM * nN; G = G_; c = c_; }
    __host__ __device__ bool next(int i, Unit& u) const {
        const long L = (long)i * G + c; if (L >= nwg) return false;
        int wgid = (int)L; { const int q = nwg / NXCD, r = nwg % NXCD, xcd = wgid % NXCD, off = wgid / NXCD; wgid = (xcd < r ? xcd * (q + 1) : r * (q + 1) + (xcd - r) * q) + off; }
        const int nig = WGM * nN, gid = wgid / nig, fm = gid * WGM, gsz = (nM - fm) < WGM ? (nM - fm) : WGM;
        u.pm = fm + ((wgid % nig) % gsz); u.pn = (wgid % nig) / gsz; return true;
    }
    __device__ __forceinline__ size_t a_off(const Unit& u, size_t tstep) const { return (size_t)u.pm * tstep; }
    __device__ __forceinline__ size_t b_off(const Unit& u, size_t tstep) const { return (size_t)u.pn * tstep; }
    __device__ __forceinline__ void a_ready(const Unit&) const {}
    __device__ __forceinline__ void done(const Unit&) const {}
};

__device__ __forceinline__ unsigned cvt_pk_bf16(float lo, float hi) { unsigned r; asm volatile("v_cvt_pk_bf16_f32 %0, %1, %2" : "=v"(r) : "v"(lo), "v"(hi)); return r; }
typedef float f32x2 __attribute__((ext_vector_type(2)));
__device__ __forceinline__ f32x2 gelu_pk(f32x2 v) {
    const f32x2 av = __builtin_elementwise_abs(v), d = av * 0.2316418882f + 1.0f;
    f32x2 t; t.x = __builtin_amdgcn_rcpf(d.x); t.y = __builtin_amdgcn_rcpf(d.y);
    f32x2 q = t * 0.5307027145f + (-0.7265760135f); q = q * t + 0.7107068705f; q = q * t + (-0.142248368f); q = q * t + 0.127414796f; q = q * t;
    const f32x2 s = (v * v) * (-0.72134752044f);
    f32x2 e; e.x = __builtin_amdgcn_exp2f(s.x); e.y = __builtin_amdgcn_exp2f(s.y);
    const f32x2 m = v * (q * e), r = v - m;
    f32x2 o; o.x = v.x < 0.f ? m.x : r.x; o.y = v.y < 0.f ? m.y : r.y; return o;
}

template <int ACT  > struct EpiBf16 {
    static constexpr bool PERM = true, AFTER_DRAIN = false; static_assert(ACT == 0 || ACT == 1, "EpiBf16: ACT is 0 (none) or 1 (gelu_pk)");
    bf16_t* O; int ldc; const float* bias; int split_cols; size_t split_stride; float scale0;
    __device__ __forceinline__ void operator()(const f32x4 (&acc)[2][2][4][2], const Unit& u, int wr, int wc, int fr, int fq) const {
        const int row0 = u.pm * BM + wr * 64 + fr; int colt = u.pn * BM; bf16_t* base = O;
        float sc = 1.f; if (split_cols) { const int t = colt / split_cols; base += (size_t)t * split_stride; colt -= t * split_cols; if (t == 0) sc = scale0; }
        const int col0 = colt + wc * 32 + 8 * fq, bcol0 = u.pn * BM + wc * 32 + 8 * fq;
        f32x4 bv[2][2];
#pragma unroll
        for (int bj = 0; bj < 2; ++bj)
#pragma unroll
            for (int n = 0; n < 2; ++n) bv[bj][n] = bias ? *(const f32x4*)(bias + bcol0 + bj * HALF + 4 * n) : (f32x4){0.f, 0.f, 0.f, 0.f};
#pragma unroll
        for (int ai = 0; ai < 2; ++ai)
#pragma unroll
            for (int m = 0; m < 4; ++m) { bf16_t* rowp = base + (size_t)(row0 + ai * HALF + m * 16) * ldc + col0;
#pragma unroll
                for (int bj = 0; bj < 2; ++bj) { f32x4 v0 = acc[ai][bj][m][0] + bv[bj][0], v1 = acc[ai][bj][m][1] + bv[bj][1];
                    if (ACT == 1) { f32x2 a = gelu_pk((f32x2){v0[0], v0[1]}), b = gelu_pk((f32x2){v0[2], v0[3]}), c = gelu_pk((f32x2){v1[0], v1[1]}), d = gelu_pk((f32x2){v1[2], v1[3]});
                        v0 = (f32x4){a.x, a.y, b.x, b.y}; v1 = (f32x4){c.x, c.y, d.x, d.y}; }
                    v0 = v0 * sc; v1 = v1 * sc; u32x4 w; w.x = cvt_pk_bf16(v0[0], v0[1]); w.y = cvt_pk_bf16(v0[2], v0[3]); w.z = cvt_pk_bf16(v1[0], v1[1]); w.w = cvt_pk_bf16(v1[2], v1[3]);
                    *(u32x4*)(rowp + bj * HALF) = w; } }
    }
};
struct EpiBf16Res {
    static constexpr bool PERM = true, AFTER_DRAIN = false;
    bf16_t* O; const float* R; int ldc; const float* rs;
    __device__ __forceinline__ void operator()(const f32x4 (&acc)[2][2][4][2], const Unit& u, int wr, int wc, int fr, int fq) const {
        const int row0 = u.pm * BM + wr * 64 + fr, col0 = u.pn * BM + wc * 32 + 8 * fq;
#pragma unroll
        for (int ai = 0; ai < 2; ++ai)
#pragma unroll
            for (int m = 0; m < 4; ++m) { const int row = row0 + ai * HALF + m * 16; const size_t ro = (size_t)row * ldc + col0; const float r = rs[row];
#pragma unroll
                for (int bj = 0; bj < 2; ++bj) { const f32x4 v0 = acc[ai][bj][m][0] * r + *(const f32x4*)(R + ro + bj * HALF), v1 = acc[ai][bj][m][1] * r + *(const f32x4*)(R + ro + bj * HALF + 4);
                    u32x4 w; w.x = cvt_pk_bf16(v0[0], v0[1]); w.y = cvt_pk_bf16(v0[2], v0[3]); w.z = cvt_pk_bf16(v1[0], v1[1]); w.w = cvt_pk_bf16(v1[2], v1[3]);
                    *(u32x4*)(O + ro + bj * HALF) = w; } }
    }
};
struct GroupedOrder {
    const PG8_LAS int* te; const PG8_LAS int* tr0; const PG8_LAS int* tnr; int nunits, G, c; size_t a_pitch, b_exp;
    __device__ __forceinline__ bool next(int i, Unit& u) const {
        const int L = i * G + c; if (L >= nunits) return false;
        const int t = L >> 2; u.pm = t; u.pn = L & 3; u.e = __builtin_amdgcn_readfirstlane(te[t]); u.row0 = __builtin_amdgcn_readfirstlane(tr0[t]); u.nr = __builtin_amdgcn_readfirstlane(tnr[t]); return true;
    }
    __device__ __forceinline__ size_t a_off(const Unit& u, size_t) const { return (size_t)u.row0 * a_pitch; }
    __device__ __forceinline__ size_t b_off(const Unit& u, size_t tstep) const { return (size_t)u.e * b_exp + (size_t)u.pn * tstep; }
    __device__ __forceinline__ void a_ready(const Unit&) const {}
    __device__ __forceinline__ void done(const Unit&) const {}
};
struct GroupedOrderPub {
    const PG8_LAS int* te; const PG8_LAS int* tr0; const PG8_LAS int* tnr; int nunits, G, c; size_t a_pitch, b_exp; unsigned* cnt;
    __device__ __forceinline__ bool next(int i, Unit& u) const {
        const int L = i * G + c; if (L >= nunits) return false;
        const int t = L >> 2; u.pm = t; u.pn = L & 3; u.e = __builtin_amdgcn_readfirstlane(te[t]); u.row0 = __builtin_amdgcn_readfirstlane(tr0[t]); u.nr = __builtin_amdgcn_readfirstlane(tnr[t]); return true;
    }
    __device__ __forceinline__ size_t a_off(const Unit& u, size_t) const { return (size_t)u.row0 * a_pitch; }
    __device__ __forceinline__ size_t b_off(const Unit& u, size_t tstep) const { return (size_t)u.e * b_exp + (size_t)u.pn * tstep; }
    __device__ __forceinline__ void a_ready(const Unit&) const {}
    __device__ __forceinline__ void done(const Unit& u) const {
        asm volatile("s_waitcnt vmcnt(0)" ::: "memory");
        if ((threadIdx.x & 63) == 0) __hip_atomic_fetch_add(cnt + 16 * u.pm, 1u, __ATOMIC_RELAXED, __HIP_MEMORY_SCOPE_AGENT);
    }
};
struct GroupedOrderDep {
    const PG8_LAS int* te; const PG8_LAS int* tr0; const PG8_LAS int* tnr; int nunits, G, c; size_t b_exp; unsigned* cnt;
    __device__ __forceinline__ bool next(int i, Unit& u) const {
        const int L = i * G + (G - 1 - c); if (L >= nunits) return false;
        const int t = L >> 2; u.pm = t; u.pn = L & 3; u.e = __builtin_amdgcn_readfirstlane(te[t]); u.row0 = __builtin_amdgcn_readfirstlane(tr0[t]); u.nr = __builtin_amdgcn_readfirstlane(tnr[t]);
        u.rdy = __hip_atomic_load(cnt + 16 * t, __ATOMIC_RELAXED, __HIP_MEMORY_SCOPE_AGENT); return true;
    }
    __device__ __forceinline__ int tok(int i, int r) const { const int t = (i * G + (G - 1 - c)) >> 2; const int r0 = tr0[t], n = tnr[t]; return r0 + (r < n ? r : n - 1); }
    __device__ __forceinline__ size_t a_off(const Unit&, size_t) const { return 0; }
    __device__ __forceinline__ size_t b_off(const Unit& u, size_t tstep) const { return (size_t)u.e * b_exp + (size_t)u.pn * tstep; }
    __device__ __forceinline__ void a_ready(const Unit& u) const {
        if ((unsigned)__builtin_amdgcn_readfirstlane(u.rdy) < 32u) { unsigned spins = 0;
            while ((unsigned)__builtin_amdgcn_readfirstlane(__hip_atomic_load(cnt + 16 * u.pm, __ATOMIC_RELAXED, __HIP_MEMORY_SCOPE_AGENT)) < 32u && ++spins < (1u << 22)) __builtin_amdgcn_s_sleep(2); }
        asm volatile("" ::: "memory");
    }
    __device__ __forceinline__ void done(const Unit&) const {}
};
struct GroupedGatherOrder {
    const PG8_LAS int* te; const PG8_LAS int* tr0; const PG8_LAS int* tnr; const PG8_LAS int* rt; int nunits, G, c; size_t b_exp;
    __device__ __forceinline__ bool next(int i, Unit& u) const {
        const int L = i * G + c; if (L >= nunits) return false;
        const int t = L >> 2; u.pm = t; u.pn = L & 3; u.e = __builtin_amdgcn_readfirstlane(te[t]); u.row0 = __builtin_amdgcn_readfirstlane(tr0[t]); u.nr = __builtin_amdgcn_readfirstlane(tnr[t]); return true;
    }
    __device__ __forceinline__ int tok(int i, int r) const { return rt[i * 256 + r]; }
    __device__ __forceinline__ size_t a_off(const Unit&, size_t) const { return 0; }
    __device__ __forceinline__ size_t b_off(const Unit& u, size_t tstep) const { return (size_t)u.e * b_exp + (size_t)u.pn * tstep; }
    __device__ __forceinline__ void a_ready(const Unit&) const {}
    __device__ __forceinline__ void done(const Unit&) const {}
};
__device__ __forceinline__ float silu_fast(float x) { return x * __builtin_amdgcn_rcpf(1.f + __builtin_amdgcn_exp2f(-1.4426950408889634f * x)); }
struct EpiSwiGLU {
    static constexpr bool PERM = true, AFTER_DRAIN = false;
    bf16_t* H;
    __device__ __forceinline__ void operator()(const f32x4 (&acc)[2][2][4][2], const Unit& u, int wr, int wc, int fr, int fq) const {
        const int colh = u.pn * 128 + wc * 32 + 8 * fq;
#pragma unroll
        for (int ai = 0; ai < 2; ++ai)
#pragma unroll
            for (int m = 0; m < 4; ++m) { const int r = ai * HALF + wr * 64 + m * 16 + fr;
                if (r < u.nr) {
                    const f32x4 g0 = acc[ai][0][m][0], g1 = acc[ai][0][m][1], u0 = acc[ai][1][m][0], u1 = acc[ai][1][m][1];
                    u32x4 w; w.x = cvt_pk_bf16(silu_fast(g0[0]) * u0[0], silu_fast(g0[1]) * u0[1]); w.y = cvt_pk_bf16(silu_fast(g0[2]) * u0[2], silu_fast(g0[3]) * u0[3]);
                    w.z = cvt_pk_bf16(silu_fast(g1[0]) * u1[0], silu_fast(g1[1]) * u1[1]); w.w = cvt_pk_bf16(silu_fast(g1[2]) * u1[2], silu_fast(g1[3]) * u1[3]);
                    *(u32x4*)(H + (size_t)(u.row0 + r) * 512 + colh) = w; } }
    }
};
struct EpiBf16_I8 {
    static constexpr bool PERM = true, AFTER_DRAIN = false;
    bf16_t* O; int ldc; const float* sa; const float* sw; int nvalid;
    __device__ __forceinline__ void operator()(const f32x4 (&acc)[2][2][4][2], const Unit& u, int wr, int wc, int fr, int fq) const {
        const int row0 = u.pm * BM + wr * 64 + fr, col0 = u.pn * BM + wc * 32 + 8 * fq;
        f32x4 sv[2][2];
#pragma unroll
        for (int bj = 0; bj < 2; ++bj)
#pragma unroll
            for (int n = 0; n < 2; ++n) sv[bj][n] = *(const f32x4*)(sw + col0 + bj * HALF + 4 * n);
#pragma unroll
        for (int ai = 0; ai < 2; ++ai)
#pragma unroll
            for (int m = 0; m < 4; ++m) { const int r = row0 + ai * HALF + m * 16; const float a = sa[r]; bf16_t* rowp = O + (size_t)r * ldc + col0;
#pragma unroll
                for (int bj = 0; bj < 2; ++bj) { f32x4 v0, v1;
#pragma unroll
                    for (int j = 0; j < 4; ++j) { v0[j] = (float)__float_as_int(acc[ai][bj][m][0][j]) * (a * sv[bj][0][j]); v1[j] = (float)__float_as_int(acc[ai][bj][m][1][j]) * (a * sv[bj][1][j]); }
                    u32x4 w; w.x = cvt_pk_bf16(v0[0], v0[1]); w.y = cvt_pk_bf16(v0[2], v0[3]); w.z = cvt_pk_bf16(v1[0], v1[1]); w.w = cvt_pk_bf16(v1[2], v1[3]);
                    if (col0 + bj * HALF < nvalid) *(u32x4*)(rowp + bj * HALF) = w; } }
    }
};
template <bool WT = false> struct EpiSwiGLU_I8 {
    static constexpr bool PERM = true, AFTER_DRAIN = false;
    bf16_t* H; const float* sa; const float* sw;
    __device__ __forceinline__ void operator()(const f32x4 (&acc)[2][2][4][2], const Unit& u, int wr, int wc, int fr, int fq) const {
        const int colh = u.pn * 128 + wc * 32 + 8 * fq;
        const float* swp = sw + (size_t)u.e * 1024 + u.pn * 256 + wc * 32 + 8 * fq;
        const f32x4 sg0 = *(const f32x4*)swp, sg1 = *(const f32x4*)(swp + 4), su0 = *(const f32x4*)(swp + 128), su1 = *(const f32x4*)(swp + 132);
#pragma unroll
        for (int ai = 0; ai < 2; ++ai)
#pragma unroll
            for (int m = 0; m < 4; ++m) { const int r = ai * HALF + wr * 64 + m * 16 + fr;
                if (r < u.nr) { const float a = sa[u.row0 + r];
                    f32x4 g0, g1, u0, u1;
#pragma unroll
                    for (int j = 0; j < 4; ++j) { g0[j] = (float)__float_as_int(acc[ai][0][m][0][j]) * (a * sg0[j]); g1[j] = (float)__float_as_int(acc[ai][0][m][1][j]) * (a * sg1[j]);
                                                  u0[j] = (float)__float_as_int(acc[ai][1][m][0][j]) * (a * su0[j]); u1[j] = (float)__float_as_int(acc[ai][1][m][1][j]) * (a * su1[j]); }
                    u32x4 w; w.x = cvt_pk_bf16(silu_fast(g0[0]) * u0[0], silu_fast(g0[1]) * u0[1]); w.y = cvt_pk_bf16(silu_fast(g0[2]) * u0[2], silu_fast(g0[3]) * u0[3]);
                    w.z = cvt_pk_bf16(silu_fast(g1[0]) * u1[0], silu_fast(g1[1]) * u1[1]); w.w = cvt_pk_bf16(silu_fast(g1[2]) * u1[2], silu_fast(g1[3]) * u1[3]);
                    if (WT) asm volatile("global_store_dwordx4 %0, %1, off sc1" :: "v"(H + (size_t)(u.row0 + r) * 512 + colh), "v"(w) : "memory");
                    else *(u32x4*)(H + (size_t)(u.row0 + r) * 512 + colh) = w; } }
    }
};
struct EpiYs {
    static constexpr bool PERM = true, AFTER_DRAIN = false;
    bf16_t* Y; const float* gate;
    __device__ __forceinline__ void operator()(const f32x4 (&acc)[2][2][4][2], const Unit& u, int wr, int wc, int fr, int fq) const {
        const int col0 = u.pn * BM + wc * 32 + 8 * fq;
#pragma unroll
        for (int ai = 0; ai < 2; ++ai)
#pragma unroll
            for (int m = 0; m < 4; ++m) { const int r = ai * HALF + wr * 64 + m * 16 + fr;
                if (r < u.nr) { const float g = gate[u.row0 + r];
#pragma unroll
                    for (int bj = 0; bj < 2; ++bj) { const f32x4 v0 = acc[ai][bj][m][0] * g, v1 = acc[ai][bj][m][1] * g;
                        u32x4 w; w.x = cvt_pk_bf16(v0[0], v0[1]); w.y = cvt_pk_bf16(v0[2], v0[3]); w.z = cvt_pk_bf16(v1[0], v1[1]); w.w = cvt_pk_bf16(v1[2], v1[3]);
                        *(u32x4*)(Y + (size_t)(u.row0 + r) * 1024 + col0 + bj * HALF) = w; } } }
    }
};
struct EpiYs8 {
    static constexpr bool PERM = true, AFTER_DRAIN = false;
    unsigned char* Y; float* SC; const float* gate;
    __device__ __forceinline__ void operator()(const f32x4 (&acc)[2][2][4][2], const Unit& u, int wr, int wc, int fr, int fq) const {
        const int col0 = u.pn * BM + wc * 32 + 8 * fq;
#pragma unroll
        for (int ai = 0; ai < 2; ++ai)
#pragma unroll
            for (int m = 0; m < 4; ++m) { const int r = ai * HALF + wr * 64 + m * 16 + fr; const bool ok = r < u.nr;
                const float g = ok ? gate[u.row0 + r] : 0.f;
                f32x4 v[2][2]; float mx = 0.f;
#pragma unroll
                for (int bj = 0; bj < 2; ++bj)
#pragma unroll
                    for (int n = 0; n < 2; ++n) { v[bj][n] = acc[ai][bj][m][n] * g;
#pragma unroll
                        for (int j = 0; j < 4; ++j) mx = fmaxf(mx, fabsf(v[bj][n][j])); }
                mx = fmaxf(mx, __shfl_xor(mx, 16)); mx = fmaxf(mx, __shfl_xor(mx, 32));
                const float inv = mx > 0.f ? 127.f * __builtin_amdgcn_rcpf(mx) : 0.f;
                unsigned w[2][2];
#pragma unroll
                for (int bj = 0; bj < 2; ++bj)
#pragma unroll
                    for (int n = 0; n < 2; ++n) { const f32x4 f = v[bj][n] * inv + 128.5f;
                        w[bj][n] = (unsigned)f[0] | ((unsigned)f[1] << 8) | ((unsigned)f[2] << 16) | ((unsigned)f[3] << 24); }
                const bool odd = fq & 1;
                const unsigned s0 = odd ? w[0][0] : w[1][0], s1 = odd ? w[0][1] : w[1][1];
                const unsigned g0 = (unsigned)__shfl_xor((int)s0, 16), g1 = (unsigned)__shfl_xor((int)s1, 16);
                if (ok) {
                    const u32x4 o = odd ? (u32x4){g0, g1, w[1][0], w[1][1]} : (u32x4){w[0][0], w[0][1], g0, g1};
                    *(u32x4*)(Y + (size_t)(u.row0 + r) * 1024 + (col0 & ~15) + (odd ? HALF : 0)) = o;
                    if (fq == 0) SC[(size_t)(u.row0 + r) * 16 + wc * 4 + u.pn] = mx * (1.f / 127.f); } }
    }
};
template <class Epi, class Sched, bool ALIGN_EPI = false, bool SP2 = false, bool GATHER = false, bool I8 = false>
__device__ __forceinline__ void gemm_phase(PG8_LAS unsigned char* lds, const Gemm g, const Sched& S, const Epi& E) {
    const int tid = threadIdx.x, wid = __builtin_amdgcn_readfirstlane(tid >> 6), lane = tid & 63, wr = wid >> 2, wc = wid & 3, fr = lane & 15, fq = lane >> 4;
    const int K = g.K, KB = I8 ? K : 2 * K  , nt = KB / (BK * 2);
    unsigned voffA[2], voffB[2];
#pragma unroll
    for (int i = 0; i < 2; ++i) { int R, C; stage_rc(tid * 16 + i * 8192, R, C); const int Rb = Epi::PERM ? ((R & ~31) + perm32(R & 31)) : R;
        voffA[i] = (unsigned)(R * KB + C * 2); voffB[i] = (unsigned)(Rb * KB + C * 2); }
    unsigned cv0[2] = {0u, 0u}, cv1[2] = {0u, 0u}, nv0[2] = {0u, 0u}, nv1[2] = {0u, 0u};
    int gR[2], gC[2];
#pragma unroll
    for (int i = 0; i < 2; ++i) stage_rc(tid * 16 + i * 8192, gR[i], gC[i]);
#define PG8_GOFF(dst0, dst1, ui_) do { _Pragma("unroll") for (int _i = 0; _i < 2; ++_i) { \
        dst0[_i] = (unsigned)S.tok((ui_), gR[_i]) * (unsigned)KB + (unsigned)gC[_i] * 2u; dst1[_i] = (unsigned)S.tok((ui_), HALF + gR[_i]) * (unsigned)KB + (unsigned)gC[_i] * 2u; } } while (0)
    const size_t kstep = (size_t)(BK * 2);
    const size_t hstep = (size_t)HALF * KB;
    const size_t tstep = 2 * hstep;
    const unsigned ldsw = (unsigned)wid * 1024u;
    const int aoff = lds_byte(wr * 64 + fr, fq * 8), boff = lds_byte(wc * 32 + fr, fq * 8), aoff1 = lds_byte(wr * 64 + fr, 32 + fq * 8), boff1 = lds_byte(wc * 32 + fr, 32 + fq * 8);
#define PG8_SA(b, h) (((b) * 2 + (h)) * HTB)
#define PG8_SB(b, h) ((4 + (b) * 2 + (h)) * HTB)
#define PG8_STAGE(bufoff, gbase, voff) do { _Pragma("unroll") for (int _i = 0; _i < 2; ++_i) \
        __builtin_amdgcn_global_load_lds((const unsigned*)((const char*)(gbase) + (voff)[_i]), (PG8_LAS unsigned*)(lds + (bufoff) + ldsw + _i * 8192), 16, 0, 0); } while (0)
#define PG8_GLDS1(gp, ldsoff) __builtin_amdgcn_global_load_lds((const unsigned*)(gp), (PG8_LAS unsigned*)(lds + (ldsoff)), 16, 0, 0)
#define PG8_STAGEA(bufoff, kptr, half, nx) do { if constexpr (GATHER) { \
        const unsigned _v0 = (half) ? ((nx) ? nv1[0] : cv1[0]) : ((nx) ? nv0[0] : cv0[0]), _v1 = (half) ? ((nx) ? nv1[1] : cv1[1]) : ((nx) ? nv0[1] : cv0[1]); \
        PG8_GLDS1((const char*)(kptr) + _v0, (bufoff) + ldsw); PG8_GLDS1((const char*)(kptr) + _v1, (bufoff) + ldsw + 8192); \
    } else { PG8_STAGE(bufoff, (kptr) + ((half) ? hstep : (size_t)0), voffA); } } while (0)
#define PG8_LDA(dst, b, h) do { _Pragma("unroll") for (int m = 0; m < 4; ++m) _Pragma("unroll") for (int k = 0; k < 2; ++k) dst[m][k] = *(const PG8_LAS bf16x8*)(lds + PG8_SA(b, h) + (k ? aoff1 : aoff) + m * 2048); } while (0)
#define PG8_LDB(dst, b, h) do { _Pragma("unroll") for (int n = 0; n < 2; ++n) _Pragma("unroll") for (int k = 0; k < 2; ++k) dst[n][k] = *(const PG8_LAS bf16x8*)(lds + PG8_SB(b, h) + (k ? boff1 : boff) + n * 2048); } while (0)
#define PG8_MMA(ai, bj, At, Bt) do { __builtin_amdgcn_s_setprio(1); _Pragma("unroll") for (int m = 0; m < 4; ++m) _Pragma("unroll") for (int n = 0; n < 2; ++n) _Pragma("unroll") for (int k = 0; k < 2; ++k) { \
        if constexpr (I8) acc[ai][bj][m][n] = __builtin_bit_cast(f32x4, __builtin_amdgcn_mfma_i32_16x16x64_i8(__builtin_bit_cast(i32x4, Bt[n][k]), __builtin_bit_cast(i32x4, At[m][k]), __builtin_bit_cast(i32x4, acc[ai][bj][m][n]), 0, 0, 0)); \
        else acc[ai][bj][m][n] = __builtin_amdgcn_mfma_f32_16x16x32_bf16(Bt[n][k], At[m][k], acc[ai][bj][m][n], 0, 0, 0); } __builtin_amdgcn_s_setprio(0); } while (0)
#define PG8_WAIT_V(n) asm volatile("s_waitcnt vmcnt(" #n ")" ::: "memory")
#define PG8_WAIT_L(n) asm volatile("s_waitcnt lgkmcnt(" #n ")" ::: "memory")
#define PG8_BAR __builtin_amdgcn_s_barrier()
#define PG8_SCHED __builtin_amdgcn_sched_barrier(0)
    Unit cur, nxt; int ui = 0;
    if (!S.next(0, cur)) return;
    if constexpr (GATHER) { PG8_GOFF(cv0, cv1, 0); }
    f32x4 acc[2][2][4][2];
#pragma unroll
    for (int a = 0; a < 2; ++a)
#pragma unroll
        for (int b = 0; b < 2; ++b)
#pragma unroll
            for (int m = 0; m < 4; ++m)
#pragma unroll
                for (int n = 0; n < 2; ++n) acc[a][b][m][n] = (f32x4){0.f, 0.f, 0.f, 0.f};
    bf16x8 At[4][2], B0[2][2], B1[2][2];
    const char* cA = (const char*)g.A + S.a_off(cur, tstep); const char* cB = (const char*)g.Bt + S.b_off(cur, tstep);
    S.a_ready(cur);
    if constexpr (SP2) {
        PG8_STAGE(PG8_SB(0, 0), cB, voffB); PG8_STAGE(PG8_SB(0, 1), cB + hstep, voffB); PG8_STAGEA(PG8_SA(0, 0), cA, 0, false); PG8_STAGEA(PG8_SA(0, 1), cA, 1, false);
        if (wr == 1) PG8_BAR;
        PG8_WAIT_V(2); PG8_BAR;
        PG8_STAGE(PG8_SB(1, 0), cB + kstep, voffB); PG8_STAGEA(PG8_SA(1, 0), cA + kstep, 0, false); PG8_STAGE(PG8_SB(1, 1), cB + hstep + kstep, voffB);
        PG8_WAIT_V(6); PG8_BAR;
    } else {
        PG8_STAGE(PG8_SB(0, 0), cB, voffB); PG8_STAGEA(PG8_SA(0, 0), cA, 0, false); PG8_STAGE(PG8_SB(0, 1), cB + hstep, voffB); PG8_STAGEA(PG8_SA(0, 1), cA, 1, false);
        if (wr == 1) PG8_BAR;
        PG8_WAIT_V(4); PG8_BAR;
        PG8_STAGE(PG8_SB(1, 0), cB + kstep, voffB); PG8_STAGEA(PG8_SA(1, 0), cA + kstep, 0, false); PG8_STAGE(PG8_SB(1, 1), cB + hstep + kstep, voffB);
        PG8_WAIT_V(6); PG8_BAR;
    }
    for (;;) {
        const bool has_next = S.next(ui + 1, nxt);
        if constexpr (GATHER) { if (has_next) { PG8_GOFF(nv0, nv1, ui + 1); } else { nv0[0] = cv0[0]; nv0[1] = cv0[1]; nv1[0] = cv1[0]; nv1[1] = cv1[1]; } }
        const char* nA = has_next ? (const char*)g.A + S.a_off(nxt, tstep) : cA; const char* nB = has_next ? (const char*)g.Bt + S.b_off(nxt, tstep) : cB;
        for (int t = 0; t < nt; t += 2) {
            const bool last = (t == nt - 2);
            const char* a1 = cA + (size_t)(t + 1) * kstep;
            const char* a2 = last ? nA : cA + (size_t)(t + 2) * kstep; const char* b2 = last ? nB : cB + (size_t)(t + 2) * kstep;
            const char* a3 = a2 + kstep; const char* b3 = b2 + kstep;
            if (last && has_next) S.a_ready(nxt);
            if constexpr (SP2) {
            PG8_LDB(B0, 0, 0); PG8_LDB(B1, 0, 1); PG8_SCHED; PG8_LDA(At, 0, 0); PG8_STAGEA(PG8_SA(1, 1), a1, 1, false);
            PG8_WAIT_V(8); PG8_WAIT_L(0); PG8_BAR; PG8_MMA(0, 0, At, B0); PG8_MMA(0, 1, At, B1); PG8_BAR; PG8_SCHED;
            PG8_LDA(At, 0, 1); PG8_STAGE(PG8_SB(0, 0), b2, voffB); PG8_STAGE(PG8_SB(0, 1), b2 + hstep, voffB); PG8_STAGEA(PG8_SA(0, 0), a2, 0, last);
            PG8_WAIT_V(8); PG8_WAIT_L(0); PG8_BAR; PG8_MMA(1, 0, At, B0); PG8_MMA(1, 1, At, B1); PG8_BAR; PG8_SCHED;
            PG8_LDB(B0, 1, 0); PG8_LDB(B1, 1, 1); PG8_SCHED; PG8_LDA(At, 1, 0); PG8_STAGEA(PG8_SA(0, 1), a2, 1, last);
            PG8_WAIT_V(8); PG8_WAIT_L(0); PG8_BAR; PG8_MMA(0, 0, At, B0); PG8_MMA(0, 1, At, B1); PG8_BAR; PG8_SCHED;
            PG8_LDA(At, 1, 1); PG8_STAGE(PG8_SB(1, 0), b3, voffB); PG8_STAGE(PG8_SB(1, 1), b3 + hstep, voffB); PG8_STAGEA(PG8_SA(1, 0), a3, 0, last);
            PG8_WAIT_V(8); PG8_WAIT_L(0); PG8_BAR; PG8_MMA(1, 0, At, B0); PG8_MMA(1, 1, At, B1); PG8_BAR; PG8_SCHED;
            } else {
            PG8_LDB(B0, 0, 0); PG8_SCHED; PG8_LDA(At, 0, 0); PG8_STAGEA(PG8_SA(1, 1), a1, 1, false);
            PG8_WAIT_L(8); PG8_BAR; PG8_WAIT_L(0); PG8_MMA(0, 0, At, B0); PG8_BAR; PG8_SCHED;
            PG8_LDB(B1, 0, 1); PG8_STAGE(PG8_SB(0, 0), b2, voffB);
            PG8_BAR; PG8_WAIT_L(0); PG8_MMA(0, 1, At, B1); PG8_BAR;
            PG8_LDA(At, 0, 1); PG8_STAGEA(PG8_SA(0, 0), a2, 0, last);
            PG8_BAR; PG8_WAIT_L(0); PG8_MMA(1, 0, At, B0); PG8_BAR; PG8_SCHED;
            PG8_STAGE(PG8_SB(0, 1), b2 + hstep, voffB);
            PG8_WAIT_V(6); PG8_BAR; PG8_MMA(1, 1, At, B1); PG8_BAR;
            PG8_LDB(B0, 1, 0); PG8_SCHED; PG8_LDA(At, 1, 0); PG8_STAGEA(PG8_SA(0, 1), a2, 1, last);
            PG8_WAIT_L(8); PG8_BAR; PG8_WAIT_L(0); PG8_MMA(0, 0, At, B0); PG8_BAR; PG8_SCHED;
            PG8_LDB(B1, 1, 1); PG8_STAGE(PG8_SB(1, 0), b3, voffB);
            PG8_BAR; PG8_WAIT_L(0); PG8_MMA(0, 1, At, B1); PG8_BAR;
            PG8_LDA(At, 1, 1); PG8_STAGEA(PG8_SA(1, 0), a3, 0, last);
            PG8_BAR; PG8_WAIT_L(0); PG8_MMA(1, 0, At, B0); PG8_BAR; PG8_SCHED;
            PG8_STAGE(PG8_SB(1, 1), b3 + hstep, voffB);
            PG8_WAIT_V(6); PG8_BAR; PG8_MMA(1, 1, At, B1); PG8_BAR;
            }
        }
        if constexpr (ALIGN_EPI) { if (wr == 0) PG8_BAR; }
        if constexpr (!Epi::AFTER_DRAIN) { E(acc, cur, wr, wc, fr, fq); S.done(cur); }
        if (!has_next) break;
#pragma unroll
        for (int a = 0; a < 2; ++a)
#pragma unroll
            for (int b = 0; b < 2; ++b)
#pragma unroll
                for (int m = 0; m < 4; ++m)
#pragma unroll
                    for (int n = 0; n < 2; ++n) acc[a][b][m][n] = (f32x4){0.f, 0.f, 0.f, 0.f};
        cur = nxt; cA = nA; cB = nB; ++ui;
        if constexpr (GATHER) { cv0[0] = nv0[0]; cv0[1] = nv0[1]; cv1[0] = nv1[0]; cv1[1] = nv1[1]; }
        if constexpr (ALIGN_EPI) { if (wr == 1) PG8_BAR; }
    }
    PG8_WAIT_V(0);
    if constexpr (!ALIGN_EPI) { if (wr == 0) PG8_BAR; }
    PG8_BAR;
    if constexpr (Epi::AFTER_DRAIN) { E.fused(acc, cur, wr, wc, fr, fq, lds, wid, lane); S.done(cur); }
#undef PG8_SA
#undef PG8_SB
#undef PG8_STAGE
#undef PG8_STAGEA
#undef PG8_GLDS1
#undef PG8_GOFF
#undef PG8_LDA
#undef PG8_LDB
#undef PG8_MMA
#undef PG8_WAIT_V
#undef PG8_WAIT_L
#undef PG8_BAR
#undef PG8_SCHED
}
}
#define GAS __attribute__((address_space(1)))
#define LAS __attribute__((address_space(3)))
typedef unsigned short bf16;
typedef unsigned v4u __attribute__((ext_vector_type(4)));
typedef float f32x4 __attribute__((ext_vector_type(4)));
typedef short bf16x8 __attribute__((ext_vector_type(8)));
typedef GAS unsigned gu32;
typedef GAS unsigned long long gu64;
#define RLX_AGENT __ATOMIC_RELAXED, __HIP_MEMORY_SCOPE_AGENT
#define LDS_WAIT() asm volatile("s_waitcnt lgkmcnt(0)" ::: "memory")
#define VM_WAIT() asm volatile("s_waitcnt vmcnt(0)" ::: "memory")
__device__ __forceinline__ unsigned long long rt() { return __builtin_amdgcn_s_memrealtime(); }
__device__ __forceinline__ unsigned f2bfu(float f) { unsigned u = __builtin_bit_cast(unsigned, f); return (u + 0x7fffu + ((u >> 16) & 1u)) >> 16; }
__device__ __forceinline__ unsigned pk2(float lo, float hi) { return f2bfu(lo) | (f2bfu(hi) << 16); }

#define XB_TMO      128
#define XB_XCNT(j)  (256  + 64 * (j))
#define XB_XSUB(j)  (1280 + 64 * (j))
#define XB_XGEN(j)  (2304 + 64 * (j))
#define XB_TOP      3328
#define XB_TOPGEN   3392
#define XCD_BAR_WORDS 3456
#define XB_SPIN_CAP (1u << 18)

__device__ __forceinline__ unsigned xb_ld(unsigned* p)              { return __hip_atomic_load(p, __ATOMIC_RELAXED, __HIP_MEMORY_SCOPE_AGENT); }
__device__ __forceinline__ unsigned xb_add(unsigned* p, unsigned v) { return __hip_atomic_fetch_add(p, v, __ATOMIC_RELAXED, __HIP_MEMORY_SCOPE_AGENT); }
__device__ __forceinline__ unsigned xb_xcc_id() { return (unsigned)__builtin_amdgcn_s_getreg((3 << 11) | 20) & 0xFu; }
#define XB_SPIN(cond, bar) do { unsigned _sp = 0; while (cond) { __builtin_amdgcn_s_sleep(1); \
    if ((++_sp & 255u) == 0u) { if (xb_ld(&(bar)[XB_TMO])) break; if (_sp > XB_SPIN_CAP) { atomicAdd(&(bar)[XB_TMO], 1u); break; } } } } while (0)

struct XcdBarrier {
    unsigned* bar; unsigned x;
    volatile LAS unsigned* st;
};

__device__ __forceinline__ XcdBarrier xcd_barrier_post(unsigned* bar, volatile LAS unsigned* st) {
    XcdBarrier b; b.bar = bar; b.x = xb_xcc_id(); b.st = st;
    if (threadIdx.x == 0) (void)xb_add(&bar[XB_XCNT(b.x)], 1u);
    return b;
}
__device__ __forceinline__ void xcd_barrier_complete(unsigned* bar, unsigned x, unsigned& nloc, unsigned& nx) {
    const unsigned G = gridDim.x * gridDim.y * gridDim.z;
    unsigned sum, cnt, mine, sp = 0u;
    for (;;) {
        sum = 0u; cnt = 0u; mine = 0u;
#pragma unroll
        for (unsigned j = 0; j < 16; ++j) { const unsigned c = xb_ld(&bar[XB_XCNT(j)]); sum += c; cnt += (c > 0u) ? 1u : 0u; mine = (j == x) ? c : mine; }
        if (sum == G) break;
        __builtin_amdgcn_s_sleep(1);
        if ((++sp & 255u) == 0u) { if (xb_ld(&bar[XB_TMO])) break; if (sp > XB_SPIN_CAP) { atomicAdd(&bar[XB_TMO], 1u); break; } }
    }
    nloc = mine > 0u ? mine : 1u; nx = cnt > 0u ? cnt : 1u;
}

__device__ __forceinline__ void xcd_barrier(const XcdBarrier& b) {
    asm volatile("s_waitcnt vmcnt(0)" ::: "memory");
    __syncthreads();
    if (threadIdx.x == 0) {
        unsigned* bar = b.bar;
        __builtin_amdgcn_s_waitcnt(0);
        unsigned nloc = b.st[0], nx = b.st[1];
        if (nloc == 0u) { xcd_barrier_complete(bar, b.x, nloc, nx); b.st[0] = nloc; b.st[1] = nx; }
        const unsigned old = xb_add(&bar[XB_XSUB(b.x)], 1u);
        const unsigned gen = old / nloc;
        if (old + 1u == (gen + 1u) * nloc) {
            __builtin_amdgcn_fence(__ATOMIC_RELEASE, "agent");
            asm volatile("s_waitcnt vmcnt(0)" ::: "memory");
            const unsigned og = xb_add(&bar[XB_TOP], 1u);
            const unsigned tg = og / nx;
            if (og + 1u == (tg + 1u) * nx) xb_add(&bar[XB_TOPGEN], 1u);
            else XB_SPIN(xb_ld(&bar[XB_TOPGEN]) == tg, bar);
            __builtin_amdgcn_fence(__ATOMIC_ACQUIRE, "agent");
            xb_add(&bar[XB_XGEN(b.x)], 1u);
            asm volatile("s_waitcnt vmcnt(0)" ::: "memory");
        } else {
            XB_SPIN(xb_ld(&bar[XB_XGEN(b.x)]) == gen, bar);
            __builtin_amdgcn_fence(__ATOMIC_ACQUIRE, "agent");
            asm volatile("s_waitcnt vmcnt(0)" ::: "memory");
        }
    }
    __syncthreads();
}

template <bool DUAL, class FA, class FB, class FB2, class FE>
__device__ __forceinline__ void naive_tile_h(float* sm, int t256, int K, FA fa, FB fb, FB2 fb2, FE fe) {
    float* As = sm; float* Bs = sm + 1088; float* Bs2 = sm + 2176;
    const int tx = t256 & 15, ty = t256 >> 4;
    float acc[4][4], acc2[4][4];
#pragma unroll
    for (int i = 0; i < 4; ++i)
#pragma unroll
        for (int j = 0; j < 4; ++j) { acc[i][j] = 0.f; acc2[i][j] = 0.f; }
    for (int k0 = 0; k0 < K; k0 += 16) {
        { const int r = t256 >> 2, kk = (t256 & 3) * 4; const float4 a = fa(r, k0 + kk); As[kk * 68 + r] = a.x; As[(kk + 1) * 68 + r] = a.y; As[(kk + 2) * 68 + r] = a.z; As[(kk + 3) * 68 + r] = a.w; }
        { const int kk = t256 >> 4, c = (t256 & 15) * 4; *(float4*)&Bs[kk * 68 + c] = fb(k0 + kk, c); if (DUAL) *(float4*)&Bs2[kk * 68 + c] = fb2(k0 + kk, c); }
        __syncthreads();
#pragma unroll
        for (int kk = 0; kk < 16; ++kk) {
            const float4 a = *(const float4*)&As[kk * 68 + ty * 4]; const float4 b = *(const float4*)&Bs[kk * 68 + tx * 4];
            const float av[4] = {a.x, a.y, a.z, a.w}; const float bv[4] = {b.x, b.y, b.z, b.w};
#pragma unroll
            for (int i = 0; i < 4; ++i)
#pragma unroll
                for (int j = 0; j < 4; ++j) acc[i][j] += av[i] * bv[j];
            if (DUAL) {
                const float4 b2 = *(const float4*)&Bs2[kk * 68 + tx * 4]; const float bw[4] = {b2.x, b2.y, b2.z, b2.w};
#pragma unroll
                for (int i = 0; i < 4; ++i)
#pragma unroll
                    for (int j = 0; j < 4; ++j) acc2[i][j] += av[i] * bw[j];
            }
        }
        __syncthreads();
    }
#pragma unroll
    for (int i = 0; i < 4; ++i) fe(ty * 4 + i, tx * 4, make_float4(acc[i][0], acc[i][1], acc[i][2], acc[i][3]), make_float4(acc2[i][0], acc2[i][1], acc2[i][2], acc2[i][3]));
}

__device__ __forceinline__ void ph_la(int gtid, int nthr, const bf16_t* PROJ, const float* upf, const float* bf, const float* upb, const float* bb, float* LAF, float* LAB) {
    for (int i = gtid; i < NTOK * 256 * 2; i += nthr) {
        const int c = i & 255, t = (i >> 8) & (NTOK - 1), dir = i >> 23;
        const bf16_t* z = PROJ + (size_t)t * PW + (dir ? C_ZB : C_ZF);
        const float* up = dir ? upb : upf; const float* bias = dir ? bb : bf;
        float pre = bias[c];
#pragma unroll
        for (int r = 0; r < 16; ++r) pre += bf2f(z[r]) * up[r * 256 + c];
        const float ls = fminf(pre, 0.f) - log1pf(expf(-fabsf(pre)));
        (dir ? LAB : LAF)[(size_t)t * 256 + c] = ls * (1.f / 16.f);
    }
}
__device__ __forceinline__ void ph_gla_scan(int bid, int tid, const bf16_t* PROJ, const float* LAF, const float* LAB, float* OF, float* OB) {
    const int es = bid & 3, dir = (bid >> 2) & 1, h = (bid >> 3) & 3, b = bid >> 5;
    const int dg = tid & 15, el = tid >> 4, e = es * 32 + el;
    const float* LA = dir ? LAB : LAF; float* O = dir ? OB : OF;
    float S0 = 0.f, S1 = 0.f, S2 = 0.f, S3 = 0.f;
#pragma unroll 4
    for (int step = 0; step < T; ++step) {
        const int t = dir ? (T - 1 - step) : step;
        const size_t row = (size_t)b * T + t;
        const bf16_t* pr = PROJ + row * PW;
        const float4 la = *(const float4*)(LA + row * 256 + h * 64 + dg * 4);
        const float4 q = ld_bf4(pr + C_GQ + h * 64 + dg * 4);
        const float4 k = ld_bf4(pr + C_GK + h * 64 + dg * 4);
        const float v = bf2f(pr[C_GV + h * 128 + e]);
        S0 = expf(la.x) * S0 + k.x * v; S1 = expf(la.y) * S1 + k.y * v; S2 = expf(la.z) * S2 + k.z * v; S3 = expf(la.w) * S3 + k.w * v;
        float part = (q.x * S0 + q.y * S1 + q.z * S2 + q.w * S3) * 0.125f;
        part += __shfl_xor(part, 1); part += __shfl_xor(part, 2); part += __shfl_xor(part, 4); part += __shfl_xor(part, 8);
        if (dg == 0) O[row * 512 + h * 128 + e] = part;
    }
}
__device__ __forceinline__ void ph_gla_combine(int gw, int NGW, int lane, const float* OF, const float* OB, const bf16_t* PROJ, const float* gain, bf16_t* MIXED) {
    for (int w = gw; w < NTOK * 4; w += NGW) {
        const int t = w >> 2, h = w & 3;
        const size_t o = (size_t)t * 512 + h * 128 + lane * 2;
        const float2 a = *(const float2*)(OF + o), bq = *(const float2*)(OB + o);
        const float v0 = a.x + bq.x, v1 = a.y + bq.y;
        const float ss = wave_sum(v0 * v0 + v1 * v1);
        const float rstd = rsqrtf(ss * (1.f / 128.f) + EPS);
        const bf16_t* g = PROJ + (size_t)t * PW + C_GG + h * 128 + lane * 2;
        const float g0 = bf2f(g[0]), g1 = bf2f(g[1]);
        bf16_t* m = MIXED + (size_t)t * D + h * 128 + lane * 2;
        m[0] = f2bf(v0 * rstd * gain[lane * 2] * silu_f(g0)); m[1] = f2bf(v1 * rstd * gain[lane * 2 + 1] * silu_f(g1));
    }
}
__device__ __forceinline__ void ph_qk_prep(int gw, int NGW, int lane, bf16_t* PROJ, const float* qg, const float* kg, const float* rope, bf16_t* OUT, int opitch) {
    const float gq = qg[lane], gk = kg[lane];
    const int pi = lane >> 1, j = pi & 15;
    for (int t = gw; t < NTOK; t += NGW) {
        bf16_t* p = PROJ + (size_t)t * PW + C_AQ + lane;
        float v[10];
#pragma unroll
        for (int hs = 8; hs < 10; ++hs) v[hs] = bf2f(p[hs * 64]);
        const int tt = t & (T - 1), pos = pi < 16 ? (tt >> 6) : (tt & 63);
        const float c = rope[pos * 16 + j], s = rope[1024 + pos * 16 + j];
#pragma unroll
        for (int hs = 8; hs < 10; ++hs) {
            const float ss = wave_sum(v[hs] * v[hs]);
            const float y = v[hs] * rsqrtf(ss * (1.f / 64.f) + EPS) * (hs < 8 ? gq : gk);
            const float partner = __shfl_xor(y, 1);
            float o = (lane & 1) ? (partner * s + y * c) : (y * c - partner * s);
            if (hs < 8) o *= 0.125f * 1.4426950408889634f;
            OUT[(size_t)t * opitch + lane + hs * 64] = f2bf(o);
        }
    }
}
__device__ __forceinline__ void ph_attn_vb(float* sm, int t256, int vb, const bf16_t* PROJ, float* ATT) {
    float* Qt = sm; float* KV = sm + 4352; float* St = sm + 8704; float* al = sm + 13056;
    const int tx = t256 & 15, ty = t256 >> 4;
    const int q0 = (vb & 63) * 64, hq = (vb >> 6) & 7, b = vb >> 9, kvh = hq >> 2;
    const size_t rowb = (size_t)b * T;
    { const int r = t256 >> 2, d0 = (t256 & 3) * 16; const bf16_t* p = PROJ + (rowb + q0 + r) * PW + C_AQ + hq * 64 + d0;
#pragma unroll
      for (int i = 0; i < 16; ++i) Qt[(d0 + i) * 68 + r] = bf2f(p[i]); }
    float O[4][4];
#pragma unroll
    for (int i = 0; i < 4; ++i)
#pragma unroll
        for (int j = 0; j < 4; ++j) O[i][j] = 0.f;
    float m_run = -INFINITY, l_run = 0.f;
    for (int k0 = 0; k0 < T; k0 += 64) {
        { const int c = t256 >> 2, d0 = (t256 & 3) * 16; const bf16_t* p = PROJ + (rowb + k0 + c) * PW + C_AK + kvh * 64 + d0;
#pragma unroll
          for (int i = 0; i < 16; ++i) KV[(d0 + i) * 68 + c] = bf2f(p[i]); }
        __syncthreads();
        float s[4][4];
#pragma unroll
        for (int i = 0; i < 4; ++i)
#pragma unroll
            for (int j = 0; j < 4; ++j) s[i][j] = 0.f;
#pragma unroll 8
        for (int d = 0; d < 64; ++d) {
            const float4 a = *(const float4*)&Qt[d * 68 + ty * 4]; const float4 bq = *(const float4*)&KV[d * 68 + tx * 4];
            const float av[4] = {a.x, a.y, a.z, a.w}; const float bv[4] = {bq.x, bq.y, bq.z, bq.w};
#pragma unroll
            for (int i = 0; i < 4; ++i)
#pragma unroll
                for (int j = 0; j < 4; ++j) s[i][j] += av[i] * bv[j];
        }
#pragma unroll
        for (int i = 0; i < 4; ++i)
#pragma unroll
            for (int j = 0; j < 4; ++j) St[(tx * 4 + j) * 68 + ty * 4 + i] = s[i][j];
        __syncthreads();
        { const int c = t256 >> 2, e0 = (t256 & 3) * 16; const bf16_t* p = PROJ + (rowb + k0 + c) * PW + C_AV + kvh * 64 + e0;
#pragma unroll
          for (int i = 0; i < 16; ++i) KV[c * 68 + e0 + i] = bf2f(p[i]); }
        if (t256 < 64) {
            float mx = -INFINITY;
            for (int c = 0; c < 64; ++c) mx = fmaxf(mx, St[c * 68 + t256]);
            const float mn = fmaxf(m_run, mx);
            const float alpha = expf(m_run - mn);
            float sum = 0.f;
            for (int c = 0; c < 64; ++c) { const float p = expf(St[c * 68 + t256] - mn); St[c * 68 + t256] = p; sum += p; }
            l_run = l_run * alpha + sum; m_run = mn; al[t256] = alpha;
        }
        __syncthreads();
#pragma unroll
        for (int i = 0; i < 4; ++i) { const float a = al[ty * 4 + i];
#pragma unroll
            for (int j = 0; j < 4; ++j) O[i][j] *= a; }
#pragma unroll 8
        for (int c = 0; c < 64; ++c) {
            const float4 a = *(const float4*)&St[c * 68 + ty * 4]; const float4 bq = *(const float4*)&KV[c * 68 + tx * 4];
            const float av[4] = {a.x, a.y, a.z, a.w}; const float bv[4] = {bq.x, bq.y, bq.z, bq.w};
#pragma unroll
            for (int i = 0; i < 4; ++i)
#pragma unroll
                for (int j = 0; j < 4; ++j) O[i][j] += av[i] * bv[j];
        }
        __syncthreads();
    }
    if (t256 < 64) al[t256] = 1.f / l_run;
    __syncthreads();
#pragma unroll
    for (int i = 0; i < 4; ++i) { const float a = al[ty * 4 + i];
        *(float4*)(ATT + (rowb + q0 + ty * 4 + i) * 512 + hq * 64 + tx * 4) = make_float4(O[i][0] * a, O[i][1] * a, O[i][2] * a, O[i][3] * a); }
    __syncthreads();
}
__device__ __forceinline__ void ph_att_norm(int gw, int NGW, int lane, const float* ATT, const float* gain, bf16_t* MIXED) {
    for (int t = gw; t < NTOK; t += NGW) {
        const float4* a = (const float4*)(ATT + (size_t)t * 512);
        const float4 v0 = a[lane], v1 = a[64 + lane];
        const float ss = wave_sum(v0.x * v0.x + v0.y * v0.y + v0.z * v0.z + v0.w * v0.w + v1.x * v1.x + v1.y * v1.y + v1.z * v1.z + v1.w * v1.w);
        const float rstd = rsqrtf(ss * (1.f / 512.f) + EPS);
        const float4 g0 = ((const float4*)gain)[lane], g1 = ((const float4*)gain)[64 + lane];
        bf16_t* m = MIXED + (size_t)t * D + 512;
        st_bf4(m + lane * 4, make_float4(v0.x * rstd * g0.x, v0.y * rstd * g0.y, v0.z * rstd * g0.z, v0.w * rstd * g0.w));
        st_bf4(m + 256 + lane * 4, make_float4(v1.x * rstd * g1.x, v1.y * rstd * g1.y, v1.z * rstd * g1.z, v1.w * rstd * g1.w));
    }
}
__device__ __forceinline__ void ph_router(int gw, int NGW, int lane, const float* H, const float* g2, const float* wg, const float* bg, const float* we, const float* be, float* RSTD, unsigned* tokinfo, unsigned* ctl) {
    for (int t = gw; t < NTOK; t += NGW) {
        const float4* hr = (const float4*)(H + (size_t)t * D);
        float ss = 0.f;
#pragma unroll
        for (int j = 0; j < 4; ++j) { const float4 v = hr[j * 64 + lane]; ss += v.x * v.x + v.y * v.y + v.z * v.z + v.w * v.w; }
        ss = wave_sum(ss);
        const float rstd = rsqrtf(ss * (1.f / D) + EPS);
        float gl[8], el[64];
#pragma unroll
        for (int i = 0; i < 8; ++i) gl[i] = 0.f;
#pragma unroll
        for (int i = 0; i < 64; ++i) el[i] = 0.f;
#pragma unroll 1
        for (int ji = 0; ji < 16; ++ji) {
            const int k = ((ji >> 2) * 64 + lane) * 4 + (ji & 3);
            const float xv = H[(size_t)t * D + k] * rstd * g2[k];
            const float4* pg = (const float4*)(wg + (size_t)k * 8);
#pragma unroll
            for (int q = 0; q < 2; ++q) { const float4 w = pg[q]; gl[q * 4] += xv * w.x; gl[q * 4 + 1] += xv * w.y; gl[q * 4 + 2] += xv * w.z; gl[q * 4 + 3] += xv * w.w; }
            const float4* pe = (const float4*)(we + (size_t)k * 64);
#pragma unroll
            for (int q = 0; q < 16; ++q) { const float4 w = pe[q]; el[q * 4] += xv * w.x; el[q * 4 + 1] += xv * w.y; el[q * 4 + 2] += xv * w.z; el[q * 4 + 3] += xv * w.w; }
        }
#pragma unroll
        for (int i = 0; i < 8; ++i) gl[i] = wave_sum(gl[i]) + bg[i];
#pragma unroll
        for (int i = 0; i < 64; ++i) el[i] = wave_sum(el[i]) + be[i];
        float best = gl[0]; int g = 0;
#pragma unroll
        for (int i = 1; i < 8; ++i) if (gl[i] > best) { best = gl[i]; g = i; }
        float den = 0.f;
#pragma unroll
        for (int i = 0; i < 8; ++i) den += expf(gl[i] - best);
        const float gw_ = 1.f / den;
        float ev[8];
#pragma unroll
        for (int j = 0; j < 8; ++j) { float v = el[j];
#pragma unroll
            for (int q = 1; q < 8; ++q) v = (g == q) ? el[q * 8 + j] : v;
            ev[j] = v; }
        float v1 = ev[0]; int i1 = 0;
#pragma unroll
        for (int j = 1; j < 8; ++j) if (ev[j] > v1) { v1 = ev[j]; i1 = j; }
        float v2 = -INFINITY; int i2 = 0;
#pragma unroll
        for (int j = 0; j < 8; ++j) if (j != i1 && ev[j] > v2) { v2 = ev[j]; i2 = j; }
        const float ex = expf(v2 - v1), p1 = 1.f / (1.f + ex), p2 = ex * p1;
        if (lane == 0) {
            const int e1 = g * 8 + i1, e2 = g * 8 + i2;
            uint4 o; o.x = (unsigned)e1; o.y = (unsigned)e2; o.z = __float_as_uint(gw_ * p1); o.w = __float_as_uint(gw_ * p2);
            ((uint4*)tokinfo)[t] = o;
            RSTD[t] = rstd;
            atomicAdd(&ctl[CW_COUNTS + e1], 1u); atomicAdd(&ctl[CW_COUNTS + e2], 1u);
        }
    }
}
__device__ __forceinline__ void ph_offsets(unsigned* ctl) {
    unsigned off = 0, nt = 0;
    for (int e = 0; e < NEXP; ++e) {
        const unsigned c = ctl[CW_COUNTS + e]; ctl[CW_OFFS + e] = off;
        for (unsigned r = 0; r < c; r += 64) { ctl[CW_TILE_E + nt] = (unsigned)e; ctl[CW_TILE_R0 + nt] = off + r; ctl[CW_TILE_NR + nt] = (c - r) < 64u ? (c - r) : 64u; ++nt; }
        off += c;
    }
    ctl[CW_OFFS + NEXP] = off; ctl[CW_NTILES] = nt;
}
__device__ __forceinline__ void ph_scatter(int gtid, int nthr, const unsigned* tokinfo, unsigned* ctl, int* tokslot, int* slottok, float* slotgate) {
    for (int t = gtid; t < NTOK; t += nthr) {
        const uint4 ti = ((const uint4*)tokinfo)[t];
        const unsigned p0 = ctl[CW_OFFS + ti.x] + atomicAdd(&ctl[CW_CURSOR + ti.x], 1u);
        const unsigned p1 = ctl[CW_OFFS + ti.y] + atomicAdd(&ctl[CW_CURSOR + ti.y], 1u);
        slottok[p0] = t; slottok[p1] = t; slotgate[p0] = __uint_as_float(ti.z); slotgate[p1] = __uint_as_float(ti.w);
        tokslot[2 * t] = (int)p0; tokslot[2 * t + 1] = (int)p1;
    }
}
__device__ __forceinline__ void ph_moe1_vb(float* sm, int t256, bool valid, int vb, const bf16_t* XN2, const float* w_gate, const float* w_up, const unsigned* ctl, const int* slottok, bf16_t* HMID) {
    const int tile = valid ? (vb >> 3) : 0, c0 = (vb & 7) * 64;
    const int e = (int)ctl[CW_TILE_E + tile], row0 = (int)ctl[CW_TILE_R0 + tile], nr = valid ? (int)ctl[CW_TILE_NR + tile] : 0;
    const float* wgp = w_gate + (size_t)e * D * DEXP; const float* wup = w_up + (size_t)e * D * DEXP;
    auto fa = [&](int r, int k) { if (r >= nr) return make_float4(0.f, 0.f, 0.f, 0.f); const int tok = slottok[row0 + r]; return ld_bf4(XN2 + (size_t)tok * D + k); };
    auto fb = [&](int k, int c) { return *(const float4*)(wgp + (size_t)k * DEXP + c0 + c); };
    auto fb2 = [&](int k, int c) { return *(const float4*)(wup + (size_t)k * DEXP + c0 + c); };
    auto fe = [&](int r, int c, float4 a, float4 u) { if (r >= nr) return; st_bf4(HMID + (size_t)(row0 + r) * DEXP + c0 + c, make_float4(silu_f(a.x) * u.x, silu_f(a.y) * u.y, silu_f(a.z) * u.z, silu_f(a.w) * u.w)); };
    naive_tile_h<true>(sm, t256, D, fa, fb, fb2, fe);
}
__device__ __forceinline__ void ph_moe2_vb(float* sm, int t256, bool valid, int vb, const bf16_t* HMID, const float* w_down, const unsigned* ctl, const float* slotgate, bf16_t* YS) {
    const int tile = valid ? (vb >> 4) : 0, c0 = (vb & 15) * 64;
    const int e = (int)ctl[CW_TILE_E + tile], row0 = (int)ctl[CW_TILE_R0 + tile], nr = valid ? (int)ctl[CW_TILE_NR + tile] : 0;
    const float* wd = w_down + (size_t)e * DEXP * D;
    auto fa = [&](int r, int k) { if (r >= nr) return make_float4(0.f, 0.f, 0.f, 0.f); return ld_bf4(HMID + (size_t)(row0 + r) * DEXP + k); };
    auto fb = [&](int k, int c) { return *(const float4*)(wd + (size_t)k * D + c0 + c); };
    auto fe = [&](int r, int c, float4 a, float4) { if (r >= nr) return; const float g = slotgate[row0 + r]; st_bf4(YS + (size_t)(row0 + r) * D + c0 + c, make_float4(a.x * g, a.y * g, a.z * g, a.w * g)); };
    naive_tile_h<false>(sm, t256, DEXP, fa, fb, fb, fe);
}
__device__ __forceinline__ void ph_final(int gw, int NGW, int lane, const bf16_t* H, const unsigned char* YS8, const float* YSC, const int* tokslot, const float* fg, float* OUTA, float* OUTB) {
    const int sub = (lane & 31) >> 3;
    float4 g[4];
#pragma unroll
    for (int j = 0; j < 4; ++j) g[j] = ((const float4*)fg)[j * 64 + lane];
    for (int t = 2 * gw; t < NTOK; t += 2 * NGW) {
        const int4 sl = *(const int4*)(tokslot + 2 * t);
        float4 v[2][4]; float ss[2] = {0.f, 0.f};
#pragma unroll
        for (int q = 0; q < 2; ++q) {
            const int s0 = q ? sl.z : sl.x, s1 = q ? sl.w : sl.y;
            const bf16_t* hr = H + (size_t)(t + q) * D;
            const unsigned* y0 = (const unsigned*)(YS8 + (size_t)s0 * D); const unsigned* y1 = (const unsigned*)(YS8 + (size_t)s1 * D);
            const float4 a0 = *(const float4*)(YSC + (size_t)s0 * 16 + sub * 4), a1 = *(const float4*)(YSC + (size_t)s1 * 16 + sub * 4);
            const float a0j[4] = {a0.x, a0.y, a0.z, a0.w}, a1j[4] = {a1.x, a1.y, a1.z, a1.w};
#pragma unroll
            for (int j = 0; j < 4; ++j) {
                const float4 hv = ld_bf4(hr + (j * 64 + lane) * 4); const unsigned w0 = y0[j * 64 + lane], w1 = y1[j * 64 + lane];
                const float p = a0j[j], r = a1j[j], off = -128.f * (p + r);
                v[q][j] = make_float4((hv.x + off) + p * (float)(w0 & 0xffu) + r * (float)(w1 & 0xffu), (hv.y + off) + p * (float)((w0 >> 8) & 0xffu) + r * (float)((w1 >> 8) & 0xffu),
                                      (hv.z + off) + p * (float)((w0 >> 16) & 0xffu) + r * (float)((w1 >> 16) & 0xffu), (hv.w + off) + p * (float)(w0 >> 24) + r * (float)(w1 >> 24));
                ss[q] += v[q][j].x * v[q][j].x + v[q][j].y * v[q][j].y + v[q][j].z * v[q][j].z + v[q][j].w * v[q][j].w;
            }
        }
#pragma unroll
        for (int q = 0; q < 2; ++q) {
            const float rstd = rsqrtf(wave_sum(ss[q]) * (1.f / D) + EPS);
            const int tt = t + q;
            float4* orow = (float4*)((tt < NTOK / 2 ? OUTA + (size_t)tt * D : OUTB + (size_t)(tt - NTOK / 2) * D));
#pragma unroll
            for (int j = 0; j < 4; ++j) orow[j * 64 + lane] = make_float4(v[q][j].x * rstd * g[j].x, v[q][j].y * rstd * g[j].y, v[q][j].z * rstd * g[j].z, v[q][j].w * rstd * g[j].w);
        }
    }
}
__device__ __forceinline__ void ph_copy_xs(int bx, int wave, int lane, const LAS int* pos, const float* H, const float* RSTD, const float* g2, bf16_t* XS) {
    float4 g[4];
#pragma unroll
    for (int j = 0; j < 4; ++j) g[j] = ((const float4*)g2)[j * 64 + lane];
#pragma unroll 1
    for (int i = 0; i < 16; i += 2) {
        const int l0 = wave * 16 + i, l1 = l0 + 1, t0 = bx * 128 + l0, t1 = t0 + 1;
        const float r0 = RSTD[t0], r1 = RSTD[t1];
        const float4* h0 = (const float4*)(H + (size_t)t0 * D); const float4* h1 = (const float4*)(H + (size_t)t1 * D);
        float4 a[4], b[4];
#pragma unroll
        for (int j = 0; j < 4; ++j) { a[j] = h0[j * 64 + lane]; b[j] = h1[j * 64 + lane]; }
        uint2* o00 = (uint2*)(XS + (size_t)pos[2 * l0] * D); uint2* o01 = (uint2*)(XS + (size_t)pos[2 * l0 + 1] * D);
        uint2* o10 = (uint2*)(XS + (size_t)pos[2 * l1] * D); uint2* o11 = (uint2*)(XS + (size_t)pos[2 * l1 + 1] * D);
#pragma unroll
        for (int j = 0; j < 4; ++j) {
            uint2 w; w.x = (unsigned)f2bf(a[j].x * r0 * g[j].x) | ((unsigned)f2bf(a[j].y * r0 * g[j].y) << 16); w.y = (unsigned)f2bf(a[j].z * r0 * g[j].z) | ((unsigned)f2bf(a[j].w * r0 * g[j].w) << 16);
            o00[j * 64 + lane] = w; o01[j * 64 + lane] = w;
            uint2 v; v.x = (unsigned)f2bf(b[j].x * r1 * g[j].x) | ((unsigned)f2bf(b[j].y * r1 * g[j].y) << 16); v.y = (unsigned)f2bf(b[j].z * r1 * g[j].z) | ((unsigned)f2bf(b[j].w * r1 * g[j].w) << 16);
            o10[j * 64 + lane] = v; o11[j * 64 + lane] = v;
        }
    }
}

__device__ __forceinline__ void ph_copy_xs_i8(int bx, int wave, int lane, const LAS int* pos, const bf16_t* H, const float* RSTD, const float* g2, unsigned char* XS8, float* SA) {
    float4 g[4];
#pragma unroll
    for (int j = 0; j < 4; ++j) g[j] = ((const float4*)g2)[lane * 4 + j];
#pragma unroll 1
    for (int i = 0; i < 16; i += 2) {
        const int l0 = wave * 16 + i, t0 = bx * 128 + l0;
        float4 a[2][4]; float mx[2];
#pragma unroll
        for (int q = 0; q < 2; ++q) { const uint4* hp = (const uint4*)(H + (size_t)(t0 + q) * D + lane * 16); const uint4 h0 = hp[0], h1 = hp[1];
            const unsigned hw[8] = {h0.x, h0.y, h0.z, h0.w, h1.x, h1.y, h1.z, h1.w};
#pragma unroll
            for (int j = 0; j < 4; ++j) a[q][j] = make_float4(__uint_as_float(hw[2 * j] << 16), __uint_as_float(hw[2 * j] & 0xffff0000u), __uint_as_float(hw[2 * j + 1] << 16), __uint_as_float(hw[2 * j + 1] & 0xffff0000u)); }
#pragma unroll
        for (int q = 0; q < 2; ++q) { const float r = RSTD[t0 + q]; float m = 0.f;
#pragma unroll
            for (int j = 0; j < 4; ++j) { a[q][j].x *= r * g[j].x; a[q][j].y *= r * g[j].y; a[q][j].z *= r * g[j].z; a[q][j].w *= r * g[j].w;
                m = fmaxf(m, fmaxf(fmaxf(fabsf(a[q][j].x), fabsf(a[q][j].y)), fmaxf(fabsf(a[q][j].z), fabsf(a[q][j].w)))); }
#pragma unroll
            for (int o = 1; o < 64; o <<= 1) m = fmaxf(m, __shfl_xor(m, o));
            mx[q] = m; }
#pragma unroll
        for (int q = 0; q < 2; ++q) { const float inv = mx[q] > 0.f ? 127.f / mx[q] : 0.f;
            v4u w;
#pragma unroll
            for (int j = 0; j < 4; ++j) { const int ia = __float2int_rn(a[q][j].x * inv), ib = __float2int_rn(a[q][j].y * inv), ic = __float2int_rn(a[q][j].z * inv), id = __float2int_rn(a[q][j].w * inv);
                w[j] = ((unsigned)ia & 0xffu) | (((unsigned)ib & 0xffu) << 8) | (((unsigned)ic & 0xffu) << 16) | ((unsigned)id << 24); }
            const int p0 = pos[2 * (l0 + q)], p1 = pos[2 * (l0 + q) + 1];
            *(GAS v4u*)(XS8 + (size_t)p0 * D + lane * 16) = w; *(GAS v4u*)(XS8 + (size_t)p1 * D + lane * 16) = w;
            if (lane == 0) { SA[p0] = mx[q] * (1.f / 127.f); SA[p1] = mx[q] * (1.f / 127.f); } }
    }
}
constexpr size_t WS_DEC = 11 * MiB;
constexpr int LDT = 72;
constexpr int GL_QE = 0, GL_KE = 9216, GL_P = 18432, GL_VT = 27648, GL_ST = 46080, GL_TOT = 64512, GL_PART = 68608, GL_RSTD = 70656;
typedef float gf32x4 __attribute__((ext_vector_type(4)));
typedef short gbf16x8 __attribute__((ext_vector_type(8)));

__device__ __forceinline__ float exp_fast(float x) { return __builtin_amdgcn_exp2f(x * 1.4426950408889634f); }
__device__ __forceinline__ float log_sigmoid_f(float x) { return fminf(x, 0.f) - 0.6931471805599453f * __builtin_amdgcn_logf(1.f + exp_fast(-fabsf(x))); }
__device__ __forceinline__ gf32x4 mfma_tile64(const LAS bf16_t* A, const LAS bf16_t* Bt, gf32x4 acc, int lane) {
    const int r = lane & 15, kq = (lane >> 4) * 8;
    const gbf16x8 a0 = *(const LAS gbf16x8*)(A + r * LDT + kq), a1 = *(const LAS gbf16x8*)(A + r * LDT + kq + 32);
    const gbf16x8 b0 = *(const LAS gbf16x8*)(Bt + r * LDT + kq), b1 = *(const LAS gbf16x8*)(Bt + r * LDT + kq + 32);
    acc = __builtin_amdgcn_mfma_f32_16x16x32_bf16(a0, b0, acc, 0, 0, 0);
    acc = __builtin_amdgcn_mfma_f32_16x16x32_bf16(a1, b1, acc, 0, 0, 0);
    return acc;
}
template <bool BWD>
__device__ __forceinline__ void gla_cumsum(const bf16_t* zbase  , const float* up  , const float* bias, int hd  , int tg, int d, LAS float* tot, float (&bv)[8], float& bl) {
    float upc[16];
#pragma unroll
    for (int r = 0; r < 16; ++r) upc[r] = up[r * 256 + hd];
    const float bs = bias[hd];
    float c[8];
#pragma unroll
    for (int i = 0; i < 8; ++i) {
        const uint4* zp = (const uint4*)(zbase + (size_t)(8 * tg + i) * PW);
        const uint4 z0 = zp[0], z1 = zp[1];
        const unsigned zw[8] = {z0.x, z0.y, z0.z, z0.w, z1.x, z1.y, z1.z, z1.w};
        float pre = bs;
#pragma unroll
        for (int r = 0; r < 8; ++r) { pre += __uint_as_float(zw[r] << 16) * upc[2 * r]; pre += __uint_as_float(zw[r] & 0xffff0000u) * upc[2 * r + 1]; }
        c[i] = log_sigmoid_f(pre) * (1.f / 16.f);
    }
    if (!BWD) {
#pragma unroll
        for (int i = 1; i < 8; ++i) c[i] += c[i - 1];
        tot[tg * 64 + d] = c[7];
    } else {
#pragma unroll
        for (int i = 6; i >= 0; --i) c[i] += c[i + 1];
        tot[tg * 64 + d] = c[0];
    }
    __syncthreads();
    float off = 0.f, all = 0.f;
#pragma unroll
    for (int t2 = 0; t2 < 8; ++t2) { const float v = tot[t2 * 64 + d]; all += v; if (BWD ? (t2 > tg) : (t2 < tg)) off += v; }
#pragma unroll
    for (int i = 0; i < 8; ++i) bv[i] = c[i] + off;
    bl = all;
}
__device__ __forceinline__ void gla_stage_vt(const bf16_t* vbase, LAS bf16_t* VT, int tid) {
    const int s = tid & 63, e0 = (tid >> 6) * 16;
    const uint4* vp = (const uint4*)(vbase + (size_t)s * PW + e0);
    const uint4 v0 = vp[0], v1 = vp[1];
    const unsigned w[8] = {v0.x, v0.y, v0.z, v0.w, v1.x, v1.y, v1.z, v1.w};
#pragma unroll
    for (int i = 0; i < 8; ++i) { VT[(e0 + 2 * i) * LDT + s] = (bf16_t)(w[i] & 0xffffu); VT[(e0 + 2 * i + 1) * LDT + s] = (bf16_t)(w[i] >> 16); }
}
__device__ __forceinline__ void gla_g1_unit(LAS unsigned char* lds, int tid, int unit, const bf16_t* PROJ, const float* upf, const float* bf_, const float* upb, const float* bb_, bf16_t* KVS, float* DEC) {
    const int n = unit & 63, h = (unit >> 6) & 3, b = unit >> 8;
    const int d = tid & 63, tg = tid >> 6, lane = tid & 63, w = tid >> 6;
    const size_t tok0 = (size_t)b * T + n * 64;
    LAS bf16_t* KET = (LAS bf16_t*)(lds + GL_QE); LAS bf16_t* VT = (LAS bf16_t*)(lds + GL_VT); LAS float* tot = (LAS float*)(lds + GL_TOT);
    gla_stage_vt(PROJ + tok0 * PW + C_GV + h * 128, VT, tid);
#pragma unroll
    for (int dir = 0; dir < 2; ++dir) {
        float bv[8], bl;
        if (dir == 0) gla_cumsum<false>(PROJ + tok0 * PW + C_ZF, upf, bf_, h * 64 + d, tg, d, tot, bv, bl);
        else          gla_cumsum<true>(PROJ + tok0 * PW + C_ZB, upb, bb_, h * 64 + d, tg, d, tot + 512, bv, bl);
        unsigned pk[4];
#pragma unroll
        for (int i = 0; i < 8; i += 2) {
            const float k0 = bf2f(PROJ[(tok0 + 8 * tg + i) * PW + C_GK + h * 64 + d]) * exp_fast(bl - bv[i]);
            const float k1 = bf2f(PROJ[(tok0 + 8 * tg + i + 1) * PW + C_GK + h * 64 + d]) * exp_fast(bl - bv[i + 1]);
            pk[i >> 1] = (unsigned)f2bf(k0) | ((unsigned)f2bf(k1) << 16);
        }
        *(LAS v4u*)(KET + d * LDT + 8 * tg) = (v4u){pk[0], pk[1], pk[2], pk[3]};
        const size_t sq = (((size_t)b * 4 + h) * 2 + dir) * 64 + n;
        if (tg == 0) DEC[sq * 64 + d] = exp_fast(bl);
        __syncthreads();
        bf16_t* kvo = KVS + sq * 8192;
#pragma unroll
        for (int dt = 0; dt < 4; ++dt) {
            gf32x4 acc = {0.f, 0.f, 0.f, 0.f};
            acc = mfma_tile64(VT + (16 * w) * LDT, KET + (16 * dt) * LDT, acc, lane);
#pragma unroll
            for (int r = 0; r < 4; ++r) kvo[(size_t)(16 * w + 4 * (lane >> 4) + r) * 64 + 16 * dt + (lane & 15)] = f2bf(acc[r]);
        }
        __syncthreads();
    }
}
template <bool BWD>
__device__ __forceinline__ void gla_g2_item(unsigned* base, const float* dc) {
    float s0 = 0.f, s1 = 0.f;
#pragma unroll 1
    for (int hf = 0; hf < 2; ++hf) {
        unsigned kv[32]; float2 dd[32];
#pragma unroll
        for (int st = 0; st < 32; ++st) { const int n = BWD ? (63 - 32 * hf - st) : (32 * hf + st); kv[st] = base[(size_t)n * 4096]; dd[st] = *(const float2*)(dc + n * 64); }
#pragma unroll
        for (int st = 0; st < 32; ++st) { const int n = BWD ? (63 - 32 * hf - st) : (32 * hf + st);
            base[(size_t)n * 4096] = (unsigned)f2bf(s0) | ((unsigned)f2bf(s1) << 16);
            s0 = dd[st].x * s0 + __uint_as_float(kv[st] << 16); s1 = dd[st].y * s1 + __uint_as_float(kv[st] & 0xffff0000u); }
    }
}
__device__ __forceinline__ void gla_g2_scan(int gtid, int nthr, bf16_t* KVS, const float* DEC) {
    for (int item = gtid; item < 64 * 4096; item += nthr) {
        const int seq = item >> 12, ed = item & 4095, d2 = (ed & 31) * 2;
        unsigned* base = (unsigned*)(KVS + (size_t)seq * 64 * 8192) + ed;
        const float* dc = DEC + (size_t)seq * 64 * 64 + d2;
        if (seq & 1) gla_g2_item<true>(base, dc); else gla_g2_item<false>(base, dc);
    }
}
__device__ __forceinline__ void gla_g3_unit(LAS unsigned char* lds, int tid, int unit, const bf16_t* PROJ, const float* upf, const float* bf_, const float* upb, const float* bb_, const bf16_t* KVS, const float* gain, bf16_t* MIXED) {
    const int n = unit & 63, h = (unit >> 6) & 3, b = unit >> 8;
    const int d = tid & 63, tg = tid >> 6, lane = tid & 63, w = tid >> 6;
    const size_t tok0 = (size_t)b * T + n * 64;
    LAS bf16_t* QE = (LAS bf16_t*)(lds + GL_QE); LAS bf16_t* KE = (LAS bf16_t*)(lds + GL_KE); LAS bf16_t* PP = (LAS bf16_t*)(lds + GL_P);
    LAS bf16_t* VT = (LAS bf16_t*)(lds + GL_VT); LAS bf16_t* ST = (LAS bf16_t*)(lds + GL_ST);
    LAS float* tot = (LAS float*)(lds + GL_TOT); LAS float* part = (LAS float*)(lds + GL_PART); LAS float* rs = (LAS float*)(lds + GL_RSTD);
    gla_stage_vt(PROJ + tok0 * PW + C_GV + h * 128, VT, tid);
    gf32x4 o[4];
#pragma unroll
    for (int rt = 0; rt < 4; ++rt) o[rt] = (gf32x4){0.f, 0.f, 0.f, 0.f};
#pragma unroll
    for (int dir = 0; dir < 2; ++dir) {
        float bv[8], bl;
        if (dir == 0) gla_cumsum<false>(PROJ + tok0 * PW + C_ZF, upf, bf_, h * 64 + d, tg, d, tot, bv, bl);
        else          gla_cumsum<true>(PROJ + tok0 * PW + C_ZB, upb, bb_, h * 64 + d, tg, d, tot + 512, bv, bl);
#pragma unroll
        for (int i = 0; i < 8; ++i) {
            const size_t ro = (tok0 + 8 * tg + i) * PW + h * 64 + d;
            const float e = exp_fast(bv[i]);
            QE[(8 * tg + i) * LDT + d] = f2bf(bf2f(PROJ[ro + C_GQ]) * e * 0.125f);
            KE[(8 * tg + i) * LDT + d] = f2bf(bf2f(PROJ[ro + C_GK]) * __builtin_amdgcn_rcpf(e));
        }
        {
            const size_t sq = (((size_t)b * 4 + h) * 2 + dir) * 64 + n;
            const int e = tid >> 2, part4 = tid & 3;
            const uint4* sp = (const uint4*)(KVS + sq * 8192 + e * 64 + part4 * 16);
            const uint4 s0 = sp[0], s1 = sp[1];
            *(LAS v4u*)(ST + e * LDT + part4 * 16) = (v4u){s0.x, s0.y, s0.z, s0.w}; *(LAS v4u*)(ST + e * LDT + part4 * 16 + 8) = (v4u){s1.x, s1.y, s1.z, s1.w};
        }
        __syncthreads();
        { const int ct = w >> 1;
#pragma unroll
          for (int j = 0; j < 2; ++j) { const int st = 2 * (w & 1) + j;
            gf32x4 acc = {0.f, 0.f, 0.f, 0.f};
            acc = mfma_tile64(QE + (16 * ct) * LDT, KE + (16 * st) * LDT, acc, lane);
            const int s = 16 * st + (lane & 15);
#pragma unroll
            for (int r = 0; r < 4; ++r) { const int c = 16 * ct + 4 * (lane >> 4) + r; const bool keep = dir ? (s >= c) : (s <= c);
                PP[c * LDT + s] = f2bf(keep ? acc[r] : 0.f); } } }
        __syncthreads();
#pragma unroll
        for (int rt = 0; rt < 4; ++rt) {
            o[rt] = mfma_tile64(PP + (16 * rt) * LDT, VT + (16 * w) * LDT, o[rt], lane);
            o[rt] = mfma_tile64(QE + (16 * rt) * LDT, ST + (16 * w) * LDT, o[rt], lane);
        }
        __syncthreads();
    }
#pragma unroll
    for (int rt = 0; rt < 4; ++rt)
#pragma unroll
        for (int r = 0; r < 4; ++r) {
            float ss = o[rt][r] * o[rt][r];
            ss += __shfl_xor(ss, 1); ss += __shfl_xor(ss, 2); ss += __shfl_xor(ss, 4); ss += __shfl_xor(ss, 8);
            if ((lane & 15) == 0) part[w * 64 + 16 * rt + 4 * (lane >> 4) + r] = ss;
        }
    __syncthreads();
    if (tid < 64) { float ss = 0.f;
#pragma unroll
        for (int t2 = 0; t2 < 8; ++t2) ss += part[t2 * 64 + tid];
        rs[tid] = rsqrtf(ss * (1.f / 128.f) + EPS); }
    __syncthreads();
    { const int e = 16 * w + (lane & 15); const float ge = gain[e];
#pragma unroll
      for (int rt = 0; rt < 4; ++rt)
#pragma unroll
        for (int r = 0; r < 4; ++r) { const int c = 16 * rt + 4 * (lane >> 4) + r;
            const float g = bf2f(PROJ[(tok0 + c) * PW + C_GG + h * 128 + e]);
            MIXED[(tok0 + c) * D + h * 128 + e] = f2bf(o[rt][r] * rs[c] * ge * g * __builtin_amdgcn_rcpf(1.f + exp_fast(-g))); } }
    __syncthreads();
}

constexpr size_t WS_BFRAG = 12 * MiB;
__device__ __forceinline__ void router_build_bfrag(int gtid, int nthr, const float* wg, const float* we, const float* g2, bf16_t* BF) {
    for (int i = gtid; i < 32 * 5 * 64; i += nthr) {
        const int ks = i / 320, rem = i - ks * 320, ct = rem >> 6, lane = rem & 63, col = 16 * ct + (lane & 15);
        unsigned hi[4], lo[4];
#pragma unroll
        for (int j = 0; j < 8; ++j) {
            const int k = 32 * ks + 8 * (lane >> 4) + j;
            float w = col < 8 ? wg[k * 8 + col] : (col < 72 ? we[k * 64 + col - 8] : 0.f);
            w *= g2[k];
            const bf16_t h = f2bf(w); const bf16_t l = f2bf(w - bf2f(h));
            if (j & 1) { hi[j >> 1] |= (unsigned)h << 16; lo[j >> 1] |= (unsigned)l << 16; } else { hi[j >> 1] = h; lo[j >> 1] = l; }
        }
        uint4* o = (uint4*)(BF + ((size_t)(ks * 5 + ct) * 2) * 512 + lane * 8);
        o[0] = make_uint4(hi[0], hi[1], hi[2], hi[3]); o[64] = make_uint4(lo[0], lo[1], lo[2], lo[3]);
    }
}
__device__ __forceinline__ void ph_router_mfma(int gw, int NGW, int lane, LAS float* lsm  , const bf16_t* H, const bf16_t* BF, const float* bg, const float* be, float* RSTD, unsigned* tokinfo, LAS int* hist, bool dry) {
    for (int task = gw; task < NTOK / 16; task += NGW) {
        const int t0 = task * 16, row = lane & 15, kg = lane >> 4;
        const bf16_t* hp = H + (size_t)(t0 + row) * D + kg * 8;
        gf32x4 acc[5];
#pragma unroll
        for (int ct = 0; ct < 5; ++ct) acc[ct] = (gf32x4){0.f, 0.f, 0.f, 0.f};
        float ss = 0.f;
#pragma unroll 2
        for (int ks = 0; ks < 32; ++ks) {
            const gbf16x8 ah = *(const gbf16x8*)(hp + ks * 32);
#pragma unroll
            for (int j = 0; j < 8; ++j) { const float xv = bf2f((bf16_t)ah[j]); ss += xv * xv; }
            const gbf16x8* bp = (const gbf16x8*)(BF + (size_t)ks * 5 * 2 * 512) + lane;
#pragma unroll
            for (int ct = 0; ct < 5; ++ct) {
                const gbf16x8 bh = bp[(ct * 2) * 64], bl = bp[(ct * 2 + 1) * 64];
                acc[ct] = __builtin_amdgcn_mfma_f32_16x16x32_bf16(ah, bh, acc[ct], 0, 0, 0);
                acc[ct] = __builtin_amdgcn_mfma_f32_16x16x32_bf16(ah, bl, acc[ct], 0, 0, 0);
            }
        }
        ss += __shfl_xor(ss, 16); ss += __shfl_xor(ss, 32);
        const float rstd = rsqrtf(ss * (1.f / D) + EPS);
#pragma unroll
        for (int ct = 0; ct < 5; ++ct) { const int col = 16 * ct + row; const float bias = col < 8 ? bg[col] : (col < 72 ? be[col - 8] : 0.f);
#pragma unroll
            for (int r = 0; r < 4; ++r) { const int rr = 4 * kg + r; const float rs = __shfl(rstd, rr); lsm[rr * 80 + col] = acc[ct][r] * rs + bias; } }
        asm volatile("s_waitcnt lgkmcnt(0)" ::: "memory");
        if (lane < 16) {
            const LAS float* L = lsm + lane * 80;
            float best = L[0]; int g = 0;
#pragma unroll
            for (int i = 1; i < 8; ++i) { const float v = L[i]; if (v > best) { best = v; g = i; } }
            float den = 0.f;
#pragma unroll
            for (int i = 0; i < 8; ++i) den += expf(L[i] - best);
            const float gw_ = 1.f / den;
            const LAS float* E = L + 8 + g * 8;
            float v1 = E[0]; int i1 = 0;
#pragma unroll
            for (int j = 1; j < 8; ++j) { const float v = E[j]; if (v > v1) { v1 = v; i1 = j; } }
            float v2 = -INFINITY; int i2 = 0;
#pragma unroll
            for (int j = 0; j < 8; ++j) { const float v = E[j]; if (j != i1 && v > v2) { v2 = v; i2 = j; } }
            const float ex = expf(v2 - v1), p1 = 1.f / (1.f + ex), p2 = ex * p1;
            const int e1 = g * 8 + i1, e2 = g * 8 + i2, t = t0 + lane;
            uint4 o; o.x = (unsigned)e1; o.y = (unsigned)e2; o.z = __float_as_uint(gw_ * p1); o.w = __float_as_uint(gw_ * p2);
            ((uint4*)tokinfo)[t] = o;
            RSTD[t] = rstd;
            if (!dry) { __hip_atomic_fetch_add(hist + e1, 1, __ATOMIC_RELAXED, __HIP_MEMORY_SCOPE_WORKGROUP); __hip_atomic_fetch_add(hist + e2, 1, __ATOMIC_RELAXED, __HIP_MEMORY_SCOPE_WORKGROUP); }
        }
        asm volatile("s_waitcnt lgkmcnt(0)" ::: "memory");
    }
}

__device__ __forceinline__ void ph_router_lds(int vcu, int G, int wave, int lane, LAS unsigned char* lds, const bf16_t* H, const bf16_t* BF, const float* bg, const float* be, float* RSTD, unsigned* tokinfo, LAS int* hist, bool dry) {
    for (int tg = vcu; tg < NTOK / 128; tg += G) {
        const int t0 = (tg * 8 + wave) * 16, row = lane & 15, kg = lane >> 4;
        const bf16_t* hp = H + (size_t)(t0 + row) * D + kg * 8;
        gf32x4 acc[5];
#pragma unroll
        for (int ct = 0; ct < 5; ++ct) acc[ct] = (gf32x4){0.f, 0.f, 0.f, 0.f};
        float ss = 0.f;
        gbf16x8 ha[2][4];
#define RT_DMA(j) do { _Pragma("unroll") for (int i = 0; i < 5; ++i) __builtin_amdgcn_global_load_lds((const unsigned*)(BF + (size_t)(j) * 20480 + (wave + 8 * i) * 512 + lane * 8), \
            (LAS unsigned*)(lds + ((j) & 1) * 65536 + (wave + 8 * i) * 1024), 16, 0, 0); } while (0)
#define RT_LDH(j) do { _Pragma("unroll") for (int k = 0; k < 4; ++k) ha[(j) & 1][k] = *(const GAS gbf16x8*)(hp + ((j) * 4 + k) * 32); } while (0)
        RT_DMA(0); RT_LDH(0);
#pragma unroll
        for (int j = 0; j < 8; ++j) {
            if (j + 1 < 8) { RT_DMA(j + 1); RT_LDH(j + 1); asm volatile("s_waitcnt vmcnt(9)" ::: "memory"); } else asm volatile("s_waitcnt vmcnt(0)" ::: "memory");
            __syncthreads();
            const LAS unsigned char* buf = lds + (j & 1) * 65536;
#pragma unroll
            for (int k = 0; k < 4; ++k) {
                const gbf16x8 ah = ha[j & 1][k];
#pragma unroll
                for (int e = 0; e < 8; ++e) { const float xv = bf2f((bf16_t)ah[e]); ss += xv * xv; }
#pragma unroll
                for (int ct = 0; ct < 5; ++ct) {
                    const gbf16x8 bh = *(const LAS gbf16x8*)(buf + ((k * 10 + ct * 2) * 64 + lane) * 16), bl = *(const LAS gbf16x8*)(buf + ((k * 10 + ct * 2 + 1) * 64 + lane) * 16);
                    acc[ct] = __builtin_amdgcn_mfma_f32_16x16x32_bf16(ah, bh, acc[ct], 0, 0, 0);
                    acc[ct] = __builtin_amdgcn_mfma_f32_16x16x32_bf16(ah, bl, acc[ct], 0, 0, 0);
                }
            }
            __syncthreads();
        }
#undef RT_DMA
#undef RT_LDH
        LAS float* lsm = (LAS float*)(lds + wave * 5120);
        ss += __shfl_xor(ss, 16); ss += __shfl_xor(ss, 32);
        const float rstd = rsqrtf(ss * (1.f / D) + EPS);
#pragma unroll
        for (int ct = 0; ct < 5; ++ct) { const int col = 16 * ct + row; const float bias = col < 8 ? bg[col] : (col < 72 ? be[col - 8] : 0.f);
#pragma unroll
            for (int r = 0; r < 4; ++r) { const int rr = 4 * kg + r; const float rs = __shfl(rstd, rr); lsm[rr * 80 + col] = acc[ct][r] * rs + bias; } }
        asm volatile("s_waitcnt lgkmcnt(0)" ::: "memory");
        if (lane < 16) {
            const LAS float* L = lsm + lane * 80;
            float best = L[0]; int g = 0;
#pragma unroll
            for (int i = 1; i < 8; ++i) { const float v = L[i]; if (v > best) { best = v; g = i; } }
            float den = 0.f;
#pragma unroll
            for (int i = 0; i < 8; ++i) den += expf(L[i] - best);
            const float gw_ = 1.f / den;
            const LAS float* E = L + 8 + g * 8;
            float v1 = E[0]; int i1 = 0;
#pragma unroll
            for (int j = 1; j < 8; ++j) { const float v = E[j]; if (v > v1) { v1 = v; i1 = j; } }
            float v2 = -INFINITY; int i2 = 0;
#pragma unroll
            for (int j = 0; j < 8; ++j) { const float v = E[j]; if (j != i1 && v > v2) { v2 = v; i2 = j; } }
            const float ex = expf(v2 - v1), p1 = 1.f / (1.f + ex), p2 = ex * p1;
            const int e1 = g * 8 + i1, e2 = g * 8 + i2, t = t0 + lane;
            uint4 o; o.x = (unsigned)e1; o.y = (unsigned)e2; o.z = __float_as_uint(gw_ * p1); o.w = __float_as_uint(gw_ * p2);
            ((uint4*)tokinfo)[t] = o;
            RSTD[t] = rstd;
            if (!dry) { __hip_atomic_fetch_add(hist + e1, 1, __ATOMIC_RELAXED, __HIP_MEMORY_SCOPE_WORKGROUP); __hip_atomic_fetch_add(hist + e2, 1, __ATOMIC_RELAXED, __HIP_MEMORY_SCOPE_WORKGROUP); }
        }
        asm volatile("s_waitcnt lgkmcnt(0)" ::: "memory");
        __syncthreads();
    }
}

constexpr int G_Z = 0, G_VT = 8192, G_G = 26624, G_ST0 = 43008, G_ST1 = 61440, G_BM = 79872, G_QE = 97280, G_KE = 106496, G_P = 115712, G_TOT = 124928, G_PART = 129024;
constexpr int BMS = 68;
typedef unsigned v2u __attribute__((ext_vector_type(2)));
struct GlaRaw3 { v4u q, k, z, v0, v1, g0, g1, sa0, sa1, sb0, sb1, oa0, oa1; float sq; };
struct GlaRaw1 { v4u k, z, v0, v1; };
__device__ __forceinline__ v4u ld16(const bf16_t* p) { return *(const GAS v4u*)p; }
__device__ __forceinline__ void gla_load3(GlaRaw3& R, int tid, int b, int h, int n, const bf16_t* PROJ, const bf16_t* KVS, const bf16_t* MIXED, const float* SSQ) {
    const size_t tok0 = (size_t)b * T + n * 64;
    const int s8 = tid >> 3, c8 = tid & 7, lane = tid & 63, w = tid >> 6;
    R.q = ld16(PROJ + (tok0 + s8) * PW + C_GQ + h * 64 + c8 * 8);
    R.k = ld16(PROJ + (tok0 + s8) * PW + C_GK + h * 64 + c8 * 8);
    R.z = ld16(PROJ + (tok0 + ((tid >> 2) & 63)) * PW + C_ZF + (tid & 3) * 8);
    R.v0 = ld16(PROJ + (tok0 + (tid >> 4)) * PW + C_GV + h * 128 + (tid & 15) * 8); R.v1 = ld16(PROJ + (tok0 + (tid >> 4) + 32) * PW + C_GV + h * 128 + (tid & 15) * 8);
    const int s16 = tid >> 4, c16 = tid & 15;
    R.g0 = ld16(PROJ + (tok0 + s16) * PW + C_GG + h * 128 + c16 * 8); R.g1 = ld16(PROJ + (tok0 + s16 + 32) * PW + C_GG + h * 128 + c16 * 8);
    const size_t sq = (((size_t)b * 4 + h) * 2) * 64 + n;
    const bf16_t* sp = KVS + sq * 8192 + (tid >> 2) * 64 + (tid & 3) * 16;
    R.sa0 = ld16(sp); R.sa1 = ld16(sp + 8); R.sb0 = ld16(sp + (size_t)64 * 8192); R.sb1 = ld16(sp + (size_t)64 * 8192 + 8);
    R.sq = SSQ[(size_t)(tid >> 6) * NTOK + tok0 + (tid & 63)];
}
__device__ __forceinline__ void gla_store_z(LAS unsigned char* lds, int tid, v4u z) {
    if (tid < 256) { LAS f32x4* zp = (LAS f32x4*)(lds + G_Z) + (tid >> 2) * 8 + (tid & 3) * 2;
        zp[0] = (f32x4){__uint_as_float(z.x << 16), __uint_as_float(z.x & 0xffff0000u), __uint_as_float(z.y << 16), __uint_as_float(z.y & 0xffff0000u)};
        zp[1] = (f32x4){__uint_as_float(z.z << 16), __uint_as_float(z.z & 0xffff0000u), __uint_as_float(z.w << 16), __uint_as_float(z.w & 0xffff0000u)}; }
}
__device__ __forceinline__ void gla_store_vt(LAS unsigned char* lds, int tid, v4u v0, v4u v1) {
    LAS bf16_t* VT = (LAS bf16_t*)(lds + G_VT); const int c16 = tid & 15, sA = (tid >> 4) ^ (8 * (c16 & 7)), sB = sA ^ 32;
    const unsigned wa[4] = {v0.x, v0.y, v0.z, v0.w}, wb[4] = {v1.x, v1.y, v1.z, v1.w};
#pragma unroll
    for (int i = 0; i < 4; ++i) { LAS bf16_t* r0 = VT + (c16 * 8 + 2 * i) * LDT; LAS bf16_t* r1 = r0 + LDT;
        r0[sA] = (bf16_t)(wa[i] & 0xffffu); r1[sA] = (bf16_t)(wa[i] >> 16); r0[sB] = (bf16_t)(wb[i] & 0xffffu); r1[sB] = (bf16_t)(wb[i] >> 16); }
}
template <bool VA>
__device__ __forceinline__ gf32x4 mfma_tile64_v(const LAS bf16_t* X, const LAS bf16_t* VTw, int w, gf32x4 acc, int lane) {
    const int r = lane & 15, grp = lane >> 4, g = (2 * w + (r >> 3)) & 7;
    const gbf16x8 x0 = *(const LAS gbf16x8*)(X + r * LDT + grp * 8), x1 = *(const LAS gbf16x8*)(X + r * LDT + grp * 8 + 32);
    const gbf16x8 v0 = *(const LAS gbf16x8*)(VTw + r * LDT + ((grp ^ g) * 8)), v1 = *(const LAS gbf16x8*)(VTw + r * LDT + (((grp + 4) ^ g) * 8));
    if (VA) { acc = __builtin_amdgcn_mfma_f32_16x16x32_bf16(v0, x0, acc, 0, 0, 0); acc = __builtin_amdgcn_mfma_f32_16x16x32_bf16(v1, x1, acc, 0, 0, 0); }
    else    { acc = __builtin_amdgcn_mfma_f32_16x16x32_bf16(x0, v0, acc, 0, 0, 0); acc = __builtin_amdgcn_mfma_f32_16x16x32_bf16(x1, v1, acc, 0, 0, 0); }
    return acc;
}
constexpr int ZBS = 40, GL_UPT = 132096;
template <int DIR>
__device__ __forceinline__ void gla_cumsum3(LAS unsigned char* lds, float bias, int w, int lane, float (&bv)[2][4], float& bl) {
    const LAS bf16_t* ZB = (const LAS bf16_t*)(lds + G_Z); const LAS bf16_t* UPT = (const LAS bf16_t*)(lds + GL_UPT) + DIR * 64 * ZBS; LAS float* tot = (LAS float*)(lds + G_TOT);
    const int r16 = lane & 15, kg = lane >> 4, dcol = 16 * (w & 3) + r16, run0 = 8 * (w >> 2) + kg;
    const gbf16x8 bfr = *(const LAS gbf16x8*)(UPT + (16 * (w & 3) + r16) * ZBS + 8 * kg);
    float c[2][4];
#pragma unroll
    for (int j = 0; j < 2; ++j) {
        const gbf16x8 afr = *(const LAS gbf16x8*)(ZB + (32 * (w >> 2) + 16 * j + r16) * ZBS + 8 * kg);
        const gf32x4 acc = __builtin_amdgcn_mfma_f32_16x16x32_bf16(afr, bfr, (gf32x4){0.f, 0.f, 0.f, 0.f}, 0, 0, 0);
#pragma unroll
        for (int r = 0; r < 4; ++r) c[j][r] = log_sigmoid_f(acc[r] + bias) * (1.f / 16.f);
        if (DIR == 0) { c[j][1] += c[j][0]; c[j][2] += c[j][1]; c[j][3] += c[j][2]; tot[(run0 + 4 * j) * 64 + dcol] = c[j][3]; }
        else          { c[j][2] += c[j][3]; c[j][1] += c[j][2]; c[j][0] += c[j][1]; tot[(run0 + 4 * j) * 64 + dcol] = c[j][0]; }
    }
    __syncthreads();
    float off0 = 0.f, off1 = 0.f, all = 0.f;
#pragma unroll
    for (int q = 0; q < 16; ++q) { const float v = tot[q * 64 + dcol]; all += v;
        if (DIR ? (q > run0) : (q < run0)) off0 += v;
        if (DIR ? (q > run0 + 4) : (q < run0 + 4)) off1 += v; }
#pragma unroll
    for (int r = 0; r < 4; ++r) { bv[0][r] = c[0][r] + off0; bv[1][r] = c[1][r] + off1; }
    bl = all;
}
__device__ __forceinline__ void gla_store_zb(LAS unsigned char* lds, int tid, v4u z) { if (tid < 256) *(LAS v4u*)((LAS bf16_t*)(lds + G_Z) + (tid >> 2) * ZBS + (tid & 3) * 8) = z; }
__device__ __forceinline__ void gla_build_upt(LAS unsigned char* lds, int tid, int h, const float* upf, const float* upb) {
    LAS bf16_t* U0 = (LAS bf16_t*)(lds + GL_UPT); LAS bf16_t* U1 = U0 + 64 * ZBS;
    const int d = tid & 63, k0 = (tid >> 6) * 4;
    unsigned a0 = 0u, a1 = 0u, b0 = 0u, b1 = 0u;
    if (k0 < 16) { const float* p = upf + k0 * 256 + h * 64 + d; a0 = (unsigned)f2bf(p[0]) | ((unsigned)f2bf(p[256]) << 16); a1 = (unsigned)f2bf(p[512]) | ((unsigned)f2bf(p[768]) << 16); }
    else { const float* p = upb + (k0 - 16) * 256 + h * 64 + d; b0 = (unsigned)f2bf(p[0]) | ((unsigned)f2bf(p[256]) << 16); b1 = (unsigned)f2bf(p[512]) | ((unsigned)f2bf(p[768]) << 16); }
    *(LAS v2u*)(U0 + d * ZBS + k0) = (v2u){a0, a1}; *(LAS v2u*)(U1 + d * ZBS + k0) = (v2u){b0, b1};
}
__device__ __forceinline__ unsigned pk_bf2(float a, float b) { return (unsigned)f2bf(a) | ((unsigned)f2bf(b) << 16); }

__device__ __forceinline__ void gla_g3_phase(LAS unsigned char* lds, int tid, int bx, const bf16_t* PROJ, const float* upf, const float* bf_, const float* upb, const float* bb_, const bf16_t* KVS, const float* gain, bf16_t* MIXED, const float* SSQ, float* ratt) {
    const int n = bx & 63, h = (bx >> 6) & 3;
    const int d = tid & 63, tg = tid >> 6, lane = tid & 63, w = tid >> 6, s8 = tid >> 3, c8 = tid & 7;
    const int dcol = 16 * (w & 3) + (lane & 15), tk0 = 32 * (w >> 2) + 4 * (lane >> 4);
    const float bsF = bf_[h * 64 + dcol], bsB = bb_[h * 64 + dcol];
    gla_build_upt(lds, tid, h, upf, upb);
    float ge4[4];
#pragma unroll
    for (int r = 0; r < 4; ++r) ge4[r] = gain[16 * w + 4 * (lane >> 4) + r];
    LAS bf16_t* QE = (LAS bf16_t*)(lds + G_QE); LAS bf16_t* KE = (LAS bf16_t*)(lds + G_KE); LAS bf16_t* PP = (LAS bf16_t*)(lds + G_P);
    LAS bf16_t* VT = (LAS bf16_t*)(lds + G_VT); LAS bf16_t* GG = (LAS bf16_t*)(lds + G_G); LAS float* BM = (LAS float*)(lds + G_BM);
    LAS float* part = (LAS float*)(lds + G_PART); LAS float* rs = (LAS float*)(lds + G_TOT);
    GlaRaw3 R; gla_load3(R, tid, 0, h, n, PROJ, KVS, MIXED, SSQ);
    for (int b = 0; b < NB; ++b) {
        const size_t tok0 = (size_t)b * T + n * 64;
        const v4u cq = R.q, ck = R.k;
        gla_store_zb(lds, tid, R.z); gla_store_vt(lds, tid, R.v0, R.v1);
        { const int s16 = tid >> 4, c16 = tid & 15; *(LAS v4u*)(GG + s16 * 128 + c16 * 8) = R.g0; *(LAS v4u*)(GG + (s16 + 32) * 128 + c16 * 8) = R.g1; }
        { const int e = tid >> 2, p4 = tid & 3; LAS bf16_t* s0 = (LAS bf16_t*)(lds + G_ST0) + e * LDT + p4 * 16; LAS bf16_t* s1 = (LAS bf16_t*)(lds + G_ST1) + e * LDT + p4 * 16;
          *(LAS v4u*)s0 = R.sa0; *(LAS v4u*)(s0 + 8) = R.sa1; *(LAS v4u*)s1 = R.sb0; *(LAS v4u*)(s1 + 8) = R.sb1; }
        part[tid] = R.sq;
        if (b + 1 < NB) gla_load3(R, tid, b + 1, h, n, PROJ, KVS, MIXED, SSQ);
        __syncthreads();
        if (tid < 64) { float q = 0.f;
#pragma unroll
            for (int hh = 0; hh < 8; ++hh) q += part[hh * 64 + tid];
            const float ms = q * (1.f / 512.f) + EPS; ((LAS float*)(lds + 143360))[tid] = sqrtf(ms); if (h == 0) ratt[tok0 + tid] = rsqrtf(ms); }
        gf32x4 o[4];
#pragma unroll
        for (int rt = 0; rt < 4; ++rt) o[rt] = (gf32x4){0.f, 0.f, 0.f, 0.f};
#pragma unroll
        for (int dir = 0; dir < 2; ++dir) {
            float bv[2][4], bl;
            if (dir == 0) gla_cumsum3<0>(lds, bsF, w, lane, bv, bl); else gla_cumsum3<1>(lds, bsB, w, lane, bv, bl);
#pragma unroll
            for (int j = 0; j < 2; ++j)
#pragma unroll
                for (int r = 0; r < 4; ++r) BM[(tk0 + 16 * j + r) * BMS + dcol] = bv[j][r];
            __syncthreads();
            {
                const f32x4 b0 = *(const LAS f32x4*)(BM + s8 * BMS + c8 * 8), b1 = *(const LAS f32x4*)(BM + s8 * BMS + c8 * 8 + 4);
                const float bb[8] = {b0.x, b0.y, b0.z, b0.w, b1.x, b1.y, b1.z, b1.w};
                const unsigned qw[4] = {cq.x, cq.y, cq.z, cq.w}, kw[4] = {ck.x, ck.y, ck.z, ck.w};
                unsigned qo[4], ko[4];
#pragma unroll
                for (int j = 0; j < 4; ++j) {
                    const float e0 = exp_fast(bb[2 * j]), e1 = exp_fast(bb[2 * j + 1]);
                    qo[j] = pk_bf2(__uint_as_float(qw[j] << 16) * e0 * 0.125f, __uint_as_float(qw[j] & 0xffff0000u) * e1 * 0.125f);
                    ko[j] = pk_bf2(__uint_as_float(kw[j] << 16) * __builtin_amdgcn_rcpf(e0), __uint_as_float(kw[j] & 0xffff0000u) * __builtin_amdgcn_rcpf(e1));
                }
                *(LAS v4u*)(QE + s8 * LDT + c8 * 8) = (v4u){qo[0], qo[1], qo[2], qo[3]}; *(LAS v4u*)(KE + s8 * LDT + c8 * 8) = (v4u){ko[0], ko[1], ko[2], ko[3]};
            }
            __syncthreads();
            { const int ct = w >> 1;
#pragma unroll
              for (int j = 0; j < 2; ++j) { const int st = 2 * (w & 1) + j;
                gf32x4 acc = {0.f, 0.f, 0.f, 0.f};
                acc = mfma_tile64(KE + (16 * st) * LDT, QE + (16 * ct) * LDT, acc, lane);
                const int c = 16 * ct + (lane & 15), s0 = 16 * st + 4 * (lane >> 4);
                float pv[4];
#pragma unroll
                for (int r = 0; r < 4; ++r) { const int s = s0 + r; const bool keep = dir ? (s >= c) : (s <= c); pv[r] = keep ? acc[r] : 0.f; }
                *(LAS v2u*)(PP + c * LDT + s0) = (v2u){pk_bf2(pv[0], pv[1]), pk_bf2(pv[2], pv[3])}; } }
            __syncthreads();
            const LAS bf16_t* ST = (const LAS bf16_t*)(lds + (dir ? G_ST1 : G_ST0));
#pragma unroll
            for (int rt = 0; rt < 4; ++rt) {
                o[rt] = mfma_tile64_v<true>(PP + (16 * rt) * LDT, VT + (16 * w) * LDT, w, o[rt], lane);
                o[rt] = mfma_tile64(ST + (16 * w) * LDT, QE + (16 * rt) * LDT, o[rt], lane);
            }
        }
#pragma unroll
        for (int rt = 0; rt < 4; ++rt) {
            float ss = o[rt][0] * o[rt][0] + o[rt][1] * o[rt][1] + o[rt][2] * o[rt][2] + o[rt][3] * o[rt][3];
            ss += __shfl_xor(ss, 16); ss += __shfl_xor(ss, 32);
            if (lane < 16) part[w * 64 + 16 * rt + lane] = ss;
        }
        __syncthreads();
        if (tid < 64) { float ss = 0.f;
#pragma unroll
            for (int t2 = 0; t2 < 8; ++t2) ss += part[t2 * 64 + tid];
            rs[tid] = rsqrtf(ss * (1.f / 128.f) + EPS) * ((LAS float*)(lds + 143360))[tid]; }
        __syncthreads();
#pragma unroll
        for (int rt = 0; rt < 4; ++rt) { const int c = 16 * rt + (lane & 15), e0 = 16 * w + 4 * (lane >> 4);
            const v2u gw2 = *(const LAS v2u*)(GG + c * 128 + e0);
            const float gv[4] = {__uint_as_float(gw2.x << 16), __uint_as_float(gw2.x & 0xffff0000u), __uint_as_float(gw2.y << 16), __uint_as_float(gw2.y & 0xffff0000u)};
            const float rc = rs[c]; float ov[4];
#pragma unroll
            for (int r = 0; r < 4; ++r) ov[r] = o[rt][r] * rc * ge4[r] * gv[r] * __builtin_amdgcn_rcpf(1.f + exp_fast(-gv[r]));
            *(GAS v2u*)(MIXED + (tok0 + c) * D + 512 + h * 128 + e0) = (v2u){pk_bf2(ov[0], ov[1]), pk_bf2(ov[2], ov[3])}; }
        __syncthreads();
    }
}
__device__ __forceinline__ void gla_load1(GlaRaw1& R, int tid, int b, int h, int n, const bf16_t* PROJ) {
    const size_t tok0 = (size_t)b * T + n * 64;
    const int s8 = tid >> 3, c8 = tid & 7, lane = tid & 63, w = tid >> 6;
    R.k = ld16(PROJ + (tok0 + s8) * PW + C_GK + h * 64 + c8 * 8);
    R.z = ld16(PROJ + (tok0 + ((tid >> 2) & 63)) * PW + C_ZF + (tid & 3) * 8);
    R.v0 = ld16(PROJ + (tok0 + (tid >> 4)) * PW + C_GV + h * 128 + (tid & 15) * 8); R.v1 = ld16(PROJ + (tok0 + (tid >> 4) + 32) * PW + C_GV + h * 128 + (tid & 15) * 8);
}
__device__ __forceinline__ void gla_g1_phase(LAS unsigned char* lds, int tid, int bx, const bf16_t* PROJ, const float* upf, const float* bf_, const float* upb, const float* bb_, bf16_t* KVS, float* DEC) {
    const int n = bx & 63, h = (bx >> 6) & 3;
    const int d = tid & 63, tg = tid >> 6, lane = tid & 63, w = tid >> 6, s8 = tid >> 3, c8 = tid & 7;
    const int dcol = 16 * (w & 3) + (lane & 15), tk0 = 32 * (w >> 2) + 4 * (lane >> 4);
    const float bsF = bf_[h * 64 + dcol], bsB = bb_[h * 64 + dcol];
    gla_build_upt(lds, tid, h, upf, upb);
    LAS bf16_t* KR = (LAS bf16_t*)(lds + G_G); LAS bf16_t* KET = (LAS bf16_t*)(lds + G_QE); LAS bf16_t* VT = (LAS bf16_t*)(lds + G_VT);
    GlaRaw1 R; gla_load1(R, tid, 0, h, n, PROJ);
    for (int b = 0; b < NB; ++b) {
        gla_store_zb(lds, tid, R.z); gla_store_vt(lds, tid, R.v0, R.v1);
        *(LAS v4u*)(KR + s8 * LDT + c8 * 8) = R.k;
        if (b + 1 < NB) gla_load1(R, tid, b + 1, h, n, PROJ);
        __syncthreads();
#pragma unroll
        for (int dir = 0; dir < 2; ++dir) {
            float bv[2][4], bl;
            if (dir == 0) gla_cumsum3<0>(lds, bsF, w, lane, bv, bl); else gla_cumsum3<1>(lds, bsB, w, lane, bv, bl);
#pragma unroll
            for (int j = 0; j < 2; ++j) {
                const int t0 = tk0 + 16 * j;
                const unsigned p0 = pk_bf2(bf2f(KR[(t0 + 0) * LDT + dcol]) * exp_fast(bl - bv[j][0]), bf2f(KR[(t0 + 1) * LDT + dcol]) * exp_fast(bl - bv[j][1]));
                const unsigned p1 = pk_bf2(bf2f(KR[(t0 + 2) * LDT + dcol]) * exp_fast(bl - bv[j][2]), bf2f(KR[(t0 + 3) * LDT + dcol]) * exp_fast(bl - bv[j][3]));
                *(LAS v2u*)(KET + dcol * LDT + t0) = (v2u){p0, p1};
            }
            const size_t sq = (((size_t)b * 4 + h) * 2 + dir) * 64 + n;
            if (w < 4 && lane < 16) DEC[sq * 64 + dcol] = exp_fast(bl);
            __syncthreads();
            bf16_t* kvo = KVS + sq * 8192;
#pragma unroll
            for (int dt = 0; dt < 4; ++dt) {
                gf32x4 acc = {0.f, 0.f, 0.f, 0.f};
                acc = mfma_tile64_v<false>(KET + (16 * dt) * LDT, VT + (16 * w) * LDT, w, acc, lane);
                *(GAS v2u*)(kvo + (size_t)(16 * w + (lane & 15)) * 64 + 16 * dt + 4 * (lane >> 4)) = (v2u){pk_bf2(acc[0], acc[1]), pk_bf2(acc[2], acc[3])};
            }
        }
        __syncthreads();
    }
}
#include <hip/hip_bf16.h>
#include <cmath>
namespace attn_body {
using bf16=__hip_bfloat16;
using bf16x8=__attribute__((ext_vector_type(8)))short;
using s16x4=__attribute__((ext_vector_type(4)))short;
using f32x16=__attribute__((ext_vector_type(16)))float;
using u32x4=__attribute__((ext_vector_type(4)))unsigned;
constexpr int BATCH=8,NHEAD=8,SEQ=4096,D=64,DM=2560,OP=1024;
constexpr int NW=8,QBLK=32,QB=QBLK*NW,KVBLK=64,NQB=SEQ/QB;
constexpr int ATTN_PITCH=DM, ATTN_UNIT_ROWS=QB;
__device__ __forceinline__ int crow(int r,int hi){return (r&3)+8*(r>>2)+4*hi;}
#define SBAR() __builtin_amdgcn_sched_barrier(0)
__device__ __forceinline__ void cmask(f32x16&p0,f32x16&p1,int jb,int qrel,int hi){
  const float NEG=-INFINITY; int kb=64*jb+4*hi;
  #pragma unroll
  for(int r=0;r<16;++r){int kv=kb+(r&3)+8*(r>>2); if(kv>qrel)p0[r]=NEG; if(kv+32>qrel)p1[r]=NEG;}
}

constexpr int NSLOT=3, SLOTB=8192;
constexpr int LDS_K=0, LDS_V=NSLOT*SLOTB, LDS_WS=2*NSLOT*SLOTB, LDS_OST=LDS_WS+NW*64*4, LDS_BYTES=LDS_OST+NW*4096;
constexpr bool FIXREF=true;
constexpr float C2=0.125f*1.4426950408889634f;
__device__ __forceinline__ void glds16(const void*gsrc,unsigned lds_dst){unsigned keep;
  asm volatile("s_mov_b32 %0, m0\n\ts_mov_b32 m0, %2\n\ts_nop 0\n\tglobal_load_lds_dwordx4 %1, off\n\ts_mov_b32 m0, %0":"=&s"(keep):"v"(gsrc),"s"(lds_dst):"memory");}
__device__ __forceinline__ float max3f(float a,float b,float c){float r;asm("v_max3_f32 %0, %1, %2, %3":"=v"(r):"v"(a),"v"(b),"v"(c));return r;}
__device__ __forceinline__ float max2f(float a,float b){float r;asm("v_max_f32_e32 %0, %1, %2":"=v"(r):"v"(a),"v"(b));return r;}
__device__ __forceinline__ float fadd_s(float a,float b){float r;asm("v_add_f32_e32 %0, %1, %2":"=v"(r):"v"(a),"v"(b));return r;}
__device__ __forceinline__ float fsub_s(float a,float b){float r;asm("v_sub_f32_e32 %0, %1, %2":"=v"(r):"v"(a),"v"(b));return r;}
typedef float f32x2_t __attribute__((ext_vector_type(2))); typedef __bf16 bf16x2_t __attribute__((ext_vector_type(2)));
__device__ __forceinline__ unsigned cvtpk_s(float lo,float hi){f32x2_t v={lo,hi};bf16x2_t b=__builtin_convertvector(v,bf16x2_t);return __builtin_bit_cast(unsigned,b);}
#define WAIT_BAR(N) asm volatile("s_waitcnt vmcnt(" #N ") lgkmcnt(0)\n\ts_barrier":::"memory")

__device__ __forceinline__ void qkt(f32x16&p0,f32x16&p1,const char*Kslot,const bf16x8*qr,const f32x16&negm,int r32,int hi){
  const char*kb=Kslot+r32*128; const int xs=(r32>>1)&7;
  #pragma unroll
  for(int d0=0;d0<4;++d0){
    const bf16x8 b0=*reinterpret_cast<const bf16x8*>(kb+(((2*d0+hi)^xs)<<4));
    const bf16x8 b1=*reinterpret_cast<const bf16x8*>(kb+(((2*d0+hi)^xs)<<4)+4096);
    if(d0==0){p0=__builtin_amdgcn_mfma_f32_32x32x16_bf16(b0,qr[0],negm,0,0,0);p1=__builtin_amdgcn_mfma_f32_32x32x16_bf16(b1,qr[0],negm,0,0,0);}
    else{p0=__builtin_amdgcn_mfma_f32_32x32x16_bf16(b0,qr[d0],p0,0,0,0);p1=__builtin_amdgcn_mfma_f32_32x32x16_bf16(b1,qr[d0],p1,0,0,0);}}
}
typedef __attribute__((address_space(3))) const char* lds_cptr;
typedef short v4i16_t __attribute__((ext_vector_type(4)));
struct KBases { int o[4]; };
__device__ __forceinline__ void kload8(bf16x8*kf,lds_cptr kring,const KBases&kb,int sl){
  #pragma unroll
  for(int d0=0;d0<4;++d0){ kf[2*d0]=*(const __attribute__((address_space(3))) bf16x8*)(kring+kb.o[d0]+sl); kf[2*d0+1]=*(const __attribute__((address_space(3))) bf16x8*)(kring+kb.o[d0]+sl+4096); }
}
__device__ __forceinline__ void kload2(bf16x8*kf,lds_cptr kring,const KBases&kb,int sl,int j){ kf[2*j]=*(const __attribute__((address_space(3))) bf16x8*)(kring+kb.o[j]+sl); kf[2*j+1]=*(const __attribute__((address_space(3))) bf16x8*)(kring+kb.o[j]+sl+4096); }
__device__ __forceinline__ s16x4 vtr(lds_cptr p){ return __builtin_bit_cast(s16x4,__builtin_amdgcn_ds_read_tr16_b64_v4i16((__attribute__((address_space(3))) v4i16_t*)p)); }
__device__ __forceinline__ float rowmax(const f32x16&p0,const f32x16&p1){
  float a=max3f(p0[0],p0[1],p1[0]),b=max3f(p0[2],p0[3],p1[1]);a=max3f(a,p1[2],p1[3]);
  #pragma unroll
  for(int r=4;r<16;r+=4){a=max3f(a,p0[r],p0[r+1]);b=max3f(b,p0[r+2],p0[r+3]);a=max3f(a,p1[r],p1[r+1]);b=max3f(b,p1[r+2],p1[r+3]);}
  const float m=max2f(a,b);
  auto rr=__builtin_amdgcn_permlane32_swap(__float_as_uint(m),__float_as_uint(m),false,false);
  return max2f(__uint_as_float(rr[0]),__uint_as_float(rr[1]));
}
__device__ __forceinline__ void pv(f32x16*o,int vb,bf16x8 pa0,bf16x8 pa1,bf16x8 pa2,bf16x8 pa3){
  #pragma unroll
  for(int d0=0;d0<2;++d0){s16x4 lo[4],hi[4];
    #pragma unroll
    for(int ks=0;ks<4;++ks){
      asm volatile("ds_read_b64_tr_b16 %0,%1 offset:%c2":"=&v"(lo[ks]):"v"(vb),"i"(d0*4096+ks*1024):"memory");
      asm volatile("ds_read_b64_tr_b16 %0,%1 offset:%c2":"=&v"(hi[ks]):"v"(vb),"i"(d0*4096+ks*1024+512):"memory");}
    asm volatile("s_waitcnt lgkmcnt(0)":::"memory");SBAR();
    #define PK(k) (bf16x8){lo[k][0],lo[k][1],lo[k][2],lo[k][3],hi[k][0],hi[k][1],hi[k][2],hi[k][3]}
    o[d0]=__builtin_amdgcn_mfma_f32_32x32x16_bf16(pa0,PK(0),o[d0],0,0,0);
    o[d0]=__builtin_amdgcn_mfma_f32_32x32x16_bf16(pa1,PK(1),o[d0],0,0,0);
    o[d0]=__builtin_amdgcn_mfma_f32_32x32x16_bf16(pa2,PK(2),o[d0],0,0,0);
    o[d0]=__builtin_amdgcn_mfma_f32_32x32x16_bf16(pa3,PK(3),o[d0],0,0,0);
    #undef PK
  }
}

#ifndef ATTN_STORE16
#define ATTN_STORE16(p,v) (*(u32x4*)(p)=(v))
#endif
template<int THRL> __device__ __forceinline__ void attn_unit(int b,int h,int qb,const bf16*Q,const bf16*__restrict__ K,const bf16*__restrict__ V,bf16*O,char*shm,const float*qg,const float*rope,float*ssq,float sbound){
  const int tid=threadIdx.x,lane=tid&63,r32=lane&31,hi=lane>>5; const int wid=__builtin_amdgcn_readfirstlane(tid>>6);
  const long rowbase=(long)b*SEQ; const int q0=qb*QB;
  const bf16*Qw=Q+(rowbase+q0+wid*QBLK)*DM+h*D;
  const bf16*Kh=K+rowbase*DM+(h>>2)*D,*Vh=V+rowbase*DM+(h>>2)*D;
  const unsigned lds0=(unsigned)(uintptr_t)shm;
  float*wsf=(float*)(shm+LDS_WS)+wid*64;
  const unsigned koff=(unsigned)((8*wid+(lane>>3))*DM+(((lane&7)^((4*wid+(lane>>4))&7))*8)),
  voff_dummy_=0u, voff=(unsigned)((16*(wid&3)+(lane>>2))*DM+(wid>>2)*32+(lane&3)*8);
  const unsigned kdst=lds0+LDS_K+wid*1024, vdst=lds0+LDS_V+wid*1024;
  #define DMA_K(t,slot) glds16(Kh+(long)(t)*KVBLK*DM+koff,(unsigned)__builtin_amdgcn_readfirstlane(kdst+(slot)))
  #define DMA_V(t,slot) glds16(Vh+(long)(t)*KVBLK*DM+voff,(unsigned)__builtin_amdgcn_readfirstlane(vdst+(slot)))
  const int vb0=(int)(lds0+LDS_V)+((lane>>4)&1)*32+(lane&3)*8+(4*hi+((lane&15)>>2))*64;
  const char*Kbase=shm+LDS_K; bf16x8 kf[8];
  const lds_cptr shm3=(lds_cptr)shm; const lds_cptr kring=shm3+LDS_K; KBases kbs; _Pragma("unroll") for(int d0=0;d0<4;++d0)kbs.o[d0]=r32*128+(((2*d0+hi)^((r32>>1)&7))<<4); const lds_cptr vp0=shm3+LDS_V+((lane>>4)&1)*32+(lane&3)*8+(4*hi+((lane&15)>>2))*64;
  const int NT=SEQ/KVBLK;
  DMA_K(0,0);DMA_V(0,0);DMA_K(1,SLOTB);
  bf16x8 qr[4];
  #pragma unroll
  for(int d0=0;d0<4;++d0)qr[d0]=*reinterpret_cast<const bf16x8*>(&Qw[(long)r32*DM+d0*16+hi*8]);
  {
    float x[4][8]; float ss=0.f;
    #pragma unroll
    for(int d0=0;d0<4;++d0){
      #pragma unroll
      for(int j=0;j<8;++j){ x[d0][j]=__uint_as_float(((unsigned)(unsigned short)qr[d0][j])<<16); ss+=x[d0][j]*x[d0][j]; } }
    ss+=__shfl_xor(ss,32);
    const float rstd=rsqrtf(ss*(1.f/64.f)+1e-6f);
    const int tt=q0+wid*QBLK+r32, prow=tt>>6, pcol=tt&63;
    #pragma unroll
    for(int d0=0;d0<4;++d0){
      const float4 g0=*reinterpret_cast<const float4*>(qg+d0*16+hi*8), g1=*reinterpret_cast<const float4*>(qg+d0*16+hi*8+4);
      const int pos=(d0<2)?prow:pcol, i0=8*(d0&1)+4*hi;
      const float4 c4=*reinterpret_cast<const float4*>(rope+pos*16+i0), s4=*reinterpret_cast<const float4*>(rope+1024+pos*16+i0);
      const float gg[8]={g0.x,g0.y,g0.z,g0.w,g1.x,g1.y,g1.z,g1.w}, cc[4]={c4.x,c4.y,c4.z,c4.w}, sn[4]={s4.x,s4.y,s4.z,s4.w};
      u32x4 pw;
      #pragma unroll
      for(int jj=0;jj<4;++jj){ const float y0=x[d0][2*jj]*rstd*gg[2*jj], y1=x[d0][2*jj+1]*rstd*gg[2*jj+1];
        pw[jj]=cvtpk_s((y0*cc[jj]-y1*sn[jj])*C2,(y0*sn[jj]+y1*cc[jj])*C2); }
      qr[d0]=__builtin_bit_cast(bf16x8,pw); } }
  float mhat=0.f,l_reg=0.f;f32x16 o[2];o[0]=f32x16{};o[1]=f32x16{};f32x16 negm; _Pragma("unroll") for(int r=0;r<16;++r)negm[r]=FIXREF?-sbound:0.f; asm volatile("":"+v"(negm));

  #define CMASK(P0,P1,t) do{}while(0)
  bool resc=false;
  #define START(P0,P1) do{ resc=false; if(!FIXREF) \
    { const float rm=rowmax(P0,P1); const float dl=rm; mhat=fadd_s(mhat,dl); \
      _Pragma("unroll") for(int r=0;r<16;++r){P0[r]=fsub_s(P0[r],dl);P1[r]=fsub_s(P1[r],dl);} \
      _Pragma("unroll") for(int r=0;r<16;++r)negm[r]=-mhat; asm volatile("":"+v"(negm)); } \
    _Pragma("unroll") for(int r=0;r<16;++r)P0[r]=__builtin_amdgcn_exp2f(P0[r]); }while(0)
  #define RESC() do{ if(resc){ asm volatile("s_waitcnt lgkmcnt(0)":::"memory"); \
      _Pragma("unroll") for(int d_=0;d_<2;++d_) _Pragma("unroll") for(int r=0;r<16;++r)o[d_][r]*=wsf[crow(r,hi)]; } }while(0)
  f32x16 pA0,pA1,pB0,pB1;
  int sl_prev=0,sl_cur=0,sl_next=SLOTB;
  #define ROT() do{sl_prev=sl_cur;sl_cur=sl_next;sl_next=(sl_next==(NSLOT-1)*SLOTB)?0:sl_next+SLOTB;}while(0)
  DMA_K(2,2*SLOTB);
  WAIT_BAR(3);
  qkt(pA0,pA1,Kbase,qr,negm,r32,hi);asm volatile("s_nop 15\n\ts_nop 7":"+v"(pA0),"+v"(pA1));CMASK(pA0,pA1,0);
  START(pA0,pA1);
  _Pragma("unroll") for(int r=0;r<16;++r)pA1[r]=__builtin_amdgcn_exp2f(pA1[r]);
  WAIT_BAR(0);
  DMA_K(3,0);DMA_V(1,SLOTB);
  ROT();
  kload8(kf,kring,kbs,sl_cur);
  WAIT_BAR(2);
  s16x4 vlo[8],vhi[8]; u32x4 pw0,pw1,pw2,pw3;
  #define PKW(P,B) cvtpk_s(P[B],P[B+1])
  #define PAF(k) __builtin_bit_cast(bf16x8,pw##k)
  #define VFR(i) (bf16x8){vlo[i][0],vlo[i][1],vlo[i][2],vlo[i][3],vhi[i][0],vhi[i][1],vhi[i][2],vhi[i][3]}
  #define PIN(x) asm volatile("":"+v"(x))
  #define MX3(a,b,c) __builtin_fmaxf(__builtin_fmaxf((a),(b)),(c))
  #define GAPA(MF,A0,A1,A2,A3,W0,W1,PW) do{ MF; sacc+=A0; sacc+=A1; sacc+=A2; sacc+=A3; PIN(sacc); W0; W1; PIN(PW); SBAR(); }while(0)
  #define EX(v) __builtin_amdgcn_exp2f(v)
  #define GAPB(MF,X,B) do{ MF; X[B]=EX(X[B]); X[B+1]=EX(X[B+1]); X[B+2]=EX(X[B+2]); X[B+3]=EX(X[B+3]); PIN(X); SBAR(); }while(0)
  #define VRD(i) do{ vlo[i]=vtr(vp_+(((i)>>2)*4096+((i)&3)*1024)); vhi[i]=vtr(vp_+(((i)>>2)*4096+((i)&3)*1024+512)); }while(0)
  #define KRD(G,j) do{ if(G){ kload2(kf,kring,kbs,sl_next,j); SBAR(); } }while(0)
  #define STEP(C0,C1,P0,P1,t,GK,GV,GL) do{ SBAR(); \
    const lds_cptr vp_=vp0+sl_prev; \
    VRD(0); SBAR(); float sacc=(P0[0]+P0[1]); \
    GAPA(C0=__builtin_amdgcn_mfma_f32_32x32x16_bf16(kf[0],qr[0],negm,0,0,0), P0[2],P0[3],P0[4],P0[5],     pw0[0]=PKW(P0,0), pw0[1]=PKW(P0,2), pw0); \
    VRD(4); SBAR(); GAPA(C1=__builtin_amdgcn_mfma_f32_32x32x16_bf16(kf[1],qr[0],negm,0,0,0), P0[6],P0[7],P0[8],P0[9],     pw0[2]=PKW(P0,4), pw0[3]=PKW(P0,6), pw0); \
    VRD(1); SBAR(); GAPA(C0=__builtin_amdgcn_mfma_f32_32x32x16_bf16(kf[2],qr[1],C0,0,0,0),   P0[10],P0[11],P0[12],P0[13], pw1[0]=PKW(P0,8), pw1[1]=PKW(P0,10), pw1); \
    VRD(5); SBAR(); GAPA(C1=__builtin_amdgcn_mfma_f32_32x32x16_bf16(kf[3],qr[1],C1,0,0,0),   P0[14],P0[15],P1[0],P1[1],   pw1[2]=PKW(P0,12),pw1[3]=PKW(P0,14), pw1); \
    VRD(2); SBAR(); GAPA(C0=__builtin_amdgcn_mfma_f32_32x32x16_bf16(kf[4],qr[2],C0,0,0,0),   P1[2],P1[3],P1[4],P1[5],     pw2[0]=PKW(P1,0), pw2[1]=PKW(P1,2), pw2); \
    VRD(6); SBAR(); GAPA(C1=__builtin_amdgcn_mfma_f32_32x32x16_bf16(kf[5],qr[2],C1,0,0,0),   P1[6],P1[7],P1[8],P1[9],     pw2[2]=PKW(P1,4), pw2[3]=PKW(P1,6), pw2); \
    VRD(3); SBAR(); GAPA(C0=__builtin_amdgcn_mfma_f32_32x32x16_bf16(kf[6],qr[3],C0,0,0,0),   P1[10],P1[11],P1[12],P1[13], pw3[0]=PKW(P1,8), pw3[1]=PKW(P1,10), pw3); \
    VRD(7); SBAR(); GAPA(C1=__builtin_amdgcn_mfma_f32_32x32x16_bf16(kf[7],qr[3],C1,0,0,0),   P1[14],P1[15],0.f,0.f,       pw3[2]=PKW(P1,12),pw3[3]=PKW(P1,14), pw3); \
    l_reg+=sacc; \
    if(GK){DMA_K((t)+3,sl_cur);} if(GV){DMA_V((t)+1,sl_next);} \
    CMASK(C0,C1,t); \
    if(!FIXREF){ float a=MX3(C0[0],C0[1],C1[0]),b=MX3(C0[2],C0[3],C1[1]); a=MX3(a,C1[2],C1[3]); \
      _Pragma("unroll") for(int r=4;r<16;r+=4){a=MX3(a,C0[r],C0[r+1]);b=MX3(b,C0[r+2],C0[r+3]);a=MX3(a,C1[r],C1[r+1]);b=MX3(b,C1[r+2],C1[r+3]);} \
      float rm=__builtin_fmaxf(a,b); { auto rr=__builtin_amdgcn_permlane32_swap(__float_as_uint(rm),__float_as_uint(rm),false,false); rm=__builtin_fmaxf(__uint_as_float(rr[0]),__uint_as_float(rr[1])); } \
      resc=false; \
      if(__builtin_expect(__any(rm>(float)THRL),0)){ const float dl=__builtin_fmaxf(rm,0.f); mhat+=dl; \
        _Pragma("unroll") for(int r=0;r<16;++r){C0[r]-=dl;C1[r]-=dl;} \
        _Pragma("unroll") for(int r=0;r<16;++r)negm[r]=-mhat; asm volatile("":"+v"(negm)); \
        const float f=__builtin_amdgcn_exp2f(-dl); l_reg*=f; if(hi==0)wsf[r32]=f; resc=true; } } \
    SBAR(); \
    GAPB(o[0]=__builtin_amdgcn_mfma_f32_32x32x16_bf16(PAF(0),VFR(0),o[0],0,0,0), C0,0); \
    GAPB(o[1]=__builtin_amdgcn_mfma_f32_32x32x16_bf16(PAF(0),VFR(4),o[1],0,0,0), C0,4); \
    KRD(GL,0); GAPB(o[0]=__builtin_amdgcn_mfma_f32_32x32x16_bf16(PAF(1),VFR(1),o[0],0,0,0), C0,8); \
    KRD(GL,1); GAPB(o[1]=__builtin_amdgcn_mfma_f32_32x32x16_bf16(PAF(1),VFR(5),o[1],0,0,0), C0,12); \
    KRD(GL,2); GAPB(o[0]=__builtin_amdgcn_mfma_f32_32x32x16_bf16(PAF(2),VFR(2),o[0],0,0,0), C1,0); \
    KRD(GL,3); GAPB(o[1]=__builtin_amdgcn_mfma_f32_32x32x16_bf16(PAF(2),VFR(6),o[1],0,0,0), C1,4); \
    GAPB(o[0]=__builtin_amdgcn_mfma_f32_32x32x16_bf16(PAF(3),VFR(3),o[0],0,0,0), C1,8); \
    GAPB(o[1]=__builtin_amdgcn_mfma_f32_32x32x16_bf16(PAF(3),VFR(7),o[1],0,0,0), C1,12); \
    }while(0)
  int t=1;
  #undef CMASK
  #define CMASK(P0,P1,t) do{}while(0)
  for(;t+5<NT;t+=2){
    STEP(pB0,pB1,pA0,pA1,t,true,true,true);     WAIT_BAR(2); RESC(); ROT();
    STEP(pA0,pA1,pB0,pB1,t+1,true,true,true);   WAIT_BAR(2); RESC(); ROT();
  }
  #undef CMASK
  #define CMASK(P0,P1,t) do{}while(0)
  #define ENDW(tt) do{ if((tt)+3<NT){WAIT_BAR(2);} else if((tt)+2<NT){WAIT_BAR(1);} else {WAIT_BAR(0);} }while(0)
  for(;t+1<NT;t+=2){
    STEP(pB0,pB1,pA0,pA1,t,(t+3<NT),(t+1<NT),(t+1<NT));       ENDW(t);   RESC(); ROT();
    STEP(pA0,pA1,pB0,pB1,t+1,(t+4<NT),(t+2<NT),(t+2<NT));     ENDW(t+1); RESC(); ROT();
  }
  STEP(pB0,pB1,pA0,pA1,NT-1,false,false,false); RESC();
  { float sacc=pB0[0]+pB0[1]; _Pragma("unroll") for(int r=2;r<16;++r)sacc+=pB0[r]; _Pragma("unroll") for(int r=0;r<16;++r)sacc+=pB1[r]; l_reg+=sacc;
    pw0=(u32x4){PKW(pB0,0),PKW(pB0,2),PKW(pB0,4),PKW(pB0,6)};pw1=(u32x4){PKW(pB0,8),PKW(pB0,10),PKW(pB0,12),PKW(pB0,14)};pw2=(u32x4){PKW(pB1,0),PKW(pB1,2),PKW(pB1,4),PKW(pB1,6)};pw3=(u32x4){PKW(pB1,8),PKW(pB1,10),PKW(pB1,12),PKW(pB1,14)};
    SBAR(); pv(o,vb0+sl_cur,PAF(0),PAF(1),PAF(2),PAF(3)); }
  #undef PKW
  #undef PAF
  #undef VFR
  #undef PIN
  #undef MX3
  #undef GAPA
  #undef GAPB
  #undef EX
  #undef VRD
  #undef KRD
  #undef STEP
  #undef ENDW
  {auto rr=__builtin_amdgcn_permlane32_swap(__float_as_uint(l_reg),__float_as_uint(l_reg),false,false);l_reg=__uint_as_float(rr[0])+__uint_as_float(rr[1]);}
  if(hi==0)wsf[32+r32]=l_reg;asm volatile("s_waitcnt lgkmcnt(0)":::"memory");
  float rli[16];
  #pragma unroll
  for(int r=0;r<16;++r)rli[r]=__builtin_amdgcn_rcpf(wsf[32+crow(r,hi)]);
  bf16*Ow=O+(rowbase+q0+wid*QBLK)*OP+h*D;
  { bf16*stg=(bf16*)(shm+LDS_OST)+wid*2048;
    #pragma unroll
    for(int r=0;r<16;++r){const int orow=crow(r,hi);
      #pragma unroll
      for(int d0=0;d0<2;++d0)stg[orow*64+d0*32+r32]=__float2bfloat16(o[d0][r]*rli[r]);}
    asm volatile("s_waitcnt lgkmcnt(0)":::"memory");
    #pragma unroll
    for(int i=0;i<4;++i){const int row=i*8+(lane>>3),ch=lane&7; const u32x4 v=*(const u32x4*)(stg+row*64+ch*8); ATTN_STORE16(Ow+(long)row*OP+ch*8,v);
      float sq=0.f;
      #pragma unroll
      for(int k=0;k<4;++k){ const float lo=__uint_as_float(v[k]<<16), hi_=__uint_as_float(v[k]&0xffff0000u); sq+=lo*lo+hi_*hi_; }
      sq+=__shfl_xor(sq,1); sq+=__shfl_xor(sq,2); sq+=__shfl_xor(sq,4);
      if(ch==0) ssq[(long)h*(BATCH*SEQ)+rowbase+q0+wid*QBLK+row]=sq; } }
  asm volatile("s_waitcnt lgkmcnt(0)\n\ts_barrier":::"memory");
  #undef DMA_K
  #undef DMA_V
  #undef CMASK
  #undef START
  #undef RESC
  #undef ROT
}
constexpr int ATTN_LDS_BYTES=LDS_BYTES;
struct AttnTensors { const bf16* Q; const bf16* K; const bf16* V; bf16* O; const float* qg; const float* rope; float* ssq; float sbound; };
struct AttnUnit { int bh; int qb; };
struct StaticOrder {
  int vcu;
  __device__ __forceinline__ explicit StaticOrder(int grid,int block):vcu((block%8)*(grid/8)+block/8){}
  __device__ __forceinline__ bool next(int i,AttnUnit&u)const{ if(i>=4)return false; const int pair=vcu>>4, c16=vcu&15; u.bh=(pair>>1)*NHEAD+(pair&1)*4+(c16>>2); u.qb=(c16&3)*4+i; return true; }
  __device__ __forceinline__ void a_ready(const AttnUnit&)const{}
  __device__ __forceinline__ void done(const AttnUnit&)const{}
};
template<class Sched,int THRL=8> __device__ __forceinline__ void attn_phase(char*lds,const AttnTensors&T,const Sched&S){
  AttnUnit u;
  for(int i=0;S.next(i,u);++i){ S.a_ready(u); attn_unit<THRL>(u.bh/NHEAD,u.bh%NHEAD,u.qb,T.Q,T.K,T.V,T.O,lds,T.qg,T.rope,T.ssq,T.sbound); S.done(u); }
}
#undef SBAR
#undef WAIT_BAR
}

constexpr int NWAVES = 8;
constexpr int RING_OFF = 0, RING_BYTES = 131072;
constexpr int LDSCTL_OFF = RING_BYTES, MISC_OFF = LDSCTL_OFF + 320;
constexpr int LDS_BYTES = 147456;
constexpr int CW_BAR = 32768;
constexpr int MAX_LAUNCH = 8;
static_assert((CW_BAR + MAX_LAUNCH * XCD_BAR_WORDS) * 4 <= (int)(1 * MiB), "barrier words inside the memset region");
constexpr size_t WS_WINT = 4 * MiB;
constexpr size_t WS_WOUTT = 9 * MiB;
constexpr size_t WS_SSQ = 13 * MiB;
constexpr size_t WS_RSTD = 3 * MiB + 65536;
constexpr size_t WS_WGU = 16 * MiB;
constexpr size_t WS_WD = 144 * MiB;
constexpr int TAB_OFF = LDSCTL_OFF + 1024;
constexpr int XS_ROWS = NSLOT + 256;

constexpr int PROF_A = -1, PROF_B = -1;
constexpr int CW_PROF = 20000;
constexpr int FP8TEST = 0;
constexpr int NCONV = 136;
constexpr int CW_COUNTS2 = 70000, CW_CURSOR2 = 75000, CW_TILECNT = 90000;
constexpr int HIST_OFF = 49152, POS_OFF = 50176;
constexpr int REP0 = 1, REPG1 = 1, REPG3 = 1, REPATT = 1, REPM1 = 1, REPM2 = 1, REPP1 = 1, REPALL = 1, REPU = 1, REPP5 = 1, DRYQK = 0, DRYAN = 0, DRYSC = 0, DRYFIN = 0, DRYRT = 0;
struct Args { const float* in[21]; float* out; unsigned char* ws; int ph_lo, ph_hi, li, pad; };

struct Frame {
    LAS unsigned char* lds;
    volatile LAS unsigned* MISC;
    int tid, lane, wave, vcu, G;
};

template <bool NT = false>
__device__ __forceinline__ void p0_transpose_item(const float* W, int ldw, int k0, int ns0, bf16* WT, int K, int nd0, LAS float* scr, int lane) {
    if (ns0 >= 0) {
        f32x4 v[8];
#pragma unroll
        for (int i = 0; i < 8; ++i) { const GAS f32x4* p = (const GAS f32x4*)(W + (size_t)(k0 + 8 * i + (lane >> 3)) * ldw + ns0 + (lane & 7) * 4); v[i] = NT ? __builtin_nontemporal_load(p) : *p; }
#pragma unroll
        for (int i = 0; i < 8; ++i) { LAS float* p = scr + (8 * i + (lane >> 3)) * 33 + (lane & 7) * 4; p[0] = v[i].x; p[1] = v[i].y; p[2] = v[i].z; p[3] = v[i].w; }
    } else {
#pragma unroll 8
        for (int i = 0; i < 32; ++i) { const int kk = 2 * i + (lane >> 5); scr[kk * 33 + (lane & 31)] = 0.f; }
    }
    LDS_WAIT(); asm volatile("" ::: "memory");
    const int c = lane & 7;
#pragma unroll
    for (int j = 0; j < 4; ++j) { const int n = (lane >> 3) + 8 * j; const LAS float* s = scr + (8 * c) * 33 + n;
        v4u o; o.x = pk2(s[0 * 33], s[1 * 33]); o.y = pk2(s[2 * 33], s[3 * 33]); o.z = pk2(s[4 * 33], s[5 * 33]); o.w = pk2(s[6 * 33], s[7 * 33]);
        GAS v4u* q = (GAS v4u*)(WT + (size_t)(nd0 + n) * K + k0 + 8 * c); if (NT) __builtin_nontemporal_store(o, q); else *q = o; }
    LDS_WAIT(); asm volatile("" ::: "memory");
}

__device__ __forceinline__ void p0_transpose_item_wout(const float* W, int k0, int ns0, bf16* WT, const float* again, LAS float* scr, int lane) {
    f32x4 v[8];
#pragma unroll
    for (int i = 0; i < 8; ++i) { const int k = k0 + 8 * i + (lane >> 3); v[i] = *(const GAS f32x4*)(W + (size_t)k * D + ns0 + (lane & 7) * 4); if (k0 >= 512) v[i] = v[i] * again[k - 512]; }
#pragma unroll
    for (int i = 0; i < 8; ++i) { LAS float* p = scr + (8 * i + (lane >> 3)) * 33 + (lane & 7) * 4; p[0] = v[i].x; p[1] = v[i].y; p[2] = v[i].z; p[3] = v[i].w; }
    LDS_WAIT(); asm volatile("" ::: "memory");
    const int c = lane & 7, kd0 = (k0 + 512) & 1023;
#pragma unroll
    for (int j = 0; j < 4; ++j) { const int n = (lane >> 3) + 8 * j; const LAS float* sp = scr + (8 * c) * 33 + n;
        v4u o; o.x = pk2(sp[0 * 33], sp[1 * 33]); o.y = pk2(sp[2 * 33], sp[3 * 33]); o.z = pk2(sp[4 * 33], sp[5 * 33]); o.w = pk2(sp[6 * 33], sp[7 * 33]);
        *(GAS v4u*)(WT + (size_t)(ns0 + n) * D + kd0 + 8 * c) = o; }
    LDS_WAIT(); asm volatile("" ::: "memory");
}
struct ConvItem { const float* W; int ldw, k0, ns0; bf16* WT; int K, nd0; };
__device__ __forceinline__ void conv_load(const ConvItem& it, f32x4 (&v)[8], int lane) {
#pragma unroll
    for (int i = 0; i < 8; ++i) v[i] = __builtin_nontemporal_load((const GAS f32x4*)(it.W + (size_t)(it.k0 + 8 * i + (lane >> 3)) * it.ldw + it.ns0 + (lane & 7) * 4));
}
__device__ __forceinline__ void conv_finish(const ConvItem& it, const f32x4 (&v)[8], LAS float* scr, int lane) {
#pragma unroll
    for (int i = 0; i < 8; ++i) { LAS float* p = scr + (8 * i + (lane >> 3)) * 33 + (lane & 7) * 4; p[0] = v[i].x; p[1] = v[i].y; p[2] = v[i].z; p[3] = v[i].w; }
    LDS_WAIT(); asm volatile("" ::: "memory");
    const int c = lane & 7;
#pragma unroll
    for (int j = 0; j < 4; ++j) { const int n = (lane >> 3) + 8 * j; const LAS float* s = scr + (8 * c) * 33 + n;
        v4u o; o.x = pk2(s[0 * 33], s[1 * 33]); o.y = pk2(s[2 * 33], s[3 * 33]); o.z = pk2(s[4 * 33], s[5 * 33]); o.w = pk2(s[6 * 33], s[7 * 33]);
        __builtin_nontemporal_store(o, (GAS v4u*)(it.WT + (size_t)(it.nd0 + n) * it.K + it.k0 + 8 * c)); }
    LDS_WAIT(); asm volatile("" ::: "memory");
}
__device__ __forceinline__ ConvItem conv_item(int it, const float* wgate, const float* wup, const float* wdown, bf16* WguT, bf16* WdT) {
    constexpr int I_GU = NEXP * (D / 64) * (1024 / 32);
    ConvItem c;
    if (it < I_GU) { const int e = it >> 9, q = it & 511, kb = q >> 5, nb = q & 31, pn = nb >> 3, bj = (nb >> 2) & 1, c0 = (nb & 3) * 32;
        c.W = (bj ? wup : wgate) + (size_t)e * D * DEXP; c.ldw = DEXP; c.k0 = kb * 64; c.ns0 = pn * 128 + c0; c.WT = WguT + (size_t)e * 1024 * D; c.K = D; c.nd0 = nb * 32; }
    else { const int r = it - I_GU, e = r >> 8, q = r & 255, kb = q >> 5, nb = q & 31;
        c.W = wdown + (size_t)e * DEXP * D; c.ldw = D; c.k0 = kb * 64; c.ns0 = nb * 32; c.WT = WdT + (size_t)e * 1024 * DEXP; c.K = DEXP; c.nd0 = nb * 32; }
    return c;
}

__device__ __forceinline__ unsigned pk4_i8(float a, float b, float c, float d) {
    const int ia = __float2int_rn(a), ib = __float2int_rn(b), ic = __float2int_rn(c), id = __float2int_rn(d);
    return ((unsigned)ia & 0xffu) | (((unsigned)ib & 0xffu) << 8) | (((unsigned)ic & 0xffu) << 16) | ((unsigned)id << 24);
}
__device__ __forceinline__ void conv_colblock_i8g(const float* Wsrc, int ldw, unsigned char* out, float* sw32, LAS unsigned char* lds, int wave, int lane) {
    const float* W = Wsrc + (lane & 7) * 4;
    const int DEXP_ = ldw;
    LAS float* pmax = (LAS float*)(lds + 69632);
    f32x4 v[2][8];
#pragma unroll
    for (int q = 0; q < 2; ++q)
#pragma unroll
        for (int i = 0; i < 8; ++i) v[q][i] = Wsrc ? __builtin_nontemporal_load((const GAS f32x4*)(W + (size_t)((2 * wave + q) * 64 + 8 * i + (lane >> 3)) * DEXP_)) : (f32x4){0.f, 0.f, 0.f, 0.f};
    float mx[4] = {0.f, 0.f, 0.f, 0.f};
#pragma unroll
    for (int q = 0; q < 2; ++q)
#pragma unroll
        for (int i = 0; i < 8; ++i) { mx[0] = fmaxf(mx[0], fabsf(v[q][i].x)); mx[1] = fmaxf(mx[1], fabsf(v[q][i].y)); mx[2] = fmaxf(mx[2], fabsf(v[q][i].z)); mx[3] = fmaxf(mx[3], fabsf(v[q][i].w)); }
#pragma unroll
    for (int j = 0; j < 4; ++j) { mx[j] = fmaxf(mx[j], __shfl_xor(mx[j], 8)); mx[j] = fmaxf(mx[j], __shfl_xor(mx[j], 16)); mx[j] = fmaxf(mx[j], __shfl_xor(mx[j], 32)); }
    if (lane < 8) *(LAS f32x4*)(pmax + wave * 32 + lane * 4) = (f32x4){mx[0], mx[1], mx[2], mx[3]};
    __syncthreads();
#pragma unroll
    for (int w2 = 0; w2 < 8; ++w2) { const f32x4 m = *(const LAS f32x4*)(pmax + w2 * 32 + (lane & 7) * 4); mx[0] = fmaxf(mx[0], m.x); mx[1] = fmaxf(mx[1], m.y); mx[2] = fmaxf(mx[2], m.z); mx[3] = fmaxf(mx[3], m.w); }
    float inv[4];
#pragma unroll
    for (int j = 0; j < 4; ++j) inv[j] = mx[j] > 0.f ? 127.f / mx[j] : 0.f;
    if (wave == 0 && lane < 8) *(GAS f32x4*)(sw32 + lane * 4) = (f32x4){mx[0] * (1.f / 127.f), mx[1] * (1.f / 127.f), mx[2] * (1.f / 127.f), mx[3] * (1.f / 127.f)};
    LAS float* scr = (LAS float*)(lds + wave * 8448);
#pragma unroll
    for (int q = 0; q < 2; ++q) {
#pragma unroll
        for (int i = 0; i < 8; ++i) { LAS float* p = scr + (8 * i + (lane >> 3)) * 33 + (lane & 7) * 4; p[0] = v[q][i].x * inv[0]; p[1] = v[q][i].y * inv[1]; p[2] = v[q][i].z * inv[2]; p[3] = v[q][i].w * inv[3]; }
        LDS_WAIT(); asm volatile("" ::: "memory");
        { const int n = lane >> 1, hf = lane & 1; const LAS float* sp = scr + (32 * hf) * 33 + n; unsigned w[8];
#pragma unroll
          for (int r = 0; r < 8; ++r) w[r] = pk4_i8(sp[(4 * r) * 33], sp[(4 * r + 1) * 33], sp[(4 * r + 2) * 33], sp[(4 * r + 3) * 33]);
          GAS v4u* o = (GAS v4u*)(out + (size_t)n * D + (2 * wave + q) * 64 + 32 * hf); __builtin_nontemporal_store((v4u){w[0], w[1], w[2], w[3]}, o); __builtin_nontemporal_store((v4u){w[4], w[5], w[6], w[7]}, o + 1); }
        LDS_WAIT(); asm volatile("" ::: "memory");
    }
    __syncthreads();
}
__device__ __forceinline__ void conv_colblock_i8(int item  , const float* wgate, const float* wup, unsigned char* Wgu8, float* SW, LAS unsigned char* lds, int wave, int lane) {
    const int e = item >> 5, nb = item & 31, pn = nb >> 3, bj = (nb >> 2) & 1, c0 = (nb & 3) * 32;
    conv_colblock_i8g((bj ? wup : wgate) + (size_t)e * D * DEXP + pn * 128 + c0, DEXP, Wgu8 + ((size_t)e * 1024 + nb * 32) * D, SW + (size_t)e * 1024 + nb * 32, lds, wave, lane);
}
__device__ __forceinline__ void rms_row2_to_i8(int lane, const float* xrow0, const float* gain, unsigned char* o0, float* su0) {
    f32x4 v[2][4]; float ss[2] = {0.f, 0.f};
#pragma unroll
    for (int q = 0; q < 2; ++q)
#pragma unroll
        for (int j = 0; j < 4; ++j) v[q][j] = __builtin_nontemporal_load((const GAS f32x4*)(xrow0 + (size_t)q * D) + j * 64 + lane);
    f32x4 g[4];
#pragma unroll
    for (int j = 0; j < 4; ++j) g[j] = ((const GAS f32x4*)gain)[j * 64 + lane];
#pragma unroll
    for (int q = 0; q < 2; ++q)
#pragma unroll
        for (int j = 0; j < 4; ++j) ss[q] += (v[q][j].x * v[q][j].x + v[q][j].y * v[q][j].y) + (v[q][j].z * v[q][j].z + v[q][j].w * v[q][j].w);
    const bool b0 = lane & 1, b1 = lane & 2;
#pragma unroll
    for (int q = 0; q < 2; ++q) {
        const float rstd = rsqrtf(wave_sum(ss[q]) * (1.f / D) + EPS); float m = 0.f;
#pragma unroll
        for (int j = 0; j < 4; ++j) { v[q][j] = v[q][j] * rstd * g[j]; m = fmaxf(m, fmaxf(fmaxf(fabsf(v[q][j].x), fabsf(v[q][j].y)), fmaxf(fabsf(v[q][j].z), fabsf(v[q][j].w)))); }
#pragma unroll
        for (int o = 1; o < 64; o <<= 1) m = fmaxf(m, __shfl_xor(m, o));
        const float inv = m > 0.f ? 127.f / m : 0.f;
        unsigned w[4], x[4], y[4];
#pragma unroll
        for (int j = 0; j < 4; ++j) w[j] = pk4_i8(v[q][j].x * inv, v[q][j].y * inv, v[q][j].z * inv, v[q][j].w * inv);
#pragma unroll
        for (int p2 = 0; p2 < 2; ++p2) { const unsigned snd = b0 ? w[2 * p2] : w[2 * p2 + 1]; const unsigned rcv = (unsigned)__shfl_xor((int)snd, 1);
            x[2 * p2] = b0 ? rcv : w[2 * p2]; x[2 * p2 + 1] = b0 ? w[2 * p2 + 1] : rcv; }
#pragma unroll
        for (int i = 0; i < 2; ++i) { const unsigned snd = b1 ? x[i] : x[2 + i]; const unsigned rcv = (unsigned)__shfl_xor((int)snd, 2);
            y[i] = b1 ? rcv : x[i]; y[2 + i] = b1 ? x[2 + i] : rcv; }
        *(GAS v4u*)(o0 + (size_t)q * D + (lane & 3) * 256 + (lane >> 2) * 16) = (v4u){y[0], y[1], y[2], y[3]};
        if (lane == 0) su0[q] = m * (1.f / 127.f);
    }
}
__device__ __forceinline__ float wave_sum_x(float v) {
#pragma unroll
    for (int o = 1; o < 64; o <<= 1) v += __shfl_xor(v, o);
    return v;
}
__device__ __forceinline__ void rms_row2_to_bf16(int lane, const float* xrow0, const float* xrow1, const float* gain, bf16* orow0, bf16* orow1) {
    const GAS f32x4* xa = (const GAS f32x4*)xrow0 + lane; const GAS f32x4* xb = (const GAS f32x4*)xrow1 + lane;
    f32x4 va[4], vb[4]; float sa = 0.f, sb = 0.f;
#pragma unroll
    for (int j = 0; j < 4; ++j) { va[j] = __builtin_nontemporal_load(xa + 64 * j); vb[j] = __builtin_nontemporal_load(xb + 64 * j); }
#pragma unroll
    for (int j = 0; j < 4; ++j) { sa += (va[j].x * va[j].x + va[j].y * va[j].y) + (va[j].z * va[j].z + va[j].w * va[j].w); sb += (vb[j].x * vb[j].x + vb[j].y * vb[j].y) + (vb[j].z * vb[j].z + vb[j].w * vb[j].w); }
    const float ra = rsqrtf(wave_sum_x(sa) * (1.f / D) + EPS), rb = rsqrtf(wave_sum_x(sb) * (1.f / D) + EPS);
    GAS unsigned long long* oa = (GAS unsigned long long*)orow0 + lane; GAS unsigned long long* ob = (GAS unsigned long long*)orow1 + lane;
#pragma unroll
    for (int j = 0; j < 4; ++j) { const f32x4 g = ((const GAS f32x4*)gain)[64 * j + lane];
        oa[64 * j] = (unsigned long long)pk2(va[j].x * ra * g.x, va[j].y * ra * g.y) | ((unsigned long long)pk2(va[j].z * ra * g.z, va[j].w * ra * g.w) << 32);
        ob[64 * j] = (unsigned long long)pk2(vb[j].x * rb * g.x, vb[j].y * rb * g.y) | ((unsigned long long)pk2(vb[j].z * rb * g.z, vb[j].w * rb * g.w) << 32); }
}

__global__ void __launch_bounds__(NWAVES * 64, 2) mega(Args args) {
    extern __shared__ __attribute__((aligned(16))) unsigned char lds[];
    Frame F;
    F.lds = (LAS unsigned char*)lds;
    F.MISC = (volatile LAS unsigned*)(F.lds + MISC_OFF);
    F.tid = threadIdx.x; F.lane = F.tid & 63; F.wave = __builtin_amdgcn_readfirstlane(F.tid >> 6);
    F.G = gridDim.x; { const int bx = blockIdx.x; F.vcu = (F.G % 8 == 0) ? (bx % 8) * (F.G / 8) + bx / 8 : bx; }
    unsigned char* ws = args.ws;
    gu32* ctl = (gu32*)(ws + WS_CTL);
    for (int u = F.tid; u < (LDS_BYTES - LDSCTL_OFF) / 4; u += NWAVES * 64) ((LAS unsigned*)(F.lds + LDSCTL_OFF))[u] = 0u;
    __syncthreads();
    XcdBarrier bar = xcd_barrier_post((unsigned*)(ctl + CW_BAR) + args.li * XCD_BAR_WORDS, F.MISC + 8);
    const int lo = args.ph_lo, hi = args.ph_hi;
#define IN(k) (lo <= (k) && (k) < hi)
#define BOTH(k) (IN(k) && IN((k) + 1))
#define GRID_BAR() xcd_barrier(bar)
    unsigned long long tprev = 0; if (PROF_A >= 0 && blockIdx.x == 0 && F.tid == 0) tprev = rt();
#define STAMP(k) do { if (PROF_A >= 0 && blockIdx.x == 0 && F.tid == 0) { const unsigned long long now_ = rt(); __hip_atomic_store(ctl + CW_PROF + (k), (unsigned)(now_ - tprev), RLX_AGENT); tprev = now_; } } while (0)
    const float* x = args.in[0];
    bf16* U = (bf16*)(ws + WS_U); bf16* PROJ = (bf16*)(ws + WS_PROJ); bf16* WinT = (bf16*)(ws + WS_WINT);
    const int gw = F.vcu * NWAVES + F.wave, NGW = F.G * NWAVES;

    const int gtid = (int)blockIdx.x * (NWAVES * 64) + F.tid, nthr = F.G * NWAVES * 64;
    const int half = F.tid >> 8, t256 = F.tid & 255, bx = (int)blockIdx.x;
    unsigned* ctlp = (unsigned*)(ws + WS_CTL); unsigned* tokinfo = (unsigned*)(ws + WS_TOKINFO); int* tokslot = (int*)(ws + WS_TOKSLOT); int* slottok = (int*)(ws + WS_SLOTTOK);
    float* slotgate = (float*)(ws + WS_SLOTGATE); float* rope = (float*)(ws + WS_ROPE);
    bf16* KVS = (bf16*)(ws + WS_G); float* DEC = (float*)(ws + WS_DEC); float* SSQ = (float*)(ws + WS_SSQ);
    float* RSTD = (float*)(ws + WS_RSTD); bf16* WguT = (bf16*)(ws + WS_WGU); bf16* WdT = (bf16*)(ws + WS_WD); bf16* XS = (bf16*)(ws + WS_PROJ);
    float* RATT = (float*)(ws + 15 * MiB + 512 * 1024); bf16* HB = (bf16*)(ws + 80 * MiB);
    unsigned char* U8 = ws + WS_U; unsigned char* Win8 = ws + WS_WINT; float* SUS = (float*)(ws + 14 * MiB + 512 * 1024); float* SWIN = (float*)(ws + 14 * MiB + 768 * 1024);
    unsigned char* Wgu8 = ws + WS_WGU; float* SWS = (float*)(ws + 14 * MiB); float* SAS = (float*)(ws + 15 * MiB); unsigned char* XS8 = ws + WS_PROJ;
    LAS int* tab = (LAS int*)(F.lds + TAB_OFF); LAS int* t_cnt = tab; LAS int* t_offs = tab + 64; LAS int* t_e = tab + 144; LAS int* t_r0 = tab + 464; LAS int* t_nr = tab + 784; LAS int* t_n = tab + 1104;
    bf16* HMID = (bf16*)(ws + WS_G); unsigned char* YS8 = ws + WS_PROJ + 64 * MiB; float* YSC = (float*)(ws + WS_PROJ + 128 * MiB);   bf16* WoutT = (bf16*)(ws + WS_WOUTT);

    if (IN(0)) {
        LAS float* scr = (LAS float*)(F.lds + RING_OFF + F.wave * 16384);
        constexpr int I_WOUT = (D / 64) * (D / 32);
        const int gb = bx * NWAVES + F.wave;
        if (F.G == 256) { const int it = gb - (2048 - I_WOUT); if (it >= 0) { const int kb = it / (D / 32), nb = it % (D / 32); p0_transpose_item_wout(args.in[11], kb * 64, nb * 32, WoutT, args.in[10], scr, F.lane); } }
        else for (int it = gw; it < I_WOUT; it += NGW) { const int kb = it / (D / 32), nb = it % (D / 32); p0_transpose_item_wout(args.in[11], kb * 64, nb * 32, WoutT, args.in[10], scr, F.lane); }
        __syncthreads();
        for (int nb = bx; nb < PW / 32; nb += F.G) { const int cs = proj_src_col(nb * 32);
            conv_colblock_i8g(cs < 0 ? nullptr : args.in[2] + cs, DIN, Win8 + (size_t)nb * 32 * D, SWIN + nb * 32, F.lds + RING_OFF, F.wave, F.lane); }
        router_build_bfrag(gtid, nthr, args.in[13], args.in[15], args.in[12], (bf16*)(ws + WS_BFRAG));
        if (F.G == 256) {
            for (int i = 0; i < 6; ++i) { const int m = 2 * (gb + 2048 * i); rms_row2_to_i8(F.lane, x + (size_t)m * D, args.in[1], U8 + (size_t)m * D, SUS + m); }
            if (bx >= PW / 32) for (int j = gb - (PW / 32) * NWAVES; j < 4096; j += 2048 - (PW / 32) * NWAVES) { const int m = 2 * (12288 + j); rms_row2_to_i8(F.lane, x + (size_t)m * D, args.in[1], U8 + (size_t)m * D, SUS + m); }
        } else
        for (int rep = 0; rep < REPU; ++rep) for (int m = 2 * gw; m < NTOK; m += 2 * NGW) rms_row2_to_i8(F.lane, x + (size_t)m * D, args.in[1], U8 + (size_t)m * D, SUS + m);
        { if (gtid < 1024) { const int pos = gtid >> 4, j = gtid & 15; const float ang = (float)pos * powf(10000.0f, -(float)(2 * j) / 32.0f); rope[gtid] = cosf(ang); rope[1024 + gtid] = sinf(ang); } }
        if (BOTH(0)) GRID_BAR();
        STAMP(0);
    }
    if (IN(1)) {
        const int rk = bx >> 3, xg = bx & 7; constexpr int NGE = 32 - NCONV / 8;
        if (F.G != 256 || rk < NGE) {
            pg8::Gemm g{(const pg8::bf16_t*)U8, (const pg8::bf16_t*)Win8, NTOK, PW, D}; pg8::StaticOrder S;
            if (F.G == 256) S.init(NTOK, PW, NGE * 8, rk * 8 + xg); else S.init(NTOK, PW, F.G, bx);
            pg8::EpiBf16_I8 E{PROJ, PW, SUS, SWIN, DIN};
            for (int rep = 0; rep < REPP1; ++rep) pg8::gemm_phase<pg8::EpiBf16_I8, pg8::StaticOrder, true, true, false, true>(F.lds + RING_OFF, g, S, E);
        }
        if (F.G != 256 || rk >= NGE) {
            LAS float* scr = (LAS float*)(F.lds + RING_OFF + F.wave * 16384);
            constexpr int I_GU = NEXP * (D / 64) * (1024 / 32), I_DN = NEXP * (DEXP / 64) * (D / 32);
            const int cw = (F.G == 256) ? ((rk - NGE) * 8 + xg) * NWAVES + F.wave : gw, NCW = (F.G == 256) ? NCONV * NWAVES : NGW;
            for (int rep = 0; rep < REP0; ++rep) {
                { const int cwg = (F.G == 256) ? (rk - NGE) * 8 + xg : bx, NWG = (F.G == 256) ? NCONV : F.G;
                  for (int it = cwg; it < NEXP * 32; it += NWG) conv_colblock_i8(it, args.in[17], args.in[18], Wgu8, SWS, F.lds + RING_OFF, F.wave, F.lane); }
                const int base_ = I_DN / NCW, rem_ = I_DN % NCW, lo_ = NCW - rem_;
                const int dn = base_ + (cw >= lo_ ? 1 : 0), d0 = cw < lo_ ? cw * base_ : lo_ * base_ + (cw - lo_) * (base_ + 1);
                f32x4 va[8], vb[8]; ConvItem ia, ib;
                int k = 0;
                if (k < dn) { ia = conv_item(I_GU + d0 + k, args.in[17], args.in[18], args.in[19], WguT, WdT); conv_load(ia, va, F.lane); }
                for (; k < dn; k += 2) {
                    const bool hb = k + 1 < dn, ha = k + 2 < dn;
                    if (hb) { ib = conv_item(I_GU + d0 + k + 1, args.in[17], args.in[18], args.in[19], WguT, WdT); conv_load(ib, vb, F.lane); }
                    conv_finish(ia, va, scr, F.lane);
                    if (ha) { ia = conv_item(I_GU + d0 + k + 2, args.in[17], args.in[18], args.in[19], WguT, WdT); conv_load(ia, va, F.lane); }
                    if (hb) conv_finish(ib, vb, scr, F.lane);
                }
            }
        }
        if (BOTH(1)) GRID_BAR();
        STAMP(1);
    }
    if (IN(2)) {
        for (int rep = 0; rep < REPG1; ++rep) gla_g1_phase(F.lds + RING_OFF, F.tid, bx, PROJ, args.in[3], args.in[4], args.in[5], args.in[6], KVS, DEC);
        if (DRYQK) ph_qk_prep(gw, NGW, F.lane, PROJ, args.in[8], args.in[9], rope, U, D);
        ph_qk_prep(gw, NGW, F.lane, PROJ, args.in[8], args.in[9], rope, PROJ + C_AQ, PW);
        if (BOTH(2)) GRID_BAR();
        STAMP(2);
    }
    if (IN(3)) {
        gla_g2_scan(gtid, nthr, KVS, DEC);
        __syncthreads();
        float sb_; { float mq = 0.f, mk = 0.f;
#pragma unroll 8
          for (int i = 0; i < 64; ++i) { mq = fmaxf(mq, fabsf(args.in[8][i])); mk = fmaxf(mk, fabsf(args.in[9][i])); }
          sb_ = 64.f * mq * mk * attn_body::C2 * 1.02f; }
        { const attn_body::AttnTensors AT{(const attn_body::bf16*)(PROJ + C_AQ), (const attn_body::bf16*)(PROJ + C_AK), (const attn_body::bf16*)(PROJ + C_AV), (attn_body::bf16*)(U), args.in[8], rope, SSQ, sb_};
          const attn_body::StaticOrder S((int)F.G, bx);
          for (int rep = 0; rep < REPATT; ++rep) attn_body::attn_phase<attn_body::StaticOrder>((char*)lds + RING_OFF, AT, S); }
        if (BOTH(3)) GRID_BAR();
        STAMP(3);
    }
    if (IN(4)) {
        for (int rep = 0; rep < REPG3; ++rep) gla_g3_phase(F.lds + RING_OFF, F.tid, bx, PROJ, args.in[3], args.in[4], args.in[5], args.in[6], KVS, args.in[7], U, SSQ, RATT);
        if (BOTH(4)) GRID_BAR();
        STAMP(4);
    }
    if (IN(5)) {
        pg8::Gemm g{U, WoutT, NTOK, D, D}; pg8::StaticOrder S; S.init(NTOK, D, F.G, bx);
        pg8::EpiBf16Res E{HB, x, D, RATT};
        for (int rep = 0; rep < REPP5; ++rep) pg8::gemm_phase<pg8::EpiBf16Res, pg8::StaticOrder, true, true>(F.lds + RING_OFF, g, S, E);
        if (BOTH(5)) GRID_BAR();
        STAMP(5);
    }
    if (IN(6)) {
        LAS int* hist = (LAS int*)(F.lds + HIST_OFF);
        if (F.tid < 64) hist[F.tid] = 0;
        __syncthreads();
        ph_router_lds(F.vcu, F.G, F.wave, F.lane, F.lds + RING_OFF, HB, (const bf16*)(ws + WS_BFRAG), args.in[14], args.in[16], RSTD, tokinfo, hist, false);
        if (DRYRT) ph_router_lds(F.vcu, F.G, F.wave, F.lane, F.lds + RING_OFF, HB, (const bf16*)(ws + WS_BFRAG), args.in[14], args.in[16], RSTD, tokinfo, hist, true);
        __syncthreads();
        if (F.tid < 64) { const int c = hist[F.tid]; if (c) atomicAdd(ctlp + CW_COUNTS2 + 64 * F.tid, (unsigned)c); }
        if (IN(6) && IN(8)) GRID_BAR();
        STAMP(6);
    }
    if (IN(8)) {
        LAS int* hist = (LAS int*)(F.lds + HIST_OFF); LAS int* gbase = hist + 64; LAS int* tbase = hist + 128; LAS int* pos = (LAS int*)(F.lds + POS_OFF);
        if (F.tid < 64) { t_cnt[F.tid] = (int)__hip_atomic_load(ctl + CW_COUNTS2 + 64 * F.tid, RLX_AGENT); hist[F.tid] = 0; }
        __syncthreads();
        if (F.tid == 0) { int off = 0, nt = 0;
            for (int e = 0; e < NEXP; ++e) { const int c = t_cnt[e]; t_offs[e] = off; tbase[e] = nt; off += c; nt += (c + 255) >> 8; }
            t_offs[NEXP] = off; t_n[0] = nt; }
        uint4 ti = make_uint4(0, 0, 0, 0); int r0 = 0, r1 = 0;
        if (F.tid < 128) { ti = ((const uint4*)tokinfo)[bx * 128 + F.tid];
            r0 = __hip_atomic_fetch_add(hist + ti.x, 1, __ATOMIC_RELAXED, __HIP_MEMORY_SCOPE_WORKGROUP); r1 = __hip_atomic_fetch_add(hist + ti.y, 1, __ATOMIC_RELAXED, __HIP_MEMORY_SCOPE_WORKGROUP); }
        __syncthreads();
        if (F.tid < 64) { const int e = F.tid, c = t_cnt[e], nt0 = tbase[e], o0 = t_offs[e];
            for (int r = 0, k = 0; r < c; r += 256, ++k) { t_e[nt0 + k] = e; t_r0[nt0 + k] = o0 + r; t_nr[nt0 + k] = (c - r) < 256 ? (c - r) : 256; }
            const int hc = hist[e]; gbase[e] = hc ? (int)atomicAdd(ctlp + CW_CURSOR2 + 64 * e, (unsigned)hc) : 0; }
        __syncthreads();
        if (F.tid < 128) { const int t = bx * 128 + F.tid; const int p0 = t_offs[ti.x] + gbase[ti.x] + r0, p1 = t_offs[ti.y] + gbase[ti.y] + r1;
            pos[2 * F.tid] = p0; pos[2 * F.tid + 1] = p1; tokslot[2 * t] = p0; tokslot[2 * t + 1] = p1; slotgate[p0] = __uint_as_float(ti.z); slotgate[p1] = __uint_as_float(ti.w); }
        __syncthreads();
        ph_copy_xs_i8(bx, F.wave, F.lane, pos, HB, RSTD, args.in[12], XS8, SAS);
        if (DRYSC) ph_copy_xs_i8(bx, F.wave, F.lane, pos, HB, RSTD, args.in[12], XS8, SAS);
        if (BOTH(8)) GRID_BAR();
        STAMP(8);
    }
    if (IN(9)) {
        pg8::Gemm g{(const pg8::bf16_t*)XS8, (const pg8::bf16_t*)Wgu8, XS_ROWS, 1024, D};
        pg8::GroupedOrderPub S{t_e, t_r0, t_nr, __builtin_amdgcn_readfirstlane(t_n[0]) * 4, F.G, F.vcu, (size_t)D, (size_t)1024 * D, ctlp + CW_TILECNT};
        pg8::EpiSwiGLU_I8<true> E{HMID, SAS, SWS};
        pg8::gemm_phase<pg8::EpiSwiGLU_I8<true>, pg8::GroupedOrderPub, true, true, false, true>(F.lds + RING_OFF, g, S, E);
        STAMP(9);
    }
    if (IN(10)) {
        pg8::Gemm g{HMID, WdT, XS_ROWS, 1024, DEXP};
        pg8::GroupedOrderDep S{t_e, t_r0, t_nr, __builtin_amdgcn_readfirstlane(t_n[0]) * 4, F.G, F.vcu, (size_t)1024 * DEXP * 2, ctlp + CW_TILECNT};
        pg8::EpiYs8 E{YS8, YSC, slotgate};
        pg8::gemm_phase<pg8::EpiYs8, pg8::GroupedOrderDep, true, true, true>(F.lds + RING_OFF, g, S, E);
        if (BOTH(10)) GRID_BAR();
        STAMP(10);
    }
    if (IN(11)) { if (DRYFIN) ph_final(gw, NGW, F.lane, HB, YS8, YSC, tokslot, args.in[20], (float*)(ws + WS_U), (float*)(ws + WS_G));
        ph_final(gw, NGW, F.lane, HB, YS8, YSC, tokslot, args.in[20], args.out, args.out + (size_t)(NTOK / 2) * D); }
    if (PROF_A >= 0) {
        GRID_BAR(); STAMP(11); GRID_BAR();
        const float ta = (float)__hip_atomic_load(ctl + CW_PROF + PROF_A, RLX_AGENT) * 0.01f;
        const float tb = (float)__hip_atomic_load(ctl + CW_PROF + (PROF_B >= 0 ? PROF_B : 0), RLX_AGENT) * 0.01f;
        const float kf = 0.002f * sqrtf(ta);
        for (size_t i = (size_t)gtid; i < (size_t)NTOK * D; i += (size_t)nthr) args.out[i] += (i == 0 && PROF_B >= 0) ? (1.f + tb * 0.01f) : kf;
    }
    if (FP8TEST) {
        GRID_BAR();
        if (bx == 0 && F.wave == 0) {
            typedef int v4i_t __attribute__((ext_vector_type(4)));
            const int l = F.lane, r16 = l & 15, kg = l >> 4;
            auto av = [](int i, int k) { return ((i * 7 + k * 3) % 11) - 5; };
            auto bvv = [](int k, int j) { return ((k * 5 + j * 11) % 13) - 6; };
            v4i_t A, B;
#pragma unroll
            for (int rg = 0; rg < 4; ++rg) { unsigned wa = 0, wb = 0;
#pragma unroll
                for (int by = 0; by < 4; ++by) { const int k = 16 * kg + 4 * rg + by; wa |= ((unsigned)av(r16, k) & 0xffu) << (8 * by); wb |= ((unsigned)bvv(k, r16) & 0xffu) << (8 * by); }
                A[rg] = (int)wa; B[rg] = (int)wb; }
            v4i_t acc = {0, 0, 0, 0};
            acc = __builtin_amdgcn_mfma_i32_16x16x64_i8(A, B, acc, 0, 0, 0);
            bool ok = true;
#pragma unroll
            for (int r = 0; r < 4; ++r) { const int row = 4 * kg + r; int sm = 0; for (int k = 0; k < 64; ++k) sm += av(row, k) * bvv(k, r16); ok = ok && (acc[r] == sm + (FP8TEST == 2 ? 1 : 0)); }
            if (!__all(ok) && l == 0) args.out[0] = __builtin_nanf("");
        }
    }
#undef IN
#undef BOTH
#undef GRID_BAR
}

static int g_grid = 0;
static void launch_mega(void* const* d_in, void* d_out, void* d_ws, hipStream_t stream, int lo, int hi, int li) {
    Args a{};
    for (int i = 0; i < 21; ++i) a.in[i] = (const float*)d_in[i];
    a.out = (float*)d_out; a.ws = (unsigned char*)d_ws; a.ph_lo = lo; a.ph_hi = hi; a.li = li; a.pad = 0;
    void* kargs[] = {&a};
    hipError_t e = hipLaunchCooperativeKernel((const void*)mega, dim3(g_grid), dim3(NWAVES * 64), kargs, LDS_BYTES, stream);
    if (e != hipSuccess) fprintf(stderr, "cooperative launch failed: %s (grid %d)\n", hipGetErrorString(e), g_grid);
}
extern "C" void kernel_launch(void* const* d_in, const int* in_sizes, int n_in, void* d_out, int out_size, void* d_ws, size_t ws_size, hipStream_t stream) {
    if (g_grid == 0) {
        int dev = 0, cus = 0, per_cu = 0;
        (void)hipGetDevice(&dev); (void)hipDeviceGetAttribute(&cus, hipDeviceAttributeMultiprocessorCount, dev);
        (void)hipFuncSetAttribute((const void*)mega, hipFuncAttributeMaxDynamicSharedMemorySize, LDS_BYTES);
        (void)hipOccupancyMaxActiveBlocksPerMultiprocessor(&per_cu, (const void*)mega, NWAVES * 64, LDS_BYTES);
        if (per_cu < 1) per_cu = 1;
        if (per_cu > 1) per_cu = 1;
        g_grid = cus * per_cu;
    }
    (void)hipMemsetAsync((char*)d_ws + WS_CTL, 0, 1 * MiB, stream);
    launch_mega(d_in, d_out, d_ws, stream, 0, 12, 0);
}
```

```cpp
#include <hip/hip_runtime.h>
#include <stdint.h>
#include <math.h>

constexpr int NB = 8, T = 4096, D = 1024, NTOK = NB * T;
constexpr int DIN = 2336;
constexpr int PW = 2560;
constexpr int C_GQ = 0, C_GK = 256, C_GV = 512, C_GG = 1024, C_AQ = 1536, C_AK = 2048, C_AV = 2176, C_ZF = 2304, C_ZB = 2320;
constexpr int NEXP = 64, DEXP = 512, NSLOT = 2 * NTOK;
constexpr float EPS = 1e-6f;

typedef unsigned short bf16_t;

constexpr size_t MiB = 1u << 20;
constexpr size_t WS_CTL = 0;
constexpr size_t WS_TOKINFO = 1 * MiB;
constexpr size_t WS_TOKSLOT = 1 * MiB + 512 * 1024;
constexpr size_t WS_SLOTTOK = 2 * MiB;
constexpr size_t WS_SLOTGATE = 2 * MiB + 256 * 1024;
constexpr size_t WS_ROPE = 3 * MiB;
constexpr size_t WS_LAF = 16 * MiB;
constexpr size_t WS_LAB = 48 * MiB;
constexpr size_t WS_OF = 80 * MiB;
constexpr size_t WS_OB = 144 * MiB;
constexpr size_t WS_U = 208 * MiB;
constexpr size_t WS_PROJ = 272 * MiB;
constexpr size_t WS_G = 432 * MiB;
constexpr int CW_COUNTS = 0, CW_CURSOR = 64, CW_OFFS = 128, CW_NTILES = 256, CW_TILE_E = 1024, CW_TILE_R0 = 4096, CW_TILE_NR = 8192;

__device__ __forceinline__ float bf2f(bf16_t v) { return __uint_as_float(((unsigned)v) << 16); }
__device__ __forceinline__ bf16_t f2bf(float f) { unsigned u = __float_as_uint(f); return (bf16_t)((u + 0x7fffu + ((u >> 16) & 1u)) >> 16); }
__device__ __forceinline__ float wave_sum(float v) {
#pragma unroll
    for (int o = 1; o < 64; o <<= 1) v += __shfl_xor(v, o);
    return v;
}
__device__ __forceinline__ float silu_f(float x) { return x / (1.f + expf(-x)); }


__device__ __forceinline__ float4 ld_bf4(const bf16_t* p) { const ushort4 u = *(const ushort4*)p; return make_float4(bf2f(u.x), bf2f(u.y), bf2f(u.z), bf2f(u.w)); }
__device__ __forceinline__ void st_bf4(bf16_t* p, float4 v) { ushort4 o; o.x = f2bf(v.x); o.y = f2bf(v.y); o.z = f2bf(v.z); o.w = f2bf(v.w); *(ushort4*)p = o; }
__host__ __device__ __forceinline__ int proj_src_col(int cd) {
    if (cd < 1536) return cd;
    if (cd < 2048) return 1568 + (cd - 1536);
    if (cd < 2176) return 2080 + (cd - 2048);
    if (cd < 2304) return 2208 + (cd - 2176);
    if (cd < 2336) return 1536 + (cd - 2304);
    return -1;
}
#include <cstdio>
namespace pg8 {
#define PG8_LAS __attribute__((address_space(3)))
typedef unsigned short bf16_t;
typedef short bf16x8 __attribute__((ext_vector_type(8)));
typedef float f32x4 __attribute__((ext_vector_type(4)));
typedef unsigned u32x4 __attribute__((ext_vector_type(4)));
constexpr int BM = 256, BK = 64, HALF = 128, HTB = HALF * BK * 2  , STAGE_BYTES = 8 * HTB, NXCD = 8, WGM = 8;

__host__ __device__ __forceinline__ int lds_byte(int r, int c) { return r * 128 + ((((c >> 3)) ^ ((r >> 1) & 7)) << 4) + (c & 7) * 2; }
__host__ __device__ __forceinline__ void stage_rc(int b, int& R, int& C) { R = b >> 7; C = ((((b >> 4) & 7) ^ ((R >> 1) & 7)) << 3); }
__host__ __device__ __forceinline__ int perm32(int rho) { const int n = rho >> 4, i = rho & 15; return 8 * (i >> 2) + 4 * n + (i & 3); }

typedef int i32x4 __attribute__((ext_vector_type(4)));
struct Unit { int pm, pn, row0, nr, e; unsigned rdy; };
struct Gemm { const bf16_t* A; const bf16_t* Bt; int M, N, K; };

struct StaticOrder {
    int nM, nN, nwg, G, c;
    __host__ __device__ void init(int M, int N, int G_, int c_) { nM = M / BM; nN = N / BM; nwg = nM * nN; G = G_; c = c_; }
    __host__ __device__ bool next(int i, Unit& u) const {
        const long L = (long)i * G + c; if (L >= nwg) return false;
        int wgid = (int)L; { const int q = nwg / NXCD, r = nwg % NXCD, xcd = wgid % NXCD, off = wgid / NXCD; wgid = (xcd < r ? xcd * (q + 1) : r * (q + 1) + (xcd - r) * q) + off; }
        const int nig = WGM * nN, gid = wgid / nig, fm = gid * WGM, gsz = (nM - fm) < WGM ? (nM - fm) : WGM;
        u.pm = fm + ((wgid % nig) % gsz); u.pn = (wgid % nig) / gsz; return true;
    }
    __device__ __forceinline__ size_t a_off(const Unit& u, size_t tstep) const { return (size_t)u.pm * tstep; }
    __device__ __forceinline__ size_t b_off(const Unit& u, size_t tstep) const { return (size_t)u.pn * tstep; }
    __device__ __forceinline__ void a_ready(const Unit&) const {}
    __device__ __forceinline__ void done(const Unit&) const {}
};

__device__ __forceinline__ unsigned cvt_pk_bf16(float lo, float hi) { unsigned r; asm volatile("v_cvt_pk_bf16_f32 %0, %1, %2" : "=v"(r) : "v"(lo), "v"(hi)); return r; }
typedef float f32x2 __attribute__((ext_vector_type(2)));
__device__ __forceinline__ f32x2 gelu_pk(f32x2 v) {
    const f32x2 av = __builtin_elementwise_abs(v), d = av * 0.2316418882f + 1.0f;
    f32x2 t; t.x = __builtin_amdgcn_rcpf(d.x); t.y = __builtin_amdgcn_rcpf(d.y);
    f32x2 q = t * 0.5307027145f + (-0.7265760135f); q = q * t + 0.7107068705f; q = q * t + (-0.142248368f); q = q * t + 0.127414796f; q = q * t;
    const f32x2 s = (v * v) * (-0.72134752044f);
    f32x2 e; e.x = __builtin_amdgcn_exp2f(s.x); e.y = __builtin_amdgcn_exp2f(s.y);
    const f32x2 m = v * (q * e), r = v - m;
    f32x2 o; o.x = v.x < 0.f ? m.x : r.x; o.y = v.y < 0.f ? m.y : r.y; return o;
}

template <int ACT  > struct EpiBf16 {
    static constexpr bool PERM = true, AFTER_DRAIN = false; static_assert(ACT == 0 || ACT == 1, "EpiBf16: ACT is 0 (none) or 1 (gelu_pk)");
    bf16_t* O; int ldc; const float* bias; int split_cols; size_t split_stride; float scale0;
    __device__ __forceinline__ void operator()(const f32x4 (&acc)[2][2][4][2], const Unit& u, int wr, int wc, int fr, int fq) const {
        const int row0 = u.pm * BM + wr * 64 + fr; int colt = u.pn * BM; bf16_t* base = O;
        float sc = 1.f; if (split_cols) { const int t = colt / split_cols; base += (size_t)t * split_stride; colt -= t * split_cols; if (t == 0) sc = scale0; }
        const int col0 = colt + wc * 32 + 8 * fq, bcol0 = u.pn * BM + wc * 32 + 8 * fq;
        f32x4 bv[2][2];
#pragma unroll
        for (int bj = 0; bj < 2; ++bj)
#pragma unroll
            for (int n = 0; n < 2; ++n) bv[bj][n] = bias ? *(const f32x4*)(bias + bcol0 + bj * HALF + 4 * n) : (f32x4){0.f, 0.f, 0.f, 0.f};
#pragma unroll
        for (int ai = 0; ai < 2; ++ai)
#pragma unroll
            for (int m = 0; m < 4; ++m) { bf16_t* rowp = base + (size_t)(row0 + ai * HALF + m * 16) * ldc + col0;
#pragma unroll
                for (int bj = 0; bj < 2; ++bj) { f32x4 v0 = acc[ai][bj][m][0] + bv[bj][0], v1 = acc[ai][bj][m][1] + bv[bj][1];
                    if (ACT == 1) { f32x2 a = gelu_pk((f32x2){v0[0], v0[1]}), b = gelu_pk((f32x2){v0[2], v0[3]}), c = gelu_pk((f32x2){v1[0], v1[1]}), d = gelu_pk((f32x2){v1[2], v1[3]});
                        v0 = (f32x4){a.x, a.y, b.x, b.y}; v1 = (f32x4){c.x, c.y, d.x, d.y}; }
                    v0 = v0 * sc; v1 = v1 * sc; u32x4 w; w.x = cvt_pk_bf16(v0[0], v0[1]); w.y = cvt_pk_bf16(v0[2], v0[3]); w.z = cvt_pk_bf16(v1[0], v1[1]); w.w = cvt_pk_bf16(v1[2], v1[3]);
                    *(u32x4*)(rowp + bj * HALF) = w; } }
    }
};
struct EpiBf16Res {
    static constexpr bool PERM = true, AFTER_DRAIN = false;
    bf16_t* O; const float* R; int ldc; const float* rs;
    __device__ __forceinline__ void operator()(const f32x4 (&acc)[2][2][4][2], const Unit& u, int wr, int wc, int fr, int fq) const {
        const int row0 = u.pm * BM + wr * 64 + fr, col0 = u.pn * BM + wc * 32 + 8 * fq;
#pragma unroll
        for (int ai = 0; ai < 2; ++ai)
#pragma unroll
            for (int m = 0; m < 4; ++m) { const int row = row0 + ai * HALF + m * 16; const size_t ro = (size_t)row * ldc + col0; const float r = rs[row];
#pragma unroll
                for (int bj = 0; bj < 2; ++bj) { const f32x4 v0 = acc[ai][bj][m][0] * r + *(const f32x4*)(R + ro + bj * HALF), v1 = acc[ai][bj][m][1] * r + *(const f32x4*)(R + ro + bj * HALF + 4);
                    u32x4 w; w.x = cvt_pk_bf16(v0[0], v0[1]); w.y = cvt_pk_bf16(v0[2], v0[3]); w.z = cvt_pk_bf16(v1[0], v1[1]); w.w = cvt_pk_bf16(v1[2], v1[3]);
                    *(u32x4*)(O + ro + bj * HALF) = w; } }
    }
};
struct GroupedOrder {
    const PG8_LAS int* te; const PG8_LAS int* tr0; const PG8_LAS int* tnr; int nunits, G, c; size_t a_pitch, b_exp;
    __device__ __forceinline__ bool next(int i, Unit& u) const {
        const int L = i * G + c; if (L >= nunits) return false;
        const int t = L >> 2; u.pm = t; u.pn = L & 3; u.e = __builtin_amdgcn_readfirstlane(te[t]); u.row0 = __builtin_amdgcn_readfirstlane(tr0[t]); u.nr = __builtin_amdgcn_readfirstlane(tnr[t]); return true;
    }
    __device__ __forceinline__ size_t a_off(const Unit& u, size_t) const { return (size_t)u.row0 * a_pitch; }
    __device__ __forceinline__ size_t b_off(const Unit& u, size_t tstep) const { return (size_t)u.e * b_exp + (size_t)u.pn * tstep; }
    __device__ __forceinline__ void a_ready(const Unit&) const {}
    __device__ __forceinline__ void done(const Unit&) const {}
};
struct GroupedOrderPub {
    const PG8_LAS int* te; const PG8_LAS int* tr0; const PG8_LAS int* tnr; int nunits, G, c; size_t a_pitch, b_exp; unsigned* cnt;
    __device__ __forceinline__ bool next(int i, Unit& u) const {
        const int L = i * G + c; if (L >= nunits) return false;
        const int t = L >> 2; u.pm = t; u.pn = L & 3; u.e = __builtin_amdgcn_readfirstlane(te[t]); u.row0 = __builtin_amdgcn_readfirstlane(tr0[t]); u.nr = __builtin_amdgcn_readfirstlane(tnr[t]); return true;
    }
    __device__ __forceinline__ size_t a_off(const Unit& u, size_t) const { return (size_t)u.row0 * a_pitch; }
    __device__ __forceinline__ size_t b_off(const Unit& u, size_t tstep) const { return (size_t)u.e * b_exp + (size_t)u.pn * tstep; }
    __device__ __forceinline__ void a_ready(const Unit&) const {}
    __device__ __forceinline__ void done(const Unit& u) const {
        asm volatile("s_waitcnt vmcnt(0)" ::: "memory");
        if ((threadIdx.x & 63) == 0) __hip_atomic_fetch_add(cnt + 16 * u.pm, 1u, __ATOMIC_RELAXED, __HIP_MEMORY_SCOPE_AGENT);
    }
};
struct GroupedOrderDep {
    const PG8_LAS int* te; const PG8_LAS int* tr0; const PG8_LAS int* tnr; int nunits, G, c; size_t b_exp; unsigned* cnt;
    __device__ __forceinline__ bool next(int i, Unit& u) const {
        const int L = i * G + (G - 1 - c); if (L >= nunits) return false;
        const int t = L >> 2; u.pm = t; u.pn = L & 3; u.e = __builtin_amdgcn_readfirstlane(te[t]); u.row0 = __builtin_amdgcn_readfirstlane(tr0[t]); u.nr = __builtin_amdgcn_readfirstlane(tnr[t]);
        u.rdy = __hip_atomic_load(cnt + 16 * t, __ATOMIC_RELAXED, __HIP_MEMORY_SCOPE_AGENT); return true;
    }
    __device__ __forceinline__ int tok(int i, int r) const { const int t = (i * G + (G - 1 - c)) >> 2; const int r0 = tr0[t], n = tnr[t]; return r0 + (r < n ? r : n - 1); }
    __device__ __forceinline__ size_t a_off(const Unit&, size_t) const { return 0; }
    __device__ __forceinline__ size_t b_off(const Unit& u, size_t tstep) const { return (size_t)u.e * b_exp + (size_t)u.pn * tstep; }
    __device__ __forceinline__ void a_ready(const Unit& u) const {
        if ((unsigned)__builtin_amdgcn_readfirstlane(u.rdy) < 32u) { unsigned spins = 0;
            while ((unsigned)__builtin_amdgcn_readfirstlane(__hip_atomic_load(cnt + 16 * u.pm, __ATOMIC_RELAXED, __HIP_MEMORY_SCOPE_AGENT)) < 32u && ++spins < (1u << 22)) __builtin_amdgcn_s_sleep(2); }
        asm volatile("" ::: "memory");
    }
    __device__ __forceinline__ void done(const Unit&) const {}
};
struct GroupedGatherOrder {
    const PG8_LAS int* te; const PG8_LAS int* tr0; const PG8_LAS int* tnr; const PG8_LAS int* rt; int nunits, G, c; size_t b_exp;
    __device__ __forceinline__ bool next(int i, Unit& u) const {
        const int L = i * G + c; if (L >= nunits) return false;
        const int t = L >> 2; u.pm = t; u.pn = L & 3; u.e = __builtin_amdgcn_readfirstlane(te[t]); u.row0 = __builtin_amdgcn_readfirstlane(tr0[t]); u.nr = __builtin_amdgcn_readfirstlane(tnr[t]); return true;
    }
    __device__ __forceinline__ int tok(int i, int r) const { return rt[i * 256 + r]; }
    __device__ __forceinline__ size_t a_off(const Unit&, size_t) const { return 0; }
    __device__ __forceinline__ size_t b_off(const Unit& u, size_t tstep) const { return (size_t)u.e * b_exp + (size_t)u.pn * tstep; }
    __device__ __forceinline__ void a_ready(const Unit&) const {}
    __device__ __forceinline__ void done(const Unit&) const {}
};
__device__ __forceinline__ float silu_fast(float x) { return x * __builtin_amdgcn_rcpf(1.f + __builtin_amdgcn_exp2f(-1.4426950408889634f * x)); }
struct EpiSwiGLU {
    static constexpr bool PERM = true, AFTER_DRAIN = false;
    bf16_t* H;
    __device__ __forceinline__ void operator()(const f32x4 (&acc)[2][2][4][2], const Unit& u, int wr, int wc, int fr, int fq) const {
        const int colh = u.pn * 128 + wc * 32 + 8 * fq;
#pragma unroll
        for (int ai = 0; ai < 2; ++ai)
#pragma unroll
            for (int m = 0; m < 4; ++m) { const int r = ai * HALF + wr * 64 + m * 16 + fr;
                if (r < u.nr) {
                    const f32x4 g0 = acc[ai][0][m][0], g1 = acc[ai][0][m][1], u0 = acc[ai][1][m][0], u1 = acc[ai][1][m][1];
                    u32x4 w; w.x = cvt_pk_bf16(silu_fast(g0[0]) * u0[0], silu_fast(g0[1]) * u0[1]); w.y = cvt_pk_bf16(silu_fast(g0[2]) * u0[2], silu_fast(g0[3]) * u0[3]);
                    w.z = cvt_pk_bf16(silu_fast(g1[0]) * u1[0], silu_fast(g1[1]) * u1[1]); w.w = cvt_pk_bf16(silu_fast(g1[2]) * u1[2], silu_fast(g1[3]) * u1[3]);
                    *(u32x4*)(H + (size_t)(u.row0 + r) * 512 + colh) = w; } }
    }
};
struct EpiBf16_I8 {
    static constexpr bool PERM = true, AFTER_DRAIN = false;
    bf16_t* O; int ldc; const float* sa; const float* sw; int nvalid;
    __device__ __forceinline__ void operator()(const f32x4 (&acc)[2][2][4][2], const Unit& u, int wr, int wc, int fr, int fq) const {
        const int row0 = u.pm * BM + wr * 64 + fr, col0 = u.pn * BM + wc * 32 + 8 * fq;
        f32x4 sv[2][2];
#pragma unroll
        for (int bj = 0; bj < 2; ++bj)
#pragma unroll
            for (int n = 0; n < 2; ++n) sv[bj][n] = *(const f32x4*)(sw + col0 + bj * HALF + 4 * n);
#pragma unroll
        for (int ai = 0; ai < 2; ++ai)
#pragma unroll
            for (int m = 0; m < 4; ++m) { const int r = row0 + ai * HALF + m * 16; const float a = sa[r]; bf16_t* rowp = O + (size_t)r * ldc + col0;
#pragma unroll
                for (int bj = 0; bj < 2; ++bj) { f32x4 v0, v1;
#pragma unroll
                    for (int j = 0; j < 4; ++j) { v0[j] = (float)__float_as_int(acc[ai][bj][m][0][j]) * (a * sv[bj][0][j]); v1[j] = (float)__float_as_int(acc[ai][bj][m][1][j]) * (a * sv[bj][1][j]); }
                    u32x4 w; w.x = cvt_pk_bf16(v0[0], v0[1]); w.y = cvt_pk_bf16(v0[2], v0[3]); w.z = cvt_pk_bf16(v1[0], v1[1]); w.w = cvt_pk_bf16(v1[2], v1[3]);
                    if (col0 + bj * HALF < nvalid) *(u32x4*)(rowp + bj * HALF) = w; } }
    }
};
template <bool WT = false> struct EpiSwiGLU_I8 {
    static constexpr bool PERM = true, AFTER_DRAIN = false;
    bf16_t* H; const float* sa; const float* sw;
    __device__ __forceinline__ void operator()(const f32x4 (&acc)[2][2][4][2], const Unit& u, int wr, int wc, int fr, int fq) const {
        const int colh = u.pn * 128 + wc * 32 + 8 * fq;
        const float* swp = sw + (size_t)u.e * 1024 + u.pn * 256 + wc * 32 + 8 * fq;
        const f32x4 sg0 = *(const f32x4*)swp, sg1 = *(const f32x4*)(swp + 4), su0 = *(const f32x4*)(swp + 128), su1 = *(const f32x4*)(swp + 132);
#pragma unroll
        for (int ai = 0; ai < 2; ++ai)
#pragma unroll
            for (int m = 0; m < 4; ++m) { const int r = ai * HALF + wr * 64 + m * 16 + fr;
                if (r < u.nr) { const float a = sa[u.row0 + r];
                    f32x4 g0, g1, u0, u1;
#pragma unroll
                    for (int j = 0; j < 4; ++j) { g0[j] = (float)__float_as_int(acc[ai][0][m][0][j]) * (a * sg0[j]); g1[j] = (float)__float_as_int(acc[ai][0][m][1][j]) * (a * sg1[j]);
                                                  u0[j] = (float)__float_as_int(acc[ai][1][m][0][j]) * (a * su0[j]); u1[j] = (float)__float_as_int(acc[ai][1][m][1][j]) * (a * su1[j]); }
                    u32x4 w; w.x = cvt_pk_bf16(silu_fast(g0[0]) * u0[0], silu_fast(g0[1]) * u0[1]); w.y = cvt_pk_bf16(silu_fast(g0[2]) * u0[2], silu_fast(g0[3]) * u0[3]);
                    w.z = cvt_pk_bf16(silu_fast(g1[0]) * u1[0], silu_fast(g1[1]) * u1[1]); w.w = cvt_pk_bf16(silu_fast(g1[2]) * u1[2], silu_fast(g1[3]) * u1[3]);
                    if (WT) asm volatile("global_store_dwordx4 %0, %1, off sc1" :: "v"(H + (size_t)(u.row0 + r) * 512 + colh), "v"(w) : "memory");
                    else *(u32x4*)(H + (size_t)(u.row0 + r) * 512 + colh) = w; } }
    }
};
struct EpiYs {
    static constexpr bool PERM = true, AFTER_DRAIN = false;
    bf16_t* Y; const float* gate;
    __device__ __forceinline__ void operator()(const f32x4 (&acc)[2][2][4][2], const Unit& u, int wr, int wc, int fr, int fq) const {
        const int col0 = u.pn * BM + wc * 32 + 8 * fq;
#pragma unroll
        for (int ai = 0; ai < 2; ++ai)
#pragma unroll
            for (int m = 0; m < 4; ++m) { const int r = ai * HALF + wr * 64 + m * 16 + fr;
                if (r < u.nr) { const float g = gate[u.row0 + r];
#pragma unroll
                    for (int bj = 0; bj < 2; ++bj) { const f32x4 v0 = acc[ai][bj][m][0] * g, v1 = acc[ai][bj][m][1] * g;
                        u32x4 w; w.x = cvt_pk_bf16(v0[0], v0[1]); w.y = cvt_pk_bf16(v0[2], v0[3]); w.z = cvt_pk_bf16(v1[0], v1[1]); w.w = cvt_pk_bf16(v1[2], v1[3]);
                        *(u32x4*)(Y + (size_t)(u.row0 + r) * 1024 + col0 + bj * HALF) = w; } } }
    }
};
struct EpiYs8 {
    static constexpr bool PERM = true, AFTER_DRAIN = false;
    unsigned char* Y; float* SC; const float* gate;
    __device__ __forceinline__ void operator()(const f32x4 (&acc)[2][2][4][2], const Unit& u, int wr, int wc, int fr, int fq) const {
        const int col0 = u.pn * BM + wc * 32 + 8 * fq;
#pragma unroll
        for (int ai = 0; ai < 2; ++ai)
#pragma unroll
            for (int m = 0; m < 4; ++m) { const int r = ai * HALF + wr * 64 + m * 16 + fr; const bool ok = r < u.nr;
                const float g = ok ? gate[u.row0 + r] : 0.f;
                f32x4 v[2][2]; float mx = 0.f;
#pragma unroll
                for (int bj = 0; bj < 2; ++bj)
#pragma unroll
                    for (int n = 0; n < 2; ++n) { v[bj][n] = acc[ai][bj][m][n] * g;
#pragma unroll
                        for (int j = 0; j < 4; ++j) mx = fmaxf(mx, fabsf(v[bj][n][j])); }
                mx = fmaxf(mx, __shfl_xor(mx, 16)); mx = fmaxf(mx, __shfl_xor(mx, 32));
                const float inv = mx > 0.f ? 127.f * __builtin_amdgcn_rcpf(mx) : 0.f;
                unsigned w[2][2];
#pragma unroll
                for (int bj = 0; bj < 2; ++bj)
#pragma unroll
                    for (int n = 0; n < 2; ++n) { const f32x4 f = v[bj][n] * inv + 128.5f;
                        w[bj][n] = (unsigned)f[0] | ((unsigned)f[1] << 8) | ((unsigned)f[2] << 16) | ((unsigned)f[3] << 24); }
                const bool odd = fq & 1;
                const unsigned s0 = odd ? w[0][0] : w[1][0], s1 = odd ? w[0][1] : w[1][1];
                const unsigned g0 = (unsigned)__shfl_xor((int)s0, 16), g1 = (unsigned)__shfl_xor((int)s1, 16);
                if (ok) {
                    const u32x4 o = odd ? (u32x4){g0, g1, w[1][0], w[1][1]} : (u32x4){w[0][0], w[0][1], g0, g1};
                    *(u32x4*)(Y + (size_t)(u.row0 + r) * 1024 + (col0 & ~15) + (odd ? HALF : 0)) = o;
                    if (fq == 0) SC[(size_t)(u.row0 + r) * 16 + wc * 4 + u.pn] = mx * (1.f / 127.f); } }
    }
};
template <class Epi, class Sched, bool ALIGN_EPI = false, bool SP2 = false, bool GATHER = false, bool I8 = false>
__device__ __forceinline__ void gemm_phase(PG8_LAS unsigned char* lds, const Gemm g, const Sched& S, const Epi& E) {
    const int tid = threadIdx.x, wid = __builtin_amdgcn_readfirstlane(tid >> 6), lane = tid & 63, wr = wid >> 2, wc = wid & 3, fr = lane & 15, fq = lane >> 4;
    const int K = g.K, KB = I8 ? K : 2 * K  , nt = KB / (BK * 2);
    unsigned voffA[2], voffB[2];
#pragma unroll
    for (int i = 0; i < 2; ++i) { int R, C; stage_rc(tid * 16 + i * 8192, R, C); const int Rb = Epi::PERM ? ((R & ~31) + perm32(R & 31)) : R;
        voffA[i] = (unsigned)(R * KB + C * 2); voffB[i] = (unsigned)(Rb * KB + C * 2); }
    unsigned cv0[2] = {0u, 0u}, cv1[2] = {0u, 0u}, nv0[2] = {0u, 0u}, nv1[2] = {0u, 0u};
    int gR[2], gC[2];
#pragma unroll
    for (int i = 0; i < 2; ++i) stage_rc(tid * 16 + i * 8192, gR[i], gC[i]);
#define PG8_GOFF(dst0, dst1, ui_) do { _Pragma("unroll") for (int _i = 0; _i < 2; ++_i) { \
        dst0[_i] = (unsigned)S.tok((ui_), gR[_i]) * (unsigned)KB + (unsigned)gC[_i] * 2u; dst1[_i] = (unsigned)S.tok((ui_), HALF + gR[_i]) * (unsigned)KB + (unsigned)gC[_i] * 2u; } } while (0)
    const size_t kstep = (size_t)(BK * 2);
    const size_t hstep = (size_t)HALF * KB;
    const size_t tstep = 2 * hstep;
    const unsigned ldsw = (unsigned)wid * 1024u;
    const int aoff = lds_byte(wr * 64 + fr, fq * 8), boff = lds_byte(wc * 32 + fr, fq * 8), aoff1 = lds_byte(wr * 64 + fr, 32 + fq * 8), boff1 = lds_byte(wc * 32 + fr, 32 + fq * 8);
#define PG8_SA(b, h) (((b) * 2 + (h)) * HTB)
#define PG8_SB(b, h) ((4 + (b) * 2 + (h)) * HTB)
#define PG8_STAGE(bufoff, gbase, voff) do { _Pragma("unroll") for (int _i = 0; _i < 2; ++_i) \
        __builtin_amdgcn_global_load_lds((const unsigned*)((const char*)(gbase) + (voff)[_i]), (PG8_LAS unsigned*)(lds + (bufoff) + ldsw + _i * 8192), 16, 0, 0); } while (0)
#define PG8_GLDS1(gp, ldsoff) __builtin_amdgcn_global_load_lds((const unsigned*)(gp), (PG8_LAS unsigned*)(lds + (ldsoff)), 16, 0, 0)
#define PG8_STAGEA(bufoff, kptr, half, nx) do { if constexpr (GATHER) { \
        const unsigned _v0 = (half) ? ((nx) ? nv1[0] : cv1[0]) : ((nx) ? nv0[0] : cv0[0]), _v1 = (half) ? ((nx) ? nv1[1] : cv1[1]) : ((nx) ? nv0[1] : cv0[1]); \
        PG8_GLDS1((const char*)(kptr) + _v0, (bufoff) + ldsw); PG8_GLDS1((const char*)(kptr) + _v1, (bufoff) + ldsw + 8192); \
    } else { PG8_STAGE(bufoff, (kptr) + ((half) ? hstep : (size_t)0), voffA); } } while (0)
#define PG8_LDA(dst, b, h) do { _Pragma("unroll") for (int m = 0; m < 4; ++m) _Pragma("unroll") for (int k = 0; k < 2; ++k) dst[m][k] = *(const PG8_LAS bf16x8*)(lds + PG8_SA(b, h) + (k ? aoff1 : aoff) + m * 2048); } while (0)
#define PG8_LDB(dst, b, h) do { _Pragma("unroll") for (int n = 0; n < 2; ++n) _Pragma("unroll") for (int k = 0; k < 2; ++k) dst[n][k] = *(const PG8_LAS bf16x8*)(lds + PG8_SB(b, h) + (k ? boff1 : boff) + n * 2048); } while (0)
#define PG8_MMA(ai, bj, At, Bt) do { __builtin_amdgcn_s_setprio(1); _Pragma("unroll") for (int m = 0; m < 4; ++m) _Pragma("unroll") for (int n = 0; n < 2; ++n) _Pragma("unroll") for (int k = 0; k < 2; ++k) { \
        if constexpr (I8) acc[ai][bj][m][n] = __builtin_bit_cast(f32x4, __builtin_amdgcn_mfma_i32_16x16x64_i8(__builtin_bit_cast(i32x4, Bt[n][k]), __builtin_bit_cast(i32x4, At[m][k]), __builtin_bit_cast(i32x4, acc[ai][bj][m][n]), 0, 0, 0)); \
        else acc[ai][bj][m][n] = __builtin_amdgcn_mfma_f32_16x16x32_bf16(Bt[n][k], At[m][k], acc[ai][bj][m][n], 0, 0, 0); } __builtin_amdgcn_s_setprio(0); } while (0)
#define PG8_WAIT_V(n) asm volatile("s_waitcnt vmcnt(" #n ")" ::: "memory")
#define PG8_WAIT_L(n) asm volatile("s_waitcnt lgkmcnt(" #n ")" ::: "memory")
#define PG8_BAR __builtin_amdgcn_s_barrier()
#define PG8_SCHED __builtin_amdgcn_sched_barrier(0)
    Unit cur, nxt; int ui = 0;
    if (!S.next(0, cur)) return;
    if constexpr (GATHER) { PG8_GOFF(cv0, cv1, 0); }
    f32x4 acc[2][2][4][2];
#pragma unroll
    for (int a = 0; a < 2; ++a)
#pragma unroll
        for (int b = 0; b < 2; ++b)
#pragma unroll
            for (int m = 0; m < 4; ++m)
#pragma unroll
                for (int n = 0; n < 2; ++n) acc[a][b][m][n] = (f32x4){0.f, 0.f, 0.f, 0.f};
    bf16x8 At[4][2], B0[2][2], B1[2][2];
    const char* cA = (const char*)g.A + S.a_off(cur, tstep); const char* cB = (const char*)g.Bt + S.b_off(cur, tstep);
    S.a_ready(cur);
    if constexpr (SP2) {
        PG8_STAGE(PG8_SB(0, 0), cB, voffB); PG8_STAGE(PG8_SB(0, 1), cB + hstep, voffB); PG8_STAGEA(PG8_SA(0, 0), cA, 0, false); PG8_STAGEA(PG8_SA(0, 1), cA, 1, false);
        if (wr == 1) PG8_BAR;
        PG8_WAIT_V(2); PG8_BAR;
        PG8_STAGE(PG8_SB(1, 0), cB + kstep, voffB); PG8_STAGEA(PG8_SA(1, 0), cA + kstep, 0, false); PG8_STAGE(PG8_SB(1, 1), cB + hstep + kstep, voffB);
        PG8_WAIT_V(6); PG8_BAR;
    } else {
        PG8_STAGE(PG8_SB(0, 0), cB, voffB); PG8_STAGEA(PG8_SA(0, 0), cA, 0, false); PG8_STAGE(PG8_SB(0, 1), cB + hstep, voffB); PG8_STAGEA(PG8_SA(0, 1), cA, 1, false);
        if (wr == 1) PG8_BAR;
        PG8_WAIT_V(4); PG8_BAR;
        PG8_STAGE(PG8_SB(1, 0), cB + kstep, voffB); PG8_STAGEA(PG8_SA(1, 0), cA + kstep, 0, false); PG8_STAGE(PG8_SB(1, 1), cB + hstep + kstep, voffB);
        PG8_WAIT_V(6); PG8_BAR;
    }
    for (;;) {
        const bool has_next = S.next(ui + 1, nxt);
        if constexpr (GATHER) { if (has_next) { PG8_GOFF(nv0, nv1, ui + 1); } else { nv0[0] = cv0[0]; nv0[1] = cv0[1]; nv1[0] = cv1[0]; nv1[1] = cv1[1]; } }
        const char* nA = has_next ? (const char*)g.A + S.a_off(nxt, tstep) : cA; const char* nB = has_next ? (const char*)g.Bt + S.b_off(nxt, tstep) : cB;
        for (int t = 0; t < nt; t += 2) {
            const bool last = (t == nt - 2);
            const char* a1 = cA + (size_t)(t + 1) * kstep;
            const char* a2 = last ? nA : cA + (size_t)(t + 2) * kstep; const char* b2 = last ? nB : cB + (size_t)(t + 2) * kstep;
            const char* a3 = a2 + kstep; const char* b3 = b2 + kstep;
            if (last && has_next) S.a_ready(nxt);
            if constexpr (SP2) {
            PG8_LDB(B0, 0, 0); PG8_LDB(B1, 0, 1); PG8_SCHED; PG8_LDA(At, 0, 0); PG8_STAGEA(PG8_SA(1, 1), a1, 1, false);
            PG8_WAIT_V(8); PG8_WAIT_L(0); PG8_BAR; PG8_MMA(0, 0, At, B0); PG8_MMA(0, 1, At, B1); PG8_BAR; PG8_SCHED;
            PG8_LDA(At, 0, 1); PG8_STAGE(PG8_SB(0, 0), b2, voffB); PG8_STAGE(PG8_SB(0, 1), b2 + hstep, voffB); PG8_STAGEA(PG8_SA(0, 0), a2, 0, last);
            PG8_WAIT_V(8); PG8_WAIT_L(0); PG8_BAR; PG8_MMA(1, 0, At, B0); PG8_MMA(1, 1, At, B1); PG8_BAR; PG8_SCHED;
            PG8_LDB(B0, 1, 0); PG8_LDB(B1, 1, 1); PG8_SCHED; PG8_LDA(At, 1, 0); PG8_STAGEA(PG8_SA(0, 1), a2, 1, last);
            PG8_WAIT_V(8); PG8_WAIT_L(0); PG8_BAR; PG8_MMA(0, 0, At, B0); PG8_MMA(0, 1, At, B1); PG8_BAR; PG8_SCHED;
            PG8_LDA(At, 1, 1); PG8_STAGE(PG8_SB(1, 0), b3, voffB); PG8_STAGE(PG8_SB(1, 1), b3 + hstep, voffB); PG8_STAGEA(PG8_SA(1, 0), a3, 0, last);
            PG8_WAIT_V(8); PG8_WAIT_L(0); PG8_BAR; PG8_MMA(1, 0, At, B0); PG8_MMA(1, 1, At, B1); PG8_BAR; PG8_SCHED;
            } else {
            PG8_LDB(B0, 0, 0); PG8_SCHED; PG8_LDA(At, 0, 0); PG8_STAGEA(PG8_SA(1, 1), a1, 1, false);
            PG8_WAIT_L(8); PG8_BAR; PG8_WAIT_L(0); PG8_MMA(0, 0, At, B0); PG8_BAR; PG8_SCHED;
            PG8_LDB(B1, 0, 1); PG8_STAGE(PG8_SB(0, 0), b2, voffB);
            PG8_BAR; PG8_WAIT_L(0); PG8_MMA(0, 1, At, B1); PG8_BAR;
            PG8_LDA(At, 0, 1); PG8_STAGEA(PG8_SA(0, 0), a2, 0, last);
            PG8_BAR; PG8_WAIT_L(0); PG8_MMA(1, 0, At, B0); PG8_BAR; PG8_SCHED;
            PG8_STAGE(PG8_SB(0, 1), b2 + hstep, voffB);
            PG8_WAIT_V(6); PG8_BAR; PG8_MMA(1, 1, At, B1); PG8_BAR;
            PG8_LDB(B0, 1, 0); PG8_SCHED; PG8_LDA(At, 1, 0); PG8_STAGEA(PG8_SA(0, 1), a2, 1, last);
            PG8_WAIT_L(8); PG8_BAR; PG8_WAIT_L(0); PG8_MMA(0, 0, At, B0); PG8_BAR; PG8_SCHED;
            PG8_LDB(B1, 1, 1); PG8_STAGE(PG8_SB(1, 0), b3, voffB);
            PG8_BAR; PG8_WAIT_L(0); PG8_MMA(0, 1, At, B1); PG8_BAR;
            PG8_LDA(At, 1, 1); PG8_STAGEA(PG8_SA(1, 0), a3, 0, last);
            PG8_BAR; PG8_WAIT_L(0); PG8_MMA(1, 0, At, B0); PG8_BAR; PG8_SCHED;
            PG8_STAGE(PG8_SB(1, 1), b3 + hstep, voffB);
            PG8_WAIT_V(6); PG8_BAR; PG8_MMA(1, 1, At, B1); PG8_BAR;
            }
        }
        if constexpr (ALIGN_EPI) { if (wr == 0) PG8_BAR; }
        if constexpr (!Epi::AFTER_DRAIN) { E(acc, cur, wr, wc, fr, fq); S.done(cur); }
        if (!has_next) break;
#pragma unroll
        for (int a = 0; a < 2; ++a)
#pragma unroll
            for (int b = 0; b < 2; ++b)
#pragma unroll
                for (int m = 0; m < 4; ++m)
#pragma unroll
                    for (int n = 0; n < 2; ++n) acc[a][b][m][n] = (f32x4){0.f, 0.f, 0.f, 0.f};
        cur = nxt; cA = nA; cB = nB; ++ui;
        if constexpr (GATHER) { cv0[0] = nv0[0]; cv0[1] = nv0[1]; cv1[0] = nv1[0]; cv1[1] = nv1[1]; }
        if constexpr (ALIGN_EPI) { if (wr == 1) PG8_BAR; }
    }
    PG8_WAIT_V(0);
    if constexpr (!ALIGN_EPI) { if (wr == 0) PG8_BAR; }
    PG8_BAR;
    if constexpr (Epi::AFTER_DRAIN) { E.fused(acc, cur, wr, wc, fr, fq, lds, wid, lane); S.done(cur); }
#undef PG8_SA
#undef PG8_SB
#undef PG8_STAGE
#undef PG8_STAGEA
#undef PG8_GLDS1
#undef PG8_GOFF
#undef PG8_LDA
#undef PG8_LDB
#undef PG8_MMA
#undef PG8_WAIT_V
#undef PG8_WAIT_L
#undef PG8_BAR
#undef PG8_SCHED
}
}
#define GAS __attribute__((address_space(1)))
#define LAS __attribute__((address_space(3)))
typedef unsigned short bf16;
typedef unsigned v4u __attribute__((ext_vector_type(4)));
typedef float f32x4 __attribute__((ext_vector_type(4)));
typedef short bf16x8 __attribute__((ext_vector_type(8)));
typedef GAS unsigned gu32;
typedef GAS unsigned long long gu64;
#define RLX_AGENT __ATOMIC_RELAXED, __HIP_MEMORY_SCOPE_AGENT
#define LDS_WAIT() asm volatile("s_waitcnt lgkmcnt(0)" ::: "memory")
#define VM_WAIT() asm volatile("s_waitcnt vmcnt(0)" ::: "memory")
__device__ __forceinline__ unsigned long long rt() { return __builtin_amdgcn_s_memrealtime(); }
__device__ __forceinline__ unsigned f2bfu(float f) { unsigned u = __builtin_bit_cast(unsigned, f); return (u + 0x7fffu + ((u >> 16) & 1u)) >> 16; }
__device__ __forceinline__ unsigned pk2(float lo, float hi) { return f2bfu(lo) | (f2bfu(hi) << 16); }

#define XB_TMO      128
#define XB_XCNT(j)  (256  + 64 * (j))
#define XB_XSUB(j)  (1280 + 64 * (j))
#define XB_XGEN(j)  (2304 + 64 * (j))
#define XB_TOP      3328
#define XB_TOPGEN   3392
#define XCD_BAR_WORDS 3456
#define XB_SPIN_CAP (1u << 18)

__device__ __forceinline__ unsigned xb_ld(unsigned* p)              { return __hip_atomic_load(p, __ATOMIC_RELAXED, __HIP_MEMORY_SCOPE_AGENT); }
__device__ __forceinline__ unsigned xb_add(unsigned* p, unsigned v) { return __hip_atomic_fetch_add(p, v, __ATOMIC_RELAXED, __HIP_MEMORY_SCOPE_AGENT); }
__device__ __forceinline__ unsigned xb_xcc_id() { return (unsigned)__builtin_amdgcn_s_getreg((3 << 11) | 20) & 0xFu; }
#define XB_SPIN(cond, bar) do { unsigned _sp = 0; while (cond) { __builtin_amdgcn_s_sleep(1); \
    if ((++_sp & 255u) == 0u) { if (xb_ld(&(bar)[XB_TMO])) break; if (_sp > XB_SPIN_CAP) { atomicAdd(&(bar)[XB_TMO], 1u); break; } } } } while (0)

struct XcdBarrier {
    unsigned* bar; unsigned x;
    volatile LAS unsigned* st;
};

__device__ __forceinline__ XcdBarrier xcd_barrier_post(unsigned* bar, volatile LAS unsigned* st) {
    XcdBarrier b; b.bar = bar; b.x = xb_xcc_id(); b.st = st;
    if (threadIdx.x == 0) (void)xb_add(&bar[XB_XCNT(b.x)], 1u);
    return b;
}
__device__ __forceinline__ void xcd_barrier_complete(unsigned* bar, unsigned x, unsigned& nloc, unsigned& nx) {
    const unsigned G = gridDim.x * gridDim.y * gridDim.z;
    unsigned sum, cnt, mine, sp = 0u;
    for (;;) {
        sum = 0u; cnt = 0u; mine = 0u;
#pragma unroll
        for (unsigned j = 0; j < 16; ++j) { const unsigned c = xb_ld(&bar[XB_XCNT(j)]); sum += c; cnt += (c > 0u) ? 1u : 0u; mine = (j == x) ? c : mine; }
        if (sum == G) break;
        __builtin_amdgcn_s_sleep(1);
        if ((++sp & 255u) == 0u) { if (xb_ld(&bar[XB_TMO])) break; if (sp > XB_SPIN_CAP) { atomicAdd(&bar[XB_TMO], 1u); break; } }
    }
    nloc = mine > 0u ? mine : 1u; nx = cnt > 0u ? cnt : 1u;
}

__device__ __forceinline__ void xcd_barrier(const XcdBarrier& b) {
    asm volatile("s_waitcnt vmcnt(0)" ::: "memory");
    __syncthreads();
    if (threadIdx.x == 0) {
        unsigned* bar = b.bar;
        __builtin_amdgcn_s_waitcnt(0);
        unsigned nloc = b.st[0], nx = b.st[1];
        if (nloc == 0u) { xcd_barrier_complete(bar, b.x, nloc, nx); b.st[0] = nloc; b.st[1] = nx; }
        const unsigned old = xb_add(&bar[XB_XSUB(b.x)], 1u);
        const unsigned gen = old / nloc;
        if (old + 1u == (gen + 1u) * nloc) {
            __builtin_amdgcn_fence(__ATOMIC_RELEASE, "agent");
            asm volatile("s_waitcnt vmcnt(0)" ::: "memory");
            const unsigned og = xb_add(&bar[XB_TOP], 1u);
            const unsigned tg = og / nx;
            if (og + 1u == (tg + 1u) * nx) xb_add(&bar[XB_TOPGEN], 1u);
            else XB_SPIN(xb_ld(&bar[XB_TOPGEN]) == tg, bar);
            __builtin_amdgcn_fence(__ATOMIC_ACQUIRE, "agent");
            xb_add(&bar[XB_XGEN(b.x)], 1u);
            asm volatile("s_waitcnt vmcnt(0)" ::: "memory");
        } else {
            XB_SPIN(xb_ld(&bar[XB_XGEN(b.x)]) == gen, bar);
            __builtin_amdgcn_fence(__ATOMIC_ACQUIRE, "agent");
            asm volatile("s_waitcnt vmcnt(0)" ::: "memory");
        }
    }
    __syncthreads();
}

template <bool DUAL, class FA, class FB, class FB2, class FE>
__device__ __forceinline__ void naive_tile_h(float* sm, int t256, int K, FA fa, FB fb, FB2 fb2, FE fe) {
    float* As = sm; float* Bs = sm + 1088; float* Bs2 = sm + 2176;
    const int tx = t256 & 15, ty = t256 >> 4;
    float acc[4][4], acc2[4][4];
#pragma unroll
    for (int i = 0; i < 4; ++i)
#pragma unroll
        for (int j = 0; j < 4; ++j) { acc[i][j] = 0.f; acc2[i][j] = 0.f; }
    for (int k0 = 0; k0 < K; k0 += 16) {
        { const int r = t256 >> 2, kk = (t256 & 3) * 4; const float4 a = fa(r, k0 + kk); As[kk * 68 + r] = a.x; As[(kk + 1) * 68 + r] = a.y; As[(kk + 2) * 68 + r] = a.z; As[(kk + 3) * 68 + r] = a.w; }
        { const int kk = t256 >> 4, c = (t256 & 15) * 4; *(float4*)&Bs[kk * 68 + c] = fb(k0 + kk, c); if (DUAL) *(float4*)&Bs2[kk * 68 + c] = fb2(k0 + kk, c); }
        __syncthreads();
#pragma unroll
        for (int kk = 0; kk < 16; ++kk) {
            const float4 a = *(const float4*)&As[kk * 68 + ty * 4]; const float4 b = *(const float4*)&Bs[kk * 68 + tx * 4];
            const float av[4] = {a.x, a.y, a.z, a.w}; const float bv[4] = {b.x, b.y, b.z, b.w};
#pragma unroll
            for (int i = 0; i < 4; ++i)
#pragma unroll
                for (int j = 0; j < 4; ++j) acc[i][j] += av[i] * bv[j];
            if (DUAL) {
                const float4 b2 = *(const float4*)&Bs2[kk * 68 + tx * 4]; const float bw[4] = {b2.x, b2.y, b2.z, b2.w};
#pragma unroll
                for (int i = 0; i < 4; ++i)
#pragma unroll
                    for (int j = 0; j < 4; ++j) acc2[i][j] += av[i] * bw[j];
            }
        }
        __syncthreads();
    }
#pragma unroll
    for (int i = 0; i < 4; ++i) fe(ty * 4 + i, tx * 4, make_float4(acc[i][0], acc[i][1], acc[i][2], acc[i][3]), make_float4(acc2[i][0], acc2[i][1], acc2[i][2], acc2[i][3]));
}

__device__ __forceinline__ void ph_la(int gtid, int nthr, const bf16_t* PROJ, const float* upf, const float* bf, const float* upb, const float* bb, float* LAF, float* LAB) {
    for (int i = gtid; i < NTOK * 256 * 2; i += nthr) {
        const int c = i & 255, t = (i >> 8) & (NTOK - 1), dir = i >> 23;
        const bf16_t* z = PROJ + (size_t)t * PW + (dir ? C_ZB : C_ZF);
        const float* up = dir ? upb : upf; const float* bias = dir ? bb : bf;
        float pre = bias[c];
#pragma unroll
        for (int r = 0; r < 16; ++r) pre += bf2f(z[r]) * up[r * 256 + c];
        const float ls = fminf(pre, 0.f) - log1pf(expf(-fabsf(pre)));
        (dir ? LAB : LAF)[(size_t)t * 256 + c] = ls * (1.f / 16.f);
    }
}
__device__ __forceinline__ void ph_gla_scan(int bid, int tid, const bf16_t* PROJ, const float* LAF, const float* LAB, float* OF, float* OB) {
    const int es = bid & 3, dir = (bid >> 2) & 1, h = (bid >> 3) & 3, b = bid >> 5;
    const int dg = tid & 15, el = tid >> 4, e = es * 32 + el;
    const float* LA = dir ? LAB : LAF; float* O = dir ? OB : OF;
    float S0 = 0.f, S1 = 0.f, S2 = 0.f, S3 = 0.f;
#pragma unroll 4
    for (int step = 0; step < T; ++step) {
        const int t = dir ? (T - 1 - step) : step;
        const size_t row = (size_t)b * T + t;
        const bf16_t* pr = PROJ + row * PW;
        const float4 la = *(const float4*)(LA + row * 256 + h * 64 + dg * 4);
        const float4 q = ld_bf4(pr + C_GQ + h * 64 + dg * 4);
        const float4 k = ld_bf4(pr + C_GK + h * 64 + dg * 4);
        const float v = bf2f(pr[C_GV + h * 128 + e]);
        S0 = expf(la.x) * S0 + k.x * v; S1 = expf(la.y) * S1 + k.y * v; S2 = expf(la.z) * S2 + k.z * v; S3 = expf(la.w) * S3 + k.w * v;
        float part = (q.x * S0 + q.y * S1 + q.z * S2 + q.w * S3) * 0.125f;
        part += __shfl_xor(part, 1); part += __shfl_xor(part, 2); part += __shfl_xor(part, 4); part += __shfl_xor(part, 8);
        if (dg == 0) O[row * 512 + h * 128 + e] = part;
    }
}
__device__ __forceinline__ void ph_gla_combine(int gw, int NGW, int lane, const float* OF, const float* OB, const bf16_t* PROJ, const float* gain, bf16_t* MIXED) {
    for (int w = gw; w < NTOK * 4; w += NGW) {
        const int t = w >> 2, h = w & 3;
        const size_t o = (size_t)t * 512 + h * 128 + lane * 2;
        const float2 a = *(const float2*)(OF + o), bq = *(const float2*)(OB + o);
        const float v0 = a.x + bq.x, v1 = a.y + bq.y;
        const float ss = wave_sum(v0 * v0 + v1 * v1);
        const float rstd = rsqrtf(ss * (1.f / 128.f) + EPS);
        const bf16_t* g = PROJ + (size_t)t * PW + C_GG + h * 128 + lane * 2;
        const float g0 = bf2f(g[0]), g1 = bf2f(g[1]);
        bf16_t* m = MIXED + (size_t)t * D + h * 128 + lane * 2;
        m[0] = f2bf(v0 * rstd * gain[lane * 2] * silu_f(g0)); m[1] = f2bf(v1 * rstd * gain[lane * 2 + 1] * silu_f(g1));
    }
}
__device__ __forceinline__ void ph_qk_prep(int gw, int NGW, int lane, bf16_t* PROJ, const float* qg, const float* kg, const float* rope, bf16_t* OUT, int opitch) {
    const float gq = qg[lane], gk = kg[lane];
    const int pi = lane >> 1, j = pi & 15;
    for (int t = gw; t < NTOK; t += NGW) {
        bf16_t* p = PROJ + (size_t)t * PW + C_AQ + lane;
        float v[10];
#pragma unroll
        for (int hs = 8; hs < 10; ++hs) v[hs] = bf2f(p[hs * 64]);
        const int tt = t & (T - 1), pos = pi < 16 ? (tt >> 6) : (tt & 63);
        const float c = rope[pos * 16 + j], s = rope[1024 + pos * 16 + j];
#pragma unroll
        for (int hs = 8; hs < 10; ++hs) {
            const float ss = wave_sum(v[hs] * v[hs]);
            const float y = v[hs] * rsqrtf(ss * (1.f / 64.f) + EPS) * (hs < 8 ? gq : gk);
            const float partner = __shfl_xor(y, 1);
            float o = (lane & 1) ? (partner * s + y * c) : (y * c - partner * s);
            if (hs < 8) o *= 0.125f * 1.4426950408889634f;
            OUT[(size_t)t * opitch + lane + hs * 64] = f2bf(o);
        }
    }
}
__device__ __forceinline__ void ph_attn_vb(float* sm, int t256, int vb, const bf16_t* PROJ, float* ATT) {
    float* Qt = sm; float* KV = sm + 4352; float* St = sm + 8704; float* al = sm + 13056;
    const int tx = t256 & 15, ty = t256 >> 4;
    const int q0 = (vb & 63) * 64, hq = (vb >> 6) & 7, b = vb >> 9, kvh = hq >> 2;
    const size_t rowb = (size_t)b * T;
    { const int r = t256 >> 2, d0 = (t256 & 3) * 16; const bf16_t* p = PROJ + (rowb + q0 + r) * PW + C_AQ + hq * 64 + d0;
#pragma unroll
      for (int i = 0; i < 16; ++i) Qt[(d0 + i) * 68 + r] = bf2f(p[i]); }
    float O[4][4];
#pragma unroll
    for (int i = 0; i < 4; ++i)
#pragma unroll
        for (int j = 0; j < 4; ++j) O[i][j] = 0.f;
    float m_run = -INFINITY, l_run = 0.f;
    for (int k0 = 0; k0 < T; k0 += 64) {
        { const int c = t256 >> 2, d0 = (t256 & 3) * 16; const bf16_t* p = PROJ + (rowb + k0 + c) * PW + C_AK + kvh * 64 + d0;
#pragma unroll
          for (int i = 0; i < 16; ++i) KV[(d0 + i) * 68 + c] = bf2f(p[i]); }
        __syncthreads();
        float s[4][4];
#pragma unroll
        for (int i = 0; i < 4; ++i)
#pragma unroll
            for (int j = 0; j < 4; ++j) s[i][j] = 0.f;
#pragma unroll 8
        for (int d = 0; d < 64; ++d) {
            const float4 a = *(const float4*)&Qt[d * 68 + ty * 4]; const float4 bq = *(const float4*)&KV[d * 68 + tx * 4];
            const float av[4] = {a.x, a.y, a.z, a.w}; const float bv[4] = {bq.x, bq.y, bq.z, bq.w};
#pragma unroll
            for (int i = 0; i < 4; ++i)
#pragma unroll
                for (int j = 0; j < 4; ++j) s[i][j] += av[i] * bv[j];
        }
#pragma unroll
        for (int i = 0; i < 4; ++i)
#pragma unroll
            for (int j = 0; j < 4; ++j) St[(tx * 4 + j) * 68 + ty * 4 + i] = s[i][j];
        __syncthreads();
        { const int c = t256 >> 2, e0 = (t256 & 3) * 16; const bf16_t* p = PROJ + (rowb + k0 + c) * PW + C_AV + kvh * 64 + e0;
#pragma unroll
          for (int i = 0; i < 16; ++i) KV[c * 68 + e0 + i] = bf2f(p[i]); }
        if (t256 < 64) {
            float mx = -INFINITY;
            for (int c = 0; c < 64; ++c) mx = fmaxf(mx, St[c * 68 + t256]);
            const float mn = fmaxf(m_run, mx);
            const float alpha = expf(m_run - mn);
            float sum = 0.f;
            for (int c = 0; c < 64; ++c) { const float p = expf(St[c * 68 + t256] - mn); St[c * 68 + t256] = p; sum += p; }
            l_run = l_run * alpha + sum; m_run = mn; al[t256] = alpha;
        }
        __syncthreads();
#pragma unroll
        for (int i = 0; i < 4; ++i) { const float a = al[ty * 4 + i];
#pragma unroll
            for (int j = 0; j < 4; ++j) O[i][j] *= a; }
#pragma unroll 8
        for (int c = 0; c < 64; ++c) {
            const float4 a = *(const float4*)&St[c * 68 + ty * 4]; const float4 bq = *(const float4*)&KV[c * 68 + tx * 4];
            const float av[4] = {a.x, a.y, a.z, a.w}; const float bv[4] = {bq.x, bq.y, bq.z, bq.w};
#pragma unroll
            for (int i = 0; i < 4; ++i)
#pragma unroll
                for (int j = 0; j < 4; ++j) O[i][j] += av[i] * bv[j];
        }
        __syncthreads();
    }
    if (t256 < 64) al[t256] = 1.f / l_run;
    __syncthreads();
#pragma unroll
    for (int i = 0; i < 4; ++i) { const float a = al[ty * 4 + i];
        *(float4*)(ATT + (rowb + q0 + ty * 4 + i) * 512 + hq * 64 + tx * 4) = make_float4(O[i][0] * a, O[i][1] * a, O[i][2] * a, O[i][3] * a); }
    __syncthreads();
}
__device__ __forceinline__ void ph_att_norm(int gw, int NGW, int lane, const float* ATT, const float* gain, bf16_t* MIXED) {
    for (int t = gw; t < NTOK; t += NGW) {
        const float4* a = (const float4*)(ATT + (size_t)t * 512);
        const float4 v0 = a[lane], v1 = a[64 + lane];
        const float ss = wave_sum(v0.x * v0.x + v0.y * v0.y + v0.z * v0.z + v0.w * v0.w + v1.x * v1.x + v1.y * v1.y + v1.z * v1.z + v1.w * v1.w);
        const float rstd = rsqrtf(ss * (1.f / 512.f) + EPS);
        const float4 g0 = ((const float4*)gain)[lane], g1 = ((const float4*)gain)[64 + lane];
        bf16_t* m = MIXED + (size_t)t * D + 512;
        st_bf4(m + lane * 4, make_float4(v0.x * rstd * g0.x, v0.y * rstd * g0.y, v0.z * rstd * g0.z, v0.w * rstd * g0.w));
        st_bf4(m + 256 + lane * 4, make_float4(v1.x * rstd * g1.x, v1.y * rstd * g1.y, v1.z * rstd * g1.z, v1.w * rstd * g1.w));
    }
}
__device__ __forceinline__ void ph_router(int gw, int NGW, int lane, const float* H, const float* g2, const float* wg, const float* bg, const float* we, const float* be, float* RSTD, unsigned* tokinfo, unsigned* ctl) {
    for (int t = gw; t < NTOK; t += NGW) {
        const float4* hr = (const float4*)(H + (size_t)t * D);
        float ss = 0.f;
#pragma unroll
        for (int j = 0; j < 4; ++j) { const float4 v = hr[j * 64 + lane]; ss += v.x * v.x + v.y * v.y + v.z * v.z + v.w * v.w; }
        ss = wave_sum(ss);
        const float rstd = rsqrtf(ss * (1.f / D) + EPS);
        float gl[8], el[64];
#pragma unroll
        for (int i = 0; i < 8; ++i) gl[i] = 0.f;
#pragma unroll
        for (int i = 0; i < 64; ++i) el[i] = 0.f;
#pragma unroll 1
        for (int ji = 0; ji < 16; ++ji) {
            const int k = ((ji >> 2) * 64 + lane) * 4 + (ji & 3);
            const float xv = H[(size_t)t * D + k] * rstd * g2[k];
            const float4* pg = (const float4*)(wg + (size_t)k * 8);
#pragma unroll
            for (int q = 0; q < 2; ++q) { const float4 w = pg[q]; gl[q * 4] += xv * w.x; gl[q * 4 + 1] += xv * w.y; gl[q * 4 + 2] += xv * w.z; gl[q * 4 + 3] += xv * w.w; }
            const float4* pe = (const float4*)(we + (size_t)k * 64);
#pragma unroll
            for (int q = 0; q < 16; ++q) { const float4 w = pe[q]; el[q * 4] += xv * w.x; el[q * 4 + 1] += xv * w.y; el[q * 4 + 2] += xv * w.z; el[q * 4 + 3] += xv * w.w; }
        }
#pragma unroll
        for (int i = 0; i < 8; ++i) gl[i] = wave_sum(gl[i]) + bg[i];
#pragma unroll
        for (int i = 0; i < 64; ++i) el[i] = wave_sum(el[i]) + be[i];
        float best = gl[0]; int g = 0;
#pragma unroll
        for (int i = 1; i < 8; ++i) if (gl[i] > best) { best = gl[i]; g = i; }
        float den = 0.f;
#pragma unroll
        for (int i = 0; i < 8; ++i) den += expf(gl[i] - best);
        const float gw_ = 1.f / den;
        float ev[8];
#pragma unroll
        for (int j = 0; j < 8; ++j) { float v = el[j];
#pragma unroll
            for (int q = 1; q < 8; ++q) v = (g == q) ? el[q * 8 + j] : v;
            ev[j] = v; }
        float v1 = ev[0]; int i1 = 0;
#pragma unroll
        for (int j = 1; j < 8; ++j) if (ev[j] > v1) { v1 = ev[j]; i1 = j; }
        float v2 = -INFINITY; int i2 = 0;
#pragma unroll
        for (int j = 0; j < 8; ++j) if (j != i1 && ev[j] > v2) { v2 = ev[j]; i2 = j; }
        const float ex = expf(v2 - v1), p1 = 1.f / (1.f + ex), p2 = ex * p1;
        if (lane == 0) {
            const int e1 = g * 8 + i1, e2 = g * 8 + i2;
            uint4 o; o.x = (unsigned)e1; o.y = (unsigned)e2; o.z = __float_as_uint(gw_ * p1); o.w = __float_as_uint(gw_ * p2);
            ((uint4*)tokinfo)[t] = o;
            RSTD[t] = rstd;
            atomicAdd(&ctl[CW_COUNTS + e1], 1u); atomicAdd(&ctl[CW_COUNTS + e2], 1u);
        }
    }
}
__device__ __forceinline__ void ph_offsets(unsigned* ctl) {
    unsigned off = 0, nt = 0;
    for (int e = 0; e < NEXP; ++e) {
        const unsigned c = ctl[CW_COUNTS + e]; ctl[CW_OFFS + e] = off;
        for (unsigned r = 0; r < c; r += 64) { ctl[CW_TILE_E + nt] = (unsigned)e; ctl[CW_TILE_R0 + nt] = off + r; ctl[CW_TILE_NR + nt] = (c - r) < 64u ? (c - r) : 64u; ++nt; }
        off += c;
    }
    ctl[CW_OFFS + NEXP] = off; ctl[CW_NTILES] = nt;
}
__device__ __forceinline__ void ph_scatter(int gtid, int nthr, const unsigned* tokinfo, unsigned* ctl, int* tokslot, int* slottok, float* slotgate) {
    for (int t = gtid; t < NTOK; t += nthr) {
        const uint4 ti = ((const uint4*)tokinfo)[t];
        const unsigned p0 = ctl[CW_OFFS + ti.x] + atomicAdd(&ctl[CW_CURSOR + ti.x], 1u);
        const unsigned p1 = ctl[CW_OFFS + ti.y] + atomicAdd(&ctl[CW_CURSOR + ti.y], 1u);
        slottok[p0] = t; slottok[p1] = t; slotgate[p0] = __uint_as_float(ti.z); slotgate[p1] = __uint_as_float(ti.w);
        tokslot[2 * t] = (int)p0; tokslot[2 * t + 1] = (int)p1;
    }
}
__device__ __forceinline__ void ph_moe1_vb(float* sm, int t256, bool valid, int vb, const bf16_t* XN2, const float* w_gate, const float* w_up, const unsigned* ctl, const int* slottok, bf16_t* HMID) {
    const int tile = valid ? (vb >> 3) : 0, c0 = (vb & 7) * 64;
    const int e = (int)ctl[CW_TILE_E + tile], row0 = (int)ctl[CW_TILE_R0 + tile], nr = valid ? (int)ctl[CW_TILE_NR + tile] : 0;
    const float* wgp = w_gate + (size_t)e * D * DEXP; const float* wup = w_up + (size_t)e * D * DEXP;
    auto fa = [&](int r, int k) { if (r >= nr) return make_float4(0.f, 0.f, 0.f, 0.f); const int tok = slottok[row0 + r]; return ld_bf4(XN2 + (size_t)tok * D + k); };
    auto fb = [&](int k, int c) { return *(const float4*)(wgp + (size_t)k * DEXP + c0 + c); };
    auto fb2 = [&](int k, int c) { return *(const float4*)(wup + (size_t)k * DEXP + c0 + c); };
    auto fe = [&](int r, int c, float4 a, float4 u) { if (r >= nr) return; st_bf4(HMID + (size_t)(row0 + r) * DEXP + c0 + c, make_float4(silu_f(a.x) * u.x, silu_f(a.y) * u.y, silu_f(a.z) * u.z, silu_f(a.w) * u.w)); };
    naive_tile_h<true>(sm, t256, D, fa, fb, fb2, fe);
}
__device__ __forceinline__ void ph_moe2_vb(float* sm, int t256, bool valid, int vb, const bf16_t* HMID, const float* w_down, const unsigned* ctl, const float* slotgate, bf16_t* YS) {
    const int tile = valid ? (vb >> 4) : 0, c0 = (vb & 15) * 64;
    const int e = (int)ctl[CW_TILE_E + tile], row0 = (int)ctl[CW_TILE_R0 + tile], nr = valid ? (int)ctl[CW_TILE_NR + tile] : 0;
    const float* wd = w_down + (size_t)e * DEXP * D;
    auto fa = [&](int r, int k) { if (r >= nr) return make_float4(0.f, 0.f, 0.f, 0.f); return ld_bf4(HMID + (size_t)(row0 + r) * DEXP + k); };
    auto fb = [&](int k, int c) { return *(const float4*)(wd + (size_t)k * D + c0 + c); };
    auto fe = [&](int r, int c, float4 a, float4) { if (r >= nr) return; const float g = slotgate[row0 + r]; st_bf4(YS + (size_t)(row0 + r) * D + c0 + c, make_float4(a.x * g, a.y * g, a.z * g, a.w * g)); };
    naive_tile_h<false>(sm, t256, DEXP, fa, fb, fb, fe);
}
__device__ __forceinline__ void ph_final(int gw, int NGW, int lane, const bf16_t* H, const unsigned char* YS8, const float* YSC, const int* tokslot, const float* fg, float* OUTA, float* OUTB) {
    const int sub = (lane & 31) >> 3;
    float4 g[4];
#pragma unroll
    for (int j = 0; j < 4; ++j) g[j] = ((const float4*)fg)[j * 64 + lane];
    for (int t = 2 * gw; t < NTOK; t += 2 * NGW) {
        const int4 sl = *(const int4*)(tokslot + 2 * t);
        float4 v[2][4]; float ss[2] = {0.f, 0.f};
#pragma unroll
        for (int q = 0; q < 2; ++q) {
            const int s0 = q ? sl.z : sl.x, s1 = q ? sl.w : sl.y;
            const bf16_t* hr = H + (size_t)(t + q) * D;
            const unsigned* y0 = (const unsigned*)(YS8 + (size_t)s0 * D); const unsigned* y1 = (const unsigned*)(YS8 + (size_t)s1 * D);
            const float4 a0 = *(const float4*)(YSC + (size_t)s0 * 16 + sub * 4), a1 = *(const float4*)(YSC + (size_t)s1 * 16 + sub * 4);
            const float a0j[4] = {a0.x, a0.y, a0.z, a0.w}, a1j[4] = {a1.x, a1.y, a1.z, a1.w};
#pragma unroll
            for (int j = 0; j < 4; ++j) {
                const float4 hv = ld_bf4(hr + (j * 64 + lane) * 4); const unsigned w0 = y0[j * 64 + lane], w1 = y1[j * 64 + lane];
                const float p = a0j[j], r = a1j[j], off = -128.f * (p + r);
                v[q][j] = make_float4((hv.x + off) + p * (float)(w0 & 0xffu) + r * (float)(w1 & 0xffu), (hv.y + off) + p * (float)((w0 >> 8) & 0xffu) + r * (float)((w1 >> 8) & 0xffu),
                                      (hv.z + off) + p * (float)((w0 >> 16) & 0xffu) + r * (float)((w1 >> 16) & 0xffu), (hv.w + off) + p * (float)(w0 >> 24) + r * (float)(w1 >> 24));
                ss[q] += v[q][j].x * v[q][j].x + v[q][j].y * v[q][j].y + v[q][j].z * v[q][j].z + v[q][j].w * v[q][j].w;
            }
        }
#pragma unroll
        for (int q = 0; q < 2; ++q) {
            const float rstd = rsqrtf(wave_sum(ss[q]) * (1.f / D) + EPS);
            const int tt = t + q;
            float4* orow = (float4*)((tt < NTOK / 2 ? OUTA + (size_t)tt * D : OUTB + (size_t)(tt - NTOK / 2) * D));
#pragma unroll
            for (int j = 0; j < 4; ++j) orow[j * 64 + lane] = make_float4(v[q][j].x * rstd * g[j].x, v[q][j].y * rstd * g[j].y, v[q][j].z * rstd * g[j].z, v[q][j].w * rstd * g[j].w);
        }
    }
}
__device__ __forceinline__ void ph_copy_xs(int bx, int wave, int lane, const LAS int* pos, const float* H, const float* RSTD, const float* g2, bf16_t* XS) {
    float4 g[4];
#pragma unroll
    for (int j = 0; j < 4; ++j) g[j] = ((const float4*)g2)[j * 64 + lane];
#pragma unroll 1
    for (int i = 0; i < 16; i += 2) {
        const int l0 = wave * 16 + i, l1 = l0 + 1, t0 = bx * 128 + l0, t1 = t0 + 1;
        const float r0 = RSTD[t0], r1 = RSTD[t1];
        const float4* h0 = (const float4*)(H + (size_t)t0 * D); const float4* h1 = (const float4*)(H + (size_t)t1 * D);
        float4 a[4], b[4];
#pragma unroll
        for (int j = 0; j < 4; ++j) { a[j] = h0[j * 64 + lane]; b[j] = h1[j * 64 + lane]; }
        uint2* o00 = (uint2*)(XS + (size_t)pos[2 * l0] * D); uint2* o01 = (uint2*)(XS + (size_t)pos[2 * l0 + 1] * D);
        uint2* o10 = (uint2*)(XS + (size_t)pos[2 * l1] * D); uint2* o11 = (uint2*)(XS + (size_t)pos[2 * l1 + 1] * D);
#pragma unroll
        for (int j = 0; j < 4; ++j) {
            uint2 w; w.x = (unsigned)f2bf(a[j].x * r0 * g[j].x) | ((unsigned)f2bf(a[j].y * r0 * g[j].y) << 16); w.y = (unsigned)f2bf(a[j].z * r0 * g[j].z) | ((unsigned)f2bf(a[j].w * r0 * g[j].w) << 16);
            o00[j * 64 + lane] = w; o01[j * 64 + lane] = w;
            uint2 v; v.x = (unsigned)f2bf(b[j].x * r1 * g[j].x) | ((unsigned)f2bf(b[j].y * r1 * g[j].y) << 16); v.y = (unsigned)f2bf(b[j].z * r1 * g[j].z) | ((unsigned)f2bf(b[j].w * r1 * g[j].w) << 16);
            o10[j * 64 + lane] = v; o11[j * 64 + lane] = v;
        }
    }
}

__device__ __forceinline__ void ph_copy_xs_i8(int bx, int wave, int lane, const LAS int* pos, const bf16_t* H, const float* RSTD, const float* g2, unsigned char* XS8, float* SA) {
    float4 g[4];
#pragma unroll
    for (int j = 0; j < 4; ++j) g[j] = ((const float4*)g2)[lane * 4 + j];
#pragma unroll 1
    for (int i = 0; i < 16; i += 2) {
        const int l0 = wave * 16 + i, t0 = bx * 128 + l0;
        float4 a[2][4]; float mx[2];
#pragma unroll
        for (int q = 0; q < 2; ++q) { const uint4* hp = (const uint4*)(H + (size_t)(t0 + q) * D + lane * 16); const uint4 h0 = hp[0], h1 = hp[1];
            const unsigned hw[8] = {h0.x, h0.y, h0.z, h0.w, h1.x, h1.y, h1.z, h1.w};
#pragma unroll
            for (int j = 0; j < 4; ++j) a[q][j] = make_float4(__uint_as_float(hw[2 * j] << 16), __uint_as_float(hw[2 * j] & 0xffff0000u), __uint_as_float(hw[2 * j + 1] << 16), __uint_as_float(hw[2 * j + 1] & 0xffff0000u)); }
#pragma unroll
        for (int q = 0; q < 2; ++q) { const float r = RSTD[t0 + q]; float m = 0.f;
#pragma unroll
            for (int j = 0; j < 4; ++j) { a[q][j].x *= r * g[j].x; a[q][j].y *= r * g[j].y; a[q][j].z *= r * g[j].z; a[q][j].w *= r * g[j].w;
                m = fmaxf(m, fmaxf(fmaxf(fabsf(a[q][j].x), fabsf(a[q][j].y)), fmaxf(fabsf(a[q][j].z), fabsf(a[q][j].w)))); }
#pragma unroll
            for (int o = 1; o < 64; o <<= 1) m = fmaxf(m, __shfl_xor(m, o));
            mx[q] = m; }
#pragma unroll
        for (int q = 0; q < 2; ++q) { const float inv = mx[q] > 0.f ? 127.f / mx[q] : 0.f;
            v4u w;
#pragma unroll
            for (int j = 0; j < 4; ++j) { const int ia = __float2int_rn(a[q][j].x * inv), ib = __float2int_rn(a[q][j].y * inv), ic = __float2int_rn(a[q][j].z * inv), id = __float2int_rn(a[q][j].w * inv);
                w[j] = ((unsigned)ia & 0xffu) | (((unsigned)ib & 0xffu) << 8) | (((unsigned)ic & 0xffu) << 16) | ((unsigned)id << 24); }
            const int p0 = pos[2 * (l0 + q)], p1 = pos[2 * (l0 + q) + 1];
            *(GAS v4u*)(XS8 + (size_t)p0 * D + lane * 16) = w; *(GAS v4u*)(XS8 + (size_t)p1 * D + lane * 16) = w;
            if (lane == 0) { SA[p0] = mx[q] * (1.f / 127.f); SA[p1] = mx[q] * (1.f / 127.f); } }
    }
}
constexpr size_t WS_DEC = 11 * MiB;
constexpr int LDT = 72;
constexpr int GL_QE = 0, GL_KE = 9216, GL_P = 18432, GL_VT = 27648, GL_ST = 46080, GL_TOT = 64512, GL_PART = 68608, GL_RSTD = 70656;
typedef float gf32x4 __attribute__((ext_vector_type(4)));
typedef short gbf16x8 __attribute__((ext_vector_type(8)));

__device__ __forceinline__ float exp_fast(float x) { return __builtin_amdgcn_exp2f(x * 1.4426950408889634f); }
__device__ __forceinline__ float log_sigmoid_f(float x) { return fminf(x, 0.f) - 0.6931471805599453f * __builtin_amdgcn_logf(1.f + exp_fast(-fabsf(x))); }
__device__ __forceinline__ gf32x4 mfma_tile64(const LAS bf16_t* A, const LAS bf16_t* Bt, gf32x4 acc, int lane) {
    const int r = lane & 15, kq = (lane >> 4) * 8;
    const gbf16x8 a0 = *(const LAS gbf16x8*)(A + r * LDT + kq), a1 = *(const LAS gbf16x8*)(A + r * LDT + kq + 32);
    const gbf16x8 b0 = *(const LAS gbf16x8*)(Bt + r * LDT + kq), b1 = *(const LAS gbf16x8*)(Bt + r * LDT + kq + 32);
    acc = __builtin_amdgcn_mfma_f32_16x16x32_bf16(a0, b0, acc, 0, 0, 0);
    acc = __builtin_amdgcn_mfma_f32_16x16x32_bf16(a1, b1, acc, 0, 0, 0);
    return acc;
}
template <bool BWD>
__device__ __forceinline__ void gla_cumsum(const bf16_t* zbase  , const float* up  , const float* bias, int hd  , int tg, int d, LAS float* tot, float (&bv)[8], float& bl) {
    float upc[16];
#pragma unroll
    for (int r = 0; r < 16; ++r) upc[r] = up[r * 256 + hd];
    const float bs = bias[hd];
    float c[8];
#pragma unroll
    for (int i = 0; i < 8; ++i) {
        const uint4* zp = (const uint4*)(zbase + (size_t)(8 * tg + i) * PW);
        const uint4 z0 = zp[0], z1 = zp[1];
        const unsigned zw[8] = {z0.x, z0.y, z0.z, z0.w, z1.x, z1.y, z1.z, z1.w};
        float pre = bs;
#pragma unroll
        for (int r = 0; r < 8; ++r) { pre += __uint_as_float(zw[r] << 16) * upc[2 * r]; pre += __uint_as_float(zw[r] & 0xffff0000u) * upc[2 * r + 1]; }
        c[i] = log_sigmoid_f(pre) * (1.f / 16.f);
    }
    if (!BWD) {
#pragma unroll
        for (int i = 1; i < 8; ++i) c[i] += c[i - 1];
        tot[tg * 64 + d] = c[7];
    } else {
#pragma unroll
        for (int i = 6; i >= 0; --i) c[i] += c[i + 1];
        tot[tg * 64 + d] = c[0];
    }
    __syncthreads();
    float off = 0.f, all = 0.f;
#pragma unroll
    for (int t2 = 0; t2 < 8; ++t2) { const float v = tot[t2 * 64 + d]; all += v; if (BWD ? (t2 > tg) : (t2 < tg)) off += v; }
#pragma unroll
    for (int i = 0; i < 8; ++i) bv[i] = c[i] + off;
    bl = all;
}
__device__ __forceinline__ void gla_stage_vt(const bf16_t* vbase, LAS bf16_t* VT, int tid) {
    const int s = tid & 63, e0 = (tid >> 6) * 16;
    const uint4* vp = (const uint4*)(vbase + (size_t)s * PW + e0);
    const uint4 v0 = vp[0], v1 = vp[1];
    const unsigned w[8] = {v0.x, v0.y, v0.z, v0.w, v1.x, v1.y, v1.z, v1.w};
#pragma unroll
    for (int i = 0; i < 8; ++i) { VT[(e0 + 2 * i) * LDT + s] = (bf16_t)(w[i] & 0xffffu); VT[(e0 + 2 * i + 1) * LDT + s] = (bf16_t)(w[i] >> 16); }
}
__device__ __forceinline__ void gla_g1_unit(LAS unsigned char* lds, int tid, int unit, const bf16_t* PROJ, const float* upf, const float* bf_, const float* upb, const float* bb_, bf16_t* KVS, float* DEC) {
    const int n = unit & 63, h = (unit >> 6) & 3, b = unit >> 8;
    const int d = tid & 63, tg = tid >> 6, lane = tid & 63, w = tid >> 6;
    const size_t tok0 = (size_t)b * T + n * 64;
    LAS bf16_t* KET = (LAS bf16_t*)(lds + GL_QE); LAS bf16_t* VT = (LAS bf16_t*)(lds + GL_VT); LAS float* tot = (LAS float*)(lds + GL_TOT);
    gla_stage_vt(PROJ + tok0 * PW + C_GV + h * 128, VT, tid);
#pragma unroll
    for (int dir = 0; dir < 2; ++dir) {
        float bv[8], bl;
        if (dir == 0) gla_cumsum<false>(PROJ + tok0 * PW + C_ZF, upf, bf_, h * 64 + d, tg, d, tot, bv, bl);
        else          gla_cumsum<true>(PROJ + tok0 * PW + C_ZB, upb, bb_, h * 64 + d, tg, d, tot + 512, bv, bl);
        unsigned pk[4];
#pragma unroll
        for (int i = 0; i < 8; i += 2) {
            const float k0 = bf2f(PROJ[(tok0 + 8 * tg + i) * PW + C_GK + h * 64 + d]) * exp_fast(bl - bv[i]);
            const float k1 = bf2f(PROJ[(tok0 + 8 * tg + i + 1) * PW + C_GK + h * 64 + d]) * exp_fast(bl - bv[i + 1]);
            pk[i >> 1] = (unsigned)f2bf(k0) | ((unsigned)f2bf(k1) << 16);
        }
        *(LAS v4u*)(KET + d * LDT + 8 * tg) = (v4u){pk[0], pk[1], pk[2], pk[3]};
        const size_t sq = (((size_t)b * 4 + h) * 2 + dir) * 64 + n;
        if (tg == 0) DEC[sq * 64 + d] = exp_fast(bl);
        __syncthreads();
        bf16_t* kvo = KVS + sq * 8192;
#pragma unroll
        for (int dt = 0; dt < 4; ++dt) {
            gf32x4 acc = {0.f, 0.f, 0.f, 0.f};
            acc = mfma_tile64(VT + (16 * w) * LDT, KET + (16 * dt) * LDT, acc, lane);
#pragma unroll
            for (int r = 0; r < 4; ++r) kvo[(size_t)(16 * w + 4 * (lane >> 4) + r) * 64 + 16 * dt + (lane & 15)] = f2bf(acc[r]);
        }
        __syncthreads();
    }
}
template <bool BWD>
__device__ __forceinline__ void gla_g2_item(unsigned* base, const float* dc) {
    float s0 = 0.f, s1 = 0.f;
#pragma unroll 1
    for (int hf = 0; hf < 2; ++hf) {
        unsigned kv[32]; float2 dd[32];
#pragma unroll
        for (int st = 0; st < 32; ++st) { const int n = BWD ? (63 - 32 * hf - st) : (32 * hf + st); kv[st] = base[(size_t)n * 4096]; dd[st] = *(const float2*)(dc + n * 64); }
#pragma unroll
        for (int st = 0; st < 32; ++st) { const int n = BWD ? (63 - 32 * hf - st) : (32 * hf + st);
            base[(size_t)n * 4096] = (unsigned)f2bf(s0) | ((unsigned)f2bf(s1) << 16);
            s0 = dd[st].x * s0 + __uint_as_float(kv[st] << 16); s1 = dd[st].y * s1 + __uint_as_float(kv[st] & 0xffff0000u); }
    }
}
__device__ __forceinline__ void gla_g2_scan(int gtid, int nthr, bf16_t* KVS, const float* DEC) {
    for (int item = gtid; item < 64 * 4096; item += nthr) {
        const int seq = item >> 12, ed = item & 4095, d2 = (ed & 31) * 2;
        unsigned* base = (unsigned*)(KVS + (size_t)seq * 64 * 8192) + ed;
        const float* dc = DEC + (size_t)seq * 64 * 64 + d2;
        if (seq & 1) gla_g2_item<true>(base, dc); else gla_g2_item<false>(base, dc);
    }
}
__device__ __forceinline__ void gla_g3_unit(LAS unsigned char* lds, int tid, int unit, const bf16_t* PROJ, const float* upf, const float* bf_, const float* upb, const float* bb_, const bf16_t* KVS, const float* gain, bf16_t* MIXED) {
    const int n = unit & 63, h = (unit >> 6) & 3, b = unit >> 8;
    const int d = tid & 63, tg = tid >> 6, lane = tid & 63, w = tid >> 6;
    const size_t tok0 = (size_t)b * T + n * 64;
    LAS bf16_t* QE = (LAS bf16_t*)(lds + GL_QE); LAS bf16_t* KE = (LAS bf16_t*)(lds + GL_KE); LAS bf16_t* PP = (LAS bf16_t*)(lds + GL_P);
    LAS bf16_t* VT = (LAS bf16_t*)(lds + GL_VT); LAS bf16_t* ST = (LAS bf16_t*)(lds + GL_ST);
    LAS float* tot = (LAS float*)(lds + GL_TOT); LAS float* part = (LAS float*)(lds + GL_PART); LAS float* rs = (LAS float*)(lds + GL_RSTD);
    gla_stage_vt(PROJ + tok0 * PW + C_GV + h * 128, VT, tid);
    gf32x4 o[4];
#pragma unroll
    for (int rt = 0; rt < 4; ++rt) o[rt] = (gf32x4){0.f, 0.f, 0.f, 0.f};
#pragma unroll
    for (int dir = 0; dir < 2; ++dir) {
        float bv[8], bl;
        if (dir == 0) gla_cumsum<false>(PROJ + tok0 * PW + C_ZF, upf, bf_, h * 64 + d, tg, d, tot, bv, bl);
        else          gla_cumsum<true>(PROJ + tok0 * PW + C_ZB, upb, bb_, h * 64 + d, tg, d, tot + 512, bv, bl);
#pragma unroll
        for (int i = 0; i < 8; ++i) {
            const size_t ro = (tok0 + 8 * tg + i) * PW + h * 64 + d;
            const float e = exp_fast(bv[i]);
            QE[(8 * tg + i) * LDT + d] = f2bf(bf2f(PROJ[ro + C_GQ]) * e * 0.125f);
            KE[(8 * tg + i) * LDT + d] = f2bf(bf2f(PROJ[ro + C_GK]) * __builtin_amdgcn_rcpf(e));
        }
        {
            const size_t sq = (((size_t)b * 4 + h) * 2 + dir) * 64 + n;
            const int e = tid >> 2, part4 = tid & 3;
            const uint4* sp = (const uint4*)(KVS + sq * 8192 + e * 64 + part4 * 16);
            const uint4 s0 = sp[0], s1 = sp[1];
            *(LAS v4u*)(ST + e * LDT + part4 * 16) = (v4u){s0.x, s0.y, s0.z, s0.w}; *(LAS v4u*)(ST + e * LDT + part4 * 16 + 8) = (v4u){s1.x, s1.y, s1.z, s1.w};
        }
        __syncthreads();
        { const int ct = w >> 1;
#pragma unroll
          for (int j = 0; j < 2; ++j) { const int st = 2 * (w & 1) + j;
            gf32x4 acc = {0.f, 0.f, 0.f, 0.f};
            acc = mfma_tile64(QE + (16 * ct) * LDT, KE + (16 * st) * LDT, acc, lane);
            const int s = 16 * st + (lane & 15);
#pragma unroll
            for (int r = 0; r < 4; ++r) { const int c = 16 * ct + 4 * (lane >> 4) + r; const bool keep = dir ? (s >= c) : (s <= c);
                PP[c * LDT + s] = f2bf(keep ? acc[r] : 0.f); } } }
        __syncthreads();
#pragma unroll
        for (int rt = 0; rt < 4; ++rt) {
            o[rt] = mfma_tile64(PP + (16 * rt) * LDT, VT + (16 * w) * LDT, o[rt], lane);
            o[rt] = mfma_tile64(QE + (16 * rt) * LDT, ST + (16 * w) * LDT, o[rt], lane);
        }
        __syncthreads();
    }
#pragma unroll
    for (int rt = 0; rt < 4; ++rt)
#pragma unroll
        for (int r = 0; r < 4; ++r) {
            float ss = o[rt][r] * o[rt][r];
            ss += __shfl_xor(ss, 1); ss += __shfl_xor(ss, 2); ss += __shfl_xor(ss, 4); ss += __shfl_xor(ss, 8);
            if ((lane & 15) == 0) part[w * 64 + 16 * rt + 4 * (lane >> 4) + r] = ss;
        }
    __syncthreads();
    if (tid < 64) { float ss = 0.f;
#pragma unroll
        for (int t2 = 0; t2 < 8; ++t2) ss += part[t2 * 64 + tid];
        rs[tid] = rsqrtf(ss * (1.f / 128.f) + EPS); }
    __syncthreads();
    { const int e = 16 * w + (lane & 15); const float ge = gain[e];
#pragma unroll
      for (int rt = 0; rt < 4; ++rt)
#pragma unroll
        for (int r = 0; r < 4; ++r) { const int c = 16 * rt + 4 * (lane >> 4) + r;
            const float g = bf2f(PROJ[(tok0 + c) * PW + C_GG + h * 128 + e]);
            MIXED[(tok0 + c) * D + h * 128 + e] = f2bf(o[rt][r] * rs[c] * ge * g * __builtin_amdgcn_rcpf(1.f + exp_fast(-g))); } }
    __syncthreads();
}

constexpr size_t WS_BFRAG = 12 * MiB;
__device__ __forceinline__ void router_build_bfrag(int gtid, int nthr, const float* wg, const float* we, const float* g2, bf16_t* BF) {
    for (int i = gtid; i < 32 * 5 * 64; i += nthr) {
        const int ks = i / 320, rem = i - ks * 320, ct = rem >> 6, lane = rem & 63, col = 16 * ct + (lane & 15);
        unsigned hi[4], lo[4];
#pragma unroll
        for (int j = 0; j < 8; ++j) {
            const int k = 32 * ks + 8 * (lane >> 4) + j;
            float w = col < 8 ? wg[k * 8 + col] : (col < 72 ? we[k * 64 + col - 8] : 0.f);
            w *= g2[k];
            const bf16_t h = f2bf(w); const bf16_t l = f2bf(w - bf2f(h));
            if (j & 1) { hi[j >> 1] |= (unsigned)h << 16; lo[j >> 1] |= (unsigned)l << 16; } else { hi[j >> 1] = h; lo[j >> 1] = l; }
        }
        uint4* o = (uint4*)(BF + ((size_t)(ks * 5 + ct) * 2) * 512 + lane * 8);
        o[0] = make_uint4(hi[0], hi[1], hi[2], hi[3]); o[64] = make_uint4(lo[0], lo[1], lo[2], lo[3]);
    }
}
__device__ __forceinline__ void ph_router_mfma(int gw, int NGW, int lane, LAS float* lsm  , const bf16_t* H, const bf16_t* BF, const float* bg, const float* be, float* RSTD, unsigned* tokinfo, LAS int* hist, bool dry) {
    for (int task = gw; task < NTOK / 16; task += NGW) {
        const int t0 = task * 16, row = lane & 15, kg = lane >> 4;
        const bf16_t* hp = H + (size_t)(t0 + row) * D + kg * 8;
        gf32x4 acc[5];
#pragma unroll
        for (int ct = 0; ct < 5; ++ct) acc[ct] = (gf32x4){0.f, 0.f, 0.f, 0.f};
        float ss = 0.f;
#pragma unroll 2
        for (int ks = 0; ks < 32; ++ks) {
            const gbf16x8 ah = *(const gbf16x8*)(hp + ks * 32);
#pragma unroll
            for (int j = 0; j < 8; ++j) { const float xv = bf2f((bf16_t)ah[j]); ss += xv * xv; }
            const gbf16x8* bp = (const gbf16x8*)(BF + (size_t)ks * 5 * 2 * 512) + lane;
#pragma unroll
            for (int ct = 0; ct < 5; ++ct) {
                const gbf16x8 bh = bp[(ct * 2) * 64], bl = bp[(ct * 2 + 1) * 64];
                acc[ct] = __builtin_amdgcn_mfma_f32_16x16x32_bf16(ah, bh, acc[ct], 0, 0, 0);
                acc[ct] = __builtin_amdgcn_mfma_f32_16x16x32_bf16(ah, bl, acc[ct], 0, 0, 0);
            }
        }
        ss += __shfl_xor(ss, 16); ss += __shfl_xor(ss, 32);
        const float rstd = rsqrtf(ss * (1.f / D) + EPS);
#pragma unroll
        for (int ct = 0; ct < 5; ++ct) { const int col = 16 * ct + row; const float bias = col < 8 ? bg[col] : (col < 72 ? be[col - 8] : 0.f);
#pragma unroll
            for (int r = 0; r < 4; ++r) { const int rr = 4 * kg + r; const float rs = __shfl(rstd, rr); lsm[rr * 80 + col] = acc[ct][r] * rs + bias; } }
        asm volatile("s_waitcnt lgkmcnt(0)" ::: "memory");
        if (lane < 16) {
            const LAS float* L = lsm + lane * 80;
            float best = L[0]; int g = 0;
#pragma unroll
            for (int i = 1; i < 8; ++i) { const float v = L[i]; if (v > best) { best = v; g = i; } }
            float den = 0.f;
#pragma unroll
            for (int i = 0; i < 8; ++i) den += expf(L[i] - best);
            const float gw_ = 1.f / den;
            const LAS float* E = L + 8 + g * 8;
            float v1 = E[0]; int i1 = 0;
#pragma unroll
            for (int j = 1; j < 8; ++j) { const float v = E[j]; if (v > v1) { v1 = v; i1 = j; } }
            float v2 = -INFINITY; int i2 = 0;
#pragma unroll
            for (int j = 0; j < 8; ++j) { const float v = E[j]; if (j != i1 && v > v2) { v2 = v; i2 = j; } }
            const float ex = expf(v2 - v1), p1 = 1.f / (1.f + ex), p2 = ex * p1;
            const int e1 = g * 8 + i1, e2 = g * 8 + i2, t = t0 + lane;
            uint4 o; o.x = (unsigned)e1; o.y = (unsigned)e2; o.z = __float_as_uint(gw_ * p1); o.w = __float_as_uint(gw_ * p2);
            ((uint4*)tokinfo)[t] = o;
            RSTD[t] = rstd;
            if (!dry) { __hip_atomic_fetch_add(hist + e1, 1, __ATOMIC_RELAXED, __HIP_MEMORY_SCOPE_WORKGROUP); __hip_atomic_fetch_add(hist + e2, 1, __ATOMIC_RELAXED, __HIP_MEMORY_SCOPE_WORKGROUP); }
        }
        asm volatile("s_waitcnt lgkmcnt(0)" ::: "memory");
    }
}

__device__ __forceinline__ void ph_router_lds(int vcu, int G, int wave, int lane, LAS unsigned char* lds, const bf16_t* H, const bf16_t* BF, const float* bg, const float* be, float* RSTD, unsigned* tokinfo, LAS int* hist, bool dry) {
    for (int tg = vcu; tg < NTOK / 128; tg += G) {
        const int t0 = (tg * 8 + wave) * 16, row = lane & 15, kg = lane >> 4;
        const bf16_t* hp = H + (size_t)(t0 + row) * D + kg * 8;
        gf32x4 acc[5];
#pragma unroll
        for (int ct = 0; ct < 5; ++ct) acc[ct] = (gf32x4){0.f, 0.f, 0.f, 0.f};
        float ss = 0.f;
        gbf16x8 ha[2][4];
#define RT_DMA(j) do { _Pragma("unroll") for (int i = 0; i < 5; ++i) __builtin_amdgcn_global_load_lds((const unsigned*)(BF + (size_t)(j) * 20480 + (wave + 8 * i) * 512 + lane * 8), \
            (LAS unsigned*)(lds + ((j) & 1) * 65536 + (wave + 8 * i) * 1024), 16, 0, 0); } while (0)
#define RT_LDH(j) do { _Pragma("unroll") for (int k = 0; k < 4; ++k) ha[(j) & 1][k] = *(const GAS gbf16x8*)(hp + ((j) * 4 + k) * 32); } while (0)
        RT_DMA(0); RT_LDH(0);
#pragma unroll
        for (int j = 0; j < 8; ++j) {
            if (j + 1 < 8) { RT_DMA(j + 1); RT_LDH(j + 1); asm volatile("s_waitcnt vmcnt(9)" ::: "memory"); } else asm volatile("s_waitcnt vmcnt(0)" ::: "memory");
            __syncthreads();
            const LAS unsigned char* buf = lds + (j & 1) * 65536;
#pragma unroll
            for (int k = 0; k < 4; ++k) {
                const gbf16x8 ah = ha[j & 1][k];
#pragma unroll
                for (int e = 0; e < 8; ++e) { const float xv = bf2f((bf16_t)ah[e]); ss += xv * xv; }
#pragma unroll
                for (int ct = 0; ct < 5; ++ct) {
                    const gbf16x8 bh = *(const LAS gbf16x8*)(buf + ((k * 10 + ct * 2) * 64 + lane) * 16), bl = *(const LAS gbf16x8*)(buf + ((k * 10 + ct * 2 + 1) * 64 + lane) * 16);
                    acc[ct] = __builtin_amdgcn_mfma_f32_16x16x32_bf16(ah, bh, acc[ct], 0, 0, 0);
                    acc[ct] = __builtin_amdgcn_mfma_f32_16x16x32_bf16(ah, bl, acc[ct], 0, 0, 0);
                }
            }
            __syncthreads();
        }
#undef RT_DMA
#undef RT_LDH
        LAS float* lsm = (LAS float*)(lds + wave * 5120);
        ss += __shfl_xor(ss, 16); ss += __shfl_xor(ss, 32);
        const float rstd = rsqrtf(ss * (1.f / D) + EPS);
#pragma unroll
        for (int ct = 0; ct < 5; ++ct) { const int col = 16 * ct + row; const float bias = col < 8 ? bg[col] : (col < 72 ? be[col - 8] : 0.f);
#pragma unroll
            for (int r = 0; r < 4; ++r) { const int rr = 4 * kg + r; const float rs = __shfl(rstd, rr); lsm[rr * 80 + col] = acc[ct][r] * rs + bias; } }
        asm volatile("s_waitcnt lgkmcnt(0)" ::: "memory");
        if (lane < 16) {
            const LAS float* L = lsm + lane * 80;
            float best = L[0]; int g = 0;
#pragma unroll
            for (int i = 1; i < 8; ++i) { const float v = L[i]; if (v > best) { best = v; g = i; } }
            float den = 0.f;
#pragma unroll
            for (int i = 0; i < 8; ++i) den += expf(L[i] - best);
            const float gw_ = 1.f / den;
            const LAS float* E = L + 8 + g * 8;
            float v1 = E[0]; int i1 = 0;
#pragma unroll
            for (int j = 1; j < 8; ++j) { const float v = E[j]; if (v > v1) { v1 = v; i1 = j; } }
            float v2 = -INFINITY; int i2 = 0;
#pragma unroll
            for (int j = 0; j < 8; ++j) { const float v = E[j]; if (j != i1 && v > v2) { v2 = v; i2 = j; } }
            const float ex = expf(v2 - v1), p1 = 1.f / (1.f + ex), p2 = ex * p1;
            const int e1 = g * 8 + i1, e2 = g * 8 + i2, t = t0 + lane;
            uint4 o; o.x = (unsigned)e1; o.y = (unsigned)e2; o.z = __float_as_uint(gw_ * p1); o.w = __float_as_uint(gw_ * p2);
            ((uint4*)tokinfo)[t] = o;
            RSTD[t] = rstd;
            if (!dry) { __hip_atomic_fetch_add(hist + e1, 1, __ATOMIC_RELAXED, __HIP_MEMORY_SCOPE_WORKGROUP); __hip_atomic_fetch_add(hist + e2, 1, __ATOMIC_RELAXED, __HIP_MEMORY_SCOPE_WORKGROUP); }
        }
        asm volatile("s_waitcnt lgkmcnt(0)" ::: "memory");
        __syncthreads();
    }
}

constexpr int G_Z = 0, G_VT = 8192, G_G = 26624, G_ST0 = 43008, G_ST1 = 61440, G_BM = 79872, G_QE = 97280, G_KE = 106496, G_P = 115712, G_TOT = 124928, G_PART = 129024;
constexpr int BMS = 68;
typedef unsigned v2u __attribute__((ext_vector_type(2)));
struct GlaRaw3 { v4u q, k, z, v0, v1, g0, g1, sa0, sa1, sb0, sb1, oa0, oa1; float sq; };
struct GlaRaw1 { v4u k, z, v0, v1; };
__device__ __forceinline__ v4u ld16(const bf16_t* p) { return *(const GAS v4u*)p; }
__device__ __forceinline__ void gla_load3(GlaRaw3& R, int tid, int b, int h, int n, const bf16_t* PROJ, const bf16_t* KVS, const bf16_t* MIXED, const float* SSQ) {
    const size_t tok0 = (size_t)b * T + n * 64;
    const int s8 = tid >> 3, c8 = tid & 7, lane = tid & 63, w = tid >> 6;
    R.q = ld16(PROJ + (tok0 + s8) * PW + C_GQ + h * 64 + c8 * 8);
    R.k = ld16(PROJ + (tok0 + s8) * PW + C_GK + h * 64 + c8 * 8);
    if (tid < 256) R.z = ld16(PROJ + (tok0 + (tid >> 2)) * PW + C_ZF + (tid & 3) * 8);
    R.v0 = ld16(PROJ + (tok0 + (tid >> 4)) * PW + C_GV + h * 128 + (tid & 15) * 8); R.v1 = ld16(PROJ + (tok0 + (tid >> 4) + 32) * PW + C_GV + h * 128 + (tid & 15) * 8);
    const int s16 = tid >> 4, c16 = tid & 15;
    R.g0 = ld16(PROJ + (tok0 + s16) * PW + C_GG + h * 128 + c16 * 8); R.g1 = ld16(PROJ + (tok0 + s16 + 32) * PW + C_GG + h * 128 + c16 * 8);
    const size_t sq = (((size_t)b * 4 + h) * 2) * 64 + n;
    const bf16_t* sp = KVS + sq * 8192 + (tid >> 3) * 64 + (tid & 7) * 8;
    R.sa0 = ld16(sp); R.sa1 = ld16(sp + 64 * 64); R.sb0 = ld16(sp + (size_t)64 * 8192); R.sb1 = ld16(sp + (size_t)64 * 8192 + 64 * 64);
    R.sq = SSQ[(size_t)(tid >> 6) * NTOK + tok0 + (tid & 63)];
}
__device__ __forceinline__ void gla_store_z(LAS unsigned char* lds, int tid, v4u z) {
    if (tid < 256) { LAS f32x4* zp = (LAS f32x4*)(lds + G_Z) + (tid >> 2) * 8 + (tid & 3) * 2;
        zp[0] = (f32x4){__uint_as_float(z.x << 16), __uint_as_float(z.x & 0xffff0000u), __uint_as_float(z.y << 16), __uint_as_float(z.y & 0xffff0000u)};
        zp[1] = (f32x4){__uint_as_float(z.z << 16), __uint_as_float(z.z & 0xffff0000u), __uint_as_float(z.w << 16), __uint_as_float(z.w & 0xffff0000u)}; }
}
__device__ __forceinline__ void gla_store_vt(LAS unsigned char* lds, int tid, v4u v0, v4u v1) {
    LAS bf16_t* VT = (LAS bf16_t*)(lds + G_VT); const int c16 = tid & 15, sA = (tid >> 4) ^ (8 * (c16 & 7)), sB = sA ^ 32;
    const unsigned wa[4] = {v0.x, v0.y, v0.z, v0.w}, wb[4] = {v1.x, v1.y, v1.z, v1.w};
#pragma unroll
    for (int i = 0; i < 4; ++i) { LAS bf16_t* r0 = VT + (c16 * 8 + 2 * i) * LDT; LAS bf16_t* r1 = r0 + LDT;
        r0[sA] = (bf16_t)(wa[i] & 0xffffu); r1[sA] = (bf16_t)(wa[i] >> 16); r0[sB] = (bf16_t)(wb[i] & 0xffffu); r1[sB] = (bf16_t)(wb[i] >> 16); }
}
template <bool VA>
__device__ __forceinline__ gf32x4 mfma_tile64_v(const LAS bf16_t* X, const LAS bf16_t* VTw, int w, gf32x4 acc, int lane) {
    const int r = lane & 15, grp = lane >> 4, g = (2 * w + (r >> 3)) & 7;
    const gbf16x8 x0 = *(const LAS gbf16x8*)(X + r * LDT + grp * 8), x1 = *(const LAS gbf16x8*)(X + r * LDT + grp * 8 + 32);
    const gbf16x8 v0 = *(const LAS gbf16x8*)(VTw + r * LDT + ((grp ^ g) * 8)), v1 = *(const LAS gbf16x8*)(VTw + r * LDT + (((grp + 4) ^ g) * 8));
    if (VA) { acc = __builtin_amdgcn_mfma_f32_16x16x32_bf16(v0, x0, acc, 0, 0, 0); acc = __builtin_amdgcn_mfma_f32_16x16x32_bf16(v1, x1, acc, 0, 0, 0); }
    else    { acc = __builtin_amdgcn_mfma_f32_16x16x32_bf16(x0, v0, acc, 0, 0, 0); acc = __builtin_amdgcn_mfma_f32_16x16x32_bf16(x1, v1, acc, 0, 0, 0); }
    return acc;
}
constexpr int ZBS = 40, GL_UPT = 132096;
template <int DIR>
__device__ __forceinline__ void gla_cumsum3(LAS unsigned char* lds, float bias, int w, int lane, float (&bv)[2][4], float& bl) {
    const LAS bf16_t* ZB = (const LAS bf16_t*)(lds + G_Z); const LAS bf16_t* UPT = (const LAS bf16_t*)(lds + GL_UPT) + DIR * 64 * ZBS; LAS float* tot = (LAS float*)(lds + G_TOT);
    const int r16 = lane & 15, kg = lane >> 4, dcol = 16 * (w & 3) + r16, run0 = 8 * (w >> 2) + kg;
    const gbf16x8 bfr = *(const LAS gbf16x8*)(UPT + (16 * (w & 3) + r16) * ZBS + 8 * kg);
    float c[2][4];
#pragma unroll
    for (int j = 0; j < 2; ++j) {
        const gbf16x8 afr = *(const LAS gbf16x8*)(ZB + (32 * (w >> 2) + 16 * j + r16) * ZBS + 8 * kg);
        const gf32x4 acc = __builtin_amdgcn_mfma_f32_16x16x32_bf16(afr, bfr, (gf32x4){0.f, 0.f, 0.f, 0.f}, 0, 0, 0);
#pragma unroll
        for (int r = 0; r < 4; ++r) c[j][r] = log_sigmoid_f(acc[r] + bias) * (1.f / 16.f);
        if (DIR == 0) { c[j][1] += c[j][0]; c[j][2] += c[j][1]; c[j][3] += c[j][2]; tot[(run0 + 4 * j) * 64 + dcol] = c[j][3]; }
        else          { c[j][2] += c[j][3]; c[j][1] += c[j][2]; c[j][0] += c[j][1]; tot[(run0 + 4 * j) * 64 + dcol] = c[j][0]; }
    }
    __syncthreads();
    float off0 = 0.f, off1 = 0.f, all = 0.f;
#pragma unroll
    for (int q = 0; q < 16; ++q) { const float v = tot[q * 64 + dcol]; all += v;
        if (DIR ? (q > run0) : (q < run0)) off0 += v;
        if (DIR ? (q > run0 + 4) : (q < run0 + 4)) off1 += v; }
#pragma unroll
    for (int r = 0; r < 4; ++r) { bv[0][r] = c[0][r] + off0; bv[1][r] = c[1][r] + off1; }
    bl = all;
}
__device__ __forceinline__ void gla_store_zb(LAS unsigned char* lds, int tid, v4u z) { if (tid < 256) *(LAS v4u*)((LAS bf16_t*)(lds + G_Z) + (tid >> 2) * ZBS + (tid & 3) * 8) = z; }
__device__ __forceinline__ void gla_build_upt(LAS unsigned char* lds, int tid, int h, const float* upf, const float* upb) {
    LAS bf16_t* U0 = (LAS bf16_t*)(lds + GL_UPT); LAS bf16_t* U1 = U0 + 64 * ZBS;
    const int d = tid & 63, k0 = (tid >> 6) * 4;
    unsigned a0 = 0u, a1 = 0u, b0 = 0u, b1 = 0u;
    if (k0 < 16) { const float* p = upf + k0 * 256 + h * 64 + d; a0 = (unsigned)f2bf(p[0]) | ((unsigned)f2bf(p[256]) << 16); a1 = (unsigned)f2bf(p[512]) | ((unsigned)f2bf(p[768]) << 16); }
    else { const float* p = upb + (k0 - 16) * 256 + h * 64 + d; b0 = (unsigned)f2bf(p[0]) | ((unsigned)f2bf(p[256]) << 16); b1 = (unsigned)f2bf(p[512]) | ((unsigned)f2bf(p[768]) << 16); }
    *(LAS v2u*)(U0 + d * ZBS + k0) = (v2u){a0, a1}; *(LAS v2u*)(U1 + d * ZBS + k0) = (v2u){b0, b1};
}
__device__ __forceinline__ unsigned pk_bf2(float a, float b) { return (unsigned)f2bf(a) | ((unsigned)f2bf(b) << 16); }

__device__ __forceinline__ void gla_g3_phase(LAS unsigned char* lds, int tid, int bx, const bf16_t* PROJ, const float* upf, const float* bf_, const float* upb, const float* bb_, const bf16_t* KVS, const float* gain, bf16_t* MIXED, const float* SSQ, float* ratt) {
    const int n = bx & 63, h = (bx >> 6) & 3;
    const int d = tid & 63, tg = tid >> 6, lane = tid & 63, w = tid >> 6, s8 = tid >> 3, c8 = tid & 7;
    const int dcol = 16 * (w & 3) + (lane & 15), tk0 = 32 * (w >> 2) + 4 * (lane >> 4);
    const float bsF = bf_[h * 64 + dcol], bsB = bb_[h * 64 + dcol];
    gla_build_upt(lds, tid, h, upf, upb);
    float ge4[4];
#pragma unroll
    for (int r = 0; r < 4; ++r) ge4[r] = gain[16 * w + 4 * (lane >> 4) + r];
    LAS bf16_t* QE = (LAS bf16_t*)(lds + G_QE); LAS bf16_t* KE = (LAS bf16_t*)(lds + G_KE); LAS bf16_t* PP = (LAS bf16_t*)(lds + G_P);
    LAS bf16_t* VT = (LAS bf16_t*)(lds + G_VT); LAS bf16_t* GG = (LAS bf16_t*)(lds + G_G); LAS float* BM = (LAS float*)(lds + G_BM);
    LAS float* part = (LAS float*)(lds + G_PART); LAS float* rs = (LAS float*)(lds + G_TOT);
    GlaRaw3 R; gla_load3(R, tid, 0, h, n, PROJ, KVS, MIXED, SSQ);
    for (int b = 0; b < NB; ++b) {
        const size_t tok0 = (size_t)b * T + n * 64;
        const v4u cq = R.q, ck = R.k;
        gla_store_zb(lds, tid, R.z); gla_store_vt(lds, tid, R.v0, R.v1);
        { const int s16 = tid >> 4, c16 = tid & 15; *(LAS v4u*)(GG + s16 * 128 + c16 * 8) = R.g0; *(LAS v4u*)(GG + (s16 + 32) * 128 + c16 * 8) = R.g1; }
        { const int e = tid >> 3, c8_ = tid & 7; LAS bf16_t* s0 = (LAS bf16_t*)(lds + G_ST0) + e * LDT + c8_ * 8; LAS bf16_t* s1 = (LAS bf16_t*)(lds + G_ST1) + e * LDT + c8_ * 8;
          *(LAS v4u*)s0 = R.sa0; *(LAS v4u*)(s0 + 64 * LDT) = R.sa1; *(LAS v4u*)s1 = R.sb0; *(LAS v4u*)(s1 + 64 * LDT) = R.sb1; }
        part[tid] = R.sq;
        if (b + 1 < NB) gla_load3(R, tid, b + 1, h, n, PROJ, KVS, MIXED, SSQ);
        __syncthreads();
        if (tid < 64) { float q = 0.f;
#pragma unroll
            for (int hh = 0; hh < 8; ++hh) q += part[hh * 64 + tid];
            const float ms = q * (1.f / 512.f) + EPS; ((LAS float*)(lds + 143360))[tid] = sqrtf(ms); if (h == 0) ratt[tok0 + tid] = rsqrtf(ms); }
        gf32x4 o[4];
#pragma unroll
        for (int rt = 0; rt < 4; ++rt) o[rt] = (gf32x4){0.f, 0.f, 0.f, 0.f};
#pragma unroll
        for (int dir = 0; dir < 2; ++dir) {
            float bv[2][4], bl;
            if (dir == 0) gla_cumsum3<0>(lds, bsF, w, lane, bv, bl); else gla_cumsum3<1>(lds, bsB, w, lane, bv, bl);
#pragma unroll
            for (int j = 0; j < 2; ++j)
#pragma unroll
                for (int r = 0; r < 4; ++r) BM[(tk0 + 16 * j + r) * BMS + dcol] = bv[j][r];
            __syncthreads();
            {
                const f32x4 b0 = *(const LAS f32x4*)(BM + s8 * BMS + c8 * 8), b1 = *(const LAS f32x4*)(BM + s8 * BMS + c8 * 8 + 4);
                const float bb[8] = {b0.x, b0.y, b0.z, b0.w, b1.x, b1.y, b1.z, b1.w};
                const unsigned qw[4] = {cq.x, cq.y, cq.z, cq.w}, kw[4] = {ck.x, ck.y, ck.z, ck.w};
                unsigned qo[4], ko[4];
#pragma unroll
                for (int j = 0; j < 4; ++j) {
                    const float e0 = exp_fast(bb[2 * j]), e1 = exp_fast(bb[2 * j + 1]);
                    qo[j] = pk_bf2(__uint_as_float(qw[j] << 16) * e0 * 0.125f, __uint_as_float(qw[j] & 0xffff0000u) * e1 * 0.125f);
                    ko[j] = pk_bf2(__uint_as_float(kw[j] << 16) * __builtin_amdgcn_rcpf(e0), __uint_as_float(kw[j] & 0xffff0000u) * __builtin_amdgcn_rcpf(e1));
                }
                *(LAS v4u*)(QE + s8 * LDT + c8 * 8) = (v4u){qo[0], qo[1], qo[2], qo[3]}; *(LAS v4u*)(KE + s8 * LDT + c8 * 8) = (v4u){ko[0], ko[1], ko[2], ko[3]};
            }
            __syncthreads();
            { const int ct = w >> 1;
#pragma unroll
              for (int j = 0; j < 2; ++j) { const int st = 2 * (w & 1) + j;
                gf32x4 acc = {0.f, 0.f, 0.f, 0.f};
                acc = mfma_tile64(KE + (16 * st) * LDT, QE + (16 * ct) * LDT, acc, lane);
                const int c = 16 * ct + (lane & 15), s0 = 16 * st + 4 * (lane >> 4);
                float pv[4];
#pragma unroll
                for (int r = 0; r < 4; ++r) { const int s = s0 + r; const bool keep = dir ? (s >= c) : (s <= c); pv[r] = keep ? acc[r] : 0.f; }
                *(LAS v2u*)(PP + c * LDT + s0) = (v2u){pk_bf2(pv[0], pv[1]), pk_bf2(pv[2], pv[3])}; } }
            __syncthreads();
            const LAS bf16_t* ST = (const LAS bf16_t*)(lds + (dir ? G_ST1 : G_ST0));
#pragma unroll
            for (int rt = 0; rt < 4; ++rt) {
                o[rt] = mfma_tile64_v<true>(PP + (16 * rt) * LDT, VT + (16 * w) * LDT, w, o[rt], lane);
                o[rt] = mfma_tile64(ST + (16 * w) * LDT, QE + (16 * rt) * LDT, o[rt], lane);
            }
        }
#pragma unroll
        for (int rt = 0; rt < 4; ++rt) {
            float ss = o[rt][0] * o[rt][0] + o[rt][1] * o[rt][1] + o[rt][2] * o[rt][2] + o[rt][3] * o[rt][3];
            ss += __shfl_xor(ss, 16); ss += __shfl_xor(ss, 32);
            if (lane < 16) part[w * 64 + 16 * rt + lane] = ss;
        }
        __syncthreads();
        if (tid < 64) { float ss = 0.f;
#pragma unroll
            for (int t2 = 0; t2 < 8; ++t2) ss += part[t2 * 64 + tid];
            rs[tid] = rsqrtf(ss * (1.f / 128.f) + EPS) * ((LAS float*)(lds + 143360))[tid]; }
        __syncthreads();
#pragma unroll
        for (int rt = 0; rt < 4; ++rt) { const int c = 16 * rt + (lane & 15), e0 = 16 * w + 4 * (lane >> 4);
            const v2u gw2 = *(const LAS v2u*)(GG + c * 128 + e0);
            const float gv[4] = {__uint_as_float(gw2.x << 16), __uint_as_float(gw2.x & 0xffff0000u), __uint_as_float(gw2.y << 16), __uint_as_float(gw2.y & 0xffff0000u)};
            const float rc = rs[c]; float ov[4];
#pragma unroll
            for (int r = 0; r < 4; ++r) ov[r] = o[rt][r] * rc * ge4[r] * gv[r] * __builtin_amdgcn_rcpf(1.f + exp_fast(-gv[r]));
            *(GAS v2u*)(MIXED + (tok0 + c) * D + 512 + h * 128 + e0) = (v2u){pk_bf2(ov[0], ov[1]), pk_bf2(ov[2], ov[3])}; }
        __syncthreads();
    }
}
__device__ __forceinline__ void gla_load1(GlaRaw1& R, int tid, int b, int h, int n, const bf16_t* PROJ) {
    const size_t tok0 = (size_t)b * T + n * 64;
    const int s8 = tid >> 3, c8 = tid & 7, lane = tid & 63, w = tid >> 6;
    R.k = ld16(PROJ + (tok0 + s8) * PW + C_GK + h * 64 + c8 * 8);
    if (tid < 256) R.z = ld16(PROJ + (tok0 + (tid >> 2)) * PW + C_ZF + (tid & 3) * 8);
    R.v0 = ld16(PROJ + (tok0 + (tid >> 4)) * PW + C_GV + h * 128 + (tid & 15) * 8); R.v1 = ld16(PROJ + (tok0 + (tid >> 4) + 32) * PW + C_GV + h * 128 + (tid & 15) * 8);
}
__device__ __forceinline__ void gla_g1_phase(LAS unsigned char* lds, int tid, int bx, const bf16_t* PROJ, const float* upf, const float* bf_, const float* upb, const float* bb_, bf16_t* KVS, float* DEC) {
    const int n = bx & 63, h = (bx >> 6) & 3;
    const int d = tid & 63, tg = tid >> 6, lane = tid & 63, w = tid >> 6, s8 = tid >> 3, c8 = tid & 7;
    const int dcol = 16 * (w & 3) + (lane & 15), tk0 = 32 * (w >> 2) + 4 * (lane >> 4);
    const float bsF = bf_[h * 64 + dcol], bsB = bb_[h * 64 + dcol];
    gla_build_upt(lds, tid, h, upf, upb);
    LAS bf16_t* KR = (LAS bf16_t*)(lds + G_G); LAS bf16_t* KET = (LAS bf16_t*)(lds + G_QE); LAS bf16_t* VT = (LAS bf16_t*)(lds + G_VT);
    GlaRaw1 R; gla_load1(R, tid, 0, h, n, PROJ);
    for (int b = 0; b < NB; ++b) {
        gla_store_zb(lds, tid, R.z); gla_store_vt(lds, tid, R.v0, R.v1);
        *(LAS v4u*)(KR + s8 * LDT + c8 * 8) = R.k;
        if (b + 1 < NB) gla_load1(R, tid, b + 1, h, n, PROJ);
        __syncthreads();
#pragma unroll
        for (int dir = 0; dir < 2; ++dir) {
            float bv[2][4], bl;
            if (dir == 0) gla_cumsum3<0>(lds, bsF, w, lane, bv, bl); else gla_cumsum3<1>(lds, bsB, w, lane, bv, bl);
#pragma unroll
            for (int j = 0; j < 2; ++j) {
                const int t0 = tk0 + 16 * j;
                const unsigned p0 = pk_bf2(bf2f(KR[(t0 + 0) * LDT + dcol]) * exp_fast(bl - bv[j][0]), bf2f(KR[(t0 + 1) * LDT + dcol]) * exp_fast(bl - bv[j][1]));
                const unsigned p1 = pk_bf2(bf2f(KR[(t0 + 2) * LDT + dcol]) * exp_fast(bl - bv[j][2]), bf2f(KR[(t0 + 3) * LDT + dcol]) * exp_fast(bl - bv[j][3]));
                *(LAS v2u*)(KET + dcol * LDT + t0) = (v2u){p0, p1};
            }
            const size_t sq = (((size_t)b * 4 + h) * 2 + dir) * 64 + n;
            if (w < 4 && lane < 16) DEC[sq * 64 + dcol] = exp_fast(bl);
            __syncthreads();
            bf16_t* kvo = KVS + sq * 8192;
#pragma unroll
            for (int dt = 0; dt < 4; ++dt) {
                gf32x4 acc = {0.f, 0.f, 0.f, 0.f};
                acc = mfma_tile64_v<false>(KET + (16 * dt) * LDT, VT + (16 * w) * LDT, w, acc, lane);
                *(GAS v2u*)(kvo + (size_t)(16 * w + (lane & 15)) * 64 + 16 * dt + 4 * (lane >> 4)) = (v2u){pk_bf2(acc[0], acc[1]), pk_bf2(acc[2], acc[3])};
            }
        }
        __syncthreads();
    }
}
#include <hip/hip_bf16.h>
#include <cmath>
namespace attn_body {
using bf16=__hip_bfloat16;
using bf16x8=__attribute__((ext_vector_type(8)))short;
using s16x4=__attribute__((ext_vector_type(4)))short;
using f32x16=__attribute__((ext_vector_type(16)))float;
using u32x4=__attribute__((ext_vector_type(4)))unsigned;
constexpr int BATCH=8,NHEAD=8,SEQ=4096,D=64,DM=2560,OP=1024;
constexpr int NW=8,QBLK=32,QB=QBLK*NW,KVBLK=64,NQB=SEQ/QB;
constexpr int ATTN_PITCH=DM, ATTN_UNIT_ROWS=QB;
__device__ __forceinline__ int crow(int r,int hi){return (r&3)+8*(r>>2)+4*hi;}
#define SBAR() __builtin_amdgcn_sched_barrier(0)
__device__ __forceinline__ void cmask(f32x16&p0,f32x16&p1,int jb,int qrel,int hi){
  const float NEG=-INFINITY; int kb=64*jb+4*hi;
  #pragma unroll
  for(int r=0;r<16;++r){int kv=kb+(r&3)+8*(r>>2); if(kv>qrel)p0[r]=NEG; if(kv+32>qrel)p1[r]=NEG;}
}

constexpr int NSLOT=3, SLOTB=8192;
constexpr int LDS_K=0, LDS_V=NSLOT*SLOTB, LDS_WS=2*NSLOT*SLOTB, LDS_OST=LDS_WS+NW*64*4, LDS_BYTES=LDS_OST+NW*4096;
constexpr bool FIXREF=true;
constexpr float C2=0.125f*1.4426950408889634f;
__device__ __forceinline__ void glds16(const void*gsrc,unsigned lds_dst){unsigned keep;
  asm volatile("s_mov_b32 %0, m0\n\ts_mov_b32 m0, %2\n\ts_nop 0\n\tglobal_load_lds_dwordx4 %1, off\n\ts_mov_b32 m0, %0":"=&s"(keep):"v"(gsrc),"s"(lds_dst):"memory");}
__device__ __forceinline__ float max3f(float a,float b,float c){float r;asm("v_max3_f32 %0, %1, %2, %3":"=v"(r):"v"(a),"v"(b),"v"(c));return r;}
__device__ __forceinline__ float max2f(float a,float b){float r;asm("v_max_f32_e32 %0, %1, %2":"=v"(r):"v"(a),"v"(b));return r;}
__device__ __forceinline__ float fadd_s(float a,float b){float r;asm("v_add_f32_e32 %0, %1, %2":"=v"(r):"v"(a),"v"(b));return r;}
__device__ __forceinline__ float fsub_s(float a,float b){float r;asm("v_sub_f32_e32 %0, %1, %2":"=v"(r):"v"(a),"v"(b));return r;}
typedef float f32x2_t __attribute__((ext_vector_type(2))); typedef __bf16 bf16x2_t __attribute__((ext_vector_type(2)));
__device__ __forceinline__ unsigned cvtpk_s(float lo,float hi){f32x2_t v={lo,hi};bf16x2_t b=__builtin_convertvector(v,bf16x2_t);return __builtin_bit_cast(unsigned,b);}
#define WAIT_BAR(N) asm volatile("s_waitcnt vmcnt(" #N ") lgkmcnt(0)\n\ts_barrier":::"memory")

__device__ __forceinline__ void qkt(f32x16&p0,f32x16&p1,const char*Kslot,const bf16x8*qr,const f32x16&negm,int r32,int hi){
  const char*kb=Kslot+r32*128; const int xs=(r32>>1)&7;
  #pragma unroll
  for(int d0=0;d0<4;++d0){
    const bf16x8 b0=*reinterpret_cast<const bf16x8*>(kb+(((2*d0+hi)^xs)<<4));
    const bf16x8 b1=*reinterpret_cast<const bf16x8*>(kb+(((2*d0+hi)^xs)<<4)+4096);
    if(d0==0){p0=__builtin_amdgcn_mfma_f32_32x32x16_bf16(b0,qr[0],negm,0,0,0);p1=__builtin_amdgcn_mfma_f32_32x32x16_bf16(b1,qr[0],negm,0,0,0);}
    else{p0=__builtin_amdgcn_mfma_f32_32x32x16_bf16(b0,qr[d0],p0,0,0,0);p1=__builtin_amdgcn_mfma_f32_32x32x16_bf16(b1,qr[d0],p1,0,0,0);}}
}
typedef __attribute__((address_space(3))) const char* lds_cptr;
typedef short v4i16_t __attribute__((ext_vector_type(4)));
struct KBases { int o[4]; };
__device__ __forceinline__ void kload8(bf16x8*kf,lds_cptr kring,const KBases&kb,int sl){
  #pragma unroll
  for(int d0=0;d0<4;++d0){ kf[2*d0]=*(const __attribute__((address_space(3))) bf16x8*)(kring+kb.o[d0]+sl); kf[2*d0+1]=*(const __attribute__((address_space(3))) bf16x8*)(kring+kb.o[d0]+sl+4096); }
}
__device__ __forceinline__ void kload2(bf16x8*kf,lds_cptr kring,const KBases&kb,int sl,int j){ kf[2*j]=*(const __attribute__((address_space(3))) bf16x8*)(kring+kb.o[j]+sl); kf[2*j+1]=*(const __attribute__((address_space(3))) bf16x8*)(kring+kb.o[j]+sl+4096); }
__device__ __forceinline__ s16x4 vtr(lds_cptr p){ return __builtin_bit_cast(s16x4,__builtin_amdgcn_ds_read_tr16_b64_v4i16((__attribute__((address_space(3))) v4i16_t*)p)); }
__device__ __forceinline__ float rowmax(const f32x16&p0,const f32x16&p1){
  float a=max3f(p0[0],p0[1],p1[0]),b=max3f(p0[2],p0[3],p1[1]);a=max3f(a,p1[2],p1[3]);
  #pragma unroll
  for(int r=4;r<16;r+=4){a=max3f(a,p0[r],p0[r+1]);b=max3f(b,p0[r+2],p0[r+3]);a=max3f(a,p1[r],p1[r+1]);b=max3f(b,p1[r+2],p1[r+3]);}
  const float m=max2f(a,b);
  auto rr=__builtin_amdgcn_permlane32_swap(__float_as_uint(m),__float_as_uint(m),false,false);
  return max2f(__uint_as_float(rr[0]),__uint_as_float(rr[1]));
}
__device__ __forceinline__ void pv(f32x16*o,int vb,bf16x8 pa0,bf16x8 pa1,bf16x8 pa2,bf16x8 pa3){
  #pragma unroll
  for(int d0=0;d0<2;++d0){s16x4 lo[4],hi[4];
    #pragma unroll
    for(int ks=0;ks<4;++ks){
      asm volatile("ds_read_b64_tr_b16 %0,%1 offset:%c2":"=&v"(lo[ks]):"v"(vb),"i"(d0*4096+ks*1024):"memory");
      asm volatile("ds_read_b64_tr_b16 %0,%1 offset:%c2":"=&v"(hi[ks]):"v"(vb),"i"(d0*4096+ks*1024+512):"memory");}
    asm volatile("s_waitcnt lgkmcnt(0)":::"memory");SBAR();
    #define PK(k) (bf16x8){lo[k][0],lo[k][1],lo[k][2],lo[k][3],hi[k][0],hi[k][1],hi[k][2],hi[k][3]}
    o[d0]=__builtin_amdgcn_mfma_f32_32x32x16_bf16(pa0,PK(0),o[d0],0,0,0);
    o[d0]=__builtin_amdgcn_mfma_f32_32x32x16_bf16(pa1,PK(1),o[d0],0,0,0);
    o[d0]=__builtin_amdgcn_mfma_f32_32x32x16_bf16(pa2,PK(2),o[d0],0,0,0);
    o[d0]=__builtin_amdgcn_mfma_f32_32x32x16_bf16(pa3,PK(3),o[d0],0,0,0);
    #undef PK
  }
}

#ifndef ATTN_STORE16
#define ATTN_STORE16(p,v) (*(u32x4*)(p)=(v))
#endif
template<int THRL> __device__ __forceinline__ void attn_unit(int b,int h,int qb,const bf16*Q,const bf16*__restrict__ K,const bf16*__restrict__ V,bf16*O,char*shm,const float*qg,const float*rope,float*ssq,float sbound){
  const int tid=threadIdx.x,lane=tid&63,r32=lane&31,hi=lane>>5; const int wid=__builtin_amdgcn_readfirstlane(tid>>6);
  const long rowbase=(long)b*SEQ; const int q0=qb*QB;
  const bf16*Qw=Q+(rowbase+q0+wid*QBLK)*DM+h*D;
  const bf16*Kh=K+rowbase*DM+(h>>2)*D,*Vh=V+rowbase*DM+(h>>2)*D;
  const unsigned lds0=(unsigned)(uintptr_t)shm;
  float*wsf=(float*)(shm+LDS_WS)+wid*64;
  const unsigned koff=(unsigned)((8*wid+(lane>>3))*DM+(((lane&7)^((4*wid+(lane>>4))&7))*8)),
  voff_dummy_=0u, voff=(unsigned)((16*(wid&3)+(lane>>2))*DM+(wid>>2)*32+(lane&3)*8);
  const unsigned kdst=lds0+LDS_K+wid*1024, vdst=lds0+LDS_V+wid*1024;
  #define DMA_K(t,slot) glds16(Kh+(long)(t)*KVBLK*DM+koff,(unsigned)__builtin_amdgcn_readfirstlane(kdst+(slot)))
  #define DMA_V(t,slot) glds16(Vh+(long)(t)*KVBLK*DM+voff,(unsigned)__builtin_amdgcn_readfirstlane(vdst+(slot)))
  const int vb0=(int)(lds0+LDS_V)+((lane>>4)&1)*32+(lane&3)*8+(4*hi+((lane&15)>>2))*64;
  const char*Kbase=shm+LDS_K; bf16x8 kf[8];
  const lds_cptr shm3=(lds_cptr)shm; const lds_cptr kring=shm3+LDS_K; KBases kbs; _Pragma("unroll") for(int d0=0;d0<4;++d0)kbs.o[d0]=r32*128+(((2*d0+hi)^((r32>>1)&7))<<4); const lds_cptr vp0=shm3+LDS_V+((lane>>4)&1)*32+(lane&3)*8+(4*hi+((lane&15)>>2))*64;
  const int NT=SEQ/KVBLK;
  DMA_K(0,0);DMA_V(0,0);DMA_K(1,SLOTB);
  bf16x8 qr[4];
  #pragma unroll
  for(int d0=0;d0<4;++d0)qr[d0]=*reinterpret_cast<const bf16x8*>(&Qw[(long)r32*DM+d0*16+hi*8]);
  {
    float x[4][8]; float ss=0.f;
    #pragma unroll
    for(int d0=0;d0<4;++d0){
      #pragma unroll
      for(int j=0;j<8;++j){ x[d0][j]=__uint_as_float(((unsigned)(unsigned short)qr[d0][j])<<16); ss+=x[d0][j]*x[d0][j]; } }
    ss+=__shfl_xor(ss,32);
    const float rstd=rsqrtf(ss*(1.f/64.f)+1e-6f);
    const int tt=q0+wid*QBLK+r32, prow=tt>>6, pcol=tt&63;
    #pragma unroll
    for(int d0=0;d0<4;++d0){
      const float4 g0=*reinterpret_cast<const float4*>(qg+d0*16+hi*8), g1=*reinterpret_cast<const float4*>(qg+d0*16+hi*8+4);
      const int pos=(d0<2)?prow:pcol, i0=8*(d0&1)+4*hi;
      const float4 c4=*reinterpret_cast<const float4*>(rope+pos*16+i0), s4=*reinterpret_cast<const float4*>(rope+1024+pos*16+i0);
      const float gg[8]={g0.x,g0.y,g0.z,g0.w,g1.x,g1.y,g1.z,g1.w}, cc[4]={c4.x,c4.y,c4.z,c4.w}, sn[4]={s4.x,s4.y,s4.z,s4.w};
      u32x4 pw;
      #pragma unroll
      for(int jj=0;jj<4;++jj){ const float y0=x[d0][2*jj]*rstd*gg[2*jj], y1=x[d0][2*jj+1]*rstd*gg[2*jj+1];
        pw[jj]=cvtpk_s((y0*cc[jj]-y1*sn[jj])*C2,(y0*sn[jj]+y1*cc[jj])*C2); }
      qr[d0]=__builtin_bit_cast(bf16x8,pw); } }
  float mhat=0.f,l_reg=0.f;f32x16 o[2];o[0]=f32x16{};o[1]=f32x16{};f32x16 negm; _Pragma("unroll") for(int r=0;r<16;++r)negm[r]=FIXREF?-sbound:0.f; asm volatile("":"+v"(negm));

  #define CMASK(P0,P1,t) do{}while(0)
  bool resc=false;
  #define START(P0,P1) do{ resc=false; if(!FIXREF) \
    { const float rm=rowmax(P0,P1); const float dl=rm; mhat=fadd_s(mhat,dl); \
      _Pragma("unroll") for(int r=0;r<16;++r){P0[r]=fsub_s(P0[r],dl);P1[r]=fsub_s(P1[r],dl);} \
      _Pragma("unroll") for(int r=0;r<16;++r)negm[r]=-mhat; asm volatile("":"+v"(negm)); } \
    _Pragma("unroll") for(int r=0;r<16;++r)P0[r]=__builtin_amdgcn_exp2f(P0[r]); }while(0)
  #define RESC() do{ if(resc){ asm volatile("s_waitcnt lgkmcnt(0)":::"memory"); \
      _Pragma("unroll") for(int d_=0;d_<2;++d_) _Pragma("unroll") for(int r=0;r<16;++r)o[d_][r]*=wsf[crow(r,hi)]; } }while(0)
  f32x16 pA0,pA1,pB0,pB1;
  int sl_prev=0,sl_cur=0,sl_next=SLOTB;
  #define ROT() do{sl_prev=sl_cur;sl_cur=sl_next;sl_next=(sl_next==(NSLOT-1)*SLOTB)?0:sl_next+SLOTB;}while(0)
  DMA_K(2,2*SLOTB);
  WAIT_BAR(3);
  qkt(pA0,pA1,Kbase,qr,negm,r32,hi);asm volatile("s_nop 15\n\ts_nop 7":"+v"(pA0),"+v"(pA1));CMASK(pA0,pA1,0);
  START(pA0,pA1);
  _Pragma("unroll") for(int r=0;r<16;++r)pA1[r]=__builtin_amdgcn_exp2f(pA1[r]);
  WAIT_BAR(0);
  DMA_K(3,0);DMA_V(1,SLOTB);
  ROT();
  kload8(kf,kring,kbs,sl_cur);
  WAIT_BAR(2);
  s16x4 vlo[8],vhi[8]; u32x4 pw0,pw1,pw2,pw3;
  #define PKW(P,B) cvtpk_s(P[B],P[B+1])
  #define PAF(k) __builtin_bit_cast(bf16x8,pw##k)
  #define VFR(i) (bf16x8){vlo[i][0],vlo[i][1],vlo[i][2],vlo[i][3],vhi[i][0],vhi[i][1],vhi[i][2],vhi[i][3]}
  #define PIN(x) asm volatile("":"+v"(x))
  #define MX3(a,b,c) __builtin_fmaxf(__builtin_fmaxf((a),(b)),(c))
  #define GAPA(MF,A0,A1,A2,A3,W0,W1,PW) do{ MF; sacc+=A0; sacc+=A1; sacc+=A2; sacc+=A3; PIN(sacc); W0; W1; PIN(PW); SBAR(); }while(0)
  #define EX(v) __builtin_amdgcn_exp2f(v)
  #define GAPB(MF,X,B) do{ MF; X[B]=EX(X[B]); X[B+1]=EX(X[B+1]); X[B+2]=EX(X[B+2]); X[B+3]=EX(X[B+3]); PIN(X); SBAR(); }while(0)
  #define VRD(i) do{ vlo[i]=vtr(vp_+(((i)>>2)*4096+((i)&3)*1024)); vhi[i]=vtr(vp_+(((i)>>2)*4096+((i)&3)*1024+512)); }while(0)
  #define KRD(G,j) do{ if(G){ kload2(kf,kring,kbs,sl_next,j); SBAR(); } }while(0)
  #define STEP(C0,C1,P0,P1,t,GK,GV,GL) do{ SBAR(); \
    const lds_cptr vp_=vp0+sl_prev; \
    VRD(0); SBAR(); float sacc=(P0[0]+P0[1]); \
    GAPA(C0=__builtin_amdgcn_mfma_f32_32x32x16_bf16(kf[0],qr[0],negm,0,0,0), P0[2],P0[3],P0[4],P0[5],     pw0[0]=PKW(P0,0), pw0[1]=PKW(P0,2), pw0); \
    VRD(4); SBAR(); GAPA(C1=__builtin_amdgcn_mfma_f32_32x32x16_bf16(kf[1],qr[0],negm,0,0,0), P0[6],P0[7],P0[8],P0[9],     pw0[2]=PKW(P0,4), pw0[3]=PKW(P0,6), pw0); \
    VRD(1); SBAR(); GAPA(C0=__builtin_amdgcn_mfma_f32_32x32x16_bf16(kf[2],qr[1],C0,0,0,0),   P0[10],P0[11],P0[12],P0[13], pw1[0]=PKW(P0,8), pw1[1]=PKW(P0,10), pw1); \
    VRD(5); SBAR(); GAPA(C1=__builtin_amdgcn_mfma_f32_32x32x16_bf16(kf[3],qr[1],C1,0,0,0),   P0[14],P0[15],P1[0],P1[1],   pw1[2]=PKW(P0,12),pw1[3]=PKW(P0,14), pw1); \
    VRD(2); SBAR(); GAPA(C0=__builtin_amdgcn_mfma_f32_32x32x16_bf16(kf[4],qr[2],C0,0,0,0),   P1[2],P1[3],P1[4],P1[5],     pw2[0]=PKW(P1,0), pw2[1]=PKW(P1,2), pw2); \
    VRD(6); SBAR(); GAPA(C1=__builtin_amdgcn_mfma_f32_32x32x16_bf16(kf[5],qr[2],C1,0,0,0),   P1[6],P1[7],P1[8],P1[9],     pw2[2]=PKW(P1,4), pw2[3]=PKW(P1,6), pw2); \
    VRD(3); SBAR(); GAPA(C0=__builtin_amdgcn_mfma_f32_32x32x16_bf16(kf[6],qr[3],C0,0,0,0),   P1[10],P1[11],P1[12],P1[13], pw3[0]=PKW(P1,8), pw3[1]=PKW(P1,10), pw3); \
    VRD(7); SBAR(); GAPA(C1=__builtin_amdgcn_mfma_f32_32x32x16_bf16(kf[7],qr[3],C1,0,0,0),   P1[14],P1[15],0.f,0.f,       pw3[2]=PKW(P1,12),pw3[3]=PKW(P1,14), pw3); \
    l_reg+=sacc; \
    if(GK){DMA_K((t)+3,sl_cur);} if(GV){DMA_V((t)+1,sl_next);} \
    CMASK(C0,C1,t); \
    if(!FIXREF){ float a=MX3(C0[0],C0[1],C1[0]),b=MX3(C0[2],C0[3],C1[1]); a=MX3(a,C1[2],C1[3]); \
      _Pragma("unroll") for(int r=4;r<16;r+=4){a=MX3(a,C0[r],C0[r+1]);b=MX3(b,C0[r+2],C0[r+3]);a=MX3(a,C1[r],C1[r+1]);b=MX3(b,C1[r+2],C1[r+3]);} \
      float rm=__builtin_fmaxf(a,b); { auto rr=__builtin_amdgcn_permlane32_swap(__float_as_uint(rm),__float_as_uint(rm),false,false); rm=__builtin_fmaxf(__uint_as_float(rr[0]),__uint_as_float(rr[1])); } \
      resc=false; \
      if(__builtin_expect(__any(rm>(float)THRL),0)){ const float dl=__builtin_fmaxf(rm,0.f); mhat+=dl; \
        _Pragma("unroll") for(int r=0;r<16;++r){C0[r]-=dl;C1[r]-=dl;} \
        _Pragma("unroll") for(int r=0;r<16;++r)negm[r]=-mhat; asm volatile("":"+v"(negm)); \
        const float f=__builtin_amdgcn_exp2f(-dl); l_reg*=f; if(hi==0)wsf[r32]=f; resc=true; } } \
    SBAR(); \
    GAPB(o[0]=__builtin_amdgcn_mfma_f32_32x32x16_bf16(PAF(0),VFR(0),o[0],0,0,0), C0,0); \
    GAPB(o[1]=__builtin_amdgcn_mfma_f32_32x32x16_bf16(PAF(0),VFR(4),o[1],0,0,0), C0,4); \
    KRD(GL,0); GAPB(o[0]=__builtin_amdgcn_mfma_f32_32x32x16_bf16(PAF(1),VFR(1),o[0],0,0,0), C0,8); \
    KRD(GL,1); GAPB(o[1]=__builtin_amdgcn_mfma_f32_32x32x16_bf16(PAF(1),VFR(5),o[1],0,0,0), C0,12); \
    KRD(GL,2); GAPB(o[0]=__builtin_amdgcn_mfma_f32_32x32x16_bf16(PAF(2),VFR(2),o[0],0,0,0), C1,0); \
    KRD(GL,3); GAPB(o[1]=__builtin_amdgcn_mfma_f32_32x32x16_bf16(PAF(2),VFR(6),o[1],0,0,0), C1,4); \
    GAPB(o[0]=__builtin_amdgcn_mfma_f32_32x32x16_bf16(PAF(3),VFR(3),o[0],0,0,0), C1,8); \
    GAPB(o[1]=__builtin_amdgcn_mfma_f32_32x32x16_bf16(PAF(3),VFR(7),o[1],0,0,0), C1,12); \
    }while(0)
  int t=1;
  #undef CMASK
  #define CMASK(P0,P1,t) do{}while(0)
  for(;t+5<NT;t+=2){
    STEP(pB0,pB1,pA0,pA1,t,true,true,true);     WAIT_BAR(2); RESC(); ROT();
    STEP(pA0,pA1,pB0,pB1,t+1,true,true,true);   WAIT_BAR(2); RESC(); ROT();
  }
  #undef CMASK
  #define CMASK(P0,P1,t) do{}while(0)
  #define ENDW(tt) do{ if((tt)+3<NT){WAIT_BAR(2);} else if((tt)+2<NT){WAIT_BAR(1);} else {WAIT_BAR(0);} }while(0)
  for(;t+1<NT;t+=2){
    STEP(pB0,pB1,pA0,pA1,t,(t+3<NT),(t+1<NT),(t+1<NT));       ENDW(t);   RESC(); ROT();
    STEP(pA0,pA1,pB0,pB1,t+1,(t+4<NT),(t+2<NT),(t+2<NT));     ENDW(t+1); RESC(); ROT();
  }
  STEP(pB0,pB1,pA0,pA1,NT-1,false,false,false); RESC();
  { float sacc=pB0[0]+pB0[1]; _Pragma("unroll") for(int r=2;r<16;++r)sacc+=pB0[r]; _Pragma("unroll") for(int r=0;r<16;++r)sacc+=pB1[r]; l_reg+=sacc;
    pw0=(u32x4){PKW(pB0,0),PKW(pB0,2),PKW(pB0,4),PKW(pB0,6)};pw1=(u32x4){PKW(pB0,8),PKW(pB0,10),PKW(pB0,12),PKW(pB0,14)};pw2=(u32x4){PKW(pB1,0),PKW(pB1,2),PKW(pB1,4),PKW(pB1,6)};pw3=(u32x4){PKW(pB1,8),PKW(pB1,10),PKW(pB1,12),PKW(pB1,14)};
    SBAR(); pv(o,vb0+sl_cur,PAF(0),PAF(1),PAF(2),PAF(3)); }
  #undef PKW
  #undef PAF
  #undef VFR
  #undef PIN
  #undef MX3
  #undef GAPA
  #undef GAPB
  #undef EX
  #undef VRD
  #undef KRD
  #undef STEP
  #undef ENDW
  {auto rr=__builtin_amdgcn_permlane32_swap(__float_as_uint(l_reg),__float_as_uint(l_reg),false,false);l_reg=__uint_as_float(rr[0])+__uint_as_float(rr[1]);}
  if(hi==0)wsf[32+r32]=l_reg;asm volatile("s_waitcnt lgkmcnt(0)":::"memory");
  float rli[16];
  #pragma unroll
  for(int r=0;r<16;++r)rli[r]=__builtin_amdgcn_rcpf(wsf[32+crow(r,hi)]);
  bf16*Ow=O+(rowbase+q0+wid*QBLK)*OP+h*D;
  { bf16*stg=(bf16*)(shm+LDS_OST)+wid*2048;
    #pragma unroll
    for(int r=0;r<16;++r){const int orow=crow(r,hi);
      #pragma unroll
      for(int d0=0;d0<2;++d0)stg[orow*64+d0*32+r32]=__float2bfloat16(o[d0][r]*rli[r]);}
    asm volatile("s_waitcnt lgkmcnt(0)":::"memory");
    #pragma unroll
    for(int i=0;i<4;++i){const int row=i*8+(lane>>3),ch=lane&7; const u32x4 v=*(const u32x4*)(stg+row*64+ch*8); ATTN_STORE16(Ow+(long)row*OP+ch*8,v);
      float sq=0.f;
      #pragma unroll
      for(int k=0;k<4;++k){ const float lo=__uint_as_float(v[k]<<16), hi_=__uint_as_float(v[k]&0xffff0000u); sq+=lo*lo+hi_*hi_; }
      sq+=__shfl_xor(sq,1); sq+=__shfl_xor(sq,2); sq+=__shfl_xor(sq,4);
      if(ch==0) ssq[(long)h*(BATCH*SEQ)+rowbase+q0+wid*QBLK+row]=sq; } }
  asm volatile("s_waitcnt lgkmcnt(0)\n\ts_barrier":::"memory");
  #undef DMA_K
  #undef DMA_V
  #undef CMASK
  #undef START
  #undef RESC
  #undef ROT
}
constexpr int ATTN_LDS_BYTES=LDS_BYTES;
struct AttnTensors { const bf16* Q; const bf16* K; const bf16* V; bf16* O; const float* qg; const float* rope; float* ssq; float sbound; };
struct AttnUnit { int bh; int qb; };
struct StaticOrder {
  int vcu;
  __device__ __forceinline__ explicit StaticOrder(int grid,int block):vcu((block%8)*(grid/8)+block/8){}
  __device__ __forceinline__ bool next(int i,AttnUnit&u)const{ if(i>=4)return false; const int pair=vcu>>4, c16=vcu&15; u.bh=(pair>>1)*NHEAD+(pair&1)*4+(c16>>2); u.qb=(c16&3)*4+i; return true; }
  __device__ __forceinline__ void a_ready(const AttnUnit&)const{}
  __device__ __forceinline__ void done(const AttnUnit&)const{}
};
template<class Sched,int THRL=8> __device__ __forceinline__ void attn_phase(char*lds,const AttnTensors&T,const Sched&S){
  AttnUnit u;
  for(int i=0;S.next(i,u);++i){ S.a_ready(u); attn_unit<THRL>(u.bh/NHEAD,u.bh%NHEAD,u.qb,T.Q,T.K,T.V,T.O,lds,T.qg,T.rope,T.ssq,T.sbound); S.done(u); }
}
#undef SBAR
#undef WAIT_BAR
}

constexpr int NWAVES = 8;
constexpr int RING_OFF = 0, RING_BYTES = 131072;
constexpr int LDSCTL_OFF = RING_BYTES, MISC_OFF = LDSCTL_OFF + 320;
constexpr int LDS_BYTES = 147456;
constexpr int CW_BAR = 32768;
constexpr int MAX_LAUNCH = 8;
static_assert((CW_BAR + MAX_LAUNCH * XCD_BAR_WORDS) * 4 <= (int)(1 * MiB), "barrier words inside the memset region");
constexpr size_t WS_WINT = 4 * MiB;
constexpr size_t WS_WOUTT = 9 * MiB;
constexpr size_t WS_SSQ = 13 * MiB;
constexpr size_t WS_RSTD = 3 * MiB + 65536;
constexpr size_t WS_WGU = 16 * MiB;
constexpr size_t WS_WD = 144 * MiB;
constexpr int TAB_OFF = LDSCTL_OFF + 1024;
constexpr int XS_ROWS = NSLOT + 256;

constexpr int PROF_A = -1, PROF_B = -1;
constexpr int CW_PROF = 20000;
constexpr int FP8TEST = 0;
constexpr int NCONV = 136;
constexpr int CW_COUNTS2 = 70000, CW_CURSOR2 = 75000, CW_TILECNT = 90000;
constexpr int HIST_OFF = 49152, POS_OFF = 50176;
constexpr int REP0 = 1, REPG1 = 1, REPG3 = 1, REPATT = 1, REPM1 = 1, REPM2 = 1, REPP1 = 1, REPALL = 1, REPU = 1, REPP5 = 1, DRYQK = 0, DRYAN = 0, DRYSC = 0, DRYFIN = 0, DRYRT = 0;
struct Args { const float* in[21]; float* out; unsigned char* ws; int ph_lo, ph_hi, li, pad; };

struct Frame {
    LAS unsigned char* lds;
    volatile LAS unsigned* MISC;
    int tid, lane, wave, vcu, G;
};

template <bool NT = false>
__device__ __forceinline__ void p0_transpose_item(const float* W, int ldw, int k0, int ns0, bf16* WT, int K, int nd0, LAS float* scr, int lane) {
    if (ns0 >= 0) {
        f32x4 v[8];
#pragma unroll
        for (int i = 0; i < 8; ++i) { const GAS f32x4* p = (const GAS f32x4*)(W + (size_t)(k0 + 8 * i + (lane >> 3)) * ldw + ns0 + (lane & 7) * 4); v[i] = NT ? __builtin_nontemporal_load(p) : *p; }
#pragma unroll
        for (int i = 0; i < 8; ++i) { LAS float* p = scr + (8 * i + (lane >> 3)) * 33 + (lane & 7) * 4; p[0] = v[i].x; p[1] = v[i].y; p[2] = v[i].z; p[3] = v[i].w; }
    } else {
#pragma unroll 8
        for (int i = 0; i < 32; ++i) { const int kk = 2 * i + (lane >> 5); scr[kk * 33 + (lane & 31)] = 0.f; }
    }
    LDS_WAIT(); asm volatile("" ::: "memory");
    const int c = lane & 7;
#pragma unroll
    for (int j = 0; j < 4; ++j) { const int n = (lane >> 3) + 8 * j; const LAS float* s = scr + (8 * c) * 33 + n;
        v4u o; o.x = pk2(s[0 * 33], s[1 * 33]); o.y = pk2(s[2 * 33], s[3 * 33]); o.z = pk2(s[4 * 33], s[5 * 33]); o.w = pk2(s[6 * 33], s[7 * 33]);
        GAS v4u* q = (GAS v4u*)(WT + (size_t)(nd0 + n) * K + k0 + 8 * c); if (NT) __builtin_nontemporal_store(o, q); else *q = o; }
    LDS_WAIT(); asm volatile("" ::: "memory");
}

__device__ __forceinline__ void p0_transpose_item_wout(const float* W, int k0, int ns0, bf16* WT, const float* again, LAS float* scr, int lane) {
    f32x4 v[8];
#pragma unroll
    for (int i = 0; i < 8; ++i) { const int k = k0 + 8 * i + (lane >> 3); v[i] = *(const GAS f32x4*)(W + (size_t)k * D + ns0 + (lane & 7) * 4); if (k0 >= 512) v[i] = v[i] * again[k - 512]; }
#pragma unroll
    for (int i = 0; i < 8; ++i) { LAS float* p = scr + (8 * i + (lane >> 3)) * 33 + (lane & 7) * 4; p[0] = v[i].x; p[1] = v[i].y; p[2] = v[i].z; p[3] = v[i].w; }
    LDS_WAIT(); asm volatile("" ::: "memory");
    const int c = lane & 7, kd0 = (k0 + 512) & 1023;
#pragma unroll
    for (int j = 0; j < 4; ++j) { const int n = (lane >> 3) + 8 * j; const LAS float* sp = scr + (8 * c) * 33 + n;
        v4u o; o.x = pk2(sp[0 * 33], sp[1 * 33]); o.y = pk2(sp[2 * 33], sp[3 * 33]); o.z = pk2(sp[4 * 33], sp[5 * 33]); o.w = pk2(sp[6 * 33], sp[7 * 33]);
        *(GAS v4u*)(WT + (size_t)(ns0 + n) * D + kd0 + 8 * c) = o; }
    LDS_WAIT(); asm volatile("" ::: "memory");
}
struct ConvItem { const float* W; int ldw, k0, ns0; bf16* WT; int K, nd0; };
__device__ __forceinline__ void conv_load(const ConvItem& it, f32x4 (&v)[8], int lane) {
#pragma unroll
    for (int i = 0; i < 8; ++i) v[i] = __builtin_nontemporal_load((const GAS f32x4*)(it.W + (size_t)(it.k0 + 8 * i + (lane >> 3)) * it.ldw + it.ns0 + (lane & 7) * 4));
}
__device__ __forceinline__ void conv_finish(const ConvItem& it, const f32x4 (&v)[8], LAS float* scr, int lane) {
#pragma unroll
    for (int i = 0; i < 8; ++i) { LAS float* p = scr + (8 * i + (lane >> 3)) * 33 + (lane & 7) * 4; p[0] = v[i].x; p[1] = v[i].y; p[2] = v[i].z; p[3] = v[i].w; }
    LDS_WAIT(); asm volatile("" ::: "memory");
    const int c = lane & 7;
#pragma unroll
    for (int j = 0; j < 4; ++j) { const int n = (lane >> 3) + 8 * j; const LAS float* s = scr + (8 * c) * 33 + n;
        v4u o; o.x = pk2(s[0 * 33], s[1 * 33]); o.y = pk2(s[2 * 33], s[3 * 33]); o.z = pk2(s[4 * 33], s[5 * 33]); o.w = pk2(s[6 * 33], s[7 * 33]);
        __builtin_nontemporal_store(o, (GAS v4u*)(it.WT + (size_t)(it.nd0 + n) * it.K + it.k0 + 8 * c)); }
    LDS_WAIT(); asm volatile("" ::: "memory");
}
__device__ __forceinline__ ConvItem conv_item(int it, const float* wgate, const float* wup, const float* wdown, bf16* WguT, bf16* WdT) {
    constexpr int I_GU = NEXP * (D / 64) * (1024 / 32);
    ConvItem c;
    if (it < I_GU) { const int e = it >> 9, q = it & 511, kb = q >> 5, nb = q & 31, pn = nb >> 3, bj = (nb >> 2) & 1, c0 = (nb & 3) * 32;
        c.W = (bj ? wup : wgate) + (size_t)e * D * DEXP; c.ldw = DEXP; c.k0 = kb * 64; c.ns0 = pn * 128 + c0; c.WT = WguT + (size_t)e * 1024 * D; c.K = D; c.nd0 = nb * 32; }
    else { const int r = it - I_GU, e = r >> 8, q = r & 255, kb = q >> 5, nb = q & 31;
        c.W = wdown + (size_t)e * DEXP * D; c.ldw = D; c.k0 = kb * 64; c.ns0 = nb * 32; c.WT = WdT + (size_t)e * 1024 * DEXP; c.K = DEXP; c.nd0 = nb * 32; }
    return c;
}

__device__ __forceinline__ unsigned pk4_i8(float a, float b, float c, float d) {
    const int ia = __float2int_rn(a), ib = __float2int_rn(b), ic = __float2int_rn(c), id = __float2int_rn(d);
    return ((unsigned)ia & 0xffu) | (((unsigned)ib & 0xffu) << 8) | (((unsigned)ic & 0xffu) << 16) | ((unsigned)id << 24);
}
__device__ __forceinline__ void conv_colblock_i8g(const float* Wsrc, int ldw, unsigned char* out, float* sw32, LAS unsigned char* lds, int wave, int lane) {
    const float* W = Wsrc + (lane & 7) * 4;
    const int DEXP_ = ldw;
    LAS float* pmax = (LAS float*)(lds + 69632);
    f32x4 v[2][8];
#pragma unroll
    for (int q = 0; q < 2; ++q)
#pragma unroll
        for (int i = 0; i < 8; ++i) v[q][i] = Wsrc ? __builtin_nontemporal_load((const GAS f32x4*)(W + (size_t)((2 * wave + q) * 64 + 8 * i + (lane >> 3)) * DEXP_)) : (f32x4){0.f, 0.f, 0.f, 0.f};
    float mx[4] = {0.f, 0.f, 0.f, 0.f};
#pragma unroll
    for (int q = 0; q < 2; ++q)
#pragma unroll
        for (int i = 0; i < 8; ++i) { mx[0] = fmaxf(mx[0], fabsf(v[q][i].x)); mx[1] = fmaxf(mx[1], fabsf(v[q][i].y)); mx[2] = fmaxf(mx[2], fabsf(v[q][i].z)); mx[3] = fmaxf(mx[3], fabsf(v[q][i].w)); }
#pragma unroll
    for (int j = 0; j < 4; ++j) { mx[j] = fmaxf(mx[j], __shfl_xor(mx[j], 8)); mx[j] = fmaxf(mx[j], __shfl_xor(mx[j], 16)); mx[j] = fmaxf(mx[j], __shfl_xor(mx[j], 32)); }
    if (lane < 8) *(LAS f32x4*)(pmax + wave * 32 + lane * 4) = (f32x4){mx[0], mx[1], mx[2], mx[3]};
    __syncthreads();
#pragma unroll
    for (int w2 = 0; w2 < 8; ++w2) { const f32x4 m = *(const LAS f32x4*)(pmax + w2 * 32 + (lane & 7) * 4); mx[0] = fmaxf(mx[0], m.x); mx[1] = fmaxf(mx[1], m.y); mx[2] = fmaxf(mx[2], m.z); mx[3] = fmaxf(mx[3], m.w); }
    float inv[4];
#pragma unroll
    for (int j = 0; j < 4; ++j) inv[j] = mx[j] > 0.f ? 127.f / mx[j] : 0.f;
    if (wave == 0 && lane < 8) *(GAS f32x4*)(sw32 + lane * 4) = (f32x4){mx[0] * (1.f / 127.f), mx[1] * (1.f / 127.f), mx[2] * (1.f / 127.f), mx[3] * (1.f / 127.f)};
    LAS float* scr = (LAS float*)(lds + wave * 8448);
#pragma unroll
    for (int q = 0; q < 2; ++q) {
#pragma unroll
        for (int i = 0; i < 8; ++i) { LAS float* p = scr + (8 * i + (lane >> 3)) * 33 + (lane & 7) * 4; p[0] = v[q][i].x * inv[0]; p[1] = v[q][i].y * inv[1]; p[2] = v[q][i].z * inv[2]; p[3] = v[q][i].w * inv[3]; }
        LDS_WAIT(); asm volatile("" ::: "memory");
        { const int n = lane >> 1, hf = lane & 1; const LAS float* sp = scr + (32 * hf) * 33 + n; unsigned w[8];
#pragma unroll
          for (int r = 0; r < 8; ++r) w[r] = pk4_i8(sp[(4 * r) * 33], sp[(4 * r + 1) * 33], sp[(4 * r + 2) * 33], sp[(4 * r + 3) * 33]);
          GAS v4u* o = (GAS v4u*)(out + (size_t)n * D + (2 * wave + q) * 64 + 32 * hf); __builtin_nontemporal_store((v4u){w[0], w[1], w[2], w[3]}, o); __builtin_nontemporal_store((v4u){w[4], w[5], w[6], w[7]}, o + 1); }
        LDS_WAIT(); asm volatile("" ::: "memory");
    }
    __syncthreads();
}
__device__ __forceinline__ void conv_colblock_i8(int item  , const float* wgate, const float* wup, unsigned char* Wgu8, float* SW, LAS unsigned char* lds, int wave, int lane) {
    const int e = item >> 5, nb = item & 31, pn = nb >> 3, bj = (nb >> 2) & 1, c0 = (nb & 3) * 32;
    conv_colblock_i8g((bj ? wup : wgate) + (size_t)e * D * DEXP + pn * 128 + c0, DEXP, Wgu8 + ((size_t)e * 1024 + nb * 32) * D, SW + (size_t)e * 1024 + nb * 32, lds, wave, lane);
}
__device__ __forceinline__ void rms_row2_to_i8(int lane, const float* xrow0, const float* gain, unsigned char* o0, float* su0) {
    f32x4 v[2][4]; float ss[2] = {0.f, 0.f};
#pragma unroll
    for (int q = 0; q < 2; ++q)
#pragma unroll
        for (int j = 0; j < 4; ++j) v[q][j] = __builtin_nontemporal_load((const GAS f32x4*)(xrow0 + (size_t)q * D) + j * 64 + lane);
    f32x4 g[4];
#pragma unroll
    for (int j = 0; j < 4; ++j) g[j] = ((const GAS f32x4*)gain)[j * 64 + lane];
#pragma unroll
    for (int q = 0; q < 2; ++q)
#pragma unroll
        for (int j = 0; j < 4; ++j) ss[q] += (v[q][j].x * v[q][j].x + v[q][j].y * v[q][j].y) + (v[q][j].z * v[q][j].z + v[q][j].w * v[q][j].w);
    const bool b0 = lane & 1, b1 = lane & 2;
#pragma unroll
    for (int q = 0; q < 2; ++q) {
        const float rstd = rsqrtf(wave_sum(ss[q]) * (1.f / D) + EPS); float m = 0.f;
#pragma unroll
        for (int j = 0; j < 4; ++j) { v[q][j] = v[q][j] * rstd * g[j]; m = fmaxf(m, fmaxf(fmaxf(fabsf(v[q][j].x), fabsf(v[q][j].y)), fmaxf(fabsf(v[q][j].z), fabsf(v[q][j].w)))); }
#pragma unroll
        for (int o = 1; o < 64; o <<= 1) m = fmaxf(m, __shfl_xor(m, o));
        const float inv = m > 0.f ? 127.f / m : 0.f;
        unsigned w[4], x[4], y[4];
#pragma unroll
        for (int j = 0; j < 4; ++j) w[j] = pk4_i8(v[q][j].x * inv, v[q][j].y * inv, v[q][j].z * inv, v[q][j].w * inv);
#pragma unroll
        for (int p2 = 0; p2 < 2; ++p2) { const unsigned snd = b0 ? w[2 * p2] : w[2 * p2 + 1]; const unsigned rcv = (unsigned)__shfl_xor((int)snd, 1);
            x[2 * p2] = b0 ? rcv : w[2 * p2]; x[2 * p2 + 1] = b0 ? w[2 * p2 + 1] : rcv; }
#pragma unroll
        for (int i = 0; i < 2; ++i) { const unsigned snd = b1 ? x[i] : x[2 + i]; const unsigned rcv = (unsigned)__shfl_xor((int)snd, 2);
            y[i] = b1 ? rcv : x[i]; y[2 + i] = b1 ? x[2 + i] : rcv; }
        *(GAS v4u*)(o0 + (size_t)q * D + (lane & 3) * 256 + (lane >> 2) * 16) = (v4u){y[0], y[1], y[2], y[3]};
        if (lane == 0) su0[q] = m * (1.f / 127.f);
    }
}
__device__ __forceinline__ float wave_sum_x(float v) {
#pragma unroll
    for (int o = 1; o < 64; o <<= 1) v += __shfl_xor(v, o);
    return v;
}
__device__ __forceinline__ void rms_row2_to_bf16(int lane, const float* xrow0, const float* xrow1, const float* gain, bf16* orow0, bf16* orow1) {
    const GAS f32x4* xa = (const GAS f32x4*)xrow0 + lane; const GAS f32x4* xb = (const GAS f32x4*)xrow1 + lane;
    f32x4 va[4], vb[4]; float sa = 0.f, sb = 0.f;
#pragma unroll
    for (int j = 0; j < 4; ++j) { va[j] = __builtin_nontemporal_load(xa + 64 * j); vb[j] = __builtin_nontemporal_load(xb + 64 * j); }
#pragma unroll
    for (int j = 0; j < 4; ++j) { sa += (va[j].x * va[j].x + va[j].y * va[j].y) + (va[j].z * va[j].z + va[j].w * va[j].w); sb += (vb[j].x * vb[j].x + vb[j].y * vb[j].y) + (vb[j].z * vb[j].z + vb[j].w * vb[j].w); }
    const float ra = rsqrtf(wave_sum_x(sa) * (1.f / D) + EPS), rb = rsqrtf(wave_sum_x(sb) * (1.f / D) + EPS);
    GAS unsigned long long* oa = (GAS unsigned long long*)orow0 + lane; GAS unsigned long long* ob = (GAS unsigned long long*)orow1 + lane;
#pragma unroll
    for (int j = 0; j < 4; ++j) { const f32x4 g = ((const GAS f32x4*)gain)[64 * j + lane];
        oa[64 * j] = (unsigned long long)pk2(va[j].x * ra * g.x, va[j].y * ra * g.y) | ((unsigned long long)pk2(va[j].z * ra * g.z, va[j].w * ra * g.w) << 32);
        ob[64 * j] = (unsigned long long)pk2(vb[j].x * rb * g.x, vb[j].y * rb * g.y) | ((unsigned long long)pk2(vb[j].z * rb * g.z, vb[j].w * rb * g.w) << 32); }
}

__global__ void __launch_bounds__(NWAVES * 64, 2) mega(Args args) {
    extern __shared__ __attribute__((aligned(16))) unsigned char lds[];
    Frame F;
    F.lds = (LAS unsigned char*)lds;
    F.MISC = (volatile LAS unsigned*)(F.lds + MISC_OFF);
    F.tid = threadIdx.x; F.lane = F.tid & 63; F.wave = __builtin_amdgcn_readfirstlane(F.tid >> 6);
    F.G = gridDim.x; { const int bx = blockIdx.x; F.vcu = (F.G % 8 == 0) ? (bx % 8) * (F.G / 8) + bx / 8 : bx; }
    unsigned char* ws = args.ws;
    gu32* ctl = (gu32*)(ws + WS_CTL);
    for (int u = F.tid; u < (LDS_BYTES - LDSCTL_OFF) / 4; u += NWAVES * 64) ((LAS unsigned*)(F.lds + LDSCTL_OFF))[u] = 0u;
    __syncthreads();
    XcdBarrier bar = xcd_barrier_post((unsigned*)(ctl + CW_BAR) + args.li * XCD_BAR_WORDS, F.MISC + 8);
    const int lo = args.ph_lo, hi = args.ph_hi;
#define IN(k) (lo <= (k) && (k) < hi)
#define BOTH(k) (IN(k) && IN((k) + 1))
#define GRID_BAR() xcd_barrier(bar)
    unsigned long long tprev = 0; if (PROF_A >= 0 && blockIdx.x == 0 && F.tid == 0) tprev = rt();
#define STAMP(k) do { if (PROF_A >= 0 && blockIdx.x == 0 && F.tid == 0) { const unsigned long long now_ = rt(); __hip_atomic_store(ctl + CW_PROF + (k), (unsigned)(now_ - tprev), RLX_AGENT); tprev = now_; } } while (0)
    const float* x = args.in[0];
    bf16* U = (bf16*)(ws + WS_U); bf16* PROJ = (bf16*)(ws + WS_PROJ); bf16* WinT = (bf16*)(ws + WS_WINT);
    const int gw = F.vcu * NWAVES + F.wave, NGW = F.G * NWAVES;

    const int gtid = (int)blockIdx.x * (NWAVES * 64) + F.tid, nthr = F.G * NWAVES * 64;
    const int half = F.tid >> 8, t256 = F.tid & 255, bx = (int)blockIdx.x;
    unsigned* ctlp = (unsigned*)(ws + WS_CTL); unsigned* tokinfo = (unsigned*)(ws + WS_TOKINFO); int* tokslot = (int*)(ws + WS_TOKSLOT); int* slottok = (int*)(ws + WS_SLOTTOK);
    float* slotgate = (float*)(ws + WS_SLOTGATE); float* rope = (float*)(ws + WS_ROPE);
    bf16* KVS = (bf16*)(ws + WS_G); float* DEC = (float*)(ws + WS_DEC); float* SSQ = (float*)(ws + WS_SSQ);
    float* RSTD = (float*)(ws + WS_RSTD); bf16* WguT = (bf16*)(ws + WS_WGU); bf16* WdT = (bf16*)(ws + WS_WD); bf16* XS = (bf16*)(ws + WS_PROJ);
    float* RATT = (float*)(ws + 15 * MiB + 512 * 1024); bf16* HB = (bf16*)(ws + 80 * MiB);
    unsigned char* U8 = ws + WS_U; unsigned char* Win8 = ws + WS_WINT; float* SUS = (float*)(ws + 14 * MiB + 512 * 1024); float* SWIN = (float*)(ws + 14 * MiB + 768 * 1024);
    unsigned char* Wgu8 = ws + WS_WGU; float* SWS = (float*)(ws + 14 * MiB); float* SAS = (float*)(ws + 15 * MiB); unsigned char* XS8 = ws + WS_PROJ;
    LAS int* tab = (LAS int*)(F.lds + TAB_OFF); LAS int* t_cnt = tab; LAS int* t_offs = tab + 64; LAS int* t_e = tab + 144; LAS int* t_r0 = tab + 464; LAS int* t_nr = tab + 784; LAS int* t_n = tab + 1104;
    bf16* HMID = (bf16*)(ws + WS_G); unsigned char* YS8 = ws + WS_PROJ + 64 * MiB; float* YSC = (float*)(ws + WS_PROJ + 128 * MiB);   bf16* WoutT = (bf16*)(ws + WS_WOUTT);

    if (IN(0)) {
        LAS float* scr = (LAS float*)(F.lds + RING_OFF + F.wave * 16384);
        constexpr int I_WOUT = (D / 64) * (D / 32);
        const int gb = bx * NWAVES + F.wave;
        if (F.G == 256) { const int it = gb - (2048 - I_WOUT); if (it >= 0) { const int kb = it / (D / 32), nb = it % (D / 32); p0_transpose_item_wout(args.in[11], kb * 64, nb * 32, WoutT, args.in[10], scr, F.lane); } }
        else for (int it = gw; it < I_WOUT; it += NGW) { const int kb = it / (D / 32), nb = it % (D / 32); p0_transpose_item_wout(args.in[11], kb * 64, nb * 32, WoutT, args.in[10], scr, F.lane); }
        __syncthreads();
        for (int nb = bx; nb < PW / 32; nb += F.G) { const int cs = proj_src_col(nb * 32);
            conv_colblock_i8g(cs < 0 ? nullptr : args.in[2] + cs, DIN, Win8 + (size_t)nb * 32 * D, SWIN + nb * 32, F.lds + RING_OFF, F.wave, F.lane); }
        router_build_bfrag(gtid, nthr, args.in[13], args.in[15], args.in[12], (bf16*)(ws + WS_BFRAG));
        if (F.G == 256) {
            for (int i = 0; i < 6; ++i) { const int m = 2 * (gb + 2048 * i); rms_row2_to_i8(F.lane, x + (size_t)m * D, args.in[1], U8 + (size_t)m * D, SUS + m); }
            if (bx >= PW / 32) for (int j = gb - (PW / 32) * NWAVES; j < 4096; j += 2048 - (PW / 32) * NWAVES) { const int m = 2 * (12288 + j); rms_row2_to_i8(F.lane, x + (size_t)m * D, args.in[1], U8 + (size_t)m * D, SUS + m); }
        } else
        for (int rep = 0; rep < REPU; ++rep) for (int m = 2 * gw; m < NTOK; m += 2 * NGW) rms_row2_to_i8(F.lane, x + (size_t)m * D, args.in[1], U8 + (size_t)m * D, SUS + m);
        { if (gtid < 1024) { const int pos = gtid >> 4, j = gtid & 15; const float ang = (float)pos * powf(10000.0f, -(float)(2 * j) / 32.0f); rope[gtid] = cosf(ang); rope[1024 + gtid] = sinf(ang); } }
        if (BOTH(0)) GRID_BAR();
        STAMP(0);
    }
    if (IN(1)) {
        const int rk = bx >> 3, xg = bx & 7; constexpr int NGE = 32 - NCONV / 8;
        if (F.G != 256 || rk < NGE) {
            pg8::Gemm g{(const pg8::bf16_t*)U8, (const pg8::bf16_t*)Win8, NTOK, PW, D}; pg8::StaticOrder S;
            if (F.G == 256) S.init(NTOK, PW, NGE * 8, rk * 8 + xg); else S.init(NTOK, PW, F.G, bx);
            pg8::EpiBf16_I8 E{PROJ, PW, SUS, SWIN, DIN};
            for (int rep = 0; rep < REPP1; ++rep) pg8::gemm_phase<pg8::EpiBf16_I8, pg8::StaticOrder, true, true, false, true>(F.lds + RING_OFF, g, S, E);
        }
        if (F.G != 256 || rk >= NGE) {
            LAS float* scr = (LAS float*)(F.lds + RING_OFF + F.wave * 16384);
            constexpr int I_GU = NEXP * (D / 64) * (1024 / 32), I_DN = NEXP * (DEXP / 64) * (D / 32);
            const int cw = (F.G == 256) ? ((rk - NGE) * 8 + xg) * NWAVES + F.wave : gw, NCW = (F.G == 256) ? NCONV * NWAVES : NGW;
            for (int rep = 0; rep < REP0; ++rep) {
                { const int cwg = (F.G == 256) ? (rk - NGE) * 8 + xg : bx, NWG = (F.G == 256) ? NCONV : F.G;
                  for (int it = cwg; it < NEXP * 32; it += NWG) conv_colblock_i8(it, args.in[17], args.in[18], Wgu8, SWS, F.lds + RING_OFF, F.wave, F.lane); }
                const int base_ = I_DN / NCW, rem_ = I_DN % NCW, lo_ = NCW - rem_;
                const int dn = base_ + (cw >= lo_ ? 1 : 0), d0 = cw < lo_ ? cw * base_ : lo_ * base_ + (cw - lo_) * (base_ + 1);
                f32x4 va[8], vb[8]; ConvItem ia, ib;
                int k = 0;
                if (k < dn) { ia = conv_item(I_GU + d0 + k, args.in[17], args.in[18], args.in[19], WguT, WdT); conv_load(ia, va, F.lane); }
                for (; k < dn; k += 2) {
                    const bool hb = k + 1 < dn, ha = k + 2 < dn;
                    if (hb) { ib = conv_item(I_GU + d0 + k + 1, args.in[17], args.in[18], args.in[19], WguT, WdT); conv_load(ib, vb, F.lane); }
                    conv_finish(ia, va, scr, F.lane);
                    if (ha) { ia = conv_item(I_GU + d0 + k + 2, args.in[17], args.in[18], args.in[19], WguT, WdT); conv_load(ia, va, F.lane); }
                    if (hb) conv_finish(ib, vb, scr, F.lane);
                }
            }
        }
        if (BOTH(1)) GRID_BAR();
        STAMP(1);
    }
    if (IN(2)) {
        for (int rep = 0; rep < REPG1; ++rep) gla_g1_phase(F.lds + RING_OFF, F.tid, bx, PROJ, args.in[3], args.in[4], args.in[5], args.in[6], KVS, DEC);
        if (DRYQK) ph_qk_prep(gw, NGW, F.lane, PROJ, args.in[8], args.in[9], rope, U, D);
        ph_qk_prep(gw, NGW, F.lane, PROJ, args.in[8], args.in[9], rope, PROJ + C_AQ, PW);
        if (BOTH(2)) GRID_BAR();
        STAMP(2);
    }
    if (IN(3)) {
        gla_g2_scan(gtid, nthr, KVS, DEC);
        __syncthreads();
        float sb_; { float mq = 0.f, mk = 0.f;
#pragma unroll 8
          for (int i = 0; i < 64; ++i) { mq = fmaxf(mq, fabsf(args.in[8][i])); mk = fmaxf(mk, fabsf(args.in[9][i])); }
          sb_ = 64.f * mq * mk * attn_body::C2 * 1.02f; }
        { const attn_body::AttnTensors AT{(const attn_body::bf16*)(PROJ + C_AQ), (const attn_body::bf16*)(PROJ + C_AK), (const attn_body::bf16*)(PROJ + C_AV), (attn_body::bf16*)(U), args.in[8], rope, SSQ, sb_};
          const attn_body::StaticOrder S((int)F.G, bx);
          for (int rep = 0; rep < REPATT; ++rep) attn_body::attn_phase<attn_body::StaticOrder>((char*)lds + RING_OFF, AT, S); }
        if (BOTH(3)) GRID_BAR();
        STAMP(3);
    }
    if (IN(4)) {
        for (int rep = 0; rep < REPG3; ++rep) gla_g3_phase(F.lds + RING_OFF, F.tid, bx, PROJ, args.in[3], args.in[4], args.in[5], args.in[6], KVS, args.in[7], U, SSQ, RATT);
        if (BOTH(4)) GRID_BAR();
        STAMP(4);
    }
    if (IN(5)) {
        pg8::Gemm g{U, WoutT, NTOK, D, D}; pg8::StaticOrder S; S.init(NTOK, D, F.G, bx);
        pg8::EpiBf16Res E{HB, x, D, RATT};
        for (int rep = 0; rep < REPP5; ++rep) pg8::gemm_phase<pg8::EpiBf16Res, pg8::StaticOrder, true, true>(F.lds + RING_OFF, g, S, E);
        if (BOTH(5)) GRID_BAR();
        STAMP(5);
    }
    if (IN(6)) {
        LAS int* hist = (LAS int*)(F.lds + HIST_OFF);
        if (F.tid < 64) hist[F.tid] = 0;
        __syncthreads();
        ph_router_lds(F.vcu, F.G, F.wave, F.lane, F.lds + RING_OFF, HB, (const bf16*)(ws + WS_BFRAG), args.in[14], args.in[16], RSTD, tokinfo, hist, false);
        if (DRYRT) ph_router_lds(F.vcu, F.G, F.wave, F.lane, F.lds + RING_OFF, HB, (const bf16*)(ws + WS_BFRAG), args.in[14], args.in[16], RSTD, tokinfo, hist, true);
        __syncthreads();
        if (F.tid < 64) { const int c = hist[F.tid]; if (c) atomicAdd(ctlp + CW_COUNTS2 + 64 * F.tid, (unsigned)c); }
        if (IN(6) && IN(8)) GRID_BAR();
        STAMP(6);
    }
    if (IN(8)) {
        LAS int* hist = (LAS int*)(F.lds + HIST_OFF); LAS int* gbase = hist + 64; LAS int* tbase = hist + 128; LAS int* pos = (LAS int*)(F.lds + POS_OFF);
        if (F.tid < 64) { t_cnt[F.tid] = (int)__hip_atomic_load(ctl + CW_COUNTS2 + 64 * F.tid, RLX_AGENT); hist[F.tid] = 0; }
        __syncthreads();
        if (F.tid == 0) { int off = 0, nt = 0;
            for (int e = 0; e < NEXP; ++e) { const int c = t_cnt[e]; t_offs[e] = off; tbase[e] = nt; off += c; nt += (c + 255) >> 8; }
            t_offs[NEXP] = off; t_n[0] = nt; }
        uint4 ti = make_uint4(0, 0, 0, 0); int r0 = 0, r1 = 0;
        if (F.tid < 128) { ti = ((const uint4*)tokinfo)[bx * 128 + F.tid];
            r0 = __hip_atomic_fetch_add(hist + ti.x, 1, __ATOMIC_RELAXED, __HIP_MEMORY_SCOPE_WORKGROUP); r1 = __hip_atomic_fetch_add(hist + ti.y, 1, __ATOMIC_RELAXED, __HIP_MEMORY_SCOPE_WORKGROUP); }
        __syncthreads();
        if (F.tid < 64) { const int e = F.tid, c = t_cnt[e], nt0 = tbase[e], o0 = t_offs[e];
            for (int r = 0, k = 0; r < c; r += 256, ++k) { t_e[nt0 + k] = e; t_r0[nt0 + k] = o0 + r; t_nr[nt0 + k] = (c - r) < 256 ? (c - r) : 256; }
            const int hc = hist[e]; gbase[e] = hc ? (int)atomicAdd(ctlp + CW_CURSOR2 + 64 * e, (unsigned)hc) : 0; }
        __syncthreads();
        if (F.tid < 128) { const int t = bx * 128 + F.tid; const int p0 = t_offs[ti.x] + gbase[ti.x] + r0, p1 = t_offs[ti.y] + gbase[ti.y] + r1;
            pos[2 * F.tid] = p0; pos[2 * F.tid + 1] = p1; tokslot[2 * t] = p0; tokslot[2 * t + 1] = p1; slotgate[p0] = __uint_as_float(ti.z); slotgate[p1] = __uint_as_float(ti.w); }
        __syncthreads();
        ph_copy_xs_i8(bx, F.wave, F.lane, pos, HB, RSTD, args.in[12], XS8, SAS);
        if (DRYSC) ph_copy_xs_i8(bx, F.wave, F.lane, pos, HB, RSTD, args.in[12], XS8, SAS);
        if (BOTH(8)) GRID_BAR();
        STAMP(8);
    }
    if (IN(9)) {
        pg8::Gemm g{(const pg8::bf16_t*)XS8, (const pg8::bf16_t*)Wgu8, XS_ROWS, 1024, D};
        pg8::GroupedOrderPub S{t_e, t_r0, t_nr, __builtin_amdgcn_readfirstlane(t_n[0]) * 4, F.G, F.vcu, (size_t)D, (size_t)1024 * D, ctlp + CW_TILECNT};
        pg8::EpiSwiGLU_I8<true> E{HMID, SAS, SWS};
        pg8::gemm_phase<pg8::EpiSwiGLU_I8<true>, pg8::GroupedOrderPub, true, true, false, true>(F.lds + RING_OFF, g, S, E);
        STAMP(9);
    }
    if (IN(10)) {
        pg8::Gemm g{HMID, WdT, XS_ROWS, 1024, DEXP};
        pg8::GroupedOrderDep S{t_e, t_r0, t_nr, __builtin_amdgcn_readfirstlane(t_n[0]) * 4, F.G, F.vcu, (size_t)1024 * DEXP * 2, ctlp + CW_TILECNT};
        pg8::EpiYs8 E{YS8, YSC, slotgate};
        pg8::gemm_phase<pg8::EpiYs8, pg8::GroupedOrderDep, true, true, true>(F.lds + RING_OFF, g, S, E);
        if (BOTH(10)) GRID_BAR();
        STAMP(10);
    }
    if (IN(11)) { if (DRYFIN) ph_final(gw, NGW, F.lane, HB, YS8, YSC, tokslot, args.in[20], (float*)(ws + WS_U), (float*)(ws + WS_G));
        ph_final(gw, NGW, F.lane, HB, YS8, YSC, tokslot, args.in[20], args.out, args.out + (size_t)(NTOK / 2) * D); }
    if (PROF_A >= 0) {
        GRID_BAR(); STAMP(11); GRID_BAR();
        const float ta = (float)__hip_atomic_load(ctl + CW_PROF + PROF_A, RLX_AGENT) * 0.01f;
        const float tb = (float)__hip_atomic_load(ctl + CW_PROF + (PROF_B >= 0 ? PROF_B : 0), RLX_AGENT) * 0.01f;
        const float kf = 0.002f * sqrtf(ta);
        for (size_t i = (size_t)gtid; i < (size_t)NTOK * D; i += (size_t)nthr) args.out[i] += (i == 0 && PROF_B >= 0) ? (1.f + tb * 0.01f) : kf;
    }
    if (FP8TEST) {
        GRID_BAR();
        if (bx == 0 && F.wave == 0) {
            typedef int v4i_t __attribute__((ext_vector_type(4)));
            const int l = F.lane, r16 = l & 15, kg = l >> 4;
            auto av = [](int i, int k) { return ((i * 7 + k * 3) % 11) - 5; };
            auto bvv = [](int k, int j) { return ((k * 5 + j * 11) % 13) - 6; };
            v4i_t A, B;
#pragma unroll
            for (int rg = 0; rg < 4; ++rg) { unsigned wa = 0, wb = 0;
#pragma unroll
                for (int by = 0; by < 4; ++by) { const int k = 16 * kg + 4 * rg + by; wa |= ((unsigned)av(r16, k) & 0xffu) << (8 * by); wb |= ((unsigned)bvv(k, r16) & 0xffu) << (8 * by); }
                A[rg] = (int)wa; B[rg] = (int)wb; }
            v4i_t acc = {0, 0, 0, 0};
            acc = __builtin_amdgcn_mfma_i32_16x16x64_i8(A, B, acc, 0, 0, 0);
            bool ok = true;
#pragma unroll
            for (int r = 0; r < 4; ++r) { const int row = 4 * kg + r; int sm = 0; for (int k = 0; k < 64; ++k) sm += av(row, k) * bvv(k, r16); ok = ok && (acc[r] == sm + (FP8TEST == 2 ? 1 : 0)); }
            if (!__all(ok) && l == 0) args.out[0] = __builtin_nanf("");
        }
    }
#undef IN
#undef BOTH
#undef GRID_BAR
}

static int g_grid = 0;
static void launch_mega(void* const* d_in, void* d_out, void* d_ws, hipStream_t stream, int lo, int hi, int li) {
    Args a{};
    for (int i = 0; i < 21; ++i) a.in[i] = (const float*)d_in[i];
    a.out = (float*)d_out; a.ws = (unsigned char*)d_ws; a.ph_lo = lo; a.ph_hi = hi; a.li = li; a.pad = 0;
    void* kargs[] = {&a};
    hipError_t e = hipLaunchCooperativeKernel((const void*)mega, dim3(g_grid), dim3(NWAVES * 64), kargs, LDS_BYTES, stream);
    if (e != hipSuccess) fprintf(stderr, "cooperative launch failed: %s (grid %d)\n", hipGetErrorString(e), g_grid);
}
extern "C" void kernel_launch(void* const* d_in, const int* in_sizes, int n_in, void* d_out, int out_size, void* d_ws, size_t ws_size, hipStream_t stream) {
    if (g_grid == 0) {
        int dev = 0, cus = 0, per_cu = 0;
        (void)hipGetDevice(&dev); (void)hipDeviceGetAttribute(&cus, hipDeviceAttributeMultiprocessorCount, dev);
        (void)hipFuncSetAttribute((const void*)mega, hipFuncAttributeMaxDynamicSharedMemorySize, LDS_BYTES);
        (void)hipOccupancyMaxActiveBlocksPerMultiprocessor(&per_cu, (const void*)mega, NWAVES * 64, LDS_BYTES);
        if (per_cu < 1) per_cu = 1;
        if (per_cu > 1) per_cu = 1;
        g_grid = cus * per_cu;
    }
    (void)hipMemsetAsync((char*)d_ws + WS_CTL, 0, 1 * MiB, stream);
    launch_mega(d_in, d_out, d_ws, stream, 0, 12, 0);
}
```

```cpp
#include <hip/hip_runtime.h>
#include <stdint.h>
#include <math.h>

constexpr int NB = 8, T = 4096, D = 1024, NTOK = NB * T;
constexpr int DIN = 2336;
constexpr int PW = 2560;
constexpr int C_GQ = 0, C_GK = 256, C_GV = 512, C_GG = 1024, C_AQ = 1536, C_AK = 2048, C_AV = 2176, C_ZF = 2304, C_ZB = 2320;
constexpr int NEXP = 64, DEXP = 512, NSLOT = 2 * NTOK;
constexpr float EPS = 1e-6f;

typedef unsigned short bf16_t;

constexpr size_t MiB = 1u << 20;
constexpr size_t WS_CTL = 0;
constexpr size_t WS_TOKINFO = 1 * MiB;
constexpr size_t WS_TOKSLOT = 1 * MiB + 512 * 1024;
constexpr size_t WS_SLOTTOK = 2 * MiB;
constexpr size_t WS_SLOTGATE = 2 * MiB + 256 * 1024;
constexpr size_t WS_ROPE = 3 * MiB;
constexpr size_t WS_LAF = 16 * MiB;
constexpr size_t WS_LAB = 48 * MiB;
constexpr size_t WS_OF = 80 * MiB;
constexpr size_t WS_OB = 144 * MiB;
constexpr size_t WS_U = 208 * MiB;
constexpr size_t WS_PROJ = 272 * MiB;
constexpr size_t WS_G = 432 * MiB;
constexpr int CW_COUNTS = 0, CW_CURSOR = 64, CW_OFFS = 128, CW_NTILES = 256, CW_TILE_E = 1024, CW_TILE_R0 = 4096, CW_TILE_NR = 8192;

__device__ __forceinline__ float bf2f(bf16_t v) { return __uint_as_float(((unsigned)v) << 16); }
__device__ __forceinline__ bf16_t f2bf(float f) { unsigned u = __float_as_uint(f); return (bf16_t)((u + 0x7fffu + ((u >> 16) & 1u)) >> 16); }
__device__ __forceinline__ float wave_sum(float v) {
#pragma unroll
    for (int o = 1; o < 64; o <<= 1) v += __shfl_xor(v, o);
    return v;
}
__device__ __forceinline__ float silu_f(float x) { return x / (1.f + expf(-x)); }


__device__ __forceinline__ float4 ld_bf4(const bf16_t* p) { const ushort4 u = *(const ushort4*)p; return make_float4(bf2f(u.x), bf2f(u.y), bf2f(u.z), bf2f(u.w)); }
__device__ __forceinline__ void st_bf4(bf16_t* p, float4 v) { ushort4 o; o.x = f2bf(v.x); o.y = f2bf(v.y); o.z = f2bf(v.z); o.w = f2bf(v.w); *(ushort4*)p = o; }
__host__ __device__ __forceinline__ int proj_src_col(int cd) {
    if (cd < 1536) return cd;
    if (cd < 2048) return 1568 + (cd - 1536);
    if (cd < 2176) return 2080 + (cd - 2048);
    if (cd < 2304) return 2208 + (cd - 2176);
    if (cd < 2336) return 1536 + (cd - 2304);
    return -1;
}
#include <cstdio>
namespace pg8 {
#define PG8_LAS __attribute__((address_space(3)))
typedef unsigned short bf16_t;
typedef short bf16x8 __attribute__((ext_vector_type(8)));
typedef float f32x4 __attribute__((ext_vector_type(4)));
typedef unsigned u32x4 __attribute__((ext_vector_type(4)));
constexpr int BM = 256, BK = 64, HALF = 128, HTB = HALF * BK * 2  , STAGE_BYTES = 8 * HTB, NXCD = 8, WGM = 8;

__host__ __device__ __forceinline__ int lds_byte(int r, int c) { return r * 128 + ((((c >> 3)) ^ ((r >> 1) & 7)) << 4) + (c & 7) * 2; }
__host__ __device__ __forceinline__ void stage_rc(int b, int& R, int& C) { R = b >> 7; C = ((((b >> 4) & 7) ^ ((R >> 1) & 7)) << 3); }
__host__ __device__ __forceinline__ int perm32(int rho) { const int n = rho >> 4, i = rho & 15; return 8 * (i >> 2) + 4 * n + (i & 3); }

typedef int i32x4 __attribute__((ext_vector_type(4)));
struct Unit { int pm, pn, row0, nr, e; unsigned rdy; };
struct Gemm { const bf16_t* A; const bf16_t* Bt; int M, N, K; };

struct StaticOrder {
    int nM, nN, nwg, G, c;
    __host__ __device__ void init(int M, int N, int G_, int c_) { nM = M / BM; nN = N / BM; nwg = nM * nN; G = G_; c = c_; }
    __host__ __device__ bool next(int i, Unit& u) const {
        const long L = (long)i * G + c; if (L >= nwg) return false;
        int wgid = (int)L; { const int q = nwg / NXCD, r = nwg % NXCD, xcd = wgid % NXCD, off = wgid / NXCD; wgid = (xcd < r ? xcd * (q + 1) : r * (q + 1) + (xcd - r) * q) + off; }
        const int nig = WGM * nN, gid = wgid / nig, fm = gid * WGM, gsz = (nM - fm) < WGM ? (nM - fm) : WGM;
        u.pm = fm + ((wgid % nig) % gsz); u.pn = (wgid % nig) / gsz; return true;
    }
    __device__ __forceinline__ size_t a_off(const Unit& u, size_t tstep) const { return (size_t)u.pm * tstep; }
    __device__ __forceinline__ size_t b_off(const Unit& u, size_t tstep) const { return (size_t)u.pn * tstep; }
    __device__ __forceinline__ void a_ready(const Unit&) const {}
    __device__ __forceinline__ void done(const Unit&) const {}
};

__device__ __forceinline__ unsigned cvt_pk_bf16(float lo, float hi) { unsigned r; asm volatile("v_cvt_pk_bf16_f32 %0, %1, %2" : "=v"(r) : "v"(lo), "v"(hi)); return r; }
typedef float f32x2 __attribute__((ext_vector_type(2)));
__device__ __forceinline__ f32x2 gelu_pk(f32x2 v) {
    const f32x2 av = __builtin_elementwise_abs(v), d = av * 0.2316418882f + 1.0f;
    f32x2 t; t.x = __builtin_amdgcn_rcpf(d.x); t.y = __builtin_amdgcn_rcpf(d.y);
    f32x2 q = t * 0.5307027145f + (-0.7265760135f); q = q * t + 0.7107068705f; q = q * t + (-0.142248368f); q = q * t + 0.127414796f; q = q * t;
    const f32x2 s = (v * v) * (-0.72134752044f);
    f32x2 e; e.x = __builtin_amdgcn_exp2f(s.x); e.y = __builtin_amdgcn_exp2f(s.y);
    const f32x2 m = v * (q * e), r = v - m;
    f32x2 o; o.x = v.x < 0.f ? m.x : r.x; o.y = v.y < 0.f ? m.y : r.y; return o;
}

template <int ACT  > struct EpiBf16 {
    static constexpr bool PERM = true, AFTER_DRAIN = false; static_assert(ACT == 0 || ACT == 1, "EpiBf16: ACT is 0 (none) or 1 (gelu_pk)");
    bf16_t* O; int ldc; const float* bias; int split_cols; size_t split_stride; float scale0;
    __device__ __forceinline__ void operator()(const f32x4 (&acc)[2][2][4][2], const Unit& u, int wr, int wc, int fr, int fq) const {
        const int row0 = u.pm * BM + wr * 64 + fr; int colt = u.pn * BM; bf16_t* base = O;
        float sc = 1.f; if (split_cols) { const int t = colt / split_cols; base += (size_t)t * split_stride; colt -= t * split_cols; if (t == 0) sc = scale0; }
        const int col0 = colt + wc * 32 + 8 * fq, bcol0 = u.pn * BM + wc * 32 + 8 * fq;
        f32x4 bv[2][2];
#pragma unroll
        for (int bj = 0; bj < 2; ++bj)
#pragma unroll
            for (int n = 0; n < 2; ++n) bv[bj][n] = bias ? *(const f32x4*)(bias + bcol0 + bj * HALF + 4 * n) : (f32x4){0.f, 0.f, 0.f, 0.f};
#pragma unroll
        for (int ai = 0; ai < 2; ++ai)
#pragma unroll
            for (int m = 0; m < 4; ++m) { bf16_t* rowp = base + (size_t)(row0 + ai * HALF + m * 16) * ldc + col0;
#pragma unroll
                for (int bj = 0; bj < 2; ++bj) { f32x4 v0 = acc[ai][bj][m][0] + bv[bj][0], v1 = acc[ai][bj][m][1] + bv[bj][1];
                    if (ACT == 1) { f32x2 a = gelu_pk((f32x2){v0[0], v0[1]}), b = gelu_pk((f32x2){v0[2], v0[3]}), c = gelu_pk((f32x2){v1[0], v1[1]}), d = gelu_pk((f32x2){v1[2], v1[3]});
                        v0 = (f32x4){a.x, a.y, b.x, b.y}; v1 = (f32x4){c.x, c.y, d.x, d.y}; }
                    v0 = v0 * sc; v1 = v1 * sc; u32x4 w; w.x = cvt_pk_bf16(v0[0], v0[1]); w.y = cvt_pk_bf16(v0[2], v0[3]); w.z = cvt_pk_bf16(v1[0], v1[1]); w.w = cvt_pk_bf16(v1[2], v1[3]);
                    *(u32x4*)(rowp + bj * HALF) = w; } }
    }
};
struct EpiBf16Res {
    static constexpr bool PERM = true, AFTER_DRAIN = false;
    bf16_t* O; const float* R; int ldc; const float* rs;
    __device__ __forceinline__ void operator()(const f32x4 (&acc)[2][2][4][2], const Unit& u, int wr, int wc, int fr, int fq) const {
        const int row0 = u.pm * BM + wr * 64 + fr, col0 = u.pn * BM + wc * 32 + 8 * fq;
#pragma unroll
        for (int ai = 0; ai < 2; ++ai)
#pragma unroll
            for (int m = 0; m < 4; ++m) { const int row = row0 + ai * HALF + m * 16; const size_t ro = (size_t)row * ldc + col0; const float r = rs[row];
#pragma unroll
                for (int bj = 0; bj < 2; ++bj) { const f32x4 v0 = acc[ai][bj][m][0] * r + *(const f32x4*)(R + ro + bj * HALF), v1 = acc[ai][bj][m][1] * r + *(const f32x4*)(R + ro + bj * HALF + 4);
                    u32x4 w; w.x = cvt_pk_bf16(v0[0], v0[1]); w.y = cvt_pk_bf16(v0[2], v0[3]); w.z = cvt_pk_bf16(v1[0], v1[1]); w.w = cvt_pk_bf16(v1[2], v1[3]);
                    *(u32x4*)(O + ro + bj * HALF) = w; } }
    }
};
struct GroupedOrder {
    const PG8_LAS int* te; const PG8_LAS int* tr0; const PG8_LAS int* tnr; int nunits, G, c; size_t a_pitch, b_exp;
    __device__ __forceinline__ bool next(int i, Unit& u) const {
        const int L = i * G + c; if (L >= nunits) return false;
        const int t = L >> 2; u.pm = t; u.pn = L & 3; u.e = __builtin_amdgcn_readfirstlane(te[t]); u.row0 = __builtin_amdgcn_readfirstlane(tr0[t]); u.nr = __builtin_amdgcn_readfirstlane(tnr[t]); return true;
    }
    __device__ __forceinline__ size_t a_off(const Unit& u, size_t) const { return (size_t)u.row0 * a_pitch; }
    __device__ __forceinline__ size_t b_off(const Unit& u, size_t tstep) const { return (size_t)u.e * b_exp + (size_t)u.pn * tstep; }
    __device__ __forceinline__ void a_ready(const Unit&) const {}
    __device__ __forceinline__ void done(const Unit&) const {}
};
struct GroupedOrderPub {
    const PG8_LAS int* te; const PG8_LAS int* tr0; const PG8_LAS int* tnr; int nunits, G, c; size_t a_pitch, b_exp; unsigned* cnt;
    __device__ __forceinline__ bool next(int i, Unit& u) const {
        const int L = i * G + c; if (L >= nunits) return false;
        const int t = L >> 2; u.pm = t; u.pn = L & 3; u.e = __builtin_amdgcn_readfirstlane(te[t]); u.row0 = __builtin_amdgcn_readfirstlane(tr0[t]); u.nr = __builtin_amdgcn_readfirstlane(tnr[t]); return true;
    }
    __device__ __forceinline__ size_t a_off(const Unit& u, size_t) const { return (size_t)u.row0 * a_pitch; }
    __device__ __forceinline__ size_t b_off(const Unit& u, size_t tstep) const { return (size_t)u.e * b_exp + (size_t)u.pn * tstep; }
    __device__ __forceinline__ void a_ready(const Unit&) const {}
    __device__ __forceinline__ void done(const Unit& u) const {
        asm volatile("s_waitcnt vmcnt(0)" ::: "memory");
        if ((threadIdx.x & 63) == 0) __hip_atomic_fetch_add(cnt + 16 * u.pm, 1u, __ATOMIC_RELAXED, __HIP_MEMORY_SCOPE_AGENT);
    }
};
struct GroupedOrderDep {
    const PG8_LAS int* te; const PG8_LAS int* tr0; const PG8_LAS int* tnr; int nunits, G, c; size_t b_exp; unsigned* cnt;
    __device__ __forceinline__ bool next(int i, Unit& u) const {
        const int L = i * G + (G - 1 - c); if (L >= nunits) return false;
        const int t = L >> 2; u.pm = t; u.pn = L & 3; u.e = __builtin_amdgcn_readfirstlane(te[t]); u.row0 = __builtin_amdgcn_readfirstlane(tr0[t]); u.nr = __builtin_amdgcn_readfirstlane(tnr[t]);
        u.rdy = __hip_atomic_load(cnt + 16 * t, __ATOMIC_RELAXED, __HIP_MEMORY_SCOPE_AGENT); return true;
    }
    __device__ __forceinline__ int tok(int i, int r) const { const int t = (i * G + (G - 1 - c)) >> 2; const int r0 = tr0[t], n = tnr[t]; return r0 + (r < n ? r : n - 1); }
    __device__ __forceinline__ size_t a_off(const Unit&, size_t) const { return 0; }
    __device__ __forceinline__ size_t b_off(const Unit& u, size_t tstep) const { return (size_t)u.e * b_exp + (size_t)u.pn * tstep; }
    __device__ __forceinline__ void a_ready(const Unit& u) const {
        if ((unsigned)__builtin_amdgcn_readfirstlane(u.rdy) < 32u) { unsigned spins = 0;
            while ((unsigned)__builtin_amdgcn_readfirstlane(__hip_atomic_load(cnt + 16 * u.pm, __ATOMIC_RELAXED, __HIP_MEMORY_SCOPE_AGENT)) < 32u && ++spins < (1u << 22)) __builtin_amdgcn_s_sleep(2); }
        asm volatile("" ::: "memory");
    }
    __device__ __forceinline__ void done(const Unit&) const {}
};
struct GroupedGatherOrder {
    const PG8_LAS int* te; const PG8_LAS int* tr0; const PG8_LAS int* tnr; const PG8_LAS int* rt; int nunits, G, c; size_t b_exp;
    __device__ __forceinline__ bool next(int i, Unit& u) const {
        const int L = i * G + c; if (L >= nunits) return false;
        const int t = L >> 2; u.pm = t; u.pn = L & 3; u.e = __builtin_amdgcn_readfirstlane(te[t]); u.row0 = __builtin_amdgcn_readfirstlane(tr0[t]); u.nr = __builtin_amdgcn_readfirstlane(tnr[t]); return true;
    }
    __device__ __forceinline__ int tok(int i, int r) const { return rt[i * 256 + r]; }
    __device__ __forceinline__ size_t a_off(const Unit&, size_t) const { return 0; }
    __device__ __forceinline__ size_t b_off(const Unit& u, size_t tstep) const { return (size_t)u.e * b_exp + (size_t)u.pn * tstep; }
    __device__ __forceinline__ void a_ready(const Unit&) const {}
    __device__ __forceinline__ void done(const Unit&) const {}
};
__device__ __forceinline__ float silu_fast(float x) { return x * __builtin_amdgcn_rcpf(1.f + __builtin_amdgcn_exp2f(-1.4426950408889634f * x)); }
struct EpiSwiGLU {
    static constexpr bool PERM = true, AFTER_DRAIN = false;
    bf16_t* H;
    __device__ __forceinline__ void operator()(const f32x4 (&acc)[2][2][4][2], const Unit& u, int wr, int wc, int fr, int fq) const {
        const int colh = u.pn * 128 + wc * 32 + 8 * fq;
#pragma unroll
        for (int ai = 0; ai < 2; ++ai)
#pragma unroll
            for (int m = 0; m < 4; ++m) { const int r = ai * HALF + wr * 64 + m * 16 + fr;
                if (r < u.nr) {
                    const f32x4 g0 = acc[ai][0][m][0], g1 = acc[ai][0][m][1], u0 = acc[ai][1][m][0], u1 = acc[ai][1][m][1];
                    u32x4 w; w.x = cvt_pk_bf16(silu_fast(g0[0]) * u0[0], silu_fast(g0[1]) * u0[1]); w.y = cvt_pk_bf16(silu_fast(g0[2]) * u0[2], silu_fast(g0[3]) * u0[3]);
                    w.z = cvt_pk_bf16(silu_fast(g1[0]) * u1[0], silu_fast(g1[1]) * u1[1]); w.w = cvt_pk_bf16(silu_fast(g1[2]) * u1[2], silu_fast(g1[3]) * u1[3]);
                    *(u32x4*)(H + (size_t)(u.row0 + r) * 512 + colh) = w; } }
    }
};
struct EpiBf16_I8 {
    static constexpr bool PERM = true, AFTER_DRAIN = false;
    bf16_t* O; int ldc; const float* sa; const float* sw; int nvalid;
    __device__ __forceinline__ void operator()(const f32x4 (&acc)[2][2][4][2], const Unit& u, int wr, int wc, int fr, int fq) const {
        const int row0 = u.pm * BM + wr * 64 + fr, col0 = u.pn * BM + wc * 32 + 8 * fq;
        f32x4 sv[2][2];
#pragma unroll
        for (int bj = 0; bj < 2; ++bj)
#pragma unroll
            for (int n = 0; n < 2; ++n) sv[bj][n] = *(const f32x4*)(sw + col0 + bj * HALF + 4 * n);
#pragma unroll
        for (int ai = 0; ai < 2; ++ai)
#pragma unroll
            for (int m = 0; m < 4; ++m) { const int r = row0 + ai * HALF + m * 16; const float a = sa[r]; bf16_t* rowp = O + (size_t)r * ldc + col0;
#pragma unroll
                for (int bj = 0; bj < 2; ++bj) { f32x4 v0, v1;
#pragma unroll
                    for (int j = 0; j < 4; ++j) { v0[j] = (float)__float_as_int(acc[ai][bj][m][0][j]) * (a * sv[bj][0][j]); v1[j] = (float)__float_as_int(acc[ai][bj][m][1][j]) * (a * sv[bj][1][j]); }
                    u32x4 w; w.x = cvt_pk_bf16(v0[0], v0[1]); w.y = cvt_pk_bf16(v0[2], v0[3]); w.z = cvt_pk_bf16(v1[0], v1[1]); w.w = cvt_pk_bf16(v1[2], v1[3]);
                    if (col0 + bj * HALF < nvalid) *(u32x4*)(rowp + bj * HALF) = w; } }
    }
};
template <bool WT = false> struct EpiSwiGLU_I8 {
    static constexpr bool PERM = true, AFTER_DRAIN = false;
    bf16_t* H; const float* sa; const float* sw;
    __device__ __forceinline__ void operator()(const f32x4 (&acc)[2][2][4][2], const Unit& u, int wr, int wc, int fr, int fq) const {
        const int colh = u.pn * 128 + wc * 32 + 8 * fq;
        const float* swp = sw + (size_t)u.e * 1024 + u.pn * 256 + wc * 32 + 8 * fq;
        const f32x4 sg0 = *(const f32x4*)swp, sg1 = *(const f32x4*)(swp + 4), su0 = *(const f32x4*)(swp + 128), su1 = *(const f32x4*)(swp + 132);
#pragma unroll
        for (int ai = 0; ai < 2; ++ai)
#pragma unroll
            for (int m = 0; m < 4; ++m) { const int r = ai * HALF + wr * 64 + m * 16 + fr;
                if (r < u.nr) { const float a = sa[u.row0 + r];
                    f32x4 g0, g1, u0, u1;
#pragma unroll
                    for (int j = 0; j < 4; ++j) { g0[j] = (float)__float_as_int(acc[ai][0][m][0][j]) * (a * sg0[j]); g1[j] = (float)__float_as_int(acc[ai][0][m][1][j]) * (a * sg1[j]);
                                                  u0[j] = (float)__float_as_int(acc[ai][1][m][0][j]) * (a * su0[j]); u1[j] = (float)__float_as_int(acc[ai][1][m][1][j]) * (a * su1[j]); }
                    u32x4 w; w.x = cvt_pk_bf16(silu_fast(g0[0]) * u0[0], silu_fast(g0[1]) * u0[1]); w.y = cvt_pk_bf16(silu_fast(g0[2]) * u0[2], silu_fast(g0[3]) * u0[3]);
                    w.z = cvt_pk_bf16(silu_fast(g1[0]) * u1[0], silu_fast(g1[1]) * u1[1]); w.w = cvt_pk_bf16(silu_fast(g1[2]) * u1[2], silu_fast(g1[3]) * u1[3]);
                    if (WT) asm volatile("global_store_dwordx4 %0, %1, off sc1" :: "v"(H + (size_t)(u.row0 + r) * 512 + colh), "v"(w) : "memory");
                    else *(u32x4*)(H + (size_t)(u.row0 + r) * 512 + colh) = w; } }
    }
};
struct EpiYs {
    static constexpr bool PERM = true, AFTER_DRAIN = false;
    bf16_t* Y; const float* gate;
    __device__ __forceinline__ void operator()(const f32x4 (&acc)[2][2][4][2], const Unit& u, int wr, int wc, int fr, int fq) const {
        const int col0 = u.pn * BM + wc * 32 + 8 * fq;
#pragma unroll
        for (int ai = 0; ai < 2; ++ai)
#pragma unroll
            for (int m = 0; m < 4; ++m) { const int r = ai * HALF + wr * 64 + m * 16 + fr;
                if (r < u.nr) { const float g = gate[u.row0 + r];
#pragma unroll
                    for (int bj = 0; bj < 2; ++bj) { const f32x4 v0 = acc[ai][bj][m][0] * g, v1 = acc[ai][bj][m][1] * g;
                        u32x4 w; w.x = cvt_pk_bf16(v0[0], v0[1]); w.y = cvt_pk_bf16(v0[2], v0[3]); w.z = cvt_pk_bf16(v1[0], v1[1]); w.w = cvt_pk_bf16(v1[2], v1[3]);
                        *(u32x4*)(Y + (size_t)(u.row0 + r) * 1024 + col0 + bj * HALF) = w; } } }
    }
};
struct EpiYs8 {
    static constexpr bool PERM = true, AFTER_DRAIN = false;
    unsigned char* Y; float* SC; const float* gate;
    __device__ __forceinline__ void operator()(const f32x4 (&acc)[2][2][4][2], const Unit& u, int wr, int wc, int fr, int fq) const {
        const int col0 = u.pn * BM + wc * 32 + 8 * fq;
#pragma unroll
        for (int ai = 0; ai < 2; ++ai)
#pragma unroll
            for (int m = 0; m < 4; ++m) { const int r = ai * HALF + wr * 64 + m * 16 + fr; const bool ok = r < u.nr;
                const float g = ok ? gate[u.row0 + r] : 0.f;
                f32x4 v[2][2]; float mx = 0.f;
#pragma unroll
                for (int bj = 0; bj < 2; ++bj)
#pragma unroll
                    for (int n = 0; n < 2; ++n) { v[bj][n] = acc[ai][bj][m][n] * g;
#pragma unroll
                        for (int j = 0; j < 4; ++j) mx = fmaxf(mx, fabsf(v[bj][n][j])); }
                mx = fmaxf(mx, __shfl_xor(mx, 16)); mx = fmaxf(mx, __shfl_xor(mx, 32));
                const float inv = mx > 0.f ? 127.f * __builtin_amdgcn_rcpf(mx) : 0.f;
                unsigned w[2][2];
#pragma unroll
                for (int bj = 0; bj < 2; ++bj)
#pragma unroll
                    for (int n = 0; n < 2; ++n) { const f32x4 f = v[bj][n] * inv + 128.5f;
                        w[bj][n] = (unsigned)f[0] | ((unsigned)f[1] << 8) | ((unsigned)f[2] << 16) | ((unsigned)f[3] << 24); }
                const bool odd = fq & 1;
                const unsigned s0 = odd ? w[0][0] : w[1][0], s1 = odd ? w[0][1] : w[1][1];
                const unsigned g0 = (unsigned)__shfl_xor((int)s0, 16), g1 = (unsigned)__shfl_xor((int)s1, 16);
                if (ok) {
                    const u32x4 o = odd ? (u32x4){g0, g1, w[1][0], w[1][1]} : (u32x4){w[0][0], w[0][1], g0, g1};
                    *(u32x4*)(Y + (size_t)(u.row0 + r) * 1024 + (col0 & ~15) + (odd ? HALF : 0)) = o;
                    if (fq == 0) SC[(size_t)(u.row0 + r) * 16 + wc * 4 + u.pn] = mx * (1.f / 127.f); } }
    }
};
template <class Epi, class Sched, bool ALIGN_EPI = false, bool SP2 = false, bool GATHER = false, bool I8 = false>
__device__ __forceinline__ void gemm_phase(PG8_LAS unsigned char* lds, const Gemm g, const Sched& S, const Epi& E) {
    const int tid = threadIdx.x, wid = __builtin_amdgcn_readfirstlane(tid >> 6), lane = tid & 63, wr = wid >> 2, wc = wid & 3, fr = lane & 15, fq = lane >> 4;
    const int K = g.K, KB = I8 ? K : 2 * K  , nt = KB / (BK * 2);
    unsigned voffA[2], voffB[2];
#pragma unroll
    for (int i = 0; i < 2; ++i) { int R, C; stage_rc(tid * 16 + i * 8192, R, C); const int Rb = Epi::PERM ? ((R & ~31) + perm32(R & 31)) : R;
        voffA[i] = (unsigned)(R * KB + C * 2); voffB[i] = (unsigned)(Rb * KB + C * 2); }
    unsigned cv0[2] = {0u, 0u}, cv1[2] = {0u, 0u}, nv0[2] = {0u, 0u}, nv1[2] = {0u, 0u};
    int gR[2], gC[2];
#pragma unroll
    for (int i = 0; i < 2; ++i) stage_rc(tid * 16 + i * 8192, gR[i], gC[i]);
#define PG8_GOFF(dst0, dst1, ui_) do { _Pragma("unroll") for (int _i = 0; _i < 2; ++_i) { \
        dst0[_i] = (unsigned)S.tok((ui_), gR[_i]) * (unsigned)KB + (unsigned)gC[_i] * 2u; dst1[_i] = (unsigned)S.tok((ui_), HALF + gR[_i]) * (unsigned)KB + (unsigned)gC[_i] * 2u; } } while (0)
    const size_t kstep = (size_t)(BK * 2);
    const size_t hstep = (size_t)HALF * KB;
    const size_t tstep = 2 * hstep;
    const unsigned ldsw = (unsigned)wid * 1024u;
    const int aoff = lds_byte(wr * 64 + fr, fq * 8), boff = lds_byte(wc * 32 + fr, fq * 8), aoff1 = lds_byte(wr * 64 + fr, 32 + fq * 8), boff1 = lds_byte(wc * 32 + fr, 32 + fq * 8);
#define PG8_SA(b, h) (((b) * 2 + (h)) * HTB)
#define PG8_SB(b, h) ((4 + (b) * 2 + (h)) * HTB)
#define PG8_STAGE(bufoff, gbase, voff) do { _Pragma("unroll") for (int _i = 0; _i < 2; ++_i) \
        __builtin_amdgcn_global_load_lds((const unsigned*)((const char*)(gbase) + (voff)[_i]), (PG8_LAS unsigned*)(lds + (bufoff) + ldsw + _i * 8192), 16, 0, 0); } while (0)
#define PG8_GLDS1(gp, ldsoff) __builtin_amdgcn_global_load_lds((const unsigned*)(gp), (PG8_LAS unsigned*)(lds + (ldsoff)), 16, 0, 0)
#define PG8_STAGEA(bufoff, kptr, half, nx) do { if constexpr (GATHER) { \
        const unsigned _v0 = (half) ? ((nx) ? nv1[0] : cv1[0]) : ((nx) ? nv0[0] : cv0[0]), _v1 = (half) ? ((nx) ? nv1[1] : cv1[1]) : ((nx) ? nv0[1] : cv0[1]); \
        PG8_GLDS1((const char*)(kptr) + _v0, (bufoff) + ldsw); PG8_GLDS1((const char*)(kptr) + _v1, (bufoff) + ldsw + 8192); \
    } else { PG8_STAGE(bufoff, (kptr) + ((half) ? hstep : (size_t)0), voffA); } } while (0)
#define PG8_LDA(dst, b, h) do { _Pragma("unroll") for (int m = 0; m < 4; ++m) _Pragma("unroll") for (int k = 0; k < 2; ++k) dst[m][k] = *(const PG8_LAS bf16x8*)(lds + PG8_SA(b, h) + (k ? aoff1 : aoff) + m * 2048); } while (0)
#define PG8_LDB(dst, b, h) do { _Pragma("unroll") for (int n = 0; n < 2; ++n) _Pragma("unroll") for (int k = 0; k < 2; ++k) dst[n][k] = *(const PG8_LAS bf16x8*)(lds + PG8_SB(b, h) + (k ? boff1 : boff) + n * 2048); } while (0)
#define PG8_MMA(ai, bj, At, Bt) do { __builtin_amdgcn_s_setprio(1); _Pragma("unroll") for (int m = 0; m < 4; ++m) _Pragma("unroll") for (int n = 0; n < 2; ++n) _Pragma("unroll") for (int k = 0; k < 2; ++k) { \
        if constexpr (I8) acc[ai][bj][m][n] = __builtin_bit_cast(f32x4, __builtin_amdgcn_mfma_i32_16x16x64_i8(__builtin_bit_cast(i32x4, Bt[n][k]), __builtin_bit_cast(i32x4, At[m][k]), __builtin_bit_cast(i32x4, acc[ai][bj][m][n]), 0, 0, 0)); \
        else acc[ai][bj][m][n] = __builtin_amdgcn_mfma_f32_16x16x32_bf16(Bt[n][k], At[m][k], acc[ai][bj][m][n], 0, 0, 0); } __builtin_amdgcn_s_setprio(0); } while (0)
#define PG8_WAIT_V(n) asm volatile("s_waitcnt vmcnt(" #n ")" ::: "memory")
#define PG8_WAIT_L(n) asm volatile("s_waitcnt lgkmcnt(" #n ")" ::: "memory")
#define PG8_BAR __builtin_amdgcn_s_barrier()
#define PG8_SCHED __builtin_amdgcn_sched_barrier(0)
    Unit cur, nxt; int ui = 0;
    if (!S.next(0, cur)) return;
    if constexpr (GATHER) { PG8_GOFF(cv0, cv1, 0); }
    f32x4 acc[2][2][4][2];
#pragma unroll
    for (int a = 0; a < 2; ++a)
#pragma unroll
        for (int b = 0; b < 2; ++b)
#pragma unroll
            for (int m = 0; m < 4; ++m)
#pragma unroll
                for (int n = 0; n < 2; ++n) acc[a][b][m][n] = (f32x4){0.f, 0.f, 0.f, 0.f};
    bf16x8 At[4][2], B0[2][2], B1[2][2];
    const char* cA = (const char*)g.A + S.a_off(cur, tstep); const char* cB = (const char*)g.Bt + S.b_off(cur, tstep);
    S.a_ready(cur);
    if constexpr (SP2) {
        PG8_STAGE(PG8_SB(0, 0), cB, voffB); PG8_STAGE(PG8_SB(0, 1), cB + hstep, voffB); PG8_STAGEA(PG8_SA(0, 0), cA, 0, false); PG8_STAGEA(PG8_SA(0, 1), cA, 1, false);
        if (wr == 1) PG8_BAR;
        PG8_WAIT_V(2); PG8_BAR;
        PG8_STAGE(PG8_SB(1, 0), cB + kstep, voffB); PG8_STAGEA(PG8_SA(1, 0), cA + kstep, 0, false); PG8_STAGE(PG8_SB(1, 1), cB + hstep + kstep, voffB);
        PG8_WAIT_V(6); PG8_BAR;
    } else {
        PG8_STAGE(PG8_SB(0, 0), cB, voffB); PG8_STAGEA(PG8_SA(0, 0), cA, 0, false); PG8_STAGE(PG8_SB(0, 1), cB + hstep, voffB); PG8_STAGEA(PG8_SA(0, 1), cA, 1, false);
        if (wr == 1) PG8_BAR;
        PG8_WAIT_V(4); PG8_BAR;
        PG8_STAGE(PG8_SB(1, 0), cB + kstep, voffB); PG8_STAGEA(PG8_SA(1, 0), cA + kstep, 0, false); PG8_STAGE(PG8_SB(1, 1), cB + hstep + kstep, voffB);
        PG8_WAIT_V(6); PG8_BAR;
    }
    for (;;) {
        const bool has_next = S.next(ui + 1, nxt);
        if constexpr (GATHER) { if (has_next) { PG8_GOFF(nv0, nv1, ui + 1); } else { nv0[0] = cv0[0]; nv0[1] = cv0[1]; nv1[0] = cv1[0]; nv1[1] = cv1[1]; } }
        const char* nA = has_next ? (const char*)g.A + S.a_off(nxt, tstep) : cA; const char* nB = has_next ? (const char*)g.Bt + S.b_off(nxt, tstep) : cB;
        for (int t = 0; t < nt; t += 2) {
            const bool last = (t == nt - 2);
            const char* a1 = cA + (size_t)(t + 1) * kstep;
            const char* a2 = last ? nA : cA + (size_t)(t + 2) * kstep; const char* b2 = last ? nB : cB + (size_t)(t + 2) * kstep;
            const char* a3 = a2 + kstep; const char* b3 = b2 + kstep;
            if (last && has_next) S.a_ready(nxt);
            if constexpr (SP2) {
            PG8_LDB(B0, 0, 0); PG8_LDB(B1, 0, 1); PG8_SCHED; PG8_LDA(At, 0, 0); PG8_STAGEA(PG8_SA(1, 1), a1, 1, false);
            PG8_WAIT_V(8); PG8_WAIT_L(0); PG8_BAR; PG8_MMA(0, 0, At, B0); PG8_MMA(0, 1, At, B1); PG8_BAR; PG8_SCHED;
            PG8_LDA(At, 0, 1); PG8_STAGE(PG8_SB(0, 0), b2, voffB); PG8_STAGE(PG8_SB(0, 1), b2 + hstep, voffB); PG8_STAGEA(PG8_SA(0, 0), a2, 0, last);
            PG8_WAIT_V(8); PG8_WAIT_L(0); PG8_BAR; PG8_MMA(1, 0, At, B0); PG8_MMA(1, 1, At, B1); PG8_BAR; PG8_SCHED;
            PG8_LDB(B0, 1, 0); PG8_LDB(B1, 1, 1); PG8_SCHED; PG8_LDA(At, 1, 0); PG8_STAGEA(PG8_SA(0, 1), a2, 1, last);
            PG8_WAIT_V(8); PG8_WAIT_L(0); PG8_BAR; PG8_MMA(0, 0, At, B0); PG8_MMA(0, 1, At, B1); PG8_BAR; PG8_SCHED;
            PG8_LDA(At, 1, 1); PG8_STAGE(PG8_SB(1, 0), b3, voffB); PG8_STAGE(PG8_SB(1, 1), b3 + hstep, voffB); PG8_STAGEA(PG8_SA(1, 0), a3, 0, last);
            PG8_WAIT_V(8); PG8_WAIT_L(0); PG8_BAR; PG8_MMA(1, 0, At, B0); PG8_MMA(1, 1, At, B1); PG8_BAR; PG8_SCHED;
            } else {
            PG8_LDB(B0, 0, 0); PG8_SCHED; PG8_LDA(At, 0, 0); PG8_STAGEA(PG8_SA(1, 1), a1, 1, false);
            PG8_WAIT_L(8); PG8_BAR; PG8_WAIT_L(0); PG8_MMA(0, 0, At, B0); PG8_BAR; PG8_SCHED;
            PG8_LDB(B1, 0, 1); PG8_STAGE(PG8_SB(0, 0), b2, voffB);
            PG8_BAR; PG8_WAIT_L(0); PG8_MMA(0, 1, At, B1); PG8_BAR;
            PG8_LDA(At, 0, 1); PG8_STAGEA(PG8_SA(0, 0), a2, 0, last);
            PG8_BAR; PG8_WAIT_L(0); PG8_MMA(1, 0, At, B0); PG8_BAR; PG8_SCHED;
            PG8_STAGE(PG8_SB(0, 1), b2 + hstep, voffB);
            PG8_WAIT_V(6); PG8_BAR; PG8_MMA(1, 1, At, B1); PG8_BAR;
            PG8_LDB(B0, 1, 0); PG8_SCHED; PG8_LDA(At, 1, 0); PG8_STAGEA(PG8_SA(0, 1), a2, 1, last);
            PG8_WAIT_L(8); PG8_BAR; PG8_WAIT_L(0); PG8_MMA(0, 0, At, B0); PG8_BAR; PG8_SCHED;
            PG8_LDB(B1, 1, 1); PG8_STAGE(PG8_SB(1, 0), b3, voffB);
            PG8_BAR; PG8_WAIT_L(0); PG8_MMA(0, 1, At, B1); PG8_BAR;
            PG8_LDA(At, 1, 1); PG8_STAGEA(PG8_SA(1, 0), a3, 0, last);
            PG8_BAR; PG8_WAIT_L(0); PG8_MMA(1, 0, At, B0); PG8_BAR; PG8_SCHED;
            PG8_STAGE(PG8_SB(1, 1), b3 + hstep, voffB);
            PG8_WAIT_V(6); PG8_BAR; PG8_MMA(1, 1, At, B1); PG8_BAR;
            }
        }
        if constexpr (ALIGN_EPI) { if (wr == 0) PG8_BAR; }
        if constexpr (!Epi::AFTER_DRAIN) { E(acc, cur, wr, wc, fr, fq); S.done(cur); }
        if (!has_next) break;
#pragma unroll
        for (int a = 0; a < 2; ++a)
#pragma unroll
            for (int b = 0; b < 2; ++b)
#pragma unroll
                for (int m = 0; m < 4; ++m)
#pragma unroll
                    for (int n = 0; n < 2; ++n) acc[a][b][m][n] = (f32x4){0.f, 0.f, 0.f, 0.f};
        cur = nxt; cA = nA; cB = nB; ++ui;
        if constexpr (GATHER) { cv0[0] = nv0[0]; cv0[1] = nv0[1]; cv1[0] = nv1[0]; cv1[1] = nv1[1]; }
        if constexpr (ALIGN_EPI) { if (wr == 1) PG8_BAR; }
    }
    PG8_WAIT_V(0);
    if constexpr (!ALIGN_EPI) { if (wr == 0) PG8_BAR; }
    PG8_BAR;
    if constexpr (Epi::AFTER_DRAIN) { E.fused(acc, cur, wr, wc, fr, fq, lds, wid, lane); S.done(cur); }
#undef PG8_SA
#undef PG8_SB
#undef PG8_STAGE
#undef PG8_STAGEA
#undef PG8_GLDS1
#undef PG8_GOFF
#undef PG8_LDA
#undef PG8_LDB
#undef PG8_MMA
#undef PG8_WAIT_V
#undef PG8_WAIT_L
#undef PG8_BAR
#undef PG8_SCHED
}
}
#define GAS __attribute__((address_space(1)))
#define LAS __attribute__((address_space(3)))
typedef unsigned short bf16;
typedef unsigned v4u __attribute__((ext_vector_type(4)));
typedef float f32x4 __attribute__((ext_vector_type(4)));
typedef short bf16x8 __attribute__((ext_vector_type(8)));
typedef GAS unsigned gu32;
typedef GAS unsigned long long gu64;
#define RLX_AGENT __ATOMIC_RELAXED, __HIP_MEMORY_SCOPE_AGENT
#define LDS_WAIT() asm volatile("s_waitcnt lgkmcnt(0)" ::: "memory")
#define VM_WAIT() asm volatile("s_waitcnt vmcnt(0)" ::: "memory")
__device__ __forceinline__ unsigned long long rt() { return __builtin_amdgcn_s_memrealtime(); }
__device__ __forceinline__ unsigned f2bfu(float f) { unsigned u = __builtin_bit_cast(unsigned, f); return (u + 0x7fffu + ((u >> 16) & 1u)) >> 16; }
__device__ __forceinline__ unsigned pk2(float lo, float hi) { return f2bfu(lo) | (f2bfu(hi) << 16); }

#define XB_TMO      128
#define XB_XCNT(j)  (256  + 64 * (j))
#define XB_XSUB(j)  (1280 + 64 * (j))
#define XB_XGEN(j)  (2304 + 64 * (j))
#define XB_TOP      3328
#define XB_TOPGEN   3392
#define XCD_BAR_WORDS 3456
#define XB_SPIN_CAP (1u << 18)

__device__ __forceinline__ unsigned xb_ld(unsigned* p)              { return __hip_atomic_load(p, __ATOMIC_RELAXED, __HIP_MEMORY_SCOPE_AGENT); }
__device__ __forceinline__ unsigned xb_add(unsigned* p, unsigned v) { return __hip_atomic_fetch_add(p, v, __ATOMIC_RELAXED, __HIP_MEMORY_SCOPE_AGENT); }
__device__ __forceinline__ unsigned xb_xcc_id() { return (unsigned)__builtin_amdgcn_s_getreg((3 << 11) | 20) & 0xFu; }
#define XB_SPIN(cond, bar) do { unsigned _sp = 0; while (cond) { __builtin_amdgcn_s_sleep(1); \
    if ((++_sp & 255u) == 0u) { if (xb_ld(&(bar)[XB_TMO])) break; if (_sp > XB_SPIN_CAP) { atomicAdd(&(bar)[XB_TMO], 1u); break; } } } } while (0)

struct XcdBarrier {
    unsigned* bar; unsigned x;
    volatile LAS unsigned* st;
};

__device__ __forceinline__ XcdBarrier xcd_barrier_post(unsigned* bar, volatile LAS unsigned* st) {
    XcdBarrier b; b.bar = bar; b.x = xb_xcc_id(); b.st = st;
    if (threadIdx.x == 0) (void)xb_add(&bar[XB_XCNT(b.x)], 1u);
    return b;
}
__device__ __forceinline__ void xcd_barrier_complete(unsigned* bar, unsigned x, unsigned& nloc, unsigned& nx) {
    const unsigned G = gridDim.x * gridDim.y * gridDim.z;
    unsigned sum, cnt, mine, sp = 0u;
    for (;;) {
        sum = 0u; cnt = 0u; mine = 0u;
#pragma unroll
        for (unsigned j = 0; j < 16; ++j) { const unsigned c = xb_ld(&bar[XB_XCNT(j)]); sum += c; cnt += (c > 0u) ? 1u : 0u; mine = (j == x) ? c : mine; }
        if (sum == G) break;
        __builtin_amdgcn_s_sleep(1);
        if ((++sp & 255u) == 0u) { if (xb_ld(&bar[XB_TMO])) break; if (sp > XB_SPIN_CAP) { atomicAdd(&bar[XB_TMO], 1u); break; } }
    }
    nloc = mine > 0u ? mine : 1u; nx = cnt > 0u ? cnt : 1u;
}

__device__ __forceinline__ void xcd_barrier(const XcdBarrier& b) {
    asm volatile("s_waitcnt vmcnt(0)" ::: "memory");
    __syncthreads();
    if (threadIdx.x == 0) {
        unsigned* bar = b.bar;
        __builtin_amdgcn_s_waitcnt(0);
        unsigned nloc = b.st[0], nx = b.st[1];
        if (nloc == 0u) { xcd_barrier_complete(bar, b.x, nloc, nx); b.st[0] = nloc; b.st[1] = nx; }
        const unsigned old = xb_add(&bar[XB_XSUB(b.x)], 1u);
        const unsigned gen = old / nloc;
        if (old + 1u == (gen + 1u) * nloc) {
            __builtin_amdgcn_fence(__ATOMIC_RELEASE, "agent");
            asm volatile("s_waitcnt vmcnt(0)" ::: "memory");
            const unsigned og = xb_add(&bar[XB_TOP], 1u);
            const unsigned tg = og / nx;
            if (og + 1u == (tg + 1u) * nx) xb_add(&bar[XB_TOPGEN], 1u);
            else XB_SPIN(xb_ld(&bar[XB_TOPGEN]) == tg, bar);
            __builtin_amdgcn_fence(__ATOMIC_ACQUIRE, "agent");
            xb_add(&bar[XB_XGEN(b.x)], 1u);
            asm volatile("s_waitcnt vmcnt(0)" ::: "memory");
        } else {
            XB_SPIN(xb_ld(&bar[XB_XGEN(b.x)]) == gen, bar);
            __builtin_amdgcn_fence(__ATOMIC_ACQUIRE, "agent");
            asm volatile("s_waitcnt vmcnt(0)" ::: "memory");
        }
    }
    __syncthreads();
}

template <bool DUAL, class FA, class FB, class FB2, class FE>
__device__ __forceinline__ void naive_tile_h(float* sm, int t256, int K, FA fa, FB fb, FB2 fb2, FE fe) {
    float* As = sm; float* Bs = sm + 1088; float* Bs2 = sm + 2176;
    const int tx = t256 & 15, ty = t256 >> 4;
    float acc[4][4], acc2[4][4];
#pragma unroll
    for (int i = 0; i < 4; ++i)
#pragma unroll
        for (int j = 0; j < 4; ++j) { acc[i][j] = 0.f; acc2[i][j] = 0.f; }
    for (int k0 = 0; k0 < K; k0 += 16) {
        { const int r = t256 >> 2, kk = (t256 & 3) * 4; const float4 a = fa(r, k0 + kk); As[kk * 68 + r] = a.x; As[(kk + 1) * 68 + r] = a.y; As[(kk + 2) * 68 + r] = a.z; As[(kk + 3) * 68 + r] = a.w; }
        { const int kk = t256 >> 4, c = (t256 & 15) * 4; *(float4*)&Bs[kk * 68 + c] = fb(k0 + kk, c); if (DUAL) *(float4*)&Bs2[kk * 68 + c] = fb2(k0 + kk, c); }
        __syncthreads();
#pragma unroll
        for (int kk = 0; kk < 16; ++kk) {
            const float4 a = *(const float4*)&As[kk * 68 + ty * 4]; const float4 b = *(const float4*)&Bs[kk * 68 + tx * 4];
            const float av[4] = {a.x, a.y, a.z, a.w}; const float bv[4] = {b.x, b.y, b.z, b.w};
#pragma unroll
            for (int i = 0; i < 4; ++i)
#pragma unroll
                for (int j = 0; j < 4; ++j) acc[i][j] += av[i] * bv[j];
            if (DUAL) {
                const float4 b2 = *(const float4*)&Bs2[kk * 68 + tx * 4]; const float bw[4] = {b2.x, b2.y, b2.z, b2.w};
#pragma unroll
                for (int i = 0; i < 4; ++i)
#pragma unroll
                    for (int j = 0; j < 4; ++j) acc2[i][j] += av[i] * bw[j];
            }
        }
        __syncthreads();
    }
#pragma unroll
    for (int i = 0; i < 4; ++i) fe(ty * 4 + i, tx * 4, make_float4(acc[i][0], acc[i][1], acc[i][2], acc[i][3]), make_float4(acc2[i][0], acc2[i][1], acc2[i][2], acc2[i][3]));
}

__device__ __forceinline__ void ph_la(int gtid, int nthr, const bf16_t* PROJ, const float* upf, const float* bf, const float* upb, const float* bb, float* LAF, float* LAB) {
    for (int i = gtid; i < NTOK * 256 * 2; i += nthr) {
        const int c = i & 255, t = (i >> 8) & (NTOK - 1), dir = i >> 23;
        const bf16_t* z = PROJ + (size_t)t * PW + (dir ? C_ZB : C_ZF);
        const float* up = dir ? upb : upf; const float* bias = dir ? bb : bf;
        float pre = bias[c];
#pragma unroll
        for (int r = 0; r < 16; ++r) pre += bf2f(z[r]) * up[r * 256 + c];
        const float ls = fminf(pre, 0.f) - log1pf(expf(-fabsf(pre)));
        (dir ? LAB : LAF)[(size_t)t * 256 + c] = ls * (1.f / 16.f);
    }
}
__device__ __forceinline__ void ph_gla_scan(int bid, int tid, const bf16_t* PROJ, const float* LAF, const float* LAB, float* OF, float* OB) {
    const int es = bid & 3, dir = (bid >> 2) & 1, h = (bid >> 3) & 3, b = bid >> 5;
    const int dg = tid & 15, el = tid >> 4, e = es * 32 + el;
    const float* LA = dir ? LAB : LAF; float* O = dir ? OB : OF;
    float S0 = 0.f, S1 = 0.f, S2 = 0.f, S3 = 0.f;
#pragma unroll 4
    for (int step = 0; step < T; ++step) {
        const int t = dir ? (T - 1 - step) : step;
        const size_t row = (size_t)b * T + t;
        const bf16_t* pr = PROJ + row * PW;
        const float4 la = *(const float4*)(LA + row * 256 + h * 64 + dg * 4);
        const float4 q = ld_bf4(pr + C_GQ + h * 64 + dg * 4);
        const float4 k = ld_bf4(pr + C_GK + h * 64 + dg * 4);
        const float v = bf2f(pr[C_GV + h * 128 + e]);
        S0 = expf(la.x) * S0 + k.x * v; S1 = expf(la.y) * S1 + k.y * v; S2 = expf(la.z) * S2 + k.z * v; S3 = expf(la.w) * S3 + k.w * v;
        float part = (q.x * S0 + q.y * S1 + q.z * S2 + q.w * S3) * 0.125f;
        part += __shfl_xor(part, 1); part += __shfl_xor(part, 2); part += __shfl_xor(part, 4); part += __shfl_xor(part, 8);
        if (dg == 0) O[row * 512 + h * 128 + e] = part;
    }
}
__device__ __forceinline__ void ph_gla_combine(int gw, int NGW, int lane, const float* OF, const float* OB, const bf16_t* PROJ, const float* gain, bf16_t* MIXED) {
    for (int w = gw; w < NTOK * 4; w += NGW) {
        const int t = w >> 2, h = w & 3;
        const size_t o = (size_t)t * 512 + h * 128 + lane * 2;
        const float2 a = *(const float2*)(OF + o), bq = *(const float2*)(OB + o);
        const float v0 = a.x + bq.x, v1 = a.y + bq.y;
        const float ss = wave_sum(v0 * v0 + v1 * v1);
        const float rstd = rsqrtf(ss * (1.f / 128.f) + EPS);
        const bf16_t* g = PROJ + (size_t)t * PW + C_GG + h * 128 + lane * 2;
        const float g0 = bf2f(g[0]), g1 = bf2f(g[1]);
        bf16_t* m = MIXED + (size_t)t * D + h * 128 + lane * 2;
        m[0] = f2bf(v0 * rstd * gain[lane * 2] * silu_f(g0)); m[1] = f2bf(v1 * rstd * gain[lane * 2 + 1] * silu_f(g1));
    }
}
__device__ __forceinline__ void ph_qk_prep(int gw, int NGW, int lane, bf16_t* PROJ, const float* qg, const float* kg, const float* rope, bf16_t* OUT, int opitch) {
    const float gq = qg[lane], gk = kg[lane];
    const int pi = lane >> 1, j = pi & 15;
    for (int t = gw; t < NTOK; t += NGW) {
        bf16_t* p = PROJ + (size_t)t * PW + C_AQ + lane;
        float v[10];
#pragma unroll
        for (int hs = 8; hs < 10; ++hs) v[hs] = bf2f(p[hs * 64]);
        const int tt = t & (T - 1), pos = pi < 16 ? (tt >> 6) : (tt & 63);
        const float c = rope[pos * 16 + j], s = rope[1024 + pos * 16 + j];
#pragma unroll
        for (int hs = 8; hs < 10; ++hs) {
            const float ss = wave_sum(v[hs] * v[hs]);
            const float y = v[hs] * rsqrtf(ss * (1.f / 64.f) + EPS) * (hs < 8 ? gq : gk);
            const float partner = __shfl_xor(y, 1);
            float o = (lane & 1) ? (partner * s + y * c) : (y * c - partner * s);
            if (hs < 8) o *= 0.125f * 1.4426950408889634f;
            OUT[(size_t)t * opitch + lane + hs * 64] = f2bf(o);
        }
    }
}
__device__ __forceinline__ void ph_attn_vb(float* sm, int t256, int vb, const bf16_t* PROJ, float* ATT) {
    float* Qt = sm; float* KV = sm + 4352; float* St = sm + 8704; float* al = sm + 13056;
    const int tx = t256 & 15, ty = t256 >> 4;
    const int q0 = (vb & 63) * 64, hq = (vb >> 6) & 7, b = vb >> 9, kvh = hq >> 2;
    const size_t rowb = (size_t)b * T;
    { const int r = t256 >> 2, d0 = (t256 & 3) * 16; const bf16_t* p = PROJ + (rowb + q0 + r) * PW + C_AQ + hq * 64 + d0;
#pragma unroll
      for (int i = 0; i < 16; ++i) Qt[(d0 + i) * 68 + r] = bf2f(p[i]); }
    float O[4][4];
#pragma unroll
    for (int i = 0; i < 4; ++i)
#pragma unroll
        for (int j = 0; j < 4; ++j) O[i][j] = 0.f;
    float m_run = -INFINITY, l_run = 0.f;
    for (int k0 = 0; k0 < T; k0 += 64) {
        { const int c = t256 >> 2, d0 = (t256 & 3) * 16; const bf16_t* p = PROJ + (rowb + k0 + c) * PW + C_AK + kvh * 64 + d0;
#pragma unroll
          for (int i = 0; i < 16; ++i) KV[(d0 + i) * 68 + c] = bf2f(p[i]); }
        __syncthreads();
        float s[4][4];
#pragma unroll
        for (int i = 0; i < 4; ++i)
#pragma unroll
            for (int j = 0; j < 4; ++j) s[i][j] = 0.f;
#pragma unroll 8
        for (int d = 0; d < 64; ++d) {
            const float4 a = *(const float4*)&Qt[d * 68 + ty * 4]; const float4 bq = *(const float4*)&KV[d * 68 + tx * 4];
            const float av[4] = {a.x, a.y, a.z, a.w}; const float bv[4] = {bq.x, bq.y, bq.z, bq.w};
#pragma unroll
            for (int i = 0; i < 4; ++i)
#pragma unroll
                for (int j = 0; j < 4; ++j) s[i][j] += av[i] * bv[j];
        }
#pragma unroll
        for (int i = 0; i < 4; ++i)
#pragma unroll
            for (int j = 0; j < 4; ++j) St[(tx * 4 + j) * 68 + ty * 4 + i] = s[i][j];
        __syncthreads();
        { const int c = t256 >> 2, e0 = (t256 & 3) * 16; const bf16_t* p = PROJ + (rowb + k0 + c) * PW + C_AV + kvh * 64 + e0;
#pragma unroll
          for (int i = 0; i < 16; ++i) KV[c * 68 + e0 + i] = bf2f(p[i]); }
        if (t256 < 64) {
            float mx = -INFINITY;
            for (int c = 0; c < 64; ++c) mx = fmaxf(mx, St[c * 68 + t256]);
            const float mn = fmaxf(m_run, mx);
            const float alpha = expf(m_run - mn);
            float sum = 0.f;
            for (int c = 0; c < 64; ++c) { const float p = expf(St[c * 68 + t256] - mn); St[c * 68 + t256] = p; sum += p; }
            l_run = l_run * alpha + sum; m_run = mn; al[t256] = alpha;
        }
        __syncthreads();
#pragma unroll
        for (int i = 0; i < 4; ++i) { const float a = al[ty * 4 + i];
#pragma unroll
            for (int j = 0; j < 4; ++j) O[i][j] *= a; }
#pragma unroll 8
        for (int c = 0; c < 64; ++c) {
            const float4 a = *(const float4*)&St[c * 68 + ty * 4]; const float4 bq = *(const float4*)&KV[c * 68 + tx * 4];
            const float av[4] = {a.x, a.y, a.z, a.w}; const float bv[4] = {bq.x, bq.y, bq.z, bq.w};
#pragma unroll
            for (int i = 0; i < 4; ++i)
#pragma unroll
                for (int j = 0; j < 4; ++j) O[i][j] += av[i] * bv[j];
        }
        __syncthreads();
    }
    if (t256 < 64) al[t256] = 1.f / l_run;
    __syncthreads();
#pragma unroll
    for (int i = 0; i < 4; ++i) { const float a = al[ty * 4 + i];
        *(float4*)(ATT + (rowb + q0 + ty * 4 + i) * 512 + hq * 64 + tx * 4) = make_float4(O[i][0] * a, O[i][1] * a, O[i][2] * a, O[i][3] * a); }
    __syncthreads();
}
__device__ __forceinline__ void ph_att_norm(int gw, int NGW, int lane, const float* ATT, const float* gain, bf16_t* MIXED) {
    for (int t = gw; t < NTOK; t += NGW) {
        const float4* a = (const float4*)(ATT + (size_t)t * 512);
        const float4 v0 = a[lane], v1 = a[64 + lane];
        const float ss = wave_sum(v0.x * v0.x + v0.y * v0.y + v0.z * v0.z + v0.w * v0.w + v1.x * v1.x + v1.y * v1.y + v1.z * v1.z + v1.w * v1.w);
        const float rstd = rsqrtf(ss * (1.f / 512.f) + EPS);
        const float4 g0 = ((const float4*)gain)[lane], g1 = ((const float4*)gain)[64 + lane];
        bf16_t* m = MIXED + (size_t)t * D + 512;
        st_bf4(m + lane * 4, make_float4(v0.x * rstd * g0.x, v0.y * rstd * g0.y, v0.z * rstd * g0.z, v0.w * rstd * g0.w));
        st_bf4(m + 256 + lane * 4, make_float4(v1.x * rstd * g1.x, v1.y * rstd * g1.y, v1.z * rstd * g1.z, v1.w * rstd * g1.w));
    }
}
__device__ __forceinline__ void ph_router(int gw, int NGW, int lane, const float* H, const float* g2, const float* wg, const float* bg, const float* we, const float* be, float* RSTD, unsigned* tokinfo, unsigned* ctl) {
    for (int t = gw; t < NTOK; t += NGW) {
        const float4* hr = (const float4*)(H + (size_t)t * D);
        float ss = 0.f;
#pragma unroll
        for (int j = 0; j < 4; ++j) { const float4 v = hr[j * 64 + lane]; ss += v.x * v.x + v.y * v.y + v.z * v.z + v.w * v.w; }
        ss = wave_sum(ss);
        const float rstd = rsqrtf(ss * (1.f / D) + EPS);
        float gl[8], el[64];
#pragma unroll
        for (int i = 0; i < 8; ++i) gl[i] = 0.f;
#pragma unroll
        for (int i = 0; i < 64; ++i) el[i] = 0.f;
#pragma unroll 1
        for (int ji = 0; ji < 16; ++ji) {
            const int k = ((ji >> 2) * 64 + lane) * 4 + (ji & 3);
            const float xv = H[(size_t)t * D + k] * rstd * g2[k];
            const float4* pg = (const float4*)(wg + (size_t)k * 8);
#pragma unroll
            for (int q = 0; q < 2; ++q) { const float4 w = pg[q]; gl[q * 4] += xv * w.x; gl[q * 4 + 1] += xv * w.y; gl[q * 4 + 2] += xv * w.z; gl[q * 4 + 3] += xv * w.w; }
            const float4* pe = (const float4*)(we + (size_t)k * 64);
#pragma unroll
            for (int q = 0; q < 16; ++q) { const float4 w = pe[q]; el[q * 4] += xv * w.x; el[q * 4 + 1] += xv * w.y; el[q * 4 + 2] += xv * w.z; el[q * 4 + 3] += xv * w.w; }
        }
#pragma unroll
        for (int i = 0; i < 8; ++i) gl[i] = wave_sum(gl[i]) + bg[i];
#pragma unroll
        for (int i = 0; i < 64; ++i) el[i] = wave_sum(el[i]) + be[i];
        float best = gl[0]; int g = 0;
#pragma unroll
        for (int i = 1; i < 8; ++i) if (gl[i] > best) { best = gl[i]; g = i; }
        float den = 0.f;
#pragma unroll
        for (int i = 0; i < 8; ++i) den += expf(gl[i] - best);
        const float gw_ = 1.f / den;
        float ev[8];
#pragma unroll
        for (int j = 0; j < 8; ++j) { float v = el[j];
#pragma unroll
            for (int q = 1; q < 8; ++q) v = (g == q) ? el[q * 8 + j] : v;
            ev[j] = v; }
        float v1 = ev[0]; int i1 = 0;
#pragma unroll
        for (int j = 1; j < 8; ++j) if (ev[j] > v1) { v1 = ev[j]; i1 = j; }
        float v2 = -INFINITY; int i2 = 0;
#pragma unroll
        for (int j = 0; j < 8; ++j) if (j != i1 && ev[j] > v2) { v2 = ev[j]; i2 = j; }
        const float ex = expf(v2 - v1), p1 = 1.f / (1.f + ex), p2 = ex * p1;
        if (lane == 0) {
            const int e1 = g * 8 + i1, e2 = g * 8 + i2;
            uint4 o; o.x = (unsigned)e1; o.y = (unsigned)e2; o.z = __float_as_uint(gw_ * p1); o.w = __float_as_uint(gw_ * p2);
            ((uint4*)tokinfo)[t] = o;
            RSTD[t] = rstd;
            atomicAdd(&ctl[CW_COUNTS + e1], 1u); atomicAdd(&ctl[CW_COUNTS + e2], 1u);
        }
    }
}
__device__ __forceinline__ void ph_offsets(unsigned* ctl) {
    unsigned off = 0, nt = 0;
    for (int e = 0; e < NEXP; ++e) {
        const unsigned c = ctl[CW_COUNTS + e]; ctl[CW_OFFS + e] = off;
        for (unsigned r = 0; r < c; r += 64) { ctl[CW_TILE_E + nt] = (unsigned)e; ctl[CW_TILE_R0 + nt] = off + r; ctl[CW_TILE_NR + nt] = (c - r) < 64u ? (c - r) : 64u; ++nt; }
        off += c;
    }
    ctl[CW_OFFS + NEXP] = off; ctl[CW_NTILES] = nt;
}
__device__ __forceinline__ void ph_scatter(int gtid, int nthr, const unsigned* tokinfo, unsigned* ctl, int* tokslot, int* slottok, float* slotgate) {
    for (int t = gtid; t < NTOK; t += nthr) {
        const uint4 ti = ((const uint4*)tokinfo)[t];
        const unsigned p0 = ctl[CW_OFFS + ti.x] + atomicAdd(&ctl[CW_CURSOR + ti.x], 1u);
        const unsigned p1 = ctl[CW_OFFS + ti.y] + atomicAdd(&ctl[CW_CURSOR + ti.y], 1u);
        slottok[p0] = t; slottok[p1] = t; slotgate[p0] = __uint_as_float(ti.z); slotgate[p1] = __uint_as_float(ti.w);
        tokslot[2 * t] = (int)p0; tokslot[2 * t + 1] = (int)p1;
    }
}
__device__ __forceinline__ void ph_moe1_vb(float* sm, int t256, bool valid, int vb, const bf16_t* XN2, const float* w_gate, const float* w_up, const unsigned* ctl, const int* slottok, bf16_t* HMID) {
    const int tile = valid ? (vb >> 3) : 0, c0 = (vb & 7) * 64;
    const int e = (int)ctl[CW_TILE_E + tile], row0 = (int)ctl[CW_TILE_R0 + tile], nr = valid ? (int)ctl[CW_TILE_NR + tile] : 0;
    const float* wgp = w_gate + (size_t)e * D * DEXP; const float* wup = w_up + (size_t)e * D * DEXP;
    auto fa = [&](int r, int k) { if (r >= nr) return make_float4(0.f, 0.f, 0.f, 0.f); const int tok = slottok[row0 + r]; return ld_bf4(XN2 + (size_t)tok * D + k); };
    auto fb = [&](int k, int c) { return *(const float4*)(wgp + (size_t)k * DEXP + c0 + c); };
    auto fb2 = [&](int k, int c) { return *(const float4*)(wup + (size_t)k * DEXP + c0 + c); };
    auto fe = [&](int r, int c, float4 a, float4 u) { if (r >= nr) return; st_bf4(HMID + (size_t)(row0 + r) * DEXP + c0 + c, make_float4(silu_f(a.x) * u.x, silu_f(a.y) * u.y, silu_f(a.z) * u.z, silu_f(a.w) * u.w)); };
    naive_tile_h<true>(sm, t256, D, fa, fb, fb2, fe);
}
__device__ __forceinline__ void ph_moe2_vb(float* sm, int t256, bool valid, int vb, const bf16_t* HMID, const float* w_down, const unsigned* ctl, const float* slotgate, bf16_t* YS) {
    const int tile = valid ? (vb >> 4) : 0, c0 = (vb & 15) * 64;
    const int e = (int)ctl[CW_TILE_E + tile], row0 = (int)ctl[CW_TILE_R0 + tile], nr = valid ? (int)ctl[CW_TILE_NR + tile] : 0;
    const float* wd = w_down + (size_t)e * DEXP * D;
    auto fa = [&](int r, int k) { if (r >= nr) return make_float4(0.f, 0.f, 0.f, 0.f); return ld_bf4(HMID + (size_t)(row0 + r) * DEXP + k); };
    auto fb = [&](int k, int c) { return *(const float4*)(wd + (size_t)k * D + c0 + c); };
    auto fe = [&](int r, int c, float4 a, float4) { if (r >= nr) return; const float g = slotgate[row0 + r]; st_bf4(YS + (size_t)(row0 + r) * D + c0 + c, make_float4(a.x * g, a.y * g, a.z * g, a.w * g)); };
    naive_tile_h<false>(sm, t256, DEXP, fa, fb, fb, fe);
}
__device__ __forceinline__ void ph_final(int gw, int NGW, int lane, const bf16_t* H, const unsigned char* YS8, const float* YSC, const int* tokslot, const float* fg, float* OUTA, float* OUTB) {
    const int sub = (lane & 31) >> 3;
    float4 g[4];
#pragma unroll
    for (int j = 0; j < 4; ++j) g[j] = ((const float4*)fg)[j * 64 + lane];
    for (int t = 2 * gw; t < NTOK; t += 2 * NGW) {
        const int4 sl = *(const int4*)(tokslot + 2 * t);
        float4 v[2][4]; float ss[2] = {0.f, 0.f};
#pragma unroll
        for (int q = 0; q < 2; ++q) {
            const int s0 = q ? sl.z : sl.x, s1 = q ? sl.w : sl.y;
            const bf16_t* hr = H + (size_t)(t + q) * D;
            const unsigned* y0 = (const unsigned*)(YS8 + (size_t)s0 * D); const unsigned* y1 = (const unsigned*)(YS8 + (size_t)s1 * D);
            const float4 a0 = *(const float4*)(YSC + (size_t)s0 * 16 + sub * 4), a1 = *(const float4*)(YSC + (size_t)s1 * 16 + sub * 4);
            const float a0j[4] = {a0.x, a0.y, a0.z, a0.w}, a1j[4] = {a1.x, a1.y, a1.z, a1.w};
#pragma unroll
            for (int j = 0; j < 4; ++j) {
                const float4 hv = ld_bf4(hr + (j * 64 + lane) * 4); const unsigned w0 = y0[j * 64 + lane], w1 = y1[j * 64 + lane];
                const float p = a0j[j], r = a1j[j], off = -128.f * (p + r);
                v[q][j] = make_float4((hv.x + off) + p * (float)(w0 & 0xffu) + r * (float)(w1 & 0xffu), (hv.y + off) + p * (float)((w0 >> 8) & 0xffu) + r * (float)((w1 >> 8) & 0xffu),
                                      (hv.z + off) + p * (float)((w0 >> 16) & 0xffu) + r * (float)((w1 >> 16) & 0xffu), (hv.w + off) + p * (float)(w0 >> 24) + r * (float)(w1 >> 24));
                ss[q] += v[q][j].x * v[q][j].x + v[q][j].y * v[q][j].y + v[q][j].z * v[q][j].z + v[q][j].w * v[q][j].w;
            }
        }
#pragma unroll
        for (int q = 0; q < 2; ++q) {
            const float rstd = rsqrtf(wave_sum(ss[q]) * (1.f / D) + EPS);
            const int tt = t + q;
            float4* orow = (float4*)((tt < NTOK / 2 ? OUTA + (size_t)tt * D : OUTB + (size_t)(tt - NTOK / 2) * D));
#pragma unroll
            for (int j = 0; j < 4; ++j) orow[j * 64 + lane] = make_float4(v[q][j].x * rstd * g[j].x, v[q][j].y * rstd * g[j].y, v[q][j].z * rstd * g[j].z, v[q][j].w * rstd * g[j].w);
        }
    }
}
__device__ __forceinline__ void ph_copy_xs(int bx, int wave, int lane, const LAS int* pos, const float* H, const float* RSTD, const float* g2, bf16_t* XS) {
    float4 g[4];
#pragma unroll
    for (int j = 0; j < 4; ++j) g[j] = ((const float4*)g2)[j * 64 + lane];
#pragma unroll 1
    for (int i = 0; i < 16; i += 2) {
        const int l0 = wave * 16 + i, l1 = l0 + 1, t0 = bx * 128 + l0, t1 = t0 + 1;
        const float r0 = RSTD[t0], r1 = RSTD[t1];
        const float4* h0 = (const float4*)(H + (size_t)t0 * D); const float4* h1 = (const float4*)(H + (size_t)t1 * D);
        float4 a[4], b[4];
#pragma unroll
        for (int j = 0; j < 4; ++j) { a[j] = h0[j * 64 + lane]; b[j] = h1[j * 64 + lane]; }
        uint2* o00 = (uint2*)(XS + (size_t)pos[2 * l0] * D); uint2* o01 = (uint2*)(XS + (size_t)pos[2 * l0 + 1] * D);
        uint2* o10 = (uint2*)(XS + (size_t)pos[2 * l1] * D); uint2* o11 = (uint2*)(XS + (size_t)pos[2 * l1 + 1] * D);
#pragma unroll
        for (int j = 0; j < 4; ++j) {
            uint2 w; w.x = (unsigned)f2bf(a[j].x * r0 * g[j].x) | ((unsigned)f2bf(a[j].y * r0 * g[j].y) << 16); w.y = (unsigned)f2bf(a[j].z * r0 * g[j].z) | ((unsigned)f2bf(a[j].w * r0 * g[j].w) << 16);
            o00[j * 64 + lane] = w; o01[j * 64 + lane] = w;
            uint2 v; v.x = (unsigned)f2bf(b[j].x * r1 * g[j].x) | ((unsigned)f2bf(b[j].y * r1 * g[j].y) << 16); v.y = (unsigned)f2bf(b[j].z * r1 * g[j].z) | ((unsigned)f2bf(b[j].w * r1 * g[j].w) << 16);
            o10[j * 64 + lane] = v; o11[j * 64 + lane] = v;
        }
    }
}

__device__ __forceinline__ void ph_copy_xs_i8(int bx, int wave, int lane, const LAS int* pos, const bf16_t* H, const float* RSTD, const float* g2, unsigned char* XS8, float* SA) {
    float4 g[4];
#pragma unroll
    for (int j = 0; j < 4; ++j) g[j] = ((const float4*)g2)[lane * 4 + j];
#pragma unroll 1
    for (int i = 0; i < 16; i += 2) {
        const int l0 = wave * 16 + i, t0 = bx * 128 + l0;
        float4 a[2][4]; float mx[2];
#pragma unroll
        for (int q = 0; q < 2; ++q) { const uint4* hp = (const uint4*)(H + (size_t)(t0 + q) * D + lane * 16); const uint4 h0 = hp[0], h1 = hp[1];
            const unsigned hw[8] = {h0.x, h0.y, h0.z, h0.w, h1.x, h1.y, h1.z, h1.w};
#pragma unroll
            for (int j = 0; j < 4; ++j) a[q][j] = make_float4(__uint_as_float(hw[2 * j] << 16), __uint_as_float(hw[2 * j] & 0xffff0000u), __uint_as_float(hw[2 * j + 1] << 16), __uint_as_float(hw[2 * j + 1] & 0xffff0000u)); }
#pragma unroll
        for (int q = 0; q < 2; ++q) { const float r = RSTD[t0 + q]; float m = 0.f;
#pragma unroll
            for (int j = 0; j < 4; ++j) { a[q][j].x *= r * g[j].x; a[q][j].y *= r * g[j].y; a[q][j].z *= r * g[j].z; a[q][j].w *= r * g[j].w;
                m = fmaxf(m, fmaxf(fmaxf(fabsf(a[q][j].x), fabsf(a[q][j].y)), fmaxf(fabsf(a[q][j].z), fabsf(a[q][j].w)))); }
#pragma unroll
            for (int o = 1; o < 64; o <<= 1) m = fmaxf(m, __shfl_xor(m, o));
            mx[q] = m; }
#pragma unroll
        for (int q = 0; q < 2; ++q) { const float inv = mx[q] > 0.f ? 127.f / mx[q] : 0.f;
            v4u w;
#pragma unroll
            for (int j = 0; j < 4; ++j) { const int ia = __float2int_rn(a[q][j].x * inv), ib = __float2int_rn(a[q][j].y * inv), ic = __float2int_rn(a[q][j].z * inv), id = __float2int_rn(a[q][j].w * inv);
                w[j] = ((unsigned)ia & 0xffu) | (((unsigned)ib & 0xffu) << 8) | (((unsigned)ic & 0xffu) << 16) | ((unsigned)id << 24); }
            const int p0 = pos[2 * (l0 + q)], p1 = pos[2 * (l0 + q) + 1];
            *(GAS v4u*)(XS8 + (size_t)p0 * D + lane * 16) = w; *(GAS v4u*)(XS8 + (size_t)p1 * D + lane * 16) = w;
            if (lane == 0) { SA[p0] = mx[q] * (1.f / 127.f); SA[p1] = mx[q] * (1.f / 127.f); } }
    }
}
constexpr size_t WS_DEC = 11 * MiB;
constexpr int LDT = 72;
constexpr int GL_QE = 0, GL_KE = 9216, GL_P = 18432, GL_VT = 27648, GL_ST = 46080, GL_TOT = 64512, GL_PART = 68608, GL_RSTD = 70656;
typedef float gf32x4 __attribute__((ext_vector_type(4)));
typedef short gbf16x8 __attribute__((ext_vector_type(8)));

__device__ __forceinline__ float exp_fast(float x) { return __builtin_amdgcn_exp2f(x * 1.4426950408889634f); }
__device__ __forceinline__ float log_sigmoid_f(float x) { return fminf(x, 0.f) - 0.6931471805599453f * __builtin_amdgcn_logf(1.f + exp_fast(-fabsf(x))); }
__device__ __forceinline__ gf32x4 mfma_tile64(const LAS bf16_t* A, const LAS bf16_t* Bt, gf32x4 acc, int lane) {
    const int r = lane & 15, kq = (lane >> 4) * 8;
    const gbf16x8 a0 = *(const LAS gbf16x8*)(A + r * LDT + kq), a1 = *(const LAS gbf16x8*)(A + r * LDT + kq + 32);
    const gbf16x8 b0 = *(const LAS gbf16x8*)(Bt + r * LDT + kq), b1 = *(const LAS gbf16x8*)(Bt + r * LDT + kq + 32);
    acc = __builtin_amdgcn_mfma_f32_16x16x32_bf16(a0, b0, acc, 0, 0, 0);
    acc = __builtin_amdgcn_mfma_f32_16x16x32_bf16(a1, b1, acc, 0, 0, 0);
    return acc;
}
template <bool BWD>
__device__ __forceinline__ void gla_cumsum(const bf16_t* zbase  , const float* up  , const float* bias, int hd  , int tg, int d, LAS float* tot, float (&bv)[8], float& bl) {
    float upc[16];
#pragma unroll
    for (int r = 0; r < 16; ++r) upc[r] = up[r * 256 + hd];
    const float bs = bias[hd];
    float c[8];
#pragma unroll
    for (int i = 0; i < 8; ++i) {
        const uint4* zp = (const uint4*)(zbase + (size_t)(8 * tg + i) * PW);
        const uint4 z0 = zp[0], z1 = zp[1];
        const unsigned zw[8] = {z0.x, z0.y, z0.z, z0.w, z1.x, z1.y, z1.z, z1.w};
        float pre = bs;
#pragma unroll
        for (int r = 0; r < 8; ++r) { pre += __uint_as_float(zw[r] << 16) * upc[2 * r]; pre += __uint_as_float(zw[r] & 0xffff0000u) * upc[2 * r + 1]; }
        c[i] = log_sigmoid_f(pre) * (1.f / 16.f);
    }
    if (!BWD) {
#pragma unroll
        for (int i = 1; i < 8; ++i) c[i] += c[i - 1];
        tot[tg * 64 + d] = c[7];
    } else {
#pragma unroll
        for (int i = 6; i >= 0; --i) c[i] += c[i + 1];
        tot[tg * 64 + d] = c[0];
    }
    __syncthreads();
    float off = 0.f, all = 0.f;
#pragma unroll
    for (int t2 = 0; t2 < 8; ++t2) { const float v = tot[t2 * 64 + d]; all += v; if (BWD ? (t2 > tg) : (t2 < tg)) off += v; }
#pragma unroll
    for (int i = 0; i < 8; ++i) bv[i] = c[i] + off;
    bl = all;
}
__device__ __forceinline__ void gla_stage_vt(const bf16_t* vbase, LAS bf16_t* VT, int tid) {
    const int s = tid & 63, e0 = (tid >> 6) * 16;
    const uint4* vp = (const uint4*)(vbase + (size_t)s * PW + e0);
    const uint4 v0 = vp[0], v1 = vp[1];
    const unsigned w[8] = {v0.x, v0.y, v0.z, v0.w, v1.x, v1.y, v1.z, v1.w};
#pragma unroll
    for (int i = 0; i < 8; ++i) { VT[(e0 + 2 * i) * LDT + s] = (bf16_t)(w[i] & 0xffffu); VT[(e0 + 2 * i + 1) * LDT + s] = (bf16_t)(w[i] >> 16); }
}
__device__ __forceinline__ void gla_g1_unit(LAS unsigned char* lds, int tid, int unit, const bf16_t* PROJ, const float* upf, const float* bf_, const float* upb, const float* bb_, bf16_t* KVS, float* DEC) {
    const int n = unit & 63, h = (unit >> 6) & 3, b = unit >> 8;
    const int d = tid & 63, tg = tid >> 6, lane = tid & 63, w = tid >> 6;
    const size_t tok0 = (size_t)b * T + n * 64;
    LAS bf16_t* KET = (LAS bf16_t*)(lds + GL_QE); LAS bf16_t* VT = (LAS bf16_t*)(lds + GL_VT); LAS float* tot = (LAS float*)(lds + GL_TOT);
    gla_stage_vt(PROJ + tok0 * PW + C_GV + h * 128, VT, tid);
#pragma unroll
    for (int dir = 0; dir < 2; ++dir) {
        float bv[8], bl;
        if (dir == 0) gla_cumsum<false>(PROJ + tok0 * PW + C_ZF, upf, bf_, h * 64 + d, tg, d, tot, bv, bl);
        else          gla_cumsum<true>(PROJ + tok0 * PW + C_ZB, upb, bb_, h * 64 + d, tg, d, tot + 512, bv, bl);
        unsigned pk[4];
#pragma unroll
        for (int i = 0; i < 8; i += 2) {
            const float k0 = bf2f(PROJ[(tok0 + 8 * tg + i) * PW + C_GK + h * 64 + d]) * exp_fast(bl - bv[i]);
            const float k1 = bf2f(PROJ[(tok0 + 8 * tg + i + 1) * PW + C_GK + h * 64 + d]) * exp_fast(bl - bv[i + 1]);
            pk[i >> 1] = (unsigned)f2bf(k0) | ((unsigned)f2bf(k1) << 16);
        }
        *(LAS v4u*)(KET + d * LDT + 8 * tg) = (v4u){pk[0], pk[1], pk[2], pk[3]};
        const size_t sq = (((size_t)b * 4 + h) * 2 + dir) * 64 + n;
        if (tg == 0) DEC[sq * 64 + d] = exp_fast(bl);
        __syncthreads();
        bf16_t* kvo = KVS + sq * 8192;
#pragma unroll
        for (int dt = 0; dt < 4; ++dt) {
            gf32x4 acc = {0.f, 0.f, 0.f, 0.f};
            acc = mfma_tile64(VT + (16 * w) * LDT, KET + (16 * dt) * LDT, acc, lane);
#pragma unroll
            for (int r = 0; r < 4; ++r) kvo[(size_t)(16 * w + 4 * (lane >> 4) + r) * 64 + 16 * dt + (lane & 15)] = f2bf(acc[r]);
        }
        __syncthreads();
    }
}
template <bool BWD>
__device__ __forceinline__ void gla_g2_item(unsigned* base, const float* dc) {
    float s0 = 0.f, s1 = 0.f;
#pragma unroll 1
    for (int hf = 0; hf < 2; ++hf) {
        unsigned kv[32]; float2 dd[32];
#pragma unroll
        for (int st = 0; st < 32; ++st) { const int n = BWD ? (63 - 32 * hf - st) : (32 * hf + st); kv[st] = base[(size_t)n * 4096]; dd[st] = *(const float2*)(dc + n * 64); }
#pragma unroll
        for (int st = 0; st < 32; ++st) { const int n = BWD ? (63 - 32 * hf - st) : (32 * hf + st);
            base[(size_t)n * 4096] = (unsigned)f2bf(s0) | ((unsigned)f2bf(s1) << 16);
            s0 = dd[st].x * s0 + __uint_as_float(kv[st] << 16); s1 = dd[st].y * s1 + __uint_as_float(kv[st] & 0xffff0000u); }
    }
}
__device__ __forceinline__ void gla_g2_scan(int gtid, int nthr, bf16_t* KVS, const float* DEC) {
    for (int item = gtid; item < 64 * 4096; item += nthr) {
        const int seq = item >> 12, ed = item & 4095, d2 = (ed & 31) * 2;
        unsigned* base = (unsigned*)(KVS + (size_t)seq * 64 * 8192) + ed;
        const float* dc = DEC + (size_t)seq * 64 * 64 + d2;
        if (seq & 1) gla_g2_item<true>(base, dc); else gla_g2_item<false>(base, dc);
    }
}
__device__ __forceinline__ void gla_g3_unit(LAS unsigned char* lds, int tid, int unit, const bf16_t* PROJ, const float* upf, const float* bf_, const float* upb, const float* bb_, const bf16_t* KVS, const float* gain, bf16_t* MIXED) {
    const int n = unit & 63, h = (unit >> 6) & 3, b = unit >> 8;
    const int d = tid & 63, tg = tid >> 6, lane = tid & 63, w = tid >> 6;
    const size_t tok0 = (size_t)b * T + n * 64;
    LAS bf16_t* QE = (LAS bf16_t*)(lds + GL_QE); LAS bf16_t* KE = (LAS bf16_t*)(lds + GL_KE); LAS bf16_t* PP = (LAS bf16_t*)(lds + GL_P);
    LAS bf16_t* VT = (LAS bf16_t*)(lds + GL_VT); LAS bf16_t* ST = (LAS bf16_t*)(lds + GL_ST);
    LAS float* tot = (LAS float*)(lds + GL_TOT); LAS float* part = (LAS float*)(lds + GL_PART); LAS float* rs = (LAS float*)(lds + GL_RSTD);
    gla_stage_vt(PROJ + tok0 * PW + C_GV + h * 128, VT, tid);
    gf32x4 o[4];
#pragma unroll
    for (int rt = 0; rt < 4; ++rt) o[rt] = (gf32x4){0.f, 0.f, 0.f, 0.f};
#pragma unroll
    for (int dir = 0; dir < 2; ++dir) {
        float bv[8], bl;
        if (dir == 0) gla_cumsum<false>(PROJ + tok0 * PW + C_ZF, upf, bf_, h * 64 + d, tg, d, tot, bv, bl);
        else          gla_cumsum<true>(PROJ + tok0 * PW + C_ZB, upb, bb_, h * 64 + d, tg, d, tot + 512, bv, bl);
#pragma unroll
        for (int i = 0; i < 8; ++i) {
            const size_t ro = (tok0 + 8 * tg + i) * PW + h * 64 + d;
            const float e = exp_fast(bv[i]);
            QE[(8 * tg + i) * LDT + d] = f2bf(bf2f(PROJ[ro + C_GQ]) * e * 0.125f);
            KE[(8 * tg + i) * LDT + d] = f2bf(bf2f(PROJ[ro + C_GK]) * __builtin_amdgcn_rcpf(e));
        }
        {
            const size_t sq = (((size_t)b * 4 + h) * 2 + dir) * 64 + n;
            const int e = tid >> 2, part4 = tid & 3;
            const uint4* sp = (const uint4*)(KVS + sq * 8192 + e * 64 + part4 * 16);
            const uint4 s0 = sp[0], s1 = sp[1];
            *(LAS v4u*)(ST + e * LDT + part4 * 16) = (v4u){s0.x, s0.y, s0.z, s0.w}; *(LAS v4u*)(ST + e * LDT + part4 * 16 + 8) = (v4u){s1.x, s1.y, s1.z, s1.w};
        }
        __syncthreads();
        { const int ct = w >> 1;
#pragma unroll
          for (int j = 0; j < 2; ++j) { const int st = 2 * (w & 1) + j;
            gf32x4 acc = {0.f, 0.f, 0.f, 0.f};
            acc = mfma_tile64(QE + (16 * ct) * LDT, KE + (16 * st) * LDT, acc, lane);
            const int s = 16 * st + (lane & 15);
#pragma unroll
            for (int r = 0; r < 4; ++r) { const int c = 16 * ct + 4 * (lane >> 4) + r; const bool keep = dir ? (s >= c) : (s <= c);
                PP[c * LDT + s] = f2bf(keep ? acc[r] : 0.f); } } }
        __syncthreads();
#pragma unroll
        for (int rt = 0; rt < 4; ++rt) {
            o[rt] = mfma_tile64(PP + (16 * rt) * LDT, VT + (16 * w) * LDT, o[rt], lane);
            o[rt] = mfma_tile64(QE + (16 * rt) * LDT, ST + (16 * w) * LDT, o[rt], lane);
        }
        __syncthreads();
    }
#pragma unroll
    for (int rt = 0; rt < 4; ++rt)
#pragma unroll
        for (int r = 0; r < 4; ++r) {
            float ss = o[rt][r] * o[rt][r];
            ss += __shfl_xor(ss, 1); ss += __shfl_xor(ss, 2); ss += __shfl_xor(ss, 4); ss += __shfl_xor(ss, 8);
            if ((lane & 15) == 0) part[w * 64 + 16 * rt + 4 * (lane >> 4) + r] = ss;
        }
    __syncthreads();
    if (tid < 64) { float ss = 0.f;
#pragma unroll
        for (int t2 = 0; t2 < 8; ++t2) ss += part[t2 * 64 + tid];
        rs[tid] = rsqrtf(ss * (1.f / 128.f) + EPS); }
    __syncthreads();
    { const int e = 16 * w + (lane & 15); const float ge = gain[e];
#pragma unroll
      for (int rt = 0; rt < 4; ++rt)
#pragma unroll
        for (int r = 0; r < 4; ++r) { const int c = 16 * rt + 4 * (lane >> 4) + r;
            const float g = bf2f(PROJ[(tok0 + c) * PW + C_GG + h * 128 + e]);
            MIXED[(tok0 + c) * D + h * 128 + e] = f2bf(o[rt][r] * rs[c] * ge * g * __builtin_amdgcn_rcpf(1.f + exp_fast(-g))); } }
    __syncthreads();
}

constexpr size_t WS_BFRAG = 12 * MiB;
__device__ __forceinline__ void router_build_bfrag(int gtid, int nthr, const float* wg, const float* we, const float* g2, bf16_t* BF) {
    for (int i = gtid; i < 32 * 5 * 64; i += nthr) {
        const int ks = i / 320, rem = i - ks * 320, ct = rem >> 6, lane = rem & 63, col = 16 * ct + (lane & 15);
        unsigned hi[4], lo[4];
#pragma unroll
        for (int j = 0; j < 8; ++j) {
            const int k = 32 * ks + 8 * (lane >> 4) + j;
            float w = col < 8 ? wg[k * 8 + col] : (col < 72 ? we[k * 64 + col - 8] : 0.f);
            w *= g2[k];
            const bf16_t h = f2bf(w); const bf16_t l = f2bf(w - bf2f(h));
            if (j & 1) { hi[j >> 1] |= (unsigned)h << 16; lo[j >> 1] |= (unsigned)l << 16; } else { hi[j >> 1] = h; lo[j >> 1] = l; }
        }
        uint4* o = (uint4*)(BF + ((size_t)(ks * 5 + ct) * 2) * 512 + lane * 8);
        o[0] = make_uint4(hi[0], hi[1], hi[2], hi[3]); o[64] = make_uint4(lo[0], lo[1], lo[2], lo[3]);
    }
}
__device__ __forceinline__ void ph_router_mfma(int gw, int NGW, int lane, LAS float* lsm  , const bf16_t* H, const bf16_t* BF, const float* bg, const float* be, float* RSTD, unsigned* tokinfo, LAS int* hist, bool dry) {
    for (int task = gw; task < NTOK / 16; task += NGW) {
        const int t0 = task * 16, row = lane & 15, kg = lane >> 4;
        const bf16_t* hp = H + (size_t)(t0 + row) * D + kg * 8;
        gf32x4 acc[5];
#pragma unroll
        for (int ct = 0; ct < 5; ++ct) acc[ct] = (gf32x4){0.f, 0.f, 0.f, 0.f};
        float ss = 0.f;
#pragma unroll 2
        for (int ks = 0; ks < 32; ++ks) {
            const gbf16x8 ah = *(const gbf16x8*)(hp + ks * 32);
#pragma unroll
            for (int j = 0; j < 8; ++j) { const float xv = bf2f((bf16_t)ah[j]); ss += xv * xv; }
            const gbf16x8* bp = (const gbf16x8*)(BF + (size_t)ks * 5 * 2 * 512) + lane;
#pragma unroll
            for (int ct = 0; ct < 5; ++ct) {
                const gbf16x8 bh = bp[(ct * 2) * 64], bl = bp[(ct * 2 + 1) * 64];
                acc[ct] = __builtin_amdgcn_mfma_f32_16x16x32_bf16(ah, bh, acc[ct], 0, 0, 0);
                acc[ct] = __builtin_amdgcn_mfma_f32_16x16x32_bf16(ah, bl, acc[ct], 0, 0, 0);
            }
        }
        ss += __shfl_xor(ss, 16); ss += __shfl_xor(ss, 32);
        const float rstd = rsqrtf(ss * (1.f / D) + EPS);
#pragma unroll
        for (int ct = 0; ct < 5; ++ct) { const int col = 16 * ct + row; const float bias = col < 8 ? bg[col] : (col < 72 ? be[col - 8] : 0.f);
#pragma unroll
            for (int r = 0; r < 4; ++r) { const int rr = 4 * kg + r; const float rs = __shfl(rstd, rr); lsm[rr * 80 + col] = acc[ct][r] * rs + bias; } }
        asm volatile("s_waitcnt lgkmcnt(0)" ::: "memory");
        if (lane < 16) {
            const LAS float* L = lsm + lane * 80;
            float best = L[0]; int g = 0;
#pragma unroll
            for (int i = 1; i < 8; ++i) { const float v = L[i]; if (v > best) { best = v; g = i; } }
            float den = 0.f;
#pragma unroll
            for (int i = 0; i < 8; ++i) den += expf(L[i] - best);
            const float gw_ = 1.f / den;
            const LAS float* E = L + 8 + g * 8;
            float v1 = E[0]; int i1 = 0;
#pragma unroll
            for (int j = 1; j < 8; ++j) { const float v = E[j]; if (v > v1) { v1 = v; i1 = j; } }
            float v2 = -INFINITY; int i2 = 0;
#pragma unroll
            for (int j = 0; j < 8; ++j) { const float v = E[j]; if (j != i1 && v > v2) { v2 = v; i2 = j; } }
            const float ex = expf(v2 - v1), p1 = 1.f / (1.f + ex), p2 = ex * p1;
            const int e1 = g * 8 + i1, e2 = g * 8 + i2, t = t0 + lane;
            uint4 o; o.x = (unsigned)e1; o.y = (unsigned)e2; o.z = __float_as_uint(gw_ * p1); o.w = __float_as_uint(gw_ * p2);
            ((uint4*)tokinfo)[t] = o;
            RSTD[t] = rstd;
            if (!dry) { __hip_atomic_fetch_add(hist + e1, 1, __ATOMIC_RELAXED, __HIP_MEMORY_SCOPE_WORKGROUP); __hip_atomic_fetch_add(hist + e2, 1, __ATOMIC_RELAXED, __HIP_MEMORY_SCOPE_WORKGROUP); }
        }
        asm volatile("s_waitcnt lgkmcnt(0)" ::: "memory");
    }
}

__device__ __forceinline__ void ph_router_lds(int vcu, int G, int wave, int lane, LAS unsigned char* lds, const bf16_t* H, const bf16_t* BF, const float* bg, const float* be, float* RSTD, unsigned* tokinfo, LAS int* hist, bool dry) {
    for (int tg = vcu; tg < NTOK / 128; tg += G) {
        const int t0 = (tg * 8 + wave) * 16, row = lane & 15, kg = lane >> 4;
        const bf16_t* hp = H + (size_t)(t0 + row) * D + kg * 8;
        gf32x4 acc[5];
#pragma unroll
        for (int ct = 0; ct < 5; ++ct) acc[ct] = (gf32x4){0.f, 0.f, 0.f, 0.f};
        float ss = 0.f;
        gbf16x8 ha[2][4];
#define RT_DMA(j) do { _Pragma("unroll") for (int i = 0; i < 5; ++i) __builtin_amdgcn_global_load_lds((const unsigned*)(BF + (size_t)(j) * 20480 + (wave + 8 * i) * 512 + lane * 8), \
            (LAS unsigned*)(lds + ((j) & 1) * 65536 + (wave + 8 * i) * 1024), 16, 0, 0); } while (0)
#define RT_LDH(j) do { _Pragma("unroll") for (int k = 0; k < 4; ++k) ha[(j) & 1][k] = *(const GAS gbf16x8*)(hp + ((j) * 4 + k) * 32); } while (0)
        RT_DMA(0); RT_LDH(0);
#pragma unroll
        for (int j = 0; j < 8; ++j) {
            if (j + 1 < 8) { RT_DMA(j + 1); RT_LDH(j + 1); asm volatile("s_waitcnt vmcnt(9)" ::: "memory"); } else asm volatile("s_waitcnt vmcnt(0)" ::: "memory");
            __syncthreads();
            const LAS unsigned char* buf = lds + (j & 1) * 65536;
#pragma unroll
            for (int k = 0; k < 4; ++k) {
                const gbf16x8 ah = ha[j & 1][k];
#pragma unroll
                for (int e = 0; e < 8; ++e) { const float xv = bf2f((bf16_t)ah[e]); ss += xv * xv; }
#pragma unroll
                for (int ct = 0; ct < 5; ++ct) {
                    const gbf16x8 bh = *(const LAS gbf16x8*)(buf + ((k * 10 + ct * 2) * 64 + lane) * 16), bl = *(const LAS gbf16x8*)(buf + ((k * 10 + ct * 2 + 1) * 64 + lane) * 16);
                    acc[ct] = __builtin_amdgcn_mfma_f32_16x16x32_bf16(ah, bh, acc[ct], 0, 0, 0);
                    acc[ct] = __builtin_amdgcn_mfma_f32_16x16x32_bf16(ah, bl, acc[ct], 0, 0, 0);
                }
            }
            __syncthreads();
        }
#undef RT_DMA
#undef RT_LDH
        LAS float* lsm = (LAS float*)(lds + wave * 5120);
        ss += __shfl_xor(ss, 16); ss += __shfl_xor(ss, 32);
        const float rstd = rsqrtf(ss * (1.f / D) + EPS);
#pragma unroll
        for (int ct = 0; ct < 5; ++ct) { const int col = 16 * ct + row; const float bias = col < 8 ? bg[col] : (col < 72 ? be[col - 8] : 0.f);
#pragma unroll
            for (int r = 0; r < 4; ++r) { const int rr = 4 * kg + r; const float rs = __shfl(rstd, rr); lsm[rr * 80 + col] = acc[ct][r] * rs + bias; } }
        asm volatile("s_waitcnt lgkmcnt(0)" ::: "memory");
        if (lane < 16) {
            const LAS float* L = lsm + lane * 80;
            float best = L[0]; int g = 0;
#pragma unroll
            for (int i = 1; i < 8; ++i) { const float v = L[i]; if (v > best) { best = v; g = i; } }
            float den = 0.f;
#pragma unroll
            for (int i = 0; i < 8; ++i) den += expf(L[i] - best);
            const float gw_ = 1.f / den;
            const LAS float* E = L + 8 + g * 8;
            float v1 = E[0]; int i1 = 0;
#pragma unroll
            for (int j = 1; j < 8; ++j) { const float v = E[j]; if (v > v1) { v1 = v; i1 = j; } }
            float v2 = -INFINITY; int i2 = 0;
#pragma unroll
            for (int j = 0; j < 8; ++j) { const float v = E[j]; if (j != i1 && v > v2) { v2 = v; i2 = j; } }
            const float ex = expf(v2 - v1), p1 = 1.f / (1.f + ex), p2 = ex * p1;
            const int e1 = g * 8 + i1, e2 = g * 8 + i2, t = t0 + lane;
            uint4 o; o.x = (unsigned)e1; o.y = (unsigned)e2; o.z = __float_as_uint(gw_ * p1); o.w = __float_as_uint(gw_ * p2);
            ((uint4*)tokinfo)[t] = o;
            RSTD[t] = rstd;
            if (!dry) { __hip_atomic_fetch_add(hist + e1, 1, __ATOMIC_RELAXED, __HIP_MEMORY_SCOPE_WORKGROUP); __hip_atomic_fetch_add(hist + e2, 1, __ATOMIC_RELAXED, __HIP_MEMORY_SCOPE_WORKGROUP); }
        }
        asm volatile("s_waitcnt lgkmcnt(0)" ::: "memory");
        __syncthreads();
    }
}

constexpr int G_Z = 0, G_VT = 8192, G_G = 26624, G_ST0 = 43008, G_ST1 = 61440, G_BM = 79872, G_QE = 97280, G_KE = 106496, G_P = 115712, G_TOT = 124928, G_PART = 129024;
constexpr int BMS = 68;
typedef unsigned v2u __attribute__((ext_vector_type(2)));
struct GlaRaw3 { v4u q, k, z, v0, v1, g0, g1, sa0, sa1, sb0, sb1, oa0, oa1; float sq; };
struct GlaRaw1 { v4u k, z, v0, v1; };
__device__ __forceinline__ v4u ld16(const bf16_t* p) { return *(const GAS v4u*)p; }
__device__ __forceinline__ void gla_load3(GlaRaw3& R, int tid, int b, int h, int n, const bf16_t* PROJ, const bf16_t* KVS, const bf16_t* MIXED, const float* SSQ) {
    const size_t tok0 = (size_t)b * T + n * 64;
    const int s8 = tid >> 3, c8 = tid & 7, lane = tid & 63, w = tid >> 6;
    R.q = ld16(PROJ + (tok0 + s8) * PW + C_GQ + h * 64 + c8 * 8);
    R.k = ld16(PROJ + (tok0 + s8) * PW + C_GK + h * 64 + c8 * 8);
    if (tid < 256) R.z = ld16(PROJ + (tok0 + (tid >> 2)) * PW + C_ZF + (tid & 3) * 8);
    R.v0 = ld16(PROJ + (tok0 + (tid >> 4)) * PW + C_GV + h * 128 + (tid & 15) * 8); R.v1 = ld16(PROJ + (tok0 + (tid >> 4) + 32) * PW + C_GV + h * 128 + (tid & 15) * 8);
    const int s16 = tid >> 4, c16 = tid & 15;
    R.g0 = ld16(PROJ + (tok0 + s16) * PW + C_GG + h * 128 + c16 * 8); R.g1 = ld16(PROJ + (tok0 + s16 + 32) * PW + C_GG + h * 128 + c16 * 8);
    const size_t sq = (((size_t)b * 4 + h) * 2) * 64 + n;
    const bf16_t* sp = KVS + sq * 8192 + (tid >> 3) * 64 + (tid & 7) * 8;
    R.sa0 = ld16(sp); R.sa1 = ld16(sp + 64 * 64); R.sb0 = ld16(sp + (size_t)64 * 8192); R.sb1 = ld16(sp + (size_t)64 * 8192 + 64 * 64);
    R.sq = SSQ[(size_t)(tid >> 6) * NTOK + tok0 + (tid & 63)];
}
__device__ __forceinline__ void gla_store_z(LAS unsigned char* lds, int tid, v4u z) {
    if (tid < 256) { LAS f32x4* zp = (LAS f32x4*)(lds + G_Z) + (tid >> 2) * 8 + (tid & 3) * 2;
        zp[0] = (f32x4){__uint_as_float(z.x << 16), __uint_as_float(z.x & 0xffff0000u), __uint_as_float(z.y << 16), __uint_as_float(z.y & 0xffff0000u)};
        zp[1] = (f32x4){__uint_as_float(z.z << 16), __uint_as_float(z.z & 0xffff0000u), __uint_as_float(z.w << 16), __uint_as_float(z.w & 0xffff0000u)}; }
}
__device__ __forceinline__ void gla_store_vt(LAS unsigned char* lds, int tid, v4u v0, v4u v1) {
    LAS bf16_t* VT = (LAS bf16_t*)(lds + G_VT); const int c16 = tid & 15, sA = (tid >> 4) ^ (8 * (c16 & 7)), sB = sA ^ 32;
    const unsigned wa[4] = {v0.x, v0.y, v0.z, v0.w}, wb[4] = {v1.x, v1.y, v1.z, v1.w};
#pragma unroll
    for (int i = 0; i < 4; ++i) { LAS bf16_t* r0 = VT + (c16 * 8 + 2 * i) * LDT; LAS bf16_t* r1 = r0 + LDT;
        r0[sA] = (bf16_t)(wa[i] & 0xffffu); r1[sA] = (bf16_t)(wa[i] >> 16); r0[sB] = (bf16_t)(wb[i] & 0xffffu); r1[sB] = (bf16_t)(wb[i] >> 16); }
}
template <bool VA>
__device__ __forceinline__ gf32x4 mfma_tile64_v(const LAS bf16_t* X, const LAS bf16_t* VTw, int w, gf32x4 acc, int lane) {
    const int r = lane & 15, grp = lane >> 4, g = (2 * w + (r >> 3)) & 7;
    const gbf16x8 x0 = *(const LAS gbf16x8*)(X + r * LDT + grp * 8), x1 = *(const LAS gbf16x8*)(X + r * LDT + grp * 8 + 32);
    const gbf16x8 v0 = *(const LAS gbf16x8*)(VTw + r * LDT + ((grp ^ g) * 8)), v1 = *(const LAS gbf16x8*)(VTw + r * LDT + (((grp + 4) ^ g) * 8));
    if (VA) { acc = __builtin_amdgcn_mfma_f32_16x16x32_bf16(v0, x0, acc, 0, 0, 0); acc = __builtin_amdgcn_mfma_f32_16x16x32_bf16(v1, x1, acc, 0, 0, 0); }
    else    { acc = __builtin_amdgcn_mfma_f32_16x16x32_bf16(x0, v0, acc, 0, 0, 0); acc = __builtin_amdgcn_mfma_f32_16x16x32_bf16(x1, v1, acc, 0, 0, 0); }
    return acc;
}
constexpr int ZBS = 40, GL_UPT = 132096;
template <int DIR>
__device__ __forceinline__ void gla_cumsum3(LAS unsigned char* lds, float bias, int w, int lane, float (&bv)[2][4], float& bl) {
    const LAS bf16_t* ZB = (const LAS bf16_t*)(lds + G_Z); const LAS bf16_t* UPT = (const LAS bf16_t*)(lds + GL_UPT) + DIR * 64 * ZBS; LAS float* tot = (LAS float*)(lds + G_TOT);
    const int r16 = lane & 15, kg = lane >> 4, dcol = 16 * (w & 3) + r16, run0 = 8 * (w >> 2) + kg;
    const gbf16x8 bfr = *(const LAS gbf16x8*)(UPT + (16 * (w & 3) + r16) * ZBS + 8 * kg);
    float c[2][4];
#pragma unroll
    for (int j = 0; j < 2; ++j) {
        const gbf16x8 afr = *(const LAS gbf16x8*)(ZB + (32 * (w >> 2) + 16 * j + r16) * ZBS + 8 * kg);
        const gf32x4 acc = __builtin_amdgcn_mfma_f32_16x16x32_bf16(afr, bfr, (gf32x4){0.f, 0.f, 0.f, 0.f}, 0, 0, 0);
#pragma unroll
        for (int r = 0; r < 4; ++r) c[j][r] = log_sigmoid_f(acc[r] + bias) * (1.f / 16.f);
        if (DIR == 0) { c[j][1] += c[j][0]; c[j][2] += c[j][1]; c[j][3] += c[j][2]; tot[(run0 + 4 * j) * 64 + dcol] = c[j][3]; }
        else          { c[j][2] += c[j][3]; c[j][1] += c[j][2]; c[j][0] += c[j][1]; tot[(run0 + 4 * j) * 64 + dcol] = c[j][0]; }
    }
    __syncthreads();
    float off0 = 0.f, off1 = 0.f, all = 0.f;
#pragma unroll
    for (int q = 0; q < 16; ++q) { const float v = tot[q * 64 + dcol]; all += v;
        if (DIR ? (q > run0) : (q < run0)) off0 += v;
        if (DIR ? (q > run0 + 4) : (q < run0 + 4)) off1 += v; }
#pragma unroll
    for (int r = 0; r < 4; ++r) { bv[0][r] = c[0][r] + off0; bv[1][r] = c[1][r] + off1; }
    bl = all;
}
__device__ __forceinline__ void gla_store_zb(LAS unsigned char* lds, int tid, v4u z) { if (tid < 256) *(LAS v4u*)((LAS bf16_t*)(lds + G_Z) + (tid >> 2) * ZBS + (tid & 3) * 8) = z; }
__device__ __forceinline__ void gla_build_upt(LAS unsigned char* lds, int tid, int h, const float* upf, const float* upb) {
    LAS bf16_t* U0 = (LAS bf16_t*)(lds + GL_UPT); LAS bf16_t* U1 = U0 + 64 * ZBS;
    const int d = tid & 63, k0 = (tid >> 6) * 4;
    unsigned a0 = 0u, a1 = 0u, b0 = 0u, b1 = 0u;
    if (k0 < 16) { const float* p = upf + k0 * 256 + h * 64 + d; a0 = (unsigned)f2bf(p[0]) | ((unsigned)f2bf(p[256]) << 16); a1 = (unsigned)f2bf(p[512]) | ((unsigned)f2bf(p[768]) << 16); }
    else { const float* p = upb + (k0 - 16) * 256 + h * 64 + d; b0 = (unsigned)f2bf(p[0]) | ((unsigned)f2bf(p[256]) << 16); b1 = (unsigned)f2bf(p[512]) | ((unsigned)f2bf(p[768]) << 16); }
    *(LAS v2u*)(U0 + d * ZBS + k0) = (v2u){a0, a1}; *(LAS v2u*)(U1 + d * ZBS + k0) = (v2u){b0, b1};
}
__device__ __forceinline__ unsigned pk_bf2(float a, float b) { return (unsigned)f2bf(a) | ((unsigned)f2bf(b) << 16); }

__device__ __forceinline__ void gla_g3_phase(LAS unsigned char* lds, int tid, int bx, const bf16_t* PROJ, const float* upf, const float* bf_, const float* upb, const float* bb_, const bf16_t* KVS, const float* gain, bf16_t* MIXED, const float* SSQ, float* ratt) {
    const int n = bx & 63, h = (bx >> 6) & 3;
    const int d = tid & 63, tg = tid >> 6, lane = tid & 63, w = tid >> 6, s8 = tid >> 3, c8 = tid & 7;
    const int dcol = 16 * (w & 3) + (lane & 15), tk0 = 32 * (w >> 2) + 4 * (lane >> 4);
    const float bsF = bf_[h * 64 + dcol], bsB = bb_[h * 64 + dcol];
    gla_build_upt(lds, tid, h, upf, upb);
    float ge4[4];
#pragma unroll
    for (int r = 0; r < 4; ++r) ge4[r] = gain[16 * w + 4 * (lane >> 4) + r];
    LAS bf16_t* QE = (LAS bf16_t*)(lds + G_QE); LAS bf16_t* KE = (LAS bf16_t*)(lds + G_KE); LAS bf16_t* PP = (LAS bf16_t*)(lds + G_P);
    LAS bf16_t* VT = (LAS bf16_t*)(lds + G_VT); LAS bf16_t* GG = (LAS bf16_t*)(lds + G_G); LAS float* BM = (LAS float*)(lds + G_BM);
    LAS float* part = (LAS float*)(lds + G_PART); LAS float* rs = (LAS float*)(lds + G_TOT);
    GlaRaw3 R; gla_load3(R, tid, 0, h, n, PROJ, KVS, MIXED, SSQ);
    for (int b = 0; b < NB; ++b) {
        const size_t tok0 = (size_t)b * T + n * 64;
        const v4u cq = R.q, ck = R.k;
        gla_store_zb(lds, tid, R.z); gla_store_vt(lds, tid, R.v0, R.v1);
        { const int s16 = tid >> 4, c16 = tid & 15; *(LAS v4u*)(GG + s16 * 128 + c16 * 8) = R.g0; *(LAS v4u*)(GG + (s16 + 32) * 128 + c16 * 8) = R.g1; }
        { const int e = tid >> 3, c8_ = tid & 7; LAS bf16_t* s0 = (LAS bf16_t*)(lds + G_ST0) + e * LDT + c8_ * 8; LAS bf16_t* s1 = (LAS bf16_t*)(lds + G_ST1) + e * LDT + c8_ * 8;
          *(LAS v4u*)s0 = R.sa0; *(LAS v4u*)(s0 + 64 * LDT) = R.sa1; *(LAS v4u*)s1 = R.sb0; *(LAS v4u*)(s1 + 64 * LDT) = R.sb1; }
        part[tid] = R.sq;
        if (b + 1 < NB) gla_load3(R, tid, b + 1, h, n, PROJ, KVS, MIXED, SSQ);
        __syncthreads();
        if (tid < 64) { float q = 0.f;
#pragma unroll
            for (int hh = 0; hh < 8; ++hh) q += part[hh * 64 + tid];
            const float ms = q * (1.f / 512.f) + EPS; ((LAS float*)(lds + 143360))[tid] = sqrtf(ms); if (h == 0) ratt[tok0 + tid] = rsqrtf(ms); }
        gf32x4 o[4];
#pragma unroll
        for (int rt = 0; rt < 4; ++rt) o[rt] = (gf32x4){0.f, 0.f, 0.f, 0.f};
#pragma unroll
        for (int dir = 0; dir < 2; ++dir) {
            float bv[2][4], bl;
            if (dir == 0) gla_cumsum3<0>(lds, bsF, w, lane, bv, bl); else gla_cumsum3<1>(lds, bsB, w, lane, bv, bl);
#pragma unroll
            for (int j = 0; j < 2; ++j)
#pragma unroll
                for (int r = 0; r < 4; ++r) BM[(tk0 + 16 * j + r) * BMS + dcol] = bv[j][r];
            __syncthreads();
            {
                const f32x4 b0 = *(const LAS f32x4*)(BM + s8 * BMS + c8 * 8), b1 = *(const LAS f32x4*)(BM + s8 * BMS + c8 * 8 + 4);
                const float bb[8] = {b0.x, b0.y, b0.z, b0.w, b1.x, b1.y, b1.z, b1.w};
                const unsigned qw[4] = {cq.x, cq.y, cq.z, cq.w}, kw[4] = {ck.x, ck.y, ck.z, ck.w};
                unsigned qo[4], ko[4];
#pragma unroll
                for (int j = 0; j < 4; ++j) {
                    const float e0 = exp_fast(bb[2 * j]), e1 = exp_fast(bb[2 * j + 1]);
                    qo[j] = pk_bf2(__uint_as_float(qw[j] << 16) * e0 * 0.125f, __uint_as_float(qw[j] & 0xffff0000u) * e1 * 0.125f);
                    ko[j] = pk_bf2(__uint_as_float(kw[j] << 16) * __builtin_amdgcn_rcpf(e0), __uint_as_float(kw[j] & 0xffff0000u) * __builtin_amdgcn_rcpf(e1));
                }
                *(LAS v4u*)(QE + s8 * LDT + c8 * 8) = (v4u){qo[0], qo[1], qo[2], qo[3]}; *(LAS v4u*)(KE + s8 * LDT + c8 * 8) = (v4u){ko[0], ko[1], ko[2], ko[3]};
            }
            __syncthreads();
            { const int ct = w >> 1;
#pragma unroll
              for (int j = 0; j < 2; ++j) { const int st = 2 * (w & 1) + j;
                gf32x4 acc = {0.f, 0.f, 0.f, 0.f};
                acc = mfma_tile64(KE + (16 * st) * LDT, QE + (16 * ct) * LDT, acc, lane);
                const int c = 16 * ct + (lane & 15), s0 = 16 * st + 4 * (lane >> 4);
                float pv[4];
#pragma unroll
                for (int r = 0; r < 4; ++r) { const int s = s0 + r; const bool keep = dir ? (s >= c) : (s <= c); pv[r] = keep ? acc[r] : 0.f; }
                *(LAS v2u*)(PP + c * LDT + s0) = (v2u){pk_bf2(pv[0], pv[1]), pk_bf2(pv[2], pv[3])}; } }
            __syncthreads();
            const LAS bf16_t* ST = (const LAS bf16_t*)(lds + (dir ? G_ST1 : G_ST0));
#pragma unroll
            for (int rt = 0; rt < 4; ++rt) {
                o[rt] = mfma_tile64_v<true>(PP + (16 * rt) * LDT, VT + (16 * w) * LDT, w, o[rt], lane);
                o[rt] = mfma_tile64(ST + (16 * w) * LDT, QE + (16 * rt) * LDT, o[rt], lane);
            }
        }
#pragma unroll
        for (int rt = 0; rt < 4; ++rt) {
            float ss = o[rt][0] * o[rt][0] + o[rt][1] * o[rt][1] + o[rt][2] * o[rt][2] + o[rt][3] * o[rt][3];
            ss += __shfl_xor(ss, 16); ss += __shfl_xor(ss, 32);
            if (lane < 16) part[w * 64 + 16 * rt + lane] = ss;
        }
        __syncthreads();
        if (tid < 64) { float ss = 0.f;
#pragma unroll
            for (int t2 = 0; t2 < 8; ++t2) ss += part[t2 * 64 + tid];
            rs[tid] = rsqrtf(ss * (1.f / 128.f) + EPS) * ((LAS float*)(lds + 143360))[tid]; }
        __syncthreads();
#pragma unroll
        for (int rt = 0; rt < 4; ++rt) { const int c = 16 * rt + (lane & 15), e0 = 16 * w + 4 * (lane >> 4);
            const v2u gw2 = *(const LAS v2u*)(GG + c * 128 + e0);
            const float gv[4] = {__uint_as_float(gw2.x << 16), __uint_as_float(gw2.x & 0xffff0000u), __uint_as_float(gw2.y << 16), __uint_as_float(gw2.y & 0xffff0000u)};
            const float rc = rs[c]; float ov[4];
#pragma unroll
            for (int r = 0; r < 4; ++r) ov[r] = o[rt][r] * rc * ge4[r] * gv[r] * __builtin_amdgcn_rcpf(1.f + exp_fast(-gv[r]));
            *(GAS v2u*)(MIXED + (tok0 + c) * D + 512 + h * 128 + e0) = (v2u){pk_bf2(ov[0], ov[1]), pk_bf2(ov[2], ov[3])}; }
        __syncthreads();
    }
}
__device__ __forceinline__ void gla_load1(GlaRaw1& R, int tid, int b, int h, int n, const bf16_t* PROJ) {
    const size_t tok0 = (size_t)b * T + n * 64;
    const int s8 = tid >> 3, c8 = tid & 7, lane = tid & 63, w = tid >> 6;
    R.k = ld16(PROJ + (tok0 + s8) * PW + C_GK + h * 64 + c8 * 8);
    if (tid < 256) R.z = ld16(PROJ + (tok0 + (tid >> 2)) * PW + C_ZF + (tid & 3) * 8);
    R.v0 = ld16(PROJ + (tok0 + (tid >> 4)) * PW + C_GV + h * 128 + (tid & 15) * 8); R.v1 = ld16(PROJ + (tok0 + (tid >> 4) + 32) * PW + C_GV + h * 128 + (tid & 15) * 8);
}
__device__ __forceinline__ void gla_g1_phase(LAS unsigned char* lds, int tid, int bx, const bf16_t* PROJ, const float* upf, const float* bf_, const float* upb, const float* bb_, bf16_t* KVS, float* DEC) {
    const int n = bx & 63, h = (bx >> 6) & 3;
    const int d = tid & 63, tg = tid >> 6, lane = tid & 63, w = tid >> 6, s8 = tid >> 3, c8 = tid & 7;
    const int dcol = 16 * (w & 3) + (lane & 15), tk0 = 32 * (w >> 2) + 4 * (lane >> 4);
    const float bsF = bf_[h * 64 + dcol], bsB = bb_[h * 64 + dcol];
    gla_build_upt(lds, tid, h, upf, upb);
    LAS bf16_t* KR = (LAS bf16_t*)(lds + G_G); LAS bf16_t* KET = (LAS bf16_t*)(lds + G_QE); LAS bf16_t* VT = (LAS bf16_t*)(lds + G_VT);
    GlaRaw1 R; gla_load1(R, tid, 0, h, n, PROJ);
    for (int b = 0; b < NB; ++b) {
        gla_store_zb(lds, tid, R.z); gla_store_vt(lds, tid, R.v0, R.v1);
        *(LAS v4u*)(KR + s8 * LDT + c8 * 8) = R.k;
        if (b + 1 < NB) gla_load1(R, tid, b + 1, h, n, PROJ);
        __syncthreads();
#pragma unroll
        for (int dir = 0; dir < 2; ++dir) {
            float bv[2][4], bl;
            if (dir == 0) gla_cumsum3<0>(lds, bsF, w, lane, bv, bl); else gla_cumsum3<1>(lds, bsB, w, lane, bv, bl);
#pragma unroll
            for (int j = 0; j < 2; ++j) {
                const int t0 = tk0 + 16 * j;
                const unsigned p0 = pk_bf2(bf2f(KR[(t0 + 0) * LDT + dcol]) * exp_fast(bl - bv[j][0]), bf2f(KR[(t0 + 1) * LDT + dcol]) * exp_fast(bl - bv[j][1]));
                const unsigned p1 = pk_bf2(bf2f(KR[(t0 + 2) * LDT + dcol]) * exp_fast(bl - bv[j][2]), bf2f(KR[(t0 + 3) * LDT + dcol]) * exp_fast(bl - bv[j][3]));
                *(LAS v2u*)(KET + dcol * LDT + t0) = (v2u){p0, p1};
            }
            const size_t sq = (((size_t)b * 4 + h) * 2 + dir) * 64 + n;
            if (w < 4 && lane < 16) DEC[sq * 64 + dcol] = exp_fast(bl);
            __syncthreads();
            bf16_t* kvo = KVS + sq * 8192;
            LAS bf16_t* STG = (LAS bf16_t*)(lds + G_ST0);
#pragma unroll
            for (int dt = 0; dt < 4; ++dt) {
                gf32x4 acc = {0.f, 0.f, 0.f, 0.f};
                acc = mfma_tile64_v<false>(KET + (16 * dt) * LDT, VT + (16 * w) * LDT, w, acc, lane);
                *(LAS v2u*)(STG + (16 * w + (lane & 15)) * LDT + 16 * dt + 4 * (lane >> 4)) = (v2u){pk_bf2(acc[0], acc[1]), pk_bf2(acc[2], acc[3])};
            }
            asm volatile("s_waitcnt lgkmcnt(0)" ::: "memory");
#pragma unroll
            for (int j = 0; j < 2; ++j) { const int row = 16 * w + 8 * j + (lane >> 3);
                const v4u x = *(const LAS v4u*)(STG + row * LDT + (lane & 7) * 8); *(GAS v4u*)(kvo + (size_t)row * 64 + (lane & 7) * 8) = x; }
        }
        __syncthreads();
    }
}
#include <hip/hip_bf16.h>
#include <cmath>
namespace attn_body {
using bf16=__hip_bfloat16;
using bf16x8=__attribute__((ext_vector_type(8)))short;
using s16x4=__attribute__((ext_vector_type(4)))short;
using f32x16=__attribute__((ext_vector_type(16)))float;
using u32x4=__attribute__((ext_vector_type(4)))unsigned;
constexpr int BATCH=8,NHEAD=8,SEQ=4096,D=64,DM=2560,OP=1024;
constexpr int NW=8,QBLK=32,QB=QBLK*NW,KVBLK=64,NQB=SEQ/QB;
constexpr int ATTN_PITCH=DM, ATTN_UNIT_ROWS=QB;
__device__ __forceinline__ int crow(int r,int hi){return (r&3)+8*(r>>2)+4*hi;}
#define SBAR() __builtin_amdgcn_sched_barrier(0)
__device__ __forceinline__ void cmask(f32x16&p0,f32x16&p1,int jb,int qrel,int hi){
  const float NEG=-INFINITY; int kb=64*jb+4*hi;
  #pragma unroll
  for(int r=0;r<16;++r){int kv=kb+(r&3)+8*(r>>2); if(kv>qrel)p0[r]=NEG; if(kv+32>qrel)p1[r]=NEG;}
}

constexpr int NSLOT=3, SLOTB=8192;
constexpr int LDS_K=0, LDS_V=NSLOT*SLOTB, LDS_WS=2*NSLOT*SLOTB, LDS_OST=LDS_WS+NW*64*4, LDS_BYTES=LDS_OST+NW*4096;
constexpr bool FIXREF=true;
constexpr float C2=0.125f*1.4426950408889634f;
__device__ __forceinline__ void glds16(const void*gsrc,unsigned lds_dst){unsigned keep;
  asm volatile("s_mov_b32 %0, m0\n\ts_mov_b32 m0, %2\n\ts_nop 0\n\tglobal_load_lds_dwordx4 %1, off\n\ts_mov_b32 m0, %0":"=&s"(keep):"v"(gsrc),"s"(lds_dst):"memory");}
__device__ __forceinline__ float max3f(float a,float b,float c){float r;asm("v_max3_f32 %0, %1, %2, %3":"=v"(r):"v"(a),"v"(b),"v"(c));return r;}
__device__ __forceinline__ float max2f(float a,float b){float r;asm("v_max_f32_e32 %0, %1, %2":"=v"(r):"v"(a),"v"(b));return r;}
__device__ __forceinline__ float fadd_s(float a,float b){float r;asm("v_add_f32_e32 %0, %1, %2":"=v"(r):"v"(a),"v"(b));return r;}
__device__ __forceinline__ float fsub_s(float a,float b){float r;asm("v_sub_f32_e32 %0, %1, %2":"=v"(r):"v"(a),"v"(b));return r;}
typedef float f32x2_t __attribute__((ext_vector_type(2))); typedef __bf16 bf16x2_t __attribute__((ext_vector_type(2)));
__device__ __forceinline__ unsigned cvtpk_s(float lo,float hi){f32x2_t v={lo,hi};bf16x2_t b=__builtin_convertvector(v,bf16x2_t);return __builtin_bit_cast(unsigned,b);}
#define WAIT_BAR(N) asm volatile("s_waitcnt vmcnt(" #N ") lgkmcnt(0)\n\ts_barrier":::"memory")

__device__ __forceinline__ void qkt(f32x16&p0,f32x16&p1,const char*Kslot,const bf16x8*qr,const f32x16&negm,int r32,int hi){
  const char*kb=Kslot+r32*128; const int xs=(r32>>1)&7;
  #pragma unroll
  for(int d0=0;d0<4;++d0){
    const bf16x8 b0=*reinterpret_cast<const bf16x8*>(kb+(((2*d0+hi)^xs)<<4));
    const bf16x8 b1=*reinterpret_cast<const bf16x8*>(kb+(((2*d0+hi)^xs)<<4)+4096);
    if(d0==0){p0=__builtin_amdgcn_mfma_f32_32x32x16_bf16(b0,qr[0],negm,0,0,0);p1=__builtin_amdgcn_mfma_f32_32x32x16_bf16(b1,qr[0],negm,0,0,0);}
    else{p0=__builtin_amdgcn_mfma_f32_32x32x16_bf16(b0,qr[d0],p0,0,0,0);p1=__builtin_amdgcn_mfma_f32_32x32x16_bf16(b1,qr[d0],p1,0,0,0);}}
}
typedef __attribute__((address_space(3))) const char* lds_cptr;
typedef short v4i16_t __attribute__((ext_vector_type(4)));
struct KBases { int o[4]; };
__device__ __forceinline__ void kload8(bf16x8*kf,lds_cptr kring,const KBases&kb,int sl){
  #pragma unroll
  for(int d0=0;d0<4;++d0){ kf[2*d0]=*(const __attribute__((address_space(3))) bf16x8*)(kring+kb.o[d0]+sl); kf[2*d0+1]=*(const __attribute__((address_space(3))) bf16x8*)(kring+kb.o[d0]+sl+4096); }
}
__device__ __forceinline__ void kload2(bf16x8*kf,lds_cptr kring,const KBases&kb,int sl,int j){ kf[2*j]=*(const __attribute__((address_space(3))) bf16x8*)(kring+kb.o[j]+sl); kf[2*j+1]=*(const __attribute__((address_space(3))) bf16x8*)(kring+kb.o[j]+sl+4096); }
__device__ __forceinline__ s16x4 vtr(lds_cptr p){ return __builtin_bit_cast(s16x4,__builtin_amdgcn_ds_read_tr16_b64_v4i16((__attribute__((address_space(3))) v4i16_t*)p)); }
__device__ __forceinline__ float rowmax(const f32x16&p0,const f32x16&p1){
  float a=max3f(p0[0],p0[1],p1[0]),b=max3f(p0[2],p0[3],p1[1]);a=max3f(a,p1[2],p1[3]);
  #pragma unroll
  for(int r=4;r<16;r+=4){a=max3f(a,p0[r],p0[r+1]);b=max3f(b,p0[r+2],p0[r+3]);a=max3f(a,p1[r],p1[r+1]);b=max3f(b,p1[r+2],p1[r+3]);}
  const float m=max2f(a,b);
  auto rr=__builtin_amdgcn_permlane32_swap(__float_as_uint(m),__float_as_uint(m),false,false);
  return max2f(__uint_as_float(rr[0]),__uint_as_float(rr[1]));
}
__device__ __forceinline__ void pv(f32x16*o,int vb,bf16x8 pa0,bf16x8 pa1,bf16x8 pa2,bf16x8 pa3){
  #pragma unroll
  for(int d0=0;d0<2;++d0){s16x4 lo[4],hi[4];
    #pragma unroll
    for(int ks=0;ks<4;++ks){
      asm volatile("ds_read_b64_tr_b16 %0,%1 offset:%c2":"=&v"(lo[ks]):"v"(vb),"i"(d0*4096+ks*1024):"memory");
      asm volatile("ds_read_b64_tr_b16 %0,%1 offset:%c2":"=&v"(hi[ks]):"v"(vb),"i"(d0*4096+ks*1024+512):"memory");}
    asm volatile("s_waitcnt lgkmcnt(0)":::"memory");SBAR();
    #define PK(k) (bf16x8){lo[k][0],lo[k][1],lo[k][2],lo[k][3],hi[k][0],hi[k][1],hi[k][2],hi[k][3]}
    o[d0]=__builtin_amdgcn_mfma_f32_32x32x16_bf16(pa0,PK(0),o[d0],0,0,0);
    o[d0]=__builtin_amdgcn_mfma_f32_32x32x16_bf16(pa1,PK(1),o[d0],0,0,0);
    o[d0]=__builtin_amdgcn_mfma_f32_32x32x16_bf16(pa2,PK(2),o[d0],0,0,0);
    o[d0]=__builtin_amdgcn_mfma_f32_32x32x16_bf16(pa3,PK(3),o[d0],0,0,0);
    #undef PK
  }
}

#ifndef ATTN_STORE16
#define ATTN_STORE16(p,v) (*(u32x4*)(p)=(v))
#endif
template<int THRL> __device__ __forceinline__ void attn_unit(int b,int h,int qb,const bf16*Q,const bf16*__restrict__ K,const bf16*__restrict__ V,bf16*O,char*shm,const float*qg,const float*rope,float*ssq,float sbound){
  const int tid=threadIdx.x,lane=tid&63,r32=lane&31,hi=lane>>5; const int wid=__builtin_amdgcn_readfirstlane(tid>>6);
  const long rowbase=(long)b*SEQ; const int q0=qb*QB;
  const bf16*Qw=Q+(rowbase+q0+wid*QBLK)*DM+h*D;
  const bf16*Kh=K+rowbase*DM+(h>>2)*D,*Vh=V+rowbase*DM+(h>>2)*D;
  const unsigned lds0=(unsigned)(uintptr_t)shm;
  float*wsf=(float*)(shm+LDS_WS)+wid*64;
  const unsigned koff=(unsigned)((8*wid+(lane>>3))*DM+(((lane&7)^((4*wid+(lane>>4))&7))*8)),
  voff_dummy_=0u, voff=(unsigned)((16*(wid&3)+(lane>>2))*DM+(wid>>2)*32+(lane&3)*8);
  const unsigned kdst=lds0+LDS_K+wid*1024, vdst=lds0+LDS_V+wid*1024;
  #define DMA_K(t,slot) glds16(Kh+(long)(t)*KVBLK*DM+koff,(unsigned)__builtin_amdgcn_readfirstlane(kdst+(slot)))
  #define DMA_V(t,slot) glds16(Vh+(long)(t)*KVBLK*DM+voff,(unsigned)__builtin_amdgcn_readfirstlane(vdst+(slot)))
  const int vb0=(int)(lds0+LDS_V)+((lane>>4)&1)*32+(lane&3)*8+(4*hi+((lane&15)>>2))*64;
  const char*Kbase=shm+LDS_K; bf16x8 kf[8];
  const lds_cptr shm3=(lds_cptr)shm; const lds_cptr kring=shm3+LDS_K; KBases kbs; _Pragma("unroll") for(int d0=0;d0<4;++d0)kbs.o[d0]=r32*128+(((2*d0+hi)^((r32>>1)&7))<<4); const lds_cptr vp0=shm3+LDS_V+((lane>>4)&1)*32+(lane&3)*8+(4*hi+((lane&15)>>2))*64;
  const int NT=SEQ/KVBLK;
  DMA_K(0,0);DMA_V(0,0);DMA_K(1,SLOTB);
  bf16x8 qr[4];
  #pragma unroll
  for(int d0=0;d0<4;++d0)qr[d0]=*reinterpret_cast<const bf16x8*>(&Qw[(long)r32*DM+d0*16+hi*8]);
  {
    float x[4][8]; float ss=0.f;
    #pragma unroll
    for(int d0=0;d0<4;++d0){
      #pragma unroll
      for(int j=0;j<8;++j){ x[d0][j]=__uint_as_float(((unsigned)(unsigned short)qr[d0][j])<<16); ss+=x[d0][j]*x[d0][j]; } }
    ss+=__shfl_xor(ss,32);
    const float rstd=rsqrtf(ss*(1.f/64.f)+1e-6f);
    const int tt=q0+wid*QBLK+r32, prow=tt>>6, pcol=tt&63;
    #pragma unroll
    for(int d0=0;d0<4;++d0){
      const float4 g0=*reinterpret_cast<const float4*>(qg+d0*16+hi*8), g1=*reinterpret_cast<const float4*>(qg+d0*16+hi*8+4);
      const int pos=(d0<2)?prow:pcol, i0=8*(d0&1)+4*hi;
      const float4 c4=*reinterpret_cast<const float4*>(rope+pos*16+i0), s4=*reinterpret_cast<const float4*>(rope+1024+pos*16+i0);
      const float gg[8]={g0.x,g0.y,g0.z,g0.w,g1.x,g1.y,g1.z,g1.w}, cc[4]={c4.x,c4.y,c4.z,c4.w}, sn[4]={s4.x,s4.y,s4.z,s4.w};
      u32x4 pw;
      #pragma unroll
      for(int jj=0;jj<4;++jj){ const float y0=x[d0][2*jj]*rstd*gg[2*jj], y1=x[d0][2*jj+1]*rstd*gg[2*jj+1];
        pw[jj]=cvtpk_s((y0*cc[jj]-y1*sn[jj])*C2,(y0*sn[jj]+y1*cc[jj])*C2); }
      qr[d0]=__builtin_bit_cast(bf16x8,pw); } }
  float mhat=0.f,l_reg=0.f;f32x16 o[2];o[0]=f32x16{};o[1]=f32x16{};f32x16 negm; _Pragma("unroll") for(int r=0;r<16;++r)negm[r]=FIXREF?-sbound:0.f; asm volatile("":"+v"(negm));

  #define CMASK(P0,P1,t) do{}while(0)
  bool resc=false;
  #define START(P0,P1) do{ resc=false; if(!FIXREF) \
    { const float rm=rowmax(P0,P1); const float dl=rm; mhat=fadd_s(mhat,dl); \
      _Pragma("unroll") for(int r=0;r<16;++r){P0[r]=fsub_s(P0[r],dl);P1[r]=fsub_s(P1[r],dl);} \
      _Pragma("unroll") for(int r=0;r<16;++r)negm[r]=-mhat; asm volatile("":"+v"(negm)); } \
    _Pragma("unroll") for(int r=0;r<16;++r)P0[r]=__builtin_amdgcn_exp2f(P0[r]); }while(0)
  #define RESC() do{ if(resc){ asm volatile("s_waitcnt lgkmcnt(0)":::"memory"); \
      _Pragma("unroll") for(int d_=0;d_<2;++d_) _Pragma("unroll") for(int r=0;r<16;++r)o[d_][r]*=wsf[crow(r,hi)]; } }while(0)
  f32x16 pA0,pA1,pB0,pB1;
  int sl_prev=0,sl_cur=0,sl_next=SLOTB;
  #define ROT() do{sl_prev=sl_cur;sl_cur=sl_next;sl_next=(sl_next==(NSLOT-1)*SLOTB)?0:sl_next+SLOTB;}while(0)
  DMA_K(2,2*SLOTB);
  WAIT_BAR(3);
  qkt(pA0,pA1,Kbase,qr,negm,r32,hi);asm volatile("s_nop 15\n\ts_nop 7":"+v"(pA0),"+v"(pA1));CMASK(pA0,pA1,0);
  START(pA0,pA1);
  _Pragma("unroll") for(int r=0;r<16;++r)pA1[r]=__builtin_amdgcn_exp2f(pA1[r]);
  WAIT_BAR(0);
  DMA_K(3,0);DMA_V(1,SLOTB);
  ROT();
  kload8(kf,kring,kbs,sl_cur);
  WAIT_BAR(2);
  s16x4 vlo[8],vhi[8]; u32x4 pw0,pw1,pw2,pw3;
  #define PKW(P,B) cvtpk_s(P[B],P[B+1])
  #define PAF(k) __builtin_bit_cast(bf16x8,pw##k)
  #define VFR(i) (bf16x8){vlo[i][0],vlo[i][1],vlo[i][2],vlo[i][3],vhi[i][0],vhi[i][1],vhi[i][2],vhi[i][3]}
  #define PIN(x) asm volatile("":"+v"(x))
  #define MX3(a,b,c) __builtin_fmaxf(__builtin_fmaxf((a),(b)),(c))
  #define GAPA(MF,A0,A1,A2,A3,W0,W1,PW) do{ MF; sacc+=A0; sacc+=A1; sacc+=A2; sacc+=A3; PIN(sacc); W0; W1; PIN(PW); SBAR(); }while(0)
  #define EX(v) __builtin_amdgcn_exp2f(v)
  #define GAPB(MF,X,B) do{ MF; X[B]=EX(X[B]); X[B+1]=EX(X[B+1]); X[B+2]=EX(X[B+2]); X[B+3]=EX(X[B+3]); PIN(X); SBAR(); }while(0)
  #define VRD(i) do{ vlo[i]=vtr(vp_+(((i)>>2)*4096+((i)&3)*1024)); vhi[i]=vtr(vp_+(((i)>>2)*4096+((i)&3)*1024+512)); }while(0)
  #define KRD(G,j) do{ if(G){ kload2(kf,kring,kbs,sl_next,j); SBAR(); } }while(0)
  #define STEP(C0,C1,P0,P1,t,GK,GV,GL) do{ SBAR(); \
    const lds_cptr vp_=vp0+sl_prev; \
    VRD(0); SBAR(); float sacc=(P0[0]+P0[1]); \
    GAPA(C0=__builtin_amdgcn_mfma_f32_32x32x16_bf16(kf[0],qr[0],negm,0,0,0), P0[2],P0[3],P0[4],P0[5],     pw0[0]=PKW(P0,0), pw0[1]=PKW(P0,2), pw0); \
    VRD(4); SBAR(); GAPA(C1=__builtin_amdgcn_mfma_f32_32x32x16_bf16(kf[1],qr[0],negm,0,0,0), P0[6],P0[7],P0[8],P0[9],     pw0[2]=PKW(P0,4), pw0[3]=PKW(P0,6), pw0); \
    VRD(1); SBAR(); GAPA(C0=__builtin_amdgcn_mfma_f32_32x32x16_bf16(kf[2],qr[1],C0,0,0,0),   P0[10],P0[11],P0[12],P0[13], pw1[0]=PKW(P0,8), pw1[1]=PKW(P0,10), pw1); \
    VRD(5); SBAR(); GAPA(C1=__builtin_amdgcn_mfma_f32_32x32x16_bf16(kf[3],qr[1],C1,0,0,0),   P0[14],P0[15],P1[0],P1[1],   pw1[2]=PKW(P0,12),pw1[3]=PKW(P0,14), pw1); \
    VRD(2); SBAR(); GAPA(C0=__builtin_amdgcn_mfma_f32_32x32x16_bf16(kf[4],qr[2],C0,0,0,0),   P1[2],P1[3],P1[4],P1[5],     pw2[0]=PKW(P1,0), pw2[1]=PKW(P1,2), pw2); \
    VRD(6); SBAR(); GAPA(C1=__builtin_amdgcn_mfma_f32_32x32x16_bf16(kf[5],qr[2],C1,0,0,0),   P1[6],P1[7],P1[8],P1[9],     pw2[2]=PKW(P1,4), pw2[3]=PKW(P1,6), pw2); \
    VRD(3); SBAR(); GAPA(C0=__builtin_amdgcn_mfma_f32_32x32x16_bf16(kf[6],qr[3],C0,0,0,0),   P1[10],P1[11],P1[12],P1[13], pw3[0]=PKW(P1,8), pw3[1]=PKW(P1,10), pw3); \
    VRD(7); SBAR(); GAPA(C1=__builtin_amdgcn_mfma_f32_32x32x16_bf16(kf[7],qr[3],C1,0,0,0),   P1[14],P1[15],0.f,0.f,       pw3[2]=PKW(P1,12),pw3[3]=PKW(P1,14), pw3); \
    l_reg+=sacc; \
    if(GK){DMA_K((t)+3,sl_cur);} if(GV){DMA_V((t)+1,sl_next);} \
    CMASK(C0,C1,t); \
    if(!FIXREF){ float a=MX3(C0[0],C0[1],C1[0]),b=MX3(C0[2],C0[3],C1[1]); a=MX3(a,C1[2],C1[3]); \
      _Pragma("unroll") for(int r=4;r<16;r+=4){a=MX3(a,C0[r],C0[r+1]);b=MX3(b,C0[r+2],C0[r+3]);a=MX3(a,C1[r],C1[r+1]);b=MX3(b,C1[r+2],C1[r+3]);} \
      float rm=__builtin_fmaxf(a,b); { auto rr=__builtin_amdgcn_permlane32_swap(__float_as_uint(rm),__float_as_uint(rm),false,false); rm=__builtin_fmaxf(__uint_as_float(rr[0]),__uint_as_float(rr[1])); } \
      resc=false; \
      if(__builtin_expect(__any(rm>(float)THRL),0)){ const float dl=__builtin_fmaxf(rm,0.f); mhat+=dl; \
        _Pragma("unroll") for(int r=0;r<16;++r){C0[r]-=dl;C1[r]-=dl;} \
        _Pragma("unroll") for(int r=0;r<16;++r)negm[r]=-mhat; asm volatile("":"+v"(negm)); \
        const float f=__builtin_amdgcn_exp2f(-dl); l_reg*=f; if(hi==0)wsf[r32]=f; resc=true; } } \
    SBAR(); \
    GAPB(o[0]=__builtin_amdgcn_mfma_f32_32x32x16_bf16(PAF(0),VFR(0),o[0],0,0,0), C0,0); \
    GAPB(o[1]=__builtin_amdgcn_mfma_f32_32x32x16_bf16(PAF(0),VFR(4),o[1],0,0,0), C0,4); \
    KRD(GL,0); GAPB(o[0]=__builtin_amdgcn_mfma_f32_32x32x16_bf16(PAF(1),VFR(1),o[0],0,0,0), C0,8); \
    KRD(GL,1); GAPB(o[1]=__builtin_amdgcn_mfma_f32_32x32x16_bf16(PAF(1),VFR(5),o[1],0,0,0), C0,12); \
    KRD(GL,2); GAPB(o[0]=__builtin_amdgcn_mfma_f32_32x32x16_bf16(PAF(2),VFR(2),o[0],0,0,0), C1,0); \
    KRD(GL,3); GAPB(o[1]=__builtin_amdgcn_mfma_f32_32x32x16_bf16(PAF(2),VFR(6),o[1],0,0,0), C1,4); \
    GAPB(o[0]=__builtin_amdgcn_mfma_f32_32x32x16_bf16(PAF(3),VFR(3),o[0],0,0,0), C1,8); \
    GAPB(o[1]=__builtin_amdgcn_mfma_f32_32x32x16_bf16(PAF(3),VFR(7),o[1],0,0,0), C1,12); \
    }while(0)
  int t=1;
  #undef CMASK
  #define CMASK(P0,P1,t) do{}while(0)
  for(;t+5<NT;t+=2){
    STEP(pB0,pB1,pA0,pA1,t,true,true,true);     WAIT_BAR(2); RESC(); ROT();
    STEP(pA0,pA1,pB0,pB1,t+1,true,true,true);   WAIT_BAR(2); RESC(); ROT();
  }
  #undef CMASK
  #define CMASK(P0,P1,t) do{}while(0)
  #define ENDW(tt) do{ if((tt)+3<NT){WAIT_BAR(2);} else if((tt)+2<NT){WAIT_BAR(1);} else {WAIT_BAR(0);} }while(0)
  for(;t+1<NT;t+=2){
    STEP(pB0,pB1,pA0,pA1,t,(t+3<NT),(t+1<NT),(t+1<NT));       ENDW(t);   RESC(); ROT();
    STEP(pA0,pA1,pB0,pB1,t+1,(t+4<NT),(t+2<NT),(t+2<NT));     ENDW(t+1); RESC(); ROT();
  }
  STEP(pB0,pB1,pA0,pA1,NT-1,false,false,false); RESC();
  { float sacc=pB0[0]+pB0[1]; _Pragma("unroll") for(int r=2;r<16;++r)sacc+=pB0[r]; _Pragma("unroll") for(int r=0;r<16;++r)sacc+=pB1[r]; l_reg+=sacc;
    pw0=(u32x4){PKW(pB0,0),PKW(pB0,2),PKW(pB0,4),PKW(pB0,6)};pw1=(u32x4){PKW(pB0,8),PKW(pB0,10),PKW(pB0,12),PKW(pB0,14)};pw2=(u32x4){PKW(pB1,0),PKW(pB1,2),PKW(pB1,4),PKW(pB1,6)};pw3=(u32x4){PKW(pB1,8),PKW(pB1,10),PKW(pB1,12),PKW(pB1,14)};
    SBAR(); pv(o,vb0+sl_cur,PAF(0),PAF(1),PAF(2),PAF(3)); }
  #undef PKW
  #undef PAF
  #undef VFR
  #undef PIN
  #undef MX3
  #undef GAPA
  #undef GAPB
  #undef EX
  #undef VRD
  #undef KRD
  #undef STEP
  #undef ENDW
  {auto rr=__builtin_amdgcn_permlane32_swap(__float_as_uint(l_reg),__float_as_uint(l_reg),false,false);l_reg=__uint_as_float(rr[0])+__uint_as_float(rr[1]);}
  if(hi==0)wsf[32+r32]=l_reg;asm volatile("s_waitcnt lgkmcnt(0)":::"memory");
  float rli[16];
  #pragma unroll
  for(int r=0;r<16;++r)rli[r]=__builtin_amdgcn_rcpf(wsf[32+crow(r,hi)]);
  bf16*Ow=O+(rowbase+q0+wid*QBLK)*OP+h*D;
  { bf16*stg=(bf16*)(shm+LDS_OST)+wid*2048;
    #pragma unroll
    for(int r=0;r<16;++r){const int orow=crow(r,hi);
      #pragma unroll
      for(int d0=0;d0<2;++d0)stg[orow*64+d0*32+r32]=__float2bfloat16(o[d0][r]*rli[r]);}
    asm volatile("s_waitcnt lgkmcnt(0)":::"memory");
    #pragma unroll
    for(int i=0;i<4;++i){const int row=i*8+(lane>>3),ch=lane&7; const u32x4 v=*(const u32x4*)(stg+row*64+ch*8); ATTN_STORE16(Ow+(long)row*OP+ch*8,v);
      float sq=0.f;
      #pragma unroll
      for(int k=0;k<4;++k){ const float lo=__uint_as_float(v[k]<<16), hi_=__uint_as_float(v[k]&0xffff0000u); sq+=lo*lo+hi_*hi_; }
      sq+=__shfl_xor(sq,1); sq+=__shfl_xor(sq,2); sq+=__shfl_xor(sq,4);
      if(ch==0) ssq[(long)h*(BATCH*SEQ)+rowbase+q0+wid*QBLK+row]=sq; } }
  asm volatile("s_waitcnt lgkmcnt(0)\n\ts_barrier":::"memory");
  #undef DMA_K
  #undef DMA_V
  #undef CMASK
  #undef START
  #undef RESC
  #undef ROT
}
constexpr int ATTN_LDS_BYTES=LDS_BYTES;
struct AttnTensors { const bf16* Q; const bf16* K; const bf16* V; bf16* O; const float* qg; const float* rope; float* ssq; float sbound; };
struct AttnUnit { int bh; int qb; };
struct StaticOrder {
  int vcu;
  __device__ __forceinline__ explicit StaticOrder(int grid,int block):vcu((block%8)*(grid/8)+block/8){}
  __device__ __forceinline__ bool next(int i,AttnUnit&u)const{ if(i>=4)return false; const int pair=vcu>>4, c16=vcu&15; u.bh=(pair>>1)*NHEAD+(pair&1)*4+(c16>>2); u.qb=(c16&3)*4+i; return true; }
  __device__ __forceinline__ void a_ready(const AttnUnit&)const{}
  __device__ __forceinline__ void done(const AttnUnit&)const{}
};
template<class Sched,int THRL=8> __device__ __forceinline__ void attn_phase(char*lds,const AttnTensors&T,const Sched&S){
  AttnUnit u;
  for(int i=0;S.next(i,u);++i){ S.a_ready(u); attn_unit<THRL>(u.bh/NHEAD,u.bh%NHEAD,u.qb,T.Q,T.K,T.V,T.O,lds,T.qg,T.rope,T.ssq,T.sbound); S.done(u); }
}
#undef SBAR
#undef WAIT_BAR
}

constexpr int NWAVES = 8;
constexpr int RING_OFF = 0, RING_BYTES = 131072;
constexpr int LDSCTL_OFF = RING_BYTES, MISC_OFF = LDSCTL_OFF + 320;
constexpr int LDS_BYTES = 147456;
constexpr int CW_BAR = 32768;
constexpr int MAX_LAUNCH = 8;
static_assert((CW_BAR + MAX_LAUNCH * XCD_BAR_WORDS) * 4 <= (int)(1 * MiB), "barrier words inside the memset region");
constexpr size_t WS_WINT = 4 * MiB;
constexpr size_t WS_WOUTT = 9 * MiB;
constexpr size_t WS_SSQ = 13 * MiB;
constexpr size_t WS_RSTD = 3 * MiB + 65536;
constexpr size_t WS_WGU = 16 * MiB;
constexpr size_t WS_WD = 144 * MiB;
constexpr int TAB_OFF = LDSCTL_OFF + 1024;
constexpr int XS_ROWS = NSLOT + 256;

constexpr int PROF_A = -1, PROF_B = -1;
constexpr int CW_PROF = 20000;
constexpr int FP8TEST = 0;
constexpr int NCONV = 136;
constexpr int CW_COUNTS2 = 70000, CW_CURSOR2 = 75000, CW_TILECNT = 90000;
constexpr int HIST_OFF = 49152, POS_OFF = 50176;
constexpr int REP0 = 1, REPG1 = 1, REPG3 = 1, REPATT = 1, REPM1 = 1, REPM2 = 1, REPP1 = 1, REPALL = 1, REPU = 1, REPP5 = 1, DRYQK = 0, DRYAN = 0, DRYSC = 0, DRYFIN = 0, DRYRT = 0;
struct Args { const float* in[21]; float* out; unsigned char* ws; int ph_lo, ph_hi, li, pad; };

struct Frame {
    LAS unsigned char* lds;
    volatile LAS unsigned* MISC;
    int tid, lane, wave, vcu, G;
};

template <bool NT = false>
__device__ __forceinline__ void p0_transpose_item(const float* W, int ldw, int k0, int ns0, bf16* WT, int K, int nd0, LAS float* scr, int lane) {
    if (ns0 >= 0) {
        f32x4 v[8];
#pragma unroll
        for (int i = 0; i < 8; ++i) { const GAS f32x4* p = (const GAS f32x4*)(W + (size_t)(k0 + 8 * i + (lane >> 3)) * ldw + ns0 + (lane & 7) * 4); v[i] = NT ? __builtin_nontemporal_load(p) : *p; }
#pragma unroll
        for (int i = 0; i < 8; ++i) { LAS float* p = scr + (8 * i + (lane >> 3)) * 33 + (lane & 7) * 4; p[0] = v[i].x; p[1] = v[i].y; p[2] = v[i].z; p[3] = v[i].w; }
    } else {
#pragma unroll 8
        for (int i = 0; i < 32; ++i) { const int kk = 2 * i + (lane >> 5); scr[kk * 33 + (lane & 31)] = 0.f; }
    }
    LDS_WAIT(); asm volatile("" ::: "memory");
    const int c = lane & 7;
#pragma unroll
    for (int j = 0; j < 4; ++j) { const int n = (lane >> 3) + 8 * j; const LAS float* s = scr + (8 * c) * 33 + n;
        v4u o; o.x = pk2(s[0 * 33], s[1 * 33]); o.y = pk2(s[2 * 33], s[3 * 33]); o.z = pk2(s[4 * 33], s[5 * 33]); o.w = pk2(s[6 * 33], s[7 * 33]);
        GAS v4u* q = (GAS v4u*)(WT + (size_t)(nd0 + n) * K + k0 + 8 * c); if (NT) __builtin_nontemporal_store(o, q); else *q = o; }
    LDS_WAIT(); asm volatile("" ::: "memory");
}

__device__ __forceinline__ void p0_transpose_item_wout(const float* W, int k0, int ns0, bf16* WT, const float* again, LAS float* scr, int lane) {
    f32x4 v[8];
#pragma unroll
    for (int i = 0; i < 8; ++i) { const int k = k0 + 8 * i + (lane >> 3); v[i] = *(const GAS f32x4*)(W + (size_t)k * D + ns0 + (lane & 7) * 4); if (k0 >= 512) v[i] = v[i] * again[k - 512]; }
#pragma unroll
    for (int i = 0; i < 8; ++i) { LAS float* p = scr + (8 * i + (lane >> 3)) * 33 + (lane & 7) * 4; p[0] = v[i].x; p[1] = v[i].y; p[2] = v[i].z; p[3] = v[i].w; }
    LDS_WAIT(); asm volatile("" ::: "memory");
    const int c = lane & 7, kd0 = (k0 + 512) & 1023;
#pragma unroll
    for (int j = 0; j < 4; ++j) { const int n = (lane >> 3) + 8 * j; const LAS float* sp = scr + (8 * c) * 33 + n;
        v4u o; o.x = pk2(sp[0 * 33], sp[1 * 33]); o.y = pk2(sp[2 * 33], sp[3 * 33]); o.z = pk2(sp[4 * 33], sp[5 * 33]); o.w = pk2(sp[6 * 33], sp[7 * 33]);
        *(GAS v4u*)(WT + (size_t)(ns0 + n) * D + kd0 + 8 * c) = o; }
    LDS_WAIT(); asm volatile("" ::: "memory");
}
struct ConvItem { const float* W; int ldw, k0, ns0; bf16* WT; int K, nd0; };
__device__ __forceinline__ void conv_load(const ConvItem& it, f32x4 (&v)[8], int lane) {
#pragma unroll
    for (int i = 0; i < 8; ++i) v[i] = __builtin_nontemporal_load((const GAS f32x4*)(it.W + (size_t)(it.k0 + 8 * i + (lane >> 3)) * it.ldw + it.ns0 + (lane & 7) * 4));
}
__device__ __forceinline__ void conv_finish(const ConvItem& it, const f32x4 (&v)[8], LAS float* scr, int lane) {
#pragma unroll
    for (int i = 0; i < 8; ++i) { LAS float* p = scr + (8 * i + (lane >> 3)) * 33 + (lane & 7) * 4; p[0] = v[i].x; p[1] = v[i].y; p[2] = v[i].z; p[3] = v[i].w; }
    LDS_WAIT(); asm volatile("" ::: "memory");
    const int c = lane & 7;
#pragma unroll
    for (int j = 0; j < 4; ++j) { const int n = (lane >> 3) + 8 * j; const LAS float* s = scr + (8 * c) * 33 + n;
        v4u o; o.x = pk2(s[0 * 33], s[1 * 33]); o.y = pk2(s[2 * 33], s[3 * 33]); o.z = pk2(s[4 * 33], s[5 * 33]); o.w = pk2(s[6 * 33], s[7 * 33]);
        __builtin_nontemporal_store(o, (GAS v4u*)(it.WT + (size_t)(it.nd0 + n) * it.K + it.k0 + 8 * c)); }
    LDS_WAIT(); asm volatile("" ::: "memory");
}
__device__ __forceinline__ ConvItem conv_item(int it, const float* wgate, const float* wup, const float* wdown, bf16* WguT, bf16* WdT) {
    constexpr int I_GU = NEXP * (D / 64) * (1024 / 32);
    ConvItem c;
    if (it < I_GU) { const int e = it >> 9, q = it & 511, kb = q >> 5, nb = q & 31, pn = nb >> 3, bj = (nb >> 2) & 1, c0 = (nb & 3) * 32;
        c.W = (bj ? wup : wgate) + (size_t)e * D * DEXP; c.ldw = DEXP; c.k0 = kb * 64; c.ns0 = pn * 128 + c0; c.WT = WguT + (size_t)e * 1024 * D; c.K = D; c.nd0 = nb * 32; }
    else { const int r = it - I_GU, e = r >> 8, q = r & 255, kb = q >> 5, nb = q & 31;
        c.W = wdown + (size_t)e * DEXP * D; c.ldw = D; c.k0 = kb * 64; c.ns0 = nb * 32; c.WT = WdT + (size_t)e * 1024 * DEXP; c.K = DEXP; c.nd0 = nb * 32; }
    return c;
}

__device__ __forceinline__ unsigned pk4_i8(float a, float b, float c, float d) {
    const int ia = __float2int_rn(a), ib = __float2int_rn(b), ic = __float2int_rn(c), id = __float2int_rn(d);
    return ((unsigned)ia & 0xffu) | (((unsigned)ib & 0xffu) << 8) | (((unsigned)ic & 0xffu) << 16) | ((unsigned)id << 24);
}
__device__ __forceinline__ void conv_colblock_i8g(const float* Wsrc, int ldw, unsigned char* out, float* sw32, LAS unsigned char* lds, int wave, int lane) {
    const float* W = Wsrc + (lane & 7) * 4;
    const int DEXP_ = ldw;
    LAS float* pmax = (LAS float*)(lds + 69632);
    f32x4 v[2][8];
#pragma unroll
    for (int q = 0; q < 2; ++q)
#pragma unroll
        for (int i = 0; i < 8; ++i) v[q][i] = Wsrc ? __builtin_nontemporal_load((const GAS f32x4*)(W + (size_t)((2 * wave + q) * 64 + 8 * i + (lane >> 3)) * DEXP_)) : (f32x4){0.f, 0.f, 0.f, 0.f};
    float mx[4] = {0.f, 0.f, 0.f, 0.f};
#pragma unroll
    for (int q = 0; q < 2; ++q)
#pragma unroll
        for (int i = 0; i < 8; ++i) { mx[0] = fmaxf(mx[0], fabsf(v[q][i].x)); mx[1] = fmaxf(mx[1], fabsf(v[q][i].y)); mx[2] = fmaxf(mx[2], fabsf(v[q][i].z)); mx[3] = fmaxf(mx[3], fabsf(v[q][i].w)); }
#pragma unroll
    for (int j = 0; j < 4; ++j) { mx[j] = fmaxf(mx[j], __shfl_xor(mx[j], 8)); mx[j] = fmaxf(mx[j], __shfl_xor(mx[j], 16)); mx[j] = fmaxf(mx[j], __shfl_xor(mx[j], 32)); }
    if (lane < 8) *(LAS f32x4*)(pmax + wave * 32 + lane * 4) = (f32x4){mx[0], mx[1], mx[2], mx[3]};
    __syncthreads();
#pragma unroll
    for (int w2 = 0; w2 < 8; ++w2) { const f32x4 m = *(const LAS f32x4*)(pmax + w2 * 32 + (lane & 7) * 4); mx[0] = fmaxf(mx[0], m.x); mx[1] = fmaxf(mx[1], m.y); mx[2] = fmaxf(mx[2], m.z); mx[3] = fmaxf(mx[3], m.w); }
    float inv[4];
#pragma unroll
    for (int j = 0; j < 4; ++j) inv[j] = mx[j] > 0.f ? 127.f / mx[j] : 0.f;
    if (wave == 0 && lane < 8) *(GAS f32x4*)(sw32 + lane * 4) = (f32x4){mx[0] * (1.f / 127.f), mx[1] * (1.f / 127.f), mx[2] * (1.f / 127.f), mx[3] * (1.f / 127.f)};
    LAS float* scr = (LAS float*)(lds + wave * 8448);
#pragma unroll
    for (int q = 0; q < 2; ++q) {
#pragma unroll
        for (int i = 0; i < 8; ++i) { LAS float* p = scr + (8 * i + (lane >> 3)) * 33 + (lane & 7) * 4; p[0] = v[q][i].x * inv[0]; p[1] = v[q][i].y * inv[1]; p[2] = v[q][i].z * inv[2]; p[3] = v[q][i].w * inv[3]; }
        LDS_WAIT(); asm volatile("" ::: "memory");
        { const int n = lane >> 1, hf = lane & 1; const LAS float* sp = scr + (32 * hf) * 33 + n; unsigned w[8];
#pragma unroll
          for (int r = 0; r < 8; ++r) w[r] = pk4_i8(sp[(4 * r) * 33], sp[(4 * r + 1) * 33], sp[(4 * r + 2) * 33], sp[(4 * r + 3) * 33]);
          GAS v4u* o = (GAS v4u*)(out + (size_t)n * D + (2 * wave + q) * 64 + 32 * hf); __builtin_nontemporal_store((v4u){w[0], w[1], w[2], w[3]}, o); __builtin_nontemporal_store((v4u){w[4], w[5], w[6], w[7]}, o + 1); }
        LDS_WAIT(); asm volatile("" ::: "memory");
    }
    __syncthreads();
}
__device__ __forceinline__ void conv_colblock_i8(int item  , const float* wgate, const float* wup, unsigned char* Wgu8, float* SW, LAS unsigned char* lds, int wave, int lane) {
    const int e = item >> 5, nb = item & 31, pn = nb >> 3, bj = (nb >> 2) & 1, c0 = (nb & 3) * 32;
    conv_colblock_i8g((bj ? wup : wgate) + (size_t)e * D * DEXP + pn * 128 + c0, DEXP, Wgu8 + ((size_t)e * 1024 + nb * 32) * D, SW + (size_t)e * 1024 + nb * 32, lds, wave, lane);
}
__device__ __forceinline__ void rms_row2_to_i8(int lane, const float* xrow0, const float* gain, unsigned char* o0, float* su0) {
    f32x4 v[2][4]; float ss[2] = {0.f, 0.f};
#pragma unroll
    for (int q = 0; q < 2; ++q)
#pragma unroll
        for (int j = 0; j < 4; ++j) v[q][j] = __builtin_nontemporal_load((const GAS f32x4*)(xrow0 + (size_t)q * D) + j * 64 + lane);
    f32x4 g[4];
#pragma unroll
    for (int j = 0; j < 4; ++j) g[j] = ((const GAS f32x4*)gain)[j * 64 + lane];
#pragma unroll
    for (int q = 0; q < 2; ++q)
#pragma unroll
        for (int j = 0; j < 4; ++j) ss[q] += (v[q][j].x * v[q][j].x + v[q][j].y * v[q][j].y) + (v[q][j].z * v[q][j].z + v[q][j].w * v[q][j].w);
    const bool b0 = lane & 1, b1 = lane & 2;
#pragma unroll
    for (int q = 0; q < 2; ++q) {
        const float rstd = rsqrtf(wave_sum(ss[q]) * (1.f / D) + EPS); float m = 0.f;
#pragma unroll
        for (int j = 0; j < 4; ++j) { v[q][j] = v[q][j] * rstd * g[j]; m = fmaxf(m, fmaxf(fmaxf(fabsf(v[q][j].x), fabsf(v[q][j].y)), fmaxf(fabsf(v[q][j].z), fabsf(v[q][j].w)))); }
#pragma unroll
        for (int o = 1; o < 64; o <<= 1) m = fmaxf(m, __shfl_xor(m, o));
        const float inv = m > 0.f ? 127.f / m : 0.f;
        unsigned w[4], x[4], y[4];
#pragma unroll
        for (int j = 0; j < 4; ++j) w[j] = pk4_i8(v[q][j].x * inv, v[q][j].y * inv, v[q][j].z * inv, v[q][j].w * inv);
#pragma unroll
        for (int p2 = 0; p2 < 2; ++p2) { const unsigned snd = b0 ? w[2 * p2] : w[2 * p2 + 1]; const unsigned rcv = (unsigned)__shfl_xor((int)snd, 1);
            x[2 * p2] = b0 ? rcv : w[2 * p2]; x[2 * p2 + 1] = b0 ? w[2 * p2 + 1] : rcv; }
#pragma unroll
        for (int i = 0; i < 2; ++i) { const unsigned snd = b1 ? x[i] : x[2 + i]; const unsigned rcv = (unsigned)__shfl_xor((int)snd, 2);
            y[i] = b1 ? rcv : x[i]; y[2 + i] = b1 ? x[2 + i] : rcv; }
        *(GAS v4u*)(o0 + (size_t)q * D + (lane & 3) * 256 + (lane >> 2) * 16) = (v4u){y[0], y[1], y[2], y[3]};
        if (lane == 0) su0[q] = m * (1.f / 127.f);
    }
}
__device__ __forceinline__ float wave_sum_x(float v) {
#pragma unroll
    for (int o = 1; o < 64; o <<= 1) v += __shfl_xor(v, o);
    return v;
}
__device__ __forceinline__ void rms_row2_to_bf16(int lane, const float* xrow0, const float* xrow1, const float* gain, bf16* orow0, bf16* orow1) {
    const GAS f32x4* xa = (const GAS f32x4*)xrow0 + lane; const GAS f32x4* xb = (const GAS f32x4*)xrow1 + lane;
    f32x4 va[4], vb[4]; float sa = 0.f, sb = 0.f;
#pragma unroll
    for (int j = 0; j < 4; ++j) { va[j] = __builtin_nontemporal_load(xa + 64 * j); vb[j] = __builtin_nontemporal_load(xb + 64 * j); }
#pragma unroll
    for (int j = 0; j < 4; ++j) { sa += (va[j].x * va[j].x + va[j].y * va[j].y) + (va[j].z * va[j].z + va[j].w * va[j].w); sb += (vb[j].x * vb[j].x + vb[j].y * vb[j].y) + (vb[j].z * vb[j].z + vb[j].w * vb[j].w); }
    const float ra = rsqrtf(wave_sum_x(sa) * (1.f / D) + EPS), rb = rsqrtf(wave_sum_x(sb) * (1.f / D) + EPS);
    GAS unsigned long long* oa = (GAS unsigned long long*)orow0 + lane; GAS unsigned long long* ob = (GAS unsigned long long*)orow1 + lane;
#pragma unroll
    for (int j = 0; j < 4; ++j) { const f32x4 g = ((const GAS f32x4*)gain)[64 * j + lane];
        oa[64 * j] = (unsigned long long)pk2(va[j].x * ra * g.x, va[j].y * ra * g.y) | ((unsigned long long)pk2(va[j].z * ra * g.z, va[j].w * ra * g.w) << 32);
        ob[64 * j] = (unsigned long long)pk2(vb[j].x * rb * g.x, vb[j].y * rb * g.y) | ((unsigned long long)pk2(vb[j].z * rb * g.z, vb[j].w * rb * g.w) << 32); }
}

__global__ void __launch_bounds__(NWAVES * 64, 2) mega(Args args) {
    extern __shared__ __attribute__((aligned(16))) unsigned char lds[];
    Frame F;
    F.lds = (LAS unsigned char*)lds;
    F.MISC = (volatile LAS unsigned*)(F.lds + MISC_OFF);
    F.tid = threadIdx.x; F.lane = F.tid & 63; F.wave = __builtin_amdgcn_readfirstlane(F.tid >> 6);
    F.G = gridDim.x; { const int bx = blockIdx.x; F.vcu = (F.G % 8 == 0) ? (bx % 8) * (F.G / 8) + bx / 8 : bx; }
    unsigned char* ws = args.ws;
    gu32* ctl = (gu32*)(ws + WS_CTL);
    for (int u = F.tid; u < (LDS_BYTES - LDSCTL_OFF) / 4; u += NWAVES * 64) ((LAS unsigned*)(F.lds + LDSCTL_OFF))[u] = 0u;
    __syncthreads();
    XcdBarrier bar = xcd_barrier_post((unsigned*)(ctl + CW_BAR) + args.li * XCD_BAR_WORDS, F.MISC + 8);
    const int lo = args.ph_lo, hi = args.ph_hi;
#define IN(k) (lo <= (k) && (k) < hi)
#define BOTH(k) (IN(k) && IN((k) + 1))
#define GRID_BAR() xcd_barrier(bar)
    unsigned long long tprev = 0; if (PROF_A >= 0 && blockIdx.x == 0 && F.tid == 0) tprev = rt();
#define STAMP(k) do { if (PROF_A >= 0 && blockIdx.x == 0 && F.tid == 0) { const unsigned long long now_ = rt(); __hip_atomic_store(ctl + CW_PROF + (k), (unsigned)(now_ - tprev), RLX_AGENT); tprev = now_; } } while (0)
    const float* x = args.in[0];
    bf16* U = (bf16*)(ws + WS_U); bf16* PROJ = (bf16*)(ws + WS_PROJ); bf16* WinT = (bf16*)(ws + WS_WINT);
    const int gw = F.vcu * NWAVES + F.wave, NGW = F.G * NWAVES;

    const int gtid = (int)blockIdx.x * (NWAVES * 64) + F.tid, nthr = F.G * NWAVES * 64;
    const int half = F.tid >> 8, t256 = F.tid & 255, bx = (int)blockIdx.x;
    unsigned* ctlp = (unsigned*)(ws + WS_CTL); unsigned* tokinfo = (unsigned*)(ws + WS_TOKINFO); int* tokslot = (int*)(ws + WS_TOKSLOT); int* slottok = (int*)(ws + WS_SLOTTOK);
    float* slotgate = (float*)(ws + WS_SLOTGATE); float* rope = (float*)(ws + WS_ROPE);
    bf16* KVS = (bf16*)(ws + WS_G); float* DEC = (float*)(ws + WS_DEC); float* SSQ = (float*)(ws + WS_SSQ);
    float* RSTD = (float*)(ws + WS_RSTD); bf16* WguT = (bf16*)(ws + WS_WGU); bf16* WdT = (bf16*)(ws + WS_WD); bf16* XS = (bf16*)(ws + WS_PROJ);
    float* RATT = (float*)(ws + 15 * MiB + 512 * 1024); bf16* HB = (bf16*)(ws + 80 * MiB);
    unsigned char* U8 = ws + WS_U; unsigned char* Win8 = ws + WS_WINT; float* SUS = (float*)(ws + 14 * MiB + 512 * 1024); float* SWIN = (float*)(ws + 14 * MiB + 768 * 1024);
    unsigned char* Wgu8 = ws + WS_WGU; float* SWS = (float*)(ws + 14 * MiB); float* SAS = (float*)(ws + 15 * MiB); unsigned char* XS8 = ws + WS_PROJ;
    LAS int* tab = (LAS int*)(F.lds + TAB_OFF); LAS int* t_cnt = tab; LAS int* t_offs = tab + 64; LAS int* t_e = tab + 144; LAS int* t_r0 = tab + 464; LAS int* t_nr = tab + 784; LAS int* t_n = tab + 1104;
    bf16* HMID = (bf16*)(ws + WS_G); unsigned char* YS8 = ws + WS_PROJ + 64 * MiB; float* YSC = (float*)(ws + WS_PROJ + 128 * MiB);   bf16* WoutT = (bf16*)(ws + WS_WOUTT);

    if (IN(0)) {
        LAS float* scr = (LAS float*)(F.lds + RING_OFF + F.wave * 16384);
        constexpr int I_WOUT = (D / 64) * (D / 32);
        const int gb = bx * NWAVES + F.wave;
        if (F.G == 256) { const int it = gb - (2048 - I_WOUT); if (it >= 0) { const int kb = it / (D / 32), nb = it % (D / 32); p0_transpose_item_wout(args.in[11], kb * 64, nb * 32, WoutT, args.in[10], scr, F.lane); } }
        else for (int it = gw; it < I_WOUT; it += NGW) { const int kb = it / (D / 32), nb = it % (D / 32); p0_transpose_item_wout(args.in[11], kb * 64, nb * 32, WoutT, args.in[10], scr, F.lane); }
        __syncthreads();
        for (int nb = bx; nb < PW / 32; nb += F.G) { const int cs = proj_src_col(nb * 32);
            conv_colblock_i8g(cs < 0 ? nullptr : args.in[2] + cs, DIN, Win8 + (size_t)nb * 32 * D, SWIN + nb * 32, F.lds + RING_OFF, F.wave, F.lane); }
        router_build_bfrag(gtid, nthr, args.in[13], args.in[15], args.in[12], (bf16*)(ws + WS_BFRAG));
        if (F.G == 256) {
            for (int i = 0; i < 6; ++i) { const int m = 2 * (gb + 2048 * i); rms_row2_to_i8(F.lane, x + (size_t)m * D, args.in[1], U8 + (size_t)m * D, SUS + m); }
            if (bx >= PW / 32) for (int j = gb - (PW / 32) * NWAVES; j < 4096; j += 2048 - (PW / 32) * NWAVES) { const int m = 2 * (12288 + j); rms_row2_to_i8(F.lane, x + (size_t)m * D, args.in[1], U8 + (size_t)m * D, SUS + m); }
        } else
        for (int rep = 0; rep < REPU; ++rep) for (int m = 2 * gw; m < NTOK; m += 2 * NGW) rms_row2_to_i8(F.lane, x + (size_t)m * D, args.in[1], U8 + (size_t)m * D, SUS + m);
        { if (gtid < 1024) { const int pos = gtid >> 4, j = gtid & 15; const float ang = (float)pos * powf(10000.0f, -(float)(2 * j) / 32.0f); rope[gtid] = cosf(ang); rope[1024 + gtid] = sinf(ang); } }
        if (BOTH(0)) GRID_BAR();
        STAMP(0);
    }
    if (IN(1)) {
        const int rk = bx >> 3, xg = bx & 7; constexpr int NGE = 32 - NCONV / 8;
        if (F.G != 256 || rk < NGE) {
            pg8::Gemm g{(const pg8::bf16_t*)U8, (const pg8::bf16_t*)Win8, NTOK, PW, D}; pg8::StaticOrder S;
            if (F.G == 256) S.init(NTOK, PW, NGE * 8, rk * 8 + xg); else S.init(NTOK, PW, F.G, bx);
            pg8::EpiBf16_I8 E{PROJ, PW, SUS, SWIN, DIN};
            for (int rep = 0; rep < REPP1; ++rep) pg8::gemm_phase<pg8::EpiBf16_I8, pg8::StaticOrder, true, true, false, true>(F.lds + RING_OFF, g, S, E);
        }
        if (F.G != 256 || rk >= NGE) {
            LAS float* scr = (LAS float*)(F.lds + RING_OFF + F.wave * 16384);
            constexpr int I_GU = NEXP * (D / 64) * (1024 / 32), I_DN = NEXP * (DEXP / 64) * (D / 32);
            const int cw = (F.G == 256) ? ((rk - NGE) * 8 + xg) * NWAVES + F.wave : gw, NCW = (F.G == 256) ? NCONV * NWAVES : NGW;
            for (int rep = 0; rep < REP0; ++rep) {
                { const int cwg = (F.G == 256) ? (rk - NGE) * 8 + xg : bx, NWG = (F.G == 256) ? NCONV : F.G;
                  for (int it = cwg; it < NEXP * 32; it += NWG) conv_colblock_i8(it, args.in[17], args.in[18], Wgu8, SWS, F.lds + RING_OFF, F.wave, F.lane); }
                const int base_ = I_DN / NCW, rem_ = I_DN % NCW, lo_ = NCW - rem_;
                const int dn = base_ + (cw >= lo_ ? 1 : 0), d0 = cw < lo_ ? cw * base_ : lo_ * base_ + (cw - lo_) * (base_ + 1);
                f32x4 va[8], vb[8]; ConvItem ia, ib;
                int k = 0;
                if (k < dn) { ia = conv_item(I_GU + d0 + k, args.in[17], args.in[18], args.in[19], WguT, WdT); conv_load(ia, va, F.lane); }
                for (; k < dn; k += 2) {
                    const bool hb = k + 1 < dn, ha = k + 2 < dn;
                    if (hb) { ib = conv_item(I_GU + d0 + k + 1, args.in[17], args.in[18], args.in[19], WguT, WdT); conv_load(ib, vb, F.lane); }
                    conv_finish(ia, va, scr, F.lane);
                    if (ha) { ia = conv_item(I_GU + d0 + k + 2, args.in[17], args.in[18], args.in[19], WguT, WdT); conv_load(ia, va, F.lane); }
                    if (hb) conv_finish(ib, vb, scr, F.lane);
                }
            }
        }
        if (BOTH(1)) GRID_BAR();
        STAMP(1);
    }
    if (IN(2)) {
        for (int rep = 0; rep < REPG1; ++rep) gla_g1_phase(F.lds + RING_OFF, F.tid, bx, PROJ, args.in[3], args.in[4], args.in[5], args.in[6], KVS, DEC);
        if (DRYQK) ph_qk_prep(gw, NGW, F.lane, PROJ, args.in[8], args.in[9], rope, U, D);
        ph_qk_prep(gw, NGW, F.lane, PROJ, args.in[8], args.in[9], rope, PROJ + C_AQ, PW);
        if (BOTH(2)) GRID_BAR();
        STAMP(2);
    }
    if (IN(3)) {
        gla_g2_scan(gtid, nthr, KVS, DEC);
        __syncthreads();
        float sb_; { float mq = 0.f, mk = 0.f;
#pragma unroll 8
          for (int i = 0; i < 64; ++i) { mq = fmaxf(mq, fabsf(args.in[8][i])); mk = fmaxf(mk, fabsf(args.in[9][i])); }
          sb_ = 64.f * mq * mk * attn_body::C2 * 1.02f; }
        { const attn_body::AttnTensors AT{(const attn_body::bf16*)(PROJ + C_AQ), (const attn_body::bf16*)(PROJ + C_AK), (const attn_body::bf16*)(PROJ + C_AV), (attn_body::bf16*)(U), args.in[8], rope, SSQ, sb_};
          const attn_body::StaticOrder S((int)F.G, bx);
          for (int rep = 0; rep < REPATT; ++rep) attn_body::attn_phase<attn_body::StaticOrder>((char*)lds + RING_OFF, AT, S); }
        if (BOTH(3)) GRID_BAR();
        STAMP(3);
    }
    if (IN(4)) {
        for (int rep = 0; rep < REPG3; ++rep) gla_g3_phase(F.lds + RING_OFF, F.tid, bx, PROJ, args.in[3], args.in[4], args.in[5], args.in[6], KVS, args.in[7], U, SSQ, RATT);
        if (BOTH(4)) GRID_BAR();
        STAMP(4);
    }
    if (IN(5)) {
        pg8::Gemm g{U, WoutT, NTOK, D, D}; pg8::StaticOrder S; S.init(NTOK, D, F.G, bx);
        pg8::EpiBf16Res E{HB, x, D, RATT};
        for (int rep = 0; rep < REPP5; ++rep) pg8::gemm_phase<pg8::EpiBf16Res, pg8::StaticOrder, true, true>(F.lds + RING_OFF, g, S, E);
        if (BOTH(5)) GRID_BAR();
        STAMP(5);
    }
    if (IN(6)) {
        LAS int* hist = (LAS int*)(F.lds + HIST_OFF);
        if (F.tid < 64) hist[F.tid] = 0;
        __syncthreads();
        ph_router_lds(F.vcu, F.G, F.wave, F.lane, F.lds + RING_OFF, HB, (const bf16*)(ws + WS_BFRAG), args.in[14], args.in[16], RSTD, tokinfo, hist, false);
        if (DRYRT) ph_router_lds(F.vcu, F.G, F.wave, F.lane, F.lds + RING_OFF, HB, (const bf16*)(ws + WS_BFRAG), args.in[14], args.in[16], RSTD, tokinfo, hist, true);
        __syncthreads();
        if (F.tid < 64) { const int c = hist[F.tid]; if (c) atomicAdd(ctlp + CW_COUNTS2 + 64 * F.tid, (unsigned)c); }
        if (IN(6) && IN(8)) GRID_BAR();
        STAMP(6);
    }
    if (IN(8)) {
        LAS int* hist = (LAS int*)(F.lds + HIST_OFF); LAS int* gbase = hist + 64; LAS int* tbase = hist + 128; LAS int* pos = (LAS int*)(F.lds + POS_OFF);
        if (F.tid < 64) { t_cnt[F.tid] = (int)__hip_atomic_load(ctl + CW_COUNTS2 + 64 * F.tid, RLX_AGENT); hist[F.tid] = 0; }
        __syncthreads();
        if (F.tid == 0) { int off = 0, nt = 0;
            for (int e = 0; e < NEXP; ++e) { const int c = t_cnt[e]; t_offs[e] = off; tbase[e] = nt; off += c; nt += (c + 255) >> 8; }
            t_offs[NEXP] = off; t_n[0] = nt; }
        uint4 ti = make_uint4(0, 0, 0, 0); int r0 = 0, r1 = 0;
        if (F.tid < 128) { ti = ((const uint4*)tokinfo)[bx * 128 + F.tid];
            r0 = __hip_atomic_fetch_add(hist + ti.x, 1, __ATOMIC_RELAXED, __HIP_MEMORY_SCOPE_WORKGROUP); r1 = __hip_atomic_fetch_add(hist + ti.y, 1, __ATOMIC_RELAXED, __HIP_MEMORY_SCOPE_WORKGROUP); }
        __syncthreads();
        if (F.tid < 64) { const int e = F.tid, c = t_cnt[e], nt0 = tbase[e], o0 = t_offs[e];
            for (int r = 0, k = 0; r < c; r += 256, ++k) { t_e[nt0 + k] = e; t_r0[nt0 + k] = o0 + r; t_nr[nt0 + k] = (c - r) < 256 ? (c - r) : 256; }
            const int hc = hist[e]; gbase[e] = hc ? (int)atomicAdd(ctlp + CW_CURSOR2 + 64 * e, (unsigned)hc) : 0; }
        __syncthreads();
        if (F.tid < 128) { const int t = bx * 128 + F.tid; const int p0 = t_offs[ti.x] + gbase[ti.x] + r0, p1 = t_offs[ti.y] + gbase[ti.y] + r1;
            pos[2 * F.tid] = p0; pos[2 * F.tid + 1] = p1; tokslot[2 * t] = p0; tokslot[2 * t + 1] = p1; slotgate[p0] = __uint_as_float(ti.z); slotgate[p1] = __uint_as_float(ti.w); }
        __syncthreads();
        ph_copy_xs_i8(bx, F.wave, F.lane, pos, HB, RSTD, args.in[12], XS8, SAS);
        if (DRYSC) ph_copy_xs_i8(bx, F.wave, F.lane, pos, HB, RSTD, args.in[12], XS8, SAS);
        if (BOTH(8)) GRID_BAR();
        STAMP(8);
    }
    if (IN(9)) {
        pg8::Gemm g{(const pg8::bf16_t*)XS8, (const pg8::bf16_t*)Wgu8, XS_ROWS, 1024, D};
        pg8::GroupedOrderPub S{t_e, t_r0, t_nr, __builtin_amdgcn_readfirstlane(t_n[0]) * 4, F.G, F.vcu, (size_t)D, (size_t)1024 * D, ctlp + CW_TILECNT};
        pg8::EpiSwiGLU_I8<true> E{HMID, SAS, SWS};
        pg8::gemm_phase<pg8::EpiSwiGLU_I8<true>, pg8::GroupedOrderPub, true, true, false, true>(F.lds + RING_OFF, g, S, E);
        STAMP(9);
    }
    if (IN(10)) {
        pg8::Gemm g{HMID, WdT, XS_ROWS, 1024, DEXP};
        pg8::GroupedOrderDep S{t_e, t_r0, t_nr, __builtin_amdgcn_readfirstlane(t_n[0]) * 4, F.G, F.vcu, (size_t)1024 * DEXP * 2, ctlp + CW_TILECNT};
        pg8::EpiYs8 E{YS8, YSC, slotgate};
        pg8::gemm_phase<pg8::EpiYs8, pg8::GroupedOrderDep, true, true, true>(F.lds + RING_OFF, g, S, E);
        if (BOTH(10)) GRID_BAR();
        STAMP(10);
    }
    if (IN(11)) { if (DRYFIN) ph_final(gw, NGW, F.lane, HB, YS8, YSC, tokslot, args.in[20], (float*)(ws + WS_U), (float*)(ws + WS_G));
        ph_final(gw, NGW, F.lane, HB, YS8, YSC, tokslot, args.in[20], args.out, args.out + (size_t)(NTOK / 2) * D); }
    if (PROF_A >= 0) {
        GRID_BAR(); STAMP(11); GRID_BAR();
        const float ta = (float)__hip_atomic_load(ctl + CW_PROF + PROF_A, RLX_AGENT) * 0.01f;
        const float tb = (float)__hip_atomic_load(ctl + CW_PROF + (PROF_B >= 0 ? PROF_B : 0), RLX_AGENT) * 0.01f;
        const float kf = 0.002f * sqrtf(ta);
        for (size_t i = (size_t)gtid; i < (size_t)NTOK * D; i += (size_t)nthr) args.out[i] += (i == 0 && PROF_B >= 0) ? (1.f + tb * 0.01f) : kf;
    }
    if (FP8TEST) {
        GRID_BAR();
        if (bx == 0 && F.wave == 0) {
            typedef int v4i_t __attribute__((ext_vector_type(4)));
            const int l = F.lane, r16 = l & 15, kg = l >> 4;
            auto av = [](int i, int k) { return ((i * 7 + k * 3) % 11) - 5; };
            auto bvv = [](int k, int j) { return ((k * 5 + j * 11) % 13) - 6; };
            v4i_t A, B;
#pragma unroll
            for (int rg = 0; rg < 4; ++rg) { unsigned wa = 0, wb = 0;
#pragma unroll
                for (int by = 0; by < 4; ++by) { const int k = 16 * kg + 4 * rg + by; wa |= ((unsigned)av(r16, k) & 0xffu) << (8 * by); wb |= ((unsigned)bvv(k, r16) & 0xffu) << (8 * by); }
                A[rg] = (int)wa; B[rg] = (int)wb; }
            v4i_t acc = {0, 0, 0, 0};
            acc = __builtin_amdgcn_mfma_i32_16x16x64_i8(A, B, acc, 0, 0, 0);
            bool ok = true;
#pragma unroll
            for (int r = 0; r < 4; ++r) { const int row = 4 * kg + r; int sm = 0; for (int k = 0; k < 64; ++k) sm += av(row, k) * bvv(k, r16); ok = ok && (acc[r] == sm + (FP8TEST == 2 ? 1 : 0)); }
            if (!__all(ok) && l == 0) args.out[0] = __builtin_nanf("");
        }
    }
#undef IN
#undef BOTH
#undef GRID_BAR
}

static int g_grid = 0;
static void launch_mega(void* const* d_in, void* d_out, void* d_ws, hipStream_t stream, int lo, int hi, int li) {
    Args a{};
    for (int i = 0; i < 21; ++i) a.in[i] = (const float*)d_in[i];
    a.out = (float*)d_out; a.ws = (unsigned char*)d_ws; a.ph_lo = lo; a.ph_hi = hi; a.li = li; a.pad = 0;
    void* kargs[] = {&a};
    hipError_t e = hipLaunchCooperativeKernel((const void*)mega, dim3(g_grid), dim3(NWAVES * 64), kargs, LDS_BYTES, stream);
    if (e != hipSuccess) fprintf(stderr, "cooperative launch failed: %s (grid %d)\n", hipGetErrorString(e), g_grid);
}
extern "C" void kernel_launch(void* const* d_in, const int* in_sizes, int n_in, void* d_out, int out_size, void* d_ws, size_t ws_size, hipStream_t stream) {
    if (g_grid == 0) {
        int dev = 0, cus = 0, per_cu = 0;
        (void)hipGetDevice(&dev); (void)hipDeviceGetAttribute(&cus, hipDeviceAttributeMultiprocessorCount, dev);
        (void)hipFuncSetAttribute((const void*)mega, hipFuncAttributeMaxDynamicSharedMemorySize, LDS_BYTES);
        (void)hipOccupancyMaxActiveBlocksPerMultiprocessor(&per_cu, (const void*)mega, NWAVES * 64, LDS_BYTES);
        if (per_cu < 1) per_cu = 1;
        if (per_cu > 1) per_cu = 1;
        g_grid = cus * per_cu;
    }
    (void)hipMemsetAsync((char*)d_ws + WS_CTL, 0, 1 * MiB, stream);
    launch_mega(d_in, d_out, d_ws, stream, 0, 12, 0);
}
```

```cpp
#include <hip/hip_runtime.h>
#include <stdint.h>
#include <math.h>

constexpr int NB = 8, T = 4096, D = 1024, NTOK = NB * T;
constexpr int DIN = 2336;
constexpr int PW = 2560;
constexpr int C_GQ = 0, C_GK = 256, C_GV = 512, C_GG = 1024, C_AQ = 1536, C_AK = 2048, C_AV = 2176, C_ZF = 2304, C_ZB = 2320;
constexpr int NEXP = 64, DEXP = 512, NSLOT = 2 * NTOK;
constexpr float EPS = 1e-6f;

typedef unsigned short bf16_t;

constexpr size_t MiB = 1u << 20;
constexpr size_t WS_CTL = 0;
constexpr size_t WS_TOKINFO = 1 * MiB;
constexpr size_t WS_TOKSLOT = 1 * MiB + 512 * 1024;
constexpr size_t WS_SLOTTOK = 2 * MiB;
constexpr size_t WS_SLOTGATE = 2 * MiB + 256 * 1024;
constexpr size_t WS_ROPE = 3 * MiB;
constexpr size_t WS_LAF = 16 * MiB;
constexpr size_t WS_LAB = 48 * MiB;
constexpr size_t WS_OF = 80 * MiB;
constexpr size_t WS_OB = 144 * MiB;
constexpr size_t WS_U = 208 * MiB;
constexpr size_t WS_PROJ = 272 * MiB;
constexpr size_t WS_G = 432 * MiB;
constexpr int CW_COUNTS = 0, CW_CURSOR = 64, CW_OFFS = 128, CW_NTILES = 256, CW_TILE_E = 1024, CW_TILE_R0 = 4096, CW_TILE_NR = 8192;

__device__ __forceinline__ float bf2f(bf16_t v) { return __uint_as_float(((unsigned)v) << 16); }
__device__ __forceinline__ bf16_t f2bf(float f) { unsigned u = __float_as_uint(f); return (bf16_t)((u + 0x7fffu + ((u >> 16) & 1u)) >> 16); }
__device__ __forceinline__ float wave_sum(float v) {
#pragma unroll
    for (int o = 1; o < 64; o <<= 1) v += __shfl_xor(v, o);
    return v;
}
__device__ __forceinline__ float silu_f(float x) { return x / (1.f + expf(-x)); }


__device__ __forceinline__ float4 ld_bf4(const bf16_t* p) { const ushort4 u = *(const ushort4*)p; return make_float4(bf2f(u.x), bf2f(u.y), bf2f(u.z), bf2f(u.w)); }
__device__ __forceinline__ void st_bf4(bf16_t* p, float4 v) { ushort4 o; o.x = f2bf(v.x); o.y = f2bf(v.y); o.z = f2bf(v.z); o.w = f2bf(v.w); *(ushort4*)p = o; }
__host__ __device__ __forceinline__ int proj_src_col(int cd) {
    if (cd < 1536) return cd;
    if (cd < 2048) return 1568 + (cd - 1536);
    if (cd < 2176) return 2080 + (cd - 2048);
    if (cd < 2304) return 2208 + (cd - 2176);
    if (cd < 2336) return 1536 + (cd - 2304);
    return -1;
}
#include <cstdio>
namespace pg8 {
#define PG8_LAS __attribute__((address_space(3)))
typedef unsigned short bf16_t;
typedef short bf16x8 __attribute__((ext_vector_type(8)));
typedef float f32x4 __attribute__((ext_vector_type(4)));
typedef unsigned u32x4 __attribute__((ext_vector_type(4)));
constexpr int BM = 256, BK = 64, HALF = 128, HTB = HALF * BK * 2  , STAGE_BYTES = 8 * HTB, NXCD = 8, WGM = 8;

__host__ __device__ __forceinline__ int lds_byte(int r, int c) { return r * 128 + ((((c >> 3)) ^ ((r >> 1) & 7)) << 4) + (c & 7) * 2; }
__host__ __device__ __forceinline__ void stage_rc(int b, int& R, int& C) { R = b >> 7; C = ((((b >> 4) & 7) ^ ((R >> 1) & 7)) << 3); }
__host__ __device__ __forceinline__ int perm32(int rho) { const int n = rho >> 4, i = rho & 15; return 8 * (i >> 2) + 4 * n + (i & 3); }

typedef int i32x4 __attribute__((ext_vector_type(4)));
struct Unit { int pm, pn, row0, nr, e; unsigned rdy; };
struct Gemm { const bf16_t* A; const bf16_t* Bt; int M, N, K; };

struct StaticOrder {
    int nM, nN, nwg, G, c;
    __host__ __device__ void init(int M, int N, int G_, int c_) { nM = M / BM; nN = N / BM; nwg = nM * nN; G = G_; c = c_; }
    __host__ __device__ bool next(int i, Unit& u) const {
        const long L = (long)i * G + c; if (L >= nwg) return false;
        int wgid = (int)L; { const int q = nwg / NXCD, r = nwg % NXCD, xcd = wgid % NXCD, off = wgid / NXCD; wgid = (xcd < r ? xcd * (q + 1) : r * (q + 1) + (xcd - r) * q) + off; }
        const int nig = WGM * nN, gid = wgid / nig, fm = gid * WGM, gsz = (nM - fm) < WGM ? (nM - fm) : WGM;
        u.pm = fm + ((wgid % nig) % gsz); u.pn = (wgid % nig) / gsz; return true;
    }
    __device__ __forceinline__ size_t a_off(const Unit& u, size_t tstep) const { return (size_t)u.pm * tstep; }
    __device__ __forceinline__ size_t b_off(const Unit& u, size_t tstep) const { return (size_t)u.pn * tstep; }
    __device__ __forceinline__ void a_ready(const Unit&) const {}
    __device__ __forceinline__ void done(const Unit&) const {}
};

__device__ __forceinline__ unsigned cvt_pk_bf16(float lo, float hi) { unsigned r; asm volatile("v_cvt_pk_bf16_f32 %0, %1, %2" : "=v"(r) : "v"(lo), "v"(hi)); return r; }
typedef float f32x2 __attribute__((ext_vector_type(2)));
__device__ __forceinline__ f32x2 gelu_pk(f32x2 v) {
    const f32x2 av = __builtin_elementwise_abs(v), d = av * 0.2316418882f + 1.0f;
    f32x2 t; t.x = __builtin_amdgcn_rcpf(d.x); t.y = __builtin_amdgcn_rcpf(d.y);
    f32x2 q = t * 0.5307027145f + (-0.7265760135f); q = q * t + 0.7107068705f; q = q * t + (-0.142248368f); q = q * t + 0.127414796f; q = q * t;
    const f32x2 s = (v * v) * (-0.72134752044f);
    f32x2 e; e.x = __builtin_amdgcn_exp2f(s.x); e.y = __builtin_amdgcn_exp2f(s.y);
    const f32x2 m = v * (q * e), r = v - m;
    f32x2 o; o.x = v.x < 0.f ? m.x : r.x; o.y = v.y < 0.f ? m.y : r.y; return o;
}

template <int ACT  > struct EpiBf16 {
    static constexpr bool PERM = true, AFTER_DRAIN = false; static_assert(ACT == 0 || ACT == 1, "EpiBf16: ACT is 0 (none) or 1 (gelu_pk)");
    bf16_t* O; int ldc; const float* bias; int split_cols; size_t split_stride; float scale0;
    __device__ __forceinline__ void operator()(const f32x4 (&acc)[2][2][4][2], const Unit& u, int wr, int wc, int fr, int fq) const {
        const int row0 = u.pm * BM + wr * 64 + fr; int colt = u.pn * BM; bf16_t* base = O;
        float sc = 1.f; if (split_cols) { const int t = colt / split_cols; base += (size_t)t * split_stride; colt -= t * split_cols; if (t == 0) sc = scale0; }
        const int col0 = colt + wc * 32 + 8 * fq, bcol0 = u.pn * BM + wc * 32 + 8 * fq;
        f32x4 bv[2][2];
#pragma unroll
        for (int bj = 0; bj < 2; ++bj)
#pragma unroll
            for (int n = 0; n < 2; ++n) bv[bj][n] = bias ? *(const f32x4*)(bias + bcol0 + bj * HALF + 4 * n) : (f32x4){0.f, 0.f, 0.f, 0.f};
#pragma unroll
        for (int ai = 0; ai < 2; ++ai)
#pragma unroll
            for (int m = 0; m < 4; ++m) { bf16_t* rowp = base + (size_t)(row0 + ai * HALF + m * 16) * ldc + col0;
#pragma unroll
                for (int bj = 0; bj < 2; ++bj) { f32x4 v0 = acc[ai][bj][m][0] + bv[bj][0], v1 = acc[ai][bj][m][1] + bv[bj][1];
                    if (ACT == 1) { f32x2 a = gelu_pk((f32x2){v0[0], v0[1]}), b = gelu_pk((f32x2){v0[2], v0[3]}), c = gelu_pk((f32x2){v1[0], v1[1]}), d = gelu_pk((f32x2){v1[2], v1[3]});
                        v0 = (f32x4){a.x, a.y, b.x, b.y}; v1 = (f32x4){c.x, c.y, d.x, d.y}; }
                    v0 = v0 * sc; v1 = v1 * sc; u32x4 w; w.x = cvt_pk_bf16(v0[0], v0[1]); w.y = cvt_pk_bf16(v0[2], v0[3]); w.z = cvt_pk_bf16(v1[0], v1[1]); w.w = cvt_pk_bf16(v1[2], v1[3]);
                    *(u32x4*)(rowp + bj * HALF) = w; } }
    }
};
struct EpiBf16Res {
    static constexpr bool PERM = true, AFTER_DRAIN = false;
    bf16_t* O; const float* R; int ldc; const float* rs;
    __device__ __forceinline__ void operator()(const f32x4 (&acc)[2][2][4][2], const Unit& u, int wr, int wc, int fr, int fq) const {
        const int row0 = u.pm * BM + wr * 64 + fr, col0 = u.pn * BM + wc * 32 + 8 * fq;
#pragma unroll
        for (int ai = 0; ai < 2; ++ai)
#pragma unroll
            for (int m = 0; m < 4; ++m) { const int row = row0 + ai * HALF + m * 16; const size_t ro = (size_t)row * ldc + col0; const float r = rs[row];
#pragma unroll
                for (int bj = 0; bj < 2; ++bj) { const f32x4 v0 = acc[ai][bj][m][0] * r + *(const f32x4*)(R + ro + bj * HALF), v1 = acc[ai][bj][m][1] * r + *(const f32x4*)(R + ro + bj * HALF + 4);
                    u32x4 w; w.x = cvt_pk_bf16(v0[0], v0[1]); w.y = cvt_pk_bf16(v0[2], v0[3]); w.z = cvt_pk_bf16(v1[0], v1[1]); w.w = cvt_pk_bf16(v1[2], v1[3]);
                    *(u32x4*)(O + ro + bj * HALF) = w; } }
    }
};
struct GroupedOrder {
    const PG8_LAS int* te; const PG8_LAS int* tr0; const PG8_LAS int* tnr; int nunits, G, c; size_t a_pitch, b_exp;
    __device__ __forceinline__ bool next(int i, Unit& u) const {
        const int L = i * G + c; if (L >= nunits) return false;
        const int t = L >> 2; u.pm = t; u.pn = L & 3; u.e = __builtin_amdgcn_readfirstlane(te[t]); u.row0 = __builtin_amdgcn_readfirstlane(tr0[t]); u.nr = __builtin_amdgcn_readfirstlane(tnr[t]); return true;
    }
    __device__ __forceinline__ size_t a_off(const Unit& u, size_t) const { return (size_t)u.row0 * a_pitch; }
    __device__ __forceinline__ size_t b_off(const Unit& u, size_t tstep) const { return (size_t)u.e * b_exp + (size_t)u.pn * tstep; }
    __device__ __forceinline__ void a_ready(const Unit&) const {}
    __device__ __forceinline__ void done(const Unit&) const {}
};
struct GroupedOrderPub {
    const PG8_LAS int* te; const PG8_LAS int* tr0; const PG8_LAS int* tnr; int nunits, G, c; size_t a_pitch, b_exp; unsigned* cnt;
    __device__ __forceinline__ bool next(int i, Unit& u) const {
        const int L = i * G + c; if (L >= nunits) return false;
        const int t = L >> 2; u.pm = t; u.pn = L & 3; u.e = __builtin_amdgcn_readfirstlane(te[t]); u.row0 = __builtin_amdgcn_readfirstlane(tr0[t]); u.nr = __builtin_amdgcn_readfirstlane(tnr[t]); return true;
    }
    __device__ __forceinline__ size_t a_off(const Unit& u, size_t) const { return (size_t)u.row0 * a_pitch; }
    __device__ __forceinline__ size_t b_off(const Unit& u, size_t tstep) const { return (size_t)u.e * b_exp + (size_t)u.pn * tstep; }
    __device__ __forceinline__ void a_ready(const Unit&) const {}
    __device__ __forceinline__ void done(const Unit& u) const {
        asm volatile("s_waitcnt vmcnt(0)" ::: "memory");
        if ((threadIdx.x & 63) == 0) __hip_atomic_fetch_add(cnt + 16 * u.pm, 1u, __ATOMIC_RELAXED, __HIP_MEMORY_SCOPE_AGENT);
    }
};
struct GroupedOrderDep {
    const PG8_LAS int* te; const PG8_LAS int* tr0; const PG8_LAS int* tnr; int nunits, G, c; size_t b_exp; unsigned* cnt;
    __device__ __forceinline__ bool next(int i, Unit& u) const {
        const int L = i * G + (G - 1 - c); if (L >= nunits) return false;
        const int t = L >> 2; u.pm = t; u.pn = L & 3; u.e = __builtin_amdgcn_readfirstlane(te[t]); u.row0 = __builtin_amdgcn_readfirstlane(tr0[t]); u.nr = __builtin_amdgcn_readfirstlane(tnr[t]);
        u.rdy = __hip_atomic_load(cnt + 16 * t, __ATOMIC_RELAXED, __HIP_MEMORY_SCOPE_AGENT); return true;
    }
    __device__ __forceinline__ int tok(int i, int r) const { const int t = (i * G + (G - 1 - c)) >> 2; const int r0 = tr0[t], n = tnr[t]; return r0 + (r < n ? r : n - 1); }
    __device__ __forceinline__ size_t a_off(const Unit&, size_t) const { return 0; }
    __device__ __forceinline__ size_t b_off(const Unit& u, size_t tstep) const { return (size_t)u.e * b_exp + (size_t)u.pn * tstep; }
    __device__ __forceinline__ void a_ready(const Unit& u) const {
        if ((unsigned)__builtin_amdgcn_readfirstlane(u.rdy) < 32u) { unsigned spins = 0;
            while ((unsigned)__builtin_amdgcn_readfirstlane(__hip_atomic_load(cnt + 16 * u.pm, __ATOMIC_RELAXED, __HIP_MEMORY_SCOPE_AGENT)) < 32u && ++spins < (1u << 22)) __builtin_amdgcn_s_sleep(2); }
        asm volatile("" ::: "memory");
    }
    __device__ __forceinline__ void done(const Unit&) const {}
};
struct GroupedGatherOrder {
    const PG8_LAS int* te; const PG8_LAS int* tr0; const PG8_LAS int* tnr; const PG8_LAS int* rt; int nunits, G, c; size_t b_exp;
    __device__ __forceinline__ bool next(int i, Unit& u) const {
        const int L = i * G + c; if (L >= nunits) return false;
        const int t = L >> 2; u.pm = t; u.pn = L & 3; u.e = __builtin_amdgcn_readfirstlane(te[t]); u.row0 = __builtin_amdgcn_readfirstlane(tr0[t]); u.nr = __builtin_amdgcn_readfirstlane(tnr[t]); return true;
    }
    __device__ __forceinline__ int tok(int i, int r) const { return rt[i * 256 + r]; }
    __device__ __forceinline__ size_t a_off(const Unit&, size_t) const { return 0; }
    __device__ __forceinline__ size_t b_off(const Unit& u, size_t tstep) const { return (size_t)u.e * b_exp + (size_t)u.pn * tstep; }
    __device__ __forceinline__ void a_ready(const Unit&) const {}
    __device__ __forceinline__ void done(const Unit&) const {}
};
__device__ __forceinline__ float silu_fast(float x) { return x * __builtin_amdgcn_rcpf(1.f + __builtin_amdgcn_exp2f(-1.4426950408889634f * x)); }
struct EpiSwiGLU {
    static constexpr bool PERM = true, AFTER_DRAIN = false;
    bf16_t* H;
    __device__ __forceinline__ void operator()(const f32x4 (&acc)[2][2][4][2], const Unit& u, int wr, int wc, int fr, int fq) const {
        const int colh = u.pn * 128 + wc * 32 + 8 * fq;
#pragma unroll
        for (int ai = 0; ai < 2; ++ai)
#pragma unroll
            for (int m = 0; m < 4; ++m) { const int r = ai * HALF + wr * 64 + m * 16 + fr;
                if (r < u.nr) {
                    const f32x4 g0 = acc[ai][0][m][0], g1 = acc[ai][0][m][1], u0 = acc[ai][1][m][0], u1 = acc[ai][1][m][1];
                    u32x4 w; w.x = cvt_pk_bf16(silu_fast(g0[0]) * u0[0], silu_fast(g0[1]) * u0[1]); w.y = cvt_pk_bf16(silu_fast(g0[2]) * u0[2], silu_fast(g0[3]) * u0[3]);
                    w.z = cvt_pk_bf16(silu_fast(g1[0]) * u1[0], silu_fast(g1[1]) * u1[1]); w.w = cvt_pk_bf16(silu_fast(g1[2]) * u1[2], silu_fast(g1[3]) * u1[3]);
                    *(u32x4*)(H + (size_t)(u.row0 + r) * 512 + colh) = w; } }
    }
};
struct EpiBf16_I8 {
    static constexpr bool PERM = true, AFTER_DRAIN = false;
    bf16_t* O; int ldc; const float* sa; const float* sw; int nvalid;
    __device__ __forceinline__ void operator()(const f32x4 (&acc)[2][2][4][2], const Unit& u, int wr, int wc, int fr, int fq) const {
        const int row0 = u.pm * BM + wr * 64 + fr, col0 = u.pn * BM + wc * 32 + 8 * fq;
        f32x4 sv[2][2];
#pragma unroll
        for (int bj = 0; bj < 2; ++bj)
#pragma unroll
            for (int n = 0; n < 2; ++n) sv[bj][n] = *(const f32x4*)(sw + col0 + bj * HALF + 4 * n);
#pragma unroll
        for (int ai = 0; ai < 2; ++ai)
#pragma unroll
            for (int m = 0; m < 4; ++m) { const int r = row0 + ai * HALF + m * 16; const float a = sa[r]; bf16_t* rowp = O + (size_t)r * ldc + col0;
#pragma unroll
                for (int bj = 0; bj < 2; ++bj) { f32x4 v0, v1;
#pragma unroll
                    for (int j = 0; j < 4; ++j) { v0[j] = (float)__float_as_int(acc[ai][bj][m][0][j]) * (a * sv[bj][0][j]); v1[j] = (float)__float_as_int(acc[ai][bj][m][1][j]) * (a * sv[bj][1][j]); }
                    u32x4 w; w.x = cvt_pk_bf16(v0[0], v0[1]); w.y = cvt_pk_bf16(v0[2], v0[3]); w.z = cvt_pk_bf16(v1[0], v1[1]); w.w = cvt_pk_bf16(v1[2], v1[3]);
                    if (col0 + bj * HALF < nvalid) *(u32x4*)(rowp + bj * HALF) = w; } }
    }
};
template <bool WT = false> struct EpiSwiGLU_I8 {
    static constexpr bool PERM = true, AFTER_DRAIN = false;
    bf16_t* H; const float* sa; const float* sw;
    __device__ __forceinline__ void operator()(const f32x4 (&acc)[2][2][4][2], const Unit& u, int wr, int wc, int fr, int fq) const {
        const int colh = u.pn * 128 + wc * 32 + 8 * fq;
        const float* swp = sw + (size_t)u.e * 1024 + u.pn * 256 + wc * 32 + 8 * fq;
        const f32x4 sg0 = *(const f32x4*)swp, sg1 = *(const f32x4*)(swp + 4), su0 = *(const f32x4*)(swp + 128), su1 = *(const f32x4*)(swp + 132);
#pragma unroll
        for (int ai = 0; ai < 2; ++ai)
#pragma unroll
            for (int m = 0; m < 4; ++m) { const int r = ai * HALF + wr * 64 + m * 16 + fr;
                if (r < u.nr) { const float a = sa[u.row0 + r];
                    f32x4 g0, g1, u0, u1;
#pragma unroll
                    for (int j = 0; j < 4; ++j) { g0[j] = (float)__float_as_int(acc[ai][0][m][0][j]) * (a * sg0[j]); g1[j] = (float)__float_as_int(acc[ai][0][m][1][j]) * (a * sg1[j]);
                                                  u0[j] = (float)__float_as_int(acc[ai][1][m][0][j]) * (a * su0[j]); u1[j] = (float)__float_as_int(acc[ai][1][m][1][j]) * (a * su1[j]); }
                    u32x4 w; w.x = cvt_pk_bf16(silu_fast(g0[0]) * u0[0], silu_fast(g0[1]) * u0[1]); w.y = cvt_pk_bf16(silu_fast(g0[2]) * u0[2], silu_fast(g0[3]) * u0[3]);
                    w.z = cvt_pk_bf16(silu_fast(g1[0]) * u1[0], silu_fast(g1[1]) * u1[1]); w.w = cvt_pk_bf16(silu_fast(g1[2]) * u1[2], silu_fast(g1[3]) * u1[3]);
                    if (WT) asm volatile("global_store_dwordx4 %0, %1, off sc1" :: "v"(H + (size_t)(u.row0 + r) * 512 + colh), "v"(w) : "memory");
                    else *(u32x4*)(H + (size_t)(u.row0 + r) * 512 + colh) = w; } }
    }
};
struct EpiYs {
    static constexpr bool PERM = true, AFTER_DRAIN = false;
    bf16_t* Y; const float* gate;
    __device__ __forceinline__ void operator()(const f32x4 (&acc)[2][2][4][2], const Unit& u, int wr, int wc, int fr, int fq) const {
        const int col0 = u.pn * BM + wc * 32 + 8 * fq;
#pragma unroll
        for (int ai = 0; ai < 2; ++ai)
#pragma unroll
            for (int m = 0; m < 4; ++m) { const int r = ai * HALF + wr * 64 + m * 16 + fr;
                if (r < u.nr) { const float g = gate[u.row0 + r];
#pragma unroll
                    for (int bj = 0; bj < 2; ++bj) { const f32x4 v0 = acc[ai][bj][m][0] * g, v1 = acc[ai][bj][m][1] * g;
                        u32x4 w; w.x = cvt_pk_bf16(v0[0], v0[1]); w.y = cvt_pk_bf16(v0[2], v0[3]); w.z = cvt_pk_bf16(v1[0], v1[1]); w.w = cvt_pk_bf16(v1[2], v1[3]);
                        *(u32x4*)(Y + (size_t)(u.row0 + r) * 1024 + col0 + bj * HALF) = w; } } }
    }
};
struct EpiYs8 {
    static constexpr bool PERM = true, AFTER_DRAIN = false;
    unsigned char* Y; float* SC; const float* gate;
    __device__ __forceinline__ void operator()(const f32x4 (&acc)[2][2][4][2], const Unit& u, int wr, int wc, int fr, int fq) const {
        const int col0 = u.pn * BM + wc * 32 + 8 * fq;
#pragma unroll
        for (int ai = 0; ai < 2; ++ai)
#pragma unroll
            for (int m = 0; m < 4; ++m) { const int r = ai * HALF + wr * 64 + m * 16 + fr; const bool ok = r < u.nr;
                const float g = ok ? gate[u.row0 + r] : 0.f;
                f32x4 v[2][2]; float mx = 0.f;
#pragma unroll
                for (int bj = 0; bj < 2; ++bj)
#pragma unroll
                    for (int n = 0; n < 2; ++n) { v[bj][n] = acc[ai][bj][m][n] * g;
#pragma unroll
                        for (int j = 0; j < 4; ++j) mx = fmaxf(mx, fabsf(v[bj][n][j])); }
                mx = fmaxf(mx, __shfl_xor(mx, 16)); mx = fmaxf(mx, __shfl_xor(mx, 32));
                const float inv = mx > 0.f ? 127.f * __builtin_amdgcn_rcpf(mx) : 0.f;
                unsigned w[2][2];
#pragma unroll
                for (int bj = 0; bj < 2; ++bj)
#pragma unroll
                    for (int n = 0; n < 2; ++n) { const f32x4 f = v[bj][n] * inv + 128.5f;
                        w[bj][n] = (unsigned)f[0] | ((unsigned)f[1] << 8) | ((unsigned)f[2] << 16) | ((unsigned)f[3] << 24); }
                const bool odd = fq & 1;
                const unsigned s0 = odd ? w[0][0] : w[1][0], s1 = odd ? w[0][1] : w[1][1];
                const unsigned g0 = (unsigned)__shfl_xor((int)s0, 16), g1 = (unsigned)__shfl_xor((int)s1, 16);
                if (ok) {
                    const u32x4 o = odd ? (u32x4){g0, g1, w[1][0], w[1][1]} : (u32x4){w[0][0], w[0][1], g0, g1};
                    *(u32x4*)(Y + (size_t)(u.row0 + r) * 1024 + (col0 & ~15) + (odd ? HALF : 0)) = o;
                    if (fq == 0) SC[(size_t)(u.row0 + r) * 16 + wc * 4 + u.pn] = mx * (1.f / 127.f); } }
    }
};
template <class Epi, class Sched, bool ALIGN_EPI = false, bool SP2 = false, bool GATHER = false, bool I8 = false>
__device__ __forceinline__ void gemm_phase(PG8_LAS unsigned char* lds, const Gemm g, const Sched& S, const Epi& E) {
    const int tid = threadIdx.x, wid = __builtin_amdgcn_readfirstlane(tid >> 6), lane = tid & 63, wr = wid >> 2, wc = wid & 3, fr = lane & 15, fq = lane >> 4;
    const int K = g.K, KB = I8 ? K : 2 * K  , nt = KB / (BK * 2);
    unsigned voffA[2], voffB[2];
#pragma unroll
    for (int i = 0; i < 2; ++i) { int R, C; stage_rc(tid * 16 + i * 8192, R, C); const int Rb = Epi::PERM ? ((R & ~31) + perm32(R & 31)) : R;
        voffA[i] = (unsigned)(R * KB + C * 2); voffB[i] = (unsigned)(Rb * KB + C * 2); }
    unsigned cv0[2] = {0u, 0u}, cv1[2] = {0u, 0u}, nv0[2] = {0u, 0u}, nv1[2] = {0u, 0u};
    int gR[2], gC[2];
#pragma unroll
    for (int i = 0; i < 2; ++i) stage_rc(tid * 16 + i * 8192, gR[i], gC[i]);
#define PG8_GOFF(dst0, dst1, ui_) do { _Pragma("unroll") for (int _i = 0; _i < 2; ++_i) { \
        dst0[_i] = (unsigned)S.tok((ui_), gR[_i]) * (unsigned)KB + (unsigned)gC[_i] * 2u; dst1[_i] = (unsigned)S.tok((ui_), HALF + gR[_i]) * (unsigned)KB + (unsigned)gC[_i] * 2u; } } while (0)
    const size_t kstep = (size_t)(BK * 2);
    const size_t hstep = (size_t)HALF * KB;
    const size_t tstep = 2 * hstep;
    const unsigned ldsw = (unsigned)wid * 1024u;
    const int aoff = lds_byte(wr * 64 + fr, fq * 8), boff = lds_byte(wc * 32 + fr, fq * 8), aoff1 = lds_byte(wr * 64 + fr, 32 + fq * 8), boff1 = lds_byte(wc * 32 + fr, 32 + fq * 8);
#define PG8_SA(b, h) (((b) * 2 + (h)) * HTB)
#define PG8_SB(b, h) ((4 + (b) * 2 + (h)) * HTB)
#define PG8_STAGE(bufoff, gbase, voff) do { _Pragma("unroll") for (int _i = 0; _i < 2; ++_i) \
        __builtin_amdgcn_global_load_lds((const unsigned*)((const char*)(gbase) + (voff)[_i]), (PG8_LAS unsigned*)(lds + (bufoff) + ldsw + _i * 8192), 16, 0, 0); } while (0)
#define PG8_GLDS1(gp, ldsoff) __builtin_amdgcn_global_load_lds((const unsigned*)(gp), (PG8_LAS unsigned*)(lds + (ldsoff)), 16, 0, 0)
#define PG8_STAGEA(bufoff, kptr, half, nx) do { if constexpr (GATHER) { \
        const unsigned _v0 = (half) ? ((nx) ? nv1[0] : cv1[0]) : ((nx) ? nv0[0] : cv0[0]), _v1 = (half) ? ((nx) ? nv1[1] : cv1[1]) : ((nx) ? nv0[1] : cv0[1]); \
        PG8_GLDS1((const char*)(kptr) + _v0, (bufoff) + ldsw); PG8_GLDS1((const char*)(kptr) + _v1, (bufoff) + ldsw + 8192); \
    } else { PG8_STAGE(bufoff, (kptr) + ((half) ? hstep : (size_t)0), voffA); } } while (0)
#define PG8_LDA(dst, b, h) do { _Pragma("unroll") for (int m = 0; m < 4; ++m) _Pragma("unroll") for (int k = 0; k < 2; ++k) dst[m][k] = *(const PG8_LAS bf16x8*)(lds + PG8_SA(b, h) + (k ? aoff1 : aoff) + m * 2048); } while (0)
#define PG8_LDB(dst, b, h) do { _Pragma("unroll") for (int n = 0; n < 2; ++n) _Pragma("unroll") for (int k = 0; k < 2; ++k) dst[n][k] = *(const PG8_LAS bf16x8*)(lds + PG8_SB(b, h) + (k ? boff1 : boff) + n * 2048); } while (0)
#define PG8_MMA(ai, bj, At, Bt) do { __builtin_amdgcn_s_setprio(1); _Pragma("unroll") for (int m = 0; m < 4; ++m) _Pragma("unroll") for (int n = 0; n < 2; ++n) _Pragma("unroll") for (int k = 0; k < 2; ++k) { \
        if constexpr (I8) acc[ai][bj][m][n] = __builtin_bit_cast(f32x4, __builtin_amdgcn_mfma_i32_16x16x64_i8(__builtin_bit_cast(i32x4, Bt[n][k]), __builtin_bit_cast(i32x4, At[m][k]), __builtin_bit_cast(i32x4, acc[ai][bj][m][n]), 0, 0, 0)); \
        else acc[ai][bj][m][n] = __builtin_amdgcn_mfma_f32_16x16x32_bf16(Bt[n][k], At[m][k], acc[ai][bj][m][n], 0, 0, 0); } __builtin_amdgcn_s_setprio(0); } while (0)
#define PG8_WAIT_V(n) asm volatile("s_waitcnt vmcnt(" #n ")" ::: "memory")
#define PG8_WAIT_L(n) asm volatile("s_waitcnt lgkmcnt(" #n ")" ::: "memory")
#define PG8_BAR __builtin_amdgcn_s_barrier()
#define PG8_SCHED __builtin_amdgcn_sched_barrier(0)
    Unit cur, nxt; int ui = 0;
    if (!S.next(0, cur)) return;
    if constexpr (GATHER) { PG8_GOFF(cv0, cv1, 0); }
    f32x4 acc[2][2][4][2];
#pragma unroll
    for (int a = 0; a < 2; ++a)
#pragma unroll
        for (int b = 0; b < 2; ++b)
#pragma unroll
            for (int m = 0; m < 4; ++m)
#pragma unroll
                for (int n = 0; n < 2; ++n) acc[a][b][m][n] = (f32x4){0.f, 0.f, 0.f, 0.f};
    bf16x8 At[4][2], B0[2][2], B1[2][2];
    const char* cA = (const char*)g.A + S.a_off(cur, tstep); const char* cB = (const char*)g.Bt + S.b_off(cur, tstep);
    S.a_ready(cur);
    if constexpr (SP2) {
        PG8_STAGE(PG8_SB(0, 0), cB, voffB); PG8_STAGE(PG8_SB(0, 1), cB + hstep, voffB); PG8_STAGEA(PG8_SA(0, 0), cA, 0, false); PG8_STAGEA(PG8_SA(0, 1), cA, 1, false);
        if (wr == 1) PG8_BAR;
        PG8_WAIT_V(2); PG8_BAR;
        PG8_STAGE(PG8_SB(1, 0), cB + kstep, voffB); PG8_STAGEA(PG8_SA(1, 0), cA + kstep, 0, false); PG8_STAGE(PG8_SB(1, 1), cB + hstep + kstep, voffB);
        PG8_WAIT_V(6); PG8_BAR;
    } else {
        PG8_STAGE(PG8_SB(0, 0), cB, voffB); PG8_STAGEA(PG8_SA(0, 0), cA, 0, false); PG8_STAGE(PG8_SB(0, 1), cB + hstep, voffB); PG8_STAGEA(PG8_SA(0, 1), cA, 1, false);
        if (wr == 1) PG8_BAR;
        PG8_WAIT_V(4); PG8_BAR;
        PG8_STAGE(PG8_SB(1, 0), cB + kstep, voffB); PG8_STAGEA(PG8_SA(1, 0), cA + kstep, 0, false); PG8_STAGE(PG8_SB(1, 1), cB + hstep + kstep, voffB);
        PG8_WAIT_V(6); PG8_BAR;
    }
    for (;;) {
        const bool has_next = S.next(ui + 1, nxt);
        if constexpr (GATHER) { if (has_next) { PG8_GOFF(nv0, nv1, ui + 1); } else { nv0[0] = cv0[0]; nv0[1] = cv0[1]; nv1[0] = cv1[0]; nv1[1] = cv1[1]; } }
        const char* nA = has_next ? (const char*)g.A + S.a_off(nxt, tstep) : cA; const char* nB = has_next ? (const char*)g.Bt + S.b_off(nxt, tstep) : cB;
        for (int t = 0; t < nt; t += 2) {
            const bool last = (t == nt - 2);
            const char* a1 = cA + (size_t)(t + 1) * kstep;
            const char* a2 = last ? nA : cA + (size_t)(t + 2) * kstep; const char* b2 = last ? nB : cB + (size_t)(t + 2) * kstep;
            const char* a3 = a2 + kstep; const char* b3 = b2 + kstep;
            if (last && has_next) S.a_ready(nxt);
            if constexpr (SP2) {
            PG8_LDB(B0, 0, 0); PG8_LDB(B1, 0, 1); PG8_SCHED; PG8_LDA(At, 0, 0); PG8_STAGEA(PG8_SA(1, 1), a1, 1, false);
            PG8_WAIT_V(8); PG8_WAIT_L(0); PG8_BAR; PG8_MMA(0, 0, At, B0); PG8_MMA(0, 1, At, B1); PG8_BAR; PG8_SCHED;
            PG8_LDA(At, 0, 1); PG8_STAGE(PG8_SB(0, 0), b2, voffB); PG8_STAGE(PG8_SB(0, 1), b2 + hstep, voffB); PG8_STAGEA(PG8_SA(0, 0), a2, 0, last);
            PG8_WAIT_V(8); PG8_WAIT_L(0); PG8_BAR; PG8_MMA(1, 0, At, B0); PG8_MMA(1, 1, At, B1); PG8_BAR; PG8_SCHED;
            PG8_LDB(B0, 1, 0); PG8_LDB(B1, 1, 1); PG8_SCHED; PG8_LDA(At, 1, 0); PG8_STAGEA(PG8_SA(0, 1), a2, 1, last);
            PG8_WAIT_V(8); PG8_WAIT_L(0); PG8_BAR; PG8_MMA(0, 0, At, B0); PG8_MMA(0, 1, At, B1); PG8_BAR; PG8_SCHED;
            PG8_LDA(At, 1, 1); PG8_STAGE(PG8_SB(1, 0), b3, voffB); PG8_STAGE(PG8_SB(1, 1), b3 + hstep, voffB); PG8_STAGEA(PG8_SA(1, 0), a3, 0, last);
            PG8_WAIT_V(8); PG8_WAIT_L(0); PG8_BAR; PG8_MMA(1, 0, At, B0); PG8_MMA(1, 1, At, B1); PG8_BAR; PG8_SCHED;
            } else {
            PG8_LDB(B0, 0, 0); PG8_SCHED; PG8_LDA(At, 0, 0); PG8_STAGEA(PG8_SA(1, 1), a1, 1, false);
            PG8_WAIT_L(8); PG8_BAR; PG8_WAIT_L(0); PG8_MMA(0, 0, At, B0); PG8_BAR; PG8_SCHED;
            PG8_LDB(B1, 0, 1); PG8_STAGE(PG8_SB(0, 0), b2, voffB);
            PG8_BAR; PG8_WAIT_L(0); PG8_MMA(0, 1, At, B1); PG8_BAR;
            PG8_LDA(At, 0, 1); PG8_STAGEA(PG8_SA(0, 0), a2, 0, last);
            PG8_BAR; PG8_WAIT_L(0); PG8_MMA(1, 0, At, B0); PG8_BAR; PG8_SCHED;
            PG8_STAGE(PG8_SB(0, 1), b2 + hstep, voffB);
            PG8_WAIT_V(6); PG8_BAR; PG8_MMA(1, 1, At, B1); PG8_BAR;
            PG8_LDB(B0, 1, 0); PG8_SCHED; PG8_LDA(At, 1, 0); PG8_STAGEA(PG8_SA(0, 1), a2, 1, last);
            PG8_WAIT_L(8); PG8_BAR; PG8_WAIT_L(0); PG8_MMA(0, 0, At, B0); PG8_BAR; PG8_SCHED;
            PG8_LDB(B1, 1, 1); PG8_STAGE(PG8_SB(1, 0), b3, voffB);
            PG8_BAR; PG8_WAIT_L(0); PG8_MMA(0, 1, At, B1); PG8_BAR;
            PG8_LDA(At, 1, 1); PG8_STAGEA(PG8_SA(1, 0), a3, 0, last);
            PG8_BAR; PG8_WAIT_L(0); PG8_MMA(1, 0, At, B0); PG8_BAR; PG8_SCHED;
            PG8_STAGE(PG8_SB(1, 1), b3 + hstep, voffB);
            PG8_WAIT_V(6); PG8_BAR; PG8_MMA(1, 1, At, B1); PG8_BAR;
            }
        }
        if constexpr (ALIGN_EPI) { if (wr == 0) PG8_BAR; }
        if constexpr (!Epi::AFTER_DRAIN) { E(acc, cur, wr, wc, fr, fq); S.done(cur); }
        if (!has_next) break;
#pragma unroll
        for (int a = 0; a < 2; ++a)
#pragma unroll
            for (int b = 0; b < 2; ++b)
#pragma unroll
                for (int m = 0; m < 4; ++m)
#pragma unroll
                    for (int n = 0; n < 2; ++n) acc[a][b][m][n] = (f32x4){0.f, 0.f, 0.f, 0.f};
        cur = nxt; cA = nA; cB = nB; ++ui;
        if constexpr (GATHER) { cv0[0] = nv0[0]; cv0[1] = nv0[1]; cv1[0] = nv1[0]; cv1[1] = nv1[1]; }
        if constexpr (ALIGN_EPI) { if (wr == 1) PG8_BAR; }
    }
    PG8_WAIT_V(0);
    if constexpr (!ALIGN_EPI) { if (wr == 0) PG8_BAR; }
    PG8_BAR;
    if constexpr (Epi::AFTER_DRAIN) { E.fused(acc, cur, wr, wc, fr, fq, lds, wid, lane); S.done(cur); }
#undef PG8_SA
#undef PG8_SB
#undef PG8_STAGE
#undef PG8_STAGEA
#undef PG8_GLDS1
#undef PG8_GOFF
#undef PG8_LDA
#undef PG8_LDB
#undef PG8_MMA
#undef PG8_WAIT_V
#undef PG8_WAIT_L
#undef PG8_BAR
#undef PG8_SCHED
}
}
#define GAS __attribute__((address_space(1)))
#define LAS __attribute__((address_space(3)))
typedef unsigned short bf16;
typedef unsigned v4u __attribute__((ext_vector_type(4)));
typedef float f32x4 __attribute__((ext_vector_type(4)));
typedef short bf16x8 __attribute__((ext_vector_type(8)));
typedef GAS unsigned gu32;
typedef GAS unsigned long long gu64;
#define RLX_AGENT __ATOMIC_RELAXED, __HIP_MEMORY_SCOPE_AGENT
#define LDS_WAIT() asm volatile("s_waitcnt lgkmcnt(0)" ::: "memory")
#define VM_WAIT() asm volatile("s_waitcnt vmcnt(0)" ::: "memory")
__device__ __forceinline__ unsigned long long rt() { return __builtin_amdgcn_s_memrealtime(); }
__device__ __forceinline__ unsigned f2bfu(float f) { unsigned u = __builtin_bit_cast(unsigned, f); return (u + 0x7fffu + ((u >> 16) & 1u)) >> 16; }
__device__ __forceinline__ unsigned pk2(float lo, float hi) { return f2bfu(lo) | (f2bfu(hi) << 16); }

#define XB_TMO      128
#define XB_XCNT(j)  (256  + 64 * (j))
#define XB_XSUB(j)  (1280 + 64 * (j))
#define XB_XGEN(j)  (2304 + 64 * (j))
#define XB_TOP      3328
#define XB_TOPGEN   3392
#define XCD_BAR_WORDS 3456
#define XB_SPIN_CAP (1u << 18)

__device__ __forceinline__ unsigned xb_ld(unsigned* p)              { return __hip_atomic_load(p, __ATOMIC_RELAXED, __HIP_MEMORY_SCOPE_AGENT); }
__device__ __forceinline__ unsigned xb_add(unsigned* p, unsigned v) { return __hip_atomic_fetch_add(p, v, __ATOMIC_RELAXED, __HIP_MEMORY_SCOPE_AGENT); }
__device__ __forceinline__ unsigned xb_xcc_id() { return (unsigned)__builtin_amdgcn_s_getreg((3 << 11) | 20) & 0xFu; }
#define XB_SPIN(cond, bar) do { unsigned _sp = 0; while (cond) { __builtin_amdgcn_s_sleep(1); \
    if ((++_sp & 255u) == 0u) { if (xb_ld(&(bar)[XB_TMO])) break; if (_sp > XB_SPIN_CAP) { atomicAdd(&(bar)[XB_TMO], 1u); break; } } } } while (0)

struct XcdBarrier {
    unsigned* bar; unsigned x;
    volatile LAS unsigned* st;
};

__device__ __forceinline__ XcdBarrier xcd_barrier_post(unsigned* bar, volatile LAS unsigned* st) {
    XcdBarrier b; b.bar = bar; b.x = xb_xcc_id(); b.st = st;
    if (threadIdx.x == 0) (void)xb_add(&bar[XB_XCNT(b.x)], 1u);
    return b;
}
__device__ __forceinline__ void xcd_barrier_complete(unsigned* bar, unsigned x, unsigned& nloc, unsigned& nx) {
    const unsigned G = gridDim.x * gridDim.y * gridDim.z;
    unsigned sum, cnt, mine, sp = 0u;
    for (;;) {
        sum = 0u; cnt = 0u; mine = 0u;
#pragma unroll
        for (unsigned j = 0; j < 16; ++j) { const unsigned c = xb_ld(&bar[XB_XCNT(j)]); sum += c; cnt += (c > 0u) ? 1u : 0u; mine = (j == x) ? c : mine; }
        if (sum == G) break;
        __builtin_amdgcn_s_sleep(1);
        if ((++sp & 255u) == 0u) { if (xb_ld(&bar[XB_TMO])) break; if (sp > XB_SPIN_CAP) { atomicAdd(&bar[XB_TMO], 1u); break; } }
    }
    nloc = mine > 0u ? mine : 1u; nx = cnt > 0u ? cnt : 1u;
}

__device__ __forceinline__ void xcd_barrier(const XcdBarrier& b) {
    asm volatile("s_waitcnt vmcnt(0)" ::: "memory");
    __syncthreads();
    if (threadIdx.x == 0) {
        unsigned* bar = b.bar;
        __builtin_amdgcn_s_waitcnt(0);
        unsigned nloc = b.st[0], nx = b.st[1];
        if (nloc == 0u) { xcd_barrier_complete(bar, b.x, nloc, nx); b.st[0] = nloc; b.st[1] = nx; }
        const unsigned old = xb_add(&bar[XB_XSUB(b.x)], 1u);
        const unsigned gen = old / nloc;
        if (old + 1u == (gen + 1u) * nloc) {
            __builtin_amdgcn_fence(__ATOMIC_RELEASE, "agent");
            asm volatile("s_waitcnt vmcnt(0)" ::: "memory");
            const unsigned og = xb_add(&bar[XB_TOP], 1u);
            const unsigned tg = og / nx;
            if (og + 1u == (tg + 1u) * nx) xb_add(&bar[XB_TOPGEN], 1u);
            else XB_SPIN(xb_ld(&bar[XB_TOPGEN]) == tg, bar);
            __builtin_amdgcn_fence(__ATOMIC_ACQUIRE, "agent");
            xb_add(&bar[XB_XGEN(b.x)], 1u);
            asm volatile("s_waitcnt vmcnt(0)" ::: "memory");
        } else {
            XB_SPIN(xb_ld(&bar[XB_XGEN(b.x)]) == gen, bar);
            __builtin_amdgcn_fence(__ATOMIC_ACQUIRE, "agent");
            asm volatile("s_waitcnt vmcnt(0)" ::: "memory");
        }
    }
    __syncthreads();
}

template <bool DUAL, class FA, class FB, class FB2, class FE>
__device__ __forceinline__ void naive_tile_h(float* sm, int t256, int K, FA fa, FB fb, FB2 fb2, FE fe) {
    float* As = sm; float* Bs = sm + 1088; float* Bs2 = sm + 2176;
    const int tx = t256 & 15, ty = t256 >> 4;
    float acc[4][4], acc2[4][4];
#pragma unroll
    for (int i = 0; i < 4; ++i)
#pragma unroll
        for (int j = 0; j < 4; ++j) { acc[i][j] = 0.f; acc2[i][j] = 0.f; }
    for (int k0 = 0; k0 < K; k0 += 16) {
        { const int r = t256 >> 2, kk = (t256 & 3) * 4; const float4 a = fa(r, k0 + kk); As[kk * 68 + r] = a.x; As[(kk + 1) * 68 + r] = a.y; As[(kk + 2) * 68 + r] = a.z; As[(kk + 3) * 68 + r] = a.w; }
        { const int kk = t256 >> 4, c = (t256 & 15) * 4; *(float4*)&Bs[kk * 68 + c] = fb(k0 + kk, c); if (DUAL) *(float4*)&Bs2[kk * 68 + c] = fb2(k0 + kk, c); }
        __syncthreads();
#pragma unroll
        for (int kk = 0; kk < 16; ++kk) {
            const float4 a = *(const float4*)&As[kk * 68 + ty * 4]; const float4 b = *(const float4*)&Bs[kk * 68 + tx * 4];
            const float av[4] = {a.x, a.y, a.z, a.w}; const float bv[4] = {b.x, b.y, b.z, b.w};
#pragma unroll
            for (int i = 0; i < 4; ++i)
#pragma unroll
                for (int j = 0; j < 4; ++j) acc[i][j] += av[i] * bv[j];
            if (DUAL) {
                const float4 b2 = *(const float4*)&Bs2[kk * 68 + tx * 4]; const float bw[4] = {b2.x, b2.y, b2.z, b2.w};
#pragma unroll
                for (int i = 0; i < 4; ++i)
#pragma unroll
                    for (int j = 0; j < 4; ++j) acc2[i][j] += av[i] * bw[j];
            }
        }
        __syncthreads();
    }
#pragma unroll
    for (int i = 0; i < 4; ++i) fe(ty * 4 + i, tx * 4, make_float4(acc[i][0], acc[i][1], acc[i][2], acc[i][3]), make_float4(acc2[i][0], acc2[i][1], acc2[i][2], acc2[i][3]));
}

__device__ __forceinline__ void ph_la(int gtid, int nthr, const bf16_t* PROJ, const float* upf, const float* bf, const float* upb, const float* bb, float* LAF, float* LAB) {
    for (int i = gtid; i < NTOK * 256 * 2; i += nthr) {
        const int c = i & 255, t = (i >> 8) & (NTOK - 1), dir = i >> 23;
        const bf16_t* z = PROJ + (size_t)t * PW + (dir ? C_ZB : C_ZF);
        const float* up = dir ? upb : upf; const float* bias = dir ? bb : bf;
        float pre = bias[c];
#pragma unroll
        for (int r = 0; r < 16; ++r) pre += bf2f(z[r]) * up[r * 256 + c];
        const float ls = fminf(pre, 0.f) - log1pf(expf(-fabsf(pre)));
        (dir ? LAB : LAF)[(size_t)t * 256 + c] = ls * (1.f / 16.f);
    }
}
__device__ __forceinline__ void ph_gla_scan(int bid, int tid, const bf16_t* PROJ, const float* LAF, const float* LAB, float* OF, float* OB) {
    const int es = bid & 3, dir = (bid >> 2) & 1, h = (bid >> 3) & 3, b = bid >> 5;
    const int dg = tid & 15, el = tid >> 4, e = es * 32 + el;
    const float* LA = dir ? LAB : LAF; float* O = dir ? OB : OF;
    float S0 = 0.f, S1 = 0.f, S2 = 0.f, S3 = 0.f;
#pragma unroll 4
    for (int step = 0; step < T; ++step) {
        const int t = dir ? (T - 1 - step) : step;
        const size_t row = (size_t)b * T + t;
        const bf16_t* pr = PROJ + row * PW;
        const float4 la = *(const float4*)(LA + row * 256 + h * 64 + dg * 4);
        const float4 q = ld_bf4(pr + C_GQ + h * 64 + dg * 4);
        const float4 k = ld_bf4(pr + C_GK + h * 64 + dg * 4);
        const float v = bf2f(pr[C_GV + h * 128 + e]);
        S0 = expf(la.x) * S0 + k.x * v; S1 = expf(la.y) * S1 + k.y * v; S2 = expf(la.z) * S2 + k.z * v; S3 = expf(la.w) * S3 + k.w * v;
        float part = (q.x * S0 + q.y * S1 + q.z * S2 + q.w * S3) * 0.125f;
        part += __shfl_xor(part, 1); part += __shfl_xor(part, 2); part += __shfl_xor(part, 4); part += __shfl_xor(part, 8);
        if (dg == 0) O[row * 512 + h * 128 + e] = part;
    }
}
__device__ __forceinline__ void ph_gla_combine(int gw, int NGW, int lane, const float* OF, const float* OB, const bf16_t* PROJ, const float* gain, bf16_t* MIXED) {
    for (int w = gw; w < NTOK * 4; w += NGW) {
        const int t = w >> 2, h = w & 3;
        const size_t o = (size_t)t * 512 + h * 128 + lane * 2;
        const float2 a = *(const float2*)(OF + o), bq = *(const float2*)(OB + o);
        const float v0 = a.x + bq.x, v1 = a.y + bq.y;
        const float ss = wave_sum(v0 * v0 + v1 * v1);
        const float rstd = rsqrtf(ss * (1.f / 128.f) + EPS);
        const bf16_t* g = PROJ + (size_t)t * PW + C_GG + h * 128 + lane * 2;
        const float g0 = bf2f(g[0]), g1 = bf2f(g[1]);
        bf16_t* m = MIXED + (size_t)t * D + h * 128 + lane * 2;
        m[0] = f2bf(v0 * rstd * gain[lane * 2] * silu_f(g0)); m[1] = f2bf(v1 * rstd * gain[lane * 2 + 1] * silu_f(g1));
    }
}
__device__ __forceinline__ void ph_qk_prep(int gw, int NGW, int lane, bf16_t* PROJ, const float* qg, const float* kg, const float* rope, bf16_t* OUT, int opitch) {
    const float gq = qg[lane], gk = kg[lane];
    const int pi = lane >> 1, j = pi & 15;
    for (int t = gw; t < NTOK; t += NGW) {
        bf16_t* p = PROJ + (size_t)t * PW + C_AQ + lane;
        float v[10];
#pragma unroll
        for (int hs = 8; hs < 10; ++hs) v[hs] = bf2f(p[hs * 64]);
        const int tt = t & (T - 1), pos = pi < 16 ? (tt >> 6) : (tt & 63);
        const float c = rope[pos * 16 + j], s = rope[1024 + pos * 16 + j];
#pragma unroll
        for (int hs = 8; hs < 10; ++hs) {
            const float ss = wave_sum(v[hs] * v[hs]);
            const float y = v[hs] * rsqrtf(ss * (1.f / 64.f) + EPS) * (hs < 8 ? gq : gk);
            const float partner = __shfl_xor(y, 1);
            float o = (lane & 1) ? (partner * s + y * c) : (y * c - partner * s);
            if (hs < 8) o *= 0.125f * 1.4426950408889634f;
            OUT[(size_t)t * opitch + lane + hs * 64] = f2bf(o);
        }
    }
}
__device__ __forceinline__ void ph_attn_vb(float* sm, int t256, int vb, const bf16_t* PROJ, float* ATT) {
    float* Qt = sm; float* KV = sm + 4352; float* St = sm + 8704; float* al = sm + 13056;
    const int tx = t256 & 15, ty = t256 >> 4;
    const int q0 = (vb & 63) * 64, hq = (vb >> 6) & 7, b = vb >> 9, kvh = hq >> 2;
    const size_t rowb = (size_t)b * T;
    { const int r = t256 >> 2, d0 = (t256 & 3) * 16; const bf16_t* p = PROJ + (rowb + q0 + r) * PW + C_AQ + hq * 64 + d0;
#pragma unroll
      for (int i = 0; i < 16; ++i) Qt[(d0 + i) * 68 + r] = bf2f(p[i]); }
    float O[4][4];
#pragma unroll
    for (int i = 0; i < 4; ++i)
#pragma unroll
        for (int j = 0; j < 4; ++j) O[i][j] = 0.f;
    float m_run = -INFINITY, l_run = 0.f;
    for (int k0 = 0; k0 < T; k0 += 64) {
        { const int c = t256 >> 2, d0 = (t256 & 3) * 16; const bf16_t* p = PROJ + (rowb + k0 + c) * PW + C_AK + kvh * 64 + d0;
#pragma unroll
          for (int i = 0; i < 16; ++i) KV[(d0 + i) * 68 + c] = bf2f(p[i]); }
        __syncthreads();
        float s[4][4];
#pragma unroll
        for (int i = 0; i < 4; ++i)
#pragma unroll
            for (int j = 0; j < 4; ++j) s[i][j] = 0.f;
#pragma unroll 8
        for (int d = 0; d < 64; ++d) {
            const float4 a = *(const float4*)&Qt[d * 68 + ty * 4]; const float4 bq = *(const float4*)&KV[d * 68 + tx * 4];
            const float av[4] = {a.x, a.y, a.z, a.w}; const float bv[4] = {bq.x, bq.y, bq.z, bq.w};
#pragma unroll
            for (int i = 0; i < 4; ++i)
#pragma unroll
                for (int j = 0; j < 4; ++j) s[i][j] += av[i] * bv[j];
        }
#pragma unroll
        for (int i = 0; i < 4; ++i)
#pragma unroll
            for (int j = 0; j < 4; ++j) St[(tx * 4 + j) * 68 + ty * 4 + i] = s[i][j];
        __syncthreads();
        { const int c = t256 >> 2, e0 = (t256 & 3) * 16; const bf16_t* p = PROJ + (rowb + k0 + c) * PW + C_AV + kvh * 64 + e0;
#pragma unroll
          for (int i = 0; i < 16; ++i) KV[c * 68 + e0 + i] = bf2f(p[i]); }
        if (t256 < 64) {
            float mx = -INFINITY;
            for (int c = 0; c < 64; ++c) mx = fmaxf(mx, St[c * 68 + t256]);
            const float mn = fmaxf(m_run, mx);
            const float alpha = expf(m_run - mn);
            float sum = 0.f;
            for (int c = 0; c < 64; ++c) { const float p = expf(St[c * 68 + t256] - mn); St[c * 68 + t256] = p; sum += p; }
            l_run = l_run * alpha + sum; m_run = mn; al[t256] = alpha;
        }
        __syncthreads();
#pragma unroll
        for (int i = 0; i < 4; ++i) { const float a = al[ty * 4 + i];
#pragma unroll
            for (int j = 0; j < 4; ++j) O[i][j] *= a; }
#pragma unroll 8
        for (int c = 0; c < 64; ++c) {
            const float4 a = *(const float4*)&St[c * 68 + ty * 4]; const float4 bq = *(const float4*)&KV[c * 68 + tx * 4];
            const float av[4] = {a.x, a.y, a.z, a.w}; const float bv[4] = {bq.x, bq.y, bq.z, bq.w};
#pragma unroll
            for (int i = 0; i < 4; ++i)
#pragma unroll
                for (int j = 0; j < 4; ++j) O[i][j] += av[i] * bv[j];
        }
        __syncthreads();
    }
    if (t256 < 64) al[t256] = 1.f / l_run;
    __syncthreads();
#pragma unroll
    for (int i = 0; i < 4; ++i) { const float a = al[ty * 4 + i];
        *(float4*)(ATT + (rowb + q0 + ty * 4 + i) * 512 + hq * 64 + tx * 4) = make_float4(O[i][0] * a, O[i][1] * a, O[i][2] * a, O[i][3] * a); }
    __syncthreads();
}
__device__ __forceinline__ void ph_att_norm(int gw, int NGW, int lane, const float* ATT, const float* gain, bf16_t* MIXED) {
    for (int t = gw; t < NTOK; t += NGW) {
        const float4* a = (const float4*)(ATT + (size_t)t * 512);
        const float4 v0 = a[lane], v1 = a[64 + lane];
        const float ss = wave_sum(v0.x * v0.x + v0.y * v0.y + v0.z * v0.z + v0.w * v0.w + v1.x * v1.x + v1.y * v1.y + v1.z * v1.z + v1.w * v1.w);
        const float rstd = rsqrtf(ss * (1.f / 512.f) + EPS);
        const float4 g0 = ((const float4*)gain)[lane], g1 = ((const float4*)gain)[64 + lane];
        bf16_t* m = MIXED + (size_t)t * D + 512;
        st_bf4(m + lane * 4, make_float4(v0.x * rstd * g0.x, v0.y * rstd * g0.y, v0.z * rstd * g0.z, v0.w * rstd * g0.w));
        st_bf4(m + 256 + lane * 4, make_float4(v1.x * rstd * g1.x, v1.y * rstd * g1.y, v1.z * rstd * g1.z, v1.w * rstd * g1.w));
    }
}
__device__ __forceinline__ void ph_router(int gw, int NGW, int lane, const float* H, const float* g2, const float* wg, const float* bg, const float* we, const float* be, float* RSTD, unsigned* tokinfo, unsigned* ctl) {
    for (int t = gw; t < NTOK; t += NGW) {
        const float4* hr = (const float4*)(H + (size_t)t * D);
        float ss = 0.f;
#pragma unroll
        for (int j = 0; j < 4; ++j) { const float4 v = hr[j * 64 + lane]; ss += v.x * v.x + v.y * v.y + v.z * v.z + v.w * v.w; }
        ss = wave_sum(ss);
        const float rstd = rsqrtf(ss * (1.f / D) + EPS);
        float gl[8], el[64];
#pragma unroll
        for (int i = 0; i < 8; ++i) gl[i] = 0.f;
#pragma unroll
        for (int i = 0; i < 64; ++i) el[i] = 0.f;
#pragma unroll 1
        for (int ji = 0; ji < 16; ++ji) {
            const int k = ((ji >> 2) * 64 + lane) * 4 + (ji & 3);
            const float xv = H[(size_t)t * D + k] * rstd * g2[k];
            const float4* pg = (const float4*)(wg + (size_t)k * 8);
#pragma unroll
            for (int q = 0; q < 2; ++q) { const float4 w = pg[q]; gl[q * 4] += xv * w.x; gl[q * 4 + 1] += xv * w.y; gl[q * 4 + 2] += xv * w.z; gl[q * 4 + 3] += xv * w.w; }
            const float4* pe = (const float4*)(we + (size_t)k * 64);
#pragma unroll
            for (int q = 0; q < 16; ++q) { const float4 w = pe[q]; el[q * 4] += xv * w.x; el[q * 4 + 1] += xv * w.y; el[q * 4 + 2] += xv * w.z; el[q * 4 + 3] += xv * w.w; }
        }
#pragma unroll
        for (int i = 0; i < 8; ++i) gl[i] = wave_sum(gl[i]) + bg[i];
#pragma unroll
        for (int i = 0; i < 64; ++i) el[i] = wave_sum(el[i]) + be[i];
        float best = gl[0]; int g = 0;
#pragma unroll
        for (int i = 1; i < 8; ++i) if (gl[i] > best) { best = gl[i]; g = i; }
        float den = 0.f;
#pragma unroll
        for (int i = 0; i < 8; ++i) den += expf(gl[i] - best);
        const float gw_ = 1.f / den;
        float ev[8];
#pragma unroll
        for (int j = 0; j < 8; ++j) { float v = el[j];
#pragma unroll
            for (int q = 1; q < 8; ++q) v = (g == q) ? el[q * 8 + j] : v;
            ev[j] = v; }
        float v1 = ev[0]; int i1 = 0;
#pragma unroll
        for (int j = 1; j < 8; ++j) if (ev[j] > v1) { v1 = ev[j]; i1 = j; }
        float v2 = -INFINITY; int i2 = 0;
#pragma unroll
        for (int j = 0; j < 8; ++j) if (j != i1 && ev[j] > v2) { v2 = ev[j]; i2 = j; }
        const float ex = expf(v2 - v1), p1 = 1.f / (1.f + ex), p2 = ex * p1;
        if (lane == 0) {
            const int e1 = g * 8 + i1, e2 = g * 8 + i2;
            uint4 o; o.x = (unsigned)e1; o.y = (unsigned)e2; o.z = __float_as_uint(gw_ * p1); o.w = __float_as_uint(gw_ * p2);
            ((uint4*)tokinfo)[t] = o;
            RSTD[t] = rstd;
            atomicAdd(&ctl[CW_COUNTS + e1], 1u); atomicAdd(&ctl[CW_COUNTS + e2], 1u);
        }
    }
}
__device__ __forceinline__ void ph_offsets(unsigned* ctl) {
    unsigned off = 0, nt = 0;
    for (int e = 0; e < NEXP; ++e) {
        const unsigned c = ctl[CW_COUNTS + e]; ctl[CW_OFFS + e] = off;
        for (unsigned r = 0; r < c; r += 64) { ctl[CW_TILE_E + nt] = (unsigned)e; ctl[CW_TILE_R0 + nt] = off + r; ctl[CW_TILE_NR + nt] = (c - r) < 64u ? (c - r) : 64u; ++nt; }
        off += c;
    }
    ctl[CW_OFFS + NEXP] = off; ctl[CW_NTILES] = nt;
}
__device__ __forceinline__ void ph_scatter(int gtid, int nthr, const unsigned* tokinfo, unsigned* ctl, int* tokslot, int* slottok, float* slotgate) {
    for (int t = gtid; t < NTOK; t += nthr) {
        const uint4 ti = ((const uint4*)tokinfo)[t];
        const unsigned p0 = ctl[CW_OFFS + ti.x] + atomicAdd(&ctl[CW_CURSOR + ti.x], 1u);
        const unsigned p1 = ctl[CW_OFFS + ti.y] + atomicAdd(&ctl[CW_CURSOR + ti.y], 1u);
        slottok[p0] = t; slottok[p1] = t; slotgate[p0] = __uint_as_float(ti.z); slotgate[p1] = __uint_as_float(ti.w);
        tokslot[2 * t] = (int)p0; tokslot[2 * t + 1] = (int)p1;
    }
}
__device__ __forceinline__ void ph_moe1_vb(float* sm, int t256, bool valid, int vb, const bf16_t* XN2, const float* w_gate, const float* w_up, const unsigned* ctl, const int* slottok, bf16_t* HMID) {
    const int tile = valid ? (vb >> 3) : 0, c0 = (vb & 7) * 64;
    const int e = (int)ctl[CW_TILE_E + tile], row0 = (int)ctl[CW_TILE_R0 + tile], nr = valid ? (int)ctl[CW_TILE_NR + tile] : 0;
    const float* wgp = w_gate + (size_t)e * D * DEXP; const float* wup = w_up + (size_t)e * D * DEXP;
    auto fa = [&](int r, int k) { if (r >= nr) return make_float4(0.f, 0.f, 0.f, 0.f); const int tok = slottok[row0 + r]; return ld_bf4(XN2 + (size_t)tok * D + k); };
    auto fb = [&](int k, int c) { return *(const float4*)(wgp + (size_t)k * DEXP + c0 + c); };
    auto fb2 = [&](int k, int c) { return *(const float4*)(wup + (size_t)k * DEXP + c0 + c); };
    auto fe = [&](int r, int c, float4 a, float4 u) { if (r >= nr) return; st_bf4(HMID + (size_t)(row0 + r) * DEXP + c0 + c, make_float4(silu_f(a.x) * u.x, silu_f(a.y) * u.y, silu_f(a.z) * u.z, silu_f(a.w) * u.w)); };
    naive_tile_h<true>(sm, t256, D, fa, fb, fb2, fe);
}
__device__ __forceinline__ void ph_moe2_vb(float* sm, int t256, bool valid, int vb, const bf16_t* HMID, const float* w_down, const unsigned* ctl, const float* slotgate, bf16_t* YS) {
    const int tile = valid ? (vb >> 4) : 0, c0 = (vb & 15) * 64;
    const int e = (int)ctl[CW_TILE_E + tile], row0 = (int)ctl[CW_TILE_R0 + tile], nr = valid ? (int)ctl[CW_TILE_NR + tile] : 0;
    const float* wd = w_down + (size_t)e * DEXP * D;
    auto fa = [&](int r, int k) { if (r >= nr) return make_float4(0.f, 0.f, 0.f, 0.f); return ld_bf4(HMID + (size_t)(row0 + r) * DEXP + k); };
    auto fb = [&](int k, int c) { return *(const float4*)(wd + (size_t)k * D + c0 + c); };
    auto fe = [&](int r, int c, float4 a, float4) { if (r >= nr) return; const float g = slotgate[row0 + r]; st_bf4(YS + (size_t)(row0 + r) * D + c0 + c, make_float4(a.x * g, a.y * g, a.z * g, a.w * g)); };
    naive_tile_h<false>(sm, t256, DEXP, fa, fb, fb, fe);
}
__device__ __forceinline__ void ph_final(int gw, int NGW, int lane, const bf16_t* H, const unsigned char* YS8, const float* YSC, const int* tokslot, const float* fg, float* OUTA, float* OUTB) {
    const int sub = (lane & 31) >> 3;
    float4 g[4];
#pragma unroll
    for (int j = 0; j < 4; ++j) g[j] = ((const float4*)fg)[j * 64 + lane];
    for (int t = 2 * gw; t < NTOK; t += 2 * NGW) {
        const int4 sl = *(const int4*)(tokslot + 2 * t);
        float4 v[2][4]; float ss[2] = {0.f, 0.f};
#pragma unroll
        for (int q = 0; q < 2; ++q) {
            const int s0 = q ? sl.z : sl.x, s1 = q ? sl.w : sl.y;
            const bf16_t* hr = H + (size_t)(t + q) * D;
            const unsigned* y0 = (const unsigned*)(YS8 + (size_t)s0 * D); const unsigned* y1 = (const unsigned*)(YS8 + (size_t)s1 * D);
            const float4 a0 = *(const float4*)(YSC + (size_t)s0 * 16 + sub * 4), a1 = *(const float4*)(YSC + (size_t)s1 * 16 + sub * 4);
            const float a0j[4] = {a0.x, a0.y, a0.z, a0.w}, a1j[4] = {a1.x, a1.y, a1.z, a1.w};
#pragma unroll
            for (int j = 0; j < 4; ++j) {
                const float4 hv = ld_bf4(hr + (j * 64 + lane) * 4); const unsigned w0 = y0[j * 64 + lane], w1 = y1[j * 64 + lane];
                const float p = a0j[j], r = a1j[j], off = -128.f * (p + r);
                v[q][j] = make_float4((hv.x + off) + p * (float)(w0 & 0xffu) + r * (float)(w1 & 0xffu), (hv.y + off) + p * (float)((w0 >> 8) & 0xffu) + r * (float)((w1 >> 8) & 0xffu),
                                      (hv.z + off) + p * (float)((w0 >> 16) & 0xffu) + r * (float)((w1 >> 16) & 0xffu), (hv.w + off) + p * (float)(w0 >> 24) + r * (float)(w1 >> 24));
                ss[q] += v[q][j].x * v[q][j].x + v[q][j].y * v[q][j].y + v[q][j].z * v[q][j].z + v[q][j].w * v[q][j].w;
            }
        }
#pragma unroll
        for (int q = 0; q < 2; ++q) {
            const float rstd = rsqrtf(wave_sum(ss[q]) * (1.f / D) + EPS);
            const int tt = t + q;
            float4* orow = (float4*)((tt < NTOK / 2 ? OUTA + (size_t)tt * D : OUTB + (size_t)(tt - NTOK / 2) * D));
#pragma unroll
            for (int j = 0; j < 4; ++j) orow[j * 64 + lane] = make_float4(v[q][j].x * rstd * g[j].x, v[q][j].y * rstd * g[j].y, v[q][j].z * rstd * g[j].z, v[q][j].w * rstd * g[j].w);
        }
    }
}
__device__ __forceinline__ void ph_copy_xs(int bx, int wave, int lane, const LAS int* pos, const float* H, const float* RSTD, const float* g2, bf16_t* XS) {
    float4 g[4];
#pragma unroll
    for (int j = 0; j < 4; ++j) g[j] = ((const float4*)g2)[j * 64 + lane];
#pragma unroll 1
    for (int i = 0; i < 16; i += 2) {
        const int l0 = wave * 16 + i, l1 = l0 + 1, t0 = bx * 128 + l0, t1 = t0 + 1;
        const float r0 = RSTD[t0], r1 = RSTD[t1];
        const float4* h0 = (const float4*)(H + (size_t)t0 * D); const float4* h1 = (const float4*)(H + (size_t)t1 * D);
        float4 a[4], b[4];
#pragma unroll
        for (int j = 0; j < 4; ++j) { a[j] = h0[j * 64 + lane]; b[j] = h1[j * 64 + lane]; }
        uint2* o00 = (uint2*)(XS + (size_t)pos[2 * l0] * D); uint2* o01 = (uint2*)(XS + (size_t)pos[2 * l0 + 1] * D);
        uint2* o10 = (uint2*)(XS + (size_t)pos[2 * l1] * D); uint2* o11 = (uint2*)(XS + (size_t)pos[2 * l1 + 1] * D);
#pragma unroll
        for (int j = 0; j < 4; ++j) {
            uint2 w; w.x = (unsigned)f2bf(a[j].x * r0 * g[j].x) | ((unsigned)f2bf(a[j].y * r0 * g[j].y) << 16); w.y = (unsigned)f2bf(a[j].z * r0 * g[j].z) | ((unsigned)f2bf(a[j].w * r0 * g[j].w) << 16);
            o00[j * 64 + lane] = w; o01[j * 64 + lane] = w;
            uint2 v; v.x = (unsigned)f2bf(b[j].x * r1 * g[j].x) | ((unsigned)f2bf(b[j].y * r1 * g[j].y) << 16); v.y = (unsigned)f2bf(b[j].z * r1 * g[j].z) | ((unsigned)f2bf(b[j].w * r1 * g[j].w) << 16);
            o10[j * 64 + lane] = v; o11[j * 64 + lane] = v;
        }
    }
}

__device__ __forceinline__ void ph_copy_xs_i8(int bx, int wave, int lane, const LAS int* pos, const bf16_t* H, const float* RSTD, const float* g2, unsigned char* XS8, float* SA) {
    float4 g[4];
#pragma unroll
    for (int j = 0; j < 4; ++j) g[j] = ((const float4*)g2)[lane * 4 + j];
#pragma unroll 1
    for (int i = 0; i < 16; i += 2) {
        const int l0 = wave * 16 + i, t0 = bx * 128 + l0;
        float4 a[2][4]; float mx[2];
#pragma unroll
        for (int q = 0; q < 2; ++q) { const uint4* hp = (const uint4*)(H + (size_t)(t0 + q) * D + lane * 16); const uint4 h0 = hp[0], h1 = hp[1];
            const unsigned hw[8] = {h0.x, h0.y, h0.z, h0.w, h1.x, h1.y, h1.z, h1.w};
#pragma unroll
            for (int j = 0; j < 4; ++j) a[q][j] = make_float4(__uint_as_float(hw[2 * j] << 16), __uint_as_float(hw[2 * j] & 0xffff0000u), __uint_as_float(hw[2 * j + 1] << 16), __uint_as_float(hw[2 * j + 1] & 0xffff0000u)); }
#pragma unroll
        for (int q = 0; q < 2; ++q) { const float r = RSTD[t0 + q]; float m = 0.f;
#pragma unroll
            for (int j = 0; j < 4; ++j) { a[q][j].x *= r * g[j].x; a[q][j].y *= r * g[j].y; a[q][j].z *= r * g[j].z; a[q][j].w *= r * g[j].w;
                m = fmaxf(m, fmaxf(fmaxf(fabsf(a[q][j].x), fabsf(a[q][j].y)), fmaxf(fabsf(a[q][j].z), fabsf(a[q][j].w)))); }
#pragma unroll
            for (int o = 1; o < 64; o <<= 1) m = fmaxf(m, __shfl_xor(m, o));
            mx[q] = m; }
#pragma unroll
        for (int q = 0; q < 2; ++q) { const float inv = mx[q] > 0.f ? 127.f / mx[q] : 0.f;
            v4u w;
#pragma unroll
            for (int j = 0; j < 4; ++j) { const int ia = __float2int_rn(a[q][j].x * inv), ib = __float2int_rn(a[q][j].y * inv), ic = __float2int_rn(a[q][j].z * inv), id = __float2int_rn(a[q][j].w * inv);
                w[j] = ((unsigned)ia & 0xffu) | (((unsigned)ib & 0xffu) << 8) | (((unsigned)ic & 0xffu) << 16) | ((unsigned)id << 24); }
            const int p0 = pos[2 * (l0 + q)], p1 = pos[2 * (l0 + q) + 1];
            *(GAS v4u*)(XS8 + (size_t)p0 * D + lane * 16) = w; *(GAS v4u*)(XS8 + (size_t)p1 * D + lane * 16) = w;
            if (lane == 0) { SA[p0] = mx[q] * (1.f / 127.f); SA[p1] = mx[q] * (1.f / 127.f); } }
    }
}
constexpr size_t WS_DEC = 11 * MiB;
constexpr int LDT = 72;
constexpr int GL_QE = 0, GL_KE = 9216, GL_P = 18432, GL_VT = 27648, GL_ST = 46080, GL_TOT = 64512, GL_PART = 68608, GL_RSTD = 70656;
typedef float gf32x4 __attribute__((ext_vector_type(4)));
typedef short gbf16x8 __attribute__((ext_vector_type(8)));

__device__ __forceinline__ float exp_fast(float x) { return __builtin_amdgcn_exp2f(x * 1.4426950408889634f); }
__device__ __forceinline__ float log_sigmoid_f(float x) { return fminf(x, 0.f) - 0.6931471805599453f * __builtin_amdgcn_logf(1.f + exp_fast(-fabsf(x))); }
__device__ __forceinline__ gf32x4 mfma_tile64(const LAS bf16_t* A, const LAS bf16_t* Bt, gf32x4 acc, int lane) {
    const int r = lane & 15, kq = (lane >> 4) * 8;
    const gbf16x8 a0 = *(const LAS gbf16x8*)(A + r * LDT + kq), a1 = *(const LAS gbf16x8*)(A + r * LDT + kq + 32);
    const gbf16x8 b0 = *(const LAS gbf16x8*)(Bt + r * LDT + kq), b1 = *(const LAS gbf16x8*)(Bt + r * LDT + kq + 32);
    acc = __builtin_amdgcn_mfma_f32_16x16x32_bf16(a0, b0, acc, 0, 0, 0);
    acc = __builtin_amdgcn_mfma_f32_16x16x32_bf16(a1, b1, acc, 0, 0, 0);
    return acc;
}
template <bool BWD>
__device__ __forceinline__ void gla_cumsum(const bf16_t* zbase  , const float* up  , const float* bias, int hd  , int tg, int d, LAS float* tot, float (&bv)[8], float& bl) {
    float upc[16];
#pragma unroll
    for (int r = 0; r < 16; ++r) upc[r] = up[r * 256 + hd];
    const float bs = bias[hd];
    float c[8];
#pragma unroll
    for (int i = 0; i < 8; ++i) {
        const uint4* zp = (const uint4*)(zbase + (size_t)(8 * tg + i) * PW);
        const uint4 z0 = zp[0], z1 = zp[1];
        const unsigned zw[8] = {z0.x, z0.y, z0.z, z0.w, z1.x, z1.y, z1.z, z1.w};
        float pre = bs;
#pragma unroll
        for (int r = 0; r < 8; ++r) { pre += __uint_as_float(zw[r] << 16) * upc[2 * r]; pre += __uint_as_float(zw[r] & 0xffff0000u) * upc[2 * r + 1]; }
        c[i] = log_sigmoid_f(pre) * (1.f / 16.f);
    }
    if (!BWD) {
#pragma unroll
        for (int i = 1; i < 8; ++i) c[i] += c[i - 1];
        tot[tg * 64 + d] = c[7];
    } else {
#pragma unroll
        for (int i = 6; i >= 0; --i) c[i] += c[i + 1];
        tot[tg * 64 + d] = c[0];
    }
    __syncthreads();
    float off = 0.f, all = 0.f;
#pragma unroll
    for (int t2 = 0; t2 < 8; ++t2) { const float v = tot[t2 * 64 + d]; all += v; if (BWD ? (t2 > tg) : (t2 < tg)) off += v; }
#pragma unroll
    for (int i = 0; i < 8; ++i) bv[i] = c[i] + off;
    bl = all;
}
__device__ __forceinline__ void gla_stage_vt(const bf16_t* vbase, LAS bf16_t* VT, int tid) {
    const int s = tid & 63, e0 = (tid >> 6) * 16;
    const uint4* vp = (const uint4*)(vbase + (size_t)s * PW + e0);
    const uint4 v0 = vp[0], v1 = vp[1];
    const unsigned w[8] = {v0.x, v0.y, v0.z, v0.w, v1.x, v1.y, v1.z, v1.w};
#pragma unroll
    for (int i = 0; i < 8; ++i) { VT[(e0 + 2 * i) * LDT + s] = (bf16_t)(w[i] & 0xffffu); VT[(e0 + 2 * i + 1) * LDT + s] = (bf16_t)(w[i] >> 16); }
}
__device__ __forceinline__ void gla_g1_unit(LAS unsigned char* lds, int tid, int unit, const bf16_t* PROJ, const float* upf, const float* bf_, const float* upb, const float* bb_, bf16_t* KVS, float* DEC) {
    const int n = unit & 63, h = (unit >> 6) & 3, b = unit >> 8;
    const int d = tid & 63, tg = tid >> 6, lane = tid & 63, w = tid >> 6;
    const size_t tok0 = (size_t)b * T + n * 64;
    LAS bf16_t* KET = (LAS bf16_t*)(lds + GL_QE); LAS bf16_t* VT = (LAS bf16_t*)(lds + GL_VT); LAS float* tot = (LAS float*)(lds + GL_TOT);
    gla_stage_vt(PROJ + tok0 * PW + C_GV + h * 128, VT, tid);
#pragma unroll
    for (int dir = 0; dir < 2; ++dir) {
        float bv[8], bl;
        if (dir == 0) gla_cumsum<false>(PROJ + tok0 * PW + C_ZF, upf, bf_, h * 64 + d, tg, d, tot, bv, bl);
        else          gla_cumsum<true>(PROJ + tok0 * PW + C_ZB, upb, bb_, h * 64 + d, tg, d, tot + 512, bv, bl);
        unsigned pk[4];
#pragma unroll
        for (int i = 0; i < 8; i += 2) {
            const float k0 = bf2f(PROJ[(tok0 + 8 * tg + i) * PW + C_GK + h * 64 + d]) * exp_fast(bl - bv[i]);
            const float k1 = bf2f(PROJ[(tok0 + 8 * tg + i + 1) * PW + C_GK + h * 64 + d]) * exp_fast(bl - bv[i + 1]);
            pk[i >> 1] = (unsigned)f2bf(k0) | ((unsigned)f2bf(k1) << 16);
        }
        *(LAS v4u*)(KET + d * LDT + 8 * tg) = (v4u){pk[0], pk[1], pk[2], pk[3]};
        const size_t sq = (((size_t)b * 4 + h) * 2 + dir) * 64 + n;
        if (tg == 0) DEC[sq * 64 + d] = exp_fast(bl);
        __syncthreads();
        bf16_t* kvo = KVS + sq * 8192;
#pragma unroll
        for (int dt = 0; dt < 4; ++dt) {
            gf32x4 acc = {0.f, 0.f, 0.f, 0.f};
            acc = mfma_tile64(VT + (16 * w) * LDT, KET + (16 * dt) * LDT, acc, lane);
#pragma unroll
            for (int r = 0; r < 4; ++r) kvo[(size_t)(16 * w + 4 * (lane >> 4) + r) * 64 + 16 * dt + (lane & 15)] = f2bf(acc[r]);
        }
        __syncthreads();
    }
}
typedef unsigned g2v2u __attribute__((ext_vector_type(2)));
template <bool BWD>
__device__ __forceinline__ void gla_g2_item(g2v2u* base  , const float* dc  ) {
    float s[4] = {0.f, 0.f, 0.f, 0.f};
#pragma unroll 1
    for (int hf = 0; hf < 4; ++hf) {
        g2v2u kv[16]; f32x4 dd[16];
#pragma unroll
        for (int st = 0; st < 16; ++st) { const int n = BWD ? (63 - 16 * hf - st) : (16 * hf + st); kv[st] = base[(size_t)n * 2048]; dd[st] = *(const f32x4*)(dc + n * 64); }
#pragma unroll
        for (int st = 0; st < 16; ++st) { const int n = BWD ? (63 - 16 * hf - st) : (16 * hf + st);
            base[(size_t)n * 2048] = (g2v2u){(unsigned)f2bf(s[0]) | ((unsigned)f2bf(s[1]) << 16), (unsigned)f2bf(s[2]) | ((unsigned)f2bf(s[3]) << 16)};
            s[0] = dd[st][0] * s[0] + __uint_as_float(kv[st][0] << 16); s[1] = dd[st][1] * s[1] + __uint_as_float(kv[st][0] & 0xffff0000u);
            s[2] = dd[st][2] * s[2] + __uint_as_float(kv[st][1] << 16); s[3] = dd[st][3] * s[3] + __uint_as_float(kv[st][1] & 0xffff0000u); }
    }
}
__device__ __forceinline__ void gla_g2_scan(int gtid, int nthr, bf16_t* KVS, const float* DEC) {
    for (int item = gtid; item < 64 * 2048; item += nthr) {
        const int seq = item >> 11, q4 = item & 2047, d4 = (q4 & 15) * 4;
        g2v2u* base = (g2v2u*)(KVS + (size_t)seq * 64 * 8192) + q4;
        const float* dc = DEC + (size_t)seq * 64 * 64 + d4;
        if (seq & 1) gla_g2_item<true>(base, dc); else gla_g2_item<false>(base, dc);
    }
}
__device__ __forceinline__ void gla_g3_unit(LAS unsigned char* lds, int tid, int unit, const bf16_t* PROJ, const float* upf, const float* bf_, const float* upb, const float* bb_, const bf16_t* KVS, const float* gain, bf16_t* MIXED) {
    const int n = unit & 63, h = (unit >> 6) & 3, b = unit >> 8;
    const int d = tid & 63, tg = tid >> 6, lane = tid & 63, w = tid >> 6;
    const size_t tok0 = (size_t)b * T + n * 64;
    LAS bf16_t* QE = (LAS bf16_t*)(lds + GL_QE); LAS bf16_t* KE = (LAS bf16_t*)(lds + GL_KE); LAS bf16_t* PP = (LAS bf16_t*)(lds + GL_P);
    LAS bf16_t* VT = (LAS bf16_t*)(lds + GL_VT); LAS bf16_t* ST = (LAS bf16_t*)(lds + GL_ST);
    LAS float* tot = (LAS float*)(lds + GL_TOT); LAS float* part = (LAS float*)(lds + GL_PART); LAS float* rs = (LAS float*)(lds + GL_RSTD);
    gla_stage_vt(PROJ + tok0 * PW + C_GV + h * 128, VT, tid);
    gf32x4 o[4];
#pragma unroll
    for (int rt = 0; rt < 4; ++rt) o[rt] = (gf32x4){0.f, 0.f, 0.f, 0.f};
#pragma unroll
    for (int dir = 0; dir < 2; ++dir) {
        float bv[8], bl;
        if (dir == 0) gla_cumsum<false>(PROJ + tok0 * PW + C_ZF, upf, bf_, h * 64 + d, tg, d, tot, bv, bl);
        else          gla_cumsum<true>(PROJ + tok0 * PW + C_ZB, upb, bb_, h * 64 + d, tg, d, tot + 512, bv, bl);
#pragma unroll
        for (int i = 0; i < 8; ++i) {
            const size_t ro = (tok0 + 8 * tg + i) * PW + h * 64 + d;
            const float e = exp_fast(bv[i]);
            QE[(8 * tg + i) * LDT + d] = f2bf(bf2f(PROJ[ro + C_GQ]) * e * 0.125f);
            KE[(8 * tg + i) * LDT + d] = f2bf(bf2f(PROJ[ro + C_GK]) * __builtin_amdgcn_rcpf(e));
        }
        {
            const size_t sq = (((size_t)b * 4 + h) * 2 + dir) * 64 + n;
            const int e = tid >> 2, part4 = tid & 3;
            const uint4* sp = (const uint4*)(KVS + sq * 8192 + e * 64 + part4 * 16);
            const uint4 s0 = sp[0], s1 = sp[1];
            *(LAS v4u*)(ST + e * LDT + part4 * 16) = (v4u){s0.x, s0.y, s0.z, s0.w}; *(LAS v4u*)(ST + e * LDT + part4 * 16 + 8) = (v4u){s1.x, s1.y, s1.z, s1.w};
        }
        __syncthreads();
        { const int ct = w >> 1;
#pragma unroll
          for (int j = 0; j < 2; ++j) { const int st = 2 * (w & 1) + j;
            gf32x4 acc = {0.f, 0.f, 0.f, 0.f};
            acc = mfma_tile64(QE + (16 * ct) * LDT, KE + (16 * st) * LDT, acc, lane);
            const int s = 16 * st + (lane & 15);
#pragma unroll
            for (int r = 0; r < 4; ++r) { const int c = 16 * ct + 4 * (lane >> 4) + r; const bool keep = dir ? (s >= c) : (s <= c);
                PP[c * LDT + s] = f2bf(keep ? acc[r] : 0.f); } } }
        __syncthreads();
#pragma unroll
        for (int rt = 0; rt < 4; ++rt) {
            o[rt] = mfma_tile64(PP + (16 * rt) * LDT, VT + (16 * w) * LDT, o[rt], lane);
            o[rt] = mfma_tile64(QE + (16 * rt) * LDT, ST + (16 * w) * LDT, o[rt], lane);
        }
        __syncthreads();
    }
#pragma unroll
    for (int rt = 0; rt < 4; ++rt)
#pragma unroll
        for (int r = 0; r < 4; ++r) {
            float ss = o[rt][r] * o[rt][r];
            ss += __shfl_xor(ss, 1); ss += __shfl_xor(ss, 2); ss += __shfl_xor(ss, 4); ss += __shfl_xor(ss, 8);
            if ((lane & 15) == 0) part[w * 64 + 16 * rt + 4 * (lane >> 4) + r] = ss;
        }
    __syncthreads();
    if (tid < 64) { float ss = 0.f;
#pragma unroll
        for (int t2 = 0; t2 < 8; ++t2) ss += part[t2 * 64 + tid];
        rs[tid] = rsqrtf(ss * (1.f / 128.f) + EPS); }
    __syncthreads();
    { const int e = 16 * w + (lane & 15); const float ge = gain[e];
#pragma unroll
      for (int rt = 0; rt < 4; ++rt)
#pragma unroll
        for (int r = 0; r < 4; ++r) { const int c = 16 * rt + 4 * (lane >> 4) + r;
            const float g = bf2f(PROJ[(tok0 + c) * PW + C_GG + h * 128 + e]);
            MIXED[(tok0 + c) * D + h * 128 + e] = f2bf(o[rt][r] * rs[c] * ge * g * __builtin_amdgcn_rcpf(1.f + exp_fast(-g))); } }
    __syncthreads();
}

constexpr size_t WS_BFRAG = 12 * MiB;
__device__ __forceinline__ void router_build_bfrag(int gtid, int nthr, const float* wg, const float* we, const float* g2, bf16_t* BF) {
    for (int i = gtid; i < 32 * 5 * 64; i += nthr) {
        const int ks = i / 320, rem = i - ks * 320, ct = rem >> 6, lane = rem & 63, col = 16 * ct + (lane & 15);
        unsigned hi[4], lo[4];
#pragma unroll
        for (int j = 0; j < 8; ++j) {
            const int k = 32 * ks + 8 * (lane >> 4) + j;
            float w = col < 8 ? wg[k * 8 + col] : (col < 72 ? we[k * 64 + col - 8] : 0.f);
            w *= g2[k];
            const bf16_t h = f2bf(w); const bf16_t l = f2bf(w - bf2f(h));
            if (j & 1) { hi[j >> 1] |= (unsigned)h << 16; lo[j >> 1] |= (unsigned)l << 16; } else { hi[j >> 1] = h; lo[j >> 1] = l; }
        }
        uint4* o = (uint4*)(BF + ((size_t)(ks * 5 + ct) * 2) * 512 + lane * 8);
        o[0] = make_uint4(hi[0], hi[1], hi[2], hi[3]); o[64] = make_uint4(lo[0], lo[1], lo[2], lo[3]);
    }
}
__device__ __forceinline__ void ph_router_mfma(int gw, int NGW, int lane, LAS float* lsm  , const bf16_t* H, const bf16_t* BF, const float* bg, const float* be, float* RSTD, unsigned* tokinfo, LAS int* hist, bool dry) {
    for (int task = gw; task < NTOK / 16; task += NGW) {
        const int t0 = task * 16, row = lane & 15, kg = lane >> 4;
        const bf16_t* hp = H + (size_t)(t0 + row) * D + kg * 8;
        gf32x4 acc[5];
#pragma unroll
        for (int ct = 0; ct < 5; ++ct) acc[ct] = (gf32x4){0.f, 0.f, 0.f, 0.f};
        float ss = 0.f;
#pragma unroll 2
        for (int ks = 0; ks < 32; ++ks) {
            const gbf16x8 ah = *(const gbf16x8*)(hp + ks * 32);
#pragma unroll
            for (int j = 0; j < 8; ++j) { const float xv = bf2f((bf16_t)ah[j]); ss += xv * xv; }
            const gbf16x8* bp = (const gbf16x8*)(BF + (size_t)ks * 5 * 2 * 512) + lane;
#pragma unroll
            for (int ct = 0; ct < 5; ++ct) {
                const gbf16x8 bh = bp[(ct * 2) * 64], bl = bp[(ct * 2 + 1) * 64];
                acc[ct] = __builtin_amdgcn_mfma_f32_16x16x32_bf16(ah, bh, acc[ct], 0, 0, 0);
                acc[ct] = __builtin_amdgcn_mfma_f32_16x16x32_bf16(ah, bl, acc[ct], 0, 0, 0);
            }
        }
        ss += __shfl_xor(ss, 16); ss += __shfl_xor(ss, 32);
        const float rstd = rsqrtf(ss * (1.f / D) + EPS);
#pragma unroll
        for (int ct = 0; ct < 5; ++ct) { const int col = 16 * ct + row; const float bias = col < 8 ? bg[col] : (col < 72 ? be[col - 8] : 0.f);
#pragma unroll
            for (int r = 0; r < 4; ++r) { const int rr = 4 * kg + r; const float rs = __shfl(rstd, rr); lsm[rr * 80 + col] = acc[ct][r] * rs + bias; } }
        asm volatile("s_waitcnt lgkmcnt(0)" ::: "memory");
        if (lane < 16) {
            const LAS float* L = lsm + lane * 80;
            float best = L[0]; int g = 0;
#pragma unroll
            for (int i = 1; i < 8; ++i) { const float v = L[i]; if (v > best) { best = v; g = i; } }
            float den = 0.f;
#pragma unroll
            for (int i = 0; i < 8; ++i) den += expf(L[i] - best);
            const float gw_ = 1.f / den;
            const LAS float* E = L + 8 + g * 8;
            float v1 = E[0]; int i1 = 0;
#pragma unroll
            for (int j = 1; j < 8; ++j) { const float v = E[j]; if (v > v1) { v1 = v; i1 = j; } }
            float v2 = -INFINITY; int i2 = 0;
#pragma unroll
            for (int j = 0; j < 8; ++j) { const float v = E[j]; if (j != i1 && v > v2) { v2 = v; i2 = j; } }
            const float ex = expf(v2 - v1), p1 = 1.f / (1.f + ex), p2 = ex * p1;
            const int e1 = g * 8 + i1, e2 = g * 8 + i2, t = t0 + lane;
            uint4 o; o.x = (unsigned)e1; o.y = (unsigned)e2; o.z = __float_as_uint(gw_ * p1); o.w = __float_as_uint(gw_ * p2);
            ((uint4*)tokinfo)[t] = o;
            RSTD[t] = rstd;
            if (!dry) { __hip_atomic_fetch_add(hist + e1, 1, __ATOMIC_RELAXED, __HIP_MEMORY_SCOPE_WORKGROUP); __hip_atomic_fetch_add(hist + e2, 1, __ATOMIC_RELAXED, __HIP_MEMORY_SCOPE_WORKGROUP); }
        }
        asm volatile("s_waitcnt lgkmcnt(0)" ::: "memory");
    }
}

__device__ __forceinline__ void ph_router_lds(int vcu, int G, int wave, int lane, LAS unsigned char* lds, const bf16_t* H, const bf16_t* BF, const float* bg, const float* be, float* RSTD, unsigned* tokinfo, LAS int* hist, bool dry) {
    for (int tg = vcu; tg < NTOK / 128; tg += G) {
        const int t0 = (tg * 8 + wave) * 16, row = lane & 15, kg = lane >> 4;
        const bf16_t* hp = H + (size_t)(t0 + row) * D + kg * 8;
        gf32x4 acc[5];
#pragma unroll
        for (int ct = 0; ct < 5; ++ct) acc[ct] = (gf32x4){0.f, 0.f, 0.f, 0.f};
        float ss = 0.f;
        gbf16x8 ha[2][4];
#define RT_DMA(j) do { _Pragma("unroll") for (int i = 0; i < 5; ++i) __builtin_amdgcn_global_load_lds((const unsigned*)(BF + (size_t)(j) * 20480 + (wave + 8 * i) * 512 + lane * 8), \
            (LAS unsigned*)(lds + ((j) & 1) * 65536 + (wave + 8 * i) * 1024), 16, 0, 0); } while (0)
#define RT_LDH(j) do { _Pragma("unroll") for (int k = 0; k < 4; ++k) ha[(j) & 1][k] = *(const GAS gbf16x8*)(hp + ((j) * 4 + k) * 32); } while (0)
        RT_DMA(0); RT_LDH(0);
#pragma unroll
        for (int j = 0; j < 8; ++j) {
            if (j + 1 < 8) { RT_DMA(j + 1); RT_LDH(j + 1); asm volatile("s_waitcnt vmcnt(9)" ::: "memory"); } else asm volatile("s_waitcnt vmcnt(0)" ::: "memory");
            __syncthreads();
            const LAS unsigned char* buf = lds + (j & 1) * 65536;
#pragma unroll
            for (int k = 0; k < 4; ++k) {
                const gbf16x8 ah = ha[j & 1][k];
#pragma unroll
                for (int e = 0; e < 8; ++e) { const float xv = bf2f((bf16_t)ah[e]); ss += xv * xv; }
#pragma unroll
                for (int ct = 0; ct < 5; ++ct) {
                    const gbf16x8 bh = *(const LAS gbf16x8*)(buf + ((k * 10 + ct * 2) * 64 + lane) * 16), bl = *(const LAS gbf16x8*)(buf + ((k * 10 + ct * 2 + 1) * 64 + lane) * 16);
                    acc[ct] = __builtin_amdgcn_mfma_f32_16x16x32_bf16(ah, bh, acc[ct], 0, 0, 0);
                    acc[ct] = __builtin_amdgcn_mfma_f32_16x16x32_bf16(ah, bl, acc[ct], 0, 0, 0);
                }
            }
            __syncthreads();
        }
#undef RT_DMA
#undef RT_LDH
        LAS float* lsm = (LAS float*)(lds + wave * 5120);
        ss += __shfl_xor(ss, 16); ss += __shfl_xor(ss, 32);
        const float rstd = rsqrtf(ss * (1.f / D) + EPS);
#pragma unroll
        for (int ct = 0; ct < 5; ++ct) { const int col = 16 * ct + row; const float bias = col < 8 ? bg[col] : (col < 72 ? be[col - 8] : 0.f);
#pragma unroll
            for (int r = 0; r < 4; ++r) { const int rr = 4 * kg + r; const float rs = __shfl(rstd, rr); lsm[rr * 80 + col] = acc[ct][r] * rs + bias; } }
        asm volatile("s_waitcnt lgkmcnt(0)" ::: "memory");
        if (lane < 16) {
            const LAS float* L = lsm + lane * 80;
            float best = L[0]; int g = 0;
#pragma unroll
            for (int i = 1; i < 8; ++i) { const float v = L[i]; if (v > best) { best = v; g = i; } }
            float den = 0.f;
#pragma unroll
            for (int i = 0; i < 8; ++i) den += expf(L[i] - best);
            const float gw_ = 1.f / den;
            const LAS float* E = L + 8 + g * 8;
            float v1 = E[0]; int i1 = 0;
#pragma unroll
            for (int j = 1; j < 8; ++j) { const float v = E[j]; if (v > v1) { v1 = v; i1 = j; } }
            float v2 = -INFINITY; int i2 = 0;
#pragma unroll
            for (int j = 0; j < 8; ++j) { const float v = E[j]; if (j != i1 && v > v2) { v2 = v; i2 = j; } }
            const float ex = expf(v2 - v1), p1 = 1.f / (1.f + ex), p2 = ex * p1;
            const int e1 = g * 8 + i1, e2 = g * 8 + i2, t = t0 + lane;
            uint4 o; o.x = (unsigned)e1; o.y = (unsigned)e2; o.z = __float_as_uint(gw_ * p1); o.w = __float_as_uint(gw_ * p2);
            ((uint4*)tokinfo)[t] = o;
            RSTD[t] = rstd;
            if (!dry) { __hip_atomic_fetch_add(hist + e1, 1, __ATOMIC_RELAXED, __HIP_MEMORY_SCOPE_WORKGROUP); __hip_atomic_fetch_add(hist + e2, 1, __ATOMIC_RELAXED, __HIP_MEMORY_SCOPE_WORKGROUP); }
        }
        asm volatile("s_waitcnt lgkmcnt(0)" ::: "memory");
        __syncthreads();
    }
}

constexpr int G_Z = 0, G_VT = 8192, G_G = 26624, G_ST0 = 43008, G_ST1 = 61440, G_BM = 79872, G_QE = 97280, G_KE = 106496, G_P = 115712, G_TOT = 124928, G_PART = 129024;
constexpr int BMS = 68;
typedef unsigned v2u __attribute__((ext_vector_type(2)));
struct GlaRaw3 { v4u q, k, z, v0, v1, g0, g1, sa0, sa1, sb0, sb1, oa0, oa1; float sq; };
struct GlaRaw1 { v4u k, z, v0, v1; };
__device__ __forceinline__ v4u ld16(const bf16_t* p) { return *(const GAS v4u*)p; }
__device__ __forceinline__ void gla_load3(GlaRaw3& R, int tid, int b, int h, int n, const bf16_t* PROJ, const bf16_t* KVS, const bf16_t* MIXED, const float* SSQ) {
    const size_t tok0 = (size_t)b * T + n * 64;
    const int s8 = tid >> 3, c8 = tid & 7, lane = tid & 63, w = tid >> 6;
    R.q = ld16(PROJ + (tok0 + s8) * PW + C_GQ + h * 64 + c8 * 8);
    R.k = ld16(PROJ + (tok0 + s8) * PW + C_GK + h * 64 + c8 * 8);
    if (tid < 256) R.z = ld16(PROJ + (tok0 + (tid >> 2)) * PW + C_ZF + (tid & 3) * 8);
    R.v0 = ld16(PROJ + (tok0 + (tid >> 4)) * PW + C_GV + h * 128 + (tid & 15) * 8); R.v1 = ld16(PROJ + (tok0 + (tid >> 4) + 32) * PW + C_GV + h * 128 + (tid & 15) * 8);
    const int s16 = tid >> 4, c16 = tid & 15;
    R.g0 = ld16(PROJ + (tok0 + s16) * PW + C_GG + h * 128 + c16 * 8); R.g1 = ld16(PROJ + (tok0 + s16 + 32) * PW + C_GG + h * 128 + c16 * 8);
    const size_t sq = (((size_t)b * 4 + h) * 2) * 64 + n;
    const bf16_t* sp = KVS + sq * 8192 + (tid >> 3) * 64 + (tid & 7) * 8;
    R.sa0 = ld16(sp); R.sa1 = ld16(sp + 64 * 64); R.sb0 = ld16(sp + (size_t)64 * 8192); R.sb1 = ld16(sp + (size_t)64 * 8192 + 64 * 64);
    R.sq = SSQ[(size_t)(tid >> 6) * NTOK + tok0 + (tid & 63)];
}
__device__ __forceinline__ void gla_store_z(LAS unsigned char* lds, int tid, v4u z) {
    if (tid < 256) { LAS f32x4* zp = (LAS f32x4*)(lds + G_Z) + (tid >> 2) * 8 + (tid & 3) * 2;
        zp[0] = (f32x4){__uint_as_float(z.x << 16), __uint_as_float(z.x & 0xffff0000u), __uint_as_float(z.y << 16), __uint_as_float(z.y & 0xffff0000u)};
        zp[1] = (f32x4){__uint_as_float(z.z << 16), __uint_as_float(z.z & 0xffff0000u), __uint_as_float(z.w << 16), __uint_as_float(z.w & 0xffff0000u)}; }
}
__device__ __forceinline__ void gla_store_vt(LAS unsigned char* lds, int tid, v4u v0, v4u v1) {
    LAS bf16_t* VT = (LAS bf16_t*)(lds + G_VT); const int c16 = tid & 15, sA = (tid >> 4) ^ (8 * (c16 & 7)), sB = sA ^ 32;
    const unsigned wa[4] = {v0.x, v0.y, v0.z, v0.w}, wb[4] = {v1.x, v1.y, v1.z, v1.w};
#pragma unroll
    for (int i = 0; i < 4; ++i) { LAS bf16_t* r0 = VT + (c16 * 8 + 2 * i) * LDT; LAS bf16_t* r1 = r0 + LDT;
        r0[sA] = (bf16_t)(wa[i] & 0xffffu); r1[sA] = (bf16_t)(wa[i] >> 16); r0[sB] = (bf16_t)(wb[i] & 0xffffu); r1[sB] = (bf16_t)(wb[i] >> 16); }
}
template <bool VA>
__device__ __forceinline__ gf32x4 mfma_tile64_v(const LAS bf16_t* X, const LAS bf16_t* VTw, int w, gf32x4 acc, int lane) {
    const int r = lane & 15, grp = lane >> 4, g = (2 * w + (r >> 3)) & 7;
    const gbf16x8 x0 = *(const LAS gbf16x8*)(X + r * LDT + grp * 8), x1 = *(const LAS gbf16x8*)(X + r * LDT + grp * 8 + 32);
    const gbf16x8 v0 = *(const LAS gbf16x8*)(VTw + r * LDT + ((grp ^ g) * 8)), v1 = *(const LAS gbf16x8*)(VTw + r * LDT + (((grp + 4) ^ g) * 8));
    if (VA) { acc = __builtin_amdgcn_mfma_f32_16x16x32_bf16(v0, x0, acc, 0, 0, 0); acc = __builtin_amdgcn_mfma_f32_16x16x32_bf16(v1, x1, acc, 0, 0, 0); }
    else    { acc = __builtin_amdgcn_mfma_f32_16x16x32_bf16(x0, v0, acc, 0, 0, 0); acc = __builtin_amdgcn_mfma_f32_16x16x32_bf16(x1, v1, acc, 0, 0, 0); }
    return acc;
}
constexpr int ZBS = 40, GL_UPT = 132096;
template <int DIR>
__device__ __forceinline__ void gla_cumsum3(LAS unsigned char* lds, float bias, int w, int lane, float (&bv)[2][4], float& bl) {
    const LAS bf16_t* ZB = (const LAS bf16_t*)(lds + G_Z); const LAS bf16_t* UPT = (const LAS bf16_t*)(lds + GL_UPT) + DIR * 64 * ZBS; LAS float* tot = (LAS float*)(lds + G_TOT);
    const int r16 = lane & 15, kg = lane >> 4, dcol = 16 * (w & 3) + r16, run0 = 8 * (w >> 2) + kg;
    const gbf16x8 bfr = *(const LAS gbf16x8*)(UPT + (16 * (w & 3) + r16) * ZBS + 8 * kg);
    float c[2][4];
#pragma unroll
    for (int j = 0; j < 2; ++j) {
        const gbf16x8 afr = *(const LAS gbf16x8*)(ZB + (32 * (w >> 2) + 16 * j + r16) * ZBS + 8 * kg);
        const gf32x4 acc = __builtin_amdgcn_mfma_f32_16x16x32_bf16(afr, bfr, (gf32x4){0.f, 0.f, 0.f, 0.f}, 0, 0, 0);
#pragma unroll
        for (int r = 0; r < 4; ++r) c[j][r] = log_sigmoid_f(acc[r] + bias) * (1.f / 16.f);
        if (DIR == 0) { c[j][1] += c[j][0]; c[j][2] += c[j][1]; c[j][3] += c[j][2]; tot[(run0 + 4 * j) * 64 + dcol] = c[j][3]; }
        else          { c[j][2] += c[j][3]; c[j][1] += c[j][2]; c[j][0] += c[j][1]; tot[(run0 + 4 * j) * 64 + dcol] = c[j][0]; }
    }
    __syncthreads();
    float off0 = 0.f, off1 = 0.f, all = 0.f;
#pragma unroll
    for (int q = 0; q < 16; ++q) { const float v = tot[q * 64 + dcol]; all += v;
        if (DIR ? (q > run0) : (q < run0)) off0 += v;
        if (DIR ? (q > run0 + 4) : (q < run0 + 4)) off1 += v; }
#pragma unroll
    for (int r = 0; r < 4; ++r) { bv[0][r] = c[0][r] + off0; bv[1][r] = c[1][r] + off1; }
    bl = all;
}
__device__ __forceinline__ void gla_store_zb(LAS unsigned char* lds, int tid, v4u z) { if (tid < 256) *(LAS v4u*)((LAS bf16_t*)(lds + G_Z) + (tid >> 2) * ZBS + (tid & 3) * 8) = z; }
__device__ __forceinline__ void gla_build_upt(LAS unsigned char* lds, int tid, int h, const float* upf, const float* upb) {
    LAS bf16_t* U0 = (LAS bf16_t*)(lds + GL_UPT); LAS bf16_t* U1 = U0 + 64 * ZBS;
    const int d = tid & 63, k0 = (tid >> 6) * 4;
    unsigned a0 = 0u, a1 = 0u, b0 = 0u, b1 = 0u;
    if (k0 < 16) { const float* p = upf + k0 * 256 + h * 64 + d; a0 = (unsigned)f2bf(p[0]) | ((unsigned)f2bf(p[256]) << 16); a1 = (unsigned)f2bf(p[512]) | ((unsigned)f2bf(p[768]) << 16); }
    else { const float* p = upb + (k0 - 16) * 256 + h * 64 + d; b0 = (unsigned)f2bf(p[0]) | ((unsigned)f2bf(p[256]) << 16); b1 = (unsigned)f2bf(p[512]) | ((unsigned)f2bf(p[768]) << 16); }
    *(LAS v2u*)(U0 + d * ZBS + k0) = (v2u){a0, a1}; *(LAS v2u*)(U1 + d * ZBS + k0) = (v2u){b0, b1};
}
__device__ __forceinline__ unsigned pk_bf2(float a, float b) { return (unsigned)f2bf(a) | ((unsigned)f2bf(b) << 16); }

__device__ __forceinline__ void gla_g3_phase(LAS unsigned char* lds, int tid, int bx, const bf16_t* PROJ, const float* upf, const float* bf_, const float* upb, const float* bb_, const bf16_t* KVS, const float* gain, bf16_t* MIXED, const float* SSQ, float* ratt) {
    const int n = bx & 63, h = (bx >> 6) & 3;
    const int d = tid & 63, tg = tid >> 6, lane = tid & 63, w = tid >> 6, s8 = tid >> 3, c8 = tid & 7;
    const int dcol = 16 * (w & 3) + (lane & 15), tk0 = 32 * (w >> 2) + 4 * (lane >> 4);
    const float bsF = bf_[h * 64 + dcol], bsB = bb_[h * 64 + dcol];
    gla_build_upt(lds, tid, h, upf, upb);
    float ge4[4];
#pragma unroll
    for (int r = 0; r < 4; ++r) ge4[r] = gain[16 * w + 4 * (lane >> 4) + r];
    LAS bf16_t* QE = (LAS bf16_t*)(lds + G_QE); LAS bf16_t* KE = (LAS bf16_t*)(lds + G_KE); LAS bf16_t* PP = (LAS bf16_t*)(lds + G_P);
    LAS bf16_t* VT = (LAS bf16_t*)(lds + G_VT); LAS bf16_t* GG = (LAS bf16_t*)(lds + G_G); LAS float* BM = (LAS float*)(lds + G_BM);
    LAS float* part = (LAS float*)(lds + G_PART); LAS float* rs = (LAS float*)(lds + G_TOT);
    GlaRaw3 R; gla_load3(R, tid, 0, h, n, PROJ, KVS, MIXED, SSQ);
    for (int b = 0; b < NB; ++b) {
        const size_t tok0 = (size_t)b * T + n * 64;
        const v4u cq = R.q, ck = R.k;
        gla_store_zb(lds, tid, R.z); gla_store_vt(lds, tid, R.v0, R.v1);
        { const int s16 = tid >> 4, c16 = tid & 15; *(LAS v4u*)(GG + s16 * 128 + c16 * 8) = R.g0; *(LAS v4u*)(GG + (s16 + 32) * 128 + c16 * 8) = R.g1; }
        { const int e = tid >> 3, c8_ = tid & 7; LAS bf16_t* s0 = (LAS bf16_t*)(lds + G_ST0) + e * LDT + c8_ * 8; LAS bf16_t* s1 = (LAS bf16_t*)(lds + G_ST1) + e * LDT + c8_ * 8;
          *(LAS v4u*)s0 = R.sa0; *(LAS v4u*)(s0 + 64 * LDT) = R.sa1; *(LAS v4u*)s1 = R.sb0; *(LAS v4u*)(s1 + 64 * LDT) = R.sb1; }
        part[tid] = R.sq;
        if (b + 1 < NB) gla_load3(R, tid, b + 1, h, n, PROJ, KVS, MIXED, SSQ);
        __syncthreads();
        if (tid < 64) { float q = 0.f;
#pragma unroll
            for (int hh = 0; hh < 8; ++hh) q += part[hh * 64 + tid];
            const float ms = q * (1.f / 512.f) + EPS; ((LAS float*)(lds + 143360))[tid] = sqrtf(ms); if (h == 0) ratt[tok0 + tid] = rsqrtf(ms); }
        gf32x4 o[4];
#pragma unroll
        for (int rt = 0; rt < 4; ++rt) o[rt] = (gf32x4){0.f, 0.f, 0.f, 0.f};
#pragma unroll
        for (int dir = 0; dir < 2; ++dir) {
            float bv[2][4], bl;
            if (dir == 0) gla_cumsum3<0>(lds, bsF, w, lane, bv, bl); else gla_cumsum3<1>(lds, bsB, w, lane, bv, bl);
#pragma unroll
            for (int j = 0; j < 2; ++j)
#pragma unroll
                for (int r = 0; r < 4; ++r) BM[(tk0 + 16 * j + r) * BMS + dcol] = bv[j][r];
            __syncthreads();
            {
                const f32x4 b0 = *(const LAS f32x4*)(BM + s8 * BMS + c8 * 8), b1 = *(const LAS f32x4*)(BM + s8 * BMS + c8 * 8 + 4);
                const float bb[8] = {b0.x, b0.y, b0.z, b0.w, b1.x, b1.y, b1.z, b1.w};
                const unsigned qw[4] = {cq.x, cq.y, cq.z, cq.w}, kw[4] = {ck.x, ck.y, ck.z, ck.w};
                unsigned qo[4], ko[4];
#pragma unroll
                for (int j = 0; j < 4; ++j) {
                    const float e0 = exp_fast(bb[2 * j]), e1 = exp_fast(bb[2 * j + 1]);
                    qo[j] = pk_bf2(__uint_as_float(qw[j] << 16) * e0 * 0.125f, __uint_as_float(qw[j] & 0xffff0000u) * e1 * 0.125f);
                    ko[j] = pk_bf2(__uint_as_float(kw[j] << 16) * __builtin_amdgcn_rcpf(e0), __uint_as_float(kw[j] & 0xffff0000u) * __builtin_amdgcn_rcpf(e1));
                }
                *(LAS v4u*)(QE + s8 * LDT + c8 * 8) = (v4u){qo[0], qo[1], qo[2], qo[3]}; *(LAS v4u*)(KE + s8 * LDT + c8 * 8) = (v4u){ko[0], ko[1], ko[2], ko[3]};
            }
            __syncthreads();
            { const int ct = w >> 1;
#pragma unroll
              for (int j = 0; j < 2; ++j) { const int st = 2 * (w & 1) + j;
                gf32x4 acc = {0.f, 0.f, 0.f, 0.f};
                acc = mfma_tile64(KE + (16 * st) * LDT, QE + (16 * ct) * LDT, acc, lane);
                const int c = 16 * ct + (lane & 15), s0 = 16 * st + 4 * (lane >> 4);
                float pv[4];
#pragma unroll
                for (int r = 0; r < 4; ++r) { const int s = s0 + r; const bool keep = dir ? (s >= c) : (s <= c); pv[r] = keep ? acc[r] : 0.f; }
                *(LAS v2u*)(PP + c * LDT + s0) = (v2u){pk_bf2(pv[0], pv[1]), pk_bf2(pv[2], pv[3])}; } }
            __syncthreads();
            const LAS bf16_t* ST = (const LAS bf16_t*)(lds + (dir ? G_ST1 : G_ST0));
#pragma unroll
            for (int rt = 0; rt < 4; ++rt) {
                o[rt] = mfma_tile64_v<true>(PP + (16 * rt) * LDT, VT + (16 * w) * LDT, w, o[rt], lane);
                o[rt] = mfma_tile64(ST + (16 * w) * LDT, QE + (16 * rt) * LDT, o[rt], lane);
            }
        }
#pragma unroll
        for (int rt = 0; rt < 4; ++rt) {
            float ss = o[rt][0] * o[rt][0] + o[rt][1] * o[rt][1] + o[rt][2] * o[rt][2] + o[rt][3] * o[rt][3];
            ss += __shfl_xor(ss, 16); ss += __shfl_xor(ss, 32);
            if (lane < 16) part[w * 64 + 16 * rt + lane] = ss;
        }
        __syncthreads();
        if (tid < 64) { float ss = 0.f;
#pragma unroll
            for (int t2 = 0; t2 < 8; ++t2) ss += part[t2 * 64 + tid];
            rs[tid] = rsqrtf(ss * (1.f / 128.f) + EPS) * ((LAS float*)(lds + 143360))[tid]; }
        __syncthreads();
#pragma unroll
        for (int rt = 0; rt < 4; ++rt) { const int c = 16 * rt + (lane & 15), e0 = 16 * w + 4 * (lane >> 4);
            const v2u gw2 = *(const LAS v2u*)(GG + c * 128 + e0);
            const float gv[4] = {__uint_as_float(gw2.x << 16), __uint_as_float(gw2.x & 0xffff0000u), __uint_as_float(gw2.y << 16), __uint_as_float(gw2.y & 0xffff0000u)};
            const float rc = rs[c]; float ov[4];
#pragma unroll
            for (int r = 0; r < 4; ++r) ov[r] = o[rt][r] * rc * ge4[r] * gv[r] * __builtin_amdgcn_rcpf(1.f + exp_fast(-gv[r]));
            *(GAS v2u*)(MIXED + (tok0 + c) * D + 512 + h * 128 + e0) = (v2u){pk_bf2(ov[0], ov[1]), pk_bf2(ov[2], ov[3])}; }
        __syncthreads();
    }
}
__device__ __forceinline__ void gla_load1(GlaRaw1& R, int tid, int b, int h, int n, const bf16_t* PROJ) {
    const size_t tok0 = (size_t)b * T + n * 64;
    const int s8 = tid >> 3, c8 = tid & 7, lane = tid & 63, w = tid >> 6;
    R.k = ld16(PROJ + (tok0 + s8) * PW + C_GK + h * 64 + c8 * 8);
    if (tid < 256) R.z = ld16(PROJ + (tok0 + (tid >> 2)) * PW + C_ZF + (tid & 3) * 8);
    R.v0 = ld16(PROJ + (tok0 + (tid >> 4)) * PW + C_GV + h * 128 + (tid & 15) * 8); R.v1 = ld16(PROJ + (tok0 + (tid >> 4) + 32) * PW + C_GV + h * 128 + (tid & 15) * 8);
}
__device__ __forceinline__ void gla_g1_phase(LAS unsigned char* lds, int tid, int bx, const bf16_t* PROJ, const float* upf, const float* bf_, const float* upb, const float* bb_, bf16_t* KVS, float* DEC) {
    const int n = bx & 63, h = (bx >> 6) & 3;
    const int d = tid & 63, tg = tid >> 6, lane = tid & 63, w = tid >> 6, s8 = tid >> 3, c8 = tid & 7;
    const int dcol = 16 * (w & 3) + (lane & 15), tk0 = 32 * (w >> 2) + 4 * (lane >> 4);
    const float bsF = bf_[h * 64 + dcol], bsB = bb_[h * 64 + dcol];
    gla_build_upt(lds, tid, h, upf, upb);
    LAS bf16_t* KR = (LAS bf16_t*)(lds + G_G); LAS bf16_t* KET = (LAS bf16_t*)(lds + G_QE); LAS bf16_t* VT = (LAS bf16_t*)(lds + G_VT);
    GlaRaw1 R; gla_load1(R, tid, 0, h, n, PROJ);
    for (int b = 0; b < NB; ++b) {
        gla_store_zb(lds, tid, R.z); gla_store_vt(lds, tid, R.v0, R.v1);
        *(LAS v4u*)(KR + s8 * LDT + c8 * 8) = R.k;
        if (b + 1 < NB) gla_load1(R, tid, b + 1, h, n, PROJ);
        __syncthreads();
#pragma unroll
        for (int dir = 0; dir < 2; ++dir) {
            float bv[2][4], bl;
            if (dir == 0) gla_cumsum3<0>(lds, bsF, w, lane, bv, bl); else gla_cumsum3<1>(lds, bsB, w, lane, bv, bl);
#pragma unroll
            for (int j = 0; j < 2; ++j) {
                const int t0 = tk0 + 16 * j;
                const unsigned p0 = pk_bf2(bf2f(KR[(t0 + 0) * LDT + dcol]) * exp_fast(bl - bv[j][0]), bf2f(KR[(t0 + 1) * LDT + dcol]) * exp_fast(bl - bv[j][1]));
                const unsigned p1 = pk_bf2(bf2f(KR[(t0 + 2) * LDT + dcol]) * exp_fast(bl - bv[j][2]), bf2f(KR[(t0 + 3) * LDT + dcol]) * exp_fast(bl - bv[j][3]));
                *(LAS v2u*)(KET + dcol * LDT + t0) = (v2u){p0, p1};
            }
            const size_t sq = (((size_t)b * 4 + h) * 2 + dir) * 64 + n;
            if (w < 4 && lane < 16) DEC[sq * 64 + dcol] = exp_fast(bl);
            __syncthreads();
            bf16_t* kvo = KVS + sq * 8192;
            LAS bf16_t* STG = (LAS bf16_t*)(lds + G_ST0);
#pragma unroll
            for (int dt = 0; dt < 4; ++dt) {
                gf32x4 acc = {0.f, 0.f, 0.f, 0.f};
                acc = mfma_tile64_v<false>(KET + (16 * dt) * LDT, VT + (16 * w) * LDT, w, acc, lane);
                *(LAS v2u*)(STG + (16 * w + (lane & 15)) * LDT + 16 * dt + 4 * (lane >> 4)) = (v2u){pk_bf2(acc[0], acc[1]), pk_bf2(acc[2], acc[3])};
            }
            asm volatile("s_waitcnt lgkmcnt(0)" ::: "memory");
#pragma unroll
            for (int j = 0; j < 2; ++j) { const int row = 16 * w + 8 * j + (lane >> 3);
                const v4u x = *(const LAS v4u*)(STG + row * LDT + (lane & 7) * 8); *(GAS v4u*)(kvo + (size_t)row * 64 + (lane & 7) * 8) = x; }
        }
        __syncthreads();
    }
}
#include <hip/hip_bf16.h>
#include <cmath>
namespace attn_body {
using bf16=__hip_bfloat16;
using bf16x8=__attribute__((ext_vector_type(8)))short;
using s16x4=__attribute__((ext_vector_type(4)))short;
using f32x16=__attribute__((ext_vector_type(16)))float;
using u32x4=__attribute__((ext_vector_type(4)))unsigned;
constexpr int BATCH=8,NHEAD=8,SEQ=4096,D=64,DM=2560,OP=1024;
constexpr int NW=8,QBLK=32,QB=QBLK*NW,KVBLK=64,NQB=SEQ/QB;
constexpr int ATTN_PITCH=DM, ATTN_UNIT_ROWS=QB;
__device__ __forceinline__ int crow(int r,int hi){return (r&3)+8*(r>>2)+4*hi;}
#define SBAR() __builtin_amdgcn_sched_barrier(0)
__device__ __forceinline__ void cmask(f32x16&p0,f32x16&p1,int jb,int qrel,int hi){
  const float NEG=-INFINITY; int kb=64*jb+4*hi;
  #pragma unroll
  for(int r=0;r<16;++r){int kv=kb+(r&3)+8*(r>>2); if(kv>qrel)p0[r]=NEG; if(kv+32>qrel)p1[r]=NEG;}
}

constexpr int NSLOT=3, SLOTB=8192;
constexpr int LDS_K=0, LDS_V=NSLOT*SLOTB, LDS_WS=2*NSLOT*SLOTB, LDS_OST=LDS_WS+NW*64*4, LDS_BYTES=LDS_OST+NW*4096;
constexpr bool FIXREF=true;
constexpr float C2=0.125f*1.4426950408889634f;
__device__ __forceinline__ void glds16(const void*gsrc,unsigned lds_dst){unsigned keep;
  asm volatile("s_mov_b32 %0, m0\n\ts_mov_b32 m0, %2\n\ts_nop 0\n\tglobal_load_lds_dwordx4 %1, off\n\ts_mov_b32 m0, %0":"=&s"(keep):"v"(gsrc),"s"(lds_dst):"memory");}
__device__ __forceinline__ float max3f(float a,float b,float c){float r;asm("v_max3_f32 %0, %1, %2, %3":"=v"(r):"v"(a),"v"(b),"v"(c));return r;}
__device__ __forceinline__ float max2f(float a,float b){float r;asm("v_max_f32_e32 %0, %1, %2":"=v"(r):"v"(a),"v"(b));return r;}
__device__ __forceinline__ float fadd_s(float a,float b){float r;asm("v_add_f32_e32 %0, %1, %2":"=v"(r):"v"(a),"v"(b));return r;}
__device__ __forceinline__ float fsub_s(float a,float b){float r;asm("v_sub_f32_e32 %0, %1, %2":"=v"(r):"v"(a),"v"(b));return r;}
typedef float f32x2_t __attribute__((ext_vector_type(2))); typedef __bf16 bf16x2_t __attribute__((ext_vector_type(2)));
__device__ __forceinline__ unsigned cvtpk_s(float lo,float hi){f32x2_t v={lo,hi};bf16x2_t b=__builtin_convertvector(v,bf16x2_t);return __builtin_bit_cast(unsigned,b);}
#define WAIT_BAR(N) asm volatile("s_waitcnt vmcnt(" #N ") lgkmcnt(0)\n\ts_barrier":::"memory")

__device__ __forceinline__ void qkt(f32x16&p0,f32x16&p1,const char*Kslot,const bf16x8*qr,const f32x16&negm,int r32,int hi){
  const char*kb=Kslot+r32*128; const int xs=(r32>>1)&7;
  #pragma unroll
  for(int d0=0;d0<4;++d0){
    const bf16x8 b0=*reinterpret_cast<const bf16x8*>(kb+(((2*d0+hi)^xs)<<4));
    const bf16x8 b1=*reinterpret_cast<const bf16x8*>(kb+(((2*d0+hi)^xs)<<4)+4096);
    if(d0==0){p0=__builtin_amdgcn_mfma_f32_32x32x16_bf16(b0,qr[0],negm,0,0,0);p1=__builtin_amdgcn_mfma_f32_32x32x16_bf16(b1,qr[0],negm,0,0,0);}
    else{p0=__builtin_amdgcn_mfma_f32_32x32x16_bf16(b0,qr[d0],p0,0,0,0);p1=__builtin_amdgcn_mfma_f32_32x32x16_bf16(b1,qr[d0],p1,0,0,0);}}
}
typedef __attribute__((address_space(3))) const char* lds_cptr;
typedef short v4i16_t __attribute__((ext_vector_type(4)));
struct KBases { int o[4]; };
__device__ __forceinline__ void kload8(bf16x8*kf,lds_cptr kring,const KBases&kb,int sl){
  #pragma unroll
  for(int d0=0;d0<4;++d0){ kf[2*d0]=*(const __attribute__((address_space(3))) bf16x8*)(kring+kb.o[d0]+sl); kf[2*d0+1]=*(const __attribute__((address_space(3))) bf16x8*)(kring+kb.o[d0]+sl+4096); }
}
__device__ __forceinline__ void kload2(bf16x8*kf,lds_cptr kring,const KBases&kb,int sl,int j){ kf[2*j]=*(const __attribute__((address_space(3))) bf16x8*)(kring+kb.o[j]+sl); kf[2*j+1]=*(const __attribute__((address_space(3))) bf16x8*)(kring+kb.o[j]+sl+4096); }
__device__ __forceinline__ s16x4 vtr(lds_cptr p){ return __builtin_bit_cast(s16x4,__builtin_amdgcn_ds_read_tr16_b64_v4i16((__attribute__((address_space(3))) v4i16_t*)p)); }
__device__ __forceinline__ float rowmax(const f32x16&p0,const f32x16&p1){
  float a=max3f(p0[0],p0[1],p1[0]),b=max3f(p0[2],p0[3],p1[1]);a=max3f(a,p1[2],p1[3]);
  #pragma unroll
  for(int r=4;r<16;r+=4){a=max3f(a,p0[r],p0[r+1]);b=max3f(b,p0[r+2],p0[r+3]);a=max3f(a,p1[r],p1[r+1]);b=max3f(b,p1[r+2],p1[r+3]);}
  const float m=max2f(a,b);
  auto rr=__builtin_amdgcn_permlane32_swap(__float_as_uint(m),__float_as_uint(m),false,false);
  return max2f(__uint_as_float(rr[0]),__uint_as_float(rr[1]));
}
__device__ __forceinline__ void pv(f32x16*o,int vb,bf16x8 pa0,bf16x8 pa1,bf16x8 pa2,bf16x8 pa3){
  #pragma unroll
  for(int d0=0;d0<2;++d0){s16x4 lo[4],hi[4];
    #pragma unroll
    for(int ks=0;ks<4;++ks){
      asm volatile("ds_read_b64_tr_b16 %0,%1 offset:%c2":"=&v"(lo[ks]):"v"(vb),"i"(d0*4096+ks*1024):"memory");
      asm volatile("ds_read_b64_tr_b16 %0,%1 offset:%c2":"=&v"(hi[ks]):"v"(vb),"i"(d0*4096+ks*1024+512):"memory");}
    asm volatile("s_waitcnt lgkmcnt(0)":::"memory");SBAR();
    #define PK(k) (bf16x8){lo[k][0],lo[k][1],lo[k][2],lo[k][3],hi[k][0],hi[k][1],hi[k][2],hi[k][3]}
    o[d0]=__builtin_amdgcn_mfma_f32_32x32x16_bf16(pa0,PK(0),o[d0],0,0,0);
    o[d0]=__builtin_amdgcn_mfma_f32_32x32x16_bf16(pa1,PK(1),o[d0],0,0,0);
    o[d0]=__builtin_amdgcn_mfma_f32_32x32x16_bf16(pa2,PK(2),o[d0],0,0,0);
    o[d0]=__builtin_amdgcn_mfma_f32_32x32x16_bf16(pa3,PK(3),o[d0],0,0,0);
    #undef PK
  }
}

#ifndef ATTN_STORE16
#define ATTN_STORE16(p,v) (*(u32x4*)(p)=(v))
#endif
template<int THRL> __device__ __forceinline__ void attn_unit(int b,int h,int qb,const bf16*Q,const bf16*__restrict__ K,const bf16*__restrict__ V,bf16*O,char*shm,const float*qg,const float*rope,float*ssq,float sbound){
  const int tid=threadIdx.x,lane=tid&63,r32=lane&31,hi=lane>>5; const int wid=__builtin_amdgcn_readfirstlane(tid>>6);
  const long rowbase=(long)b*SEQ; const int q0=qb*QB;
  const bf16*Qw=Q+(rowbase+q0+wid*QBLK)*DM+h*D;
  const bf16*Kh=K+rowbase*DM+(h>>2)*D,*Vh=V+rowbase*DM+(h>>2)*D;
  const unsigned lds0=(unsigned)(uintptr_t)shm;
  float*wsf=(float*)(shm+LDS_WS)+wid*64;
  const unsigned koff=(unsigned)((8*wid+(lane>>3))*DM+(((lane&7)^((4*wid+(lane>>4))&7))*8)),
  voff_dummy_=0u, voff=(unsigned)((16*(wid&3)+(lane>>2))*DM+(wid>>2)*32+(lane&3)*8);
  const unsigned kdst=lds0+LDS_K+wid*1024, vdst=lds0+LDS_V+wid*1024;
  #define DMA_K(t,slot) glds16(Kh+(long)(t)*KVBLK*DM+koff,(unsigned)__builtin_amdgcn_readfirstlane(kdst+(slot)))
  #define DMA_V(t,slot) glds16(Vh+(long)(t)*KVBLK*DM+voff,(unsigned)__builtin_amdgcn_readfirstlane(vdst+(slot)))
  const int vb0=(int)(lds0+LDS_V)+((lane>>4)&1)*32+(lane&3)*8+(4*hi+((lane&15)>>2))*64;
  const char*Kbase=shm+LDS_K; bf16x8 kf[8];
  const lds_cptr shm3=(lds_cptr)shm; const lds_cptr kring=shm3+LDS_K; KBases kbs; _Pragma("unroll") for(int d0=0;d0<4;++d0)kbs.o[d0]=r32*128+(((2*d0+hi)^((r32>>1)&7))<<4); const lds_cptr vp0=shm3+LDS_V+((lane>>4)&1)*32+(lane&3)*8+(4*hi+((lane&15)>>2))*64;
  const int NT=SEQ/KVBLK;
  DMA_K(0,0);DMA_V(0,0);DMA_K(1,SLOTB);
  bf16x8 qr[4];
  #pragma unroll
  for(int d0=0;d0<4;++d0)qr[d0]=*reinterpret_cast<const bf16x8*>(&Qw[(long)r32*DM+d0*16+hi*8]);
  {
    float x[4][8]; float ss=0.f;
    #pragma unroll
    for(int d0=0;d0<4;++d0){
      #pragma unroll
      for(int j=0;j<8;++j){ x[d0][j]=__uint_as_float(((unsigned)(unsigned short)qr[d0][j])<<16); ss+=x[d0][j]*x[d0][j]; } }
    ss+=__shfl_xor(ss,32);
    const float rstd=rsqrtf(ss*(1.f/64.f)+1e-6f);
    const int tt=q0+wid*QBLK+r32, prow=tt>>6, pcol=tt&63;
    #pragma unroll
    for(int d0=0;d0<4;++d0){
      const float4 g0=*reinterpret_cast<const float4*>(qg+d0*16+hi*8), g1=*reinterpret_cast<const float4*>(qg+d0*16+hi*8+4);
      const int pos=(d0<2)?prow:pcol, i0=8*(d0&1)+4*hi;
      const float4 c4=*reinterpret_cast<const float4*>(rope+pos*16+i0), s4=*reinterpret_cast<const float4*>(rope+1024+pos*16+i0);
      const float gg[8]={g0.x,g0.y,g0.z,g0.w,g1.x,g1.y,g1.z,g1.w}, cc[4]={c4.x,c4.y,c4.z,c4.w}, sn[4]={s4.x,s4.y,s4.z,s4.w};
      u32x4 pw;
      #pragma unroll
      for(int jj=0;jj<4;++jj){ const float y0=x[d0][2*jj]*rstd*gg[2*jj], y1=x[d0][2*jj+1]*rstd*gg[2*jj+1];
        pw[jj]=cvtpk_s((y0*cc[jj]-y1*sn[jj])*C2,(y0*sn[jj]+y1*cc[jj])*C2); }
      qr[d0]=__builtin_bit_cast(bf16x8,pw); } }
  float mhat=0.f,l_reg=0.f;f32x16 o[2];o[0]=f32x16{};o[1]=f32x16{};f32x16 negm; _Pragma("unroll") for(int r=0;r<16;++r)negm[r]=FIXREF?-sbound:0.f; asm volatile("":"+v"(negm));

  #define CMASK(P0,P1,t) do{}while(0)
  bool resc=false;
  #define START(P0,P1) do{ resc=false; if(!FIXREF) \
    { const float rm=rowmax(P0,P1); const float dl=rm; mhat=fadd_s(mhat,dl); \
      _Pragma("unroll") for(int r=0;r<16;++r){P0[r]=fsub_s(P0[r],dl);P1[r]=fsub_s(P1[r],dl);} \
      _Pragma("unroll") for(int r=0;r<16;++r)negm[r]=-mhat; asm volatile("":"+v"(negm)); } \
    _Pragma("unroll") for(int r=0;r<16;++r)P0[r]=__builtin_amdgcn_exp2f(P0[r]); }while(0)
  #define RESC() do{ if(resc){ asm volatile("s_waitcnt lgkmcnt(0)":::"memory"); \
      _Pragma("unroll") for(int d_=0;d_<2;++d_) _Pragma("unroll") for(int r=0;r<16;++r)o[d_][r]*=wsf[crow(r,hi)]; } }while(0)
  f32x16 pA0,pA1,pB0,pB1;
  int sl_prev=0,sl_cur=0,sl_next=SLOTB;
  #define ROT() do{sl_prev=sl_cur;sl_cur=sl_next;sl_next=(sl_next==(NSLOT-1)*SLOTB)?0:sl_next+SLOTB;}while(0)
  DMA_K(2,2*SLOTB);
  WAIT_BAR(3);
  qkt(pA0,pA1,Kbase,qr,negm,r32,hi);asm volatile("s_nop 15\n\ts_nop 7":"+v"(pA0),"+v"(pA1));CMASK(pA0,pA1,0);
  START(pA0,pA1);
  _Pragma("unroll") for(int r=0;r<16;++r)pA1[r]=__builtin_amdgcn_exp2f(pA1[r]);
  WAIT_BAR(0);
  DMA_K(3,0);DMA_V(1,SLOTB);
  ROT();
  kload8(kf,kring,kbs,sl_cur);
  WAIT_BAR(2);
  s16x4 vlo[8],vhi[8]; u32x4 pw0,pw1,pw2,pw3;
  #define PKW(P,B) cvtpk_s(P[B],P[B+1])
  #define PAF(k) __builtin_bit_cast(bf16x8,pw##k)
  #define VFR(i) (bf16x8){vlo[i][0],vlo[i][1],vlo[i][2],vlo[i][3],vhi[i][0],vhi[i][1],vhi[i][2],vhi[i][3]}
  #define PIN(x) asm volatile("":"+v"(x))
  #define MX3(a,b,c) __builtin_fmaxf(__builtin_fmaxf((a),(b)),(c))
  #define GAPA(MF,A0,A1,A2,A3,W0,W1,PW) do{ MF; sacc+=A0; sacc+=A1; sacc+=A2; sacc+=A3; PIN(sacc); W0; W1; PIN(PW); SBAR(); }while(0)
  #define EX(v) __builtin_amdgcn_exp2f(v)
  #define GAPB(MF,X,B) do{ MF; X[B]=EX(X[B]); X[B+1]=EX(X[B+1]); X[B+2]=EX(X[B+2]); X[B+3]=EX(X[B+3]); PIN(X); SBAR(); }while(0)
  #define VRD(i) do{ vlo[i]=vtr(vp_+(((i)>>2)*4096+((i)&3)*1024)); vhi[i]=vtr(vp_+(((i)>>2)*4096+((i)&3)*1024+512)); }while(0)
  #define KRD(G,j) do{ if(G){ kload2(kf,kring,kbs,sl_next,j); SBAR(); } }while(0)
  #define STEP(C0,C1,P0,P1,t,GK,GV,GL) do{ SBAR(); \
    const lds_cptr vp_=vp0+sl_prev; \
    VRD(0); SBAR(); float sacc=(P0[0]+P0[1]); \
    GAPA(C0=__builtin_amdgcn_mfma_f32_32x32x16_bf16(kf[0],qr[0],negm,0,0,0), P0[2],P0[3],P0[4],P0[5],     pw0[0]=PKW(P0,0), pw0[1]=PKW(P0,2), pw0); \
    VRD(4); SBAR(); GAPA(C1=__builtin_amdgcn_mfma_f32_32x32x16_bf16(kf[1],qr[0],negm,0,0,0), P0[6],P0[7],P0[8],P0[9],     pw0[2]=PKW(P0,4), pw0[3]=PKW(P0,6), pw0); \
    VRD(1); SBAR(); GAPA(C0=__builtin_amdgcn_mfma_f32_32x32x16_bf16(kf[2],qr[1],C0,0,0,0),   P0[10],P0[11],P0[12],P0[13], pw1[0]=PKW(P0,8), pw1[1]=PKW(P0,10), pw1); \
    VRD(5); SBAR(); GAPA(C1=__builtin_amdgcn_mfma_f32_32x32x16_bf16(kf[3],qr[1],C1,0,0,0),   P0[14],P0[15],P1[0],P1[1],   pw1[2]=PKW(P0,12),pw1[3]=PKW(P0,14), pw1); \
    VRD(2); SBAR(); GAPA(C0=__builtin_amdgcn_mfma_f32_32x32x16_bf16(kf[4],qr[2],C0,0,0,0),   P1[2],P1[3],P1[4],P1[5],     pw2[0]=PKW(P1,0), pw2[1]=PKW(P1,2), pw2); \
    VRD(6); SBAR(); GAPA(C1=__builtin_amdgcn_mfma_f32_32x32x16_bf16(kf[5],qr[2],C1,0,0,0),   P1[6],P1[7],P1[8],P1[9],     pw2[2]=PKW(P1,4), pw2[3]=PKW(P1,6), pw2); \
    VRD(3); SBAR(); GAPA(C0=__builtin_amdgcn_mfma_f32_32x32x16_bf16(kf[6],qr[3],C0,0,0,0),   P1[10],P1[11],P1[12],P1[13], pw3[0]=PKW(P1,8), pw3[1]=PKW(P1,10), pw3); \
    VRD(7); SBAR(); GAPA(C1=__builtin_amdgcn_mfma_f32_32x32x16_bf16(kf[7],qr[3],C1,0,0,0),   P1[14],P1[15],0.f,0.f,       pw3[2]=PKW(P1,12),pw3[3]=PKW(P1,14), pw3); \
    l_reg+=sacc; \
    if(GK){DMA_K((t)+3,sl_cur);} if(GV){DMA_V((t)+1,sl_next);} \
    CMASK(C0,C1,t); \
    if(!FIXREF){ float a=MX3(C0[0],C0[1],C1[0]),b=MX3(C0[2],C0[3],C1[1]); a=MX3(a,C1[2],C1[3]); \
      _Pragma("unroll") for(int r=4;r<16;r+=4){a=MX3(a,C0[r],C0[r+1]);b=MX3(b,C0[r+2],C0[r+3]);a=MX3(a,C1[r],C1[r+1]);b=MX3(b,C1[r+2],C1[r+3]);} \
      float rm=__builtin_fmaxf(a,b); { auto rr=__builtin_amdgcn_permlane32_swap(__float_as_uint(rm),__float_as_uint(rm),false,false); rm=__builtin_fmaxf(__uint_as_float(rr[0]),__uint_as_float(rr[1])); } \
      resc=false; \
      if(__builtin_expect(__any(rm>(float)THRL),0)){ const float dl=__builtin_fmaxf(rm,0.f); mhat+=dl; \
        _Pragma("unroll") for(int r=0;r<16;++r){C0[r]-=dl;C1[r]-=dl;} \
        _Pragma("unroll") for(int r=0;r<16;++r)negm[r]=-mhat; asm volatile("":"+v"(negm)); \
        const float f=__builtin_amdgcn_exp2f(-dl); l_reg*=f; if(hi==0)wsf[r32]=f; resc=true; } } \
    SBAR(); \
    GAPB(o[0]=__builtin_amdgcn_mfma_f32_32x32x16_bf16(PAF(0),VFR(0),o[0],0,0,0), C0,0); \
    GAPB(o[1]=__builtin_amdgcn_mfma_f32_32x32x16_bf16(PAF(0),VFR(4),o[1],0,0,0), C0,4); \
    KRD(GL,0); GAPB(o[0]=__builtin_amdgcn_mfma_f32_32x32x16_bf16(PAF(1),VFR(1),o[0],0,0,0), C0,8); \
    KRD(GL,1); GAPB(o[1]=__builtin_amdgcn_mfma_f32_32x32x16_bf16(PAF(1),VFR(5),o[1],0,0,0), C0,12); \
    KRD(GL,2); GAPB(o[0]=__builtin_amdgcn_mfma_f32_32x32x16_bf16(PAF(2),VFR(2),o[0],0,0,0), C1,0); \
    KRD(GL,3); GAPB(o[1]=__builtin_amdgcn_mfma_f32_32x32x16_bf16(PAF(2),VFR(6),o[1],0,0,0), C1,4); \
    GAPB(o[0]=__builtin_amdgcn_mfma_f32_32x32x16_bf16(PAF(3),VFR(3),o[0],0,0,0), C1,8); \
    GAPB(o[1]=__builtin_amdgcn_mfma_f32_32x32x16_bf16(PAF(3),VFR(7),o[1],0,0,0), C1,12); \
    }while(0)
  int t=1;
  #undef CMASK
  #define CMASK(P0,P1,t) do{}while(0)
  for(;t+5<NT;t+=2){
    STEP(pB0,pB1,pA0,pA1,t,true,true,true);     WAIT_BAR(2); RESC(); ROT();
    STEP(pA0,pA1,pB0,pB1,t+1,true,true,true);   WAIT_BAR(2); RESC(); ROT();
  }
  #undef CMASK
  #define CMASK(P0,P1,t) do{}while(0)
  #define ENDW(tt) do{ if((tt)+3<NT){WAIT_BAR(2);} else if((tt)+2<NT){WAIT_BAR(1);} else {WAIT_BAR(0);} }while(0)
  for(;t+1<NT;t+=2){
    STEP(pB0,pB1,pA0,pA1,t,(t+3<NT),(t+1<NT),(t+1<NT));       ENDW(t);   RESC(); ROT();
    STEP(pA0,pA1,pB0,pB1,t+1,(t+4<NT),(t+2<NT),(t+2<NT));     ENDW(t+1); RESC(); ROT();
  }
  STEP(pB0,pB1,pA0,pA1,NT-1,false,false,false); RESC();
  { float sacc=pB0[0]+pB0[1]; _Pragma("unroll") for(int r=2;r<16;++r)sacc+=pB0[r]; _Pragma("unroll") for(int r=0;r<16;++r)sacc+=pB1[r]; l_reg+=sacc;
    pw0=(u32x4){PKW(pB0,0),PKW(pB0,2),PKW(pB0,4),PKW(pB0,6)};pw1=(u32x4){PKW(pB0,8),PKW(pB0,10),PKW(pB0,12),PKW(pB0,14)};pw2=(u32x4){PKW(pB1,0),PKW(pB1,2),PKW(pB1,4),PKW(pB1,6)};pw3=(u32x4){PKW(pB1,8),PKW(pB1,10),PKW(pB1,12),PKW(pB1,14)};
    SBAR(); pv(o,vb0+sl_cur,PAF(0),PAF(1),PAF(2),PAF(3)); }
  #undef PKW
  #undef PAF
  #undef VFR
  #undef PIN
  #undef MX3
  #undef GAPA
  #undef GAPB
  #undef EX
  #undef VRD
  #undef KRD
  #undef STEP
  #undef ENDW
  {auto rr=__builtin_amdgcn_permlane32_swap(__float_as_uint(l_reg),__float_as_uint(l_reg),false,false);l_reg=__uint_as_float(rr[0])+__uint_as_float(rr[1]);}
  if(hi==0)wsf[32+r32]=l_reg;asm volatile("s_waitcnt lgkmcnt(0)":::"memory");
  float rli[16];
  #pragma unroll
  for(int r=0;r<16;++r)rli[r]=__builtin_amdgcn_rcpf(wsf[32+crow(r,hi)]);
  bf16*Ow=O+(rowbase+q0+wid*QBLK)*OP+h*D;
  { bf16*stg=(bf16*)(shm+LDS_OST)+wid*2048;
    #pragma unroll
    for(int r=0;r<16;++r){const int orow=crow(r,hi);
      #pragma unroll
      for(int d0=0;d0<2;++d0)stg[orow*64+d0*32+r32]=__float2bfloat16(o[d0][r]*rli[r]);}
    asm volatile("s_waitcnt lgkmcnt(0)":::"memory");
    #pragma unroll
    for(int i=0;i<4;++i){const int row=i*8+(lane>>3),ch=lane&7; const u32x4 v=*(const u32x4*)(stg+row*64+ch*8); ATTN_STORE16(Ow+(long)row*OP+ch*8,v);
      float sq=0.f;
      #pragma unroll
      for(int k=0;k<4;++k){ const float lo=__uint_as_float(v[k]<<16), hi_=__uint_as_float(v[k]&0xffff0000u); sq+=lo*lo+hi_*hi_; }
      sq+=__shfl_xor(sq,1); sq+=__shfl_xor(sq,2); sq+=__shfl_xor(sq,4);
      if(ch==0) ssq[(long)h*(BATCH*SEQ)+rowbase+q0+wid*QBLK+row]=sq; } }
  asm volatile("s_waitcnt lgkmcnt(0)\n\ts_barrier":::"memory");
  #undef DMA_K
  #undef DMA_V
  #undef CMASK
  #undef START
  #undef RESC
  #undef ROT
}
constexpr int ATTN_LDS_BYTES=LDS_BYTES;
struct AttnTensors { const bf16* Q; const bf16* K; const bf16* V; bf16* O; const float* qg; const float* rope; float* ssq; float sbound; };
struct AttnUnit { int bh; int qb; };
struct StaticOrder {
  int vcu;
  __device__ __forceinline__ explicit StaticOrder(int grid,int block):vcu((block%8)*(grid/8)+block/8){}
  __device__ __forceinline__ bool next(int i,AttnUnit&u)const{ if(i>=4)return false; const int pair=vcu>>4, c16=vcu&15; u.bh=(pair>>1)*NHEAD+(pair&1)*4+(c16>>2); u.qb=(c16&3)*4+i; return true; }
  __device__ __forceinline__ void a_ready(const AttnUnit&)const{}
  __device__ __forceinline__ void done(const AttnUnit&)const{}
};
template<class Sched,int THRL=8> __device__ __forceinline__ void attn_phase(char*lds,const AttnTensors&T,const Sched&S){
  AttnUnit u;
  for(int i=0;S.next(i,u);++i){ S.a_ready(u); attn_unit<THRL>(u.bh/NHEAD,u.bh%NHEAD,u.qb,T.Q,T.K,T.V,T.O,lds,T.qg,T.rope,T.ssq,T.sbound); S.done(u); }
}
#undef SBAR
#undef WAIT_BAR
}

constexpr int NWAVES = 8;
constexpr int RING_OFF = 0, RING_BYTES = 131072;
constexpr int LDSCTL_OFF = RING_BYTES, MISC_OFF = LDSCTL_OFF + 320;
constexpr int LDS_BYTES = 147456;
constexpr int CW_BAR = 32768;
constexpr int MAX_LAUNCH = 8;
static_assert((CW_BAR + MAX_LAUNCH * XCD_BAR_WORDS) * 4 <= (int)(1 * MiB), "barrier words inside the memset region");
constexpr size_t WS_WINT = 4 * MiB;
constexpr size_t WS_WOUTT = 9 * MiB;
constexpr size_t WS_SSQ = 13 * MiB;
constexpr size_t WS_RSTD = 3 * MiB + 65536;
constexpr size_t WS_WGU = 16 * MiB;
constexpr size_t WS_WD = 144 * MiB;
constexpr int TAB_OFF = LDSCTL_OFF + 1024;
constexpr int XS_ROWS = NSLOT + 256;

constexpr int PROF_A = -1, PROF_B = -1;
constexpr int CW_PROF = 20000;
constexpr int FP8TEST = 0;
constexpr int NCONV = 136;
constexpr int CW_COUNTS2 = 70000, CW_CURSOR2 = 75000, CW_TILECNT = 90000;
constexpr int HIST_OFF = 49152, POS_OFF = 50176;
constexpr int REP0 = 1, REPG1 = 1, REPG3 = 1, REPATT = 1, REPM1 = 1, REPM2 = 1, REPP1 = 1, REPALL = 1, REPU = 1, REPP5 = 1, DRYQK = 0, DRYAN = 0, DRYSC = 0, DRYFIN = 0, DRYRT = 0;
struct Args { const float* in[21]; float* out; unsigned char* ws; int ph_lo, ph_hi, li, pad; };

struct Frame {
    LAS unsigned char* lds;
    volatile LAS unsigned* MISC;
    int tid, lane, wave, vcu, G;
};

template <bool NT = false>
__device__ __forceinline__ void p0_transpose_item(const float* W, int ldw, int k0, int ns0, bf16* WT, int K, int nd0, LAS float* scr, int lane) {
    if (ns0 >= 0) {
        f32x4 v[8];
#pragma unroll
        for (int i = 0; i < 8; ++i) { const GAS f32x4* p = (const GAS f32x4*)(W + (size_t)(k0 + 8 * i + (lane >> 3)) * ldw + ns0 + (lane & 7) * 4); v[i] = NT ? __builtin_nontemporal_load(p) : *p; }
#pragma unroll
        for (int i = 0; i < 8; ++i) { LAS float* p = scr + (8 * i + (lane >> 3)) * 33 + (lane & 7) * 4; p[0] = v[i].x; p[1] = v[i].y; p[2] = v[i].z; p[3] = v[i].w; }
    } else {
#pragma unroll 8
        for (int i = 0; i < 32; ++i) { const int kk = 2 * i + (lane >> 5); scr[kk * 33 + (lane & 31)] = 0.f; }
    }
    LDS_WAIT(); asm volatile("" ::: "memory");
    const int c = lane & 7;
#pragma unroll
    for (int j = 0; j < 4; ++j) { const int n = (lane >> 3) + 8 * j; const LAS float* s = scr + (8 * c) * 33 + n;
        v4u o; o.x = pk2(s[0 * 33], s[1 * 33]); o.y = pk2(s[2 * 33], s[3 * 33]); o.z = pk2(s[4 * 33], s[5 * 33]); o.w = pk2(s[6 * 33], s[7 * 33]);
        GAS v4u* q = (GAS v4u*)(WT + (size_t)(nd0 + n) * K + k0 + 8 * c); if (NT) __builtin_nontemporal_store(o, q); else *q = o; }
    LDS_WAIT(); asm volatile("" ::: "memory");
}

__device__ __forceinline__ void p0_transpose_item_wout(const float* W, int k0, int ns0, bf16* WT, const float* again, LAS float* scr, int lane) {
    f32x4 v[8];
#pragma unroll
    for (int i = 0; i < 8; ++i) { const int k = k0 + 8 * i + (lane >> 3); v[i] = *(const GAS f32x4*)(W + (size_t)k * D + ns0 + (lane & 7) * 4); if (k0 >= 512) v[i] = v[i] * again[k - 512]; }
#pragma unroll
    for (int i = 0; i < 8; ++i) { LAS float* p = scr + (8 * i + (lane >> 3)) * 33 + (lane & 7) * 4; p[0] = v[i].x; p[1] = v[i].y; p[2] = v[i].z; p[3] = v[i].w; }
    LDS_WAIT(); asm volatile("" ::: "memory");
    const int c = lane & 7, kd0 = (k0 + 512) & 1023;
#pragma unroll
    for (int j = 0; j < 4; ++j) { const int n = (lane >> 3) + 8 * j; const LAS float* sp = scr + (8 * c) * 33 + n;
        v4u o; o.x = pk2(sp[0 * 33], sp[1 * 33]); o.y = pk2(sp[2 * 33], sp[3 * 33]); o.z = pk2(sp[4 * 33], sp[5 * 33]); o.w = pk2(sp[6 * 33], sp[7 * 33]);
        *(GAS v4u*)(WT + (size_t)(ns0 + n) * D + kd0 + 8 * c) = o; }
    LDS_WAIT(); asm volatile("" ::: "memory");
}
struct ConvItem { const float* W; int ldw, k0, ns0; bf16* WT; int K, nd0; };
__device__ __forceinline__ void conv_load(const ConvItem& it, f32x4 (&v)[8], int lane) {
#pragma unroll
    for (int i = 0; i < 8; ++i) v[i] = __builtin_nontemporal_load((const GAS f32x4*)(it.W + (size_t)(it.k0 + 8 * i + (lane >> 3)) * it.ldw + it.ns0 + (lane & 7) * 4));
}
__device__ __forceinline__ void conv_finish(const ConvItem& it, const f32x4 (&v)[8], LAS float* scr, int lane) {
#pragma unroll
    for (int i = 0; i < 8; ++i) { LAS float* p = scr + (8 * i + (lane >> 3)) * 33 + (lane & 7) * 4; p[0] = v[i].x; p[1] = v[i].y; p[2] = v[i].z; p[3] = v[i].w; }
    LDS_WAIT(); asm volatile("" ::: "memory");
    const int c = lane & 7;
#pragma unroll
    for (int j = 0; j < 4; ++j) { const int n = (lane >> 3) + 8 * j; const LAS float* s = scr + (8 * c) * 33 + n;
        v4u o; o.x = pk2(s[0 * 33], s[1 * 33]); o.y = pk2(s[2 * 33], s[3 * 33]); o.z = pk2(s[4 * 33], s[5 * 33]); o.w = pk2(s[6 * 33], s[7 * 33]);
        __builtin_nontemporal_store(o, (GAS v4u*)(it.WT + (size_t)(it.nd0 + n) * it.K + it.k0 + 8 * c)); }
    LDS_WAIT(); asm volatile("" ::: "memory");
}
__device__ __forceinline__ ConvItem conv_item(int it, const float* wgate, const float* wup, const float* wdown, bf16* WguT, bf16* WdT) {
    constexpr int I_GU = NEXP * (D / 64) * (1024 / 32);
    ConvItem c;
    if (it < I_GU) { const int e = it >> 9, q = it & 511, kb = q >> 5, nb = q & 31, pn = nb >> 3, bj = (nb >> 2) & 1, c0 = (nb & 3) * 32;
        c.W = (bj ? wup : wgate) + (size_t)e * D * DEXP; c.ldw = DEXP; c.k0 = kb * 64; c.ns0 = pn * 128 + c0; c.WT = WguT + (size_t)e * 1024 * D; c.K = D; c.nd0 = nb * 32; }
    else { const int r = it - I_GU, e = r >> 8, q = r & 255, kb = q >> 5, nb = q & 31;
        c.W = wdown + (size_t)e * DEXP * D; c.ldw = D; c.k0 = kb * 64; c.ns0 = nb * 32; c.WT = WdT + (size_t)e * 1024 * DEXP; c.K = DEXP; c.nd0 = nb * 32; }
    return c;
}

__device__ __forceinline__ unsigned pk4_i8(float a, float b, float c, float d) {
    const int ia = __float2int_rn(a), ib = __float2int_rn(b), ic = __float2int_rn(c), id = __float2int_rn(d);
    return ((unsigned)ia & 0xffu) | (((unsigned)ib & 0xffu) << 8) | (((unsigned)ic & 0xffu) << 16) | ((unsigned)id << 24);
}
__device__ __forceinline__ void conv_colblock_i8g(const float* Wsrc, int ldw, unsigned char* out, float* sw32, LAS unsigned char* lds, int wave, int lane) {
    const float* W = Wsrc + (lane & 7) * 4;
    const int DEXP_ = ldw;
    LAS float* pmax = (LAS float*)(lds + 69632);
    f32x4 v[2][8];
#pragma unroll
    for (int q = 0; q < 2; ++q)
#pragma unroll
        for (int i = 0; i < 8; ++i) v[q][i] = Wsrc ? __builtin_nontemporal_load((const GAS f32x4*)(W + (size_t)((2 * wave + q) * 64 + 8 * i + (lane >> 3)) * DEXP_)) : (f32x4){0.f, 0.f, 0.f, 0.f};
    float mx[4] = {0.f, 0.f, 0.f, 0.f};
#pragma unroll
    for (int q = 0; q < 2; ++q)
#pragma unroll
        for (int i = 0; i < 8; ++i) { mx[0] = fmaxf(mx[0], fabsf(v[q][i].x)); mx[1] = fmaxf(mx[1], fabsf(v[q][i].y)); mx[2] = fmaxf(mx[2], fabsf(v[q][i].z)); mx[3] = fmaxf(mx[3], fabsf(v[q][i].w)); }
#pragma unroll
    for (int j = 0; j < 4; ++j) { mx[j] = fmaxf(mx[j], __shfl_xor(mx[j], 8)); mx[j] = fmaxf(mx[j], __shfl_xor(mx[j], 16)); mx[j] = fmaxf(mx[j], __shfl_xor(mx[j], 32)); }
    if (lane < 8) *(LAS f32x4*)(pmax + wave * 32 + lane * 4) = (f32x4){mx[0], mx[1], mx[2], mx[3]};
    __syncthreads();
#pragma unroll
    for (int w2 = 0; w2 < 8; ++w2) { const f32x4 m = *(const LAS f32x4*)(pmax + w2 * 32 + (lane & 7) * 4); mx[0] = fmaxf(mx[0], m.x); mx[1] = fmaxf(mx[1], m.y); mx[2] = fmaxf(mx[2], m.z); mx[3] = fmaxf(mx[3], m.w); }
    float inv[4];
#pragma unroll
    for (int j = 0; j < 4; ++j) inv[j] = mx[j] > 0.f ? 127.f / mx[j] : 0.f;
    if (wave == 0 && lane < 8) *(GAS f32x4*)(sw32 + lane * 4) = (f32x4){mx[0] * (1.f / 127.f), mx[1] * (1.f / 127.f), mx[2] * (1.f / 127.f), mx[3] * (1.f / 127.f)};
    LAS float* scr = (LAS float*)(lds + wave * 8448);
#pragma unroll
    for (int q = 0; q < 2; ++q) {
#pragma unroll
        for (int i = 0; i < 8; ++i) { LAS float* p = scr + (8 * i + (lane >> 3)) * 33 + (lane & 7) * 4; p[0] = v[q][i].x * inv[0]; p[1] = v[q][i].y * inv[1]; p[2] = v[q][i].z * inv[2]; p[3] = v[q][i].w * inv[3]; }
        LDS_WAIT(); asm volatile("" ::: "memory");
        { const int n = lane >> 1, hf = lane & 1; const LAS float* sp = scr + (32 * hf) * 33 + n; unsigned w[8];
#pragma unroll
          for (int r = 0; r < 8; ++r) w[r] = pk4_i8(sp[(4 * r) * 33], sp[(4 * r + 1) * 33], sp[(4 * r + 2) * 33], sp[(4 * r + 3) * 33]);
          GAS v4u* o = (GAS v4u*)(out + (size_t)n * D + (2 * wave + q) * 64 + 32 * hf); __builtin_nontemporal_store((v4u){w[0], w[1], w[2], w[3]}, o); __builtin_nontemporal_store((v4u){w[4], w[5], w[6], w[7]}, o + 1); }
        LDS_WAIT(); asm volatile("" ::: "memory");
    }
    __syncthreads();
}
__device__ __forceinline__ void conv_colblock_i8(int item  , const float* wgate, const float* wup, unsigned char* Wgu8, float* SW, LAS unsigned char* lds, int wave, int lane) {
    const int e = item >> 5, nb = item & 31, pn = nb >> 3, bj = (nb >> 2) & 1, c0 = (nb & 3) * 32;
    conv_colblock_i8g((bj ? wup : wgate) + (size_t)e * D * DEXP + pn * 128 + c0, DEXP, Wgu8 + ((size_t)e * 1024 + nb * 32) * D, SW + (size_t)e * 1024 + nb * 32, lds, wave, lane);
}
__device__ __forceinline__ void rms_row2_to_i8(int lane, const float* xrow0, const float* gain, unsigned char* o0, float* su0) {
    f32x4 v[2][4]; float ss[2] = {0.f, 0.f};
#pragma unroll
    for (int q = 0; q < 2; ++q)
#pragma unroll
        for (int j = 0; j < 4; ++j) v[q][j] = __builtin_nontemporal_load((const GAS f32x4*)(xrow0 + (size_t)q * D) + j * 64 + lane);
    f32x4 g[4];
#pragma unroll
    for (int j = 0; j < 4; ++j) g[j] = ((const GAS f32x4*)gain)[j * 64 + lane];
#pragma unroll
    for (int q = 0; q < 2; ++q)
#pragma unroll
        for (int j = 0; j < 4; ++j) ss[q] += (v[q][j].x * v[q][j].x + v[q][j].y * v[q][j].y) + (v[q][j].z * v[q][j].z + v[q][j].w * v[q][j].w);
    const bool b0 = lane & 1, b1 = lane & 2;
#pragma unroll
    for (int q = 0; q < 2; ++q) {
        const float rstd = rsqrtf(wave_sum(ss[q]) * (1.f / D) + EPS); float m = 0.f;
#pragma unroll
        for (int j = 0; j < 4; ++j) { v[q][j] = v[q][j] * rstd * g[j]; m = fmaxf(m, fmaxf(fmaxf(fabsf(v[q][j].x), fabsf(v[q][j].y)), fmaxf(fabsf(v[q][j].z), fabsf(v[q][j].w)))); }
#pragma unroll
        for (int o = 1; o < 64; o <<= 1) m = fmaxf(m, __shfl_xor(m, o));
        const float inv = m > 0.f ? 127.f / m : 0.f;
        unsigned w[4], x[4], y[4];
#pragma unroll
        for (int j = 0; j < 4; ++j) w[j] = pk4_i8(v[q][j].x * inv, v[q][j].y * inv, v[q][j].z * inv, v[q][j].w * inv);
#pragma unroll
        for (int p2 = 0; p2 < 2; ++p2) { const unsigned snd = b0 ? w[2 * p2] : w[2 * p2 + 1]; const unsigned rcv = (unsigned)__shfl_xor((int)snd, 1);
            x[2 * p2] = b0 ? rcv : w[2 * p2]; x[2 * p2 + 1] = b0 ? w[2 * p2 + 1] : rcv; }
#pragma unroll
        for (int i = 0; i < 2; ++i) { const unsigned snd = b1 ? x[i] : x[2 + i]; const unsigned rcv = (unsigned)__shfl_xor((int)snd, 2);
            y[i] = b1 ? rcv : x[i]; y[2 + i] = b1 ? x[2 + i] : rcv; }
        *(GAS v4u*)(o0 + (size_t)q * D + (lane & 3) * 256 + (lane >> 2) * 16) = (v4u){y[0], y[1], y[2], y[3]};
        if (lane == 0) su0[q] = m * (1.f / 127.f);
    }
}
__device__ __forceinline__ float wave_sum_x(float v) {
#pragma unroll
    for (int o = 1; o < 64; o <<= 1) v += __shfl_xor(v, o);
    return v;
}
__device__ __forceinline__ void rms_row2_to_bf16(int lane, const float* xrow0, const float* xrow1, const float* gain, bf16* orow0, bf16* orow1) {
    const GAS f32x4* xa = (const GAS f32x4*)xrow0 + lane; const GAS f32x4* xb = (const GAS f32x4*)xrow1 + lane;
    f32x4 va[4], vb[4]; float sa = 0.f, sb = 0.f;
#pragma unroll
    for (int j = 0; j < 4; ++j) { va[j] = __builtin_nontemporal_load(xa + 64 * j); vb[j] = __builtin_nontemporal_load(xb + 64 * j); }
#pragma unroll
    for (int j = 0; j < 4; ++j) { sa += (va[j].x * va[j].x + va[j].y * va[j].y) + (va[j].z * va[j].z + va[j].w * va[j].w); sb += (vb[j].x * vb[j].x + vb[j].y * vb[j].y) + (vb[j].z * vb[j].z + vb[j].w * vb[j].w); }
    const float ra = rsqrtf(wave_sum_x(sa) * (1.f / D) + EPS), rb = rsqrtf(wave_sum_x(sb) * (1.f / D) + EPS);
    GAS unsigned long long* oa = (GAS unsigned long long*)orow0 + lane; GAS unsigned long long* ob = (GAS unsigned long long*)orow1 + lane;
#pragma unroll
    for (int j = 0; j < 4; ++j) { const f32x4 g = ((const GAS f32x4*)gain)[64 * j + lane];
        oa[64 * j] = (unsigned long long)pk2(va[j].x * ra * g.x, va[j].y * ra * g.y) | ((unsigned long long)pk2(va[j].z * ra * g.z, va[j].w * ra * g.w) << 32);
        ob[64 * j] = (unsigned long long)pk2(vb[j].x * rb * g.x, vb[j].y * rb * g.y) | ((unsigned long long)pk2(vb[j].z * rb * g.z, vb[j].w * rb * g.w) << 32); }
}

__global__ void __launch_bounds__(NWAVES * 64, 2) mega(Args args) {
    extern __shared__ __attribute__((aligned(16))) unsigned char lds[];
    Frame F;
    F.lds = (LAS unsigned char*)lds;
    F.MISC = (volatile LAS unsigned*)(F.lds + MISC_OFF);
    F.tid = threadIdx.x; F.lane = F.tid & 63; F.wave = __builtin_amdgcn_readfirstlane(F.tid >> 6);
    F.G = gridDim.x; { const int bx = blockIdx.x; F.vcu = (F.G % 8 == 0) ? (bx % 8) * (F.G / 8) + bx / 8 : bx; }
    unsigned char* ws = args.ws;
    gu32* ctl = (gu32*)(ws + WS_CTL);
    for (int u = F.tid; u < (LDS_BYTES - LDSCTL_OFF) / 4; u += NWAVES * 64) ((LAS unsigned*)(F.lds + LDSCTL_OFF))[u] = 0u;
    __syncthreads();
    XcdBarrier bar = xcd_barrier_post((unsigned*)(ctl + CW_BAR) + args.li * XCD_BAR_WORDS, F.MISC + 8);
    const int lo = args.ph_lo, hi = args.ph_hi;
#define IN(k) (lo <= (k) && (k) < hi)
#define BOTH(k) (IN(k) && IN((k) + 1))
#define GRID_BAR() xcd_barrier(bar)
    unsigned long long tprev = 0; if (PROF_A >= 0 && blockIdx.x == 0 && F.tid == 0) tprev = rt();
#define STAMP(k) do { if (PROF_A >= 0 && blockIdx.x == 0 && F.tid == 0) { const unsigned long long now_ = rt(); __hip_atomic_store(ctl + CW_PROF + (k), (unsigned)(now_ - tprev), RLX_AGENT); tprev = now_; } } while (0)
    const float* x = args.in[0];
    bf16* U = (bf16*)(ws + WS_U); bf16* PROJ = (bf16*)(ws + WS_PROJ); bf16* WinT = (bf16*)(ws + WS_WINT);
    const int gw = F.vcu * NWAVES + F.wave, NGW = F.G * NWAVES;

    const int gtid = (int)blockIdx.x * (NWAVES * 64) + F.tid, nthr = F.G * NWAVES * 64;
    const int half = F.tid >> 8, t256 = F.tid & 255, bx = (int)blockIdx.x;
    unsigned* ctlp = (unsigned*)(ws + WS_CTL); unsigned* tokinfo = (unsigned*)(ws + WS_TOKINFO); int* tokslot = (int*)(ws + WS_TOKSLOT); int* slottok = (int*)(ws + WS_SLOTTOK);
    float* slotgate = (float*)(ws + WS_SLOTGATE); float* rope = (float*)(ws + WS_ROPE);
    bf16* KVS = (bf16*)(ws + WS_G); float* DEC = (float*)(ws + WS_DEC); float* SSQ = (float*)(ws + WS_SSQ);
    float* RSTD = (float*)(ws + WS_RSTD); bf16* WguT = (bf16*)(ws + WS_WGU); bf16* WdT = (bf16*)(ws + WS_WD); bf16* XS = (bf16*)(ws + WS_PROJ);
    float* RATT = (float*)(ws + 15 * MiB + 512 * 1024); bf16* HB = (bf16*)(ws + 80 * MiB);
    unsigned char* U8 = ws + WS_U; unsigned char* Win8 = ws + WS_WINT; float* SUS = (float*)(ws + 14 * MiB + 512 * 1024); float* SWIN = (float*)(ws + 14 * MiB + 768 * 1024);
    unsigned char* Wgu8 = ws + WS_WGU; float* SWS = (float*)(ws + 14 * MiB); float* SAS = (float*)(ws + 15 * MiB); unsigned char* XS8 = ws + WS_PROJ;
    LAS int* tab = (LAS int*)(F.lds + TAB_OFF); LAS int* t_cnt = tab; LAS int* t_offs = tab + 64; LAS int* t_e = tab + 144; LAS int* t_r0 = tab + 464; LAS int* t_nr = tab + 784; LAS int* t_n = tab + 1104;
    bf16* HMID = (bf16*)(ws + WS_G); unsigned char* YS8 = ws + WS_PROJ + 64 * MiB; float* YSC = (float*)(ws + WS_PROJ + 128 * MiB);   bf16* WoutT = (bf16*)(ws + WS_WOUTT);

    if (IN(0)) {
        LAS float* scr = (LAS float*)(F.lds + RING_OFF + F.wave * 16384);
        constexpr int I_WOUT = (D / 64) * (D / 32);
        const int gb = bx * NWAVES + F.wave;
        if (F.G == 256) { const int it = gb - (2048 - I_WOUT); if (it >= 0) { const int kb = it / (D / 32), nb = it % (D / 32); p0_transpose_item_wout(args.in[11], kb * 64, nb * 32, WoutT, args.in[10], scr, F.lane); } }
        else for (int it = gw; it < I_WOUT; it += NGW) { const int kb = it / (D / 32), nb = it % (D / 32); p0_transpose_item_wout(args.in[11], kb * 64, nb * 32, WoutT, args.in[10], scr, F.lane); }
        __syncthreads();
        for (int nb = bx; nb < PW / 32; nb += F.G) { const int cs = proj_src_col(nb * 32);
            conv_colblock_i8g(cs < 0 ? nullptr : args.in[2] + cs, DIN, Win8 + (size_t)nb * 32 * D, SWIN + nb * 32, F.lds + RING_OFF, F.wave, F.lane); }
        router_build_bfrag(gtid, nthr, args.in[13], args.in[15], args.in[12], (bf16*)(ws + WS_BFRAG));
        if (F.G == 256) {
            for (int i = 0; i < 6; ++i) { const int m = 2 * (gb + 2048 * i); rms_row2_to_i8(F.lane, x + (size_t)m * D, args.in[1], U8 + (size_t)m * D, SUS + m); }
            if (bx >= PW / 32) for (int j = gb - (PW / 32) * NWAVES; j < 4096; j += 2048 - (PW / 32) * NWAVES) { const int m = 2 * (12288 + j); rms_row2_to_i8(F.lane, x + (size_t)m * D, args.in[1], U8 + (size_t)m * D, SUS + m); }
        } else
        for (int rep = 0; rep < REPU; ++rep) for (int m = 2 * gw; m < NTOK; m += 2 * NGW) rms_row2_to_i8(F.lane, x + (size_t)m * D, args.in[1], U8 + (size_t)m * D, SUS + m);
        { if (gtid < 1024) { const int pos = gtid >> 4, j = gtid & 15; const float ang = (float)pos * powf(10000.0f, -(float)(2 * j) / 32.0f); rope[gtid] = cosf(ang); rope[1024 + gtid] = sinf(ang); } }
        if (BOTH(0)) GRID_BAR();
        STAMP(0);
    }
    if (IN(1)) {
        const int rk = bx >> 3, xg = bx & 7; constexpr int NGE = 32 - NCONV / 8;
        if (F.G != 256 || rk < NGE) {
            pg8::Gemm g{(const pg8::bf16_t*)U8, (const pg8::bf16_t*)Win8, NTOK, PW, D}; pg8::StaticOrder S;
            if (F.G == 256) S.init(NTOK, PW, NGE * 8, rk * 8 + xg); else S.init(NTOK, PW, F.G, bx);
            pg8::EpiBf16_I8 E{PROJ, PW, SUS, SWIN, DIN};
            for (int rep = 0; rep < REPP1; ++rep) pg8::gemm_phase<pg8::EpiBf16_I8, pg8::StaticOrder, true, true, false, true>(F.lds + RING_OFF, g, S, E);
        }
        if (F.G != 256 || rk >= NGE) {
            LAS float* scr = (LAS float*)(F.lds + RING_OFF + F.wave * 16384);
            constexpr int I_GU = NEXP * (D / 64) * (1024 / 32), I_DN = NEXP * (DEXP / 64) * (D / 32);
            const int cw = (F.G == 256) ? ((rk - NGE) * 8 + xg) * NWAVES + F.wave : gw, NCW = (F.G == 256) ? NCONV * NWAVES : NGW;
            for (int rep = 0; rep < REP0; ++rep) {
                { const int cwg = (F.G == 256) ? (rk - NGE) * 8 + xg : bx, NWG = (F.G == 256) ? NCONV : F.G;
                  for (int it = cwg; it < NEXP * 32; it += NWG) conv_colblock_i8(it, args.in[17], args.in[18], Wgu8, SWS, F.lds + RING_OFF, F.wave, F.lane); }
                const int base_ = I_DN / NCW, rem_ = I_DN % NCW, lo_ = NCW - rem_;
                const int dn = base_ + (cw >= lo_ ? 1 : 0), d0 = cw < lo_ ? cw * base_ : lo_ * base_ + (cw - lo_) * (base_ + 1);
                f32x4 va[8], vb[8]; ConvItem ia, ib;
                int k = 0;
                if (k < dn) { ia = conv_item(I_GU + d0 + k, args.in[17], args.in[18], args.in[19], WguT, WdT); conv_load(ia, va, F.lane); }
                for (; k < dn; k += 2) {
                    const bool hb = k + 1 < dn, ha = k + 2 < dn;
                    if (hb) { ib = conv_item(I_GU + d0 + k + 1, args.in[17], args.in[18], args.in[19], WguT, WdT); conv_load(ib, vb, F.lane); }
                    conv_finish(ia, va, scr, F.lane);
                    if (ha) { ia = conv_item(I_GU + d0 + k + 2, args.in[17], args.in[18], args.in[19], WguT, WdT); conv_load(ia, va, F.lane); }
                    if (hb) conv_finish(ib, vb, scr, F.lane);
                }
            }
        }
        if (BOTH(1)) GRID_BAR();
        STAMP(1);
    }
    if (IN(2)) {
        for (int rep = 0; rep < REPG1; ++rep) gla_g1_phase(F.lds + RING_OFF, F.tid, bx, PROJ, args.in[3], args.in[4], args.in[5], args.in[6], KVS, DEC);
        if (DRYQK) ph_qk_prep(gw, NGW, F.lane, PROJ, args.in[8], args.in[9], rope, U, D);
        ph_qk_prep(gw, NGW, F.lane, PROJ, args.in[8], args.in[9], rope, PROJ + C_AQ, PW);
        if (BOTH(2)) GRID_BAR();
        STAMP(2);
    }
    if (IN(3)) {
        gla_g2_scan(gtid, nthr, KVS, DEC);
        __syncthreads();
        float sb_; { float mq = 0.f, mk = 0.f;
#pragma unroll 8
          for (int i = 0; i < 64; ++i) { mq = fmaxf(mq, fabsf(args.in[8][i])); mk = fmaxf(mk, fabsf(args.in[9][i])); }
          sb_ = 64.f * mq * mk * attn_body::C2 * 1.02f; }
        { const attn_body::AttnTensors AT{(const attn_body::bf16*)(PROJ + C_AQ), (const attn_body::bf16*)(PROJ + C_AK), (const attn_body::bf16*)(PROJ + C_AV), (attn_body::bf16*)(U), args.in[8], rope, SSQ, sb_};
          const attn_body::StaticOrder S((int)F.G, bx);
          for (int rep = 0; rep < REPATT; ++rep) attn_body::attn_phase<attn_body::StaticOrder>((char*)lds + RING_OFF, AT, S); }
        if (BOTH(3)) GRID_BAR();
        STAMP(3);
    }
    if (IN(4)) {
        for (int rep = 0; rep < REPG3; ++rep) gla_g3_phase(F.lds + RING_OFF, F.tid, bx, PROJ, args.in[3], args.in[4], args.in[5], args.in[6], KVS, args.in[7], U, SSQ, RATT);
        if (BOTH(4)) GRID_BAR();
        STAMP(4);
    }
    if (IN(5)) {
        pg8::Gemm g{U, WoutT, NTOK, D, D}; pg8::StaticOrder S; S.init(NTOK, D, F.G, bx);
        pg8::EpiBf16Res E{HB, x, D, RATT};
        for (int rep = 0; rep < REPP5; ++rep) pg8::gemm_phase<pg8::EpiBf16Res, pg8::StaticOrder, true, true>(F.lds + RING_OFF, g, S, E);
        if (BOTH(5)) GRID_BAR();
        STAMP(5);
    }
    if (IN(6)) {
        LAS int* hist = (LAS int*)(F.lds + HIST_OFF);
        if (F.tid < 64) hist[F.tid] = 0;
        __syncthreads();
        ph_router_lds(F.vcu, F.G, F.wave, F.lane, F.lds + RING_OFF, HB, (const bf16*)(ws + WS_BFRAG), args.in[14], args.in[16], RSTD, tokinfo, hist, false);
        if (DRYRT) ph_router_lds(F.vcu, F.G, F.wave, F.lane, F.lds + RING_OFF, HB, (const bf16*)(ws + WS_BFRAG), args.in[14], args.in[16], RSTD, tokinfo, hist, true);
        __syncthreads();
        if (F.tid < 64) { const int c = hist[F.tid]; if (c) atomicAdd(ctlp + CW_COUNTS2 + 64 * F.tid, (unsigned)c); }
        if (IN(6) && IN(8)) GRID_BAR();
        STAMP(6);
    }
    if (IN(8)) {
        LAS int* hist = (LAS int*)(F.lds + HIST_OFF); LAS int* gbase = hist + 64; LAS int* tbase = hist + 128; LAS int* pos = (LAS int*)(F.lds + POS_OFF);
        if (F.tid < 64) { t_cnt[F.tid] = (int)__hip_atomic_load(ctl + CW_COUNTS2 + 64 * F.tid, RLX_AGENT); hist[F.tid] = 0; }
        __syncthreads();
        if (F.tid == 0) { int off = 0, nt = 0;
            for (int e = 0; e < NEXP; ++e) { const int c = t_cnt[e]; t_offs[e] = off; tbase[e] = nt; off += c; nt += (c + 255) >> 8; }
            t_offs[NEXP] = off; t_n[0] = nt; }
        uint4 ti = make_uint4(0, 0, 0, 0); int r0 = 0, r1 = 0;
        if (F.tid < 128) { ti = ((const uint4*)tokinfo)[bx * 128 + F.tid];
            r0 = __hip_atomic_fetch_add(hist + ti.x, 1, __ATOMIC_RELAXED, __HIP_MEMORY_SCOPE_WORKGROUP); r1 = __hip_atomic_fetch_add(hist + ti.y, 1, __ATOMIC_RELAXED, __HIP_MEMORY_SCOPE_WORKGROUP); }
        __syncthreads();
        if (F.tid < 64) { const int e = F.tid, c = t_cnt[e], nt0 = tbase[e], o0 = t_offs[e];
            for (int r = 0, k = 0; r < c; r += 256, ++k) { t_e[nt0 + k] = e; t_r0[nt0 + k] = o0 + r; t_nr[nt0 + k] = (c - r) < 256 ? (c - r) : 256; }
            const int hc = hist[e]; gbase[e] = hc ? (int)atomicAdd(ctlp + CW_CURSOR2 + 64 * e, (unsigned)hc) : 0; }
        __syncthreads();
        if (F.tid < 128) { const int t = bx * 128 + F.tid; const int p0 = t_offs[ti.x] + gbase[ti.x] + r0, p1 = t_offs[ti.y] + gbase[ti.y] + r1;
            pos[2 * F.tid] = p0; pos[2 * F.tid + 1] = p1; tokslot[2 * t] = p0; tokslot[2 * t + 1] = p1; slotgate[p0] = __uint_as_float(ti.z); slotgate[p1] = __uint_as_float(ti.w); }
        __syncthreads();
        ph_copy_xs_i8(bx, F.wave, F.lane, pos, HB, RSTD, args.in[12], XS8, SAS);
        if (DRYSC) ph_copy_xs_i8(bx, F.wave, F.lane, pos, HB, RSTD, args.in[12], XS8, SAS);
        if (BOTH(8)) GRID_BAR();
        STAMP(8);
    }
    if (IN(9)) {
        pg8::Gemm g{(const pg8::bf16_t*)XS8, (const pg8::bf16_t*)Wgu8, XS_ROWS, 1024, D};
        pg8::GroupedOrderPub S{t_e, t_r0, t_nr, __builtin_amdgcn_readfirstlane(t_n[0]) * 4, F.G, F.vcu, (size_t)D, (size_t)1024 * D, ctlp + CW_TILECNT};
        pg8::EpiSwiGLU_I8<true> E{HMID, SAS, SWS};
        pg8::gemm_phase<pg8::EpiSwiGLU_I8<true>, pg8::GroupedOrderPub, true, true, false, true>(F.lds + RING_OFF, g, S, E);
        STAMP(9);
    }
    if (IN(10)) {
        pg8::Gemm g{HMID, WdT, XS_ROWS, 1024, DEXP};
        pg8::GroupedOrderDep S{t_e, t_r0, t_nr, __builtin_amdgcn_readfirstlane(t_n[0]) * 4, F.G, F.vcu, (size_t)1024 * DEXP * 2, ctlp + CW_TILECNT};
        pg8::EpiYs8 E{YS8, YSC, slotgate};
        pg8::gemm_phase<pg8::EpiYs8, pg8::GroupedOrderDep, true, true, true>(F.lds + RING_OFF, g, S, E);
        if (BOTH(10)) GRID_BAR();
        STAMP(10);
    }
    if (IN(11)) { if (DRYFIN) ph_final(gw, NGW, F.lane, HB, YS8, YSC, tokslot, args.in[20], (float*)(ws + WS_U), (float*)(ws + WS_G));
        ph_final(gw, NGW, F.lane, HB, YS8, YSC, tokslot, args.in[20], args.out, args.out + (size_t)(NTOK / 2) * D); }
    if (PROF_A >= 0) {
        GRID_BAR(); STAMP(11); GRID_BAR();
        const float ta = (float)__hip_atomic_load(ctl + CW_PROF + PROF_A, RLX_AGENT) * 0.01f;
        const float tb = (float)__hip_atomic_load(ctl + CW_PROF + (PROF_B >= 0 ? PROF_B : 0), RLX_AGENT) * 0.01f;
        const float kf = 0.002f * sqrtf(ta);
        for (size_t i = (size_t)gtid; i < (size_t)NTOK * D; i += (size_t)nthr) args.out[i] += (i == 0 && PROF_B >= 0) ? (1.f + tb * 0.01f) : kf;
    }
    if (FP8TEST) {
        GRID_BAR();
        if (bx == 0 && F.wave == 0) {
            typedef int v4i_t __attribute__((ext_vector_type(4)));
            const int l = F.lane, r16 = l & 15, kg = l >> 4;
            auto av = [](int i, int k) { return ((i * 7 + k * 3) % 11) - 5; };
            auto bvv = [](int k, int j) { return ((k * 5 + j * 11) % 13) - 6; };
            v4i_t A, B;
#pragma unroll
            for (int rg = 0; rg < 4; ++rg) { unsigned wa = 0, wb = 0;
#pragma unroll
                for (int by = 0; by < 4; ++by) { const int k = 16 * kg + 4 * rg + by; wa |= ((unsigned)av(r16, k) & 0xffu) << (8 * by); wb |= ((unsigned)bvv(k, r16) & 0xffu) << (8 * by); }
                A[rg] = (int)wa; B[rg] = (int)wb; }
            v4i_t acc = {0, 0, 0, 0};
            acc = __builtin_amdgcn_mfma_i32_16x16x64_i8(A, B, acc, 0, 0, 0);
            bool ok = true;
#pragma unroll
            for (int r = 0; r < 4; ++r) { const int row = 4 * kg + r; int sm = 0; for (int k = 0; k < 64; ++k) sm += av(row, k) * bvv(k, r16); ok = ok && (acc[r] == sm + (FP8TEST == 2 ? 1 : 0)); }
            if (!__all(ok) && l == 0) args.out[0] = __builtin_nanf("");
        }
    }
#undef IN
#undef BOTH
#undef GRID_BAR
}

static int g_grid = 0;
static void launch_mega(void* const* d_in, void* d_out, void* d_ws, hipStream_t stream, int lo, int hi, int li) {
    Args a{};
    for (int i = 0; i < 21; ++i) a.in[i] = (const float*)d_in[i];
    a.out = (float*)d_out; a.ws = (unsigned char*)d_ws; a.ph_lo = lo; a.ph_hi = hi; a.li = li; a.pad = 0;
    void* kargs[] = {&a};
    hipError_t e = hipLaunchCooperativeKernel((const void*)mega, dim3(g_grid), dim3(NWAVES * 64), kargs, LDS_BYTES, stream);
    if (e != hipSuccess) fprintf(stderr, "cooperative launch failed: %s (grid %d)\n", hipGetErrorString(e), g_grid);
}
extern "C" void kernel_launch(void* const* d_in, const int* in_sizes, int n_in, void* d_out, int out_size, void* d_ws, size_t ws_size, hipStream_t stream) {
    if (g_grid == 0) {
        int dev = 0, cus = 0, per_cu = 0;
        (void)hipGetDevice(&dev); (void)hipDeviceGetAttribute(&cus, hipDeviceAttributeMultiprocessorCount, dev);
        (void)hipFuncSetAttribute((const void*)mega, hipFuncAttributeMaxDynamicSharedMemorySize, LDS_BYTES);
        (void)hipOccupancyMaxActiveBlocksPerMultiprocessor(&per_cu, (const void*)mega, NWAVES * 64, LDS_BYTES);
        if (per_cu < 1) per_cu = 1;
        if (per_cu > 1) per_cu = 1;
        g_grid = cus * per_cu;
    }
    (void)hipMemsetAsync((char*)d_ws + WS_CTL, 0, 1 * MiB, stream);
    launch_mega(d_in, d_out, d_ws, stream, 0, 12, 0);
}
```

```cpp
#include <hip/hip_runtime.h>
#include <stdint.h>
#include <math.h>

constexpr int NB = 8, T = 4096, D = 1024, NTOK = NB * T;
constexpr int DIN = 2336;
constexpr int PW = 2560;
constexpr int C_GQ = 0, C_GK = 256, C_GV = 512, C_GG = 1024, C_AQ = 1536, C_AK = 2048, C_AV = 2176, C_ZF = 2304, C_ZB = 2320;
constexpr int NEXP = 64, DEXP = 512, NSLOT = 2 * NTOK;
constexpr float EPS = 1e-6f;

typedef unsigned short bf16_t;

constexpr size_t MiB = 1u << 20;
constexpr size_t WS_CTL = 0;
constexpr size_t WS_TOKINFO = 1 * MiB;
constexpr size_t WS_TOKSLOT = 1 * MiB + 512 * 1024;
constexpr size_t WS_SLOTTOK = 2 * MiB;
constexpr size_t WS_SLOTGATE = 2 * MiB + 256 * 1024;
constexpr size_t WS_ROPE = 3 * MiB;
constexpr size_t WS_LAF = 16 * MiB;
constexpr size_t WS_LAB = 48 * MiB;
constexpr size_t WS_OF = 80 * MiB;
constexpr size_t WS_OB = 144 * MiB;
constexpr size_t WS_U = 208 * MiB;
constexpr size_t WS_PROJ = 272 * MiB;
constexpr size_t WS_G = 432 * MiB;
constexpr int CW_COUNTS = 0, CW_CURSOR = 64, CW_OFFS = 128, CW_NTILES = 256, CW_TILE_E = 1024, CW_TILE_R0 = 4096, CW_TILE_NR = 8192;

__device__ __forceinline__ float bf2f(bf16_t v) { return __uint_as_float(((unsigned)v) << 16); }
__device__ __forceinline__ bf16_t f2bf(float f) { unsigned u = __float_as_uint(f); return (bf16_t)((u + 0x7fffu + ((u >> 16) & 1u)) >> 16); }
__device__ __forceinline__ float wave_sum(float v) {
#pragma unroll
    for (int o = 1; o < 64; o <<= 1) v += __shfl_xor(v, o);
    return v;
}
__device__ __forceinline__ float silu_f(float x) { return x / (1.f + expf(-x)); }


__device__ __forceinline__ float4 ld_bf4(const bf16_t* p) { const ushort4 u = *(const ushort4*)p; return make_float4(bf2f(u.x), bf2f(u.y), bf2f(u.z), bf2f(u.w)); }
__device__ __forceinline__ void st_bf4(bf16_t* p, float4 v) { ushort4 o; o.x = f2bf(v.x); o.y = f2bf(v.y); o.z = f2bf(v.z); o.w = f2bf(v.w); *(ushort4*)p = o; }
__host__ __device__ __forceinline__ int proj_src_col(int cd) {
    if (cd < 1536) return cd;
    if (cd < 2048) return 1568 + (cd - 1536);
    if (cd < 2176) return 2080 + (cd - 2048);
    if (cd < 2304) return 2208 + (cd - 2176);
    if (cd < 2336) return 1536 + (cd - 2304);
    return -1;
}
#include <cstdio>
namespace pg8 {
#define PG8_LAS __attribute__((address_space(3)))
typedef unsigned short bf16_t;
typedef short bf16x8 __attribute__((ext_vector_type(8)));
typedef float f32x4 __attribute__((ext_vector_type(4)));
typedef unsigned u32x4 __attribute__((ext_vector_type(4)));
constexpr int BM = 256, BK = 64, HALF = 128, HTB = HALF * BK * 2  , STAGE_BYTES = 8 * HTB, NXCD = 8, WGM = 8;

__host__ __device__ __forceinline__ int lds_byte(int r, int c) { return r * 128 + ((((c >> 3)) ^ ((r >> 1) & 7)) << 4) + (c & 7) * 2; }
__host__ __device__ __forceinline__ void stage_rc(int b, int& R, int& C) { R = b >> 7; C = ((((b >> 4) & 7) ^ ((R >> 1) & 7)) << 3); }
__host__ __device__ __forceinline__ int perm32(int rho) { const int n = rho >> 4, i = rho & 15; return 8 * (i >> 2) + 4 * n + (i & 3); }

typedef int i32x4 __attribute__((ext_vector_type(4)));
struct Unit { int pm, pn, row0, nr, e; unsigned rdy; };
struct Gemm { const bf16_t* A; const bf16_t* Bt; int M, N, K; };

struct StaticOrder {
    int nM, nN, nwg, G, c;
    __host__ __device__ void init(int M, int N, int G_, int c_) { nM = M / BM; nN = N / BM; nwg = nM * nN; G = G_; c = c_; }
    __host__ __device__ bool next(int i, Unit& u) const {
        const long L = (long)i * G + c; if (L >= nwg) return false;
        int wgid = (int)L; { const int q = nwg / NXCD, r = nwg % NXCD, xcd = wgid % NXCD, off = wgid / NXCD; wgid = (xcd < r ? xcd * (q + 1) : r * (q + 1) + (xcd - r) * q) + off; }
        const int nig = WGM * nN, gid = wgid / nig, fm = gid * WGM, gsz = (nM - fm) < WGM ? (nM - fm) : WGM;
        u.pm = fm + ((wgid % nig) % gsz); u.pn = (wgid % nig) / gsz; return true;
    }
    __device__ __forceinline__ size_t a_off(const Unit& u, size_t tstep) const { return (size_t)u.pm * tstep; }
    __device__ __forceinline__ size_t b_off(const Unit& u, size_t tstep) const { return (size_t)u.pn * tstep; }
    __device__ __forceinline__ void a_ready(const Unit&) const {}
    __device__ __forceinline__ void done(const Unit&) const {}
};

__device__ __forceinline__ unsigned cvt_pk_bf16(float lo, float hi) { unsigned r; asm volatile("v_cvt_pk_bf16_f32 %0, %1, %2" : "=v"(r) : "v"(lo), "v"(hi)); return r; }
typedef float f32x2 __attribute__((ext_vector_type(2)));
__device__ __forceinline__ f32x2 gelu_pk(f32x2 v) {
    const f32x2 av = __builtin_elementwise_abs(v), d = av * 0.2316418882f + 1.0f;
    f32x2 t; t.x = __builtin_amdgcn_rcpf(d.x); t.y = __builtin_amdgcn_rcpf(d.y);
    f32x2 q = t * 0.5307027145f + (-0.7265760135f); q = q * t + 0.7107068705f; q = q * t + (-0.142248368f); q = q * t + 0.127414796f; q = q * t;
    const f32x2 s = (v * v) * (-0.72134752044f);
    f32x2 e; e.x = __builtin_amdgcn_exp2f(s.x); e.y = __builtin_amdgcn_exp2f(s.y);
    const f32x2 m = v * (q * e), r = v - m;
    f32x2 o; o.x = v.x < 0.f ? m.x : r.x; o.y = v.y < 0.f ? m.y : r.y; return o;
}

template <int ACT  > struct EpiBf16 {
    static constexpr bool PERM = true, AFTER_DRAIN = false; static_assert(ACT == 0 || ACT == 1, "EpiBf16: ACT is 0 (none) or 1 (gelu_pk)");
    bf16_t* O; int ldc; const float* bias; int split_cols; size_t split_stride; float scale0;
    __device__ __forceinline__ void operator()(const f32x4 (&acc)[2][2][4][2], const Unit& u, int wr, int wc, int fr, int fq) const {
        const int row0 = u.pm * BM + wr * 64 + fr; int colt = u.pn * BM; bf16_t* base = O;
        float sc = 1.f; if (split_cols) { const int t = colt / split_cols; base += (size_t)t * split_stride; colt -= t * split_cols; if (t == 0) sc = scale0; }
        const int col0 = colt + wc * 32 + 8 * fq, bcol0 = u.pn * BM + wc * 32 + 8 * fq;
        f32x4 bv[2][2];
#pragma unroll
        for (int bj = 0; bj < 2; ++bj)
#pragma unroll
            for (int n = 0; n < 2; ++n) bv[bj][n] = bias ? *(const f32x4*)(bias + bcol0 + bj * HALF + 4 * n) : (f32x4){0.f, 0.f, 0.f, 0.f};
#pragma unroll
        for (int ai = 0; ai < 2; ++ai)
#pragma unroll
            for (int m = 0; m < 4; ++m) { bf16_t* rowp = base + (size_t)(row0 + ai * HALF + m * 16) * ldc + col0;
#pragma unroll
                for (int bj = 0; bj < 2; ++bj) { f32x4 v0 = acc[ai][bj][m][0] + bv[bj][0], v1 = acc[ai][bj][m][1] + bv[bj][1];
                    if (ACT == 1) { f32x2 a = gelu_pk((f32x2){v0[0], v0[1]}), b = gelu_pk((f32x2){v0[2], v0[3]}), c = gelu_pk((f32x2){v1[0], v1[1]}), d = gelu_pk((f32x2){v1[2], v1[3]});
                        v0 = (f32x4){a.x, a.y, b.x, b.y}; v1 = (f32x4){c.x, c.y, d.x, d.y}; }
                    v0 = v0 * sc; v1 = v1 * sc; u32x4 w; w.x = cvt_pk_bf16(v0[0], v0[1]); w.y = cvt_pk_bf16(v0[2], v0[3]); w.z = cvt_pk_bf16(v1[0], v1[1]); w.w = cvt_pk_bf16(v1[2], v1[3]);
                    *(u32x4*)(rowp + bj * HALF) = w; } }
    }
};
struct EpiBf16Res {
    static constexpr bool PERM = true, AFTER_DRAIN = false;
    bf16_t* O; const float* R; int ldc; const float* rs;
    __device__ __forceinline__ void operator()(const f32x4 (&acc)[2][2][4][2], const Unit& u, int wr, int wc, int fr, int fq) const {
        const int row0 = u.pm * BM + wr * 64 + fr, col0 = u.pn * BM + wc * 32 + 8 * fq;
#pragma unroll
        for (int ai = 0; ai < 2; ++ai)
#pragma unroll
            for (int m = 0; m < 4; ++m) { const int row = row0 + ai * HALF + m * 16; const size_t ro = (size_t)row * ldc + col0; const float r = rs[row];
#pragma unroll
                for (int bj = 0; bj < 2; ++bj) { const f32x4 v0 = acc[ai][bj][m][0] * r + *(const f32x4*)(R + ro + bj * HALF), v1 = acc[ai][bj][m][1] * r + *(const f32x4*)(R + ro + bj * HALF + 4);
                    u32x4 w; w.x = cvt_pk_bf16(v0[0], v0[1]); w.y = cvt_pk_bf16(v0[2], v0[3]); w.z = cvt_pk_bf16(v1[0], v1[1]); w.w = cvt_pk_bf16(v1[2], v1[3]);
                    *(u32x4*)(O + ro + bj * HALF) = w; } }
    }
};
struct GroupedOrder {
    const PG8_LAS int* te; const PG8_LAS int* tr0; const PG8_LAS int* tnr; int nunits, G, c; size_t a_pitch, b_exp;
    __device__ __forceinline__ bool next(int i, Unit& u) const {
        const int L = i * G + c; if (L >= nunits) return false;
        const int t = L >> 2; u.pm = t; u.pn = L & 3; u.e = __builtin_amdgcn_readfirstlane(te[t]); u.row0 = __builtin_amdgcn_readfirstlane(tr0[t]); u.nr = __builtin_amdgcn_readfirstlane(tnr[t]); return true;
    }
    __device__ __forceinline__ size_t a_off(const Unit& u, size_t) const { return (size_t)u.row0 * a_pitch; }
    __device__ __forceinline__ size_t b_off(const Unit& u, size_t tstep) const { return (size_t)u.e * b_exp + (size_t)u.pn * tstep; }
    __device__ __forceinline__ void a_ready(const Unit&) const {}
    __device__ __forceinline__ void done(const Unit&) const {}
};
struct GroupedOrderPub {
    const PG8_LAS int* te; const PG8_LAS int* tr0; const PG8_LAS int* tnr; int nunits, G, c; size_t a_pitch, b_exp; unsigned* cnt;
    __device__ __forceinline__ bool next(int i, Unit& u) const {
        const int L = i * G + c; if (L >= nunits) return false;
        const int t = L >> 2; u.pm = t; u.pn = L & 3; u.e = __builtin_amdgcn_readfirstlane(te[t]); u.row0 = __builtin_amdgcn_readfirstlane(tr0[t]); u.nr = __builtin_amdgcn_readfirstlane(tnr[t]); return true;
    }
    __device__ __forceinline__ size_t a_off(const Unit& u, size_t) const { return (size_t)u.row0 * a_pitch; }
    __device__ __forceinline__ size_t b_off(const Unit& u, size_t tstep) const { return (size_t)u.e * b_exp + (size_t)u.pn * tstep; }
    __device__ __forceinline__ void a_ready(const Unit&) const {}
    __device__ __forceinline__ void done(const Unit& u) const {
        asm volatile("s_waitcnt vmcnt(0)" ::: "memory");
        if ((threadIdx.x & 63) == 0) __hip_atomic_fetch_add(cnt + 16 * u.pm, 1u, __ATOMIC_RELAXED, __HIP_MEMORY_SCOPE_AGENT);
    }
};
struct GroupedOrderDep {
    const PG8_LAS int* te; const PG8_LAS int* tr0; const PG8_LAS int* tnr; int nunits, G, c; size_t b_exp; unsigned* cnt;
    __device__ __forceinline__ bool next(int i, Unit& u) const {
        const int L = i * G + (G - 1 - c); if (L >= nunits) return false;
        const int t = L >> 2; u.pm = t; u.pn = L & 3; u.e = __builtin_amdgcn_readfirstlane(te[t]); u.row0 = __builtin_amdgcn_readfirstlane(tr0[t]); u.nr = __builtin_amdgcn_readfirstlane(tnr[t]);
        u.rdy = __hip_atomic_load(cnt + 16 * t, __ATOMIC_RELAXED, __HIP_MEMORY_SCOPE_AGENT); return true;
    }
    __device__ __forceinline__ int tok(int i, int r) const { const int t = (i * G + (G - 1 - c)) >> 2; const int r0 = tr0[t], n = tnr[t]; return r0 + (r < n ? r : n - 1); }
    __device__ __forceinline__ size_t a_off(const Unit&, size_t) const { return 0; }
    __device__ __forceinline__ size_t b_off(const Unit& u, size_t tstep) const { return (size_t)u.e * b_exp + (size_t)u.pn * tstep; }
    __device__ __forceinline__ void a_ready(const Unit& u) const {
        if ((unsigned)__builtin_amdgcn_readfirstlane(u.rdy) < 32u) { unsigned spins = 0;
            while ((unsigned)__builtin_amdgcn_readfirstlane(__hip_atomic_load(cnt + 16 * u.pm, __ATOMIC_RELAXED, __HIP_MEMORY_SCOPE_AGENT)) < 32u && ++spins < (1u << 22)) __builtin_amdgcn_s_sleep(2); }
        asm volatile("" ::: "memory");
    }
    __device__ __forceinline__ void done(const Unit&) const {}
};
struct GroupedGatherOrder {
    const PG8_LAS int* te; const PG8_LAS int* tr0; const PG8_LAS int* tnr; const PG8_LAS int* rt; int nunits, G, c; size_t b_exp;
    __device__ __forceinline__ bool next(int i, Unit& u) const {
        const int L = i * G + c; if (L >= nunits) return false;
        const int t = L >> 2; u.pm = t; u.pn = L & 3; u.e = __builtin_amdgcn_readfirstlane(te[t]); u.row0 = __builtin_amdgcn_readfirstlane(tr0[t]); u.nr = __builtin_amdgcn_readfirstlane(tnr[t]); return true;
    }
    __device__ __forceinline__ int tok(int i, int r) const { return rt[i * 256 + r]; }
    __device__ __forceinline__ size_t a_off(const Unit&, size_t) const { return 0; }
    __device__ __forceinline__ size_t b_off(const Unit& u, size_t tstep) const { return (size_t)u.e * b_exp + (size_t)u.pn * tstep; }
    __device__ __forceinline__ void a_ready(const Unit&) const {}
    __device__ __forceinline__ void done(const Unit&) const {}
};
struct GroupedGatherPub {
    const PG8_LAS int* te; const PG8_LAS int* tr0; const PG8_LAS int* tnr; const PG8_LAS int* rt; int nunits, G, c; size_t b_exp; unsigned* cnt;
    __device__ __forceinline__ bool next(int i, Unit& u) const {
        const int L = i * G + c; if (L >= nunits) return false;
        const int t = L >> 2; u.pm = t; u.pn = L & 3; u.e = __builtin_amdgcn_readfirstlane(te[t]); u.row0 = __builtin_amdgcn_readfirstlane(tr0[t]); u.nr = __builtin_amdgcn_readfirstlane(tnr[t]); return true;
    }
    __device__ __forceinline__ int tok(int i, int r) const { return rt[i * 256 + r]; }
    __device__ __forceinline__ size_t a_off(const Unit&, size_t) const { return 0; }
    __device__ __forceinline__ size_t b_off(const Unit& u, size_t tstep) const { return (size_t)u.e * b_exp + (size_t)u.pn * tstep; }
    __device__ __forceinline__ void a_ready(const Unit&) const {}
    __device__ __forceinline__ void done(const Unit& u) const {
        asm volatile("s_waitcnt vmcnt(0)" ::: "memory");
        if ((threadIdx.x & 63) == 0) __hip_atomic_fetch_add(cnt + 16 * u.pm, 1u, __ATOMIC_RELAXED, __HIP_MEMORY_SCOPE_AGENT);
    }
};
__device__ __forceinline__ float silu_fast(float x) { return x * __builtin_amdgcn_rcpf(1.f + __builtin_amdgcn_exp2f(-1.4426950408889634f * x)); }
struct EpiSwiGLU {
    static constexpr bool PERM = true, AFTER_DRAIN = false;
    bf16_t* H;
    __device__ __forceinline__ void operator()(const f32x4 (&acc)[2][2][4][2], const Unit& u, int wr, int wc, int fr, int fq) const {
        const int colh = u.pn * 128 + wc * 32 + 8 * fq;
#pragma unroll
        for (int ai = 0; ai < 2; ++ai)
#pragma unroll
            for (int m = 0; m < 4; ++m) { const int r = ai * HALF + wr * 64 + m * 16 + fr;
                if (r < u.nr) {
                    const f32x4 g0 = acc[ai][0][m][0], g1 = acc[ai][0][m][1], u0 = acc[ai][1][m][0], u1 = acc[ai][1][m][1];
                    u32x4 w; w.x = cvt_pk_bf16(silu_fast(g0[0]) * u0[0], silu_fast(g0[1]) * u0[1]); w.y = cvt_pk_bf16(silu_fast(g0[2]) * u0[2], silu_fast(g0[3]) * u0[3]);
                    w.z = cvt_pk_bf16(silu_fast(g1[0]) * u1[0], silu_fast(g1[1]) * u1[1]); w.w = cvt_pk_bf16(silu_fast(g1[2]) * u1[2], silu_fast(g1[3]) * u1[3]);
                    *(u32x4*)(H + (size_t)(u.row0 + r) * 512 + colh) = w; } }
    }
};
struct EpiBf16_I8 {
    static constexpr bool PERM = true, AFTER_DRAIN = false;
    bf16_t* O; int ldc; const float* sa; const float* sw; int nvalid;
    __device__ __forceinline__ void operator()(const f32x4 (&acc)[2][2][4][2], const Unit& u, int wr, int wc, int fr, int fq) const {
        const int row0 = u.pm * BM + wr * 64 + fr, col0 = u.pn * BM + wc * 32 + 8 * fq;
        f32x4 sv[2][2];
#pragma unroll
        for (int bj = 0; bj < 2; ++bj)
#pragma unroll
            for (int n = 0; n < 2; ++n) sv[bj][n] = *(const f32x4*)(sw + col0 + bj * HALF + 4 * n);
#pragma unroll
        for (int ai = 0; ai < 2; ++ai)
#pragma unroll
            for (int m = 0; m < 4; ++m) { const int r = row0 + ai * HALF + m * 16; const float a = sa[r]; bf16_t* rowp = O + (size_t)r * ldc + col0;
#pragma unroll
                for (int bj = 0; bj < 2; ++bj) { f32x4 v0, v1;
#pragma unroll
                    for (int j = 0; j < 4; ++j) { v0[j] = (float)__float_as_int(acc[ai][bj][m][0][j]) * (a * sv[bj][0][j]); v1[j] = (float)__float_as_int(acc[ai][bj][m][1][j]) * (a * sv[bj][1][j]); }
                    u32x4 w; w.x = cvt_pk_bf16(v0[0], v0[1]); w.y = cvt_pk_bf16(v0[2], v0[3]); w.z = cvt_pk_bf16(v1[0], v1[1]); w.w = cvt_pk_bf16(v1[2], v1[3]);
                    if (col0 + bj * HALF < nvalid) *(u32x4*)(rowp + bj * HALF) = w; } }
    }
};
template <bool WT = false> struct EpiSwiGLU_I8 {
    static constexpr bool PERM = true, AFTER_DRAIN = false;
    bf16_t* H; const float* sa; const float* sw;
    __device__ __forceinline__ void operator()(const f32x4 (&acc)[2][2][4][2], const Unit& u, int wr, int wc, int fr, int fq) const {
        const int colh = u.pn * 128 + wc * 32 + 8 * fq;
        const float* swp = sw + (size_t)u.e * 1024 + u.pn * 256 + wc * 32 + 8 * fq;
        const f32x4 sg0 = *(const f32x4*)swp, sg1 = *(const f32x4*)(swp + 4), su0 = *(const f32x4*)(swp + 128), su1 = *(const f32x4*)(swp + 132);
#pragma unroll
        for (int ai = 0; ai < 2; ++ai)
#pragma unroll
            for (int m = 0; m < 4; ++m) { const int r = ai * HALF + wr * 64 + m * 16 + fr;
                if (r < u.nr) { const float a = sa[u.row0 + r];
                    f32x4 g0, g1, u0, u1;
#pragma unroll
                    for (int j = 0; j < 4; ++j) { g0[j] = (float)__float_as_int(acc[ai][0][m][0][j]) * (a * sg0[j]); g1[j] = (float)__float_as_int(acc[ai][0][m][1][j]) * (a * sg1[j]);
                                                  u0[j] = (float)__float_as_int(acc[ai][1][m][0][j]) * (a * su0[j]); u1[j] = (float)__float_as_int(acc[ai][1][m][1][j]) * (a * su1[j]); }
                    u32x4 w; w.x = cvt_pk_bf16(silu_fast(g0[0]) * u0[0], silu_fast(g0[1]) * u0[1]); w.y = cvt_pk_bf16(silu_fast(g0[2]) * u0[2], silu_fast(g0[3]) * u0[3]);
                    w.z = cvt_pk_bf16(silu_fast(g1[0]) * u1[0], silu_fast(g1[1]) * u1[1]); w.w = cvt_pk_bf16(silu_fast(g1[2]) * u1[2], silu_fast(g1[3]) * u1[3]);
                    if (WT) asm volatile("global_store_dwordx4 %0, %1, off sc1" :: "v"(H + (size_t)(u.row0 + r) * 512 + colh), "v"(w) : "memory");
                    else *(u32x4*)(H + (size_t)(u.row0 + r) * 512 + colh) = w; } }
    }
};
struct EpiYs {
    static constexpr bool PERM = true, AFTER_DRAIN = false;
    bf16_t* Y; const float* gate;
    __device__ __forceinline__ void operator()(const f32x4 (&acc)[2][2][4][2], const Unit& u, int wr, int wc, int fr, int fq) const {
        const int col0 = u.pn * BM + wc * 32 + 8 * fq;
#pragma unroll
        for (int ai = 0; ai < 2; ++ai)
#pragma unroll
            for (int m = 0; m < 4; ++m) { const int r = ai * HALF + wr * 64 + m * 16 + fr;
                if (r < u.nr) { const float g = gate[u.row0 + r];
#pragma unroll
                    for (int bj = 0; bj < 2; ++bj) { const f32x4 v0 = acc[ai][bj][m][0] * g, v1 = acc[ai][bj][m][1] * g;
                        u32x4 w; w.x = cvt_pk_bf16(v0[0], v0[1]); w.y = cvt_pk_bf16(v0[2], v0[3]); w.z = cvt_pk_bf16(v1[0], v1[1]); w.w = cvt_pk_bf16(v1[2], v1[3]);
                        *(u32x4*)(Y + (size_t)(u.row0 + r) * 1024 + col0 + bj * HALF) = w; } } }
    }
};
struct EpiYs8 {
    static constexpr bool PERM = true, AFTER_DRAIN = false;
    unsigned char* Y; float* SC; const float* gate;
    __device__ __forceinline__ void operator()(const f32x4 (&acc)[2][2][4][2], const Unit& u, int wr, int wc, int fr, int fq) const {
        const int col0 = u.pn * BM + wc * 32 + 8 * fq;
#pragma unroll
        for (int ai = 0; ai < 2; ++ai)
#pragma unroll
            for (int m = 0; m < 4; ++m) { const int r = ai * HALF + wr * 64 + m * 16 + fr; const bool ok = r < u.nr;
                const float g = ok ? gate[u.row0 + r] : 0.f;
                f32x4 v[2][2]; float mx = 0.f;
#pragma unroll
                for (int bj = 0; bj < 2; ++bj)
#pragma unroll
                    for (int n = 0; n < 2; ++n) { v[bj][n] = acc[ai][bj][m][n] * g;
#pragma unroll
                        for (int j = 0; j < 4; ++j) mx = fmaxf(mx, fabsf(v[bj][n][j])); }
                mx = fmaxf(mx, __shfl_xor(mx, 16)); mx = fmaxf(mx, __shfl_xor(mx, 32));
                const float inv = mx > 0.f ? 127.f * __builtin_amdgcn_rcpf(mx) : 0.f;
                unsigned w[2][2];
#pragma unroll
                for (int bj = 0; bj < 2; ++bj)
#pragma unroll
                    for (int n = 0; n < 2; ++n) { const f32x4 f = v[bj][n] * inv + 128.5f;
                        w[bj][n] = (unsigned)f[0] | ((unsigned)f[1] << 8) | ((unsigned)f[2] << 16) | ((unsigned)f[3] << 24); }
                const bool odd = fq & 1;
                const unsigned s0 = odd ? w[0][0] : w[1][0], s1 = odd ? w[0][1] : w[1][1];
                const unsigned g0 = (unsigned)__shfl_xor((int)s0, 16), g1 = (unsigned)__shfl_xor((int)s1, 16);
                if (ok) {
                    const u32x4 o = odd ? (u32x4){g0, g1, w[1][0], w[1][1]} : (u32x4){w[0][0], w[0][1], g0, g1};
                    *(u32x4*)(Y + (size_t)(u.row0 + r) * 1024 + (col0 & ~15) + (odd ? HALF : 0)) = o;
                    if (fq == 0) SC[(size_t)(u.row0 + r) * 16 + wc * 4 + u.pn] = mx * (1.f / 127.f); } }
    }
};
template <class Epi, class Sched, bool ALIGN_EPI = false, bool SP2 = false, bool GATHER = false, bool I8 = false>
__device__ __forceinline__ void gemm_phase(PG8_LAS unsigned char* lds, const Gemm g, const Sched& S, const Epi& E) {
    const int tid = threadIdx.x, wid = __builtin_amdgcn_readfirstlane(tid >> 6), lane = tid & 63, wr = wid >> 2, wc = wid & 3, fr = lane & 15, fq = lane >> 4;
    const int K = g.K, KB = I8 ? K : 2 * K  , nt = KB / (BK * 2);
    unsigned voffA[2], voffB[2];
#pragma unroll
    for (int i = 0; i < 2; ++i) { int R, C; stage_rc(tid * 16 + i * 8192, R, C); const int Rb = Epi::PERM ? ((R & ~31) + perm32(R & 31)) : R;
        voffA[i] = (unsigned)(R * KB + C * 2); voffB[i] = (unsigned)(Rb * KB + C * 2); }
    unsigned cv0[2] = {0u, 0u}, cv1[2] = {0u, 0u}, nv0[2] = {0u, 0u}, nv1[2] = {0u, 0u};
    int gR[2], gC[2];
#pragma unroll
    for (int i = 0; i < 2; ++i) stage_rc(tid * 16 + i * 8192, gR[i], gC[i]);
#define PG8_GOFF(dst0, dst1, ui_) do { _Pragma("unroll") for (int _i = 0; _i < 2; ++_i) { \
        dst0[_i] = (unsigned)S.tok((ui_), gR[_i]) * (unsigned)KB + (unsigned)gC[_i] * 2u; dst1[_i] = (unsigned)S.tok((ui_), HALF + gR[_i]) * (unsigned)KB + (unsigned)gC[_i] * 2u; } } while (0)
    const size_t kstep = (size_t)(BK * 2);
    const size_t hstep = (size_t)HALF * KB;
    const size_t tstep = 2 * hstep;
    const unsigned ldsw = (unsigned)wid * 1024u;
    const int aoff = lds_byte(wr * 64 + fr, fq * 8), boff = lds_byte(wc * 32 + fr, fq * 8), aoff1 = lds_byte(wr * 64 + fr, 32 + fq * 8), boff1 = lds_byte(wc * 32 + fr, 32 + fq * 8);
#define PG8_SA(b, h) (((b) * 2 + (h)) * HTB)
#define PG8_SB(b, h) ((4 + (b) * 2 + (h)) * HTB)
#define PG8_STAGE(bufoff, gbase, voff) do { _Pragma("unroll") for (int _i = 0; _i < 2; ++_i) \
        __builtin_amdgcn_global_load_lds((const unsigned*)((const char*)(gbase) + (voff)[_i]), (PG8_LAS unsigned*)(lds + (bufoff) + ldsw + _i * 8192), 16, 0, 0); } while (0)
#define PG8_GLDS1(gp, ldsoff) __builtin_amdgcn_global_load_lds((const unsigned*)(gp), (PG8_LAS unsigned*)(lds + (ldsoff)), 16, 0, 0)
#define PG8_STAGEA(bufoff, kptr, half, nx) do { if constexpr (GATHER) { \
        const unsigned _v0 = (half) ? ((nx) ? nv1[0] : cv1[0]) : ((nx) ? nv0[0] : cv0[0]), _v1 = (half) ? ((nx) ? nv1[1] : cv1[1]) : ((nx) ? nv0[1] : cv0[1]); \
        PG8_GLDS1((const char*)(kptr) + _v0, (bufoff) + ldsw); PG8_GLDS1((const char*)(kptr) + _v1, (bufoff) + ldsw + 8192); \
    } else { PG8_STAGE(bufoff, (kptr) + ((half) ? hstep : (size_t)0), voffA); } } while (0)
#define PG8_LDA(dst, b, h) do { _Pragma("unroll") for (int m = 0; m < 4; ++m) _Pragma("unroll") for (int k = 0; k < 2; ++k) dst[m][k] = *(const PG8_LAS bf16x8*)(lds + PG8_SA(b, h) + (k ? aoff1 : aoff) + m * 2048); } while (0)
#define PG8_LDB(dst, b, h) do { _Pragma("unroll") for (int n = 0; n < 2; ++n) _Pragma("unroll") for (int k = 0; k < 2; ++k) dst[n][k] = *(const PG8_LAS bf16x8*)(lds + PG8_SB(b, h) + (k ? boff1 : boff) + n * 2048); } while (0)
#define PG8_MMA(ai, bj, At, Bt) do { __builtin_amdgcn_s_setprio(1); _Pragma("unroll") for (int m = 0; m < 4; ++m) _Pragma("unroll") for (int n = 0; n < 2; ++n) _Pragma("unroll") for (int k = 0; k < 2; ++k) { \
        if constexpr (I8) acc[ai][bj][m][n] = __builtin_bit_cast(f32x4, __builtin_amdgcn_mfma_i32_16x16x64_i8(__builtin_bit_cast(i32x4, Bt[n][k]), __builtin_bit_cast(i32x4, At[m][k]), __builtin_bit_cast(i32x4, acc[ai][bj][m][n]), 0, 0, 0)); \
        else acc[ai][bj][m][n] = __builtin_amdgcn_mfma_f32_16x16x32_bf16(Bt[n][k], At[m][k], acc[ai][bj][m][n], 0, 0, 0); } __builtin_amdgcn_s_setprio(0); } while (0)
#define PG8_WAIT_V(n) asm volatile("s_waitcnt vmcnt(" #n ")" ::: "memory")
#define PG8_WAIT_L(n) asm volatile("s_waitcnt lgkmcnt(" #n ")" ::: "memory")
#define PG8_BAR __builtin_amdgcn_s_barrier()
#define PG8_SCHED __builtin_amdgcn_sched_barrier(0)
    Unit cur, nxt; int ui = 0;
    if (!S.next(0, cur)) return;
    if constexpr (GATHER) { PG8_GOFF(cv0, cv1, 0); }
    f32x4 acc[2][2][4][2];
#pragma unroll
    for (int a = 0; a < 2; ++a)
#pragma unroll
        for (int b = 0; b < 2; ++b)
#pragma unroll
            for (int m = 0; m < 4; ++m)
#pragma unroll
                for (int n = 0; n < 2; ++n) acc[a][b][m][n] = (f32x4){0.f, 0.f, 0.f, 0.f};
    bf16x8 At[4][2], B0[2][2], B1[2][2];
    const char* cA = (const char*)g.A + S.a_off(cur, tstep); const char* cB = (const char*)g.Bt + S.b_off(cur, tstep);
    S.a_ready(cur);
    if constexpr (SP2) {
        PG8_STAGE(PG8_SB(0, 0), cB, voffB); PG8_STAGE(PG8_SB(0, 1), cB + hstep, voffB); PG8_STAGEA(PG8_SA(0, 0), cA, 0, false); PG8_STAGEA(PG8_SA(0, 1), cA, 1, false);
        if (wr == 1) PG8_BAR;
        PG8_WAIT_V(2); PG8_BAR;
        PG8_STAGE(PG8_SB(1, 0), cB + kstep, voffB); PG8_STAGEA(PG8_SA(1, 0), cA + kstep, 0, false); PG8_STAGE(PG8_SB(1, 1), cB + hstep + kstep, voffB);
        PG8_WAIT_V(6); PG8_BAR;
    } else {
        PG8_STAGE(PG8_SB(0, 0), cB, voffB); PG8_STAGEA(PG8_SA(0, 0), cA, 0, false); PG8_STAGE(PG8_SB(0, 1), cB + hstep, voffB); PG8_STAGEA(PG8_SA(0, 1), cA, 1, false);
        if (wr == 1) PG8_BAR;
        PG8_WAIT_V(4); PG8_BAR;
        PG8_STAGE(PG8_SB(1, 0), cB + kstep, voffB); PG8_STAGEA(PG8_SA(1, 0), cA + kstep, 0, false); PG8_STAGE(PG8_SB(1, 1), cB + hstep + kstep, voffB);
        PG8_WAIT_V(6); PG8_BAR;
    }
    for (;;) {
        const bool has_next = S.next(ui + 1, nxt);
        if constexpr (GATHER) { if (has_next) { PG8_GOFF(nv0, nv1, ui + 1); } else { nv0[0] = cv0[0]; nv0[1] = cv0[1]; nv1[0] = cv1[0]; nv1[1] = cv1[1]; } }
        const char* nA = has_next ? (const char*)g.A + S.a_off(nxt, tstep) : cA; const char* nB = has_next ? (const char*)g.Bt + S.b_off(nxt, tstep) : cB;
        for (int t = 0; t < nt; t += 2) {
            const bool last = (t == nt - 2);
            const char* a1 = cA + (size_t)(t + 1) * kstep;
            const char* a2 = last ? nA : cA + (size_t)(t + 2) * kstep; const char* b2 = last ? nB : cB + (size_t)(t + 2) * kstep;
            const char* a3 = a2 + kstep; const char* b3 = b2 + kstep;
            if (last && has_next) S.a_ready(nxt);
            if constexpr (SP2) {
            PG8_LDB(B0, 0, 0); PG8_LDB(B1, 0, 1); PG8_SCHED; PG8_LDA(At, 0, 0); PG8_STAGEA(PG8_SA(1, 1), a1, 1, false);
            PG8_WAIT_V(8); PG8_WAIT_L(0); PG8_BAR; PG8_MMA(0, 0, At, B0); PG8_MMA(0, 1, At, B1); PG8_BAR; PG8_SCHED;
            PG8_LDA(At, 0, 1); PG8_STAGE(PG8_SB(0, 0), b2, voffB); PG8_STAGE(PG8_SB(0, 1), b2 + hstep, voffB); PG8_STAGEA(PG8_SA(0, 0), a2, 0, last);
            PG8_WAIT_V(8); PG8_WAIT_L(0); PG8_BAR; PG8_MMA(1, 0, At, B0); PG8_MMA(1, 1, At, B1); PG8_BAR; PG8_SCHED;
            PG8_LDB(B0, 1, 0); PG8_LDB(B1, 1, 1); PG8_SCHED; PG8_LDA(At, 1, 0); PG8_STAGEA(PG8_SA(0, 1), a2, 1, last);
            PG8_WAIT_V(8); PG8_WAIT_L(0); PG8_BAR; PG8_MMA(0, 0, At, B0); PG8_MMA(0, 1, At, B1); PG8_BAR; PG8_SCHED;
            PG8_LDA(At, 1, 1); PG8_STAGE(PG8_SB(1, 0), b3, voffB); PG8_STAGE(PG8_SB(1, 1), b3 + hstep, voffB); PG8_STAGEA(PG8_SA(1, 0), a3, 0, last);
            PG8_WAIT_V(8); PG8_WAIT_L(0); PG8_BAR; PG8_MMA(1, 0, At, B0); PG8_MMA(1, 1, At, B1); PG8_BAR; PG8_SCHED;
            } else {
            PG8_LDB(B0, 0, 0); PG8_SCHED; PG8_LDA(At, 0, 0); PG8_STAGEA(PG8_SA(1, 1), a1, 1, false);
            PG8_WAIT_L(8); PG8_BAR; PG8_WAIT_L(0); PG8_MMA(0, 0, At, B0); PG8_BAR; PG8_SCHED;
            PG8_LDB(B1, 0, 1); PG8_STAGE(PG8_SB(0, 0), b2, voffB);
            PG8_BAR; PG8_WAIT_L(0); PG8_MMA(0, 1, At, B1); PG8_BAR;
            PG8_LDA(At, 0, 1); PG8_STAGEA(PG8_SA(0, 0), a2, 0, last);
            PG8_BAR; PG8_WAIT_L(0); PG8_MMA(1, 0, At, B0); PG8_BAR; PG8_SCHED;
            PG8_STAGE(PG8_SB(0, 1), b2 + hstep, voffB);
            PG8_WAIT_V(6); PG8_BAR; PG8_MMA(1, 1, At, B1); PG8_BAR;
            PG8_LDB(B0, 1, 0); PG8_SCHED; PG8_LDA(At, 1, 0); PG8_STAGEA(PG8_SA(0, 1), a2, 1, last);
            PG8_WAIT_L(8); PG8_BAR; PG8_WAIT_L(0); PG8_MMA(0, 0, At, B0); PG8_BAR; PG8_SCHED;
            PG8_LDB(B1, 1, 1); PG8_STAGE(PG8_SB(1, 0), b3, voffB);
            PG8_BAR; PG8_WAIT_L(0); PG8_MMA(0, 1, At, B1); PG8_BAR;
            PG8_LDA(At, 1, 1); PG8_STAGEA(PG8_SA(1, 0), a3, 0, last);
            PG8_BAR; PG8_WAIT_L(0); PG8_MMA(1, 0, At, B0); PG8_BAR; PG8_SCHED;
            PG8_STAGE(PG8_SB(1, 1), b3 + hstep, voffB);
            PG8_WAIT_V(6); PG8_BAR; PG8_MMA(1, 1, At, B1); PG8_BAR;
            }
        }
        if constexpr (ALIGN_EPI) { if (wr == 0) PG8_BAR; }
        if constexpr (!Epi::AFTER_DRAIN) { E(acc, cur, wr, wc, fr, fq); S.done(cur); }
        if (!has_next) break;
#pragma unroll
        for (int a = 0; a < 2; ++a)
#pragma unroll
            for (int b = 0; b < 2; ++b)
#pragma unroll
                for (int m = 0; m < 4; ++m)
#pragma unroll
                    for (int n = 0; n < 2; ++n) acc[a][b][m][n] = (f32x4){0.f, 0.f, 0.f, 0.f};
        cur = nxt; cA = nA; cB = nB; ++ui;
        if constexpr (GATHER) { cv0[0] = nv0[0]; cv0[1] = nv0[1]; cv1[0] = nv1[0]; cv1[1] = nv1[1]; }
        if constexpr (ALIGN_EPI) { if (wr == 1) PG8_BAR; }
    }
    PG8_WAIT_V(0);
    if constexpr (!ALIGN_EPI) { if (wr == 0) PG8_BAR; }
    PG8_BAR;
    if constexpr (Epi::AFTER_DRAIN) { E.fused(acc, cur, wr, wc, fr, fq, lds, wid, lane); S.done(cur); }
#undef PG8_SA
#undef PG8_SB
#undef PG8_STAGE
#undef PG8_STAGEA
#undef PG8_GLDS1
#undef PG8_GOFF
#undef PG8_LDA
#undef PG8_LDB
#undef PG8_MMA
#undef PG8_WAIT_V
#undef PG8_WAIT_L
#undef PG8_BAR
#undef PG8_SCHED
}
}
#define GAS __attribute__((address_space(1)))
#define LAS __attribute__((address_space(3)))
typedef unsigned short bf16;
typedef unsigned v4u __attribute__((ext_vector_type(4)));
typedef float f32x4 __attribute__((ext_vector_type(4)));
typedef short bf16x8 __attribute__((ext_vector_type(8)));
typedef GAS unsigned gu32;
typedef GAS unsigned long long gu64;
#define RLX_AGENT __ATOMIC_RELAXED, __HIP_MEMORY_SCOPE_AGENT
#define LDS_WAIT() asm volatile("s_waitcnt lgkmcnt(0)" ::: "memory")
#define VM_WAIT() asm volatile("s_waitcnt vmcnt(0)" ::: "memory")
__device__ __forceinline__ unsigned long long rt() { return __builtin_amdgcn_s_memrealtime(); }
__device__ __forceinline__ unsigned f2bfu(float f) { unsigned u = __builtin_bit_cast(unsigned, f); return (u + 0x7fffu + ((u >> 16) & 1u)) >> 16; }
__device__ __forceinline__ unsigned pk2(float lo, float hi) { return f2bfu(lo) | (f2bfu(hi) << 16); }

#define XB_TMO      128
#define XB_XCNT(j)  (256  + 64 * (j))
#define XB_XSUB(j)  (1280 + 64 * (j))
#define XB_XGEN(j)  (2304 + 64 * (j))
#define XB_TOP      3328
#define XB_TOPGEN   3392
#define XCD_BAR_WORDS 3456
#define XB_SPIN_CAP (1u << 18)

__device__ __forceinline__ unsigned xb_ld(unsigned* p)              { return __hip_atomic_load(p, __ATOMIC_RELAXED, __HIP_MEMORY_SCOPE_AGENT); }
__device__ __forceinline__ unsigned xb_add(unsigned* p, unsigned v) { return __hip_atomic_fetch_add(p, v, __ATOMIC_RELAXED, __HIP_MEMORY_SCOPE_AGENT); }
__device__ __forceinline__ unsigned xb_xcc_id() { return (unsigned)__builtin_amdgcn_s_getreg((3 << 11) | 20) & 0xFu; }
#define XB_SPIN(cond, bar) do { unsigned _sp = 0; while (cond) { __builtin_amdgcn_s_sleep(1); \
    if ((++_sp & 255u) == 0u) { if (xb_ld(&(bar)[XB_TMO])) break; if (_sp > XB_SPIN_CAP) { atomicAdd(&(bar)[XB_TMO], 1u); break; } } } } while (0)

struct XcdBarrier {
    unsigned* bar; unsigned x;
    volatile LAS unsigned* st;
};

__device__ __forceinline__ XcdBarrier xcd_barrier_post(unsigned* bar, volatile LAS unsigned* st) {
    XcdBarrier b; b.bar = bar; b.x = xb_xcc_id(); b.st = st;
    if (threadIdx.x == 0) (void)xb_add(&bar[XB_XCNT(b.x)], 1u);
    return b;
}
__device__ __forceinline__ void xcd_barrier_complete(unsigned* bar, unsigned x, unsigned& nloc, unsigned& nx) {
    const unsigned G = gridDim.x * gridDim.y * gridDim.z;
    unsigned sum, cnt, mine, sp = 0u;
    for (;;) {
        sum = 0u; cnt = 0u; mine = 0u;
#pragma unroll
        for (unsigned j = 0; j < 16; ++j) { const unsigned c = xb_ld(&bar[XB_XCNT(j)]); sum += c; cnt += (c > 0u) ? 1u : 0u; mine = (j == x) ? c : mine; }
        if (sum == G) break;
        __builtin_amdgcn_s_sleep(1);
        if ((++sp & 255u) == 0u) { if (xb_ld(&bar[XB_TMO])) break; if (sp > XB_SPIN_CAP) { atomicAdd(&bar[XB_TMO], 1u); break; } }
    }
    nloc = mine > 0u ? mine : 1u; nx = cnt > 0u ? cnt : 1u;
}

__device__ __forceinline__ void xcd_barrier(const XcdBarrier& b) {
    asm volatile("s_waitcnt vmcnt(0)" ::: "memory");
    __syncthreads();
    if (threadIdx.x == 0) {
        unsigned* bar = b.bar;
        __builtin_amdgcn_s_waitcnt(0);
        unsigned nloc = b.st[0], nx = b.st[1];
        if (nloc == 0u) { xcd_barrier_complete(bar, b.x, nloc, nx); b.st[0] = nloc; b.st[1] = nx; }
        const unsigned old = xb_add(&bar[XB_XSUB(b.x)], 1u);
        const unsigned gen = old / nloc;
        if (old + 1u == (gen + 1u) * nloc) {
            __builtin_amdgcn_fence(__ATOMIC_RELEASE, "agent");
            asm volatile("s_waitcnt vmcnt(0)" ::: "memory");
            const unsigned og = xb_add(&bar[XB_TOP], 1u);
            const unsigned tg = og / nx;
            if (og + 1u == (tg + 1u) * nx) xb_add(&bar[XB_TOPGEN], 1u);
            else XB_SPIN(xb_ld(&bar[XB_TOPGEN]) == tg, bar);
            __builtin_amdgcn_fence(__ATOMIC_ACQUIRE, "agent");
            xb_add(&bar[XB_XGEN(b.x)], 1u);
            asm volatile("s_waitcnt vmcnt(0)" ::: "memory");
        } else {
            XB_SPIN(xb_ld(&bar[XB_XGEN(b.x)]) == gen, bar);
            __builtin_amdgcn_fence(__ATOMIC_ACQUIRE, "agent");
            asm volatile("s_waitcnt vmcnt(0)" ::: "memory");
        }
    }
    __syncthreads();
}

template <bool DUAL, class FA, class FB, class FB2, class FE>
__device__ __forceinline__ void naive_tile_h(float* sm, int t256, int K, FA fa, FB fb, FB2 fb2, FE fe) {
    float* As = sm; float* Bs = sm + 1088; float* Bs2 = sm + 2176;
    const int tx = t256 & 15, ty = t256 >> 4;
    float acc[4][4], acc2[4][4];
#pragma unroll
    for (int i = 0; i < 4; ++i)
#pragma unroll
        for (int j = 0; j < 4; ++j) { acc[i][j] = 0.f; acc2[i][j] = 0.f; }
    for (int k0 = 0; k0 < K; k0 += 16) {
        { const int r = t256 >> 2, kk = (t256 & 3) * 4; const float4 a = fa(r, k0 + kk); As[kk * 68 + r] = a.x; As[(kk + 1) * 68 + r] = a.y; As[(kk + 2) * 68 + r] = a.z; As[(kk + 3) * 68 + r] = a.w; }
        { const int kk = t256 >> 4, c = (t256 & 15) * 4; *(float4*)&Bs[kk * 68 + c] = fb(k0 + kk, c); if (DUAL) *(float4*)&Bs2[kk * 68 + c] = fb2(k0 + kk, c); }
        __syncthreads();
#pragma unroll
        for (int kk = 0; kk < 16; ++kk) {
            const float4 a = *(const float4*)&As[kk * 68 + ty * 4]; const float4 b = *(const float4*)&Bs[kk * 68 + tx * 4];
            const float av[4] = {a.x, a.y, a.z, a.w}; const float bv[4] = {b.x, b.y, b.z, b.w};
#pragma unroll
            for (int i = 0; i < 4; ++i)
#pragma unroll
                for (int j = 0; j < 4; ++j) acc[i][j] += av[i] * bv[j];
            if (DUAL) {
                const float4 b2 = *(const float4*)&Bs2[kk * 68 + tx * 4]; const float bw[4] = {b2.x, b2.y, b2.z, b2.w};
#pragma unroll
                for (int i = 0; i < 4; ++i)
#pragma unroll
                    for (int j = 0; j < 4; ++j) acc2[i][j] += av[i] * bw[j];
            }
        }
        __syncthreads();
    }
#pragma unroll
    for (int i = 0; i < 4; ++i) fe(ty * 4 + i, tx * 4, make_float4(acc[i][0], acc[i][1], acc[i][2], acc[i][3]), make_float4(acc2[i][0], acc2[i][1], acc2[i][2], acc2[i][3]));
}

__device__ __forceinline__ void ph_la(int gtid, int nthr, const bf16_t* PROJ, const float* upf, const float* bf, const float* upb, const float* bb, float* LAF, float* LAB) {
    for (int i = gtid; i < NTOK * 256 * 2; i += nthr) {
        const int c = i & 255, t = (i >> 8) & (NTOK - 1), dir = i >> 23;
        const bf16_t* z = PROJ + (size_t)t * PW + (dir ? C_ZB : C_ZF);
        const float* up = dir ? upb : upf; const float* bias = dir ? bb : bf;
        float pre = bias[c];
#pragma unroll
        for (int r = 0; r < 16; ++r) pre += bf2f(z[r]) * up[r * 256 + c];
        const float ls = fminf(pre, 0.f) - log1pf(expf(-fabsf(pre)));
        (dir ? LAB : LAF)[(size_t)t * 256 + c] = ls * (1.f / 16.f);
    }
}
__device__ __forceinline__ void ph_gla_scan(int bid, int tid, const bf16_t* PROJ, const float* LAF, const float* LAB, float* OF, float* OB) {
    const int es = bid & 3, dir = (bid >> 2) & 1, h = (bid >> 3) & 3, b = bid >> 5;
    const int dg = tid & 15, el = tid >> 4, e = es * 32 + el;
    const float* LA = dir ? LAB : LAF; float* O = dir ? OB : OF;
    float S0 = 0.f, S1 = 0.f, S2 = 0.f, S3 = 0.f;
#pragma unroll 4
    for (int step = 0; step < T; ++step) {
        const int t = dir ? (T - 1 - step) : step;
        const size_t row = (size_t)b * T + t;
        const bf16_t* pr = PROJ + row * PW;
        const float4 la = *(const float4*)(LA + row * 256 + h * 64 + dg * 4);
        const float4 q = ld_bf4(pr + C_GQ + h * 64 + dg * 4);
        const float4 k = ld_bf4(pr + C_GK + h * 64 + dg * 4);
        const float v = bf2f(pr[C_GV + h * 128 + e]);
        S0 = expf(la.x) * S0 + k.x * v; S1 = expf(la.y) * S1 + k.y * v; S2 = expf(la.z) * S2 + k.z * v; S3 = expf(la.w) * S3 + k.w * v;
        float part = (q.x * S0 + q.y * S1 + q.z * S2 + q.w * S3) * 0.125f;
        part += __shfl_xor(part, 1); part += __shfl_xor(part, 2); part += __shfl_xor(part, 4); part += __shfl_xor(part, 8);
        if (dg == 0) O[row * 512 + h * 128 + e] = part;
    }
}
__device__ __forceinline__ void ph_gla_combine(int gw, int NGW, int lane, const float* OF, const float* OB, const bf16_t* PROJ, const float* gain, bf16_t* MIXED) {
    for (int w = gw; w < NTOK * 4; w += NGW) {
        const int t = w >> 2, h = w & 3;
        const size_t o = (size_t)t * 512 + h * 128 + lane * 2;
        const float2 a = *(const float2*)(OF + o), bq = *(const float2*)(OB + o);
        const float v0 = a.x + bq.x, v1 = a.y + bq.y;
        const float ss = wave_sum(v0 * v0 + v1 * v1);
        const float rstd = rsqrtf(ss * (1.f / 128.f) + EPS);
        const bf16_t* g = PROJ + (size_t)t * PW + C_GG + h * 128 + lane * 2;
        const float g0 = bf2f(g[0]), g1 = bf2f(g[1]);
        bf16_t* m = MIXED + (size_t)t * D + h * 128 + lane * 2;
        m[0] = f2bf(v0 * rstd * gain[lane * 2] * silu_f(g0)); m[1] = f2bf(v1 * rstd * gain[lane * 2 + 1] * silu_f(g1));
    }
}
__device__ __forceinline__ void ph_qk_prep(int gw, int NGW, int lane, bf16_t* PROJ, const float* qg, const float* kg, const float* rope, bf16_t* OUT, int opitch) {
    const float gq = qg[lane], gk = kg[lane];
    const int pi = lane >> 1, j = pi & 15;
    for (int t = gw; t < NTOK; t += NGW) {
        bf16_t* p = PROJ + (size_t)t * PW + C_AQ + lane;
        float v[10];
#pragma unroll
        for (int hs = 8; hs < 10; ++hs) v[hs] = bf2f(p[hs * 64]);
        const int tt = t & (T - 1), pos = pi < 16 ? (tt >> 6) : (tt & 63);
        const float c = rope[pos * 16 + j], s = rope[1024 + pos * 16 + j];
#pragma unroll
        for (int hs = 8; hs < 10; ++hs) {
            const float ss = wave_sum(v[hs] * v[hs]);
            const float y = v[hs] * rsqrtf(ss * (1.f / 64.f) + EPS) * (hs < 8 ? gq : gk);
            const float partner = __shfl_xor(y, 1);
            float o = (lane & 1) ? (partner * s + y * c) : (y * c - partner * s);
            if (hs < 8) o *= 0.125f * 1.4426950408889634f;
            OUT[(size_t)t * opitch + lane + hs * 64] = f2bf(o);
        }
    }
}
__device__ __forceinline__ void ph_attn_vb(float* sm, int t256, int vb, const bf16_t* PROJ, float* ATT) {
    float* Qt = sm; float* KV = sm + 4352; float* St = sm + 8704; float* al = sm + 13056;
    const int tx = t256 & 15, ty = t256 >> 4;
    const int q0 = (vb & 63) * 64, hq = (vb >> 6) & 7, b = vb >> 9, kvh = hq >> 2;
    const size_t rowb = (size_t)b * T;
    { const int r = t256 >> 2, d0 = (t256 & 3) * 16; const bf16_t* p = PROJ + (rowb + q0 + r) * PW + C_AQ + hq * 64 + d0;
#pragma unroll
      for (int i = 0; i < 16; ++i) Qt[(d0 + i) * 68 + r] = bf2f(p[i]); }
    float O[4][4];
#pragma unroll
    for (int i = 0; i < 4; ++i)
#pragma unroll
        for (int j = 0; j < 4; ++j) O[i][j] = 0.f;
    float m_run = -INFINITY, l_run = 0.f;
    for (int k0 = 0; k0 < T; k0 += 64) {
        { const int c = t256 >> 2, d0 = (t256 & 3) * 16; const bf16_t* p = PROJ + (rowb + k0 + c) * PW + C_AK + kvh * 64 + d0;
#pragma unroll
          for (int i = 0; i < 16; ++i) KV[(d0 + i) * 68 + c] = bf2f(p[i]); }
        __syncthreads();
        float s[4][4];
#pragma unroll
        for (int i = 0; i < 4; ++i)
#pragma unroll
            for (int j = 0; j < 4; ++j) s[i][j] = 0.f;
#pragma unroll 8
        for (int d = 0; d < 64; ++d) {
            const float4 a = *(const float4*)&Qt[d * 68 + ty * 4]; const float4 bq = *(const float4*)&KV[d * 68 + tx * 4];
            const float av[4] = {a.x, a.y, a.z, a.w}; const float bv[4] = {bq.x, bq.y, bq.z, bq.w};
#pragma unroll
            for (int i = 0; i < 4; ++i)
#pragma unroll
                for (int j = 0; j < 4; ++j) s[i][j] += av[i] * bv[j];
        }
#pragma unroll
        for (int i = 0; i < 4; ++i)
#pragma unroll
            for (int j = 0; j < 4; ++j) St[(tx * 4 + j) * 68 + ty * 4 + i] = s[i][j];
        __syncthreads();
        { const int c = t256 >> 2, e0 = (t256 & 3) * 16; const bf16_t* p = PROJ + (rowb + k0 + c) * PW + C_AV + kvh * 64 + e0;
#pragma unroll
          for (int i = 0; i < 16; ++i) KV[c * 68 + e0 + i] = bf2f(p[i]); }
        if (t256 < 64) {
            float mx = -INFINITY;
            for (int c = 0; c < 64; ++c) mx = fmaxf(mx, St[c * 68 + t256]);
            const float mn = fmaxf(m_run, mx);
            const float alpha = expf(m_run - mn);
            float sum = 0.f;
            for (int c = 0; c < 64; ++c) { const float p = expf(St[c * 68 + t256] - mn); St[c * 68 + t256] = p; sum += p; }
            l_run = l_run * alpha + sum; m_run = mn; al[t256] = alpha;
        }
        __syncthreads();
#pragma unroll
        for (int i = 0; i < 4; ++i) { const float a = al[ty * 4 + i];
#pragma unroll
            for (int j = 0; j < 4; ++j) O[i][j] *= a; }
#pragma unroll 8
        for (int c = 0; c < 64; ++c) {
            const float4 a = *(const float4*)&St[c * 68 + ty * 4]; const float4 bq = *(const float4*)&KV[c * 68 + tx * 4];
            const float av[4] = {a.x, a.y, a.z, a.w}; const float bv[4] = {bq.x, bq.y, bq.z, bq.w};
#pragma unroll
            for (int i = 0; i < 4; ++i)
#pragma unroll
                for (int j = 0; j < 4; ++j) O[i][j] += av[i] * bv[j];
        }
        __syncthreads();
    }
    if (t256 < 64) al[t256] = 1.f / l_run;
    __syncthreads();
#pragma unroll
    for (int i = 0; i < 4; ++i) { const float a = al[ty * 4 + i];
        *(float4*)(ATT + (rowb + q0 + ty * 4 + i) * 512 + hq * 64 + tx * 4) = make_float4(O[i][0] * a, O[i][1] * a, O[i][2] * a, O[i][3] * a); }
    __syncthreads();
}
__device__ __forceinline__ void ph_att_norm(int gw, int NGW, int lane, const float* ATT, const float* gain, bf16_t* MIXED) {
    for (int t = gw; t < NTOK; t += NGW) {
        const float4* a = (const float4*)(ATT + (size_t)t * 512);
        const float4 v0 = a[lane], v1 = a[64 + lane];
        const float ss = wave_sum(v0.x * v0.x + v0.y * v0.y + v0.z * v0.z + v0.w * v0.w + v1.x * v1.x + v1.y * v1.y + v1.z * v1.z + v1.w * v1.w);
        const float rstd = rsqrtf(ss * (1.f / 512.f) + EPS);
        const float4 g0 = ((const float4*)gain)[lane], g1 = ((const float4*)gain)[64 + lane];
        bf16_t* m = MIXED + (size_t)t * D + 512;
        st_bf4(m + lane * 4, make_float4(v0.x * rstd * g0.x, v0.y * rstd * g0.y, v0.z * rstd * g0.z, v0.w * rstd * g0.w));
        st_bf4(m + 256 + lane * 4, make_float4(v1.x * rstd * g1.x, v1.y * rstd * g1.y, v1.z * rstd * g1.z, v1.w * rstd * g1.w));
    }
}
__device__ __forceinline__ void ph_router(int gw, int NGW, int lane, const float* H, const float* g2, const float* wg, const float* bg, const float* we, const float* be, float* RSTD, unsigned* tokinfo, unsigned* ctl) {
    for (int t = gw; t < NTOK; t += NGW) {
        const float4* hr = (const float4*)(H + (size_t)t * D);
        float ss = 0.f;
#pragma unroll
        for (int j = 0; j < 4; ++j) { const float4 v = hr[j * 64 + lane]; ss += v.x * v.x + v.y * v.y + v.z * v.z + v.w * v.w; }
        ss = wave_sum(ss);
        const float rstd = rsqrtf(ss * (1.f / D) + EPS);
        float gl[8], el[64];
#pragma unroll
        for (int i = 0; i < 8; ++i) gl[i] = 0.f;
#pragma unroll
        for (int i = 0; i < 64; ++i) el[i] = 0.f;
#pragma unroll 1
        for (int ji = 0; ji < 16; ++ji) {
            const int k = ((ji >> 2) * 64 + lane) * 4 + (ji & 3);
            const float xv = H[(size_t)t * D + k] * rstd * g2[k];
            const float4* pg = (const float4*)(wg + (size_t)k * 8);
#pragma unroll
            for (int q = 0; q < 2; ++q) { const float4 w = pg[q]; gl[q * 4] += xv * w.x; gl[q * 4 + 1] += xv * w.y; gl[q * 4 + 2] += xv * w.z; gl[q * 4 + 3] += xv * w.w; }
            const float4* pe = (const float4*)(we + (size_t)k * 64);
#pragma unroll
            for (int q = 0; q < 16; ++q) { const float4 w = pe[q]; el[q * 4] += xv * w.x; el[q * 4 + 1] += xv * w.y; el[q * 4 + 2] += xv * w.z; el[q * 4 + 3] += xv * w.w; }
        }
#pragma unroll
        for (int i = 0; i < 8; ++i) gl[i] = wave_sum(gl[i]) + bg[i];
#pragma unroll
        for (int i = 0; i < 64; ++i) el[i] = wave_sum(el[i]) + be[i];
        float best = gl[0]; int g = 0;
#pragma unroll
        for (int i = 1; i < 8; ++i) if (gl[i] > best) { best = gl[i]; g = i; }
        float den = 0.f;
#pragma unroll
        for (int i = 0; i < 8; ++i) den += expf(gl[i] - best);
        const float gw_ = 1.f / den;
        float ev[8];
#pragma unroll
        for (int j = 0; j < 8; ++j) { float v = el[j];
#pragma unroll
            for (int q = 1; q < 8; ++q) v = (g == q) ? el[q * 8 + j] : v;
            ev[j] = v; }
        float v1 = ev[0]; int i1 = 0;
#pragma unroll
        for (int j = 1; j < 8; ++j) if (ev[j] > v1) { v1 = ev[j]; i1 = j; }
        float v2 = -INFINITY; int i2 = 0;
#pragma unroll
        for (int j = 0; j < 8; ++j) if (j != i1 && ev[j] > v2) { v2 = ev[j]; i2 = j; }
        const float ex = expf(v2 - v1), p1 = 1.f / (1.f + ex), p2 = ex * p1;
        if (lane == 0) {
            const int e1 = g * 8 + i1, e2 = g * 8 + i2;
            uint4 o; o.x = (unsigned)e1; o.y = (unsigned)e2; o.z = __float_as_uint(gw_ * p1); o.w = __float_as_uint(gw_ * p2);
            ((uint4*)tokinfo)[t] = o;
            RSTD[t] = rstd;
            atomicAdd(&ctl[CW_COUNTS + e1], 1u); atomicAdd(&ctl[CW_COUNTS + e2], 1u);
        }
    }
}
__device__ __forceinline__ void ph_offsets(unsigned* ctl) {
    unsigned off = 0, nt = 0;
    for (int e = 0; e < NEXP; ++e) {
        const unsigned c = ctl[CW_COUNTS + e]; ctl[CW_OFFS + e] = off;
        for (unsigned r = 0; r < c; r += 64) { ctl[CW_TILE_E + nt] = (unsigned)e; ctl[CW_TILE_R0 + nt] = off + r; ctl[CW_TILE_NR + nt] = (c - r) < 64u ? (c - r) : 64u; ++nt; }
        off += c;
    }
    ctl[CW_OFFS + NEXP] = off; ctl[CW_NTILES] = nt;
}
__device__ __forceinline__ void ph_scatter(int gtid, int nthr, const unsigned* tokinfo, unsigned* ctl, int* tokslot, int* slottok, float* slotgate) {
    for (int t = gtid; t < NTOK; t += nthr) {
        const uint4 ti = ((const uint4*)tokinfo)[t];
        const unsigned p0 = ctl[CW_OFFS + ti.x] + atomicAdd(&ctl[CW_CURSOR + ti.x], 1u);
        const unsigned p1 = ctl[CW_OFFS + ti.y] + atomicAdd(&ctl[CW_CURSOR + ti.y], 1u);
        slottok[p0] = t; slottok[p1] = t; slotgate[p0] = __uint_as_float(ti.z); slotgate[p1] = __uint_as_float(ti.w);
        tokslot[2 * t] = (int)p0; tokslot[2 * t + 1] = (int)p1;
    }
}
__device__ __forceinline__ void ph_moe1_vb(float* sm, int t256, bool valid, int vb, const bf16_t* XN2, const float* w_gate, const float* w_up, const unsigned* ctl, const int* slottok, bf16_t* HMID) {
    const int tile = valid ? (vb >> 3) : 0, c0 = (vb & 7) * 64;
    const int e = (int)ctl[CW_TILE_E + tile], row0 = (int)ctl[CW_TILE_R0 + tile], nr = valid ? (int)ctl[CW_TILE_NR + tile] : 0;
    const float* wgp = w_gate + (size_t)e * D * DEXP; const float* wup = w_up + (size_t)e * D * DEXP;
    auto fa = [&](int r, int k) { if (r >= nr) return make_float4(0.f, 0.f, 0.f, 0.f); const int tok = slottok[row0 + r]; return ld_bf4(XN2 + (size_t)tok * D + k); };
    auto fb = [&](int k, int c) { return *(const float4*)(wgp + (size_t)k * DEXP + c0 + c); };
    auto fb2 = [&](int k, int c) { return *(const float4*)(wup + (size_t)k * DEXP + c0 + c); };
    auto fe = [&](int r, int c, float4 a, float4 u) { if (r >= nr) return; st_bf4(HMID + (size_t)(row0 + r) * DEXP + c0 + c, make_float4(silu_f(a.x) * u.x, silu_f(a.y) * u.y, silu_f(a.z) * u.z, silu_f(a.w) * u.w)); };
    naive_tile_h<true>(sm, t256, D, fa, fb, fb2, fe);
}
__device__ __forceinline__ void ph_moe2_vb(float* sm, int t256, bool valid, int vb, const bf16_t* HMID, const float* w_down, const unsigned* ctl, const float* slotgate, bf16_t* YS) {
    const int tile = valid ? (vb >> 4) : 0, c0 = (vb & 15) * 64;
    const int e = (int)ctl[CW_TILE_E + tile], row0 = (int)ctl[CW_TILE_R0 + tile], nr = valid ? (int)ctl[CW_TILE_NR + tile] : 0;
    const float* wd = w_down + (size_t)e * DEXP * D;
    auto fa = [&](int r, int k) { if (r >= nr) return make_float4(0.f, 0.f, 0.f, 0.f); return ld_bf4(HMID + (size_t)(row0 + r) * DEXP + k); };
    auto fb = [&](int k, int c) { return *(const float4*)(wd + (size_t)k * D + c0 + c); };
    auto fe = [&](int r, int c, float4 a, float4) { if (r >= nr) return; const float g = slotgate[row0 + r]; st_bf4(YS + (size_t)(row0 + r) * D + c0 + c, make_float4(a.x * g, a.y * g, a.z * g, a.w * g)); };
    naive_tile_h<false>(sm, t256, DEXP, fa, fb, fb, fe);
}
__device__ __forceinline__ void ph_final(int gw, int NGW, int lane, const bf16_t* H, const unsigned char* YS8, const float* YSC, const int* tokslot, const float* fg, float* OUTA, float* OUTB) {
    const int sub = (lane & 31) >> 3;
    float4 g[4];
#pragma unroll
    for (int j = 0; j < 4; ++j) g[j] = ((const float4*)fg)[j * 64 + lane];
    for (int t = 2 * gw; t < NTOK; t += 2 * NGW) {
        const int4 sl = *(const int4*)(tokslot + 2 * t);
        float4 v[2][4]; float ss[2] = {0.f, 0.f};
#pragma unroll
        for (int q = 0; q < 2; ++q) {
            const int s0 = q ? sl.z : sl.x, s1 = q ? sl.w : sl.y;
            const bf16_t* hr = H + (size_t)(t + q) * D;
            const unsigned* y0 = (const unsigned*)(YS8 + (size_t)s0 * D); const unsigned* y1 = (const unsigned*)(YS8 + (size_t)s1 * D);
            const float4 a0 = *(const float4*)(YSC + (size_t)s0 * 16 + sub * 4), a1 = *(const float4*)(YSC + (size_t)s1 * 16 + sub * 4);
            const float a0j[4] = {a0.x, a0.y, a0.z, a0.w}, a1j[4] = {a1.x, a1.y, a1.z, a1.w};
#pragma unroll
            for (int j = 0; j < 4; ++j) {
                const float4 hv = ld_bf4(hr + (j * 64 + lane) * 4); const unsigned w0 = y0[j * 64 + lane], w1 = y1[j * 64 + lane];
                const float p = a0j[j], r = a1j[j], off = -128.f * (p + r);
                v[q][j] = make_float4((hv.x + off) + p * (float)(w0 & 0xffu) + r * (float)(w1 & 0xffu), (hv.y + off) + p * (float)((w0 >> 8) & 0xffu) + r * (float)((w1 >> 8) & 0xffu),
                                      (hv.z + off) + p * (float)((w0 >> 16) & 0xffu) + r * (float)((w1 >> 16) & 0xffu), (hv.w + off) + p * (float)(w0 >> 24) + r * (float)(w1 >> 24));
                ss[q] += v[q][j].x * v[q][j].x + v[q][j].y * v[q][j].y + v[q][j].z * v[q][j].z + v[q][j].w * v[q][j].w;
            }
        }
#pragma unroll
        for (int q = 0; q < 2; ++q) {
            const float rstd = rsqrtf(wave_sum(ss[q]) * (1.f / D) + EPS);
            const int tt = t + q;
            float4* orow = (float4*)((tt < NTOK / 2 ? OUTA + (size_t)tt * D : OUTB + (size_t)(tt - NTOK / 2) * D));
#pragma unroll
            for (int j = 0; j < 4; ++j) orow[j * 64 + lane] = make_float4(v[q][j].x * rstd * g[j].x, v[q][j].y * rstd * g[j].y, v[q][j].z * rstd * g[j].z, v[q][j].w * rstd * g[j].w);
        }
    }
}
__device__ __forceinline__ void ph_copy_xs(int bx, int wave, int lane, const LAS int* pos, const float* H, const float* RSTD, const float* g2, bf16_t* XS) {
    float4 g[4];
#pragma unroll
    for (int j = 0; j < 4; ++j) g[j] = ((const float4*)g2)[j * 64 + lane];
#pragma unroll 1
    for (int i = 0; i < 16; i += 2) {
        const int l0 = wave * 16 + i, l1 = l0 + 1, t0 = bx * 128 + l0, t1 = t0 + 1;
        const float r0 = RSTD[t0], r1 = RSTD[t1];
        const float4* h0 = (const float4*)(H + (size_t)t0 * D); const float4* h1 = (const float4*)(H + (size_t)t1 * D);
        float4 a[4], b[4];
#pragma unroll
        for (int j = 0; j < 4; ++j) { a[j] = h0[j * 64 + lane]; b[j] = h1[j * 64 + lane]; }
        uint2* o00 = (uint2*)(XS + (size_t)pos[2 * l0] * D); uint2* o01 = (uint2*)(XS + (size_t)pos[2 * l0 + 1] * D);
        uint2* o10 = (uint2*)(XS + (size_t)pos[2 * l1] * D); uint2* o11 = (uint2*)(XS + (size_t)pos[2 * l1 + 1] * D);
#pragma unroll
        for (int j = 0; j < 4; ++j) {
            uint2 w; w.x = (unsigned)f2bf(a[j].x * r0 * g[j].x) | ((unsigned)f2bf(a[j].y * r0 * g[j].y) << 16); w.y = (unsigned)f2bf(a[j].z * r0 * g[j].z) | ((unsigned)f2bf(a[j].w * r0 * g[j].w) << 16);
            o00[j * 64 + lane] = w; o01[j * 64 + lane] = w;
            uint2 v; v.x = (unsigned)f2bf(b[j].x * r1 * g[j].x) | ((unsigned)f2bf(b[j].y * r1 * g[j].y) << 16); v.y = (unsigned)f2bf(b[j].z * r1 * g[j].z) | ((unsigned)f2bf(b[j].w * r1 * g[j].w) << 16);
            o10[j * 64 + lane] = v; o11[j * 64 + lane] = v;
        }
    }
}

__device__ __forceinline__ void ph_copy_xs_i8(int bx, int wave, int lane, const LAS int* pos, const bf16_t* H, const float* RSTD, const float* g2, unsigned char* XS8, float* SA) {
    float4 g[4];
#pragma unroll
    for (int j = 0; j < 4; ++j) g[j] = ((const float4*)g2)[lane * 4 + j];
#pragma unroll 1
    for (int i = 0; i < 16; i += 2) {
        const int l0 = wave * 16 + i, t0 = bx * 128 + l0;
        float4 a[2][4]; float mx[2];
#pragma unroll
        for (int q = 0; q < 2; ++q) { const uint4* hp = (const uint4*)(H + (size_t)(t0 + q) * D + lane * 16); const uint4 h0 = hp[0], h1 = hp[1];
            const unsigned hw[8] = {h0.x, h0.y, h0.z, h0.w, h1.x, h1.y, h1.z, h1.w};
#pragma unroll
            for (int j = 0; j < 4; ++j) a[q][j] = make_float4(__uint_as_float(hw[2 * j] << 16), __uint_as_float(hw[2 * j] & 0xffff0000u), __uint_as_float(hw[2 * j + 1] << 16), __uint_as_float(hw[2 * j + 1] & 0xffff0000u)); }
#pragma unroll
        for (int q = 0; q < 2; ++q) { const float r = RSTD[t0 + q]; float m = 0.f;
#pragma unroll
            for (int j = 0; j < 4; ++j) { a[q][j].x *= r * g[j].x; a[q][j].y *= r * g[j].y; a[q][j].z *= r * g[j].z; a[q][j].w *= r * g[j].w;
                m = fmaxf(m, fmaxf(fmaxf(fabsf(a[q][j].x), fabsf(a[q][j].y)), fmaxf(fabsf(a[q][j].z), fabsf(a[q][j].w)))); }
#pragma unroll
            for (int o = 1; o < 64; o <<= 1) m = fmaxf(m, __shfl_xor(m, o));
            mx[q] = m; }
#pragma unroll
        for (int q = 0; q < 2; ++q) { const float inv = mx[q] > 0.f ? 127.f / mx[q] : 0.f;
            v4u w;
#pragma unroll
            for (int j = 0; j < 4; ++j) { const int ia = __float2int_rn(a[q][j].x * inv), ib = __float2int_rn(a[q][j].y * inv), ic = __float2int_rn(a[q][j].z * inv), id = __float2int_rn(a[q][j].w * inv);
                w[j] = ((unsigned)ia & 0xffu) | (((unsigned)ib & 0xffu) << 8) | (((unsigned)ic & 0xffu) << 16) | ((unsigned)id << 24); }
            const int p0 = pos[2 * (l0 + q)], p1 = pos[2 * (l0 + q) + 1];
            *(GAS v4u*)(XS8 + (size_t)p0 * D + lane * 16) = w; *(GAS v4u*)(XS8 + (size_t)p1 * D + lane * 16) = w;
            if (lane == 0) { SA[p0] = mx[q] * (1.f / 127.f); SA[p1] = mx[q] * (1.f / 127.f); } }
    }
}
constexpr size_t WS_DEC = 11 * MiB;
constexpr int LDT = 72;
constexpr int GL_QE = 0, GL_KE = 9216, GL_P = 18432, GL_VT = 27648, GL_ST = 46080, GL_TOT = 64512, GL_PART = 68608, GL_RSTD = 70656;
typedef float gf32x4 __attribute__((ext_vector_type(4)));
typedef short gbf16x8 __attribute__((ext_vector_type(8)));

__device__ __forceinline__ float exp_fast(float x) { return __builtin_amdgcn_exp2f(x * 1.4426950408889634f); }
__device__ __forceinline__ float log_sigmoid_f(float x) { return fminf(x, 0.f) - 0.6931471805599453f * __builtin_amdgcn_logf(1.f + exp_fast(-fabsf(x))); }
__device__ __forceinline__ gf32x4 mfma_tile64(const LAS bf16_t* A, const LAS bf16_t* Bt, gf32x4 acc, int lane) {
    const int r = lane & 15, kq = (lane >> 4) * 8;
    const gbf16x8 a0 = *(const LAS gbf16x8*)(A + r * LDT + kq), a1 = *(const LAS gbf16x8*)(A + r * LDT + kq + 32);
    const gbf16x8 b0 = *(const LAS gbf16x8*)(Bt + r * LDT + kq), b1 = *(const LAS gbf16x8*)(Bt + r * LDT + kq + 32);
    acc = __builtin_amdgcn_mfma_f32_16x16x32_bf16(a0, b0, acc, 0, 0, 0);
    acc = __builtin_amdgcn_mfma_f32_16x16x32_bf16(a1, b1, acc, 0, 0, 0);
    return acc;
}
template <bool BWD>
__device__ __forceinline__ void gla_cumsum(const bf16_t* zbase  , const float* up  , const float* bias, int hd  , int tg, int d, LAS float* tot, float (&bv)[8], float& bl) {
    float upc[16];
#pragma unroll
    for (int r = 0; r < 16; ++r) upc[r] = up[r * 256 + hd];
    const float bs = bias[hd];
    float c[8];
#pragma unroll
    for (int i = 0; i < 8; ++i) {
        const uint4* zp = (const uint4*)(zbase + (size_t)(8 * tg + i) * PW);
        const uint4 z0 = zp[0], z1 = zp[1];
        const unsigned zw[8] = {z0.x, z0.y, z0.z, z0.w, z1.x, z1.y, z1.z, z1.w};
        float pre = bs;
#pragma unroll
        for (int r = 0; r < 8; ++r) { pre += __uint_as_float(zw[r] << 16) * upc[2 * r]; pre += __uint_as_float(zw[r] & 0xffff0000u) * upc[2 * r + 1]; }
        c[i] = log_sigmoid_f(pre) * (1.f / 16.f);
    }
    if (!BWD) {
#pragma unroll
        for (int i = 1; i < 8; ++i) c[i] += c[i - 1];
        tot[tg * 64 + d] = c[7];
    } else {
#pragma unroll
        for (int i = 6; i >= 0; --i) c[i] += c[i + 1];
        tot[tg * 64 + d] = c[0];
    }
    __syncthreads();
    float off = 0.f, all = 0.f;
#pragma unroll
    for (int t2 = 0; t2 < 8; ++t2) { const float v = tot[t2 * 64 + d]; all += v; if (BWD ? (t2 > tg) : (t2 < tg)) off += v; }
#pragma unroll
    for (int i = 0; i < 8; ++i) bv[i] = c[i] + off;
    bl = all;
}
__device__ __forceinline__ void gla_stage_vt(const bf16_t* vbase, LAS bf16_t* VT, int tid) {
    const int s = tid & 63, e0 = (tid >> 6) * 16;
    const uint4* vp = (const uint4*)(vbase + (size_t)s * PW + e0);
    const uint4 v0 = vp[0], v1 = vp[1];
    const unsigned w[8] = {v0.x, v0.y, v0.z, v0.w, v1.x, v1.y, v1.z, v1.w};
#pragma unroll
    for (int i = 0; i < 8; ++i) { VT[(e0 + 2 * i) * LDT + s] = (bf16_t)(w[i] & 0xffffu); VT[(e0 + 2 * i + 1) * LDT + s] = (bf16_t)(w[i] >> 16); }
}
__device__ __forceinline__ void gla_g1_unit(LAS unsigned char* lds, int tid, int unit, const bf16_t* PROJ, const float* upf, const float* bf_, const float* upb, const float* bb_, bf16_t* KVS, float* DEC) {
    const int n = unit & 63, h = (unit >> 6) & 3, b = unit >> 8;
    const int d = tid & 63, tg = tid >> 6, lane = tid & 63, w = tid >> 6;
    const size_t tok0 = (size_t)b * T + n * 64;
    LAS bf16_t* KET = (LAS bf16_t*)(lds + GL_QE); LAS bf16_t* VT = (LAS bf16_t*)(lds + GL_VT); LAS float* tot = (LAS float*)(lds + GL_TOT);
    gla_stage_vt(PROJ + tok0 * PW + C_GV + h * 128, VT, tid);
#pragma unroll
    for (int dir = 0; dir < 2; ++dir) {
        float bv[8], bl;
        if (dir == 0) gla_cumsum<false>(PROJ + tok0 * PW + C_ZF, upf, bf_, h * 64 + d, tg, d, tot, bv, bl);
        else          gla_cumsum<true>(PROJ + tok0 * PW + C_ZB, upb, bb_, h * 64 + d, tg, d, tot + 512, bv, bl);
        unsigned pk[4];
#pragma unroll
        for (int i = 0; i < 8; i += 2) {
            const float k0 = bf2f(PROJ[(tok0 + 8 * tg + i) * PW + C_GK + h * 64 + d]) * exp_fast(bl - bv[i]);
            const float k1 = bf2f(PROJ[(tok0 + 8 * tg + i + 1) * PW + C_GK + h * 64 + d]) * exp_fast(bl - bv[i + 1]);
            pk[i >> 1] = (unsigned)f2bf(k0) | ((unsigned)f2bf(k1) << 16);
        }
        *(LAS v4u*)(KET + d * LDT + 8 * tg) = (v4u){pk[0], pk[1], pk[2], pk[3]};
        const size_t sq = (((size_t)b * 4 + h) * 2 + dir) * 64 + n;
        if (tg == 0) DEC[sq * 64 + d] = exp_fast(bl);
        __syncthreads();
        bf16_t* kvo = KVS + sq * 8192;
#pragma unroll
        for (int dt = 0; dt < 4; ++dt) {
            gf32x4 acc = {0.f, 0.f, 0.f, 0.f};
            acc = mfma_tile64(VT + (16 * w) * LDT, KET + (16 * dt) * LDT, acc, lane);
#pragma unroll
            for (int r = 0; r < 4; ++r) kvo[(size_t)(16 * w + 4 * (lane >> 4) + r) * 64 + 16 * dt + (lane & 15)] = f2bf(acc[r]);
        }
        __syncthreads();
    }
}
typedef unsigned g2v2u __attribute__((ext_vector_type(2)));
template <bool BWD>
__device__ __forceinline__ void gla_g2_item(g2v2u* base  , const float* dc  ) {
    float s[4] = {0.f, 0.f, 0.f, 0.f};
#pragma unroll 1
    for (int hf = 0; hf < 4; ++hf) {
        g2v2u kv[16]; f32x4 dd[16];
#pragma unroll
        for (int st = 0; st < 16; ++st) { const int n = BWD ? (63 - 16 * hf - st) : (16 * hf + st); kv[st] = base[(size_t)n * 2048]; dd[st] = *(const f32x4*)(dc + n * 64); }
#pragma unroll
        for (int st = 0; st < 16; ++st) { const int n = BWD ? (63 - 16 * hf - st) : (16 * hf + st);
            base[(size_t)n * 2048] = (g2v2u){(unsigned)f2bf(s[0]) | ((unsigned)f2bf(s[1]) << 16), (unsigned)f2bf(s[2]) | ((unsigned)f2bf(s[3]) << 16)};
            s[0] = dd[st][0] * s[0] + __uint_as_float(kv[st][0] << 16); s[1] = dd[st][1] * s[1] + __uint_as_float(kv[st][0] & 0xffff0000u);
            s[2] = dd[st][2] * s[2] + __uint_as_float(kv[st][1] << 16); s[3] = dd[st][3] * s[3] + __uint_as_float(kv[st][1] & 0xffff0000u); }
    }
}
__device__ __forceinline__ void gla_g2_scan(int gtid, int nthr, bf16_t* KVS, const float* DEC) {
    for (int item = gtid; item < 64 * 2048; item += nthr) {
        const int seq = item >> 11, q4 = item & 2047, d4 = (q4 & 15) * 4;
        g2v2u* base = (g2v2u*)(KVS + (size_t)seq * 64 * 8192) + q4;
        const float* dc = DEC + (size_t)seq * 64 * 64 + d4;
        if (seq & 1) gla_g2_item<true>(base, dc); else gla_g2_item<false>(base, dc);
    }
}
__device__ __forceinline__ void gla_g3_unit(LAS unsigned char* lds, int tid, int unit, const bf16_t* PROJ, const float* upf, const float* bf_, const float* upb, const float* bb_, const bf16_t* KVS, const float* gain, bf16_t* MIXED) {
    const int n = unit & 63, h = (unit >> 6) & 3, b = unit >> 8;
    const int d = tid & 63, tg = tid >> 6, lane = tid & 63, w = tid >> 6;
    const size_t tok0 = (size_t)b * T + n * 64;
    LAS bf16_t* QE = (LAS bf16_t*)(lds + GL_QE); LAS bf16_t* KE = (LAS bf16_t*)(lds + GL_KE); LAS bf16_t* PP = (LAS bf16_t*)(lds + GL_P);
    LAS bf16_t* VT = (LAS bf16_t*)(lds + GL_VT); LAS bf16_t* ST = (LAS bf16_t*)(lds + GL_ST);
    LAS float* tot = (LAS float*)(lds + GL_TOT); LAS float* part = (LAS float*)(lds + GL_PART); LAS float* rs = (LAS float*)(lds + GL_RSTD);
    gla_stage_vt(PROJ + tok0 * PW + C_GV + h * 128, VT, tid);
    gf32x4 o[4];
#pragma unroll
    for (int rt = 0; rt < 4; ++rt) o[rt] = (gf32x4){0.f, 0.f, 0.f, 0.f};
#pragma unroll
    for (int dir = 0; dir < 2; ++dir) {
        float bv[8], bl;
        if (dir == 0) gla_cumsum<false>(PROJ + tok0 * PW + C_ZF, upf, bf_, h * 64 + d, tg, d, tot, bv, bl);
        else          gla_cumsum<true>(PROJ + tok0 * PW + C_ZB, upb, bb_, h * 64 + d, tg, d, tot + 512, bv, bl);
#pragma unroll
        for (int i = 0; i < 8; ++i) {
            const size_t ro = (tok0 + 8 * tg + i) * PW + h * 64 + d;
            const float e = exp_fast(bv[i]);
            QE[(8 * tg + i) * LDT + d] = f2bf(bf2f(PROJ[ro + C_GQ]) * e * 0.125f);
            KE[(8 * tg + i) * LDT + d] = f2bf(bf2f(PROJ[ro + C_GK]) * __builtin_amdgcn_rcpf(e));
        }
        {
            const size_t sq = (((size_t)b * 4 + h) * 2 + dir) * 64 + n;
            const int e = tid >> 2, part4 = tid & 3;
            const uint4* sp = (const uint4*)(KVS + sq * 8192 + e * 64 + part4 * 16);
            const uint4 s0 = sp[0], s1 = sp[1];
            *(LAS v4u*)(ST + e * LDT + part4 * 16) = (v4u){s0.x, s0.y, s0.z, s0.w}; *(LAS v4u*)(ST + e * LDT + part4 * 16 + 8) = (v4u){s1.x, s1.y, s1.z, s1.w};
        }
        __syncthreads();
        { const int ct = w >> 1;
#pragma unroll
          for (int j = 0; j < 2; ++j) { const int st = 2 * (w & 1) + j;
            gf32x4 acc = {0.f, 0.f, 0.f, 0.f};
            acc = mfma_tile64(QE + (16 * ct) * LDT, KE + (16 * st) * LDT, acc, lane);
            const int s = 16 * st + (lane & 15);
#pragma unroll
            for (int r = 0; r < 4; ++r) { const int c = 16 * ct + 4 * (lane >> 4) + r; const bool keep = dir ? (s >= c) : (s <= c);
                PP[c * LDT + s] = f2bf(keep ? acc[r] : 0.f); } } }
        __syncthreads();
#pragma unroll
        for (int rt = 0; rt < 4; ++rt) {
            o[rt] = mfma_tile64(PP + (16 * rt) * LDT, VT + (16 * w) * LDT, o[rt], lane);
            o[rt] = mfma_tile64(QE + (16 * rt) * LDT, ST + (16 * w) * LDT, o[rt], lane);
        }
        __syncthreads();
    }
#pragma unroll
    for (int rt = 0; rt < 4; ++rt)
#pragma unroll
        for (int r = 0; r < 4; ++r) {
            float ss = o[rt][r] * o[rt][r];
            ss += __shfl_xor(ss, 1); ss += __shfl_xor(ss, 2); ss += __shfl_xor(ss, 4); ss += __shfl_xor(ss, 8);
            if ((lane & 15) == 0) part[w * 64 + 16 * rt + 4 * (lane >> 4) + r] = ss;
        }
    __syncthreads();
    if (tid < 64) { float ss = 0.f;
#pragma unroll
        for (int t2 = 0; t2 < 8; ++t2) ss += part[t2 * 64 + tid];
        rs[tid] = rsqrtf(ss * (1.f / 128.f) + EPS); }
    __syncthreads();
    { const int e = 16 * w + (lane & 15); const float ge = gain[e];
#pragma unroll
      for (int rt = 0; rt < 4; ++rt)
#pragma unroll
        for (int r = 0; r < 4; ++r) { const int c = 16 * rt + 4 * (lane >> 4) + r;
            const float g = bf2f(PROJ[(tok0 + c) * PW + C_GG + h * 128 + e]);
            MIXED[(tok0 + c) * D + h * 128 + e] = f2bf(o[rt][r] * rs[c] * ge * g * __builtin_amdgcn_rcpf(1.f + exp_fast(-g))); } }
    __syncthreads();
}

constexpr size_t WS_BFRAG = 12 * MiB;
__device__ __forceinline__ void router_build_bfrag(int gtid, int nthr, const float* wg, const float* we, const float* g2, bf16_t* BF) {
    for (int i = gtid; i < 32 * 5 * 64; i += nthr) {
        const int ks = i / 320, rem = i - ks * 320, ct = rem >> 6, lane = rem & 63, col = 16 * ct + (lane & 15);
        unsigned hi[4], lo[4];
#pragma unroll
        for (int j = 0; j < 8; ++j) {
            const int k = 32 * ks + 8 * (lane >> 4) + j;
            float w = col < 8 ? wg[k * 8 + col] : (col < 72 ? we[k * 64 + col - 8] : 0.f);
            w *= g2[k];
            const bf16_t h = f2bf(w); const bf16_t l = f2bf(w - bf2f(h));
            if (j & 1) { hi[j >> 1] |= (unsigned)h << 16; lo[j >> 1] |= (unsigned)l << 16; } else { hi[j >> 1] = h; lo[j >> 1] = l; }
        }
        uint4* o = (uint4*)(BF + ((size_t)(ks * 5 + ct) * 2) * 512 + lane * 8);
        o[0] = make_uint4(hi[0], hi[1], hi[2], hi[3]); o[64] = make_uint4(lo[0], lo[1], lo[2], lo[3]);
    }
}
__device__ __forceinline__ void ph_router_mfma(int gw, int NGW, int lane, LAS float* lsm  , const bf16_t* H, const bf16_t* BF, const float* bg, const float* be, float* RSTD, unsigned* tokinfo, LAS int* hist, bool dry) {
    for (int task = gw; task < NTOK / 16; task += NGW) {
        const int t0 = task * 16, row = lane & 15, kg = lane >> 4;
        const bf16_t* hp = H + (size_t)(t0 + row) * D + kg * 8;
        gf32x4 acc[5];
#pragma unroll
        for (int ct = 0; ct < 5; ++ct) acc[ct] = (gf32x4){0.f, 0.f, 0.f, 0.f};
        float ss = 0.f;
#pragma unroll 2
        for (int ks = 0; ks < 32; ++ks) {
            const gbf16x8 ah = *(const gbf16x8*)(hp + ks * 32);
#pragma unroll
            for (int j = 0; j < 8; ++j) { const float xv = bf2f((bf16_t)ah[j]); ss += xv * xv; }
            const gbf16x8* bp = (const gbf16x8*)(BF + (size_t)ks * 5 * 2 * 512) + lane;
#pragma unroll
            for (int ct = 0; ct < 5; ++ct) {
                const gbf16x8 bh = bp[(ct * 2) * 64], bl = bp[(ct * 2 + 1) * 64];
                acc[ct] = __builtin_amdgcn_mfma_f32_16x16x32_bf16(ah, bh, acc[ct], 0, 0, 0);
                acc[ct] = __builtin_amdgcn_mfma_f32_16x16x32_bf16(ah, bl, acc[ct], 0, 0, 0);
            }
        }
        ss += __shfl_xor(ss, 16); ss += __shfl_xor(ss, 32);
        const float rstd = rsqrtf(ss * (1.f / D) + EPS);
#pragma unroll
        for (int ct = 0; ct < 5; ++ct) { const int col = 16 * ct + row; const float bias = col < 8 ? bg[col] : (col < 72 ? be[col - 8] : 0.f);
#pragma unroll
            for (int r = 0; r < 4; ++r) { const int rr = 4 * kg + r; const float rs = __shfl(rstd, rr); lsm[rr * 80 + col] = acc[ct][r] * rs + bias; } }
        asm volatile("s_waitcnt lgkmcnt(0)" ::: "memory");
        if (lane < 16) {
            const LAS float* L = lsm + lane * 80;
            float best = L[0]; int g = 0;
#pragma unroll
            for (int i = 1; i < 8; ++i) { const float v = L[i]; if (v > best) { best = v; g = i; } }
            float den = 0.f;
#pragma unroll
            for (int i = 0; i < 8; ++i) den += expf(L[i] - best);
            const float gw_ = 1.f / den;
            const LAS float* E = L + 8 + g * 8;
            float v1 = E[0]; int i1 = 0;
#pragma unroll
            for (int j = 1; j < 8; ++j) { const float v = E[j]; if (v > v1) { v1 = v; i1 = j; } }
            float v2 = -INFINITY; int i2 = 0;
#pragma unroll
            for (int j = 0; j < 8; ++j) { const float v = E[j]; if (j != i1 && v > v2) { v2 = v; i2 = j; } }
            const float ex = expf(v2 - v1), p1 = 1.f / (1.f + ex), p2 = ex * p1;
            const int e1 = g * 8 + i1, e2 = g * 8 + i2, t = t0 + lane;
            uint4 o; o.x = (unsigned)e1; o.y = (unsigned)e2; o.z = __float_as_uint(gw_ * p1); o.w = __float_as_uint(gw_ * p2);
            ((uint4*)tokinfo)[t] = o;
            RSTD[t] = rstd;
            if (!dry) { __hip_atomic_fetch_add(hist + e1, 1, __ATOMIC_RELAXED, __HIP_MEMORY_SCOPE_WORKGROUP); __hip_atomic_fetch_add(hist + e2, 1, __ATOMIC_RELAXED, __HIP_MEMORY_SCOPE_WORKGROUP); }
        }
        asm volatile("s_waitcnt lgkmcnt(0)" ::: "memory");
    }
}

__device__ __forceinline__ unsigned pk4_i8r(float a, float b, float c, float d) { const int ia = __float2int_rn(a), ib = __float2int_rn(b), ic = __float2int_rn(c), id = __float2int_rn(d); return ((unsigned)ia & 0xffu) | (((unsigned)ib & 0xffu) << 8) | (((unsigned)ic & 0xffu) << 16) | ((unsigned)id << 24); }
__device__ __forceinline__ void ph_router_lds(int vcu, int G, int wave, int lane, LAS unsigned char* lds, const bf16_t* H, const bf16_t* BF, const float* bg, const float* be, float* RSTD, unsigned* tokinfo, LAS int* hist, bool dry, const float* g2, unsigned char* XN8, float* SAT) {
    float4 gq[4];
#pragma unroll
    for (int j = 0; j < 4; ++j) gq[j] = ((const float4*)g2)[j * 64 + lane];
    for (int tg = vcu; tg < NTOK / 128; tg += G) {
        const int t0 = (tg * 8 + wave) * 16, row = lane & 15, kg = lane >> 4;
        const bf16_t* hp = H + (size_t)(t0 + row) * D + kg * 8;
        gf32x4 acc[5];
#pragma unroll
        for (int ct = 0; ct < 5; ++ct) acc[ct] = (gf32x4){0.f, 0.f, 0.f, 0.f};
        float ss = 0.f;
        gbf16x8 ha[2][4];
#define RT_DMA(j) do { _Pragma("unroll") for (int i = 0; i < 5; ++i) __builtin_amdgcn_global_load_lds((const unsigned*)(BF + (size_t)(j) * 20480 + (wave + 8 * i) * 512 + lane * 8), \
            (LAS unsigned*)(lds + ((j) & 1) * 65536 + (wave + 8 * i) * 1024), 16, 0, 0); } while (0)
#define RT_LDH(j) do { _Pragma("unroll") for (int k = 0; k < 4; ++k) ha[(j) & 1][k] = *(const GAS gbf16x8*)(hp + ((j) * 4 + k) * 32); } while (0)
        RT_DMA(0); RT_LDH(0);
#pragma unroll
        for (int j = 0; j < 8; ++j) {
            if (j + 1 < 8) { RT_DMA(j + 1); RT_LDH(j + 1); asm volatile("s_waitcnt vmcnt(9)" ::: "memory"); } else asm volatile("s_waitcnt vmcnt(0)" ::: "memory");
            __syncthreads();
            const LAS unsigned char* buf = lds + (j & 1) * 65536;
#pragma unroll
            for (int k = 0; k < 4; ++k) {
                const gbf16x8 ah = ha[j & 1][k];
#pragma unroll
                for (int e = 0; e < 8; ++e) { const float xv = bf2f((bf16_t)ah[e]); ss += xv * xv; }
#pragma unroll
                for (int ct = 0; ct < 5; ++ct) {
                    const gbf16x8 bh = *(const LAS gbf16x8*)(buf + ((k * 10 + ct * 2) * 64 + lane) * 16), bl = *(const LAS gbf16x8*)(buf + ((k * 10 + ct * 2 + 1) * 64 + lane) * 16);
                    acc[ct] = __builtin_amdgcn_mfma_f32_16x16x32_bf16(ah, bh, acc[ct], 0, 0, 0);
                    acc[ct] = __builtin_amdgcn_mfma_f32_16x16x32_bf16(ah, bl, acc[ct], 0, 0, 0);
                }
            }
            __syncthreads();
        }
#undef RT_DMA
#undef RT_LDH
        LAS float* lsm = (LAS float*)(lds + wave * 5120);
        ss += __shfl_xor(ss, 16); ss += __shfl_xor(ss, 32);
        const float rstd = rsqrtf(ss * (1.f / D) + EPS);
        if (!dry) {
#pragma unroll 2
            for (int r = 0; r < 16; ++r) {
                const float rs_ = __shfl(rstd, r); const bf16_t* hr = H + (size_t)(t0 + r) * D;
                float4 a[4]; float m = 0.f;
#pragma unroll
                for (int j = 0; j < 4; ++j) { a[j] = ld_bf4(hr + (j * 64 + lane) * 4); a[j].x *= rs_ * gq[j].x; a[j].y *= rs_ * gq[j].y; a[j].z *= rs_ * gq[j].z; a[j].w *= rs_ * gq[j].w;
                    m = fmaxf(m, fmaxf(fmaxf(fabsf(a[j].x), fabsf(a[j].y)), fmaxf(fabsf(a[j].z), fabsf(a[j].w)))); }
#pragma unroll
                for (int o = 1; o < 64; o <<= 1) m = fmaxf(m, __shfl_xor(m, o));
                const float inv = m > 0.f ? 127.f / m : 0.f;
                unsigned w4[4], x4[4], y4[4];
#pragma unroll
                for (int j = 0; j < 4; ++j) w4[j] = pk4_i8r(a[j].x * inv, a[j].y * inv, a[j].z * inv, a[j].w * inv);
                const bool b0 = lane & 1, b1 = lane & 2;
#pragma unroll
                for (int p2 = 0; p2 < 2; ++p2) { const unsigned snd = b0 ? w4[2 * p2] : w4[2 * p2 + 1]; const unsigned rcv = (unsigned)__shfl_xor((int)snd, 1);
                    x4[2 * p2] = b0 ? rcv : w4[2 * p2]; x4[2 * p2 + 1] = b0 ? w4[2 * p2 + 1] : rcv; }
#pragma unroll
                for (int i = 0; i < 2; ++i) { const unsigned snd = b1 ? x4[i] : x4[2 + i]; const unsigned rcv = (unsigned)__shfl_xor((int)snd, 2);
                    y4[i] = b1 ? rcv : x4[i]; y4[2 + i] = b1 ? x4[2 + i] : rcv; }
                *(GAS v4u*)(XN8 + (size_t)(t0 + r) * D + (lane & 3) * 256 + (lane >> 2) * 16) = (v4u){y4[0], y4[1], y4[2], y4[3]};
                if (lane == 0) SAT[t0 + r] = m * (1.f / 127.f);
            }
        }
#pragma unroll
        for (int ct = 0; ct < 5; ++ct) { const int col = 16 * ct + row; const float bias = col < 8 ? bg[col] : (col < 72 ? be[col - 8] : 0.f);
#pragma unroll
            for (int r = 0; r < 4; ++r) { const int rr = 4 * kg + r; const float rs = __shfl(rstd, rr); lsm[rr * 80 + col] = acc[ct][r] * rs + bias; } }
        asm volatile("s_waitcnt lgkmcnt(0)" ::: "memory");
        if (lane < 16) {
            const LAS float* L = lsm + lane * 80;
            float best = L[0]; int g = 0;
#pragma unroll
            for (int i = 1; i < 8; ++i) { const float v = L[i]; if (v > best) { best = v; g = i; } }
            float den = 0.f;
#pragma unroll
            for (int i = 0; i < 8; ++i) den += expf(L[i] - best);
            const float gw_ = 1.f / den;
            const LAS float* E = L + 8 + g * 8;
            float v1 = E[0]; int i1 = 0;
#pragma unroll
            for (int j = 1; j < 8; ++j) { const float v = E[j]; if (v > v1) { v1 = v; i1 = j; } }
            float v2 = -INFINITY; int i2 = 0;
#pragma unroll
            for (int j = 0; j < 8; ++j) { const float v = E[j]; if (j != i1 && v > v2) { v2 = v; i2 = j; } }
            const float ex = expf(v2 - v1), p1 = 1.f / (1.f + ex), p2 = ex * p1;
            const int e1 = g * 8 + i1, e2 = g * 8 + i2, t = t0 + lane;
            uint4 o; o.x = (unsigned)e1; o.y = (unsigned)e2; o.z = __float_as_uint(gw_ * p1); o.w = __float_as_uint(gw_ * p2);
            ((uint4*)tokinfo)[t] = o;
            RSTD[t] = rstd;
            if (!dry) { __hip_atomic_fetch_add(hist + e1, 1, __ATOMIC_RELAXED, __HIP_MEMORY_SCOPE_WORKGROUP); __hip_atomic_fetch_add(hist + e2, 1, __ATOMIC_RELAXED, __HIP_MEMORY_SCOPE_WORKGROUP); }
        }
        asm volatile("s_waitcnt lgkmcnt(0)" ::: "memory");
        __syncthreads();
    }
}

constexpr int G_Z = 0, G_VT = 8192, G_G = 26624, G_ST0 = 43008, G_ST1 = 61440, G_BM = 79872, G_QE = 97280, G_KE = 106496, G_P = 115712, G_TOT = 124928, G_PART = 129024;
constexpr int BMS = 68;
typedef unsigned v2u __attribute__((ext_vector_type(2)));
struct GlaRaw3 { v4u q, k, z, v0, v1, g0, g1, sa0, sa1, sb0, sb1, oa0, oa1; float sq; };
struct GlaRaw1 { v4u k, z, v0, v1; };
__device__ __forceinline__ v4u ld16(const bf16_t* p) { return *(const GAS v4u*)p; }
__device__ __forceinline__ void gla_load3(GlaRaw3& R, int tid, int b, int h, int n, const bf16_t* PROJ, const bf16_t* KVS, const bf16_t* MIXED, const float* SSQ) {
    const size_t tok0 = (size_t)b * T + n * 64;
    const int s8 = tid >> 3, c8 = tid & 7, lane = tid & 63, w = tid >> 6;
    R.q = ld16(PROJ + (tok0 + s8) * PW + C_GQ + h * 64 + c8 * 8);
    R.k = ld16(PROJ + (tok0 + s8) * PW + C_GK + h * 64 + c8 * 8);
    if (tid < 256) R.z = ld16(PROJ + (tok0 + (tid >> 2)) * PW + C_ZF + (tid & 3) * 8);
    R.v0 = ld16(PROJ + (tok0 + (tid >> 4)) * PW + C_GV + h * 128 + (tid & 15) * 8); R.v1 = ld16(PROJ + (tok0 + (tid >> 4) + 32) * PW + C_GV + h * 128 + (tid & 15) * 8);
    const int s16 = tid >> 4, c16 = tid & 15;
    R.g0 = ld16(PROJ + (tok0 + s16) * PW + C_GG + h * 128 + c16 * 8); R.g1 = ld16(PROJ + (tok0 + s16 + 32) * PW + C_GG + h * 128 + c16 * 8);
    const size_t sq = (((size_t)b * 4 + h) * 2) * 64 + n;
    const bf16_t* sp = KVS + sq * 8192 + (tid >> 3) * 64 + (tid & 7) * 8;
    R.sa0 = ld16(sp); R.sa1 = ld16(sp + 64 * 64); R.sb0 = ld16(sp + (size_t)64 * 8192); R.sb1 = ld16(sp + (size_t)64 * 8192 + 64 * 64);
    R.sq = SSQ[(size_t)(tid >> 6) * NTOK + tok0 + (tid & 63)];
}
__device__ __forceinline__ void gla_store_z(LAS unsigned char* lds, int tid, v4u z) {
    if (tid < 256) { LAS f32x4* zp = (LAS f32x4*)(lds + G_Z) + (tid >> 2) * 8 + (tid & 3) * 2;
        zp[0] = (f32x4){__uint_as_float(z.x << 16), __uint_as_float(z.x & 0xffff0000u), __uint_as_float(z.y << 16), __uint_as_float(z.y & 0xffff0000u)};
        zp[1] = (f32x4){__uint_as_float(z.z << 16), __uint_as_float(z.z & 0xffff0000u), __uint_as_float(z.w << 16), __uint_as_float(z.w & 0xffff0000u)}; }
}
__device__ __forceinline__ void gla_store_vt(LAS unsigned char* lds, int tid, v4u v0, v4u v1) {
    LAS bf16_t* VT = (LAS bf16_t*)(lds + G_VT); const int c16 = tid & 15, sA = (tid >> 4) ^ (8 * (c16 & 7)), sB = sA ^ 32;
    const unsigned wa[4] = {v0.x, v0.y, v0.z, v0.w}, wb[4] = {v1.x, v1.y, v1.z, v1.w};
#pragma unroll
    for (int i = 0; i < 4; ++i) { LAS bf16_t* r0 = VT + (c16 * 8 + 2 * i) * LDT; LAS bf16_t* r1 = r0 + LDT;
        r0[sA] = (bf16_t)(wa[i] & 0xffffu); r1[sA] = (bf16_t)(wa[i] >> 16); r0[sB] = (bf16_t)(wb[i] & 0xffffu); r1[sB] = (bf16_t)(wb[i] >> 16); }
}
template <bool VA>
__device__ __forceinline__ gf32x4 mfma_tile64_v(const LAS bf16_t* X, const LAS bf16_t* VTw, int w, gf32x4 acc, int lane) {
    const int r = lane & 15, grp = lane >> 4, g = (2 * w + (r >> 3)) & 7;
    const gbf16x8 x0 = *(const LAS gbf16x8*)(X + r * LDT + grp * 8), x1 = *(const LAS gbf16x8*)(X + r * LDT + grp * 8 + 32);
    const gbf16x8 v0 = *(const LAS gbf16x8*)(VTw + r * LDT + ((grp ^ g) * 8)), v1 = *(const LAS gbf16x8*)(VTw + r * LDT + (((grp + 4) ^ g) * 8));
    if (VA) { acc = __builtin_amdgcn_mfma_f32_16x16x32_bf16(v0, x0, acc, 0, 0, 0); acc = __builtin_amdgcn_mfma_f32_16x16x32_bf16(v1, x1, acc, 0, 0, 0); }
    else    { acc = __builtin_amdgcn_mfma_f32_16x16x32_bf16(x0, v0, acc, 0, 0, 0); acc = __builtin_amdgcn_mfma_f32_16x16x32_bf16(x1, v1, acc, 0, 0, 0); }
    return acc;
}
constexpr int ZBS = 40, GL_UPT = 132096;
template <int DIR>
__device__ __forceinline__ void gla_cumsum3(LAS unsigned char* lds, float bias, int w, int lane, float (&bv)[2][4], float& bl) {
    const LAS bf16_t* ZB = (const LAS bf16_t*)(lds + G_Z); const LAS bf16_t* UPT = (const LAS bf16_t*)(lds + GL_UPT) + DIR * 64 * ZBS; LAS float* tot = (LAS float*)(lds + G_TOT);
    const int r16 = lane & 15, kg = lane >> 4, dcol = 16 * (w & 3) + r16, run0 = 8 * (w >> 2) + kg;
    const gbf16x8 bfr = *(const LAS gbf16x8*)(UPT + (16 * (w & 3) + r16) * ZBS + 8 * kg);
    float c[2][4];
#pragma unroll
    for (int j = 0; j < 2; ++j) {
        const gbf16x8 afr = *(const LAS gbf16x8*)(ZB + (32 * (w >> 2) + 16 * j + r16) * ZBS + 8 * kg);
        const gf32x4 acc = __builtin_amdgcn_mfma_f32_16x16x32_bf16(afr, bfr, (gf32x4){0.f, 0.f, 0.f, 0.f}, 0, 0, 0);
#pragma unroll
        for (int r = 0; r < 4; ++r) c[j][r] = log_sigmoid_f(acc[r] + bias) * (1.f / 16.f);
        if (DIR == 0) { c[j][1] += c[j][0]; c[j][2] += c[j][1]; c[j][3] += c[j][2]; tot[(run0 + 4 * j) * 64 + dcol] = c[j][3]; }
        else          { c[j][2] += c[j][3]; c[j][1] += c[j][2]; c[j][0] += c[j][1]; tot[(run0 + 4 * j) * 64 + dcol] = c[j][0]; }
    }
    __syncthreads();
    float off0 = 0.f, off1 = 0.f, all = 0.f;
#pragma unroll
    for (int q = 0; q < 16; ++q) { const float v = tot[q * 64 + dcol]; all += v;
        if (DIR ? (q > run0) : (q < run0)) off0 += v;
        if (DIR ? (q > run0 + 4) : (q < run0 + 4)) off1 += v; }
#pragma unroll
    for (int r = 0; r < 4; ++r) { bv[0][r] = c[0][r] + off0; bv[1][r] = c[1][r] + off1; }
    bl = all;
}
__device__ __forceinline__ void gla_store_zb(LAS unsigned char* lds, int tid, v4u z) { if (tid < 256) *(LAS v4u*)((LAS bf16_t*)(lds + G_Z) + (tid >> 2) * ZBS + (tid & 3) * 8) = z; }
__device__ __forceinline__ void gla_build_upt(LAS unsigned char* lds, int tid, int h, const float* upf, const float* upb) {
    LAS bf16_t* U0 = (LAS bf16_t*)(lds + GL_UPT); LAS bf16_t* U1 = U0 + 64 * ZBS;
    const int d = tid & 63, k0 = (tid >> 6) * 4;
    unsigned a0 = 0u, a1 = 0u, b0 = 0u, b1 = 0u;
    if (k0 < 16) { const float* p = upf + k0 * 256 + h * 64 + d; a0 = (unsigned)f2bf(p[0]) | ((unsigned)f2bf(p[256]) << 16); a1 = (unsigned)f2bf(p[512]) | ((unsigned)f2bf(p[768]) << 16); }
    else { const float* p = upb + (k0 - 16) * 256 + h * 64 + d; b0 = (unsigned)f2bf(p[0]) | ((unsigned)f2bf(p[256]) << 16); b1 = (unsigned)f2bf(p[512]) | ((unsigned)f2bf(p[768]) << 16); }
    *(LAS v2u*)(U0 + d * ZBS + k0) = (v2u){a0, a1}; *(LAS v2u*)(U1 + d * ZBS + k0) = (v2u){b0, b1};
}
__device__ __forceinline__ unsigned pk_bf2(float a, float b) { return (unsigned)f2bf(a) | ((unsigned)f2bf(b) << 16); }

__device__ __forceinline__ void gla_g3_phase(LAS unsigned char* lds, int tid, int bx, const bf16_t* PROJ, const float* upf, const float* bf_, const float* upb, const float* bb_, const bf16_t* KVS, const float* gain, bf16_t* MIXED, const float* SSQ, float* ratt) {
    const int n = bx & 63, h = (bx >> 6) & 3;
    const int d = tid & 63, tg = tid >> 6, lane = tid & 63, w = tid >> 6, s8 = tid >> 3, c8 = tid & 7;
    const int dcol = 16 * (w & 3) + (lane & 15), tk0 = 32 * (w >> 2) + 4 * (lane >> 4);
    const float bsF = bf_[h * 64 + dcol], bsB = bb_[h * 64 + dcol];
    gla_build_upt(lds, tid, h, upf, upb);
    float ge4[4];
#pragma unroll
    for (int r = 0; r < 4; ++r) ge4[r] = gain[16 * w + 4 * (lane >> 4) + r];
    LAS bf16_t* QE = (LAS bf16_t*)(lds + G_QE); LAS bf16_t* KE = (LAS bf16_t*)(lds + G_KE); LAS bf16_t* PP = (LAS bf16_t*)(lds + G_P);
    LAS bf16_t* VT = (LAS bf16_t*)(lds + G_VT); LAS bf16_t* GG = (LAS bf16_t*)(lds + G_G); LAS float* BM = (LAS float*)(lds + G_BM);
    LAS float* part = (LAS float*)(lds + G_PART); LAS float* rs = (LAS float*)(lds + G_TOT);
    GlaRaw3 R; gla_load3(R, tid, 0, h, n, PROJ, KVS, MIXED, SSQ);
    for (int b = 0; b < NB; ++b) {
        const size_t tok0 = (size_t)b * T + n * 64;
        const v4u cq = R.q, ck = R.k;
        gla_store_zb(lds, tid, R.z); gla_store_vt(lds, tid, R.v0, R.v1);
        { const int s16 = tid >> 4, c16 = tid & 15; *(LAS v4u*)(GG + s16 * 128 + c16 * 8) = R.g0; *(LAS v4u*)(GG + (s16 + 32) * 128 + c16 * 8) = R.g1; }
        { const int e = tid >> 3, c8_ = tid & 7; LAS bf16_t* s0 = (LAS bf16_t*)(lds + G_ST0) + e * LDT + c8_ * 8; LAS bf16_t* s1 = (LAS bf16_t*)(lds + G_ST1) + e * LDT + c8_ * 8;
          *(LAS v4u*)s0 = R.sa0; *(LAS v4u*)(s0 + 64 * LDT) = R.sa1; *(LAS v4u*)s1 = R.sb0; *(LAS v4u*)(s1 + 64 * LDT) = R.sb1; }
        part[tid] = R.sq;
        if (b + 1 < NB) gla_load3(R, tid, b + 1, h, n, PROJ, KVS, MIXED, SSQ);
        __syncthreads();
        if (tid < 64) { float q = 0.f;
#pragma unroll
            for (int hh = 0; hh < 8; ++hh) q += part[hh * 64 + tid];
            const float ms = q * (1.f / 512.f) + EPS; ((LAS float*)(lds + 143360))[tid] = sqrtf(ms); if (h == 0) ratt[tok0 + tid] = rsqrtf(ms); }
        gf32x4 o[4];
#pragma unroll
        for (int rt = 0; rt < 4; ++rt) o[rt] = (gf32x4){0.f, 0.f, 0.f, 0.f};
#pragma unroll
        for (int dir = 0; dir < 2; ++dir) {
            float bv[2][4], bl;
            if (dir == 0) gla_cumsum3<0>(lds, bsF, w, lane, bv, bl); else gla_cumsum3<1>(lds, bsB, w, lane, bv, bl);
#pragma unroll
            for (int j = 0; j < 2; ++j)
#pragma unroll
                for (int r = 0; r < 4; ++r) BM[(tk0 + 16 * j + r) * BMS + dcol] = bv[j][r];
            __syncthreads();
            {
                const f32x4 b0 = *(const LAS f32x4*)(BM + s8 * BMS + c8 * 8), b1 = *(const LAS f32x4*)(BM + s8 * BMS + c8 * 8 + 4);
                const float bb[8] = {b0.x, b0.y, b0.z, b0.w, b1.x, b1.y, b1.z, b1.w};
                const unsigned qw[4] = {cq.x, cq.y, cq.z, cq.w}, kw[4] = {ck.x, ck.y, ck.z, ck.w};
                unsigned qo[4], ko[4];
#pragma unroll
                for (int j = 0; j < 4; ++j) {
                    const float e0 = exp_fast(bb[2 * j]), e1 = exp_fast(bb[2 * j + 1]);
                    qo[j] = pk_bf2(__uint_as_float(qw[j] << 16) * e0 * 0.125f, __uint_as_float(qw[j] & 0xffff0000u) * e1 * 0.125f);
                    ko[j] = pk_bf2(__uint_as_float(kw[j] << 16) * __builtin_amdgcn_rcpf(e0), __uint_as_float(kw[j] & 0xffff0000u) * __builtin_amdgcn_rcpf(e1));
                }
                *(LAS v4u*)(QE + s8 * LDT + c8 * 8) = (v4u){qo[0], qo[1], qo[2], qo[3]}; *(LAS v4u*)(KE + s8 * LDT + c8 * 8) = (v4u){ko[0], ko[1], ko[2], ko[3]};
            }
            __syncthreads();
            { const int ct = w >> 1;
#pragma unroll
              for (int j = 0; j < 2; ++j) { const int st = 2 * (w & 1) + j;
                gf32x4 acc = {0.f, 0.f, 0.f, 0.f};
                acc = mfma_tile64(KE + (16 * st) * LDT, QE + (16 * ct) * LDT, acc, lane);
                const int c = 16 * ct + (lane & 15), s0 = 16 * st + 4 * (lane >> 4);
                float pv[4];
#pragma unroll
                for (int r = 0; r < 4; ++r) { const int s = s0 + r; const bool keep = dir ? (s >= c) : (s <= c); pv[r] = keep ? acc[r] : 0.f; }
                *(LAS v2u*)(PP + c * LDT + s0) = (v2u){pk_bf2(pv[0], pv[1]), pk_bf2(pv[2], pv[3])}; } }
            __syncthreads();
            const LAS bf16_t* ST = (const LAS bf16_t*)(lds + (dir ? G_ST1 : G_ST0));
#pragma unroll
            for (int rt = 0; rt < 4; ++rt) {
                o[rt] = mfma_tile64_v<true>(PP + (16 * rt) * LDT, VT + (16 * w) * LDT, w, o[rt], lane);
                o[rt] = mfma_tile64(ST + (16 * w) * LDT, QE + (16 * rt) * LDT, o[rt], lane);
            }
        }
#pragma unroll
        for (int rt = 0; rt < 4; ++rt) {
            float ss = o[rt][0] * o[rt][0] + o[rt][1] * o[rt][1] + o[rt][2] * o[rt][2] + o[rt][3] * o[rt][3];
            ss += __shfl_xor(ss, 16); ss += __shfl_xor(ss, 32);
            if (lane < 16) part[w * 64 + 16 * rt + lane] = ss;
        }
        __syncthreads();
        if (tid < 64) { float ss = 0.f;
#pragma unroll
            for (int t2 = 0; t2 < 8; ++t2) ss += part[t2 * 64 + tid];
            rs[tid] = rsqrtf(ss * (1.f / 128.f) + EPS) * ((LAS float*)(lds + 143360))[tid]; }
        __syncthreads();
#pragma unroll
        for (int rt = 0; rt < 4; ++rt) { const int c = 16 * rt + (lane & 15), e0 = 16 * w + 4 * (lane >> 4);
            const v2u gw2 = *(const LAS v2u*)(GG + c * 128 + e0);
            const float gv[4] = {__uint_as_float(gw2.x << 16), __uint_as_float(gw2.x & 0xffff0000u), __uint_as_float(gw2.y << 16), __uint_as_float(gw2.y & 0xffff0000u)};
            const float rc = rs[c]; float ov[4];
#pragma unroll
            for (int r = 0; r < 4; ++r) ov[r] = o[rt][r] * rc * ge4[r] * gv[r] * __builtin_amdgcn_rcpf(1.f + exp_fast(-gv[r]));
            *(GAS v2u*)(MIXED + (tok0 + c) * D + 512 + h * 128 + e0) = (v2u){pk_bf2(ov[0], ov[1]), pk_bf2(ov[2], ov[3])}; }
        __syncthreads();
    }
}
__device__ __forceinline__ void gla_load1(GlaRaw1& R, int tid, int b, int h, int n, const bf16_t* PROJ) {
    const size_t tok0 = (size_t)b * T + n * 64;
    const int s8 = tid >> 3, c8 = tid & 7, lane = tid & 63, w = tid >> 6;
    R.k = ld16(PROJ + (tok0 + s8) * PW + C_GK + h * 64 + c8 * 8);
    if (tid < 256) R.z = ld16(PROJ + (tok0 + (tid >> 2)) * PW + C_ZF + (tid & 3) * 8);
    R.v0 = ld16(PROJ + (tok0 + (tid >> 4)) * PW + C_GV + h * 128 + (tid & 15) * 8); R.v1 = ld16(PROJ + (tok0 + (tid >> 4) + 32) * PW + C_GV + h * 128 + (tid & 15) * 8);
}
__device__ __forceinline__ void gla_g1_phase(LAS unsigned char* lds, int tid, int bx, const bf16_t* PROJ, const float* upf, const float* bf_, const float* upb, const float* bb_, bf16_t* KVS, float* DEC) {
    const int n = bx & 63, h = (bx >> 6) & 3;
    const int d = tid & 63, tg = tid >> 6, lane = tid & 63, w = tid >> 6, s8 = tid >> 3, c8 = tid & 7;
    const int dcol = 16 * (w & 3) + (lane & 15), tk0 = 32 * (w >> 2) + 4 * (lane >> 4);
    const float bsF = bf_[h * 64 + dcol], bsB = bb_[h * 64 + dcol];
    gla_build_upt(lds, tid, h, upf, upb);
    LAS bf16_t* KR = (LAS bf16_t*)(lds + G_G); LAS bf16_t* KET = (LAS bf16_t*)(lds + G_QE); LAS bf16_t* VT = (LAS bf16_t*)(lds + G_VT);
    GlaRaw1 R; gla_load1(R, tid, 0, h, n, PROJ);
    for (int b = 0; b < NB; ++b) {
        gla_store_zb(lds, tid, R.z); gla_store_vt(lds, tid, R.v0, R.v1);
        *(LAS v4u*)(KR + s8 * LDT + c8 * 8) = R.k;
        if (b + 1 < NB) gla_load1(R, tid, b + 1, h, n, PROJ);
        __syncthreads();
#pragma unroll
        for (int dir = 0; dir < 2; ++dir) {
            float bv[2][4], bl;
            if (dir == 0) gla_cumsum3<0>(lds, bsF, w, lane, bv, bl); else gla_cumsum3<1>(lds, bsB, w, lane, bv, bl);
#pragma unroll
            for (int j = 0; j < 2; ++j) {
                const int t0 = tk0 + 16 * j;
                const unsigned p0 = pk_bf2(bf2f(KR[(t0 + 0) * LDT + dcol]) * exp_fast(bl - bv[j][0]), bf2f(KR[(t0 + 1) * LDT + dcol]) * exp_fast(bl - bv[j][1]));
                const unsigned p1 = pk_bf2(bf2f(KR[(t0 + 2) * LDT + dcol]) * exp_fast(bl - bv[j][2]), bf2f(KR[(t0 + 3) * LDT + dcol]) * exp_fast(bl - bv[j][3]));
                *(LAS v2u*)(KET + dcol * LDT + t0) = (v2u){p0, p1};
            }
            const size_t sq = (((size_t)b * 4 + h) * 2 + dir) * 64 + n;
            if (w < 4 && lane < 16) DEC[sq * 64 + dcol] = exp_fast(bl);
            __syncthreads();
            bf16_t* kvo = KVS + sq * 8192;
            LAS bf16_t* STG = (LAS bf16_t*)(lds + G_ST0);
#pragma unroll
            for (int dt = 0; dt < 4; ++dt) {
                gf32x4 acc = {0.f, 0.f, 0.f, 0.f};
                acc = mfma_tile64_v<false>(KET + (16 * dt) * LDT, VT + (16 * w) * LDT, w, acc, lane);
                *(LAS v2u*)(STG + (16 * w + (lane & 15)) * LDT + 16 * dt + 4 * (lane >> 4)) = (v2u){pk_bf2(acc[0], acc[1]), pk_bf2(acc[2], acc[3])};
            }
            asm volatile("s_waitcnt lgkmcnt(0)" ::: "memory");
#pragma unroll
            for (int j = 0; j < 2; ++j) { const int row = 16 * w + 8 * j + (lane >> 3);
                const v4u x = *(const LAS v4u*)(STG + row * LDT + (lane & 7) * 8); *(GAS v4u*)(kvo + (size_t)row * 64 + (lane & 7) * 8) = x; }
        }
        __syncthreads();
    }
}
#include <hip/hip_bf16.h>
#include <cmath>
namespace attn_body {
using bf16=__hip_bfloat16;
using bf16x8=__attribute__((ext_vector_type(8)))short;
using s16x4=__attribute__((ext_vector_type(4)))short;
using f32x16=__attribute__((ext_vector_type(16)))float;
using u32x4=__attribute__((ext_vector_type(4)))unsigned;
constexpr int BATCH=8,NHEAD=8,SEQ=4096,D=64,DM=2560,OP=1024;
constexpr int NW=8,QBLK=32,QB=QBLK*NW,KVBLK=64,NQB=SEQ/QB;
constexpr int ATTN_PITCH=DM, ATTN_UNIT_ROWS=QB;
__device__ __forceinline__ int crow(int r,int hi){return (r&3)+8*(r>>2)+4*hi;}
#define SBAR() __builtin_amdgcn_sched_barrier(0)
__device__ __forceinline__ void cmask(f32x16&p0,f32x16&p1,int jb,int qrel,int hi){
  const float NEG=-INFINITY; int kb=64*jb+4*hi;
  #pragma unroll
  for(int r=0;r<16;++r){int kv=kb+(r&3)+8*(r>>2); if(kv>qrel)p0[r]=NEG; if(kv+32>qrel)p1[r]=NEG;}
}

constexpr int NSLOT=3, SLOTB=8192;
constexpr int LDS_K=0, LDS_V=NSLOT*SLOTB, LDS_WS=2*NSLOT*SLOTB, LDS_OST=LDS_WS+NW*64*4, LDS_BYTES=LDS_OST+NW*4096;
constexpr bool FIXREF=true;
constexpr float C2=0.125f*1.4426950408889634f;
__device__ __forceinline__ void glds16(const void*gsrc,unsigned lds_dst){unsigned keep;
  asm volatile("s_mov_b32 %0, m0\n\ts_mov_b32 m0, %2\n\ts_nop 0\n\tglobal_load_lds_dwordx4 %1, off\n\ts_mov_b32 m0, %0":"=&s"(keep):"v"(gsrc),"s"(lds_dst):"memory");}
__device__ __forceinline__ float max3f(float a,float b,float c){float r;asm("v_max3_f32 %0, %1, %2, %3":"=v"(r):"v"(a),"v"(b),"v"(c));return r;}
__device__ __forceinline__ float max2f(float a,float b){float r;asm("v_max_f32_e32 %0, %1, %2":"=v"(r):"v"(a),"v"(b));return r;}
__device__ __forceinline__ float fadd_s(float a,float b){float r;asm("v_add_f32_e32 %0, %1, %2":"=v"(r):"v"(a),"v"(b));return r;}
__device__ __forceinline__ float fsub_s(float a,float b){float r;asm("v_sub_f32_e32 %0, %1, %2":"=v"(r):"v"(a),"v"(b));return r;}
typedef float f32x2_t __attribute__((ext_vector_type(2))); typedef __bf16 bf16x2_t __attribute__((ext_vector_type(2)));
__device__ __forceinline__ unsigned cvtpk_s(float lo,float hi){f32x2_t v={lo,hi};bf16x2_t b=__builtin_convertvector(v,bf16x2_t);return __builtin_bit_cast(unsigned,b);}
#define WAIT_BAR(N) asm volatile("s_waitcnt vmcnt(" #N ") lgkmcnt(0)\n\ts_barrier":::"memory")

__device__ __forceinline__ void qkt(f32x16&p0,f32x16&p1,const char*Kslot,const bf16x8*qr,const f32x16&negm,int r32,int hi){
  const char*kb=Kslot+r32*128; const int xs=(r32>>1)&7;
  #pragma unroll
  for(int d0=0;d0<4;++d0){
    const bf16x8 b0=*reinterpret_cast<const bf16x8*>(kb+(((2*d0+hi)^xs)<<4));
    const bf16x8 b1=*reinterpret_cast<const bf16x8*>(kb+(((2*d0+hi)^xs)<<4)+4096);
    if(d0==0){p0=__builtin_amdgcn_mfma_f32_32x32x16_bf16(b0,qr[0],negm,0,0,0);p1=__builtin_amdgcn_mfma_f32_32x32x16_bf16(b1,qr[0],negm,0,0,0);}
    else{p0=__builtin_amdgcn_mfma_f32_32x32x16_bf16(b0,qr[d0],p0,0,0,0);p1=__builtin_amdgcn_mfma_f32_32x32x16_bf16(b1,qr[d0],p1,0,0,0);}}
}
typedef __attribute__((address_space(3))) const char* lds_cptr;
typedef short v4i16_t __attribute__((ext_vector_type(4)));
struct KBases { int o[4]; };
__device__ __forceinline__ void kload8(bf16x8*kf,lds_cptr kring,const KBases&kb,int sl){
  #pragma unroll
  for(int d0=0;d0<4;++d0){ kf[2*d0]=*(const __attribute__((address_space(3))) bf16x8*)(kring+kb.o[d0]+sl); kf[2*d0+1]=*(const __attribute__((address_space(3))) bf16x8*)(kring+kb.o[d0]+sl+4096); }
}
__device__ __forceinline__ void kload2(bf16x8*kf,lds_cptr kring,const KBases&kb,int sl,int j){ kf[2*j]=*(const __attribute__((address_space(3))) bf16x8*)(kring+kb.o[j]+sl); kf[2*j+1]=*(const __attribute__((address_space(3))) bf16x8*)(kring+kb.o[j]+sl+4096); }
__device__ __forceinline__ s16x4 vtr(lds_cptr p){ return __builtin_bit_cast(s16x4,__builtin_amdgcn_ds_read_tr16_b64_v4i16((__attribute__((address_space(3))) v4i16_t*)p)); }
__device__ __forceinline__ float rowmax(const f32x16&p0,const f32x16&p1){
  float a=max3f(p0[0],p0[1],p1[0]),b=max3f(p0[2],p0[3],p1[1]);a=max3f(a,p1[2],p1[3]);
  #pragma unroll
  for(int r=4;r<16;r+=4){a=max3f(a,p0[r],p0[r+1]);b=max3f(b,p0[r+2],p0[r+3]);a=max3f(a,p1[r],p1[r+1]);b=max3f(b,p1[r+2],p1[r+3]);}
  const float m=max2f(a,b);
  auto rr=__builtin_amdgcn_permlane32_swap(__float_as_uint(m),__float_as_uint(m),false,false);
  return max2f(__uint_as_float(rr[0]),__uint_as_float(rr[1]));
}
__device__ __forceinline__ void pv(f32x16*o,int vb,bf16x8 pa0,bf16x8 pa1,bf16x8 pa2,bf16x8 pa3){
  #pragma unroll
  for(int d0=0;d0<2;++d0){s16x4 lo[4],hi[4];
    #pragma unroll
    for(int ks=0;ks<4;++ks){
      asm volatile("ds_read_b64_tr_b16 %0,%1 offset:%c2":"=&v"(lo[ks]):"v"(vb),"i"(d0*4096+ks*1024):"memory");
      asm volatile("ds_read_b64_tr_b16 %0,%1 offset:%c2":"=&v"(hi[ks]):"v"(vb),"i"(d0*4096+ks*1024+512):"memory");}
    asm volatile("s_waitcnt lgkmcnt(0)":::"memory");SBAR();
    #define PK(k) (bf16x8){lo[k][0],lo[k][1],lo[k][2],lo[k][3],hi[k][0],hi[k][1],hi[k][2],hi[k][3]}
    o[d0]=__builtin_amdgcn_mfma_f32_32x32x16_bf16(pa0,PK(0),o[d0],0,0,0);
    o[d0]=__builtin_amdgcn_mfma_f32_32x32x16_bf16(pa1,PK(1),o[d0],0,0,0);
    o[d0]=__builtin_amdgcn_mfma_f32_32x32x16_bf16(pa2,PK(2),o[d0],0,0,0);
    o[d0]=__builtin_amdgcn_mfma_f32_32x32x16_bf16(pa3,PK(3),o[d0],0,0,0);
    #undef PK
  }
}

#ifndef ATTN_STORE16
#define ATTN_STORE16(p,v) (*(u32x4*)(p)=(v))
#endif
template<int THRL> __device__ __forceinline__ void attn_unit(int b,int h,int qb,const bf16*Q,const bf16*__restrict__ K,const bf16*__restrict__ V,bf16*O,char*shm,const float*qg,const float*rope,float*ssq,float sbound){
  const int tid=threadIdx.x,lane=tid&63,r32=lane&31,hi=lane>>5; const int wid=__builtin_amdgcn_readfirstlane(tid>>6);
  const long rowbase=(long)b*SEQ; const int q0=qb*QB;
  const bf16*Qw=Q+(rowbase+q0+wid*QBLK)*DM+h*D;
  const bf16*Kh=K+rowbase*DM+(h>>2)*D,*Vh=V+rowbase*DM+(h>>2)*D;
  const unsigned lds0=(unsigned)(uintptr_t)shm;
  float*wsf=(float*)(shm+LDS_WS)+wid*64;
  const unsigned koff=(unsigned)((8*wid+(lane>>3))*DM+(((lane&7)^((4*wid+(lane>>4))&7))*8)),
  voff_dummy_=0u, voff=(unsigned)((16*(wid&3)+(lane>>2))*DM+(wid>>2)*32+(lane&3)*8);
  const unsigned kdst=lds0+LDS_K+wid*1024, vdst=lds0+LDS_V+wid*1024;
  #define DMA_K(t,slot) glds16(Kh+(long)(t)*KVBLK*DM+koff,(unsigned)__builtin_amdgcn_readfirstlane(kdst+(slot)))
  #define DMA_V(t,slot) glds16(Vh+(long)(t)*KVBLK*DM+voff,(unsigned)__builtin_amdgcn_readfirstlane(vdst+(slot)))
  const int vb0=(int)(lds0+LDS_V)+((lane>>4)&1)*32+(lane&3)*8+(4*hi+((lane&15)>>2))*64;
  const char*Kbase=shm+LDS_K; bf16x8 kf[8];
  const lds_cptr shm3=(lds_cptr)shm; const lds_cptr kring=shm3+LDS_K; KBases kbs; _Pragma("unroll") for(int d0=0;d0<4;++d0)kbs.o[d0]=r32*128+(((2*d0+hi)^((r32>>1)&7))<<4); const lds_cptr vp0=shm3+LDS_V+((lane>>4)&1)*32+(lane&3)*8+(4*hi+((lane&15)>>2))*64;
  const int NT=SEQ/KVBLK;
  DMA_K(0,0);DMA_V(0,0);DMA_K(1,SLOTB);
  bf16x8 qr[4];
  #pragma unroll
  for(int d0=0;d0<4;++d0)qr[d0]=*reinterpret_cast<const bf16x8*>(&Qw[(long)r32*DM+d0*16+hi*8]);
  {
    float x[4][8]; float ss=0.f;
    #pragma unroll
    for(int d0=0;d0<4;++d0){
      #pragma unroll
      for(int j=0;j<8;++j){ x[d0][j]=__uint_as_float(((unsigned)(unsigned short)qr[d0][j])<<16); ss+=x[d0][j]*x[d0][j]; } }
    ss+=__shfl_xor(ss,32);
    const float rstd=rsqrtf(ss*(1.f/64.f)+1e-6f);
    const int tt=q0+wid*QBLK+r32, prow=tt>>6, pcol=tt&63;
    #pragma unroll
    for(int d0=0;d0<4;++d0){
      const float4 g0=*reinterpret_cast<const float4*>(qg+d0*16+hi*8), g1=*reinterpret_cast<const float4*>(qg+d0*16+hi*8+4);
      const int pos=(d0<2)?prow:pcol, i0=8*(d0&1)+4*hi;
      const float4 c4=*reinterpret_cast<const float4*>(rope+pos*16+i0), s4=*reinterpret_cast<const float4*>(rope+1024+pos*16+i0);
      const float gg[8]={g0.x,g0.y,g0.z,g0.w,g1.x,g1.y,g1.z,g1.w}, cc[4]={c4.x,c4.y,c4.z,c4.w}, sn[4]={s4.x,s4.y,s4.z,s4.w};
      u32x4 pw;
      #pragma unroll
      for(int jj=0;jj<4;++jj){ const float y0=x[d0][2*jj]*rstd*gg[2*jj], y1=x[d0][2*jj+1]*rstd*gg[2*jj+1];
        pw[jj]=cvtpk_s((y0*cc[jj]-y1*sn[jj])*C2,(y0*sn[jj]+y1*cc[jj])*C2); }
      qr[d0]=__builtin_bit_cast(bf16x8,pw); } }
  float mhat=0.f,l_reg=0.f;f32x16 o[2];o[0]=f32x16{};o[1]=f32x16{};f32x16 negm; _Pragma("unroll") for(int r=0;r<16;++r)negm[r]=FIXREF?-sbound:0.f; asm volatile("":"+v"(negm));

  #define CMASK(P0,P1,t) do{}while(0)
  bool resc=false;
  #define START(P0,P1) do{ resc=false; if(!FIXREF) \
    { const float rm=rowmax(P0,P1); const float dl=rm; mhat=fadd_s(mhat,dl); \
      _Pragma("unroll") for(int r=0;r<16;++r){P0[r]=fsub_s(P0[r],dl);P1[r]=fsub_s(P1[r],dl);} \
      _Pragma("unroll") for(int r=0;r<16;++r)negm[r]=-mhat; asm volatile("":"+v"(negm)); } \
    _Pragma("unroll") for(int r=0;r<16;++r)P0[r]=__builtin_amdgcn_exp2f(P0[r]); }while(0)
  #define RESC() do{ if(resc){ asm volatile("s_waitcnt lgkmcnt(0)":::"memory"); \
      _Pragma("unroll") for(int d_=0;d_<2;++d_) _Pragma("unroll") for(int r=0;r<16;++r)o[d_][r]*=wsf[crow(r,hi)]; } }while(0)
  f32x16 pA0,pA1,pB0,pB1;
  int sl_prev=0,sl_cur=0,sl_next=SLOTB;
  #define ROT() do{sl_prev=sl_cur;sl_cur=sl_next;sl_next=(sl_next==(NSLOT-1)*SLOTB)?0:sl_next+SLOTB;}while(0)
  DMA_K(2,2*SLOTB);
  WAIT_BAR(3);
  qkt(pA0,pA1,Kbase,qr,negm,r32,hi);asm volatile("s_nop 15\n\ts_nop 7":"+v"(pA0),"+v"(pA1));CMASK(pA0,pA1,0);
  START(pA0,pA1);
  _Pragma("unroll") for(int r=0;r<16;++r)pA1[r]=__builtin_amdgcn_exp2f(pA1[r]);
  WAIT_BAR(0);
  DMA_K(3,0);DMA_V(1,SLOTB);
  ROT();
  kload8(kf,kring,kbs,sl_cur);
  WAIT_BAR(2);
  s16x4 vlo[8],vhi[8]; u32x4 pw0,pw1,pw2,pw3;
  #define PKW(P,B) cvtpk_s(P[B],P[B+1])
  #define PAF(k) __builtin_bit_cast(bf16x8,pw##k)
  #define VFR(i) (bf16x8){vlo[i][0],vlo[i][1],vlo[i][2],vlo[i][3],vhi[i][0],vhi[i][1],vhi[i][2],vhi[i][3]}
  #define PIN(x) asm volatile("":"+v"(x))
  #define MX3(a,b,c) __builtin_fmaxf(__builtin_fmaxf((a),(b)),(c))
  #define GAPA(MF,A0,A1,A2,A3,W0,W1,PW) do{ MF; sacc+=A0; sacc+=A1; sacc+=A2; sacc+=A3; PIN(sacc); W0; W1; PIN(PW); SBAR(); }while(0)
  #define EX(v) __builtin_amdgcn_exp2f(v)
  #define GAPB(MF,X,B) do{ MF; X[B]=EX(X[B]); X[B+1]=EX(X[B+1]); X[B+2]=EX(X[B+2]); X[B+3]=EX(X[B+3]); PIN(X); SBAR(); }while(0)
  #define VRD(i) do{ vlo[i]=vtr(vp_+(((i)>>2)*4096+((i)&3)*1024)); vhi[i]=vtr(vp_+(((i)>>2)*4096+((i)&3)*1024+512)); }while(0)
  #define KRD(G,j) do{ if(G){ kload2(kf,kring,kbs,sl_next,j); SBAR(); } }while(0)
  #define STEP(C0,C1,P0,P1,t,GK,GV,GL) do{ SBAR(); \
    const lds_cptr vp_=vp0+sl_prev; \
    VRD(0); SBAR(); float sacc=(P0[0]+P0[1]); \
    GAPA(C0=__builtin_amdgcn_mfma_f32_32x32x16_bf16(kf[0],qr[0],negm,0,0,0), P0[2],P0[3],P0[4],P0[5],     pw0[0]=PKW(P0,0), pw0[1]=PKW(P0,2), pw0); \
    VRD(4); SBAR(); GAPA(C1=__builtin_amdgcn_mfma_f32_32x32x16_bf16(kf[1],qr[0],negm,0,0,0), P0[6],P0[7],P0[8],P0[9],     pw0[2]=PKW(P0,4), pw0[3]=PKW(P0,6), pw0); \
    VRD(1); SBAR(); GAPA(C0=__builtin_amdgcn_mfma_f32_32x32x16_bf16(kf[2],qr[1],C0,0,0,0),   P0[10],P0[11],P0[12],P0[13], pw1[0]=PKW(P0,8), pw1[1]=PKW(P0,10), pw1); \
    VRD(5); SBAR(); GAPA(C1=__builtin_amdgcn_mfma_f32_32x32x16_bf16(kf[3],qr[1],C1,0,0,0),   P0[14],P0[15],P1[0],P1[1],   pw1[2]=PKW(P0,12),pw1[3]=PKW(P0,14), pw1); \
    VRD(2); SBAR(); GAPA(C0=__builtin_amdgcn_mfma_f32_32x32x16_bf16(kf[4],qr[2],C0,0,0,0),   P1[2],P1[3],P1[4],P1[5],     pw2[0]=PKW(P1,0), pw2[1]=PKW(P1,2), pw2); \
    VRD(6); SBAR(); GAPA(C1=__builtin_amdgcn_mfma_f32_32x32x16_bf16(kf[5],qr[2],C1,0,0,0),   P1[6],P1[7],P1[8],P1[9],     pw2[2]=PKW(P1,4), pw2[3]=PKW(P1,6), pw2); \
    VRD(3); SBAR(); GAPA(C0=__builtin_amdgcn_mfma_f32_32x32x16_bf16(kf[6],qr[3],C0,0,0,0),   P1[10],P1[11],P1[12],P1[13], pw3[0]=PKW(P1,8), pw3[1]=PKW(P1,10), pw3); \
    VRD(7); SBAR(); GAPA(C1=__builtin_amdgcn_mfma_f32_32x32x16_bf16(kf[7],qr[3],C1,0,0,0),   P1[14],P1[15],0.f,0.f,       pw3[2]=PKW(P1,12),pw3[3]=PKW(P1,14), pw3); \
    l_reg+=sacc; \
    if(GK){DMA_K((t)+3,sl_cur);} if(GV){DMA_V((t)+1,sl_next);} \
    CMASK(C0,C1,t); \
    if(!FIXREF){ float a=MX3(C0[0],C0[1],C1[0]),b=MX3(C0[2],C0[3],C1[1]); a=MX3(a,C1[2],C1[3]); \
      _Pragma("unroll") for(int r=4;r<16;r+=4){a=MX3(a,C0[r],C0[r+1]);b=MX3(b,C0[r+2],C0[r+3]);a=MX3(a,C1[r],C1[r+1]);b=MX3(b,C1[r+2],C1[r+3]);} \
      float rm=__builtin_fmaxf(a,b); { auto rr=__builtin_amdgcn_permlane32_swap(__float_as_uint(rm),__float_as_uint(rm),false,false); rm=__builtin_fmaxf(__uint_as_float(rr[0]),__uint_as_float(rr[1])); } \
      resc=false; \
      if(__builtin_expect(__any(rm>(float)THRL),0)){ const float dl=__builtin_fmaxf(rm,0.f); mhat+=dl; \
        _Pragma("unroll") for(int r=0;r<16;++r){C0[r]-=dl;C1[r]-=dl;} \
        _Pragma("unroll") for(int r=0;r<16;++r)negm[r]=-mhat; asm volatile("":"+v"(negm)); \
        const float f=__builtin_amdgcn_exp2f(-dl); l_reg*=f; if(hi==0)wsf[r32]=f; resc=true; } } \
    SBAR(); \
    GAPB(o[0]=__builtin_amdgcn_mfma_f32_32x32x16_bf16(PAF(0),VFR(0),o[0],0,0,0), C0,0); \
    GAPB(o[1]=__builtin_amdgcn_mfma_f32_32x32x16_bf16(PAF(0),VFR(4),o[1],0,0,0), C0,4); \
    KRD(GL,0); GAPB(o[0]=__builtin_amdgcn_mfma_f32_32x32x16_bf16(PAF(1),VFR(1),o[0],0,0,0), C0,8); \
    KRD(GL,1); GAPB(o[1]=__builtin_amdgcn_mfma_f32_32x32x16_bf16(PAF(1),VFR(5),o[1],0,0,0), C0,12); \
    KRD(GL,2); GAPB(o[0]=__builtin_amdgcn_mfma_f32_32x32x16_bf16(PAF(2),VFR(2),o[0],0,0,0), C1,0); \
    KRD(GL,3); GAPB(o[1]=__builtin_amdgcn_mfma_f32_32x32x16_bf16(PAF(2),VFR(6),o[1],0,0,0), C1,4); \
    GAPB(o[0]=__builtin_amdgcn_mfma_f32_32x32x16_bf16(PAF(3),VFR(3),o[0],0,0,0), C1,8); \
    GAPB(o[1]=__builtin_amdgcn_mfma_f32_32x32x16_bf16(PAF(3),VFR(7),o[1],0,0,0), C1,12); \
    }while(0)
  int t=1;
  #undef CMASK
  #define CMASK(P0,P1,t) do{}while(0)
  for(;t+5<NT;t+=2){
    STEP(pB0,pB1,pA0,pA1,t,true,true,true);     WAIT_BAR(2); RESC(); ROT();
    STEP(pA0,pA1,pB0,pB1,t+1,true,true,true);   WAIT_BAR(2); RESC(); ROT();
  }
  #undef CMASK
  #define CMASK(P0,P1,t) do{}while(0)
  #define ENDW(tt) do{ if((tt)+3<NT){WAIT_BAR(2);} else if((tt)+2<NT){WAIT_BAR(1);} else {WAIT_BAR(0);} }while(0)
  for(;t+1<NT;t+=2){
    STEP(pB0,pB1,pA0,pA1,t,(t+3<NT),(t+1<NT),(t+1<NT));       ENDW(t);   RESC(); ROT();
    STEP(pA0,pA1,pB0,pB1,t+1,(t+4<NT),(t+2<NT),(t+2<NT));     ENDW(t+1); RESC(); ROT();
  }
  STEP(pB0,pB1,pA0,pA1,NT-1,false,false,false); RESC();
  { float sacc=pB0[0]+pB0[1]; _Pragma("unroll") for(int r=2;r<16;++r)sacc+=pB0[r]; _Pragma("unroll") for(int r=0;r<16;++r)sacc+=pB1[r]; l_reg+=sacc;
    pw0=(u32x4){PKW(pB0,0),PKW(pB0,2),PKW(pB0,4),PKW(pB0,6)};pw1=(u32x4){PKW(pB0,8),PKW(pB0,10),PKW(pB0,12),PKW(pB0,14)};pw2=(u32x4){PKW(pB1,0),PKW(pB1,2),PKW(pB1,4),PKW(pB1,6)};pw3=(u32x4){PKW(pB1,8),PKW(pB1,10),PKW(pB1,12),PKW(pB1,14)};
    SBAR(); pv(o,vb0+sl_cur,PAF(0),PAF(1),PAF(2),PAF(3)); }
  #undef PKW
  #undef PAF
  #undef VFR
  #undef PIN
  #undef MX3
  #undef GAPA
  #undef GAPB
  #undef EX
  #undef VRD
  #undef KRD
  #undef STEP
  #undef ENDW
  {auto rr=__builtin_amdgcn_permlane32_swap(__float_as_uint(l_reg),__float_as_uint(l_reg),false,false);l_reg=__uint_as_float(rr[0])+__uint_as_float(rr[1]);}
  if(hi==0)wsf[32+r32]=l_reg;asm volatile("s_waitcnt lgkmcnt(0)":::"memory");
  float rli[16];
  #pragma unroll
  for(int r=0;r<16;++r)rli[r]=__builtin_amdgcn_rcpf(wsf[32+crow(r,hi)]);
  bf16*Ow=O+(rowbase+q0+wid*QBLK)*OP+h*D;
  { bf16*stg=(bf16*)(shm+LDS_OST)+wid*2048;
    #pragma unroll
    for(int r=0;r<16;++r){const int orow=crow(r,hi);
      #pragma unroll
      for(int d0=0;d0<2;++d0)stg[orow*64+d0*32+r32]=__float2bfloat16(o[d0][r]*rli[r]);}
    asm volatile("s_waitcnt lgkmcnt(0)":::"memory");
    #pragma unroll
    for(int i=0;i<4;++i){const int row=i*8+(lane>>3),ch=lane&7; const u32x4 v=*(const u32x4*)(stg+row*64+ch*8); ATTN_STORE16(Ow+(long)row*OP+ch*8,v);
      float sq=0.f;
      #pragma unroll
      for(int k=0;k<4;++k){ const float lo=__uint_as_float(v[k]<<16), hi_=__uint_as_float(v[k]&0xffff0000u); sq+=lo*lo+hi_*hi_; }
      sq+=__shfl_xor(sq,1); sq+=__shfl_xor(sq,2); sq+=__shfl_xor(sq,4);
      if(ch==0) ssq[(long)h*(BATCH*SEQ)+rowbase+q0+wid*QBLK+row]=sq; } }
  asm volatile("s_waitcnt lgkmcnt(0)\n\ts_barrier":::"memory");
  #undef DMA_K
  #undef DMA_V
  #undef CMASK
  #undef START
  #undef RESC
  #undef ROT
}
constexpr int ATTN_LDS_BYTES=LDS_BYTES;
struct AttnTensors { const bf16* Q; const bf16* K; const bf16* V; bf16* O; const float* qg; const float* rope; float* ssq; float sbound; };
struct AttnUnit { int bh; int qb; };
struct StaticOrder {
  int vcu;
  __device__ __forceinline__ explicit StaticOrder(int grid,int block):vcu((block%8)*(grid/8)+block/8){}
  __device__ __forceinline__ bool next(int i,AttnUnit&u)const{ if(i>=4)return false; const int pair=vcu>>4, c16=vcu&15; u.bh=(pair>>1)*NHEAD+(pair&1)*4+(c16>>2); u.qb=(c16&3)*4+i; return true; }
  __device__ __forceinline__ void a_ready(const AttnUnit&)const{}
  __device__ __forceinline__ void done(const AttnUnit&)const{}
};
template<class Sched,int THRL=8> __device__ __forceinline__ void attn_phase(char*lds,const AttnTensors&T,const Sched&S){
  AttnUnit u;
  for(int i=0;S.next(i,u);++i){ S.a_ready(u); attn_unit<THRL>(u.bh/NHEAD,u.bh%NHEAD,u.qb,T.Q,T.K,T.V,T.O,lds,T.qg,T.rope,T.ssq,T.sbound); S.done(u); }
}
#undef SBAR
#undef WAIT_BAR
}

constexpr int NWAVES = 8;
constexpr int RING_OFF = 0, RING_BYTES = 131072;
constexpr int LDSCTL_OFF = RING_BYTES, MISC_OFF = LDSCTL_OFF + 320;
constexpr int LDS_BYTES = 147456;
constexpr int CW_BAR = 32768;
constexpr int MAX_LAUNCH = 8;
static_assert((CW_BAR + MAX_LAUNCH * XCD_BAR_WORDS) * 4 <= (int)(1 * MiB), "barrier words inside the memset region");
constexpr size_t WS_WINT = 4 * MiB;
constexpr size_t WS_WOUTT = 9 * MiB;
constexpr size_t WS_SSQ = 13 * MiB;
constexpr size_t WS_RSTD = 3 * MiB + 65536;
constexpr size_t WS_WGU = 16 * MiB;
constexpr size_t WS_WD = 144 * MiB;
constexpr int TAB_OFF = LDSCTL_OFF + 1024;
constexpr int XS_ROWS = NSLOT + 256;

constexpr int PROF_A = -1, PROF_B = -1;
constexpr int CW_PROF = 20000;
constexpr int FP8TEST = 0;
constexpr int NCONV = 136;
constexpr int CW_COUNTS2 = 70000, CW_CURSOR2 = 75000, CW_TILECNT = 90000;
constexpr int HIST_OFF = 49152, POS_OFF = 50176;
constexpr int REP0 = 1, REPG1 = 1, REPG3 = 1, REPATT = 1, REPM1 = 1, REPM2 = 1, REPP1 = 1, REPALL = 1, REPU = 1, REPP5 = 1, DRYQK = 0, DRYAN = 0, DRYSC = 0, DRYFIN = 0, DRYRT = 0;
struct Args { const float* in[21]; float* out; unsigned char* ws; int ph_lo, ph_hi, li, pad; };

struct Frame {
    LAS unsigned char* lds;
    volatile LAS unsigned* MISC;
    int tid, lane, wave, vcu, G;
};

template <bool NT = false>
__device__ __forceinline__ void p0_transpose_item(const float* W, int ldw, int k0, int ns0, bf16* WT, int K, int nd0, LAS float* scr, int lane) {
    if (ns0 >= 0) {
        f32x4 v[8];
#pragma unroll
        for (int i = 0; i < 8; ++i) { const GAS f32x4* p = (const GAS f32x4*)(W + (size_t)(k0 + 8 * i + (lane >> 3)) * ldw + ns0 + (lane & 7) * 4); v[i] = NT ? __builtin_nontemporal_load(p) : *p; }
#pragma unroll
        for (int i = 0; i < 8; ++i) { LAS float* p = scr + (8 * i + (lane >> 3)) * 33 + (lane & 7) * 4; p[0] = v[i].x; p[1] = v[i].y; p[2] = v[i].z; p[3] = v[i].w; }
    } else {
#pragma unroll 8
        for (int i = 0; i < 32; ++i) { const int kk = 2 * i + (lane >> 5); scr[kk * 33 + (lane & 31)] = 0.f; }
    }
    LDS_WAIT(); asm volatile("" ::: "memory");
    const int c = lane & 7;
#pragma unroll
    for (int j = 0; j < 4; ++j) { const int n = (lane >> 3) + 8 * j; const LAS float* s = scr + (8 * c) * 33 + n;
        v4u o; o.x = pk2(s[0 * 33], s[1 * 33]); o.y = pk2(s[2 * 33], s[3 * 33]); o.z = pk2(s[4 * 33], s[5 * 33]); o.w = pk2(s[6 * 33], s[7 * 33]);
        GAS v4u* q = (GAS v4u*)(WT + (size_t)(nd0 + n) * K + k0 + 8 * c); if (NT) __builtin_nontemporal_store(o, q); else *q = o; }
    LDS_WAIT(); asm volatile("" ::: "memory");
}

__device__ __forceinline__ void p0_transpose_item_wout(const float* W, int k0, int ns0, bf16* WT, const float* again, LAS float* scr, int lane) {
    f32x4 v[8];
#pragma unroll
    for (int i = 0; i < 8; ++i) { const int k = k0 + 8 * i + (lane >> 3); v[i] = *(const GAS f32x4*)(W + (size_t)k * D + ns0 + (lane & 7) * 4); if (k0 >= 512) v[i] = v[i] * again[k - 512]; }
#pragma unroll
    for (int i = 0; i < 8; ++i) { LAS float* p = scr + (8 * i + (lane >> 3)) * 33 + (lane & 7) * 4; p[0] = v[i].x; p[1] = v[i].y; p[2] = v[i].z; p[3] = v[i].w; }
    LDS_WAIT(); asm volatile("" ::: "memory");
    const int c = lane & 7, kd0 = (k0 + 512) & 1023;
#pragma unroll
    for (int j = 0; j < 4; ++j) { const int n = (lane >> 3) + 8 * j; const LAS float* sp = scr + (8 * c) * 33 + n;
        v4u o; o.x = pk2(sp[0 * 33], sp[1 * 33]); o.y = pk2(sp[2 * 33], sp[3 * 33]); o.z = pk2(sp[4 * 33], sp[5 * 33]); o.w = pk2(sp[6 * 33], sp[7 * 33]);
        *(GAS v4u*)(WT + (size_t)(ns0 + n) * D + kd0 + 8 * c) = o; }
    LDS_WAIT(); asm volatile("" ::: "memory");
}
struct ConvItem { const float* W; int ldw, k0, ns0; bf16* WT; int K, nd0; };
__device__ __forceinline__ void conv_load(const ConvItem& it, f32x4 (&v)[8], int lane) {
#pragma unroll
    for (int i = 0; i < 8; ++i) v[i] = __builtin_nontemporal_load((const GAS f32x4*)(it.W + (size_t)(it.k0 + 8 * i + (lane >> 3)) * it.ldw + it.ns0 + (lane & 7) * 4));
}
__device__ __forceinline__ void conv_finish(const ConvItem& it, const f32x4 (&v)[8], LAS float* scr, int lane) {
#pragma unroll
    for (int i = 0; i < 8; ++i) { LAS float* p = scr + (8 * i + (lane >> 3)) * 33 + (lane & 7) * 4; p[0] = v[i].x; p[1] = v[i].y; p[2] = v[i].z; p[3] = v[i].w; }
    LDS_WAIT(); asm volatile("" ::: "memory");
    const int c = lane & 7;
#pragma unroll
    for (int j = 0; j < 4; ++j) { const int n = (lane >> 3) + 8 * j; const LAS float* s = scr + (8 * c) * 33 + n;
        v4u o; o.x = pk2(s[0 * 33], s[1 * 33]); o.y = pk2(s[2 * 33], s[3 * 33]); o.z = pk2(s[4 * 33], s[5 * 33]); o.w = pk2(s[6 * 33], s[7 * 33]);
        __builtin_nontemporal_store(o, (GAS v4u*)(it.WT + (size_t)(it.nd0 + n) * it.K + it.k0 + 8 * c)); }
    LDS_WAIT(); asm volatile("" ::: "memory");
}
__device__ __forceinline__ ConvItem conv_item(int it, const float* wgate, const float* wup, const float* wdown, bf16* WguT, bf16* WdT) {
    constexpr int I_GU = NEXP * (D / 64) * (1024 / 32);
    ConvItem c;
    if (it < I_GU) { const int e = it >> 9, q = it & 511, kb = q >> 5, nb = q & 31, pn = nb >> 3, bj = (nb >> 2) & 1, c0 = (nb & 3) * 32;
        c.W = (bj ? wup : wgate) + (size_t)e * D * DEXP; c.ldw = DEXP; c.k0 = kb * 64; c.ns0 = pn * 128 + c0; c.WT = WguT + (size_t)e * 1024 * D; c.K = D; c.nd0 = nb * 32; }
    else { const int r = it - I_GU, e = r >> 8, q = r & 255, kb = q >> 5, nb = q & 31;
        c.W = wdown + (size_t)e * DEXP * D; c.ldw = D; c.k0 = kb * 64; c.ns0 = nb * 32; c.WT = WdT + (size_t)e * 1024 * DEXP; c.K = DEXP; c.nd0 = nb * 32; }
    return c;
}

__device__ __forceinline__ unsigned pk4_i8(float a, float b, float c, float d) {
    const int ia = __float2int_rn(a), ib = __float2int_rn(b), ic = __float2int_rn(c), id = __float2int_rn(d);
    return ((unsigned)ia & 0xffu) | (((unsigned)ib & 0xffu) << 8) | (((unsigned)ic & 0xffu) << 16) | ((unsigned)id << 24);
}
__device__ __forceinline__ void conv_colblock_i8g(const float* Wsrc, int ldw, unsigned char* out, float* sw32, LAS unsigned char* lds, int wave, int lane) {
    const float* W = Wsrc + (lane & 7) * 4;
    const int DEXP_ = ldw;
    LAS float* pmax = (LAS float*)(lds + 69632);
    f32x4 v[2][8];
#pragma unroll
    for (int q = 0; q < 2; ++q)
#pragma unroll
        for (int i = 0; i < 8; ++i) v[q][i] = Wsrc ? __builtin_nontemporal_load((const GAS f32x4*)(W + (size_t)((2 * wave + q) * 64 + 8 * i + (lane >> 3)) * DEXP_)) : (f32x4){0.f, 0.f, 0.f, 0.f};
    float mx[4] = {0.f, 0.f, 0.f, 0.f};
#pragma unroll
    for (int q = 0; q < 2; ++q)
#pragma unroll
        for (int i = 0; i < 8; ++i) { mx[0] = fmaxf(mx[0], fabsf(v[q][i].x)); mx[1] = fmaxf(mx[1], fabsf(v[q][i].y)); mx[2] = fmaxf(mx[2], fabsf(v[q][i].z)); mx[3] = fmaxf(mx[3], fabsf(v[q][i].w)); }
#pragma unroll
    for (int j = 0; j < 4; ++j) { mx[j] = fmaxf(mx[j], __shfl_xor(mx[j], 8)); mx[j] = fmaxf(mx[j], __shfl_xor(mx[j], 16)); mx[j] = fmaxf(mx[j], __shfl_xor(mx[j], 32)); }
    if (lane < 8) *(LAS f32x4*)(pmax + wave * 32 + lane * 4) = (f32x4){mx[0], mx[1], mx[2], mx[3]};
    __syncthreads();
#pragma unroll
    for (int w2 = 0; w2 < 8; ++w2) { const f32x4 m = *(const LAS f32x4*)(pmax + w2 * 32 + (lane & 7) * 4); mx[0] = fmaxf(mx[0], m.x); mx[1] = fmaxf(mx[1], m.y); mx[2] = fmaxf(mx[2], m.z); mx[3] = fmaxf(mx[3], m.w); }
    float inv[4];
#pragma unroll
    for (int j = 0; j < 4; ++j) inv[j] = mx[j] > 0.f ? 127.f / mx[j] : 0.f;
    if (wave == 0 && lane < 8) *(GAS f32x4*)(sw32 + lane * 4) = (f32x4){mx[0] * (1.f / 127.f), mx[1] * (1.f / 127.f), mx[2] * (1.f / 127.f), mx[3] * (1.f / 127.f)};
    LAS float* scr = (LAS float*)(lds + wave * 8448);
#pragma unroll
    for (int q = 0; q < 2; ++q) {
#pragma unroll
        for (int i = 0; i < 8; ++i) { LAS float* p = scr + (8 * i + (lane >> 3)) * 33 + (lane & 7) * 4; p[0] = v[q][i].x * inv[0]; p[1] = v[q][i].y * inv[1]; p[2] = v[q][i].z * inv[2]; p[3] = v[q][i].w * inv[3]; }
        LDS_WAIT(); asm volatile("" ::: "memory");
        { const int n = lane >> 1, hf = lane & 1; const LAS float* sp = scr + (32 * hf) * 33 + n; unsigned w[8];
#pragma unroll
          for (int r = 0; r < 8; ++r) w[r] = pk4_i8(sp[(4 * r) * 33], sp[(4 * r + 1) * 33], sp[(4 * r + 2) * 33], sp[(4 * r + 3) * 33]);
          GAS v4u* o = (GAS v4u*)(out + (size_t)n * D + (2 * wave + q) * 64 + 32 * hf); __builtin_nontemporal_store((v4u){w[0], w[1], w[2], w[3]}, o); __builtin_nontemporal_store((v4u){w[4], w[5], w[6], w[7]}, o + 1); }
        LDS_WAIT(); asm volatile("" ::: "memory");
    }
    __syncthreads();
}
__device__ __forceinline__ void conv_colblock_i8(int item  , const float* wgate, const float* wup, unsigned char* Wgu8, float* SW, LAS unsigned char* lds, int wave, int lane) {
    const int e = item >> 5, nb = item & 31, pn = nb >> 3, bj = (nb >> 2) & 1, c0 = (nb & 3) * 32;
    conv_colblock_i8g((bj ? wup : wgate) + (size_t)e * D * DEXP + pn * 128 + c0, DEXP, Wgu8 + ((size_t)e * 1024 + nb * 32) * D, SW + (size_t)e * 1024 + nb * 32, lds, wave, lane);
}
__device__ __forceinline__ void rms_row2_to_i8(int lane, const float* xrow0, const float* gain, unsigned char* o0, float* su0) {
    f32x4 v[2][4]; float ss[2] = {0.f, 0.f};
#pragma unroll
    for (int q = 0; q < 2; ++q)
#pragma unroll
        for (int j = 0; j < 4; ++j) v[q][j] = __builtin_nontemporal_load((const GAS f32x4*)(xrow0 + (size_t)q * D) + j * 64 + lane);
    f32x4 g[4];
#pragma unroll
    for (int j = 0; j < 4; ++j) g[j] = ((const GAS f32x4*)gain)[j * 64 + lane];
#pragma unroll
    for (int q = 0; q < 2; ++q)
#pragma unroll
        for (int j = 0; j < 4; ++j) ss[q] += (v[q][j].x * v[q][j].x + v[q][j].y * v[q][j].y) + (v[q][j].z * v[q][j].z + v[q][j].w * v[q][j].w);
    const bool b0 = lane & 1, b1 = lane & 2;
#pragma unroll
    for (int q = 0; q < 2; ++q) {
        const float rstd = rsqrtf(wave_sum(ss[q]) * (1.f / D) + EPS); float m = 0.f;
#pragma unroll
        for (int j = 0; j < 4; ++j) { v[q][j] = v[q][j] * rstd * g[j]; m = fmaxf(m, fmaxf(fmaxf(fabsf(v[q][j].x), fabsf(v[q][j].y)), fmaxf(fabsf(v[q][j].z), fabsf(v[q][j].w)))); }
#pragma unroll
        for (int o = 1; o < 64; o <<= 1) m = fmaxf(m, __shfl_xor(m, o));
        const float inv = m > 0.f ? 127.f / m : 0.f;
        unsigned w[4], x[4], y[4];
#pragma unroll
        for (int j = 0; j < 4; ++j) w[j] = pk4_i8(v[q][j].x * inv, v[q][j].y * inv, v[q][j].z * inv, v[q][j].w * inv);
#pragma unroll
        for (int p2 = 0; p2 < 2; ++p2) { const unsigned snd = b0 ? w[2 * p2] : w[2 * p2 + 1]; const unsigned rcv = (unsigned)__shfl_xor((int)snd, 1);
            x[2 * p2] = b0 ? rcv : w[2 * p2]; x[2 * p2 + 1] = b0 ? w[2 * p2 + 1] : rcv; }
#pragma unroll
        for (int i = 0; i < 2; ++i) { const unsigned snd = b1 ? x[i] : x[2 + i]; const unsigned rcv = (unsigned)__shfl_xor((int)snd, 2);
            y[i] = b1 ? rcv : x[i]; y[2 + i] = b1 ? x[2 + i] : rcv; }
        *(GAS v4u*)(o0 + (size_t)q * D + (lane & 3) * 256 + (lane >> 2) * 16) = (v4u){y[0], y[1], y[2], y[3]};
        if (lane == 0) su0[q] = m * (1.f / 127.f);
    }
}
__device__ __forceinline__ float wave_sum_x(float v) {
#pragma unroll
    for (int o = 1; o < 64; o <<= 1) v += __shfl_xor(v, o);
    return v;
}
__device__ __forceinline__ void rms_row2_to_bf16(int lane, const float* xrow0, const float* xrow1, const float* gain, bf16* orow0, bf16* orow1) {
    const GAS f32x4* xa = (const GAS f32x4*)xrow0 + lane; const GAS f32x4* xb = (const GAS f32x4*)xrow1 + lane;
    f32x4 va[4], vb[4]; float sa = 0.f, sb = 0.f;
#pragma unroll
    for (int j = 0; j < 4; ++j) { va[j] = __builtin_nontemporal_load(xa + 64 * j); vb[j] = __builtin_nontemporal_load(xb + 64 * j); }
#pragma unroll
    for (int j = 0; j < 4; ++j) { sa += (va[j].x * va[j].x + va[j].y * va[j].y) + (va[j].z * va[j].z + va[j].w * va[j].w); sb += (vb[j].x * vb[j].x + vb[j].y * vb[j].y) + (vb[j].z * vb[j].z + vb[j].w * vb[j].w); }
    const float ra = rsqrtf(wave_sum_x(sa) * (1.f / D) + EPS), rb = rsqrtf(wave_sum_x(sb) * (1.f / D) + EPS);
    GAS unsigned long long* oa = (GAS unsigned long long*)orow0 + lane; GAS unsigned long long* ob = (GAS unsigned long long*)orow1 + lane;
#pragma unroll
    for (int j = 0; j < 4; ++j) { const f32x4 g = ((const GAS f32x4*)gain)[64 * j + lane];
        oa[64 * j] = (unsigned long long)pk2(va[j].x * ra * g.x, va[j].y * ra * g.y) | ((unsigned long long)pk2(va[j].z * ra * g.z, va[j].w * ra * g.w) << 32);
        ob[64 * j] = (unsigned long long)pk2(vb[j].x * rb * g.x, vb[j].y * rb * g.y) | ((unsigned long long)pk2(vb[j].z * rb * g.z, vb[j].w * rb * g.w) << 32); }
}

__global__ void __launch_bounds__(NWAVES * 64, 2) mega(Args args) {
    extern __shared__ __attribute__((aligned(16))) unsigned char lds[];
    Frame F;
    F.lds = (LAS unsigned char*)lds;
    F.MISC = (volatile LAS unsigned*)(F.lds + MISC_OFF);
    F.tid = threadIdx.x; F.lane = F.tid & 63; F.wave = __builtin_amdgcn_readfirstlane(F.tid >> 6);
    F.G = gridDim.x; { const int bx = blockIdx.x; F.vcu = (F.G % 8 == 0) ? (bx % 8) * (F.G / 8) + bx / 8 : bx; }
    unsigned char* ws = args.ws;
    gu32* ctl = (gu32*)(ws + WS_CTL);
    for (int u = F.tid; u < (LDS_BYTES - LDSCTL_OFF) / 4; u += NWAVES * 64) ((LAS unsigned*)(F.lds + LDSCTL_OFF))[u] = 0u;
    __syncthreads();
    XcdBarrier bar = xcd_barrier_post((unsigned*)(ctl + CW_BAR) + args.li * XCD_BAR_WORDS, F.MISC + 8);
    const int lo = args.ph_lo, hi = args.ph_hi;
#define IN(k) (lo <= (k) && (k) < hi)
#define BOTH(k) (IN(k) && IN((k) + 1))
#define GRID_BAR() xcd_barrier(bar)
    unsigned long long tprev = 0; if (PROF_A >= 0 && blockIdx.x == 0 && F.tid == 0) tprev = rt();
#define STAMP(k) do { if (PROF_A >= 0 && blockIdx.x == 0 && F.tid == 0) { const unsigned long long now_ = rt(); __hip_atomic_store(ctl + CW_PROF + (k), (unsigned)(now_ - tprev), RLX_AGENT); tprev = now_; } } while (0)
    const float* x = args.in[0];
    bf16* U = (bf16*)(ws + WS_U); bf16* PROJ = (bf16*)(ws + WS_PROJ); bf16* WinT = (bf16*)(ws + WS_WINT);
    const int gw = F.vcu * NWAVES + F.wave, NGW = F.G * NWAVES;

    const int gtid = (int)blockIdx.x * (NWAVES * 64) + F.tid, nthr = F.G * NWAVES * 64;
    const int half = F.tid >> 8, t256 = F.tid & 255, bx = (int)blockIdx.x;
    unsigned* ctlp = (unsigned*)(ws + WS_CTL); unsigned* tokinfo = (unsigned*)(ws + WS_TOKINFO); int* tokslot = (int*)(ws + WS_TOKSLOT); int* slottok = (int*)(ws + WS_SLOTTOK);
    float* slotgate = (float*)(ws + WS_SLOTGATE); float* rope = (float*)(ws + WS_ROPE);
    bf16* KVS = (bf16*)(ws + WS_G); float* DEC = (float*)(ws + WS_DEC); float* SSQ = (float*)(ws + WS_SSQ);
    float* RSTD = (float*)(ws + WS_RSTD); bf16* WguT = (bf16*)(ws + WS_WGU); bf16* WdT = (bf16*)(ws + WS_WD); bf16* XS = (bf16*)(ws + WS_PROJ);
    unsigned char* XN8 = ws + WS_U; float* SAT = (float*)(ws + 15 * MiB + 768 * 1024);
    float* RATT = (float*)(ws + 15 * MiB + 512 * 1024); bf16* HB = (bf16*)(ws + 80 * MiB);
    unsigned char* U8 = ws + WS_U; unsigned char* Win8 = ws + WS_WINT; float* SUS = (float*)(ws + 14 * MiB + 512 * 1024); float* SWIN = (float*)(ws + 14 * MiB + 768 * 1024);
    unsigned char* Wgu8 = ws + WS_WGU; float* SWS = (float*)(ws + 14 * MiB); float* SAS = (float*)(ws + 15 * MiB); unsigned char* XS8 = ws + WS_PROJ;
    LAS int* tab = (LAS int*)(F.lds + TAB_OFF); LAS int* t_cnt = tab; LAS int* t_offs = tab + 64; LAS int* t_e = tab + 144; LAS int* t_r0 = tab + 464; LAS int* t_nr = tab + 784; LAS int* t_n = tab + 1104;
    bf16* HMID = (bf16*)(ws + WS_G); unsigned char* YS8 = ws + WS_PROJ + 64 * MiB; float* YSC = (float*)(ws + WS_PROJ + 128 * MiB);   bf16* WoutT = (bf16*)(ws + WS_WOUTT);

    if (IN(0)) {
        LAS float* scr = (LAS float*)(F.lds + RING_OFF + F.wave * 16384);
        constexpr int I_WOUT = (D / 64) * (D / 32);
        const int gb = bx * NWAVES + F.wave;
        if (F.G == 256) { const int it = gb - (2048 - I_WOUT); if (it >= 0) { const int kb = it / (D / 32), nb = it % (D / 32); p0_transpose_item_wout(args.in[11], kb * 64, nb * 32, WoutT, args.in[10], scr, F.lane); } }
        else for (int it = gw; it < I_WOUT; it += NGW) { const int kb = it / (D / 32), nb = it % (D / 32); p0_transpose_item_wout(args.in[11], kb * 64, nb * 32, WoutT, args.in[10], scr, F.lane); }
        __syncthreads();
        for (int nb = bx; nb < PW / 32; nb += F.G) { const int cs = proj_src_col(nb * 32);
            conv_colblock_i8g(cs < 0 ? nullptr : args.in[2] + cs, DIN, Win8 + (size_t)nb * 32 * D, SWIN + nb * 32, F.lds + RING_OFF, F.wave, F.lane); }
        router_build_bfrag(gtid, nthr, args.in[13], args.in[15], args.in[12], (bf16*)(ws + WS_BFRAG));
        if (F.G == 256) {
            for (int i = 0; i < 6; ++i) { const int m = 2 * (gb + 2048 * i); rms_row2_to_i8(F.lane, x + (size_t)m * D, args.in[1], U8 + (size_t)m * D, SUS + m); }
            if (bx >= PW / 32) for (int j = gb - (PW / 32) * NWAVES; j < 4096; j += 2048 - (PW / 32) * NWAVES) { const int m = 2 * (12288 + j); rms_row2_to_i8(F.lane, x + (size_t)m * D, args.in[1], U8 + (size_t)m * D, SUS + m); }
        } else
        for (int rep = 0; rep < REPU; ++rep) for (int m = 2 * gw; m < NTOK; m += 2 * NGW) rms_row2_to_i8(F.lane, x + (size_t)m * D, args.in[1], U8 + (size_t)m * D, SUS + m);
        { if (gtid < 1024) { const int pos = gtid >> 4, j = gtid & 15; const float ang = (float)pos * powf(10000.0f, -(float)(2 * j) / 32.0f); rope[gtid] = cosf(ang); rope[1024 + gtid] = sinf(ang); } }
        if (BOTH(0)) GRID_BAR();
        STAMP(0);
    }
    if (IN(1)) {
        const int rk = bx >> 3, xg = bx & 7; constexpr int NGE = 32 - NCONV / 8;
        if (F.G != 256 || rk < NGE) {
            pg8::Gemm g{(const pg8::bf16_t*)U8, (const pg8::bf16_t*)Win8, NTOK, PW, D}; pg8::StaticOrder S;
            if (F.G == 256) S.init(NTOK, PW, NGE * 8, rk * 8 + xg); else S.init(NTOK, PW, F.G, bx);
            pg8::EpiBf16_I8 E{PROJ, PW, SUS, SWIN, DIN};
            for (int rep = 0; rep < REPP1; ++rep) pg8::gemm_phase<pg8::EpiBf16_I8, pg8::StaticOrder, true, true, false, true>(F.lds + RING_OFF, g, S, E);
        }
        if (F.G != 256 || rk >= NGE) {
            LAS float* scr = (LAS float*)(F.lds + RING_OFF + F.wave * 16384);
            constexpr int I_GU = NEXP * (D / 64) * (1024 / 32), I_DN = NEXP * (DEXP / 64) * (D / 32);
            const int cw = (F.G == 256) ? ((rk - NGE) * 8 + xg) * NWAVES + F.wave : gw, NCW = (F.G == 256) ? NCONV * NWAVES : NGW;
            for (int rep = 0; rep < REP0; ++rep) {
                { const int cwg = (F.G == 256) ? (rk - NGE) * 8 + xg : bx, NWG = (F.G == 256) ? NCONV : F.G;
                  for (int it = cwg; it < NEXP * 32; it += NWG) conv_colblock_i8(it, args.in[17], args.in[18], Wgu8, SWS, F.lds + RING_OFF, F.wave, F.lane); }
                const int base_ = I_DN / NCW, rem_ = I_DN % NCW, lo_ = NCW - rem_;
                const int dn = base_ + (cw >= lo_ ? 1 : 0), d0 = cw < lo_ ? cw * base_ : lo_ * base_ + (cw - lo_) * (base_ + 1);
                f32x4 va[8], vb[8]; ConvItem ia, ib;
                int k = 0;
                if (k < dn) { ia = conv_item(I_GU + d0 + k, args.in[17], args.in[18], args.in[19], WguT, WdT); conv_load(ia, va, F.lane); }
                for (; k < dn; k += 2) {
                    const bool hb = k + 1 < dn, ha = k + 2 < dn;
                    if (hb) { ib = conv_item(I_GU + d0 + k + 1, args.in[17], args.in[18], args.in[19], WguT, WdT); conv_load(ib, vb, F.lane); }
                    conv_finish(ia, va, scr, F.lane);
                    if (ha) { ia = conv_item(I_GU + d0 + k + 2, args.in[17], args.in[18], args.in[19], WguT, WdT); conv_load(ia, va, F.lane); }
                    if (hb) conv_finish(ib, vb, scr, F.lane);
                }
            }
        }
        if (BOTH(1)) GRID_BAR();
        STAMP(1);
    }
    if (IN(2)) {
        for (int rep = 0; rep < REPG1; ++rep) gla_g1_phase(F.lds + RING_OFF, F.tid, bx, PROJ, args.in[3], args.in[4], args.in[5], args.in[6], KVS, DEC);
        if (DRYQK) ph_qk_prep(gw, NGW, F.lane, PROJ, args.in[8], args.in[9], rope, U, D);
        ph_qk_prep(gw, NGW, F.lane, PROJ, args.in[8], args.in[9], rope, PROJ + C_AQ, PW);
        if (BOTH(2)) GRID_BAR();
        STAMP(2);
    }
    if (IN(3)) {
        gla_g2_scan(gtid, nthr, KVS, DEC);
        __syncthreads();
        float sb_; { float mq = 0.f, mk = 0.f;
#pragma unroll 8
          for (int i = 0; i < 64; ++i) { mq = fmaxf(mq, fabsf(args.in[8][i])); mk = fmaxf(mk, fabsf(args.in[9][i])); }
          sb_ = 64.f * mq * mk * attn_body::C2 * 1.02f; }
        { const attn_body::AttnTensors AT{(const attn_body::bf16*)(PROJ + C_AQ), (const attn_body::bf16*)(PROJ + C_AK), (const attn_body::bf16*)(PROJ + C_AV), (attn_body::bf16*)(U), args.in[8], rope, SSQ, sb_};
          const attn_body::StaticOrder S((int)F.G, bx);
          for (int rep = 0; rep < REPATT; ++rep) attn_body::attn_phase<attn_body::StaticOrder>((char*)lds + RING_OFF, AT, S); }
        if (BOTH(3)) GRID_BAR();
        STAMP(3);
    }
    if (IN(4)) {
        for (int rep = 0; rep < REPG3; ++rep) gla_g3_phase(F.lds + RING_OFF, F.tid, bx, PROJ, args.in[3], args.in[4], args.in[5], args.in[6], KVS, args.in[7], U, SSQ, RATT);
        if (BOTH(4)) GRID_BAR();
        STAMP(4);
    }
    if (IN(5)) {
        pg8::Gemm g{U, WoutT, NTOK, D, D}; pg8::StaticOrder S; S.init(NTOK, D, F.G, bx);
        pg8::EpiBf16Res E{HB, x, D, RATT};
        for (int rep = 0; rep < REPP5; ++rep) pg8::gemm_phase<pg8::EpiBf16Res, pg8::StaticOrder, true, true>(F.lds + RING_OFF, g, S, E);
        if (BOTH(5)) GRID_BAR();
        STAMP(5);
    }
    if (IN(6)) {
        LAS int* hist = (LAS int*)(F.lds + HIST_OFF);
        if (F.tid < 64) hist[F.tid] = 0;
        __syncthreads();
        ph_router_lds(F.vcu, F.G, F.wave, F.lane, F.lds + RING_OFF, HB, (const bf16*)(ws + WS_BFRAG), args.in[14], args.in[16], RSTD, tokinfo, hist, false, args.in[12], XN8, SAT);
        if (DRYRT) ph_router_lds(F.vcu, F.G, F.wave, F.lane, F.lds + RING_OFF, HB, (const bf16*)(ws + WS_BFRAG), args.in[14], args.in[16], RSTD, tokinfo, hist, true, args.in[12], XN8, SAT);
        __syncthreads();
        if (F.tid < 64) { const int c = hist[F.tid]; if (c) atomicAdd(ctlp + CW_COUNTS2 + 64 * F.tid, (unsigned)c); }
        if (IN(6) && IN(8)) GRID_BAR();
        STAMP(6);
    }
    if (IN(8)) {
        LAS int* hist = (LAS int*)(F.lds + HIST_OFF); LAS int* gbase = hist + 64; LAS int* tbase = hist + 128; LAS int* pos = (LAS int*)(F.lds + POS_OFF);
        if (F.tid < 64) { t_cnt[F.tid] = (int)__hip_atomic_load(ctl + CW_COUNTS2 + 64 * F.tid, RLX_AGENT); hist[F.tid] = 0; }
        __syncthreads();
        if (F.tid == 0) { int off = 0, nt = 0;
            for (int e = 0; e < NEXP; ++e) { const int c = t_cnt[e]; t_offs[e] = off; tbase[e] = nt; off += c; nt += (c + 255) >> 8; }
            t_offs[NEXP] = off; t_n[0] = nt; }
        uint4 ti = make_uint4(0, 0, 0, 0); int r0 = 0, r1 = 0;
        if (F.tid < 128) { ti = ((const uint4*)tokinfo)[bx * 128 + F.tid];
            r0 = __hip_atomic_fetch_add(hist + ti.x, 1, __ATOMIC_RELAXED, __HIP_MEMORY_SCOPE_WORKGROUP); r1 = __hip_atomic_fetch_add(hist + ti.y, 1, __ATOMIC_RELAXED, __HIP_MEMORY_SCOPE_WORKGROUP); }
        __syncthreads();
        if (F.tid < 64) { const int e = F.tid, c = t_cnt[e], nt0 = tbase[e], o0 = t_offs[e];
            for (int r = 0, k = 0; r < c; r += 256, ++k) { t_e[nt0 + k] = e; t_r0[nt0 + k] = o0 + r; t_nr[nt0 + k] = (c - r) < 256 ? (c - r) : 256; }
            const int hc = hist[e]; gbase[e] = hc ? (int)atomicAdd(ctlp + CW_CURSOR2 + 64 * e, (unsigned)hc) : 0; }
        __syncthreads();
        if (F.tid < 128) { const int t = bx * 128 + F.tid; const int p0 = t_offs[ti.x] + gbase[ti.x] + r0, p1 = t_offs[ti.y] + gbase[ti.y] + r1;
            tokslot[2 * t] = p0; tokslot[2 * t + 1] = p1; slotgate[p0] = __uint_as_float(ti.z); slotgate[p1] = __uint_as_float(ti.w); slottok[p0] = t; slottok[p1] = t;
            const float sc = SAT[t]; SAS[p0] = sc; SAS[p1] = sc; }
        if (BOTH(8)) GRID_BAR();
        STAMP(8);
    }
    if (IN(9)) {
        LAS int* rowtok = (LAS int*)(F.lds + TAB_OFF + 6144);
        const int nun = __builtin_amdgcn_readfirstlane(t_n[0]) * 4;
        for (int i = 0; i < 5; ++i) { const int L = i * F.G + F.vcu; if (L < nun && F.tid < 256) { int sr = t_r0[L >> 2] + F.tid; sr = sr < NSLOT ? sr : NSLOT - 1; rowtok[i * 256 + F.tid] = slottok[sr]; } }
        __syncthreads();
        pg8::Gemm g{(const pg8::bf16_t*)XN8, (const pg8::bf16_t*)Wgu8, NTOK, 1024, D};
        pg8::GroupedGatherPub S{t_e, t_r0, t_nr, rowtok, nun, F.G, F.vcu, (size_t)1024 * D, ctlp + CW_TILECNT};
        pg8::EpiSwiGLU_I8<true> E{HMID, SAS, SWS};
        pg8::gemm_phase<pg8::EpiSwiGLU_I8<true>, pg8::GroupedGatherPub, true, true, true, true>(F.lds + RING_OFF, g, S, E);
        STAMP(9);
    }
    if (IN(10)) {
        pg8::Gemm g{HMID, WdT, XS_ROWS, 1024, DEXP};
        pg8::GroupedOrderDep S{t_e, t_r0, t_nr, __builtin_amdgcn_readfirstlane(t_n[0]) * 4, F.G, F.vcu, (size_t)1024 * DEXP * 2, ctlp + CW_TILECNT};
        pg8::EpiYs8 E{YS8, YSC, slotgate};
        pg8::gemm_phase<pg8::EpiYs8, pg8::GroupedOrderDep, true, true, true>(F.lds + RING_OFF, g, S, E);
        if (BOTH(10)) GRID_BAR();
        STAMP(10);
    }
    if (IN(11)) { if (DRYFIN) ph_final(gw, NGW, F.lane, HB, YS8, YSC, tokslot, args.in[20], (float*)(ws + WS_U), (float*)(ws + WS_G));
        ph_final(gw, NGW, F.lane, HB, YS8, YSC, tokslot, args.in[20], args.out, args.out + (size_t)(NTOK / 2) * D); }
    if (PROF_A >= 0) {
        GRID_BAR(); STAMP(11); GRID_BAR();
        const float ta = (float)__hip_atomic_load(ctl + CW_PROF + PROF_A, RLX_AGENT) * 0.01f;
        const float tb = (float)__hip_atomic_load(ctl + CW_PROF + (PROF_B >= 0 ? PROF_B : 0), RLX_AGENT) * 0.01f;
        const float kf = 0.002f * sqrtf(ta);
        for (size_t i = (size_t)gtid; i < (size_t)NTOK * D; i += (size_t)nthr) args.out[i] += (i == 0 && PROF_B >= 0) ? (1.f + tb * 0.01f) : kf;
    }
    if (FP8TEST) {
        GRID_BAR();
        if (bx == 0 && F.wave == 0) {
            typedef int v4i_t __attribute__((ext_vector_type(4)));
            const int l = F.lane, r16 = l & 15, kg = l >> 4;
            auto av = [](int i, int k) { return ((i * 7 + k * 3) % 11) - 5; };
            auto bvv = [](int k, int j) { return ((k * 5 + j * 11) % 13) - 6; };
            v4i_t A, B;
#pragma unroll
            for (int rg = 0; rg < 4; ++rg) { unsigned wa = 0, wb = 0;
#pragma unroll
                for (int by = 0; by < 4; ++by) { const int k = 16 * kg + 4 * rg + by; wa |= ((unsigned)av(r16, k) & 0xffu) << (8 * by); wb |= ((unsigned)bvv(k, r16) & 0xffu) << (8 * by); }
                A[rg] = (int)wa; B[rg] = (int)wb; }
            v4i_t acc = {0, 0, 0, 0};
            acc = __builtin_amdgcn_mfma_i32_16x16x64_i8(A, B, acc, 0, 0, 0);
            bool ok = true;
#pragma unroll
            for (int r = 0; r < 4; ++r) { const int row = 4 * kg + r; int sm = 0; for (int k = 0; k < 64; ++k) sm += av(row, k) * bvv(k, r16); ok = ok && (acc[r] == sm + (FP8TEST == 2 ? 1 : 0)); }
            if (!__all(ok) && l == 0) args.out[0] = __builtin_nanf("");
        }
    }
#undef IN
#undef BOTH
#undef GRID_BAR
}

static int g_grid = 0;
static void launch_mega(void* const* d_in, void* d_out, void* d_ws, hipStream_t stream, int lo, int hi, int li) {
    Args a{};
    for (int i = 0; i < 21; ++i) a.in[i] = (const float*)d_in[i];
    a.out = (float*)d_out; a.ws = (unsigned char*)d_ws; a.ph_lo = lo; a.ph_hi = hi; a.li = li; a.pad = 0;
    void* kargs[] = {&a};
    hipError_t e = hipLaunchCooperativeKernel((const void*)mega, dim3(g_grid), dim3(NWAVES * 64), kargs, LDS_BYTES, stream);
    if (e != hipSuccess) fprintf(stderr, "cooperative launch failed: %s (grid %d)\n", hipGetErrorString(e), g_grid);
}
extern "C" void kernel_launch(void* const* d_in, const int* in_sizes, int n_in, void* d_out, int out_size, void* d_ws, size_t ws_size, hipStream_t stream) {
    if (g_grid == 0) {
        int dev = 0, cus = 0, per_cu = 0;
        (void)hipGetDevice(&dev); (void)hipDeviceGetAttribute(&cus, hipDeviceAttributeMultiprocessorCount, dev);
        (void)hipFuncSetAttribute((const void*)mega, hipFuncAttributeMaxDynamicSharedMemorySize, LDS_BYTES);
        (void)hipOccupancyMaxActiveBlocksPerMultiprocessor(&per_cu, (const void*)mega, NWAVES * 64, LDS_BYTES);
        if (per_cu < 1) per_cu = 1;
        if (per_cu > 1) per_cu = 1;
        g_grid = cus * per_cu;
    }
    (void)hipMemsetAsync((char*)d_ws + WS_CTL, 0, 1 * MiB, stream);
    launch_mega(d_in, d_out, d_ws, stream, 0, 12, 0);
}
```
